# Optimizing an MI355X kernel written in HIP

```python
import math
import jax, jax.numpy as jnp
from jax import lax
import numpy as np

D_MODEL = 1024
BATCH = 8
SEQ = 2048
DEPTH = 2

ATTN_WIDTH = D_MODEL // 2
SSM_WIDTH = D_MODEL // 2
HEAD_DIM = 64
N_Q_HEADS = ATTN_WIDTH // HEAD_DIM
N_KV_HEADS = 2
Q_PER_KV = N_Q_HEADS // N_KV_HEADS
KV_WIDTH = N_KV_HEADS * HEAD_DIM
WINDOW = 128
ATTN_BLOCK = 128
ROPE_THETA = 10000.0

SSM_GROUP_CH = 16
SSM_GROUPS = SSM_WIDTH // SSM_GROUP_CH
SSM_STATE = 64

IN_WIDTH = ATTN_WIDTH + 2 * KV_WIDTH + SSM_WIDTH

N_EXPERTS = 16
N_EXPERT_GROUPS = 4
EXPERTS_PER_GROUP = N_EXPERTS // N_EXPERT_GROUPS
TOP_K = 2
D_FF_EXPERT = D_MODEL // 2

EPS = 1e-6

kernel_name = "hymba_swa_s5_grouped_moe_adaln"


def rmsnorm(x, g):
    xf = x.astype(jnp.float32)
    y = xf * lax.rsqrt(jnp.mean(xf * xf, axis=-1, keepdims=True) + EPS)
    return (y * g.astype(jnp.float32)).astype(x.dtype)


def rope(x, pos):
    half = HEAD_DIM // 2
    freq = ROPE_THETA ** (-jnp.arange(half, dtype=jnp.float32) / half)
    ang = pos.astype(jnp.float32)[..., None] * freq
    cos = jnp.cos(ang)[:, :, None, :]
    sin = jnp.sin(ang)[:, :, None, :]
    xf = x.astype(jnp.float32)
    x1, x2 = xf[..., :half], xf[..., half:]
    out = jnp.concatenate([x1 * cos - x2 * sin, x2 * cos + x1 * sin], axis=-1)
    return out.astype(x.dtype)


def swa_attention(q, k, v, sink):
    bsz, s = q.shape[0], q.shape[1]
    nb = s // ATTN_BLOCK
    qb = q.reshape(bsz, nb, ATTN_BLOCK, N_KV_HEADS, Q_PER_KV, HEAD_DIM)
    kb = k.reshape(bsz, nb, ATTN_BLOCK, N_KV_HEADS, HEAD_DIM)
    vb = v.reshape(bsz, nb, ATTN_BLOCK, N_KV_HEADS, HEAD_DIM)
    pad = ((0, 0), (1, 0), (0, 0), (0, 0), (0, 0))
    kk = jnp.concatenate([jnp.pad(kb, pad)[:, :-1], kb], axis=2)
    vv = jnp.concatenate([jnp.pad(vb, pad)[:, :-1], vb], axis=2)
    scores = jnp.einsum('bnqkgd,bnskd->bnkgqs', qb, kk).astype(jnp.float32) * (HEAD_DIM ** -0.5)
    qi = jnp.arange(ATTN_BLOCK)[:, None]
    sj = jnp.arange(2 * ATTN_BLOCK)[None, :]
    diff = qi + ATTN_BLOCK - sj
    band = (diff >= 0) & (diff < WINDOW)
    real_key = (jnp.arange(nb)[:, None, None] > 0) | (sj >= ATTN_BLOCK)[None]
    mask = (band[None] & real_key)[None, :, None, None]
    scores = jnp.where(mask, scores, -jnp.inf)
    sink_l = jnp.broadcast_to(
        sink.astype(jnp.float32).reshape(N_KV_HEADS, Q_PER_KV)[None, None, :, :, None, None],
        scores.shape[:-1] + (1,))
    p = jax.nn.softmax(jnp.concatenate([scores, sink_l], axis=-1), axis=-1)[..., :-1]
    out = jnp.einsum('bnkgqs,bnskd->bnqkgd', p.astype(v.dtype), vv)
    return out.reshape(bsz, s, N_Q_HEADS * HEAD_DIM)


def _ssm_combine(e1, e2):
    a1, b1 = e1
    a2, b2 = e2
    return a1 * a2, a2 * b1 + b2


def s5_mixer(u, lam_re, lam_im, b_re, b_im, c_re, c_im, d_skip, log_dt, w_glu):
    bsz, s, _ = u.shape
    f32 = jnp.float32
    uf = u.astype(f32).reshape(bsz, s, SSM_GROUPS, SSM_GROUP_CH)
    lam = lax.complex(lam_re.astype(f32), lam_im.astype(f32))
    dt = jnp.exp(log_dt.astype(f32))[:, None]
    lam_bar = jnp.exp(lam * dt)
    b_c = lax.complex(b_re.astype(f32), b_im.astype(f32))
    b_bar = ((lam_bar - 1.0) / lam)[..., None] * b_c
    bu = jnp.einsum('blgh,gph->blgp', uf.astype(jnp.complex64), b_bar)
    a = jnp.broadcast_to(lam_bar, bu.shape)
    _, states = lax.associative_scan(_ssm_combine, (a, bu), axis=1)
    c_c = lax.complex(c_re.astype(f32), c_im.astype(f32))
    y = jnp.real(jnp.einsum('blgp,ghp->blgh', states, c_c))
    y = y + d_skip.astype(f32).reshape(SSM_GROUPS, SSM_GROUP_CH) * uf
    y = jax.nn.gelu(y.reshape(bsz, s, SSM_WIDTH))
    y = y * jax.nn.sigmoid(y @ w_glu.astype(f32))
    return y.astype(u.dtype)


def moe_ffn(h, w_router, router_bias, w_gate, w_up, w_down):
    bsz, s, d = h.shape
    t = h.reshape(-1, d)
    logits = t.astype(jnp.float32) @ w_router.astype(jnp.float32)
    probs = jax.nn.softmax(logits, axis=-1)
    sel = probs + router_bias.astype(jnp.float32)
    grp = sel.reshape(-1, N_EXPERT_GROUPS, EXPERTS_PER_GROUP)
    gscore = lax.top_k(grp, TOP_K)[0].sum(-1)
    gbest = jnp.argmax(gscore, axis=-1)
    in_group = (jnp.arange(N_EXPERTS) // EXPERTS_PER_GROUP)[None, :] == gbest[:, None]
    _, idx = lax.top_k(jnp.where(in_group, sel, -jnp.inf), TOP_K)
    gates = jnp.take_along_axis(probs, idx, axis=-1)
    gates = gates / jnp.sum(gates, axis=-1, keepdims=True)
    combine = jnp.sum(jax.nn.one_hot(idx, N_EXPERTS, dtype=jnp.float32) * gates[..., None], axis=1)
    g = jnp.einsum('td,edf->tef', t, w_gate)
    up = jnp.einsum('td,edf->tef', t, w_up)
    act = jax.nn.silu(g) * up * combine.astype(t.dtype)[..., None]
    y = jnp.einsum('tef,efd->td', act, w_down)
    return y.reshape(bsz, s, d)


def setup_inputs(seed: int = 0) -> dict:
    key = jax.random.key(seed)
    ks = jax.random.split(key, 32)
    f32 = jnp.float32
    nrm = lambda k, shp, sc: jax.random.normal(k, shp, f32) * sc
    x = nrm(ks[0], (BATCH, SEQ, D_MODEL), 1.0)
    c = nrm(ks[1], (BATCH, D_MODEL), 1.0)
    offs = jax.random.randint(ks[2], (BATCH, 1), 0, 1024, dtype=jnp.int32)
    positions = offs + jnp.arange(SEQ, dtype=jnp.int32)[None, :]
    ada_w = nrm(ks[3], (DEPTH, D_MODEL, 6 * D_MODEL), 0.5 * D_MODEL ** -0.5)
    ada_b = nrm(ks[4], (DEPTH, 6 * D_MODEL), 0.02)
    norm1_g = 1.0 + nrm(ks[5], (DEPTH, D_MODEL), 0.02)
    w_in = nrm(ks[6], (DEPTH, D_MODEL, IN_WIDTH), D_MODEL ** -0.5)
    q_norm_g = 1.0 + nrm(ks[7], (DEPTH, HEAD_DIM), 0.02)
    k_norm_g = 1.0 + nrm(ks[8], (DEPTH, HEAD_DIM), 0.02)
    attn_sink = nrm(ks[9], (DEPTH, N_Q_HEADS), 0.5)
    n = jnp.arange(SSM_STATE, dtype=f32)
    lam_re = -0.5 + nrm(ks[10], (DEPTH, SSM_GROUPS, SSM_STATE), 0.01)
    lam_im = math.pi * n + nrm(ks[11], (DEPTH, SSM_GROUPS, SSM_STATE), 0.01)
    b_sc = (2.0 * SSM_GROUP_CH) ** -0.5
    ssm_b_re = nrm(ks[12], (DEPTH, SSM_GROUPS, SSM_STATE, SSM_GROUP_CH), b_sc)
    ssm_b_im = nrm(ks[13], (DEPTH, SSM_GROUPS, SSM_STATE, SSM_GROUP_CH), b_sc)
    c_sc = (2.0 * SSM_STATE) ** -0.5
    ssm_c_re = nrm(ks[14], (DEPTH, SSM_GROUPS, SSM_GROUP_CH, SSM_STATE), c_sc)
    ssm_c_im = nrm(ks[15], (DEPTH, SSM_GROUPS, SSM_GROUP_CH, SSM_STATE), c_sc)
    ssm_d = nrm(ks[16], (DEPTH, SSM_WIDTH), 1.0)
    ssm_log_dt = jax.random.uniform(ks[17], (DEPTH, SSM_GROUPS), f32, math.log(0.001), math.log(0.1))
    w_glu = nrm(ks[18], (DEPTH, SSM_WIDTH, SSM_WIDTH), SSM_WIDTH ** -0.5)
    attn_out_g = 1.0 + nrm(ks[19], (DEPTH, ATTN_WIDTH), 0.02)
    ssm_out_g = 1.0 + nrm(ks[20], (DEPTH, SSM_WIDTH), 0.02)
    w_out = nrm(ks[21], (DEPTH, ATTN_WIDTH + SSM_WIDTH, D_MODEL), (ATTN_WIDTH + SSM_WIDTH) ** -0.5)
    norm2_g = 1.0 + nrm(ks[22], (DEPTH, D_MODEL), 0.02)
    w_router = nrm(ks[23], (D_MODEL, N_EXPERTS), D_MODEL ** -0.5)
    router_bias = nrm(ks[24], (N_EXPERTS,), 0.01)
    w_exp_gate = nrm(ks[25], (DEPTH, N_EXPERTS, D_MODEL, D_FF_EXPERT), D_MODEL ** -0.5)
    w_exp_up = nrm(ks[26], (DEPTH, N_EXPERTS, D_MODEL, D_FF_EXPERT), D_MODEL ** -0.5)
    w_exp_down = nrm(ks[27], (DEPTH, N_EXPERTS, D_FF_EXPERT, D_MODEL), D_FF_EXPERT ** -0.5)
    return {"x": x, "c": c, "positions": positions, "ada_w": ada_w, "ada_b": ada_b,
            "norm1_g": norm1_g, "w_in": w_in, "q_norm_g": q_norm_g, "k_norm_g": k_norm_g,
            "attn_sink": attn_sink, "lam_re": lam_re, "lam_im": lam_im,
            "ssm_b_re": ssm_b_re, "ssm_b_im": ssm_b_im, "ssm_c_re": ssm_c_re, "ssm_c_im": ssm_c_im,
            "ssm_d": ssm_d, "ssm_log_dt": ssm_log_dt, "w_glu": w_glu,
            "attn_out_g": attn_out_g, "ssm_out_g": ssm_out_g, "w_out": w_out, "norm2_g": norm2_g,
            "w_router": w_router, "router_bias": router_bias,
            "w_exp_gate": w_exp_gate, "w_exp_up": w_exp_up, "w_exp_down": w_exp_down}


def reference(x, c, positions, ada_w, ada_b, norm1_g, w_in, q_norm_g, k_norm_g, attn_sink,
              lam_re, lam_im, ssm_b_re, ssm_b_im, ssm_c_re, ssm_c_im, ssm_d, ssm_log_dt, w_glu,
              attn_out_g, ssm_out_g, w_out, norm2_g, w_router, router_bias,
              w_exp_gate, w_exp_up, w_exp_down):
    bsz, s, _ = x.shape
    for l in range(DEPTH):
        mod = jax.nn.silu(c) @ ada_w[l] + ada_b[l]
        sh1, sc1, g1, sh2, sc2, g2 = jnp.split(mod, 6, axis=-1)
        h = rmsnorm(x, norm1_g[l]) * (1.0 + sc1[:, None]) + sh1[:, None]
        proj = h @ w_in[l]
        q = proj[..., :ATTN_WIDTH].reshape(bsz, s, N_Q_HEADS, HEAD_DIM)
        k = proj[..., ATTN_WIDTH:ATTN_WIDTH + KV_WIDTH].reshape(bsz, s, N_KV_HEADS, HEAD_DIM)
        v = proj[..., ATTN_WIDTH + KV_WIDTH:ATTN_WIDTH + 2 * KV_WIDTH].reshape(bsz, s, N_KV_HEADS, HEAD_DIM)
        u = proj[..., ATTN_WIDTH + 2 * KV_WIDTH:]
        q = rope(rmsnorm(q, q_norm_g[l]), positions)
        k = rope(rmsnorm(k, k_norm_g[l]), positions)
        attn = swa_attention(q, k, v, attn_sink[l])
        ssm = s5_mixer(u, lam_re[l], lam_im[l], ssm_b_re[l], ssm_b_im[l], ssm_c_re[l], ssm_c_im[l],
                       ssm_d[l], ssm_log_dt[l], w_glu[l])
        merged = jnp.concatenate([rmsnorm(attn, attn_out_g[l]), rmsnorm(ssm, ssm_out_g[l])], axis=-1)
        x = x + g1[:, None] * (merged @ w_out[l])
        h2 = rmsnorm(x, norm2_g[l]) * (1.0 + sc2[:, None]) + sh2[:, None]
        x = x + g2[:, None] * moe_ffn(h2, w_router, router_bias, w_exp_gate[l], w_exp_up[l], w_exp_down[l])
    return x
```

```cpp
#include <hip/hip_runtime.h>
#include <stdint.h>

namespace {
constexpr int D = 1024, NB = 8, S = 2048, T = NB * S, DEPTH = 2;
constexpr int AW = 512, HD = 64, NQ = 8, NKV = 2, INW = 1280;
constexpr int SG = 32, SCH = 16, SP = 64, SW = 512;
constexpr int NE = 16, DFF = 512;
constexpr int NBUCKET = 24;
constexpr float EPS = 1e-6f;

struct Ptrs {
  const float *x, *c; const int* pos; const float *ada_w, *ada_b, *norm1_g, *w_in, *q_norm_g, *k_norm_g, *attn_sink,
      *lam_re, *lam_im, *b_re, *b_im, *c_re, *c_im, *ssm_d, *log_dt, *w_glu, *attn_out_g, *ssm_out_g, *w_out, *norm2_g,
      *w_router, *router_bias, *w_gate, *w_up, *w_down;
};

__device__ __forceinline__ float wave_sum(float v) {
#pragma unroll
  for (int o = 32; o > 0; o >>= 1) v += __shfl_xor(v, o);
  return v;
}

__global__ void __launch_bounds__(256) k_mod(const float* __restrict__ c, const float* __restrict__ ada_w,
                                             const float* __restrict__ ada_b, float* __restrict__ mod) {
  __shared__ float sc[8 * 1024];
  for (int i = threadIdx.x; i < 8192; i += 256) { float v = c[i]; sc[i] = v / (1.f + expf(-v)); }
  __syncthreads();
  int col = blockIdx.x * 256 + threadIdx.x;
  int l = col / 6144, j = col % 6144;
  float acc[8];
#pragma unroll
  for (int b = 0; b < 8; ++b) acc[b] = 0.f;
  const float* w = ada_w + (size_t)l * 1024 * 6144 + j;
  for (int k = 0; k < 1024; ++k) {
    float wv = w[(size_t)k * 6144];
#pragma unroll
    for (int b = 0; b < 8; ++b) acc[b] += sc[b * 1024 + k] * wv;
  }
#pragma unroll
  for (int b = 0; b < 8; ++b) mod[(size_t)(l * 8 + b) * 6144 + j] = acc[b] + ada_b[l * 6144 + j];
}

__global__ void k_cs(const int* __restrict__ pos, float2* __restrict__ cs) {
  int i = blockIdx.x * 256 + threadIdx.x;
  int t = i >> 5, f = i & 31;
  float freq = powf(10000.f, -(float)f / 32.f);
  float ang = (float)pos[t] * freq;
  float sn, cn; sincosf(ang, &sn, &cn);
  cs[i] = make_float2(cn, sn);
}

__global__ void __launch_bounds__(256) k_norm(const float* __restrict__ x, const float* __restrict__ g,
                                              const float* __restrict__ modl, int shi, int sci, float* __restrict__ h) {
  int t = blockIdx.x * 4 + (threadIdx.x >> 6), lane = threadIdx.x & 63, b = t / S;
  const float* xr = x + (size_t)t * D;
  float v[16]; float ss = 0.f;
#pragma unroll
  for (int i = 0; i < 16; ++i) { v[i] = xr[lane + 64 * i]; ss += v[i] * v[i]; }
  ss = wave_sum(ss);
  float rinv = rsqrtf(ss * (1.f / D) + EPS);
  const float* sh = modl + (size_t)b * 6144 + shi * 1024;
  const float* sc = modl + (size_t)b * 6144 + sci * 1024;
#pragma unroll
  for (int i = 0; i < 16; ++i) { int d = lane + 64 * i; h[(size_t)t * D + d] = v[i] * rinv * g[d] * (1.f + sc[d]) + sh[d]; }
}

struct GemmArgs {
  const float* A;
  const int* rowtok;
  const float* W0; const float* W1;
  int lda, ldw, ksplit, M, N, K;
};

template <class Epi>
__device__ __forceinline__ void gemm_tile(const GemmArgs& g, int m0, int n0, Epi& epi) {
  __shared__ float sA[16][68];
  __shared__ float sB[16][68];
  const int tid = threadIdx.x, tx = tid & 15, ty = tid >> 4;
  float acc[4][4];
#pragma unroll
  for (int i = 0; i < 4; ++i)
#pragma unroll
    for (int j = 0; j < 4; ++j) acc[i][j] = 0.f;
  const int ar = tid >> 2, ak = (tid & 3) * 4;
  int arow = m0 + ar;
  long asrc = -1;
  if (arow < g.M) { if (g.rowtok) { int tk = g.rowtok[arow]; asrc = tk; } else asrc = arow; }
  const int bk = tid >> 4, bn = (tid & 15) * 4;
  for (int k0 = 0; k0 < g.K; k0 += 16) {
    float4 av = make_float4(0, 0, 0, 0);
    if (asrc >= 0) av = *(const float4*)(g.A + (size_t)asrc * g.lda + k0 + ak);
    int kk = k0 + bk;
    const float* wrow = (kk < g.ksplit) ? (g.W0 + (size_t)kk * g.ldw) : (g.W1 + (size_t)(kk - g.ksplit) * g.ldw);
    float4 bv = *(const float4*)(wrow + n0 + bn);
    __syncthreads();
    sA[ak + 0][ar] = av.x; sA[ak + 1][ar] = av.y; sA[ak + 2][ar] = av.z; sA[ak + 3][ar] = av.w;
    *(float4*)&sB[bk][bn] = bv;
    __syncthreads();
#pragma unroll
    for (int k = 0; k < 16; ++k) {
      float4 a = *(const float4*)&sA[k][ty * 4];
      float4 b = *(const float4*)&sB[k][tx * 4];
      float aa[4] = {a.x, a.y, a.z, a.w}, bb[4] = {b.x, b.y, b.z, b.w};
#pragma unroll
      for (int i = 0; i < 4; ++i)
#pragma unroll
        for (int j = 0; j < 4; ++j) acc[i][j] += aa[i] * bb[j];
    }
  }
#pragma unroll
  for (int i = 0; i < 4; ++i)
#pragma unroll
    for (int j = 0; j < 4; ++j) epi(m0 + ty * 4 + i, n0 + tx * 4 + j, acc[i][j]);
}

struct EpiStore { float* C; long ldc; __device__ void operator()(int m, int n, float v) { C[(size_t)m * ldc + n] = v; } };
struct EpiGlu { const float* y; float* ssm; __device__ void operator()(int m, int n, float v) { float yy = y[(size_t)m * SW + n]; ssm[(size_t)m * SW + n] = yy / (1.f + expf(-v)); } };
struct EpiOut { const float* x; const float* modl; float* x1; __device__ void operator()(int m, int n, float v) {
  int b = m / S; float g1 = modl[(size_t)b * 6144 + 2 * 1024 + n]; x1[(size_t)m * D + n] = x[(size_t)m * D + n] + g1 * v; } };

template <class Epi>
__global__ void __launch_bounds__(256) k_gemm(GemmArgs g, Epi epi) { gemm_tile(g, blockIdx.y * 64, blockIdx.x * 64, epi); }

__global__ void __launch_bounds__(256) k_qknorm(float* __restrict__ proj, const float* __restrict__ qg, const float* __restrict__ kg,
                                                const float2* __restrict__ cs) {
  int i = blockIdx.x * 256 + threadIdx.x;
  int t = i / 10, hh = i % 10;
  float* p = proj + (size_t)t * INW + hh * 64;
  const float* g = hh < 8 ? qg : kg;
  float v[64]; float ss = 0.f;
#pragma unroll
  for (int j = 0; j < 64; ++j) { v[j] = p[j]; ss += v[j] * v[j]; }
  float rinv = rsqrtf(ss * (1.f / 64.f) + EPS);
#pragma unroll
  for (int j = 0; j < 32; ++j) {
    float2 c = cs[(size_t)t * 32 + j];
    float x1 = v[j] * rinv * g[j], x2 = v[j + 32] * rinv * g[j + 32];
    p[j] = x1 * c.x - x2 * c.y; p[j + 32] = x2 * c.x + x1 * c.y;
  }
}

__global__ void __launch_bounds__(256) k_attn(const float* __restrict__ proj, const float* __restrict__ sink, float* __restrict__ attn) {
  int i = blockIdx.x * 256 + threadIdx.x;
  int t = i >> 3, h = i & 7, kvh = h >> 2;
  int s = t % S;
  const float* q = proj + (size_t)t * INW + h * 64;
  float qv[64], o[64];
#pragma unroll
  for (int j = 0; j < 64; ++j) { qv[j] = q[j] * 0.125f; o[j] = 0.f; }
  float m = sink[h], l = 1.f;
  int j0 = s - 127; if (j0 < 0) j0 = 0;
  for (int sj = j0; sj <= s; ++sj) {
    const float* kr = proj + (size_t)(t - s + sj) * INW + 512 + kvh * 64;
    const float* vr = kr + 128;
    float sc = 0.f;
#pragma unroll
    for (int j = 0; j < 64; ++j) sc += qv[j] * kr[j];
    float mn = fmaxf(m, sc), a = expf(m - mn), p = expf(sc - mn);
    l = l * a + p; m = mn;
#pragma unroll
    for (int j = 0; j < 64; ++j) o[j] = o[j] * a + p * vr[j];
  }
  float inv = 1.f / l;
#pragma unroll
  for (int j = 0; j < 64; ++j) attn[(size_t)t * AW + h * 64 + j] = o[j] * inv;
}

__global__ void __launch_bounds__(64) k_ssm(const float* __restrict__ proj, Ptrs P, int l, float* __restrict__ y) {
  __shared__ float su[32][16];
  __shared__ float sre[32][64], sim[32][64];
  __shared__ float cre[16][64], cim[16][64];
  const int b = blockIdx.x / SG, g = blockIdx.x % SG, p = threadIdx.x;
  const float dt = expf(P.log_dt[l * SG + g]);
  const float lr = P.lam_re[(l * SG + g) * SP + p], li = P.lam_im[(l * SG + g) * SP + p];
  const float mag = expf(lr * dt);
  float sn, cn; sincosf(li * dt, &sn, &cn);
  const float ar = mag * cn, ai = mag * sn;
  const float den = lr * lr + li * li;
  const float fr = ((ar - 1.f) * lr + ai * li) / den, fi = (ai * lr - (ar - 1.f) * li) / den;
  float Br[16], Bi[16];
#pragma unroll
  for (int h = 0; h < 16; ++h) {
    float br = P.b_re[((size_t)(l * SG + g) * SP + p) * SCH + h], bi = P.b_im[((size_t)(l * SG + g) * SP + p) * SCH + h];
    Br[h] = fr * br - fi * bi; Bi[h] = fr * bi + fi * br;
  }
  for (int i = p; i < 16 * 64; i += 64) {
    cre[i / 64][i % 64] = P.c_re[(size_t)(l * SG + g) * SCH * SP + i];
    cim[i / 64][i % 64] = P.c_im[(size_t)(l * SG + g) * SCH * SP + i];
  }
  float dsk[8];
#pragma unroll
  for (int i = 0; i < 8; ++i) dsk[i] = P.ssm_d[l * SW + g * 16 + ((p + 64 * i) & 15)];
  float xr = 0.f, xi = 0.f;
  for (int t0 = 0; t0 < S; t0 += 32) {
    __syncthreads();
#pragma unroll
    for (int i = 0; i < 8; ++i) { int o = p + 64 * i; su[o >> 4][o & 15] = proj[(size_t)(b * S + t0 + (o >> 4)) * INW + 768 + g * 16 + (o & 15)]; }
    __syncthreads();
    for (int tt = 0; tt < 32; ++tt) {
      float bur = 0.f, bui = 0.f;
#pragma unroll
      for (int h = 0; h < 16; ++h) { float uu = su[tt][h]; bur += Br[h] * uu; bui += Bi[h] * uu; }
      float nr = ar * xr - ai * xi + bur, ni = ar * xi + ai * xr + bui;
      xr = nr; xi = ni;
      sre[tt][p] = xr; sim[tt][p] = xi;
    }
    __syncthreads();
#pragma unroll
    for (int i = 0; i < 8; ++i) {
      int o = p + 64 * i, tt = o >> 4, h = o & 15;
      float acc = 0.f;
      for (int pp = 0; pp < 64; ++pp) acc += cre[h][pp] * sre[tt][pp] - cim[h][pp] * sim[tt][pp];
      acc += dsk[i] * su[tt][h];
      float u3 = acc * acc * acc;
      float ge = 0.5f * acc * (1.f + tanhf(0.7978845608028654f * (acc + 0.044715f * u3)));
      y[(size_t)(b * S + t0 + tt) * SW + g * 16 + h] = ge;
    }
  }
}

__global__ void __launch_bounds__(256) k_merge(const float* __restrict__ attn, const float* __restrict__ ssm,
                                               const float* __restrict__ ga, const float* __restrict__ gs, float* __restrict__ merged) {
  int t = blockIdx.x * 4 + (threadIdx.x >> 6), lane = threadIdx.x & 63;
  float a[8], s[8]; float sa = 0.f, ssq = 0.f;
#pragma unroll
  for (int i = 0; i < 8; ++i) { a[i] = attn[(size_t)t * AW + lane + 64 * i]; s[i] = ssm[(size_t)t * SW + lane + 64 * i]; sa += a[i] * a[i]; ssq += s[i] * s[i]; }
  sa = wave_sum(sa); ssq = wave_sum(ssq);
  float ra = rsqrtf(sa * (1.f / 512.f) + EPS), rs = rsqrtf(ssq * (1.f / 512.f) + EPS);
#pragma unroll
  for (int i = 0; i < 8; ++i) { int d = lane + 64 * i; merged[(size_t)t * D + d] = a[i] * ra * ga[d]; merged[(size_t)t * D + 512 + d] = s[i] * rs * gs[d]; }
}

__global__ void __launch_bounds__(256) k_route(const float* __restrict__ h2, const float* __restrict__ wr, const float* __restrict__ rb,
                                               int* __restrict__ cnt, int* __restrict__ list, float2* __restrict__ tokw, int* __restrict__ tokpair) {
  int t = blockIdx.x * 4 + (threadIdx.x >> 6), lane = threadIdx.x & 63;
  float lg[16];
#pragma unroll
  for (int e = 0; e < 16; ++e) lg[e] = 0.f;
  for (int i = 0; i < 16; ++i) {
    int k = lane + 64 * i; float hv = h2[(size_t)t * D + k];
    const float4* w4 = (const float4*)(wr + (size_t)k * 16);
#pragma unroll
    for (int q = 0; q < 4; ++q) { float4 w = w4[q]; lg[q * 4] += hv * w.x; lg[q * 4 + 1] += hv * w.y; lg[q * 4 + 2] += hv * w.z; lg[q * 4 + 3] += hv * w.w; }
  }
#pragma unroll
  for (int e = 0; e < 16; ++e) lg[e] = wave_sum(lg[e]);
  float mx = lg[0];
#pragma unroll
  for (int e = 1; e < 16; ++e) mx = fmaxf(mx, lg[e]);
  float pr[16], sel[16]; float sum = 0.f;
#pragma unroll
  for (int e = 0; e < 16; ++e) { pr[e] = expf(lg[e] - mx); sum += pr[e]; }
  float inv = 1.f / sum;
#pragma unroll
  for (int e = 0; e < 16; ++e) { pr[e] *= inv; sel[e] = pr[e] + rb[e]; }
  int gbest = 0; float gbs = -1e30f;
#pragma unroll
  for (int g = 0; g < 4; ++g) {
    float m1 = -1e30f, m2 = -1e30f;
#pragma unroll
    for (int j = 0; j < 4; ++j) { float v = sel[g * 4 + j]; if (v > m1) { m2 = m1; m1 = v; } else if (v > m2) m2 = v; }
    float gs = m1 + m2;
    if (gs > gbs) { gbs = gs; gbest = g; }
  }
  float s4[4], p4[4];
#pragma unroll
  for (int g = 0; g < 4; ++g) if (g == gbest) {
#pragma unroll
    for (int j = 0; j < 4; ++j) { s4[j] = sel[g * 4 + j]; p4[j] = pr[g * 4 + j]; }
  }
  int i0 = 0; float b0 = s4[0];
#pragma unroll
  for (int j = 1; j < 4; ++j) if (s4[j] > b0) { b0 = s4[j]; i0 = j; }
  int i1 = -1; float b1 = -1e30f;
#pragma unroll
  for (int j = 0; j < 4; ++j) if (j != i0 && s4[j] > b1) { b1 = s4[j]; i1 = j; }
  float p0 = 0.f, p1 = 0.f;
#pragma unroll
  for (int j = 0; j < 4; ++j) { if (j == i0) p0 = p4[j]; if (j == i1) p1 = p4[j]; }
  float w0 = p0 / (p0 + p1), w1 = p1 / (p0 + p1);
  int lo = i0 < i1 ? i0 : i1, hi = i0 < i1 ? i1 : i0;
  float wlo = i0 < i1 ? w0 : w1, whi = i0 < i1 ? w1 : w0;
  int pidx = (lo == 0) ? (hi - 1) : (lo == 1 ? (hi + 1) : 5);
  int bucket = gbest * 6 + pidx;
  if (lane == 0) {
    int pos = atomicAdd(&cnt[bucket], 1);
    list[bucket * T + pos] = t;
    tokw[t] = make_float2(wlo, whi);
    tokpair[t] = bucket;
  }
}

__device__ __forceinline__ void bucket_experts(int bucket, int& elo, int& ehi) {
  int g = bucket / 6, pi = bucket % 6;
  int lo = pi < 3 ? 0 : (pi < 5 ? 1 : 2);
  int hi = pi < 3 ? pi + 1 : (pi < 5 ? pi - 1 : 3);
  elo = g * 4 + lo; ehi = g * 4 + hi;
}

template <int TM>
__device__ __forceinline__ bool find_tile(const int* cnt, int mt, int& bucket, int& tib, int& slot0) {
  int acc = 0;
  for (int bk = 0; bk < NBUCKET; ++bk) {
    int nt = (cnt[bk] + TM - 1) / TM;
    if (mt < acc + nt) { bucket = bk; tib = mt - acc; slot0 = (acc + tib) * TM; return true; }
    acc += nt;
  }
  return false;
}

__global__ void __launch_bounds__(256) k_moe_gu(const float* __restrict__ h2, const float* __restrict__ wg, const float* __restrict__ wu,
                                                const int* __restrict__ cnt, const int* __restrict__ list, const float2* __restrict__ tokw,
                                                float* __restrict__ act) {
  int bucket, tib, slot0;
  if (!find_tile<64>(cnt, blockIdx.y, bucket, tib, slot0)) return;
  int elo, ehi; bucket_experts(bucket, elo, ehi);
  const int n0 = blockIdx.x * 64;
  const int e = n0 < 512 ? elo : ehi, f0 = n0 & 511;
  const float* Wg = wg + (size_t)e * D * DFF + f0;
  const float* Wu = wu + (size_t)e * D * DFF + f0;
  __shared__ float sA[16][68];
  __shared__ float sG[16][68];
  __shared__ float sU[16][68];
  const int tid = threadIdx.x, tx = tid & 15, ty = tid >> 4;
  float ag[4][4], au[4][4];
#pragma unroll
  for (int i = 0; i < 4; ++i)
#pragma unroll
    for (int j = 0; j < 4; ++j) { ag[i][j] = 0.f; au[i][j] = 0.f; }
  const int ar = tid >> 2, ak = (tid & 3) * 4;
  int pos = tib * 64 + ar;
  long asrc = pos < cnt[bucket] ? list[bucket * T + pos] : -1;
  const int bk = tid >> 4, bn = (tid & 15) * 4;
  for (int k0 = 0; k0 < D; k0 += 16) {
    float4 av = make_float4(0, 0, 0, 0);
    if (asrc >= 0) av = *(const float4*)(h2 + (size_t)asrc * D + k0 + ak);
    float4 gv = *(const float4*)(Wg + (size_t)(k0 + bk) * DFF + bn);
    float4 uv = *(const float4*)(Wu + (size_t)(k0 + bk) * DFF + bn);
    __syncthreads();
    sA[ak + 0][ar] = av.x; sA[ak + 1][ar] = av.y; sA[ak + 2][ar] = av.z; sA[ak + 3][ar] = av.w;
    *(float4*)&sG[bk][bn] = gv; *(float4*)&sU[bk][bn] = uv;
    __syncthreads();
#pragma unroll
    for (int k = 0; k < 16; ++k) {
      float4 a = *(const float4*)&sA[k][ty * 4];
      float4 g4 = *(const float4*)&sG[k][tx * 4];
      float4 u4 = *(const float4*)&sU[k][tx * 4];
      float aa[4] = {a.x, a.y, a.z, a.w}, gg[4] = {g4.x, g4.y, g4.z, g4.w}, uu[4] = {u4.x, u4.y, u4.z, u4.w};
#pragma unroll
      for (int i = 0; i < 4; ++i)
#pragma unroll
        for (int j = 0; j < 4; ++j) { ag[i][j] += aa[i] * gg[j]; au[i][j] += aa[i] * uu[j]; }
    }
  }
#pragma unroll
  for (int i = 0; i < 4; ++i) {
    int r = ty * 4 + i, ps = tib * 64 + r;
    float w = 0.f;
    if (ps < cnt[bucket]) { int tk = list[bucket * T + ps]; float2 ww = tokw[tk]; w = n0 < 512 ? ww.x : ww.y; }
#pragma unroll
    for (int j = 0; j < 4; ++j) {
      float gv = ag[i][j], uv = au[i][j];
      act[(size_t)(slot0 + r) * D + n0 + tx * 4 + j] = gv / (1.f + expf(-gv)) * uv * w;
    }
  }
}

struct EpiDown { const float* x1; const float* modl; float* out; const int* rowtok; __device__ void operator()(int m, int n, float v) {
  int tk = rowtok[m]; if (tk < 0) return; int b = tk / S; float g2 = modl[(size_t)b * 6144 + 5 * 1024 + n];
  out[(size_t)tk * D + n] = x1[(size_t)tk * D + n] + g2 * v; } };

__global__ void __launch_bounds__(256) k_moe_down(const float* __restrict__ act, const float* __restrict__ wd, const int* __restrict__ cnt,
                                                  const int* __restrict__ list, const float* __restrict__ x1, const float* __restrict__ modl,
                                                  float* __restrict__ out) {
  int bucket, tib, slot0;
  if (!find_tile<64>(cnt, blockIdx.y, bucket, tib, slot0)) return;
  int elo, ehi; bucket_experts(bucket, elo, ehi);
  __shared__ int stok[64];
  if (threadIdx.x < 64) { int ps = tib * 64 + threadIdx.x; stok[threadIdx.x] = ps < cnt[bucket] ? list[bucket * T + ps] : -1; }
  __syncthreads();
  GemmArgs g{}; g.A = act + (size_t)slot0 * D; g.lda = D; g.rowtok = nullptr;
  g.W0 = wd + (size_t)elo * DFF * D; g.W1 = wd + (size_t)ehi * DFF * D; g.ldw = D; g.ksplit = DFF; g.M = 64; g.N = D; g.K = D;
  EpiDown epi{x1, modl, out, stok};
  gemm_tile(g, 0, blockIdx.x * 64, epi);
}

}

extern "C" void kernel_launch(void* const* d_in, const int* in_sizes, int n_in, void* d_out, int out_size, void* d_ws,
                              size_t ws_size, hipStream_t stream) {
  Ptrs P;
  P.x = (const float*)d_in[0]; P.c = (const float*)d_in[1]; P.pos = (const int*)d_in[2];
  P.ada_w = (const float*)d_in[3]; P.ada_b = (const float*)d_in[4]; P.norm1_g = (const float*)d_in[5];
  P.w_in = (const float*)d_in[6]; P.q_norm_g = (const float*)d_in[7]; P.k_norm_g = (const float*)d_in[8];
  P.attn_sink = (const float*)d_in[9]; P.lam_re = (const float*)d_in[10]; P.lam_im = (const float*)d_in[11];
  P.b_re = (const float*)d_in[12]; P.b_im = (const float*)d_in[13]; P.c_re = (const float*)d_in[14]; P.c_im = (const float*)d_in[15];
  P.ssm_d = (const float*)d_in[16]; P.log_dt = (const float*)d_in[17]; P.w_glu = (const float*)d_in[18];
  P.attn_out_g = (const float*)d_in[19]; P.ssm_out_g = (const float*)d_in[20]; P.w_out = (const float*)d_in[21];
  P.norm2_g = (const float*)d_in[22]; P.w_router = (const float*)d_in[23]; P.router_bias = (const float*)d_in[24];
  P.w_gate = (const float*)d_in[25]; P.w_up = (const float*)d_in[26]; P.w_down = (const float*)d_in[27];
  float* out = (float*)d_out;

  char* w = (char*)d_ws; size_t off = 0;
  auto take = [&](size_t bytes) { char* p = w + off; off += (bytes + 255) & ~(size_t)255; return p; };
  float* mod = (float*)take((size_t)DEPTH * 8 * 6144 * 4);
  float2* cs = (float2*)take((size_t)T * 32 * 8);
  int* cnt = (int*)take(256 * DEPTH);
  int* list = (int*)take((size_t)NBUCKET * T * 4);
  float2* tokw = (float2*)take((size_t)T * 8);
  int* tokpair = (int*)take((size_t)T * 4);
  float* bufA = (float*)take((size_t)T * D * 4);
  float* proj = (float*)take((size_t)T * INW * 4);
  float* attn = (float*)take((size_t)T * AW * 4);
  float* yb = (float*)take((size_t)T * SW * 4);
  float* x1 = (float*)take((size_t)T * D * 4);
  float* ssm = x1;
  (void)ws_size; (void)in_sizes; (void)n_in; (void)out_size;

  (void)hipMemsetAsync(cnt, 0, 256 * DEPTH, stream);
  k_mod<<<DEPTH * 6144 / 256, 256, 0, stream>>>(P.c, P.ada_w, P.ada_b, mod);
  k_cs<<<T * 32 / 256, 256, 0, stream>>>(P.pos, cs);

  for (int l = 0; l < DEPTH; ++l) {
    const float* xin = l == 0 ? P.x : out;
    const float* modl = mod + (size_t)l * 8 * 6144;
    k_norm<<<T / 4, 256, 0, stream>>>(xin, P.norm1_g + l * D, modl, 0, 1, bufA);
    { GemmArgs g{}; g.A = bufA; g.lda = D; g.rowtok = nullptr; g.W0 = P.w_in + (size_t)l * D * INW; g.W1 = g.W0; g.ldw = INW; g.ksplit = D; g.M = T; g.N = INW; g.K = D;
      k_gemm<<<dim3(INW / 64, T / 64), 256, 0, stream>>>(g, EpiStore{proj, INW}); }
    k_qknorm<<<T * 10 / 256, 256, 0, stream>>>(proj, P.q_norm_g + l * HD, P.k_norm_g + l * HD, cs);
    k_attn<<<T * 8 / 256, 256, 0, stream>>>(proj, P.attn_sink + l * NQ, attn);
    k_ssm<<<NB * SG, 64, 0, stream>>>(proj, P, l, yb);
    { GemmArgs g{}; g.A = yb; g.lda = SW; g.rowtok = nullptr; g.W0 = P.w_glu + (size_t)l * SW * SW; g.W1 = g.W0; g.ldw = SW; g.ksplit = SW; g.M = T; g.N = SW; g.K = SW;
      k_gemm<<<dim3(SW / 64, T / 64), 256, 0, stream>>>(g, EpiGlu{yb, ssm}); }
    k_merge<<<T / 4, 256, 0, stream>>>(attn, ssm, P.attn_out_g + l * AW, P.ssm_out_g + l * SW, bufA);
    { GemmArgs g{}; g.A = bufA; g.lda = D; g.rowtok = nullptr; g.W0 = P.w_out + (size_t)l * D * D; g.W1 = g.W0; g.ldw = D; g.ksplit = D; g.M = T; g.N = D; g.K = D;
      k_gemm<<<dim3(D / 64, T / 64), 256, 0, stream>>>(g, EpiOut{xin, modl, x1}); }
    k_norm<<<T / 4, 256, 0, stream>>>(x1, P.norm2_g + l * D, modl, 3, 4, bufA);
    int* cntl = cnt + l * 64;
    k_route<<<T / 4, 256, 0, stream>>>(bufA, P.w_router, P.router_bias, cntl, list, tokw, tokpair);
    k_moe_gu<<<dim3(D / 64, T / 64 + NBUCKET), 256, 0, stream>>>(bufA, P.w_gate + (size_t)l * NE * D * DFF, P.w_up + (size_t)l * NE * D * DFF,
                                                                 cntl, list, tokw, proj);
    k_moe_down<<<dim3(D / 64, T / 64 + NBUCKET), 256, 0, stream>>>(proj, P.w_down + (size_t)l * NE * DFF * D, cntl, list, x1, modl, out);
  }
}
```

```cpp
#include <hip/hip_runtime.h>
#include <hip/hip_cooperative_groups.h>
#include <stdint.h>
#include <cstdio>
#include <cstring>

namespace {

constexpr int D = 1024, NB = 8, S = 2048, T = NB * S, DEPTH = 2;
constexpr int AW = 512, HD = 64, NQ = 8, NKV = 2, INW = 1280;
constexpr int SG = 32, SCH = 16, SP = 64, SW = 512;
constexpr int NE = 16, DFF = 512;
constexpr int NBUCKET = 24;
constexpr float EPS = 1e-6f;

struct Ptrs {
  const float *x, *c; const int* pos; const float *ada_w, *ada_b, *norm1_g, *w_in, *q_norm_g, *k_norm_g, *attn_sink,
      *lam_re, *lam_im, *b_re, *b_im, *c_re, *c_im, *ssm_d, *log_dt, *w_glu, *attn_out_g, *ssm_out_g, *w_out, *norm2_g,
      *w_router, *router_bias, *w_gate, *w_up, *w_down;
};

__device__ __forceinline__ float wave_sum(float v) {
#pragma unroll
  for (int o = 32; o > 0; o >>= 1) v += __shfl_xor(v, o);
  return v;
}

__global__ void __launch_bounds__(256) k_mod(const float* __restrict__ c, const float* __restrict__ ada_w,
                                             const float* __restrict__ ada_b, float* __restrict__ mod) {
  __shared__ float sc[8 * 1024];
  for (int i = threadIdx.x; i < 8192; i += 256) { float v = c[i]; sc[i] = v / (1.f + expf(-v)); }
  __syncthreads();
  int col = blockIdx.x * 256 + threadIdx.x;
  int l = col / 6144, j = col % 6144;
  float acc[8];
#pragma unroll
  for (int b = 0; b < 8; ++b) acc[b] = 0.f;
  const float* w = ada_w + (size_t)l * 1024 * 6144 + j;
  for (int k = 0; k < 1024; ++k) {
    float wv = w[(size_t)k * 6144];
#pragma unroll
    for (int b = 0; b < 8; ++b) acc[b] += sc[b * 1024 + k] * wv;
  }
#pragma unroll
  for (int b = 0; b < 8; ++b) mod[(size_t)(l * 8 + b) * 6144 + j] = acc[b] + ada_b[l * 6144 + j];
}

__global__ void k_cs(const int* __restrict__ pos, float2* __restrict__ cs) {
  int i = blockIdx.x * 256 + threadIdx.x;
  int t = i >> 5, f = i & 31;
  float freq = powf(10000.f, -(float)f / 32.f);
  float ang = (float)pos[t] * freq;
  float sn, cn; sincosf(ang, &sn, &cn);
  cs[i] = make_float2(cn, sn);
}

__global__ void __launch_bounds__(256) k_norm(const float* __restrict__ x, const float* __restrict__ g,
                                              const float* __restrict__ modl, int shi, int sci, float* __restrict__ h) {
  int t = blockIdx.x * 4 + (threadIdx.x >> 6), lane = threadIdx.x & 63, b = t / S;
  const float* xr = x + (size_t)t * D;
  float v[16]; float ss = 0.f;
#pragma unroll
  for (int i = 0; i < 16; ++i) { v[i] = xr[lane + 64 * i]; ss += v[i] * v[i]; }
  ss = wave_sum(ss);
  float rinv = rsqrtf(ss * (1.f / D) + EPS);
  const float* sh = modl + (size_t)b * 6144 + shi * 1024;
  const float* sc = modl + (size_t)b * 6144 + sci * 1024;
#pragma unroll
  for (int i = 0; i < 16; ++i) { int d = lane + 64 * i; h[(size_t)t * D + d] = v[i] * rinv * g[d] * (1.f + sc[d]) + sh[d]; }
}

struct GemmArgs {
  const float* A;
  const int* rowtok;
  const float* W0; const float* W1;
  int lda, ldw, ksplit, M, N, K;
};

template <class Epi>
__device__ __forceinline__ void gemm_tile(const GemmArgs& g, int m0, int n0, Epi& epi) {
  __shared__ float sA[16][68];
  __shared__ float sB[16][68];
  const int tid = threadIdx.x, tx = tid & 15, ty = tid >> 4;
  float acc[4][4];
#pragma unroll
  for (int i = 0; i < 4; ++i)
#pragma unroll
    for (int j = 0; j < 4; ++j) acc[i][j] = 0.f;
  const int ar = tid >> 2, ak = (tid & 3) * 4;
  int arow = m0 + ar;
  long asrc = -1;
  if (arow < g.M) { if (g.rowtok) { int tk = g.rowtok[arow]; asrc = tk; } else asrc = arow; }
  const int bk = tid >> 4, bn = (tid & 15) * 4;
  for (int k0 = 0; k0 < g.K; k0 += 16) {
    float4 av = make_float4(0, 0, 0, 0);
    if (asrc >= 0) av = *(const float4*)(g.A + (size_t)asrc * g.lda + k0 + ak);
    int kk = k0 + bk;
    const float* wrow = (kk < g.ksplit) ? (g.W0 + (size_t)kk * g.ldw) : (g.W1 + (size_t)(kk - g.ksplit) * g.ldw);
    float4 bv = *(const float4*)(wrow + n0 + bn);
    __syncthreads();
    sA[ak + 0][ar] = av.x; sA[ak + 1][ar] = av.y; sA[ak + 2][ar] = av.z; sA[ak + 3][ar] = av.w;
    *(float4*)&sB[bk][bn] = bv;
    __syncthreads();
#pragma unroll
    for (int k = 0; k < 16; ++k) {
      float4 a = *(const float4*)&sA[k][ty * 4];
      float4 b = *(const float4*)&sB[k][tx * 4];
      float aa[4] = {a.x, a.y, a.z, a.w}, bb[4] = {b.x, b.y, b.z, b.w};
#pragma unroll
      for (int i = 0; i < 4; ++i)
#pragma unroll
        for (int j = 0; j < 4; ++j) acc[i][j] += aa[i] * bb[j];
    }
  }
#pragma unroll
  for (int i = 0; i < 4; ++i)
#pragma unroll
    for (int j = 0; j < 4; ++j) epi(m0 + ty * 4 + i, n0 + tx * 4 + j, acc[i][j]);
}

struct EpiStore { float* C; long ldc; __device__ void operator()(int m, int n, float v) { C[(size_t)m * ldc + n] = v; } };
struct EpiGlu { const float* y; float* ssm; __device__ void operator()(int m, int n, float v) { float yy = y[(size_t)m * SW + n]; ssm[(size_t)m * SW + n] = yy / (1.f + expf(-v)); } };
struct EpiOut { const float* x; const float* modl; float* x1; __device__ void operator()(int m, int n, float v) {
  int b = m / S; float g1 = modl[(size_t)b * 6144 + 2 * 1024 + n]; x1[(size_t)m * D + n] = x[(size_t)m * D + n] + g1 * v; } };

template <class Epi>
__global__ void __launch_bounds__(256) k_gemm(GemmArgs g, Epi epi) { gemm_tile(g, blockIdx.y * 64, blockIdx.x * 64, epi); }

__global__ void __launch_bounds__(256) k_qknorm(float* __restrict__ proj, const float* __restrict__ qg, const float* __restrict__ kg,
                                                const float2* __restrict__ cs) {
  int i = blockIdx.x * 256 + threadIdx.x;
  int t = i / 10, hh = i % 10;
  float* p = proj + (size_t)t * INW + hh * 64;
  const float* g = hh < 8 ? qg : kg;
  float v[64]; float ss = 0.f;
#pragma unroll
  for (int j = 0; j < 64; ++j) { v[j] = p[j]; ss += v[j] * v[j]; }
  float rinv = rsqrtf(ss * (1.f / 64.f) + EPS);
#pragma unroll
  for (int j = 0; j < 32; ++j) {
    float2 c = cs[(size_t)t * 32 + j];
    float x1 = v[j] * rinv * g[j], x2 = v[j + 32] * rinv * g[j + 32];
    p[j] = x1 * c.x - x2 * c.y; p[j + 32] = x2 * c.x + x1 * c.y;
  }
}

__global__ void __launch_bounds__(256) k_attn(const float* __restrict__ proj, const float* __restrict__ sink, float* __restrict__ attn) {
  int i = blockIdx.x * 256 + threadIdx.x;
  int t = i >> 3, h = i & 7, kvh = h >> 2;
  int s = t % S;
  const float* q = proj + (size_t)t * INW + h * 64;
  float qv[64], o[64];
#pragma unroll
  for (int j = 0; j < 64; ++j) { qv[j] = q[j] * 0.125f; o[j] = 0.f; }
  float m = sink[h], l = 1.f;
  int j0 = s - 127; if (j0 < 0) j0 = 0;
  for (int sj = j0; sj <= s; ++sj) {
    const float* kr = proj + (size_t)(t - s + sj) * INW + 512 + kvh * 64;
    const float* vr = kr + 128;
    float sc = 0.f;
#pragma unroll
    for (int j = 0; j < 64; ++j) sc += qv[j] * kr[j];
    float mn = fmaxf(m, sc), a = expf(m - mn), p = expf(sc - mn);
    l = l * a + p; m = mn;
#pragma unroll
    for (int j = 0; j < 64; ++j) o[j] = o[j] * a + p * vr[j];
  }
  float inv = 1.f / l;
#pragma unroll
  for (int j = 0; j < 64; ++j) attn[(size_t)t * AW + h * 64 + j] = o[j] * inv;
}

__global__ void __launch_bounds__(64) k_ssm(const float* __restrict__ proj, Ptrs P, int l, float* __restrict__ y) {
  __shared__ float su[32][16];
  __shared__ float sre[32][64], sim[32][64];
  __shared__ float cre[16][64], cim[16][64];
  const int b = blockIdx.x / SG, g = blockIdx.x % SG, p = threadIdx.x;
  const float dt = expf(P.log_dt[l * SG + g]);
  const float lr = P.lam_re[(l * SG + g) * SP + p], li = P.lam_im[(l * SG + g) * SP + p];
  const float mag = expf(lr * dt);
  float sn, cn; sincosf(li * dt, &sn, &cn);
  const float ar = mag * cn, ai = mag * sn;
  const float den = lr * lr + li * li;
  const float fr = ((ar - 1.f) * lr + ai * li) / den, fi = (ai * lr - (ar - 1.f) * li) / den;
  float Br[16], Bi[16];
#pragma unroll
  for (int h = 0; h < 16; ++h) {
    float br = P.b_re[((size_t)(l * SG + g) * SP + p) * SCH + h], bi = P.b_im[((size_t)(l * SG + g) * SP + p) * SCH + h];
    Br[h] = fr * br - fi * bi; Bi[h] = fr * bi + fi * br;
  }
  for (int i = p; i < 16 * 64; i += 64) {
    cre[i / 64][i % 64] = P.c_re[(size_t)(l * SG + g) * SCH * SP + i];
    cim[i / 64][i % 64] = P.c_im[(size_t)(l * SG + g) * SCH * SP + i];
  }
  float dsk[8];
#pragma unroll
  for (int i = 0; i < 8; ++i) dsk[i] = P.ssm_d[l * SW + g * 16 + ((p + 64 * i) & 15)];
  float xr = 0.f, xi = 0.f;
  for (int t0 = 0; t0 < S; t0 += 32) {
    __syncthreads();
#pragma unroll
    for (int i = 0; i < 8; ++i) { int o = p + 64 * i; su[o >> 4][o & 15] = proj[(size_t)(b * S + t0 + (o >> 4)) * INW + 768 + g * 16 + (o & 15)]; }
    __syncthreads();
    for (int tt = 0; tt < 32; ++tt) {
      float bur = 0.f, bui = 0.f;
#pragma unroll
      for (int h = 0; h < 16; ++h) { float uu = su[tt][h]; bur += Br[h] * uu; bui += Bi[h] * uu; }
      float nr = ar * xr - ai * xi + bur, ni = ar * xi + ai * xr + bui;
      xr = nr; xi = ni;
      sre[tt][p] = xr; sim[tt][p] = xi;
    }
    __syncthreads();
#pragma unroll
    for (int i = 0; i < 8; ++i) {
      int o = p + 64 * i, tt = o >> 4, h = o & 15;
      float acc = 0.f;
      for (int pp = 0; pp < 64; ++pp) acc += cre[h][pp] * sre[tt][pp] - cim[h][pp] * sim[tt][pp];
      acc += dsk[i] * su[tt][h];
      float u3 = acc * acc * acc;
      float ge = 0.5f * acc * (1.f + tanhf(0.7978845608028654f * (acc + 0.044715f * u3)));
      y[(size_t)(b * S + t0 + tt) * SW + g * 16 + h] = ge;
    }
  }
}

__global__ void __launch_bounds__(256) k_merge(const float* __restrict__ attn, const float* __restrict__ ssm,
                                               const float* __restrict__ ga, const float* __restrict__ gs, float* __restrict__ merged) {
  int t = blockIdx.x * 4 + (threadIdx.x >> 6), lane = threadIdx.x & 63;
  float a[8], s[8]; float sa = 0.f, ssq = 0.f;
#pragma unroll
  for (int i = 0; i < 8; ++i) { a[i] = attn[(size_t)t * AW + lane + 64 * i]; s[i] = ssm[(size_t)t * SW + lane + 64 * i]; sa += a[i] * a[i]; ssq += s[i] * s[i]; }
  sa = wave_sum(sa); ssq = wave_sum(ssq);
  float ra = rsqrtf(sa * (1.f / 512.f) + EPS), rs = rsqrtf(ssq * (1.f / 512.f) + EPS);
#pragma unroll
  for (int i = 0; i < 8; ++i) { int d = lane + 64 * i; merged[(size_t)t * D + d] = a[i] * ra * ga[d]; merged[(size_t)t * D + 512 + d] = s[i] * rs * gs[d]; }
}

__global__ void __launch_bounds__(256) k_route(const float* __restrict__ h2, const float* __restrict__ wr, const float* __restrict__ rb,
                                               int* __restrict__ cnt, int* __restrict__ list, float2* __restrict__ tokw, int* __restrict__ tokpair) {
  int t = blockIdx.x * 4 + (threadIdx.x >> 6), lane = threadIdx.x & 63;
  float lg[16];
#pragma unroll
  for (int e = 0; e < 16; ++e) lg[e] = 0.f;
  for (int i = 0; i < 16; ++i) {
    int k = lane + 64 * i; float hv = h2[(size_t)t * D + k];
    const float4* w4 = (const float4*)(wr + (size_t)k * 16);
#pragma unroll
    for (int q = 0; q < 4; ++q) { float4 w = w4[q]; lg[q * 4] += hv * w.x; lg[q * 4 + 1] += hv * w.y; lg[q * 4 + 2] += hv * w.z; lg[q * 4 + 3] += hv * w.w; }
  }
#pragma unroll
  for (int e = 0; e < 16; ++e) lg[e] = wave_sum(lg[e]);
  float mx = lg[0];
#pragma unroll
  for (int e = 1; e < 16; ++e) mx = fmaxf(mx, lg[e]);
  float pr[16], sel[16]; float sum = 0.f;
#pragma unroll
  for (int e = 0; e < 16; ++e) { pr[e] = expf(lg[e] - mx); sum += pr[e]; }
  float inv = 1.f / sum;
#pragma unroll
  for (int e = 0; e < 16; ++e) { pr[e] *= inv; sel[e] = pr[e] + rb[e]; }
  int gbest = 0; float gbs = -1e30f;
#pragma unroll
  for (int g = 0; g < 4; ++g) {
    float m1 = -1e30f, m2 = -1e30f;
#pragma unroll
    for (int j = 0; j < 4; ++j) { float v = sel[g * 4 + j]; if (v > m1) { m2 = m1; m1 = v; } else if (v > m2) m2 = v; }
    float gs = m1 + m2;
    if (gs > gbs) { gbs = gs; gbest = g; }
  }
  float s4[4], p4[4];
#pragma unroll
  for (int g = 0; g < 4; ++g) if (g == gbest) {
#pragma unroll
    for (int j = 0; j < 4; ++j) { s4[j] = sel[g * 4 + j]; p4[j] = pr[g * 4 + j]; }
  }
  int i0 = 0; float b0 = s4[0];
#pragma unroll
  for (int j = 1; j < 4; ++j) if (s4[j] > b0) { b0 = s4[j]; i0 = j; }
  int i1 = -1; float b1 = -1e30f;
#pragma unroll
  for (int j = 0; j < 4; ++j) if (j != i0 && s4[j] > b1) { b1 = s4[j]; i1 = j; }
  float p0 = 0.f, p1 = 0.f;
#pragma unroll
  for (int j = 0; j < 4; ++j) { if (j == i0) p0 = p4[j]; if (j == i1) p1 = p4[j]; }
  float w0 = p0 / (p0 + p1), w1 = p1 / (p0 + p1);
  int lo = i0 < i1 ? i0 : i1, hi = i0 < i1 ? i1 : i0;
  float wlo = i0 < i1 ? w0 : w1, whi = i0 < i1 ? w1 : w0;
  int pidx = (lo == 0) ? (hi - 1) : (lo == 1 ? (hi + 1) : 5);
  int bucket = gbest * 6 + pidx;
  if (lane == 0) {
    int pos = atomicAdd(&cnt[bucket], 1);
    list[bucket * T + pos] = t;
    tokw[t] = make_float2(wlo, whi);
    tokpair[t] = bucket;
  }
}

__device__ __forceinline__ void bucket_experts(int bucket, int& elo, int& ehi) {
  int g = bucket / 6, pi = bucket % 6;
  int lo = pi < 3 ? 0 : (pi < 5 ? 1 : 2);
  int hi = pi < 3 ? pi + 1 : (pi < 5 ? pi - 1 : 3);
  elo = g * 4 + lo; ehi = g * 4 + hi;
}

template <int TM>
__device__ __forceinline__ bool find_tile(const int* cnt, int mt, int& bucket, int& tib, int& slot0) {
  int acc = 0;
  for (int bk = 0; bk < NBUCKET; ++bk) {
    int nt = (cnt[bk] + TM - 1) / TM;
    if (mt < acc + nt) { bucket = bk; tib = mt - acc; slot0 = (acc + tib) * TM; return true; }
    acc += nt;
  }
  return false;
}

__global__ void __launch_bounds__(256) k_moe_gu(const float* __restrict__ h2, const float* __restrict__ wg, const float* __restrict__ wu,
                                                const int* __restrict__ cnt, const int* __restrict__ list, const float2* __restrict__ tokw,
                                                float* __restrict__ act) {
  int bucket, tib, slot0;
  if (!find_tile<64>(cnt, blockIdx.y, bucket, tib, slot0)) return;
  int elo, ehi; bucket_experts(bucket, elo, ehi);
  const int n0 = blockIdx.x * 64;
  const int e = n0 < 512 ? elo : ehi, f0 = n0 & 511;
  const float* Wg = wg + (size_t)e * D * DFF + f0;
  const float* Wu = wu + (size_t)e * D * DFF + f0;
  __shared__ float sA[16][68];
  __shared__ float sG[16][68];
  __shared__ float sU[16][68];
  const int tid = threadIdx.x, tx = tid & 15, ty = tid >> 4;
  float ag[4][4], au[4][4];
#pragma unroll
  for (int i = 0; i < 4; ++i)
#pragma unroll
    for (int j = 0; j < 4; ++j) { ag[i][j] = 0.f; au[i][j] = 0.f; }
  const int ar = tid >> 2, ak = (tid & 3) * 4;
  int pos = tib * 64 + ar;
  long asrc = pos < cnt[bucket] ? list[bucket * T + pos] : -1;
  const int bk = tid >> 4, bn = (tid & 15) * 4;
  for (int k0 = 0; k0 < D; k0 += 16) {
    float4 av = make_float4(0, 0, 0, 0);
    if (asrc >= 0) av = *(const float4*)(h2 + (size_t)asrc * D + k0 + ak);
    float4 gv = *(const float4*)(Wg + (size_t)(k0 + bk) * DFF + bn);
    float4 uv = *(const float4*)(Wu + (size_t)(k0 + bk) * DFF + bn);
    __syncthreads();
    sA[ak + 0][ar] = av.x; sA[ak + 1][ar] = av.y; sA[ak + 2][ar] = av.z; sA[ak + 3][ar] = av.w;
    *(float4*)&sG[bk][bn] = gv; *(float4*)&sU[bk][bn] = uv;
    __syncthreads();
#pragma unroll
    for (int k = 0; k < 16; ++k) {
      float4 a = *(const float4*)&sA[k][ty * 4];
      float4 g4 = *(const float4*)&sG[k][tx * 4];
      float4 u4 = *(const float4*)&sU[k][tx * 4];
      float aa[4] = {a.x, a.y, a.z, a.w}, gg[4] = {g4.x, g4.y, g4.z, g4.w}, uu[4] = {u4.x, u4.y, u4.z, u4.w};
#pragma unroll
      for (int i = 0; i < 4; ++i)
#pragma unroll
        for (int j = 0; j < 4; ++j) { ag[i][j] += aa[i] * gg[j]; au[i][j] += aa[i] * uu[j]; }
    }
  }
#pragma unroll
  for (int i = 0; i < 4; ++i) {
    int r = ty * 4 + i, ps = tib * 64 + r;
    float w = 0.f;
    if (ps < cnt[bucket]) { int tk = list[bucket * T + ps]; float2 ww = tokw[tk]; w = n0 < 512 ? ww.x : ww.y; }
#pragma unroll
    for (int j = 0; j < 4; ++j) {
      float gv = ag[i][j], uv = au[i][j];
      act[(size_t)(slot0 + r) * D + n0 + tx * 4 + j] = gv / (1.f + expf(-gv)) * uv * w;
    }
  }
}

struct EpiDown { const float* x1; const float* modl; float* out; const int* rowtok; __device__ void operator()(int m, int n, float v) {
  int tk = rowtok[m]; if (tk < 0) return; int b = tk / S; float g2 = modl[(size_t)b * 6144 + 5 * 1024 + n];
  out[(size_t)tk * D + n] = x1[(size_t)tk * D + n] + g2 * v; } };

__global__ void __launch_bounds__(256) k_moe_down(const float* __restrict__ act, const float* __restrict__ wd, const int* __restrict__ cnt,
                                                  const int* __restrict__ list, const float* __restrict__ x1, const float* __restrict__ modl,
                                                  float* __restrict__ out) {
  int bucket, tib, slot0;
  if (!find_tile<64>(cnt, blockIdx.y, bucket, tib, slot0)) return;
  int elo, ehi; bucket_experts(bucket, elo, ehi);
  __shared__ int stok[64];
  if (threadIdx.x < 64) { int ps = tib * 64 + threadIdx.x; stok[threadIdx.x] = ps < cnt[bucket] ? list[bucket * T + ps] : -1; }
  __syncthreads();
  GemmArgs g{}; g.A = act + (size_t)slot0 * D; g.lda = D; g.rowtok = nullptr;
  g.W0 = wd + (size_t)elo * DFF * D; g.W1 = wd + (size_t)ehi * DFF * D; g.ldw = D; g.ksplit = DFF; g.M = 64; g.N = D; g.K = D;
  EpiDown epi{x1, modl, out, stok};
  gemm_tile(g, 0, blockIdx.x * 64, epi);
}


typedef unsigned short bf16_t;
typedef short bf16x8 __attribute__((ext_vector_type(8)));
typedef float f32x4 __attribute__((ext_vector_type(4)));
typedef float f32x16 __attribute__((ext_vector_type(16)));
typedef float f32x2 __attribute__((ext_vector_type(2)));
typedef __bf16 bf16x2_t __attribute__((ext_vector_type(2)));
typedef unsigned u32x4 __attribute__((ext_vector_type(4)));
typedef unsigned u32x2 __attribute__((ext_vector_type(2)));

constexpr int NTHR = 256;
constexpr int TM = 128;
constexpr int MAXMT = T / TM + NBUCKET;

__device__ __forceinline__ unsigned pack2(float lo, float hi) {
  f32x2 v = {lo, hi};
  return __builtin_bit_cast(unsigned, __builtin_convertvector(v, bf16x2_t));
}
__device__ __forceinline__ int launder(int x) { asm volatile("" : "+v"(x)); return x; }
__device__ __forceinline__ float bf_lo(unsigned u) { return __uint_as_float(u << 16); }
__device__ __forceinline__ float bf_hi(unsigned u) { return __uint_as_float(u & 0xffff0000u); }
__device__ __forceinline__ float bf1(bf16_t u) { return __uint_as_float(((unsigned)u) << 16); }

struct MP {
  Ptrs in;
  float* out;
  float* mod; float2* cs; int* cnt; int* list; float2* tokw;
  bf16_t* ssmB; bf16_t* ssmC; float* ssmL;
  bf16_t* WinT; bf16_t* WgluT; bf16_t* WoutT; bf16_t* WgT; bf16_t* WuT; bf16_t* WdT;
  bf16_t* h; bf16_t* q; bf16_t* k; bf16_t* vT; bf16_t* u; bf16_t* attn; bf16_t* y; bf16_t* ssm; bf16_t* act;
  float* ssqa; float* ssqs; float* x1;
  float* dbg0; float* dbg1;
};

__device__ __forceinline__ void transpose_tile(const float* __restrict__ src, int N, bf16_t* __restrict__ dst, int K, int k0, int n0,
                                               const float* __restrict__ gain, float* lds) {
  const int tid = launder(threadIdx.x);
  {
    const int r = tid >> 4, c4 = (tid & 15) * 4;
#pragma unroll
    for (int i = 0; i < 4; ++i) {
      const int kk = k0 + r + 16 * i;
      float4 v = *(const float4*)(src + (size_t)kk * N + n0 + c4);
      if (gain) { const float gg = gain[kk]; v.x *= gg; v.y *= gg; v.z *= gg; v.w *= gg; }
      float* d = lds + (r + 16 * i) * 65 + c4;
      d[0] = v.x; d[1] = v.y; d[2] = v.z; d[3] = v.w;
    }
  }
  __syncthreads();
  {
    const int n = tid >> 2, kq = (tid & 3) * 16;
    unsigned w[8];
#pragma unroll
    for (int j = 0; j < 8; ++j) w[j] = pack2(lds[(kq + 2 * j) * 65 + n], lds[(kq + 2 * j + 1) * 65 + n]);
    u32x4* d = (u32x4*)(dst + (size_t)(n0 + n) * K + k0 + kq);
    d[0] = (u32x4){w[0], w[1], w[2], w[3]};
    d[1] = (u32x4){w[4], w[5], w[6], w[7]};
  }
  __syncthreads();
}

constexpr int TT_WIN = 16 * 20, TT_GLU = 8 * 8, TT_OUT = 16 * 16, TT_EXP = 16 * 128;
constexpr int TT_LAYER = TT_WIN + TT_GLU + TT_OUT + 3 * TT_EXP;
constexpr int P0_MOD = DEPTH * 96;
constexpr int P0_TR = DEPTH * TT_LAYER;
constexpr int P0_CS = T * 32 / 256;
constexpr int P0_SSM = DEPTH * SG;
constexpr int P0_TOTAL = P0_MOD + P0_TR + P0_CS + P0_SSM + 1;

__device__ void phase0_item(const MP& p, int it, char* smem) {
  const int tid = launder(threadIdx.x);
  float* ldsf = (float*)smem;
  if (it < P0_MOD) {
    const int l = it / 96, j0 = (it % 96) * 64;
    float* sc = ldsf;
    float* red = ldsf + 8192;
    for (int i = tid; i < 8192; i += NTHR) { float v = p.in.c[i]; sc[i] = v / (1.f + __expf(-v)); }
    __syncthreads();
    const int kg = tid >> 6, col = tid & 63;
    float acc[8];
#pragma unroll
    for (int b = 0; b < 8; ++b) acc[b] = 0.f;
    const float* w = p.in.ada_w + (size_t)l * 1024 * 6144 + j0 + col;
#pragma unroll 8
    for (int k = kg * 256; k < kg * 256 + 256; ++k) {
      const float wv = w[(size_t)k * 6144];
#pragma unroll
      for (int b = 0; b < 8; ++b) acc[b] += sc[b * 1024 + k] * wv;
    }
#pragma unroll
    for (int b = 0; b < 8; ++b) red[(kg * 8 + b) * 64 + col] = acc[b];
    __syncthreads();
    for (int o = tid; o < 512; o += NTHR) {
      const int b = o >> 6, c = o & 63;
      const float v = red[(0 * 8 + b) * 64 + c] + red[(1 * 8 + b) * 64 + c] + red[(2 * 8 + b) * 64 + c] + red[(3 * 8 + b) * 64 + c];
      p.mod[(size_t)(l * 8 + b) * 6144 + j0 + c] = v + p.in.ada_b[l * 6144 + j0 + c];
    }
    __syncthreads();
    return;
  }
  it -= P0_MOD;
  if (it < P0_TR) {
    const int l = it / TT_LAYER; int r = it % TT_LAYER;
    if (r < TT_WIN) { transpose_tile(p.in.w_in + (size_t)l * D * INW, INW, p.WinT + (size_t)l * INW * D, D, (r / 20) * 64, (r % 20) * 64, nullptr, ldsf); return; }
    r -= TT_WIN;
    if (r < TT_GLU) { transpose_tile(p.in.w_glu + (size_t)l * SW * SW, SW, p.WgluT + (size_t)l * SW * SW, SW, (r / 8) * 64, (r % 8) * 64, nullptr, ldsf); return; }
    r -= TT_GLU;
    if (r < TT_OUT) {
      const int k0 = (r / 16) * 64;
      const float* gain = k0 < 512 ? (p.in.attn_out_g + l * AW) : (p.in.ssm_out_g + l * SW - 512);
      transpose_tile(p.in.w_out + (size_t)l * D * D, D, p.WoutT + (size_t)l * D * D, D, k0, (r % 16) * 64, gain, ldsf); return; }
    r -= TT_OUT;
    const int kind = r / TT_EXP; r %= TT_EXP;
    const int e = r / 128, tt = r % 128;
    if (kind == 0) { transpose_tile(p.in.w_gate + (size_t)(l * NE + e) * D * DFF, DFF, p.WgT + (size_t)(l * NE + e) * DFF * D, D, (tt / 8) * 64, (tt % 8) * 64, nullptr, ldsf); return; }
    if (kind == 1) { transpose_tile(p.in.w_up + (size_t)(l * NE + e) * D * DFF, DFF, p.WuT + (size_t)(l * NE + e) * DFF * D, D, (tt / 8) * 64, (tt % 8) * 64, nullptr, ldsf); return; }
    transpose_tile(p.in.w_down + (size_t)(l * NE + e) * DFF * D, D, p.WdT + (size_t)(l * NE + e) * D * DFF, DFF, (tt / 16) * 64, (tt % 16) * 64, nullptr, ldsf);
    return;
  }
  it -= P0_TR;
  if (it < P0_CS) {
    const int i = it * 256 + tid, t = i >> 5, f = i & 31;
    const float freq = powf(10000.f, -(float)f / 32.f);
    const float ang = (float)p.in.pos[t] * freq;
    float sn, cn; sincosf(ang, &sn, &cn);
    p.cs[i] = make_float2(cn, sn);
    return;
  }
  it -= P0_CS;
  if (it < P0_SSM) {
    const int lg = it;
    if (tid < 64) {
      const int pp = tid;
      const float dt = expf(p.in.log_dt[lg]);
      const float lr = p.in.lam_re[lg * SP + pp], li = p.in.lam_im[lg * SP + pp];
      const float mag = expf(lr * dt);
      float sn, cn; sincosf(li * dt, &sn, &cn);
      const float ar = mag * cn, ai = mag * sn;
      const float den = lr * lr + li * li;
      const float fr = ((ar - 1.f) * lr + ai * li) / den, fi = (ai * lr - (ar - 1.f) * li) / den;
      p.ssmL[(lg * SP + pp) * 2] = ar; p.ssmL[(lg * SP + pp) * 2 + 1] = ai;
      unsigned wr[8], wi[8];
#pragma unroll
      for (int hh = 0; hh < 8; ++hh) {
        const float br0 = p.in.b_re[((size_t)lg * SP + pp) * SCH + 2 * hh], bi0 = p.in.b_im[((size_t)lg * SP + pp) * SCH + 2 * hh];
        const float br1 = p.in.b_re[((size_t)lg * SP + pp) * SCH + 2 * hh + 1], bi1 = p.in.b_im[((size_t)lg * SP + pp) * SCH + 2 * hh + 1];
        wr[hh] = pack2(fr * br0 - fi * bi0, fr * br1 - fi * bi1);
        wi[hh] = pack2(fr * bi0 + fi * br0, fr * bi1 + fi * br1);
      }
      u32x4* dr = (u32x4*)(p.ssmB + ((size_t)lg * 128 + pp) * 16);
      u32x4* di = (u32x4*)(p.ssmB + ((size_t)lg * 128 + 64 + pp) * 16);
      dr[0] = (u32x4){wr[0], wr[1], wr[2], wr[3]}; dr[1] = (u32x4){wr[4], wr[5], wr[6], wr[7]};
      di[0] = (u32x4){wi[0], wi[1], wi[2], wi[3]}; di[1] = (u32x4){wi[4], wi[5], wi[6], wi[7]};
    }
    for (int o = tid; o < 16 * 64; o += NTHR) {
      const int hh = o >> 6, pp = o & 63;
      const float cr = p.in.c_re[(size_t)lg * SCH * SP + o], ci = p.in.c_im[(size_t)lg * SCH * SP + o];
      *(unsigned*)(p.ssmC + ((size_t)lg * 16 + hh) * 128 + 2 * pp) = pack2(cr, -ci);
    }
    return;
  }
  for (int i = tid; i < 64 * DEPTH; i += NTHR) p.cnt[i] = 0;
}

__device__ __forceinline__ void norm_token(const float* __restrict__ xr, const float* __restrict__ g, const float* __restrict__ sh,
                                           const float* __restrict__ sc, bf16_t* __restrict__ hr, int lane, float (&hv)[16]) {
  float4 v[4]; float ss = 0.f;
#pragma unroll
  for (int i = 0; i < 4; ++i) { v[i] = *(const float4*)(xr + lane * 4 + 256 * i); ss += v[i].x * v[i].x + v[i].y * v[i].y + v[i].z * v[i].z + v[i].w * v[i].w; }
  ss = wave_sum(ss);
  const float rinv = rsqrtf(ss * (1.f / D) + EPS);
#pragma unroll
  for (int i = 0; i < 4; ++i) {
    const int d = lane * 4 + 256 * i;
    const float4 gg = *(const float4*)(g + d), s1 = *(const float4*)(sc + d), s0 = *(const float4*)(sh + d);
    hv[4 * i + 0] = v[i].x * rinv * gg.x * (1.f + s1.x) + s0.x;
    hv[4 * i + 1] = v[i].y * rinv * gg.y * (1.f + s1.y) + s0.y;
    hv[4 * i + 2] = v[i].z * rinv * gg.z * (1.f + s1.z) + s0.z;
    hv[4 * i + 3] = v[i].w * rinv * gg.w * (1.f + s1.w) + s0.w;
    *(u32x2*)(hr + d) = (u32x2){pack2(hv[4 * i], hv[4 * i + 1]), pack2(hv[4 * i + 2], hv[4 * i + 3])};
  }
}

__device__ void phase_norm1(const MP& p, int l, const float* xin) {
  const int tid = launder(threadIdx.x);
  const int wave = tid >> 6, lane = tid & 63;
  const float* modl = p.mod + (size_t)l * 8 * 6144;
  for (int t = blockIdx.x * 4 + wave; t < T; t += gridDim.x * 4) {
    const int b = t / S; float hv[16];
    norm_token(xin + (size_t)t * D, p.in.norm1_g + l * D, modl + (size_t)b * 6144, modl + (size_t)b * 6144 + 1024, p.h + (size_t)t * D, lane, hv);
  }
}

struct GemmTile {
  const bf16_t* A0; const bf16_t* A1; long lda; int ksA;
  int arow[4];
  const bf16_t* B0[4]; const bf16_t* B1[4]; long ldb; int ksB;
  int K;
};

__device__ __forceinline__ int lds_off(int row, int chunk) { return row * 128 + ((chunk ^ ((row >> 1) & 7)) << 4); }

template <bool BSPLIT>
__device__ __forceinline__ void gemm_mainloop(const GemmTile& g, char* smem, f32x4 (&acc)[4][4]) {
  const int tid = launder(threadIdx.x), lane = tid & 63, wave = tid >> 6, wr = wave >> 1, wc = wave & 1, fr = lane & 15, fq = lane >> 4;
  const int r0 = tid >> 3, c8 = tid & 7;
#pragma unroll
  for (int m = 0; m < 4; ++m)
#pragma unroll
    for (int n = 0; n < 4; ++n) acc[m][n] = (f32x4){0.f, 0.f, 0.f, 0.f};
  u32x4 ra[4], rb[4];
  auto gload = [&](int kt) {
    const int kk = kt * 64;
    const bf16_t* Ab = kk < g.ksA ? g.A0 + kk : g.A1 + (kk - g.ksA);
    const bool bs = kk < g.ksB; const int kb = bs ? kk : kk - g.ksB;
#pragma unroll
    for (int i = 0; i < 4; ++i) {
      ra[i] = (u32x4){0u, 0u, 0u, 0u};
      if (g.arow[i] >= 0) ra[i] = *(const u32x4*)(Ab + (size_t)g.arow[i] * g.lda + c8 * 8);
      const bf16_t* Bb = bs ? g.B0[i] : g.B1[i];
      rb[i] = *(const u32x4*)(Bb + (size_t)r0 * g.ldb + kb + c8 * 8);
    }
  };
  auto lstore = [&](int buf) {
    char* As = smem + buf * 32768; char* Bs = As + 16384;
#pragma unroll
    for (int i = 0; i < 4; ++i) {
      const int off = lds_off(r0 + 32 * i, c8);
      *(u32x4*)(As + off) = ra[i];
      *(u32x4*)(Bs + off) = rb[i];
    }
  };
  const int nk = g.K / 64;
  gload(0); lstore(0);
  __syncthreads();
  for (int kt = 0; kt < nk; ++kt) {
    if (kt + 1 < nk) gload(kt + 1);
    const char* As = smem + (kt & 1) * 32768; const char* Bs = As + 16384;
#pragma unroll
    for (int ks = 0; ks < 2; ++ks) {
      bf16x8 af[4], bfr[4];
#pragma unroll
      for (int m = 0; m < 4; ++m) af[m] = *(const bf16x8*)(As + lds_off(wr * 64 + 16 * m + fr, ks * 4 + fq));
#pragma unroll
      for (int n = 0; n < 4; ++n) {
        const int brow = BSPLIT ? ((n >> 1) * 64 + wc * 32 + (n & 1) * 16 + fr) : (wc * 64 + 16 * n + fr);
        bfr[n] = *(const bf16x8*)(Bs + lds_off(brow, ks * 4 + fq));
      }
#pragma unroll
      for (int m = 0; m < 4; ++m)
#pragma unroll
        for (int n = 0; n < 4; ++n) acc[m][n] = __builtin_amdgcn_mfma_f32_16x16x32_bf16(bfr[n], af[m], acc[m][n], 0, 0, 0);
    }
    if (kt + 1 < nk) lstore((kt + 1) & 1);
    __syncthreads();
  }
}

__device__ void phase_inproj(const MP& p, int l, char* smem) {
  const int tid = launder(threadIdx.x), lane = tid & 63, wave = tid >> 6, wr = wave >> 1, wc = wave & 1, fr = lane & 15, fq = lane >> 4;
  const int r0 = tid >> 3;
  const int ntiles = (T / 128) * (INW / 128);
  for (int tile = blockIdx.x; tile < ntiles; tile += gridDim.x) {
    const int mt = tile / 10, nt = tile % 10, m0 = mt * 128, n0 = nt * 128;
    GemmTile g;
    g.A0 = p.h; g.A1 = p.h; g.lda = D; g.ksA = D; g.K = D;
    const bf16_t* W = p.WinT + (size_t)l * INW * D;
#pragma unroll
    for (int i = 0; i < 4; ++i) { g.arow[i] = m0 + r0 + 32 * i; g.B0[i] = W + (size_t)(n0 + 32 * i) * D; g.B1[i] = g.B0[i]; }
    g.ldb = D; g.ksB = D;
    f32x4 acc[4][4];
    gemm_mainloop<false>(g, smem, acc);
    const int rowb = m0 + wr * 64 + fr;
    if (nt <= 4) {
      const float* gv = (nt < 4 ? p.in.q_norm_g : p.in.k_norm_g) + l * HD;
      const float scl = nt < 4 ? 0.125f : 1.f;
      f32x4 g1[2], g2[2];
#pragma unroll
      for (int n = 0; n < 2; ++n) { g1[n] = *(const f32x4*)(gv + 16 * n + 4 * fq); g2[n] = *(const f32x4*)(gv + 32 + 16 * n + 4 * fq); }
#pragma unroll
      for (int m = 0; m < 4; ++m) {
        const int t = rowb + 16 * m;
        float ss = 0.f;
#pragma unroll
        for (int n = 0; n < 4; ++n)
#pragma unroll
          for (int j = 0; j < 4; ++j) ss += acc[m][n][j] * acc[m][n][j];
        ss += __shfl_xor(ss, 16); ss += __shfl_xor(ss, 32);
        const float rinv = rsqrtf(ss * (1.f / 64.f) + EPS) * scl;
        bf16_t* dst = nt < 4 ? (p.q + (size_t)t * AW + (2 * nt + wc) * 64) : (p.k + (size_t)t * 128 + wc * 64);
#pragma unroll
        for (int n = 0; n < 2; ++n) {
          const int c = 16 * n + 4 * fq;
          const f32x4 csa = *(const f32x4*)((const float*)p.cs + ((size_t)t * 32 + c) * 2);
          const f32x4 csb = *(const f32x4*)((const float*)p.cs + ((size_t)t * 32 + c + 2) * 2);
          const float cn[4] = {csa[0], csa[2], csb[0], csb[2]}, sn[4] = {csa[1], csa[3], csb[1], csb[3]};
          float o1[4], o2[4];
#pragma unroll
          for (int j = 0; j < 4; ++j) {
            const float x1 = acc[m][n][j] * rinv * g1[n][j], x2 = acc[m][n + 2][j] * rinv * g2[n][j];
            o1[j] = x1 * cn[j] - x2 * sn[j]; o2[j] = x2 * cn[j] + x1 * sn[j];
          }
          *(u32x2*)(dst + c) = (u32x2){pack2(o1[0], o1[1]), pack2(o1[2], o1[3])};
          *(u32x2*)(dst + 32 + c) = (u32x2){pack2(o2[0], o2[1]), pack2(o2[2], o2[3])};
        }
      }
    } else if (nt == 5) {
      const int b = m0 / S;
#pragma unroll
      for (int m = 0; m < 4; ++m) {
        const int s = (rowb + 16 * m) % S;
        const int k16 = s & 15;
        const int sp = (s & ~15) | (k16 & 3) | (((k16 >> 3) & 1) << 2) | (((k16 >> 2) & 1) << 3);
#pragma unroll
        for (int n = 0; n < 4; ++n)
#pragma unroll
          for (int j = 0; j < 4; ++j) {
            const int d = 16 * n + 4 * fq + j;
            p.vT[((size_t)(b * 2 + wc) * 64 + d) * S + sp] = (bf16_t)(pack2(acc[m][n][j], 0.f) & 0xffffu);
          }
      }
    } else {
#pragma unroll
      for (int m = 0; m < 4; ++m) {
        const int t = rowb + 16 * m;
#pragma unroll
        for (int n = 0; n < 4; ++n)
          *(u32x2*)(p.u + (size_t)t * SW + (nt - 6) * 128 + wc * 64 + 16 * n + 4 * fq) = (u32x2){pack2(acc[m][n][0], acc[m][n][1]), pack2(acc[m][n][2], acc[m][n][3])};
      }
    }
  }
}

__device__ __forceinline__ int crow32(int r, int hf) { return (r & 3) + 8 * (r >> 2) + 4 * hf; }

__device__ void attn_task(const MP& p, int l, int task, int lane) {
  lane = launder(lane);
  const int h = task & 7, qt = (task >> 3) & 63, b = task >> 9, kvh = h >> 2;
  const int s0 = qt * 32, t0 = b * S + s0, ql = lane & 31, hf = lane >> 5;
  bf16x8 qf[4];
#pragma unroll
  for (int st = 0; st < 4; ++st) qf[st] = *(const bf16x8*)(p.q + (size_t)(t0 + ql) * AW + h * 64 + 16 * st + 8 * hf);
  const int ktmin = s0 >= 128 ? 0 : (128 - s0) / 32;
  f32x16 sc[5];
#pragma unroll
  for (int kt = 0; kt < 5; ++kt) {
#pragma unroll
    for (int r = 0; r < 16; ++r) sc[kt][r] = 0.f;
    if (kt >= ktmin) {
      const int kstart = s0 - 128 + 32 * kt;
      const bf16_t* kp = p.k + (size_t)(b * S + kstart + ql) * 128 + kvh * 64 + 8 * hf;
#pragma unroll
      for (int st = 0; st < 4; ++st) {
        const bf16x8 kf = *(const bf16x8*)(kp + 16 * st);
        sc[kt] = __builtin_amdgcn_mfma_f32_32x32x16_bf16(kf, qf[st], sc[kt], 0, 0, 0);
      }
    }
  }
  const float sink = p.in.attn_sink[l * NQ + h];
  float mx = sink;
#pragma unroll
  for (int kt = 0; kt < 5; ++kt) {
    if (kt >= ktmin) {
#pragma unroll
      for (int r = 0; r < 16; ++r) {
        const int dk = 32 * kt + crow32(r, hf) - 128 - ql;
        const bool valid = dk <= 0 && dk > -128;
        sc[kt][r] = valid ? sc[kt][r] : -1e30f;
        mx = fmaxf(mx, sc[kt][r]);
      }
    }
  }
  mx = fmaxf(mx, __shfl_xor(mx, 32));
  float lsum = 0.f;
#pragma unroll
  for (int kt = 0; kt < 5; ++kt) {
    if (kt >= ktmin) {
#pragma unroll
      for (int r = 0; r < 16; ++r) { const float e = __expf(sc[kt][r] - mx); sc[kt][r] = e; lsum += e; }
    }
  }
  lsum += __shfl_xor(lsum, 32);
  lsum += __expf(sink - mx);
  const float inv = 1.f / lsum;
  f32x16 o[2];
#pragma unroll
  for (int r = 0; r < 16; ++r) { o[0][r] = 0.f; o[1][r] = 0.f; }
#pragma unroll
  for (int kt = 0; kt < 5; ++kt) {
    if (kt >= ktmin) {
      const int kstart = s0 - 128 + 32 * kt;
#pragma unroll
      for (int s = 0; s < 2; ++s) {
        u32x4 pw;
#pragma unroll
        for (int j = 0; j < 4; ++j) pw[j] = pack2(sc[kt][8 * s + 2 * j] * inv, sc[kt][8 * s + 2 * j + 1] * inv);
        const bf16x8 pa = __builtin_bit_cast(bf16x8, pw);
#pragma unroll
        for (int dt = 0; dt < 2; ++dt) {
          const bf16x8 vb = *(const bf16x8*)(p.vT + ((size_t)(b * 2 + kvh) * 64 + 32 * dt + ql) * S + kstart + 16 * s + 8 * hf);
          o[dt] = __builtin_amdgcn_mfma_f32_32x32x16_bf16(pa, vb, o[dt], 0, 0, 0);
        }
      }
    }
  }
#pragma unroll
  for (int r = 0; r < 16; ++r) {
    const int t = t0 + crow32(r, hf);
    bf16_t* dst = p.attn + (size_t)t * AW + h * 64 + ql;
    const unsigned w = pack2(o[0][r], o[1][r]);
    dst[0] = (bf16_t)(w & 0xffffu); dst[32] = (bf16_t)(w >> 16);
    float v = o[0][r] * o[0][r] + o[1][r] * o[1][r];
    v += __shfl_xor(v, 1); v += __shfl_xor(v, 2); v += __shfl_xor(v, 4); v += __shfl_xor(v, 8); v += __shfl_xor(v, 16);
    if (ql == 0) p.ssqa[(size_t)t * 8 + h] = v;
  }
}
__device__ void ssm_task(const MP& p, int l, int b, int g, int lane, char* wl) {
  lane = launder(lane);
  const int lg = l * SG + g, hf = lane >> 5, fr = lane & 15, fq = lane >> 4;
  const float ar = p.ssmL[(lg * SP + lane) * 2], ai = p.ssmL[(lg * SP + lane) * 2 + 1];
  bf16x8 bB[4], cB[4];
#pragma unroll
  for (int nt = 0; nt < 4; ++nt) bB[nt] = *(const bf16x8*)(p.ssmB + ((size_t)lg * 128 + nt * 32 + (lane & 31)) * 16 + 8 * hf);
#pragma unroll
  for (int ks = 0; ks < 4; ++ks) cB[ks] = *(const bf16x8*)(p.ssmC + ((size_t)lg * 16 + fr) * 128 + 32 * ks + 8 * fq);
  const float dsk = p.in.ssm_d[l * SW + g * 16 + fr];
  float xr = 0.f, xi = 0.f;
  const int wbase = (lane & 3) * 4;
  const int pch = lane >> 2;
  for (int c = 0; c < S / 32; ++c) {
    const int tb = b * S + c * 32;
    const bf16x8 ua = *(const bf16x8*)(p.u + (size_t)(tb + (lane & 31)) * SW + g * 16 + 8 * hf);
    bf16_t uraw[8];
#pragma unroll
    for (int i = 0; i < 8; ++i) uraw[i] = p.u[(size_t)(tb + 16 * (i >> 2) + 4 * fq + (i & 3)) * SW + g * 16 + fr];
    f32x16 bu[4];
#pragma unroll
    for (int nt = 0; nt < 4; ++nt) {
#pragma unroll
      for (int r = 0; r < 16; ++r) bu[nt][r] = 0.f;
      bu[nt] = __builtin_amdgcn_mfma_f32_32x32x16_bf16(ua, bB[nt], bu[nt], 0, 0, 0);
    }
    asm volatile("s_nop 15\n\ts_nop 7" : "+v"(bu[0]), "+v"(bu[1]), "+v"(bu[2]), "+v"(bu[3]));
#pragma unroll
    for (int r = 0; r < 16; ++r) {
      auto s0 = __builtin_amdgcn_permlane32_swap(__float_as_uint(bu[0][r]), __float_as_uint(bu[1][r]), false, false);
      bu[0][r] = __uint_as_float(s0[0]); bu[1][r] = __uint_as_float(s0[1]);
      auto s1 = __builtin_amdgcn_permlane32_swap(__float_as_uint(bu[2][r]), __float_as_uint(bu[3][r]), false, false);
      bu[2][r] = __uint_as_float(s1[0]); bu[3][r] = __uint_as_float(s1[1]);
    }
#pragma unroll
    for (int r4 = 0; r4 < 4; ++r4) {
#pragma unroll
      for (int half = 0; half < 2; ++half) {
#pragma unroll
        for (int j = 0; j < 4; ++j) {
          const int t = 8 * r4 + 4 * half + j, r = 4 * r4 + j;
          const float bre = half ? bu[1][r] : bu[0][r], bim = half ? bu[3][r] : bu[2][r];
          const float nr = ar * xr - ai * xi + bre, ni = ar * xi + ai * xr + bim;
          xr = nr; xi = ni;
          *(unsigned*)(wl + t * 256 + ((pch ^ (t & 15)) << 4) + wbase) = pack2(nr, ni);
        }
      }
    }
    asm volatile("s_waitcnt lgkmcnt(0)" ::: "memory");
#pragma unroll
    for (int mt = 0; mt < 2; ++mt) {
      f32x4 acc = {0.f, 0.f, 0.f, 0.f};
      const int t = 16 * mt + fr;
#pragma unroll
      for (int ks = 0; ks < 4; ++ks) {
        const bf16x8 af = *(const bf16x8*)(wl + t * 256 + (((4 * ks + fq) ^ (t & 15)) << 4));
        acc = __builtin_amdgcn_mfma_f32_16x16x32_bf16(af, cB[ks], acc, 0, 0, 0);
      }
#pragma unroll
      for (int j = 0; j < 4; ++j) {
        const int tt = tb + 16 * mt + 4 * fq + j;
        const float uu = bf1(uraw[4 * mt + j]);
        const float v = acc[j] + dsk * uu;
        const float z2 = 1.5957691216057308f * (v + 0.044715f * v * v * v);
        const float ge = v / (1.f + __expf(-z2));
        p.y[(size_t)tt * SW + g * 16 + fr] = (bf16_t)(pack2(ge, 0.f) & 0xffffu);
      }
    }
    asm volatile("s_waitcnt lgkmcnt(0)" ::: "memory");
  }
}

__device__ void phase_attn(const MP& p, int l) {
  const int tid = launder(threadIdx.x);
  const int wave = tid >> 6, lane = tid & 63;
  for (int task = blockIdx.x * 4 + wave; task < NB * 64 * 8; task += gridDim.x * 4) attn_task(p, l, task, lane);
}
__device__ void phase_ssm(const MP& p, int l, char* smem) {
  const int tid = launder(threadIdx.x);
  const int wave = tid >> 6, lane = tid & 63;
  if (wave == 0) for (int task = blockIdx.x; task < NB * SG; task += gridDim.x) ssm_task(p, l, task / SG, task % SG, lane, smem);
}
template <bool BSPLIT>
__device__ __forceinline__ void gemm_mainloop_mid(const GemmTile& g, char* smem, f32x4 (&acc)[4][4], int ktmid, const float (&mids)[4]) {
  const int tid = launder(threadIdx.x), lane = tid & 63, wave = tid >> 6, wr = wave >> 1, wc = wave & 1, fr = lane & 15, fq = lane >> 4;
  const int r0 = tid >> 3, c8 = tid & 7;
#pragma unroll
  for (int m = 0; m < 4; ++m)
#pragma unroll
    for (int n = 0; n < 4; ++n) acc[m][n] = (f32x4){0.f, 0.f, 0.f, 0.f};
  u32x4 ra[4], rb[4];
  auto gload = [&](int kt) {
    const int kk = kt * 64;
    const bf16_t* Ab = kk < g.ksA ? g.A0 + kk : g.A1 + (kk - g.ksA);
    const bool bs = kk < g.ksB; const int kb = bs ? kk : kk - g.ksB;
#pragma unroll
    for (int i = 0; i < 4; ++i) {
      ra[i] = (u32x4){0u, 0u, 0u, 0u};
      if (g.arow[i] >= 0) ra[i] = *(const u32x4*)(Ab + (size_t)g.arow[i] * g.lda + c8 * 8);
      const bf16_t* Bb = bs ? g.B0[i] : g.B1[i];
      rb[i] = *(const u32x4*)(Bb + (size_t)r0 * g.ldb + kb + c8 * 8);
    }
  };
  auto lstore = [&](int buf) {
    char* As = smem + buf * 32768; char* Bs = As + 16384;
#pragma unroll
    for (int i = 0; i < 4; ++i) {
      const int off = lds_off(r0 + 32 * i, c8);
      *(u32x4*)(As + off) = ra[i];
      *(u32x4*)(Bs + off) = rb[i];
    }
  };
  const int nk = g.K / 64;
  gload(0); lstore(0);
  __syncthreads();
  for (int kt = 0; kt < nk; ++kt) {
    if (kt + 1 < nk) gload(kt + 1);
    if (kt == ktmid) {
#pragma unroll
      for (int m = 0; m < 4; ++m)
#pragma unroll
        for (int n = 0; n < 4; ++n) acc[m][n] *= mids[m];
    }
    const char* As = smem + (kt & 1) * 32768; const char* Bs = As + 16384;
#pragma unroll
    for (int ks = 0; ks < 2; ++ks) {
      bf16x8 af[4], bfr[4];
#pragma unroll
      for (int m = 0; m < 4; ++m) af[m] = *(const bf16x8*)(As + lds_off(wr * 64 + 16 * m + fr, ks * 4 + fq));
#pragma unroll
      for (int n = 0; n < 4; ++n) {
        const int brow = BSPLIT ? ((n >> 1) * 64 + wc * 32 + (n & 1) * 16 + fr) : (wc * 64 + 16 * n + fr);
        bfr[n] = *(const bf16x8*)(Bs + lds_off(brow, ks * 4 + fq));
      }
#pragma unroll
      for (int m = 0; m < 4; ++m)
#pragma unroll
        for (int n = 0; n < 4; ++n) acc[m][n] = __builtin_amdgcn_mfma_f32_16x16x32_bf16(bfr[n], af[m], acc[m][n], 0, 0, 0);
    }
    if (kt + 1 < nk) lstore((kt + 1) & 1);
    __syncthreads();
  }
}

__device__ void phase_glu(const MP& p, int l, char* smem) {
  const int tid = launder(threadIdx.x), lane = tid & 63, wave = tid >> 6, wr = wave >> 1, wc = wave & 1, fr = lane & 15, fq = lane >> 4;
  const int r0 = tid >> 3;
  const int ntiles = (T / 128) * (SW / 128);
  for (int tile = blockIdx.x; tile < ntiles; tile += gridDim.x) {
    const int mt = tile >> 2, nt = tile & 3, m0 = mt * 128, n0 = nt * 128;
    GemmTile g;
    g.A0 = p.y; g.A1 = p.y; g.lda = SW; g.ksA = SW; g.K = SW;
    const bf16_t* W = p.WgluT + (size_t)l * SW * SW;
#pragma unroll
    for (int i = 0; i < 4; ++i) { g.arow[i] = m0 + r0 + 32 * i; g.B0[i] = W + (size_t)(n0 + 32 * i) * SW; g.B1[i] = g.B0[i]; }
    g.ldb = SW; g.ksB = SW;
    f32x4 acc[4][4];
    gemm_mainloop<false>(g, smem, acc);
#pragma unroll
    for (int m = 0; m < 4; ++m) {
      const int t = m0 + wr * 64 + 16 * m + fr;
      float ss = 0.f;
#pragma unroll
      for (int n = 0; n < 4; ++n) {
        const int col = n0 + wc * 64 + 16 * n + 4 * fq;
        const u32x2 yr = *(const u32x2*)(p.y + (size_t)t * SW + col);
        const float yv[4] = {bf_lo(yr[0]), bf_hi(yr[0]), bf_lo(yr[1]), bf_hi(yr[1])};
        float o[4];
#pragma unroll
        for (int j = 0; j < 4; ++j) { o[j] = yv[j] / (1.f + __expf(-acc[m][n][j])); ss += o[j] * o[j]; }
        *(u32x2*)(p.ssm + (size_t)t * SW + col) = (u32x2){pack2(o[0], o[1]), pack2(o[2], o[3])};
      }
      ss += __shfl_xor(ss, 16); ss += __shfl_xor(ss, 32);
      if (fq == 0) p.ssqs[(size_t)t * 8 + nt * 2 + wc] = ss;
    }
  }
}

__device__ void phase_out(const MP& p, int l, char* smem, const float* xin) {
  const int tid = launder(threadIdx.x), lane = tid & 63, wave = tid >> 6, wr = wave >> 1, wc = wave & 1, fr = lane & 15, fq = lane >> 4;
  const int r0 = tid >> 3;
  const float* modl = p.mod + (size_t)l * 8 * 6144;
  const int ntiles = (T / 128) * (D / 128);
  for (int tile = blockIdx.x; tile < ntiles; tile += gridDim.x) {
    const int mt = tile >> 3, nt = tile & 7, m0 = mt * 128, n0 = nt * 128, b = m0 / S;
    GemmTile g;
    g.A0 = p.attn; g.A1 = p.ssm; g.lda = AW; g.ksA = AW; g.K = D;
    const bf16_t* W = p.WoutT + (size_t)l * D * D;
#pragma unroll
    for (int i = 0; i < 4; ++i) { g.arow[i] = m0 + r0 + 32 * i; g.B0[i] = W + (size_t)(n0 + 32 * i) * D; g.B1[i] = g.B0[i]; }
    g.ldb = D; g.ksB = D;
    float mids[4], rs[4];
#pragma unroll
    for (int m = 0; m < 4; ++m) {
      const int t = m0 + wr * 64 + 16 * m + fr;
      const f32x4 a0 = *(const f32x4*)(p.ssqa + (size_t)t * 8), a1 = *(const f32x4*)(p.ssqa + (size_t)t * 8 + 4);
      const f32x4 s0 = *(const f32x4*)(p.ssqs + (size_t)t * 8), s1 = *(const f32x4*)(p.ssqs + (size_t)t * 8 + 4);
      const float sa = ((a0[0] + a0[1]) + (a0[2] + a0[3])) + ((a1[0] + a1[1]) + (a1[2] + a1[3]));
      const float sq = ((s0[0] + s0[1]) + (s0[2] + s0[3])) + ((s1[0] + s1[1]) + (s1[2] + s1[3]));
      const float ra = rsqrtf(sa * (1.f / 512.f) + EPS);
      rs[m] = rsqrtf(sq * (1.f / 512.f) + EPS);
      mids[m] = ra / rs[m];
    }
    f32x4 acc[4][4];
    gemm_mainloop_mid<false>(g, smem, acc, 8, mids);
#pragma unroll
    for (int m = 0; m < 4; ++m) {
      const int t = m0 + wr * 64 + 16 * m + fr;
#pragma unroll
      for (int n = 0; n < 4; ++n) {
        const int col = n0 + wc * 64 + 16 * n + 4 * fq;
        const f32x4 xv = *(const f32x4*)(xin + (size_t)t * D + col);
        const f32x4 g1 = *(const f32x4*)(modl + (size_t)b * 6144 + 2 * 1024 + col);
        f32x4 o;
#pragma unroll
        for (int j = 0; j < 4; ++j) o[j] = xv[j] + g1[j] * (acc[m][n][j] * rs[m]);
        *(f32x4*)(p.x1 + (size_t)t * D + col) = o;
      }
    }
  }
}
__device__ void phase_norm2_route(const MP& p, int l, char* smem) {
  const int tid = launder(threadIdx.x);
  const int wave = tid >> 6, lane = tid & 63;
  float* wrT = (float*)smem;
  for (int i = tid; i < 1024 * 4; i += NTHR) {
    const int k = i >> 2, e4 = (i & 3) * 4;
    const float4 v = *(const float4*)(p.in.w_router + (size_t)k * 16 + e4);
    wrT[(e4 + 0) * 1024 + k] = v.x; wrT[(e4 + 1) * 1024 + k] = v.y; wrT[(e4 + 2) * 1024 + k] = v.z; wrT[(e4 + 3) * 1024 + k] = v.w;
  }
  __syncthreads();
  const float* modl = p.mod + (size_t)l * 8 * 6144;
  float rb[16];
#pragma unroll
  for (int e = 0; e < 16; ++e) rb[e] = p.in.router_bias[e];
  int* cntl = p.cnt + l * 64;
  int my_t = -1, my_bucket = 0; float my_wlo = 0.f, my_whi = 0.f;
  int slot = 0;
  for (int t = blockIdx.x * 4 + wave; t < T; t += gridDim.x * 4, ++slot) {
    const int b = t / S; float hv[16];
    norm_token(p.x1 + (size_t)t * D, p.in.norm2_g + l * D, modl + (size_t)b * 6144 + 3 * 1024, modl + (size_t)b * 6144 + 4 * 1024,
               p.h + (size_t)t * D, lane, hv);
    float lg[16];
    const int loff = launder(lane * 4);
#pragma unroll
    for (int e = 0; e < 16; ++e) {
      float a = 0.f;
#pragma unroll
      for (int i = 0; i < 4; ++i) {
        const f32x4 w = *(const f32x4*)(wrT + e * 1024 + loff + 256 * i);
        a += hv[4 * i] * w[0] + hv[4 * i + 1] * w[1] + hv[4 * i + 2] * w[2] + hv[4 * i + 3] * w[3];
      }
      lg[e] = wave_sum(a);
    }
    float mx = lg[0];
#pragma unroll
    for (int e = 1; e < 16; ++e) mx = fmaxf(mx, lg[e]);
    float pr[16], sel[16]; float sum = 0.f;
#pragma unroll
    for (int e = 0; e < 16; ++e) { pr[e] = expf(lg[e] - mx); sum += pr[e]; }
    const float inv = 1.f / sum;
#pragma unroll
    for (int e = 0; e < 16; ++e) { pr[e] *= inv; sel[e] = pr[e] + rb[e]; }
    int gbest = 0; float gbs = -1e30f;
#pragma unroll
    for (int g = 0; g < 4; ++g) {
      float m1 = -1e30f, m2 = -1e30f;
#pragma unroll
      for (int j = 0; j < 4; ++j) { const float v = sel[g * 4 + j]; if (v > m1) { m2 = m1; m1 = v; } else if (v > m2) m2 = v; }
      const float gs = m1 + m2;
      if (gs > gbs) { gbs = gs; gbest = g; }
    }
    float s4[4], p4[4];
#pragma unroll
    for (int j = 0; j < 4; ++j) { s4[j] = sel[j]; p4[j] = pr[j]; }
#pragma unroll
    for (int g = 1; g < 4; ++g) if (g == gbest) {
#pragma unroll
      for (int j = 0; j < 4; ++j) { s4[j] = sel[g * 4 + j]; p4[j] = pr[g * 4 + j]; }
    }
    int i0 = 0; float b0 = s4[0];
#pragma unroll
    for (int j = 1; j < 4; ++j) if (s4[j] > b0) { b0 = s4[j]; i0 = j; }
    int i1 = -1; float b1 = -1e30f;
#pragma unroll
    for (int j = 0; j < 4; ++j) if (j != i0 && s4[j] > b1) { b1 = s4[j]; i1 = j; }
    float p0 = 0.f, p1 = 0.f;
#pragma unroll
    for (int j = 0; j < 4; ++j) { if (j == i0) p0 = p4[j]; if (j == i1) p1 = p4[j]; }
    const float w0 = p0 / (p0 + p1), w1 = p1 / (p0 + p1);
    const int lo = i0 < i1 ? i0 : i1, hi = i0 < i1 ? i1 : i0;
    const float wlo = i0 < i1 ? w0 : w1, whi = i0 < i1 ? w1 : w0;
    const int pidx = (lo == 0) ? (hi - 1) : (lo == 1 ? (hi + 1) : 5);
    const int bucket = gbest * 6 + pidx;
    if (lane == slot) { my_t = t; my_bucket = bucket; my_wlo = wlo; my_whi = whi; }
  }
  if (my_t >= 0) {
    const int pos = atomicAdd(&cntl[my_bucket], 1);
    p.list[my_bucket * T + pos] = my_t;
    p.tokw[my_t] = make_float2(my_wlo, my_whi);
  }
  __syncthreads();
}

__device__ __forceinline__ void bucket_experts2(int bucket, int& elo, int& ehi) {
  const int g = bucket / 6, pi = bucket % 6;
  const int lo = pi < 3 ? 0 : (pi < 5 ? 1 : 2);
  const int hi = pi < 3 ? pi + 1 : (pi < 5 ? pi - 1 : 3);
  elo = g * 4 + lo; ehi = g * 4 + hi;
}
__device__ __forceinline__ bool moe_find_tile(const int* cnt, int mt, int& bucket, int& tib, int& nrow) {
  int acc = 0;
  for (int bk = 0; bk < NBUCKET; ++bk) {
    const int c = cnt[bk], nt = (c + TM - 1) / TM;
    if (mt < acc + nt) { bucket = bk; tib = mt - acc; nrow = c - tib * TM; return true; }
    acc += nt;
  }
  return false;
}
__device__ __forceinline__ int moe_total_tiles(const int* cnt) {
  int acc = 0;
  for (int bk = 0; bk < NBUCKET; ++bk) acc += (cnt[bk] + TM - 1) / TM;
  return acc;
}

__device__ void phase_moe_gu(const MP& p, int l, char* smem) {
  const int tid = launder(threadIdx.x), lane = tid & 63, wave = tid >> 6, wr = wave >> 1, wc = wave & 1, fr = lane & 15, fq = lane >> 4;
  const int r0 = tid >> 3;
  const int* cntl = p.cnt + l * 64;
  const int nmt = moe_total_tiles(cntl);
  const int ntiles = nmt * 16;
  for (int tile = blockIdx.x; tile < ntiles; tile += gridDim.x) {
    const int mt = tile >> 4, nt = tile & 15;
    int bucket, tib, nrow;
    moe_find_tile(cntl, mt, bucket, tib, nrow);
    int elo, ehi; bucket_experts2(bucket, elo, ehi);
    const int e = nt < 8 ? elo : ehi, f0 = (nt & 7) * 64;
    const int* lst = p.list + bucket * T + tib * TM;
    GemmTile g;
    g.A0 = p.h; g.A1 = p.h; g.lda = D; g.ksA = D; g.K = D;
    const bf16_t* Wg = p.WgT + ((size_t)(l * NE + e) * DFF + f0) * D;
    const bf16_t* Wu = p.WuT + ((size_t)(l * NE + e) * DFF + f0) * D;
#pragma unroll
    for (int i = 0; i < 4; ++i) {
      const int r = r0 + 32 * i;
      g.arow[i] = r < nrow ? lst[r] : -1;
      g.B0[i] = (i < 2 ? Wg : Wu) + (size_t)(32 * (i & 1)) * D; g.B1[i] = g.B0[i];
    }
    g.ldb = D; g.ksB = D;
    f32x4 acc[4][4];
    gemm_mainloop<true>(g, smem, acc);
#pragma unroll
    for (int m = 0; m < 4; ++m) {
      const int r = wr * 64 + 16 * m + fr;
      float w = 0.f;
      if (r < nrow) { const float2 ww = p.tokw[lst[r]]; w = nt < 8 ? ww.x : ww.y; }
      bf16_t* dst = p.act + (size_t)(mt * TM + r) * D + (nt < 8 ? 0 : 512) + f0 + wc * 32 + 4 * fq;
#pragma unroll
      for (int n = 0; n < 2; ++n) {
        float o[4];
#pragma unroll
        for (int j = 0; j < 4; ++j) { const float gv = acc[m][n][j], uv = acc[m][n + 2][j]; o[j] = gv / (1.f + __expf(-gv)) * uv * w; }
        *(u32x2*)(dst + 16 * n) = (u32x2){pack2(o[0], o[1]), pack2(o[2], o[3])};
      }
    }
  }
}

__device__ void phase_moe_down(const MP& p, int l, char* smem) {
  const int tid = launder(threadIdx.x), lane = tid & 63, wave = tid >> 6, wr = wave >> 1, wc = wave & 1, fr = lane & 15, fq = lane >> 4;
  const int r0 = tid >> 3;
  const int* cntl = p.cnt + l * 64;
  const float* modl = p.mod + (size_t)l * 8 * 6144;
  const int nmt = moe_total_tiles(cntl);
  const int ntiles = nmt * 8;
  for (int tile = blockIdx.x; tile < ntiles; tile += gridDim.x) {
    const int mt = tile >> 3, nt = tile & 7, n0 = nt * 128;
    int bucket, tib, nrow;
    moe_find_tile(cntl, mt, bucket, tib, nrow);
    int elo, ehi; bucket_experts2(bucket, elo, ehi);
    const int* lst = p.list + bucket * T + tib * TM;
    GemmTile g;
    g.A0 = p.act; g.A1 = p.act; g.lda = D; g.ksA = D; g.K = D;
    const bf16_t* Wlo = p.WdT + ((size_t)(l * NE + elo) * D + n0) * DFF;
    const bf16_t* Whi = p.WdT + ((size_t)(l * NE + ehi) * D + n0) * DFF;
#pragma unroll
    for (int i = 0; i < 4; ++i) {
      g.arow[i] = mt * TM + r0 + 32 * i;
      g.B0[i] = Wlo + (size_t)(32 * i) * DFF; g.B1[i] = Whi + (size_t)(32 * i) * DFF;
    }
    g.ldb = DFF; g.ksB = DFF;
    f32x4 acc[4][4];
    gemm_mainloop<false>(g, smem, acc);
#pragma unroll
    for (int m = 0; m < 4; ++m) {
      const int r = wr * 64 + 16 * m + fr;
      if (r < nrow) {
        const int tk = lst[r], b = tk / S;
#pragma unroll
        for (int n = 0; n < 4; ++n) {
          const int col = n0 + wc * 64 + 16 * n + 4 * fq;
          const f32x4 xv = *(const f32x4*)(p.x1 + (size_t)tk * D + col);
          const f32x4 g2 = *(const f32x4*)(modl + (size_t)b * 6144 + 5 * 1024 + col);
          f32x4 o;
#pragma unroll
          for (int j = 0; j < 4; ++j) o[j] = xv[j] + g2[j] * acc[m][n][j];
          *(f32x4*)(p.out + (size_t)tk * D + col) = o;
        }
      }
    }
  }
}

constexpr int DEV_STAGE = 7;
constexpr int NSUB = 9;

__global__ void __launch_bounds__(NTHR, 2) mega(MP p, int ph0, int ph1) {
  __shared__ __attribute__((aligned(16))) char smem[65536];
  for (int ph = ph0; ph < ph1; ++ph) {
    if (ph == 0) {
      for (int it = blockIdx.x; it < P0_TOTAL; it += gridDim.x) {
        bool skip = false;
        if (it >= P0_MOD && it < P0_MOD + P0_TR) {
          int r = (it - P0_MOD) % TT_LAYER;
          if (DEV_STAGE < 5 && r >= TT_WIN) skip = true;
          else if (DEV_STAGE < 7 && r >= TT_WIN + TT_GLU + TT_OUT) skip = true;
        }
        if (!skip) phase0_item(p, it, smem);
      }
    } else {
      const int l = (ph - 1) / NSUB, sub = (ph - 1) % NSUB;
      const float* xin = l == 0 ? p.in.x : p.out;
      if (sub == 0) phase_norm1(p, l, xin);
      else if (sub == 1) phase_inproj(p, l, smem);
      else if (sub == 2) phase_attn(p, l);
      else if (sub == 3) phase_ssm(p, l, smem);
      else if (sub == 4) phase_glu(p, l, smem);
      else if (sub == 5) phase_out(p, l, smem, xin);
      else if (sub == 6) phase_norm2_route(p, l, smem);
      else if (sub == 7) phase_moe_gu(p, l, smem);
      else if (sub == 8) phase_moe_down(p, l, smem);
    }
  }
}

}

extern "C" void kernel_launch(void* const* d_in, const int* in_sizes, int n_in, void* d_out, int out_size, void* d_ws,
                              size_t ws_size, hipStream_t stream) {
  MP p; memset(&p, 0, sizeof(p));
  Ptrs& P = p.in;
  P.x = (const float*)d_in[0]; P.c = (const float*)d_in[1]; P.pos = (const int*)d_in[2];
  P.ada_w = (const float*)d_in[3]; P.ada_b = (const float*)d_in[4]; P.norm1_g = (const float*)d_in[5];
  P.w_in = (const float*)d_in[6]; P.q_norm_g = (const float*)d_in[7]; P.k_norm_g = (const float*)d_in[8];
  P.attn_sink = (const float*)d_in[9]; P.lam_re = (const float*)d_in[10]; P.lam_im = (const float*)d_in[11];
  P.b_re = (const float*)d_in[12]; P.b_im = (const float*)d_in[13]; P.c_re = (const float*)d_in[14]; P.c_im = (const float*)d_in[15];
  P.ssm_d = (const float*)d_in[16]; P.log_dt = (const float*)d_in[17]; P.w_glu = (const float*)d_in[18];
  P.attn_out_g = (const float*)d_in[19]; P.ssm_out_g = (const float*)d_in[20]; P.w_out = (const float*)d_in[21];
  P.norm2_g = (const float*)d_in[22]; P.w_router = (const float*)d_in[23]; P.router_bias = (const float*)d_in[24];
  P.w_gate = (const float*)d_in[25]; P.w_up = (const float*)d_in[26]; P.w_down = (const float*)d_in[27];
  float* out = (float*)d_out; p.out = out;

  char* w = (char*)d_ws; size_t off = 0;
  auto take = [&](size_t bytes) { char* q = w + off; off += (bytes + 255) & ~(size_t)255; return q; };
  p.mod = (float*)take((size_t)DEPTH * 8 * 6144 * 4);
  p.cs = (float2*)take((size_t)T * 32 * 8);
  p.cnt = (int*)take(1024);
  p.list = (int*)take((size_t)NBUCKET * T * 4);
  p.tokw = (float2*)take((size_t)T * 8);
  p.ssmB = (bf16_t*)take((size_t)DEPTH * SG * 128 * 16 * 2);
  p.ssmC = (bf16_t*)take((size_t)DEPTH * SG * 16 * 128 * 2);
  p.ssmL = (float*)take((size_t)DEPTH * SG * SP * 2 * 4);
  p.WinT = (bf16_t*)take((size_t)DEPTH * INW * D * 2);
  p.WgluT = (bf16_t*)take((size_t)DEPTH * SW * SW * 2);
  p.WoutT = (bf16_t*)take((size_t)DEPTH * D * D * 2);
  p.h = (bf16_t*)take((size_t)T * D * 2);
  p.q = (bf16_t*)take((size_t)T * AW * 2);
  p.k = (bf16_t*)take((size_t)T * 128 * 2);
  p.vT = (bf16_t*)take((size_t)T * 128 * 2);
  p.u = (bf16_t*)take((size_t)T * SW * 2);
  p.act = p.q;
  p.attn = (bf16_t*)take((size_t)T * AW * 2);
  p.ssqa = (float*)take((size_t)T * 8 * 4);
  p.y = (bf16_t*)take((size_t)T * SW * 2);
  p.ssm = (bf16_t*)take((size_t)T * SW * 2);
  p.ssqs = (float*)take((size_t)T * 8 * 4);
  p.x1 = (float*)take((size_t)T * D * 4);
  p.WgT = (bf16_t*)take((size_t)DEPTH * NE * DFF * D * 2);
  p.WuT = (bf16_t*)take((size_t)DEPTH * NE * DFF * D * 2);
  p.WdT = (bf16_t*)take((size_t)DEPTH * NE * DFF * D * 2);
  static_assert((size_t)MAXMT * TM * D * 2 <= (size_t)T * (AW + 128 + 128 + SW) * 2, "act overlay too small");
  if (off > ws_size) { fprintf(stderr, "workspace too small: need %zu have %zu\n", off, ws_size); return; }
  (void)in_sizes; (void)n_in; (void)out_size;

  const int grid = 512;
  mega<<<grid, NTHR, 0, stream>>>(p, 0, 1);
  for (int l = 0; l < DEPTH; ++l)
    for (int sub = 0; sub < NSUB; ++sub) mega<<<grid, NTHR, 0, stream>>>(p, 1 + l * NSUB + sub, 1 + l * NSUB + sub + 1);
}
```

```cpp
#include <hip/hip_runtime.h>
#include <hip/hip_cooperative_groups.h>
#include <stdint.h>
#include <cstdio>
#include <cstring>

namespace {
constexpr int D = 1024, NB = 8, S = 2048, T = NB * S, DEPTH = 2;
constexpr int AW = 512, HD = 64, NQ = 8, NKV = 2, INW = 1280;
constexpr int SG = 32, SCH = 16, SP = 64, SW = 512;
constexpr int NE = 16, DFF = 512;
constexpr int NBUCKET = 24;
constexpr float EPS = 1e-6f;

struct Ptrs {
  const float *x, *c; const int* pos; const float *ada_w, *ada_b, *norm1_g, *w_in, *q_norm_g, *k_norm_g, *attn_sink,
      *lam_re, *lam_im, *b_re, *b_im, *c_re, *c_im, *ssm_d, *log_dt, *w_glu, *attn_out_g, *ssm_out_g, *w_out, *norm2_g,
      *w_router, *router_bias, *w_gate, *w_up, *w_down;
};

__device__ __forceinline__ float row_sum32_dpp(float v) {
  v += __int_as_float(__builtin_amdgcn_update_dpp(0, __float_as_int(v), 0xB1, 0xF, 0xF, true));
  v += __int_as_float(__builtin_amdgcn_update_dpp(0, __float_as_int(v), 0x4E, 0xF, 0xF, true));
  v += __int_as_float(__builtin_amdgcn_update_dpp(0, __float_as_int(v), 0x141, 0xF, 0xF, true));
  v += __int_as_float(__builtin_amdgcn_update_dpp(0, __float_as_int(v), 0x140, 0xF, 0xF, true));
  v += __int_as_float(__builtin_amdgcn_update_dpp(0, __float_as_int(v), 0x142, 0xA, 0xF, false));
  return v;
}
__device__ __forceinline__ float wave_sum(float v) {
  v = row_sum32_dpp(v);
  return __int_as_float(__builtin_amdgcn_readlane(__float_as_int(v), 31)) + __int_as_float(__builtin_amdgcn_readlane(__float_as_int(v), 63));
}

typedef unsigned short bf16_t;
typedef short bf16x8 __attribute__((ext_vector_type(8)));
typedef float f32x4 __attribute__((ext_vector_type(4)));
typedef float f32x16 __attribute__((ext_vector_type(16)));
typedef float f32x2 __attribute__((ext_vector_type(2)));
typedef __bf16 bf16x2_t __attribute__((ext_vector_type(2)));
typedef unsigned u32x4 __attribute__((ext_vector_type(4)));
typedef unsigned u32x2 __attribute__((ext_vector_type(2)));

constexpr int NTHR = 256;
constexpr int TM = 128;
constexpr int MAXMT = T / TM + NBUCKET;
constexpr int NSUBL = 8;
constexpr int SMEM_MM = 65536 + 16;

__device__ __forceinline__ unsigned pack2(float lo, float hi) {
  f32x2 v = {lo, hi};
  return __builtin_bit_cast(unsigned, __builtin_convertvector(v, bf16x2_t));
}
__device__ __forceinline__ int launder(int x) { asm volatile("" : "+v"(x)); return x; }
__device__ __forceinline__ float bf_lo(unsigned u) { return __uint_as_float(u << 16); }
__device__ __forceinline__ float bf_hi(unsigned u) { return __uint_as_float(u & 0xffff0000u); }
__device__ __forceinline__ float bf1(bf16_t u) { return __uint_as_float(((unsigned)u) << 16); }

constexpr size_t al256(size_t x) { return (x + 255) & ~(size_t)255; }
constexpr size_t OFF_BAR = 0;
constexpr size_t OFF_CLAIM = OFF_BAR + al256(4096 * 4);
constexpr size_t OFF_MOD = OFF_CLAIM + al256(4096 * 4 + 256);
constexpr size_t OFF_CS = OFF_MOD + al256((size_t)DEPTH * 8 * 6144 * 4);
constexpr size_t OFF_CNT = OFF_CS + al256((size_t)T * 32 * 8);
constexpr size_t OFF_LIST = OFF_CNT + al256(256 * 4 * DEPTH);
constexpr size_t OFF_TOKW = OFF_LIST + al256((size_t)NBUCKET * NSUBL * T * 4);
constexpr size_t OFF_SSMB = OFF_TOKW + al256((size_t)T * 8);
constexpr size_t OFF_SSMC = OFF_SSMB + al256((size_t)DEPTH * SG * 128 * 16 * 2);
constexpr size_t OFF_SSML = OFF_SSMC + al256((size_t)DEPTH * SG * 16 * 128 * 2);
constexpr size_t OFF_WINT = OFF_SSML + al256((size_t)DEPTH * SG * SP * 2 * 4);
constexpr size_t OFF_WGLUT = OFF_WINT + al256((size_t)DEPTH * INW * D * 2);
constexpr size_t OFF_WOUTT = OFF_WGLUT + al256((size_t)DEPTH * SW * SW * 2);
constexpr size_t OFF_H = OFF_WOUTT + al256((size_t)DEPTH * D * D * 2);
constexpr size_t OFF_Q = OFF_H + al256((size_t)T * D * 2);
constexpr size_t OFF_K = OFF_Q + al256((size_t)T * AW * 2);
constexpr size_t OFF_VT = OFF_K + al256((size_t)T * 128 * 2);
constexpr size_t OFF_U = OFF_VT + al256((size_t)T * 128 * 2);
constexpr size_t OFF_ATTN = OFF_U + al256((size_t)T * SW * 2);
constexpr size_t OFF_ACT = OFF_Q;
static_assert((size_t)MAXMT * TM * D * 2 <= OFF_ATTN - OFF_Q, "act overlay too small");
constexpr size_t OFF_SSQA = OFF_ATTN + al256((size_t)T * AW * 2);
constexpr size_t OFF_Y = OFF_SSQA + al256((size_t)T * 8 * 4);
constexpr size_t OFF_SSM = OFF_Y + al256((size_t)T * SW * 2);
constexpr size_t OFF_SSQS = OFF_SSM + al256((size_t)T * SW * 2);
constexpr size_t OFF_X1 = OFF_SSQS + al256((size_t)T * 8 * 4);
constexpr size_t OFF_XMID = OFF_X1 + al256((size_t)T * D * 2);
constexpr size_t OFF_WGT = OFF_XMID + al256((size_t)T * D * 2);
constexpr size_t OFF_WUT = OFF_WGT + al256((size_t)DEPTH * NE * DFF * D * 2);
constexpr size_t OFF_WDT = OFF_WUT + al256((size_t)DEPTH * NE * DFF * D * 2);
constexpr size_t WS_TOTAL = OFF_WDT + al256((size_t)DEPTH * NE * DFF * D * 2);

struct MP {
  Ptrs in;
  float* out;
  char* ws;
  __device__ __forceinline__ unsigned* bar() const { return (unsigned*)(ws + OFF_BAR); }
  __device__ __forceinline__ unsigned* claim() const { return (unsigned*)(ws + OFF_CLAIM); }
  __device__ __forceinline__ float* mod() const { return (float*)(ws + OFF_MOD); }
  __device__ __forceinline__ float2* cs() const { return (float2*)(ws + OFF_CS); }
  __device__ __forceinline__ int* cnt() const { return (int*)(ws + OFF_CNT); }
  __device__ __forceinline__ int* list() const { return (int*)(ws + OFF_LIST); }
  __device__ __forceinline__ float2* tokw() const { return (float2*)(ws + OFF_TOKW); }
  __device__ __forceinline__ bf16_t* ssmB() const { return (bf16_t*)(ws + OFF_SSMB); }
  __device__ __forceinline__ bf16_t* ssmC() const { return (bf16_t*)(ws + OFF_SSMC); }
  __device__ __forceinline__ float* ssmL() const { return (float*)(ws + OFF_SSML); }
  __device__ __forceinline__ bf16_t* WinT() const { return (bf16_t*)(ws + OFF_WINT); }
  __device__ __forceinline__ bf16_t* WgluT() const { return (bf16_t*)(ws + OFF_WGLUT); }
  __device__ __forceinline__ bf16_t* WoutT() const { return (bf16_t*)(ws + OFF_WOUTT); }
  __device__ __forceinline__ bf16_t* WgT() const { return (bf16_t*)(ws + OFF_WGT); }
  __device__ __forceinline__ bf16_t* WuT() const { return (bf16_t*)(ws + OFF_WUT); }
  __device__ __forceinline__ bf16_t* WdT() const { return (bf16_t*)(ws + OFF_WDT); }
  __device__ __forceinline__ bf16_t* h() const { return (bf16_t*)(ws + OFF_H); }
  __device__ __forceinline__ bf16_t* q() const { return (bf16_t*)(ws + OFF_Q); }
  __device__ __forceinline__ bf16_t* k() const { return (bf16_t*)(ws + OFF_K); }
  __device__ __forceinline__ bf16_t* vT() const { return (bf16_t*)(ws + OFF_VT); }
  __device__ __forceinline__ bf16_t* u() const { return (bf16_t*)(ws + OFF_U); }
  __device__ __forceinline__ bf16_t* attn() const { return (bf16_t*)(ws + OFF_ATTN); }
  __device__ __forceinline__ bf16_t* y() const { return (bf16_t*)(ws + OFF_Y); }
  __device__ __forceinline__ bf16_t* ssm() const { return (bf16_t*)(ws + OFF_SSM); }
  __device__ __forceinline__ bf16_t* act() const { return (bf16_t*)(ws + OFF_ACT); }
  __device__ __forceinline__ float* ssqa() const { return (float*)(ws + OFF_SSQA); }
  __device__ __forceinline__ float* ssqs() const { return (float*)(ws + OFF_SSQS); }
  __device__ __forceinline__ bf16_t* x1() const { return (bf16_t*)(ws + OFF_X1); }
  __device__ __forceinline__ bf16_t* xmid() const { return (bf16_t*)(ws + OFF_XMID); }
};

constexpr int TT_WIN = 8 * 20, TT_GLU = 4 * 8, TT_OUT = 8 * 16, TT_EXP = 16 * 64;
constexpr int TT_LAYER = TT_WIN + TT_GLU + TT_OUT + 3 * TT_EXP;
constexpr int P0_MOD = DEPTH * 192;
constexpr int P0_TR = DEPTH * TT_LAYER;
constexpr int P0_CS = T * 32 / 256;
constexpr int P0_SSM = DEPTH * SG;
constexpr int P0_MISC = P0_MOD + P0_CS + P0_SSM + 1;

__device__ void phase0_item(const MP& p, int it, char* smem) {
  const int tid = launder(threadIdx.x);
  float* ldsf = (float*)smem;
  if (it < P0_MOD) {
    const int l = it / 192, j0 = (it % 192) * 32;
    float* sc = ldsf;
    float* red = ldsf + 8192;
    for (int i = tid; i < 8192; i += NTHR) { float v = p.in.c[i]; sc[i] = v / (1.f + __expf(-v)); }
    __syncthreads();
    const int kg = tid >> 3, cq = (tid & 7) * 4;
    float acc[8][4];
#pragma unroll
    for (int b = 0; b < 8; ++b)
#pragma unroll
      for (int j = 0; j < 4; ++j) acc[b][j] = 0.f;
    const float* w = p.in.ada_w + (size_t)l * 1024 * 6144 + j0 + cq;
#pragma unroll 8
    for (int kk = 0; kk < 32; ++kk) {
      const int k = kg * 32 + kk;
      const float4 wv = *(const float4*)(w + (size_t)k * 6144);
#pragma unroll
      for (int b = 0; b < 8; ++b) { const float s = sc[b * 1024 + k]; acc[b][0] += s * wv.x; acc[b][1] += s * wv.y; acc[b][2] += s * wv.z; acc[b][3] += s * wv.w; }
    }
#pragma unroll
    for (int b = 0; b < 8; ++b) *(float4*)(red + (kg * 8 + b) * 32 + cq) = make_float4(acc[b][0], acc[b][1], acc[b][2], acc[b][3]);
    __syncthreads();
    {
      const int b = tid >> 5, c = tid & 31;
      float v = 0.f;
#pragma unroll 8
      for (int g = 0; g < 32; ++g) v += red[(g * 8 + b) * 32 + c];
      p.mod()[(size_t)(l * 8 + b) * 6144 + j0 + c] = v + p.in.ada_b[l * 6144 + j0 + c];
    }
    __syncthreads();
    return;
  }
  it -= P0_MOD;
  if (it < P0_CS) {
    const int i = it * 256 + tid, t = i >> 5, f = i & 31;
    const float freq = powf(10000.f, -(float)f / 32.f);
    const float ang = (float)p.in.pos[t] * freq;
    float sn, cn; sincosf(ang, &sn, &cn);
    p.cs()[i] = make_float2(cn, sn);
    return;
  }
  it -= P0_CS;
  if (it < P0_SSM) {
    const int lg = it;
    if (tid < 64) {
      const int pp = tid;
      const float dt = expf(p.in.log_dt[lg]);
      const float lr = p.in.lam_re[lg * SP + pp], li = p.in.lam_im[lg * SP + pp];
      const float mag = expf(lr * dt);
      float sn, cn; sincosf(li * dt, &sn, &cn);
      const float ar = mag * cn, ai = mag * sn;
      const float den = lr * lr + li * li;
      const float fr = ((ar - 1.f) * lr + ai * li) / den, fi = (ai * lr - (ar - 1.f) * li) / den;
      p.ssmL()[(lg * SP + pp) * 2] = ar; p.ssmL()[(lg * SP + pp) * 2 + 1] = ai;
      unsigned wr[8], wi[8];
#pragma unroll
      for (int hh = 0; hh < 8; ++hh) {
        const float br0 = p.in.b_re[((size_t)lg * SP + pp) * SCH + 2 * hh], bi0 = p.in.b_im[((size_t)lg * SP + pp) * SCH + 2 * hh];
        const float br1 = p.in.b_re[((size_t)lg * SP + pp) * SCH + 2 * hh + 1], bi1 = p.in.b_im[((size_t)lg * SP + pp) * SCH + 2 * hh + 1];
        wr[hh] = pack2(fr * br0 - fi * bi0, fr * br1 - fi * bi1);
        wi[hh] = pack2(fr * bi0 + fi * br0, fr * bi1 + fi * br1);
      }
      u32x4* dr = (u32x4*)(p.ssmB() + ((size_t)lg * 128 + pp) * 16);
      u32x4* di = (u32x4*)(p.ssmB() + ((size_t)lg * 128 + 64 + pp) * 16);
      dr[0] = (u32x4){wr[0], wr[1], wr[2], wr[3]}; dr[1] = (u32x4){wr[4], wr[5], wr[6], wr[7]};
      di[0] = (u32x4){wi[0], wi[1], wi[2], wi[3]}; di[1] = (u32x4){wi[4], wi[5], wi[6], wi[7]};
    }
    for (int o = tid; o < 16 * 64; o += NTHR) {
      const int hh = o >> 6, pp = o & 63;
      const float cr = p.in.c_re[(size_t)lg * SCH * SP + o], ci = p.in.c_im[(size_t)lg * SCH * SP + o];
      *(unsigned*)(p.ssmC() + ((size_t)lg * 16 + hh) * 128 + 2 * pp) = pack2(cr, -ci);
    }
    return;
  }
  for (int i = tid; i < 256 * DEPTH; i += NTHR) p.cnt()[i] = 0;
}

struct TrDesc { const float* src; bf16_t* dst; const float* gain; int N, K, k0, n0; };
__device__ __forceinline__ void tr_decode(const MP& p, int it, TrDesc& d) {
  const int l = it / TT_LAYER; int r = it % TT_LAYER;
  d.gain = nullptr;
  if (r < TT_WIN) { d.src = p.in.w_in + (size_t)l * D * INW; d.N = INW; d.dst = p.WinT() + (size_t)l * INW * D; d.K = D; d.k0 = (r / 20) * 128; d.n0 = (r % 20) * 64; return; }
  r -= TT_WIN;
  if (r < TT_GLU) { d.src = p.in.w_glu + (size_t)l * SW * SW; d.N = SW; d.dst = p.WgluT() + (size_t)l * SW * SW; d.K = SW; d.k0 = (r / 8) * 128; d.n0 = (r % 8) * 64; return; }
  r -= TT_GLU;
  if (r < TT_OUT) {
    d.k0 = (r / 16) * 128; d.n0 = (r % 16) * 64;
    d.gain = d.k0 < 512 ? (p.in.attn_out_g + l * AW) : (p.in.ssm_out_g + l * SW - 512);
    d.src = p.in.w_out + (size_t)l * D * D; d.N = D; d.dst = p.WoutT() + (size_t)l * D * D; d.K = D; return; }
  r -= TT_OUT;
  const int kind = r / TT_EXP; r %= TT_EXP;
  const int e = r / 64, tt = r % 64;
  if (kind == 0) { d.src = p.in.w_gate + (size_t)(l * NE + e) * D * DFF; d.N = DFF; d.dst = p.WgT() + (size_t)(l * NE + e) * DFF * D; d.K = D; d.k0 = (tt / 8) * 128; d.n0 = (tt % 8) * 64; return; }
  if (kind == 1) { d.src = p.in.w_up + (size_t)(l * NE + e) * D * DFF; d.N = DFF; d.dst = p.WuT() + (size_t)(l * NE + e) * DFF * D; d.K = D; d.k0 = (tt / 8) * 128; d.n0 = (tt % 8) * 64; return; }
  d.src = p.in.w_down + (size_t)(l * NE + e) * DFF * D; d.N = D; d.dst = p.WdT() + (size_t)(l * NE + e) * D * DFF; d.K = DFF; d.k0 = (tt / 16) * 128; d.n0 = (tt % 16) * 64;
}
__device__ void phase0_transposes(const MP& p, char* smem) {
  const int tid = launder(threadIdx.x);
  float* lds = (float*)smem;
  const int r = tid >> 4, c4 = (tid & 15) * 4;
  const int n = tid >> 2, kq = (tid & 3) * 32;
  TrDesc cur, nxt;
  float4 v[8]; float gg[8];
  auto load = [&](const TrDesc& d) {
#pragma unroll
    for (int i = 0; i < 8; ++i) v[i] = *(const float4*)(d.src + (size_t)(d.k0 + r + 16 * i) * d.N + d.n0 + c4);
    if (d.gain) {
#pragma unroll
      for (int i = 0; i < 8; ++i) gg[i] = d.gain[d.k0 + r + 16 * i];
    } else {
#pragma unroll
      for (int i = 0; i < 8; ++i) gg[i] = 1.f;
    }
  };
  int it = blockIdx.x;
  if (it < P0_TR) { tr_decode(p, it, cur); load(cur); nxt = cur; }
  for (; it < P0_TR; it += gridDim.x) {
#pragma unroll
    for (int i = 0; i < 8; ++i) {
      float* d = lds + (r + 16 * i) * 65 + c4;
      d[0] = v[i].x * gg[i]; d[1] = v[i].y * gg[i]; d[2] = v[i].z * gg[i]; d[3] = v[i].w * gg[i];
    }
    __syncthreads();
    const int nit = it + gridDim.x;
    if (nit < P0_TR) { tr_decode(p, nit, nxt); load(nxt); }
    unsigned w[16];
#pragma unroll
    for (int j = 0; j < 16; ++j) w[j] = pack2(lds[(kq + 2 * j) * 65 + n], lds[(kq + 2 * j + 1) * 65 + n]);
    u32x4* dd = (u32x4*)(cur.dst + (size_t)(cur.n0 + n) * cur.K + cur.k0 + kq);
#pragma unroll
    for (int j = 0; j < 4; ++j) dd[j] = (u32x4){w[4 * j], w[4 * j + 1], w[4 * j + 2], w[4 * j + 3]};
    __syncthreads();
    cur = nxt;
  }
}

__device__ __forceinline__ float4 load_x4(const MP& p, int l, size_t idx) {
  if (l == 0) return *(const float4*)(p.in.x + idx);
  const u32x2 r = *(const u32x2*)(p.xmid() + idx);
  return make_float4(bf_lo(r[0]), bf_hi(r[0]), bf_lo(r[1]), bf_hi(r[1]));
}
__device__ void phase_norm1(const MP& p, int l) {
  const int tid = launder(threadIdx.x);
  const int wave = tid >> 6, lane = tid & 63;
  const float* modl = p.mod() + (size_t)l * 8 * 6144;
  const float* g = p.in.norm1_g + l * D;
  for (int t = blockIdx.x * 4 + wave; t < T; t += gridDim.x * 4) {
    const int b = t / S;
    const float* sh = modl + (size_t)b * 6144; const float* sc = sh + 1024;
    float4 v[4]; float ss = 0.f;
#pragma unroll
    for (int i = 0; i < 4; ++i) { v[i] = load_x4(p, l, (size_t)t * D + lane * 4 + 256 * i); ss += v[i].x * v[i].x + v[i].y * v[i].y + v[i].z * v[i].z + v[i].w * v[i].w; }
    ss = wave_sum(ss);
    const float rinv = rsqrtf(ss * (1.f / D) + EPS);
#pragma unroll
    for (int i = 0; i < 4; ++i) {
      const int d = lane * 4 + 256 * i;
      const float4 gg = *(const float4*)(g + d), s1 = *(const float4*)(sc + d), s0 = *(const float4*)(sh + d);
      const float h0 = v[i].x * rinv * gg.x * (1.f + s1.x) + s0.x, h1 = v[i].y * rinv * gg.y * (1.f + s1.y) + s0.y;
      const float h2 = v[i].z * rinv * gg.z * (1.f + s1.z) + s0.z, h3 = v[i].w * rinv * gg.w * (1.f + s1.w) + s0.w;
      *(u32x2*)(p.h() + (size_t)t * D + d) = (u32x2){pack2(h0, h1), pack2(h2, h3)};
    }
  }
}

struct GemmTile {
  const bf16_t* A0; const bf16_t* A1; long lda; int ksA;
  int arow[4];
  const bf16_t* Blo0; const bf16_t* Bhi0;
  const bf16_t* Blo1; const bf16_t* Bhi1;
  long ldb; int ksB;
  int K;
};

__device__ __forceinline__ int lds_off(int row, int chunk) { return row * 128 + ((chunk ^ ((row >> 1) & 7)) << 4); }

template <bool BSPLIT, bool MID>
__device__ __forceinline__ void gemm_mainloop_t(const GemmTile& g, const GemmTile& gnext, bool hasnext, bool preloaded, char* smem, f32x4 (&acc)[4][4],
                                                int ktmid, const float (&mids)[4]) {
  const int tid = launder(threadIdx.x), lane = tid & 63, wave = tid >> 6, wr = wave >> 1, wc = wave & 1, fr = lane & 15, fq = lane >> 4;
  const int r0 = tid >> 3, c8 = tid & 7;
  const int csrc = (c8 ^ ((r0 >> 1) & 7)) * 8;
#pragma unroll
  for (int m = 0; m < 4; ++m)
#pragma unroll
    for (int n = 0; n < 4; ++n) acc[m][n] = (f32x4){0.f, 0.f, 0.f, 0.f};
  auto stage = [&](const GemmTile& gg, int kt, int buf) {
    const int kk = kt * 64;
    const bf16_t* Ab = kk < gg.ksA ? gg.A0 + kk : gg.A1 + (kk - gg.ksA);
    const bool bs = kk < gg.ksB; const int kb = bs ? kk : kk - gg.ksB;
    char* As = smem + buf * 32768 + tid * 16; char* Bs = As + 16384;
#pragma unroll
    for (int i = 0; i < 4; ++i) {
      __builtin_amdgcn_global_load_lds((const void*)(Ab + (size_t)gg.arow[i] * gg.lda + csrc), (void*)(As + i * 4096), 16, 0, 0);
      const bf16_t* Bb = bs ? (i < 2 ? gg.Blo0 : gg.Bhi0) : (i < 2 ? gg.Blo1 : gg.Bhi1);
      __builtin_amdgcn_global_load_lds((const void*)(Bb + (size_t)(r0 + 32 * (i & 1)) * gg.ldb + kb + csrc), (void*)(Bs + i * 4096), 16, 0, 0);
    }
  };
  const int nk = g.K / 64;
  if (!preloaded) {
    stage(g, 0, 0);
    asm volatile("s_waitcnt vmcnt(0)" ::: "memory");
    __syncthreads();
  }
  for (int kt = 0; kt < nk; ++kt) {
    if (kt + 1 < nk) stage(g, kt + 1, (kt + 1) & 1);
    else if (hasnext) stage(gnext, 0, 0);
    if (MID && kt == ktmid) {
#pragma unroll
      for (int m = 0; m < 4; ++m)
#pragma unroll
        for (int n = 0; n < 4; ++n) acc[m][n] *= mids[m];
    }
    const char* As = smem + (kt & 1) * 32768; const char* Bs = As + 16384;
    {
      bf16x8 af[2][4], bfr[2][4];
#pragma unroll
      for (int ks = 0; ks < 2; ++ks) {
#pragma unroll
        for (int m = 0; m < 4; ++m) af[ks][m] = *(const bf16x8*)(As + lds_off(wr * 64 + 16 * m + fr, ks * 4 + fq));
#pragma unroll
        for (int n = 0; n < 4; ++n) {
          const int brow = BSPLIT ? ((n >> 1) * 64 + wc * 32 + (n & 1) * 16 + fr) : (wc * 64 + 16 * n + fr);
          bfr[ks][n] = *(const bf16x8*)(Bs + lds_off(brow, ks * 4 + fq));
        }
      }
#pragma unroll
      for (int ks = 0; ks < 2; ++ks)
#pragma unroll
        for (int m = 0; m < 4; ++m)
#pragma unroll
          for (int n = 0; n < 4; ++n) acc[m][n] = __builtin_amdgcn_mfma_f32_16x16x32_bf16(bfr[ks][n], af[ks][m], acc[m][n], 0, 0, 0);
      __builtin_amdgcn_sched_group_barrier(0x100, 8, 0);
#pragma unroll
      for (int i = 0; i < 8; ++i) { __builtin_amdgcn_sched_group_barrier(0x008, 2, 0); __builtin_amdgcn_sched_group_barrier(0x100, 1, 0); }
      __builtin_amdgcn_sched_group_barrier(0x008, 16, 0);
    }
    __builtin_amdgcn_sched_barrier(0);
    asm volatile("s_waitcnt vmcnt(0)" ::: "memory");
    __syncthreads();
  }
}
template <bool BSPLIT>
__device__ __forceinline__ void gemm_mainloop(const GemmTile& g, const GemmTile& gnext, bool hasnext, bool preloaded, char* smem, f32x4 (&acc)[4][4]) {
  const float dummy[4] = {1.f, 1.f, 1.f, 1.f};
  gemm_mainloop_t<BSPLIT, false>(g, gnext, hasnext, preloaded, smem, acc, -1, dummy);
}

struct TileMap { int base, ntl, lb, nlb; };
__device__ __forceinline__ TileMap tm_init(int nMt, int nNt) {
  TileMap t;
  if ((gridDim.x & 7) == 0) {
    const int xcd = blockIdx.x & 7;
    t.lb = blockIdx.x >> 3; t.nlb = gridDim.x >> 3;
    const int mlo = (nMt * xcd) >> 3, mhi = (nMt * (xcd + 1)) >> 3;
    t.base = mlo * nNt; t.ntl = (mhi - mlo) * nNt;
  } else { t.lb = blockIdx.x; t.nlb = gridDim.x; t.base = 0; t.ntl = nMt * nNt; }
  return t;
}
__device__ __forceinline__ int tm_tile(const TileMap& t, int j) { const int li = t.lb + t.nlb * j; return li < t.ntl ? t.base + li : -1; }
__device__ void phase_inproj(const MP& p, int l, char* smem) {
  const int tid = launder(threadIdx.x), lane = tid & 63, wave = tid >> 6, wr = wave >> 1, wc = wave & 1, fr = lane & 15, fq = lane >> 4;
  const int r0 = tid >> 3;
  const int ntiles = (T / 128) * (INW / 128);
  const bf16_t* W = p.WinT() + (size_t)l * INW * D;
  auto make = [&](int tile, GemmTile& g) {
    const int m0 = (tile / 10) * 128, n0 = (tile % 10) * 128;
    g.A0 = p.h(); g.A1 = p.h(); g.lda = D; g.ksA = D; g.K = D;
#pragma unroll
    for (int i = 0; i < 4; ++i) g.arow[i] = m0 + r0 + 32 * i;
    g.Blo0 = W + (size_t)n0 * D; g.Bhi0 = g.Blo0 + (size_t)64 * D; g.Blo1 = g.Blo0; g.Bhi1 = g.Bhi0;
    g.ldb = D; g.ksB = D;
  };
  GemmTile g, gn; bool pre = false;
  const TileMap tmap = tm_init(T / 128, INW / 128);
  { const int t0 = tm_tile(tmap, 0); if (t0 >= 0) { make(t0, g); gn = g; } }
  for (int jt = 0; ; ++jt) {
    const int tile = tm_tile(tmap, jt); if (tile < 0) break;
    const int mt = tile / 10, nt = tile % 10, m0 = mt * 128;
    const int nxt = tm_tile(tmap, jt + 1); const bool hasn = nxt >= 0;
    if (hasn) make(nxt, gn);
    f32x4 acc[4][4];
    gemm_mainloop<false>(g, gn, hasn, pre, smem, acc);
    pre = hasn; g = gn;
    const int rowb = m0 + wr * 64 + fr;
    if (nt <= 4) {
      const float* gv = (nt < 4 ? p.in.q_norm_g : p.in.k_norm_g) + l * HD;
      const float scl = nt < 4 ? 0.125f : 1.f;
      f32x4 g1[2], g2[2];
#pragma unroll
      for (int n = 0; n < 2; ++n) { g1[n] = *(const f32x4*)(gv + 16 * n + 4 * fq); g2[n] = *(const f32x4*)(gv + 32 + 16 * n + 4 * fq); }
#pragma unroll
      for (int m = 0; m < 4; ++m) {
        const int t = rowb + 16 * m;
        float ss = 0.f;
#pragma unroll
        for (int n = 0; n < 4; ++n)
#pragma unroll
          for (int j = 0; j < 4; ++j) ss += acc[m][n][j] * acc[m][n][j];
        ss += __shfl_xor(ss, 16); ss += __shfl_xor(ss, 32);
        const float rinv = rsqrtf(ss * (1.f / 64.f) + EPS) * scl;
        bf16_t* dst = nt < 4 ? (p.q() + (size_t)t * AW + (2 * nt + wc) * 64) : (p.k() + (size_t)t * 128 + wc * 64);
#pragma unroll
        for (int n = 0; n < 2; ++n) {
          const int c = 16 * n + 4 * fq;
          const f32x4 csa = *(const f32x4*)((const float*)p.cs() + ((size_t)t * 32 + c) * 2);
          const f32x4 csb = *(const f32x4*)((const float*)p.cs() + ((size_t)t * 32 + c + 2) * 2);
          const float cn[4] = {csa[0], csa[2], csb[0], csb[2]}, sn[4] = {csa[1], csa[3], csb[1], csb[3]};
          float o1[4], o2[4];
#pragma unroll
          for (int j = 0; j < 4; ++j) {
            const float x1 = acc[m][n][j] * rinv * g1[n][j], x2 = acc[m][n + 2][j] * rinv * g2[n][j];
            o1[j] = x1 * cn[j] - x2 * sn[j]; o2[j] = x2 * cn[j] + x1 * sn[j];
          }
          *(u32x2*)(dst + c) = (u32x2){pack2(o1[0], o1[1]), pack2(o1[2], o1[3])};
          *(u32x2*)(dst + 32 + c) = (u32x2){pack2(o2[0], o2[1]), pack2(o2[2], o2[3])};
        }
      }
    } else if (nt == 5) {
      const int b = m0 / S;
#pragma unroll
      for (int m = 0; m < 4; ++m) {
        const int s = (rowb + 16 * m) % S;
        const int k16 = s & 15;
        const int sp = (s & ~15) | (k16 & 3) | (((k16 >> 3) & 1) << 2) | (((k16 >> 2) & 1) << 3);
#pragma unroll
        for (int n = 0; n < 4; ++n)
#pragma unroll
          for (int j = 0; j < 4; ++j) {
            const int d = 16 * n + 4 * fq + j;
            p.vT()[((size_t)(b * 2 + wc) * 64 + d) * S + sp] = (bf16_t)(pack2(acc[m][n][j], 0.f) & 0xffffu);
          }
      }
    } else {
#pragma unroll
      for (int m = 0; m < 4; ++m) {
        const int t = rowb + 16 * m;
#pragma unroll
        for (int n = 0; n < 4; ++n)
          *(u32x2*)(p.u() + (size_t)t * SW + (nt - 6) * 128 + wc * 64 + 16 * n + 4 * fq) = (u32x2){pack2(acc[m][n][0], acc[m][n][1]), pack2(acc[m][n][2], acc[m][n][3])};
      }
    }
  }
}

__device__ __forceinline__ int crow32(int r, int hf) { return (r & 3) + 8 * (r >> 2) + 4 * hf; }
__device__ void attn_task(const MP& p, int l, int task, int lane) {
  lane = launder(lane);
  task = __builtin_amdgcn_readfirstlane(task);
  const int h = task & 7, qt = (task >> 3) & 63, b = task >> 9, kvh = h >> 2;
  const int s0 = qt * 32, t0 = b * S + s0, ql = lane & 31, hf = lane >> 5;
  int kst[5];
#pragma unroll
  for (int kt = 0; kt < 5; ++kt) { const int ks = s0 - 128 + 32 * kt; kst[kt] = ks < 0 ? 0 : ks; }
  bf16x8 qf[4], kf[5][4];
#pragma unroll
  for (int st = 0; st < 4; ++st) qf[st] = *(const bf16x8*)(p.q() + (size_t)(t0 + ql) * AW + h * 64 + 16 * st + 8 * hf);
#pragma unroll
  for (int kt = 0; kt < 5; ++kt)
#pragma unroll
    for (int st = 0; st < 4; ++st) kf[kt][st] = *(const bf16x8*)(p.k() + (size_t)(b * S + kst[kt] + ql) * 128 + kvh * 64 + 8 * hf + 16 * st);
  f32x16 sc[5];
#pragma unroll
  for (int kt = 0; kt < 5; ++kt) {
#pragma unroll
    for (int r = 0; r < 16; ++r) sc[kt][r] = 0.f;
#pragma unroll
    for (int st = 0; st < 4; ++st) sc[kt] = __builtin_amdgcn_mfma_f32_32x32x16_bf16(kf[kt][st], qf[st], sc[kt], 0, 0, 0);
  }
  bf16x8 vb[5][2][2];
#pragma unroll
  for (int kt = 0; kt < 5; ++kt)
#pragma unroll
    for (int s = 0; s < 2; ++s)
#pragma unroll
      for (int dt = 0; dt < 2; ++dt)
        vb[kt][s][dt] = *(const bf16x8*)(p.vT() + ((size_t)(b * 2 + kvh) * 64 + 32 * dt + ql) * S + kst[kt] + 16 * s + 8 * hf);
  const float sink = p.in.attn_sink[l * NQ + h];
  float mx = sink;
#pragma unroll
  for (int kt = 0; kt < 5; ++kt) {
#pragma unroll
    for (int r = 0; r < 16; ++r) {
      const int kp = s0 - 128 + 32 * kt + crow32(r, hf);
      const int dk = kp - (s0 + ql);
      const bool valid = kp >= 0 && dk <= 0 && dk > -128;
      sc[kt][r] = valid ? sc[kt][r] : -1e30f;
      mx = fmaxf(mx, sc[kt][r]);
    }
  }
  mx = fmaxf(mx, __shfl_xor(mx, 32));
  float lsum = 0.f;
#pragma unroll
  for (int kt = 0; kt < 5; ++kt) {
#pragma unroll
    for (int r = 0; r < 16; ++r) { const float e = __expf(sc[kt][r] - mx); sc[kt][r] = e; lsum += e; }
  }
  lsum += __shfl_xor(lsum, 32);
  lsum += __expf(sink - mx);
  const float inv = 1.f / lsum;
  f32x16 o[2];
#pragma unroll
  for (int r = 0; r < 16; ++r) { o[0][r] = 0.f; o[1][r] = 0.f; }
#pragma unroll
  for (int kt = 0; kt < 5; ++kt) {
#pragma unroll
    for (int s = 0; s < 2; ++s) {
      u32x4 pw;
#pragma unroll
      for (int j = 0; j < 4; ++j) pw[j] = pack2(sc[kt][8 * s + 2 * j] * inv, sc[kt][8 * s + 2 * j + 1] * inv);
      const bf16x8 pa = __builtin_bit_cast(bf16x8, pw);
#pragma unroll
      for (int dt = 0; dt < 2; ++dt) o[dt] = __builtin_amdgcn_mfma_f32_32x32x16_bf16(pa, vb[kt][s][dt], o[dt], 0, 0, 0);
    }
  }
#pragma unroll
  for (int r = 0; r < 16; ++r) {
    const int t = t0 + crow32(r, hf);
    bf16_t* dst = p.attn() + (size_t)t * AW + h * 64 + ql;
    const unsigned w = pack2(o[0][r], o[1][r]);
    dst[0] = (bf16_t)(w & 0xffffu); dst[32] = (bf16_t)(w >> 16);
    float v = o[0][r] * o[0][r] + o[1][r] * o[1][r];
    v = row_sum32_dpp(v);
    if (ql == 31) p.ssqa()[(size_t)t * 8 + h] = v;
  }
}
constexpr int SSEG = 4, SEGLEN = S / SSEG, SEGCH = SEGLEN / 32;

__device__ __forceinline__ void ssm_bu(const bf16x8& ua, const bf16x8 (&bB)[4], f32x16 (&bu)[4]) {
#pragma unroll
  for (int nt = 0; nt < 4; ++nt) {
#pragma unroll
    for (int r = 0; r < 16; ++r) bu[nt][r] = 0.f;
    bu[nt] = __builtin_amdgcn_mfma_f32_32x32x16_bf16(ua, bB[nt], bu[nt], 0, 0, 0);
  }
  asm volatile("s_nop 15\n\ts_nop 7" : "+v"(bu[0]), "+v"(bu[1]), "+v"(bu[2]), "+v"(bu[3]));
#pragma unroll
  for (int r = 0; r < 16; ++r) {
    auto s0 = __builtin_amdgcn_permlane32_swap(__float_as_uint(bu[0][r]), __float_as_uint(bu[1][r]), false, false);
    bu[0][r] = __uint_as_float(s0[0]); bu[1][r] = __uint_as_float(s0[1]);
    auto s1 = __builtin_amdgcn_permlane32_swap(__float_as_uint(bu[2][r]), __float_as_uint(bu[3][r]), false, false);
    bu[2][r] = __uint_as_float(s1[0]); bu[3][r] = __uint_as_float(s1[1]);
  }
}

__device__ void ssm_block(const MP& p, int l, int b, int g, int tid, char* smem) {
  const int lane = tid & 63, seg = tid >> 6;
  char* wl = smem + seg * 8192;
  float* fin = (float*)(smem + 4 * 8192);
  const int lg = l * SG + g, hf = lane >> 5, fr = lane & 15, fq = lane >> 4;
  const float ar = p.ssmL()[(lg * SP + lane) * 2], ai = p.ssmL()[(lg * SP + lane) * 2 + 1];
  bf16x8 bB[4], cB[4];
#pragma unroll
  for (int nt = 0; nt < 4; ++nt) bB[nt] = *(const bf16x8*)(p.ssmB() + ((size_t)lg * 128 + nt * 32 + (lane & 31)) * 16 + 8 * hf);
#pragma unroll
  for (int ks = 0; ks < 4; ++ks) cB[ks] = *(const bf16x8*)(p.ssmC() + ((size_t)lg * 16 + fr) * 128 + 32 * ks + 8 * fq);
  const float dsk = p.in.ssm_d[l * SW + g * 16 + fr];
  const int t0 = b * S + seg * SEGLEN;
  const bf16_t* urow = p.u() + (size_t)(t0 + (lane & 31)) * SW + g * 16 + 8 * hf;
  float xr = 0.f, xi = 0.f;
  if (seg < SSEG - 1) {
    bf16x8 ua = *(const bf16x8*)(urow);
    for (int c = 0; c < SEGCH; ++c) {
      const bf16x8 un = *(const bf16x8*)(urow + (size_t)((c + 1 < SEGCH ? c + 1 : c) * 32) * SW);
      f32x16 bu[4];
      ssm_bu(ua, bB, bu);
#pragma unroll
      for (int r4 = 0; r4 < 4; ++r4)
#pragma unroll
        for (int half = 0; half < 2; ++half)
#pragma unroll
          for (int j = 0; j < 4; ++j) {
            const int r = 4 * r4 + j;
            const float bre = half ? bu[1][r] : bu[0][r], bim = half ? bu[3][r] : bu[2][r];
            const float nr = ar * xr - ai * xi + bre, ni = ar * xi + ai * xr + bim;
            xr = nr; xi = ni;
          }
      ua = un;
    }
  }
  fin[(seg * 64 + lane) * 2] = xr; fin[(seg * 64 + lane) * 2 + 1] = xi;
  __syncthreads();
  {
    float pr = ar, pi = ai;
#pragma unroll
    for (int i = 0; i < 9; ++i) { const float nr = pr * pr - pi * pi, ni = 2.f * pr * pi; pr = nr; pi = ni; }
    static_assert(SEGLEN == 512, "lam^SEGLEN squaring count");
    float cr = 0.f, ci = 0.f;
    for (int j = 0; j < seg; ++j) {
      const float fr_ = fin[(j * 64 + lane) * 2], fi_ = fin[(j * 64 + lane) * 2 + 1];
      const float nr = pr * cr - pi * ci + fr_, ni = pr * ci + pi * cr + fi_;
      cr = nr; ci = ni;
    }
    xr = cr; xi = ci;
  }
  const int wbase = (lane & 3) * 4;
  const int pch = lane >> 2;
  const bf16_t* uep = p.u() + (size_t)(t0 + 4 * fq) * SW + g * 16 + fr;
  bf16x8 ua = *(const bf16x8*)(urow);
  bf16_t uraw[8];
#pragma unroll
  for (int i = 0; i < 8; ++i) uraw[i] = uep[(size_t)(16 * (i >> 2) + (i & 3)) * SW];
  for (int c = 0; c < SEGCH; ++c) {
    const int tb = t0 + c * 32;
    const int cn = (c + 1 < SEGCH ? c + 1 : c) * 32;
    const bf16x8 un = *(const bf16x8*)(urow + (size_t)cn * SW);
    bf16_t unraw[8];
#pragma unroll
    for (int i = 0; i < 8; ++i) unraw[i] = uep[(size_t)(cn + 16 * (i >> 2) + (i & 3)) * SW];
    f32x16 bu[4];
    ssm_bu(ua, bB, bu);
#pragma unroll
    for (int r4 = 0; r4 < 4; ++r4) {
#pragma unroll
      for (int half = 0; half < 2; ++half) {
#pragma unroll
        for (int j = 0; j < 4; ++j) {
          const int t = 8 * r4 + 4 * half + j, r = 4 * r4 + j;
          const float bre = half ? bu[1][r] : bu[0][r], bim = half ? bu[3][r] : bu[2][r];
          const float nr = ar * xr - ai * xi + bre, ni = ar * xi + ai * xr + bim;
          xr = nr; xi = ni;
          *(unsigned*)(wl + t * 256 + ((pch ^ (t & 15)) << 4) + wbase) = pack2(nr, ni);
        }
      }
    }
    asm volatile("s_waitcnt lgkmcnt(0)" ::: "memory");
#pragma unroll
    for (int mt = 0; mt < 2; ++mt) {
      f32x4 acc = {0.f, 0.f, 0.f, 0.f};
      const int t = 16 * mt + fr;
#pragma unroll
      for (int ks = 0; ks < 4; ++ks) {
        const bf16x8 af = *(const bf16x8*)(wl + t * 256 + (((4 * ks + fq) ^ (t & 15)) << 4));
        acc = __builtin_amdgcn_mfma_f32_16x16x32_bf16(af, cB[ks], acc, 0, 0, 0);
      }
#pragma unroll
      for (int j = 0; j < 4; ++j) {
        const int tt = tb + 16 * mt + 4 * fq + j;
        const float uu = bf1(uraw[4 * mt + j]);
        const float v = acc[j] + dsk * uu;
        const float z2 = 1.5957691216057308f * (v + 0.044715f * v * v * v);
        const float ge = v * __builtin_amdgcn_rcpf(1.f + __expf(-z2));
        p.y()[(size_t)tt * SW + g * 16 + fr] = (bf16_t)(pack2(ge, 0.f) & 0xffffu);
      }
    }
    asm volatile("s_waitcnt lgkmcnt(0)" ::: "memory");
    ua = un;
#pragma unroll
    for (int i = 0; i < 8; ++i) uraw[i] = unraw[i];
  }
}

__device__ void phase_attn(const MP& p, int l) {
  const int tid = launder(threadIdx.x);
  const int wave = tid >> 6, lane = tid & 63;
  for (int task = blockIdx.x * 4 + wave; task < NB * 64 * 8; task += gridDim.x * 4) attn_task(p, l, task, lane);
}
__device__ void phase_ssm(const MP& p, int l, char* smem, int wid) {
  const int tid = launder(threadIdx.x);
  if (wid < 0) return;
  const int nw = (int)__hip_atomic_load(p.claim() + 4096, __ATOMIC_RELAXED, __HIP_MEMORY_SCOPE_AGENT);
  for (int task = wid; task < NB * SG; task += nw) {
    ssm_block(p, l, task / SG, task % SG, tid, smem);
    __syncthreads();
  }
}
__device__ void phase_glu(const MP& p, int l, char* smem) {
  const int tid = launder(threadIdx.x), lane = tid & 63, wave = tid >> 6, wr = wave >> 1, wc = wave & 1, fr = lane & 15, fq = lane >> 4;
  const int r0 = tid >> 3;
  const int ntiles = (T / 128) * (SW / 128);
  const bf16_t* W = p.WgluT() + (size_t)l * SW * SW;
  auto make = [&](int tile, GemmTile& g) {
    const int m0 = (tile >> 2) * 128, n0 = (tile & 3) * 128;
    g.A0 = p.y(); g.A1 = p.y(); g.lda = SW; g.ksA = SW; g.K = SW;
#pragma unroll
    for (int i = 0; i < 4; ++i) g.arow[i] = m0 + r0 + 32 * i;
    g.Blo0 = W + (size_t)n0 * SW; g.Bhi0 = g.Blo0 + (size_t)64 * SW; g.Blo1 = g.Blo0; g.Bhi1 = g.Bhi0;
    g.ldb = SW; g.ksB = SW;
  };
  GemmTile g, gn; bool pre = false;
  const TileMap tmap = tm_init(T / 128, SW / 128);
  { const int t0 = tm_tile(tmap, 0); if (t0 >= 0) { make(t0, g); gn = g; } }
  for (int jt = 0; ; ++jt) {
    const int tile = tm_tile(tmap, jt); if (tile < 0) break;
    const int mt = tile >> 2, nt = tile & 3, m0 = mt * 128, n0 = nt * 128;
    const int nxt = tm_tile(tmap, jt + 1); const bool hasn = nxt >= 0;
    if (hasn) make(nxt, gn);
    f32x4 acc[4][4];
    gemm_mainloop<false>(g, gn, hasn, pre, smem, acc);
    pre = hasn; g = gn;
#pragma unroll
    for (int m = 0; m < 4; ++m) {
      const int t = m0 + wr * 64 + 16 * m + fr;
      float ss = 0.f;
#pragma unroll
      for (int n = 0; n < 4; ++n) {
        const int col = n0 + wc * 64 + 16 * n + 4 * fq;
        const u32x2 yr = *(const u32x2*)(p.y() + (size_t)t * SW + col);
        const float yv[4] = {bf_lo(yr[0]), bf_hi(yr[0]), bf_lo(yr[1]), bf_hi(yr[1])};
        float o[4];
#pragma unroll
        for (int j = 0; j < 4; ++j) { o[j] = yv[j] * __builtin_amdgcn_rcpf(1.f + __expf(-acc[m][n][j])); ss += o[j] * o[j]; }
        *(u32x2*)(p.ssm() + (size_t)t * SW + col) = (u32x2){pack2(o[0], o[1]), pack2(o[2], o[3])};
      }
      ss += __shfl_xor(ss, 16); ss += __shfl_xor(ss, 32);
      if (fq == 0) p.ssqs()[(size_t)t * 8 + nt * 2 + wc] = ss;
    }
  }
}

__device__ void phase_out(const MP& p, int l, char* smem) {
  const int tid = launder(threadIdx.x), lane = tid & 63, wave = tid >> 6, wr = wave >> 1, wc = wave & 1, fr = lane & 15, fq = lane >> 4;
  const int r0 = tid >> 3;
  const float* modl = p.mod() + (size_t)l * 8 * 6144;
  const int ntiles = (T / 128) * (D / 128);
  const bf16_t* W = p.WoutT() + (size_t)l * D * D;
  auto make = [&](int tile, GemmTile& g) {
    const int m0 = (tile >> 3) * 128, n0 = (tile & 7) * 128;
    g.A0 = p.attn(); g.A1 = p.ssm(); g.lda = AW; g.ksA = AW; g.K = D;
#pragma unroll
    for (int i = 0; i < 4; ++i) g.arow[i] = m0 + r0 + 32 * i;
    g.Blo0 = W + (size_t)n0 * D; g.Bhi0 = g.Blo0 + (size_t)64 * D; g.Blo1 = g.Blo0; g.Bhi1 = g.Bhi0;
    g.ldb = D; g.ksB = D;
  };
  GemmTile g, gn; bool pre = false;
  const TileMap tmap = tm_init(T / 128, D / 128);
  { const int t0 = tm_tile(tmap, 0); if (t0 >= 0) { make(t0, g); gn = g; } }
  for (int jt = 0; ; ++jt) {
    const int tile = tm_tile(tmap, jt); if (tile < 0) break;
    const int mt = tile >> 3, nt = tile & 7, m0 = mt * 128, n0 = nt * 128, b = m0 / S;
    const int nxt = tm_tile(tmap, jt + 1); const bool hasn = nxt >= 0;
    if (hasn) make(nxt, gn);
    float mids[4], rs[4];
#pragma unroll
    for (int m = 0; m < 4; ++m) {
      const int t = m0 + wr * 64 + 16 * m + fr;
      const f32x4 a0 = *(const f32x4*)(p.ssqa() + (size_t)t * 8), a1 = *(const f32x4*)(p.ssqa() + (size_t)t * 8 + 4);
      const f32x4 s0 = *(const f32x4*)(p.ssqs() + (size_t)t * 8), s1 = *(const f32x4*)(p.ssqs() + (size_t)t * 8 + 4);
      const float sa = ((a0[0] + a0[1]) + (a0[2] + a0[3])) + ((a1[0] + a1[1]) + (a1[2] + a1[3]));
      const float sq = ((s0[0] + s0[1]) + (s0[2] + s0[3])) + ((s1[0] + s1[1]) + (s1[2] + s1[3]));
      const float ra = rsqrtf(sa * (1.f / 512.f) + EPS);
      rs[m] = rsqrtf(sq * (1.f / 512.f) + EPS);
      mids[m] = ra / rs[m];
    }
    f32x4 acc[4][4];
    gemm_mainloop_t<false, true>(g, gn, hasn, pre, smem, acc, 8, mids);
    pre = hasn; g = gn;
#pragma unroll
    for (int m = 0; m < 4; ++m) {
      const int t = m0 + wr * 64 + 16 * m + fr;
#pragma unroll
      for (int n = 0; n < 4; ++n) {
        const int col = n0 + wc * 64 + 16 * n + 4 * fq;
        const float4 xq = load_x4(p, l, (size_t)t * D + col);
        const f32x4 xv = {xq.x, xq.y, xq.z, xq.w};
        const f32x4 g1 = *(const f32x4*)(modl + (size_t)b * 6144 + 2 * 1024 + col);
        f32x4 o;
#pragma unroll
        for (int j = 0; j < 4; ++j) o[j] = xv[j] + g1[j] * (acc[m][n][j] * rs[m]);
        *(u32x2*)(p.x1() + (size_t)t * D + col) = (u32x2){pack2(o[0], o[1]), pack2(o[2], o[3])};
      }
    }
  }
}
__device__ void phase_norm2_route(const MP& p, int l, char* smem) {
  const int tid = launder(threadIdx.x);
  const int wave = tid >> 6, lane = tid & 63;
  float* wrT = (float*)smem;
  for (int i = tid; i < 1024 * 4; i += NTHR) {
    const int k = i >> 2, e4 = (i & 3) * 4;
    const float4 v = *(const float4*)(p.in.w_router + (size_t)k * 16 + e4);
    wrT[(e4 + 0) * 1024 + k] = v.x; wrT[(e4 + 1) * 1024 + k] = v.y; wrT[(e4 + 2) * 1024 + k] = v.z; wrT[(e4 + 3) * 1024 + k] = v.w;
  }
  __syncthreads();
  const float* modl = p.mod() + (size_t)l * 8 * 6144;
  float rb[16];
#pragma unroll
  for (int e = 0; e < 16; ++e) rb[e] = p.in.router_bias[e];
  int* cntl = p.cnt() + l * 256;
  int my_t = -1, my_bucket = 0; float my_wlo = 0.f, my_whi = 0.f;
  const float* g2n = p.in.norm2_g + l * D;
  const int tstep = gridDim.x * 4;
  int t = blockIdx.x * 4 + wave;
  float4 xv[4];
  if (t < T) {
#pragma unroll
    for (int i = 0; i < 4; ++i) { const u32x2 r = *(const u32x2*)(p.x1() + (size_t)t * D + lane * 4 + 256 * i); xv[i] = make_float4(bf_lo(r[0]), bf_hi(r[0]), bf_lo(r[1]), bf_hi(r[1])); }
  }
  for (int slot = 0; t < T; t += tstep, ++slot) {
    const int b = t / S;
    float4 xn[4];
    const int tn = t + tstep < T ? t + tstep : t;
#pragma unroll
    for (int i = 0; i < 4; ++i) { const u32x2 r = *(const u32x2*)(p.x1() + (size_t)tn * D + lane * 4 + 256 * i); xn[i] = make_float4(bf_lo(r[0]), bf_hi(r[0]), bf_lo(r[1]), bf_hi(r[1])); }
    float ss = 0.f;
#pragma unroll
    for (int i = 0; i < 4; ++i) ss += xv[i].x * xv[i].x + xv[i].y * xv[i].y + xv[i].z * xv[i].z + xv[i].w * xv[i].w;
    ss = wave_sum(ss);
    const float rinv = rsqrtf(ss * (1.f / D) + EPS);
    const float* sh = modl + (size_t)b * 6144 + 3 * 1024; const float* sc = modl + (size_t)b * 6144 + 4 * 1024;
    float hv[16];
#pragma unroll
    for (int i = 0; i < 4; ++i) {
      const int d = lane * 4 + 256 * i;
      const float4 gg = *(const float4*)(g2n + d), s1 = *(const float4*)(sc + d), s0 = *(const float4*)(sh + d);
      hv[4 * i + 0] = xv[i].x * rinv * gg.x * (1.f + s1.x) + s0.x;
      hv[4 * i + 1] = xv[i].y * rinv * gg.y * (1.f + s1.y) + s0.y;
      hv[4 * i + 2] = xv[i].z * rinv * gg.z * (1.f + s1.z) + s0.z;
      hv[4 * i + 3] = xv[i].w * rinv * gg.w * (1.f + s1.w) + s0.w;
      *(u32x2*)(p.h() + (size_t)t * D + d) = (u32x2){pack2(hv[4 * i], hv[4 * i + 1]), pack2(hv[4 * i + 2], hv[4 * i + 3])};
    }
    float a[16];
    const int loff = launder(lane * 4);
#pragma unroll
    for (int e = 0; e < 16; ++e) {
      float s = 0.f;
#pragma unroll
      for (int i = 0; i < 4; ++i) {
        const f32x4 w = *(const f32x4*)(wrT + e * 1024 + loff + 256 * i);
        s += hv[4 * i] * w[0] + hv[4 * i + 1] * w[1] + hv[4 * i + 2] * w[2] + hv[4 * i + 3] * w[3];
      }
      a[e] = s;
    }
    float lg[16];
#pragma unroll
    for (int e = 0; e < 16; ++e) lg[e] = wave_sum(a[e]);
    float mx = lg[0];
#pragma unroll
    for (int e = 1; e < 16; ++e) mx = fmaxf(mx, lg[e]);
    float pr[16], sel[16]; float sum = 0.f;
#pragma unroll
    for (int e = 0; e < 16; ++e) { pr[e] = __expf(lg[e] - mx); sum += pr[e]; }
    const float inv = 1.f / sum;
#pragma unroll
    for (int e = 0; e < 16; ++e) { pr[e] *= inv; sel[e] = pr[e] + rb[e]; }
    int gbest = 0; float gbs = -1e30f;
#pragma unroll
    for (int g = 0; g < 4; ++g) {
      float m1 = -1e30f, m2 = -1e30f;
#pragma unroll
      for (int j = 0; j < 4; ++j) { const float v = sel[g * 4 + j]; if (v > m1) { m2 = m1; m1 = v; } else if (v > m2) m2 = v; }
      const float gs = m1 + m2;
      if (gs > gbs) { gbs = gs; gbest = g; }
    }
    float s4[4], p4[4];
#pragma unroll
    for (int j = 0; j < 4; ++j) { s4[j] = sel[j]; p4[j] = pr[j]; }
#pragma unroll
    for (int g = 1; g < 4; ++g) if (g == gbest) {
#pragma unroll
      for (int j = 0; j < 4; ++j) { s4[j] = sel[g * 4 + j]; p4[j] = pr[g * 4 + j]; }
    }
    int i0 = 0; float b0 = s4[0];
#pragma unroll
    for (int j = 1; j < 4; ++j) if (s4[j] > b0) { b0 = s4[j]; i0 = j; }
    int i1 = -1; float bb1 = -1e30f;
#pragma unroll
    for (int j = 0; j < 4; ++j) if (j != i0 && s4[j] > bb1) { bb1 = s4[j]; i1 = j; }
    float p0 = 0.f, p1 = 0.f;
#pragma unroll
    for (int j = 0; j < 4; ++j) { if (j == i0) p0 = p4[j]; if (j == i1) p1 = p4[j]; }
    const float w0 = p0 / (p0 + p1), w1 = p1 / (p0 + p1);
    const int lo = i0 < i1 ? i0 : i1, hi = i0 < i1 ? i1 : i0;
    const float wlo = i0 < i1 ? w0 : w1, whi = i0 < i1 ? w1 : w0;
    const int pidx = (lo == 0) ? (hi - 1) : (lo == 1 ? (hi + 1) : 5);
    const int bucket = gbest * 6 + pidx;
    if (lane == slot) { my_t = t; my_bucket = bucket; my_wlo = wlo; my_whi = whi; }
#pragma unroll
    for (int i = 0; i < 4; ++i) xv[i] = xn[i];
  }
  if (my_t >= 0) {
    const int sl = my_bucket * NSUBL + (blockIdx.x & (NSUBL - 1));
    const int pos = atomicAdd(&cntl[sl], 1);
    p.list()[(size_t)sl * T + pos] = my_t;
    p.tokw()[my_t] = make_float2(my_wlo, my_whi);
  }
  __syncthreads();
}

__device__ __forceinline__ void bucket_experts2(int bucket, int& elo, int& ehi) {
  const int g = bucket / 6, pi = bucket % 6;
  const int lo = pi < 3 ? 0 : (pi < 5 ? 1 : 2);
  const int hi = pi < 3 ? pi + 1 : (pi < 5 ? pi - 1 : 3);
  elo = g * 4 + lo; ehi = g * 4 + hi;
}
__device__ __forceinline__ void moe_map_build(const int* cnt, int* mm, int tid) {
  if (tid < NBUCKET) {
    int acc = 0;
#pragma unroll
    for (int x = 0; x < NSUBL; ++x) { mm[32 + 16 * tid + x] = acc; acc += cnt[tid * NSUBL + x]; }
    mm[32 + 16 * tid + 8] = acc;
  }
  __syncthreads();
  if (tid == 0) {
    int acc = 0;
    for (int bk = 0; bk < NBUCKET; ++bk) { mm[bk] = acc; acc += (mm[32 + 16 * bk + 8] + TM - 1) / TM; }
    mm[NBUCKET] = acc;
  }
  __syncthreads();
}
__device__ __forceinline__ void moe_find_tile(const int* mm, int mt, int& bucket, int& tib, int& nrow) {
  int bk = 0;
#pragma unroll
  for (int j = 1; j < NBUCKET; ++j) bk += (mt >= mm[j]) ? 1 : 0;
  bucket = bk; tib = mt - mm[bk]; nrow = mm[32 + 16 * bk + 8] - tib * TM;
}
__device__ __forceinline__ int moe_token(const int* list, const int* mm, int bk, int q) {
  const int* sp = mm + 32 + 16 * bk;
  int x = 0, s = 0;
#pragma unroll
  for (int j = 1; j < NSUBL; ++j) { const int v = sp[j]; const bool ge = q >= v; x += ge ? 1 : 0; s = ge ? v : s; }
  return list[(size_t)(bk * NSUBL + x) * T + (q - s)];
}

__device__ void phase_moe_gu(const MP& p, int l, char* smem) {
  const int tid = launder(threadIdx.x), lane = tid & 63, wave = tid >> 6, wr = wave >> 1, wc = wave & 1, fr = lane & 15, fq = lane >> 4;
  const int r0 = tid >> 3;
  int* mm = (int*)(smem + SMEM_MM);
  moe_map_build(p.cnt() + l * 256, mm, tid);
  const int nmt = mm[NBUCKET];
  const int ntiles = nmt * 16;
  auto make = [&](int tile, GemmTile& g) {
    const int mt = tile >> 4, nt = tile & 15;
    int bucket, tib, nrow;
    moe_find_tile(mm, mt, bucket, tib, nrow);
    int elo, ehi; bucket_experts2(bucket, elo, ehi);
    const int e = nt < 8 ? elo : ehi, f0 = (nt & 7) * 64;
    g.A0 = p.h(); g.A1 = p.h(); g.lda = D; g.ksA = D; g.K = D;
    const bf16_t* Wg = p.WgT() + ((size_t)(l * NE + e) * DFF + f0) * D;
    const bf16_t* Wu = p.WuT() + ((size_t)(l * NE + e) * DFF + f0) * D;
#pragma unroll
    for (int i = 0; i < 4; ++i) {
      const int r = r0 + 32 * i;
      g.arow[i] = moe_token(p.list(), mm, bucket, tib * TM + (r < nrow ? r : nrow - 1));
    }
    g.Blo0 = Wg; g.Bhi0 = Wu; g.Blo1 = Wg; g.Bhi1 = Wu;
    g.ldb = D; g.ksB = D;
  };
  GemmTile g, gn; bool pre = false;
  const TileMap tmap = tm_init(nmt, 16);
  { const int t0 = tm_tile(tmap, 0); if (t0 >= 0) { make(t0, g); gn = g; } }
  for (int jt = 0; ; ++jt) {
    const int tile = tm_tile(tmap, jt); if (tile < 0) break;
    const int mt = tile >> 4, nt = tile & 15;
    int bucket, tib, nrow;
    moe_find_tile(mm, mt, bucket, tib, nrow);
    const int f0 = (nt & 7) * 64;
    const int nxt = tm_tile(tmap, jt + 1); const bool hasn = nxt >= 0;
    if (hasn) make(nxt, gn);
    float wv[4];
#pragma unroll
    for (int m = 0; m < 4; ++m) {
      const int r = wr * 64 + 16 * m + fr;
      const float2 ww = p.tokw()[moe_token(p.list(), mm, bucket, tib * TM + (r < nrow ? r : nrow - 1))];
      wv[m] = r < nrow ? (nt < 8 ? ww.x : ww.y) : 0.f;
    }
    f32x4 acc[4][4];
    gemm_mainloop<true>(g, gn, hasn, pre, smem, acc);
    pre = hasn; g = gn;
#pragma unroll
    for (int m = 0; m < 4; ++m) {
      const int r = wr * 64 + 16 * m + fr;
      const float w = wv[m];
      bf16_t* dst = p.act() + (size_t)(mt * TM + r) * D + (nt < 8 ? 0 : 512) + f0 + wc * 32 + 4 * fq;
#pragma unroll
      for (int n = 0; n < 2; ++n) {
        float o[4];
#pragma unroll
        for (int j = 0; j < 4; ++j) { const float gv = acc[m][n][j], uv = acc[m][n + 2][j]; o[j] = gv * __builtin_amdgcn_rcpf(1.f + __expf(-gv)) * uv * w; }
        *(u32x2*)(dst + 16 * n) = (u32x2){pack2(o[0], o[1]), pack2(o[2], o[3])};
      }
    }
  }
}

__device__ void phase_moe_down(const MP& p, int l, char* smem) {
  const int tid = launder(threadIdx.x), lane = tid & 63, wave = tid >> 6, wr = wave >> 1, wc = wave & 1, fr = lane & 15, fq = lane >> 4;
  const int r0 = tid >> 3;
  int* mm = (int*)(smem + SMEM_MM);
  moe_map_build(p.cnt() + l * 256, mm, tid);
  const float* modl = p.mod() + (size_t)l * 8 * 6144;
  const int nmt = mm[NBUCKET];
  const int ntiles = nmt * 8;
  auto make = [&](int tile, GemmTile& g) {
    const int mt = tile >> 3, n0 = (tile & 7) * 128;
    int bucket, tib, nrow;
    moe_find_tile(mm, mt, bucket, tib, nrow);
    int elo, ehi; bucket_experts2(bucket, elo, ehi);
    g.A0 = p.act(); g.A1 = p.act(); g.lda = D; g.ksA = D; g.K = D;
    const bf16_t* Wlo = p.WdT() + ((size_t)(l * NE + elo) * D + n0) * DFF;
    const bf16_t* Whi = p.WdT() + ((size_t)(l * NE + ehi) * D + n0) * DFF;
#pragma unroll
    for (int i = 0; i < 4; ++i) {
      g.arow[i] = mt * TM + r0 + 32 * i;
    }
    g.Blo0 = Wlo; g.Bhi0 = Wlo + (size_t)64 * DFF; g.Blo1 = Whi; g.Bhi1 = Whi + (size_t)64 * DFF;
    g.ldb = DFF; g.ksB = DFF;
  };
  GemmTile g, gn; bool pre = false;
  const TileMap tmap = tm_init(nmt, 8);
  { const int t0 = tm_tile(tmap, 0); if (t0 >= 0) { make(t0, g); gn = g; } }
  for (int jt = 0; ; ++jt) {
    const int tile = tm_tile(tmap, jt); if (tile < 0) break;
    const int mt = tile >> 3, nt = tile & 7, n0 = nt * 128;
    int bucket, tib, nrow;
    moe_find_tile(mm, mt, bucket, tib, nrow);
    const int nxt = tm_tile(tmap, jt + 1); const bool hasn = nxt >= 0;
    if (hasn) make(nxt, gn);
    int tkv[4];
#pragma unroll
    for (int m = 0; m < 4; ++m) {
      const int r = wr * 64 + 16 * m + fr;
      tkv[m] = moe_token(p.list(), mm, bucket, tib * TM + (r < nrow ? r : nrow - 1));
    }
    f32x4 acc[4][4];
    gemm_mainloop<false>(g, gn, hasn, pre, smem, acc);
    pre = hasn; g = gn;
#pragma unroll
    for (int m = 0; m < 4; ++m) {
      const int r = wr * 64 + 16 * m + fr;
      const int tk = tkv[m], b = tk / S;
      f32x4 o[4];
#pragma unroll
      for (int n = 0; n < 4; ++n) {
        const int col = n0 + wc * 64 + 16 * n + 4 * fq;
        const u32x2 xr = *(const u32x2*)(p.x1() + (size_t)tk * D + col);
        const f32x4 xv = {bf_lo(xr[0]), bf_hi(xr[0]), bf_lo(xr[1]), bf_hi(xr[1])};
        const f32x4 g2 = *(const f32x4*)(modl + (size_t)b * 6144 + 5 * 1024 + col);
#pragma unroll
        for (int j = 0; j < 4; ++j) o[n][j] = xv[j] + g2[j] * acc[m][n][j];
      }
      if (r < nrow) {
        if (l + 1 < DEPTH) {
#pragma unroll
          for (int n = 0; n < 4; ++n) *(u32x2*)(p.xmid() + (size_t)tk * D + n0 + wc * 64 + 16 * n + 4 * fq) = (u32x2){pack2(o[n][0], o[n][1]), pack2(o[n][2], o[n][3])};
        } else {
#pragma unroll
          for (int n = 0; n < 4; ++n) *(f32x4*)(p.out + (size_t)tk * D + n0 + wc * 64 + 16 * n + 4 * fq) = o[n];
        }
      }
    }
  }
}
#define XB_TMO      128
#define XB_XCNT(j)  (256  + 64 * (j))
#define XB_XSUB(j)  (1280 + 64 * (j))
#define XB_XGEN(j)  (2304 + 64 * (j))
#define XB_TOP      3328
#define XB_TOPGEN   3392
#define XCD_BAR_WORDS 3456
#define XB_SPIN_CAP (1u << 22)
#define LAS __attribute__((address_space(3)))

__device__ __forceinline__ unsigned xb_ld(unsigned* p)              { return __hip_atomic_load(p, __ATOMIC_RELAXED, __HIP_MEMORY_SCOPE_AGENT); }
__device__ __forceinline__ unsigned xb_add(unsigned* p, unsigned v) { return __hip_atomic_fetch_add(p, v, __ATOMIC_RELAXED, __HIP_MEMORY_SCOPE_AGENT); }
__device__ __forceinline__ unsigned xb_xcc_id() { return (unsigned)__builtin_amdgcn_s_getreg((3 << 11) | 20) & 0xFu; }
#define XB_SPIN(cond, bar) do { unsigned _sp = 0; while (cond) { __builtin_amdgcn_s_sleep(1); \
    if ((++_sp & 255u) == 0u) { if (xb_ld(&(bar)[XB_TMO])) break; if (_sp > XB_SPIN_CAP) { atomicAdd(&(bar)[XB_TMO], 1u); break; } } } } while (0)

struct XcdBarrier { unsigned* bar; unsigned x; volatile LAS unsigned* st; };

__device__ __forceinline__ XcdBarrier xcd_barrier_post(unsigned* bar, volatile LAS unsigned* st) {
  XcdBarrier b; b.bar = bar; b.x = xb_xcc_id(); b.st = st;
  if (threadIdx.x == 0) (void)xb_add(&bar[XB_XCNT(b.x)], 1u);
  return b;
}
__device__ __forceinline__ void xcd_barrier_complete(unsigned* bar, unsigned x, unsigned& nloc, unsigned& nx) {
  const unsigned G = gridDim.x * gridDim.y * gridDim.z;
  unsigned sum, cnt, mine, sp = 0u;
  for (;;) {
    sum = 0u; cnt = 0u; mine = 0u;
#pragma unroll
    for (unsigned j = 0; j < 16; ++j) { const unsigned c = xb_ld(&bar[XB_XCNT(j)]); sum += c; cnt += (c > 0u) ? 1u : 0u; mine = (j == x) ? c : mine; }
    if (sum == G) break;
    __builtin_amdgcn_s_sleep(1);
    if ((++sp & 255u) == 0u) { if (xb_ld(&bar[XB_TMO])) break; if (sp > XB_SPIN_CAP) { atomicAdd(&bar[XB_TMO], 1u); break; } }
  }
  nloc = mine > 0u ? mine : 1u; nx = cnt > 0u ? cnt : 1u;
}
__device__ __forceinline__ void xcd_barrier(const XcdBarrier& b) {
  asm volatile("s_waitcnt vmcnt(0)" ::: "memory");
  __syncthreads();
  if (threadIdx.x == 0) {
    unsigned* bar = b.bar;
    __builtin_amdgcn_s_waitcnt(0);
    unsigned nloc = b.st[0], nx = b.st[1];
    if (nloc == 0u) { xcd_barrier_complete(bar, b.x, nloc, nx); b.st[0] = nloc; b.st[1] = nx; }
    const unsigned old = xb_add(&bar[XB_XSUB(b.x)], 1u);
    const unsigned gen = old / nloc;
    if (old + 1u == (gen + 1u) * nloc) {
      __builtin_amdgcn_fence(__ATOMIC_RELEASE, "agent");
      asm volatile("s_waitcnt vmcnt(0)" ::: "memory");
      const unsigned og = xb_add(&bar[XB_TOP], 1u);
      const unsigned tg = og / nx;
      if (og + 1u == (tg + 1u) * nx) xb_add(&bar[XB_TOPGEN], 1u);
      else XB_SPIN(xb_ld(&bar[XB_TOPGEN]) == tg, bar);
      __builtin_amdgcn_fence(__ATOMIC_ACQUIRE, "agent");
      xb_add(&bar[XB_XGEN(b.x)], 1u);
      asm volatile("s_waitcnt vmcnt(0)" ::: "memory");
    } else {
      XB_SPIN(xb_ld(&bar[XB_XGEN(b.x)]) == gen, bar);
      __builtin_amdgcn_fence(__ATOMIC_ACQUIRE, "agent");
      asm volatile("s_waitcnt vmcnt(0)" ::: "memory");
    }
  }
  __syncthreads();
}

constexpr int NSUB = 9;

__global__ void __launch_bounds__(NTHR, 2) mega(MP p) {
  __shared__ __attribute__((aligned(16))) char smem[65536 + 16 + 2048];
  unsigned* xb_words = (unsigned*)(smem + 65536);
  if (threadIdx.x < 4) xb_words[threadIdx.x] = 0u;
  __syncthreads();
  const XcdBarrier xb = xcd_barrier_post(p.bar(), (volatile LAS unsigned*)xb_words);
  if (threadIdx.x == 0) {
    const unsigned key = (xb_xcc_id() << 8) | ((unsigned)__builtin_amdgcn_s_getreg((7 << 11) | (8 << 6) | 4) & 0xffu);
    const unsigned rank = xb_add(p.claim() + key, 1u);
    xb_words[2] = rank == 0u ? xb_add(p.claim() + 4096, 1u) : 0xffffffffu;
  }
  __syncthreads();
  const int ssm_wid = (int)xb_words[2];
  for (int it = blockIdx.x; it < P0_MISC; it += gridDim.x) phase0_item(p, it, smem);
  phase0_transposes(p, smem);
  xcd_barrier(xb);
  for (int l = 0; l < DEPTH; ++l) {
    phase_norm1(p, l);               xcd_barrier(xb);
    phase_inproj(p, l, smem);        xcd_barrier(xb);
    phase_attn(p, l);                xcd_barrier(xb);
    phase_ssm(p, l, smem, ssm_wid);  xcd_barrier(xb);
    phase_glu(p, l, smem);           xcd_barrier(xb);
    phase_out(p, l, smem);           xcd_barrier(xb);
    phase_norm2_route(p, l, smem);   xcd_barrier(xb);
    phase_moe_gu(p, l, smem);        xcd_barrier(xb);
    phase_moe_down(p, l, smem);
    if (l + 1 < DEPTH) xcd_barrier(xb);
  }
}

}

extern "C" void kernel_launch(void* const* d_in, const int* in_sizes, int n_in, void* d_out, int out_size, void* d_ws,
                              size_t ws_size, hipStream_t stream) {
  MP p; memset(&p, 0, sizeof(p));
  Ptrs& P = p.in;
  P.x = (const float*)d_in[0]; P.c = (const float*)d_in[1]; P.pos = (const int*)d_in[2];
  P.ada_w = (const float*)d_in[3]; P.ada_b = (const float*)d_in[4]; P.norm1_g = (const float*)d_in[5];
  P.w_in = (const float*)d_in[6]; P.q_norm_g = (const float*)d_in[7]; P.k_norm_g = (const float*)d_in[8];
  P.attn_sink = (const float*)d_in[9]; P.lam_re = (const float*)d_in[10]; P.lam_im = (const float*)d_in[11];
  P.b_re = (const float*)d_in[12]; P.b_im = (const float*)d_in[13]; P.c_re = (const float*)d_in[14]; P.c_im = (const float*)d_in[15];
  P.ssm_d = (const float*)d_in[16]; P.log_dt = (const float*)d_in[17]; P.w_glu = (const float*)d_in[18];
  P.attn_out_g = (const float*)d_in[19]; P.ssm_out_g = (const float*)d_in[20]; P.w_out = (const float*)d_in[21];
  P.norm2_g = (const float*)d_in[22]; P.w_router = (const float*)d_in[23]; P.router_bias = (const float*)d_in[24];
  P.w_gate = (const float*)d_in[25]; P.w_up = (const float*)d_in[26]; P.w_down = (const float*)d_in[27];
  p.out = (float*)d_out;

  p.ws = (char*)d_ws;
  if (WS_TOTAL > ws_size) { fprintf(stderr, "workspace too small: need %zu have %zu\n", (size_t)WS_TOTAL, ws_size); return; }
  (void)in_sizes; (void)n_in; (void)out_size;

  static int grid_blocks = 0;
  if (!grid_blocks) {
    int dev = 0, cus = 0, per_cu = 0;
    (void)hipGetDevice(&dev);
    (void)hipDeviceGetAttribute(&cus, hipDeviceAttributeMultiprocessorCount, dev);
    (void)hipOccupancyMaxActiveBlocksPerMultiprocessor(&per_cu, mega, NTHR, 0);
    if (per_cu > 2) per_cu = 2;
    if (per_cu < 1) per_cu = 1;
    grid_blocks = cus * per_cu;
  }
  (void)hipMemsetAsync(p.ws + OFF_BAR, 0, OFF_MOD - OFF_BAR, stream);
  void* args[] = {&p};
  hipError_t e = hipLaunchCooperativeKernel((void*)mega, dim3(grid_blocks), dim3(NTHR), args, 0, stream);
  if (e != hipSuccess) fprintf(stderr, "cooperative launch failed: %s (grid %d)\n", hipGetErrorString(e), grid_blocks);
}
```

```cpp
#include <hip/hip_runtime.h>
#include <hip/hip_cooperative_groups.h>
#include <stdint.h>
#include <cstdio>
#include <cstring>

namespace {
constexpr int D = 1024, NB = 8, S = 2048, T = NB * S, DEPTH = 2;
constexpr int AW = 512, HD = 64, NQ = 8, NKV = 2, INW = 1280;
constexpr int SG = 32, SCH = 16, SP = 64, SW = 512;
constexpr int NE = 16, DFF = 512;
constexpr int NBUCKET = 24;
constexpr float EPS = 1e-6f;

struct Ptrs {
  const float *x, *c; const int* pos; const float *ada_w, *ada_b, *norm1_g, *w_in, *q_norm_g, *k_norm_g, *attn_sink,
      *lam_re, *lam_im, *b_re, *b_im, *c_re, *c_im, *ssm_d, *log_dt, *w_glu, *attn_out_g, *ssm_out_g, *w_out, *norm2_g,
      *w_router, *router_bias, *w_gate, *w_up, *w_down;
};

__device__ __forceinline__ float row_sum32_dpp(float v) {
  v += __int_as_float(__builtin_amdgcn_update_dpp(0, __float_as_int(v), 0xB1, 0xF, 0xF, true));
  v += __int_as_float(__builtin_amdgcn_update_dpp(0, __float_as_int(v), 0x4E, 0xF, 0xF, true));
  v += __int_as_float(__builtin_amdgcn_update_dpp(0, __float_as_int(v), 0x141, 0xF, 0xF, true));
  v += __int_as_float(__builtin_amdgcn_update_dpp(0, __float_as_int(v), 0x140, 0xF, 0xF, true));
  v += __int_as_float(__builtin_amdgcn_update_dpp(0, __float_as_int(v), 0x142, 0xA, 0xF, false));
  return v;
}
__device__ __forceinline__ float wave_sum(float v) {
  v = row_sum32_dpp(v);
  return __int_as_float(__builtin_amdgcn_readlane(__float_as_int(v), 31)) + __int_as_float(__builtin_amdgcn_readlane(__float_as_int(v), 63));
}

typedef unsigned short bf16_t;
typedef short bf16x8 __attribute__((ext_vector_type(8)));
typedef float f32x4 __attribute__((ext_vector_type(4)));
typedef float f32x16 __attribute__((ext_vector_type(16)));
typedef float f32x2 __attribute__((ext_vector_type(2)));
typedef __bf16 bf16x2_t __attribute__((ext_vector_type(2)));
typedef unsigned u32x4 __attribute__((ext_vector_type(4)));
typedef unsigned u32x2 __attribute__((ext_vector_type(2)));

constexpr int NTHR = 256;
constexpr int TM = 128;
constexpr int MAXMT = T / TM + NBUCKET;
constexpr int NSUBL = 8;
constexpr int SMEM_MM = 65536 + 16;

__device__ __forceinline__ unsigned pack2(float lo, float hi) {
  f32x2 v = {lo, hi};
  return __builtin_bit_cast(unsigned, __builtin_convertvector(v, bf16x2_t));
}
__device__ __forceinline__ int launder(int x) { asm volatile("" : "+v"(x)); return x; }
__device__ __forceinline__ float bf_lo(unsigned u) { return __uint_as_float(u << 16); }
__device__ __forceinline__ float bf_hi(unsigned u) { return __uint_as_float(u & 0xffff0000u); }
__device__ __forceinline__ float bf1(bf16_t u) { return __uint_as_float(((unsigned)u) << 16); }

constexpr size_t al256(size_t x) { return (x + 255) & ~(size_t)255; }
constexpr size_t OFF_BAR = 0;
constexpr size_t OFF_CLAIM = OFF_BAR + al256(4096 * 4);
constexpr size_t OFF_MOD = OFF_CLAIM + al256(4096 * 4 + 256);
constexpr size_t OFF_CS = OFF_MOD + al256((size_t)DEPTH * 8 * 6144 * 4);
constexpr size_t OFF_CNT = OFF_CS + al256((size_t)T * 32 * 8);
constexpr size_t OFF_LIST = OFF_CNT + al256(256 * 4 * DEPTH);
constexpr size_t OFF_TOKW = OFF_LIST + al256((size_t)NBUCKET * NSUBL * T * 4);
constexpr size_t OFF_SSMB = OFF_TOKW + al256((size_t)T * 8);
constexpr size_t OFF_SSMC = OFF_SSMB + al256((size_t)DEPTH * SG * 128 * 16 * 2);
constexpr size_t OFF_SSML = OFF_SSMC + al256((size_t)DEPTH * SG * 16 * 128 * 2);
constexpr size_t OFF_WINT = OFF_SSML + al256((size_t)DEPTH * SG * SP * 2 * 4);
constexpr size_t OFF_WGLUT = OFF_WINT + al256((size_t)DEPTH * INW * D * 2);
constexpr size_t OFF_WOUTT = OFF_WGLUT + al256((size_t)DEPTH * SW * SW * 2);
constexpr size_t OFF_H = OFF_WOUTT + al256((size_t)DEPTH * D * D * 2);
constexpr size_t OFF_Q = OFF_H + al256((size_t)T * D * 2);
constexpr size_t OFF_K = OFF_Q + al256((size_t)T * AW * 2);
constexpr size_t OFF_VT = OFF_K + al256((size_t)T * 128 * 2);
constexpr size_t OFF_U = OFF_VT + al256((size_t)T * 128 * 2);
constexpr size_t OFF_ATTN = OFF_U + al256((size_t)T * SW * 2);
constexpr size_t OFF_ACT = OFF_Q;
static_assert((size_t)MAXMT * TM * D * 2 <= OFF_ATTN - OFF_Q, "act overlay too small");
constexpr size_t OFF_SSQA = OFF_ATTN + al256((size_t)T * AW * 2);
constexpr size_t OFF_Y = OFF_SSQA + al256((size_t)T * 8 * 4);
constexpr size_t OFF_SSM = OFF_Y + al256((size_t)T * SW * 2);
constexpr size_t OFF_SSQS = OFF_SSM + al256((size_t)T * SW * 2);
constexpr size_t OFF_X1 = OFF_SSQS + al256((size_t)T * 8 * 4);
constexpr size_t OFF_XMID = OFF_X1 + al256((size_t)T * D * 2);
constexpr size_t OFF_WGT = OFF_XMID + al256((size_t)T * D * 2);
constexpr size_t OFF_WUT = OFF_WGT + al256((size_t)DEPTH * NE * DFF * D * 2);
constexpr size_t OFF_WDT = OFF_WUT + al256((size_t)DEPTH * NE * DFF * D * 2);
constexpr size_t WS_TOTAL = OFF_WDT + al256((size_t)DEPTH * NE * DFF * D * 2);

struct MP {
  Ptrs in;
  float* out;
  char* ws;
  __device__ __forceinline__ unsigned* bar() const { return (unsigned*)(ws + OFF_BAR); }
  __device__ __forceinline__ unsigned* claim() const { return (unsigned*)(ws + OFF_CLAIM); }
  __device__ __forceinline__ float* mod() const { return (float*)(ws + OFF_MOD); }
  __device__ __forceinline__ float2* cs() const { return (float2*)(ws + OFF_CS); }
  __device__ __forceinline__ int* cnt() const { return (int*)(ws + OFF_CNT); }
  __device__ __forceinline__ int* list() const { return (int*)(ws + OFF_LIST); }
  __device__ __forceinline__ float2* tokw() const { return (float2*)(ws + OFF_TOKW); }
  __device__ __forceinline__ bf16_t* ssmB() const { return (bf16_t*)(ws + OFF_SSMB); }
  __device__ __forceinline__ bf16_t* ssmC() const { return (bf16_t*)(ws + OFF_SSMC); }
  __device__ __forceinline__ float* ssmL() const { return (float*)(ws + OFF_SSML); }
  __device__ __forceinline__ bf16_t* WinT() const { return (bf16_t*)(ws + OFF_WINT); }
  __device__ __forceinline__ bf16_t* WgluT() const { return (bf16_t*)(ws + OFF_WGLUT); }
  __device__ __forceinline__ bf16_t* WoutT() const { return (bf16_t*)(ws + OFF_WOUTT); }
  __device__ __forceinline__ bf16_t* WgT() const { return (bf16_t*)(ws + OFF_WGT); }
  __device__ __forceinline__ bf16_t* WuT() const { return (bf16_t*)(ws + OFF_WUT); }
  __device__ __forceinline__ bf16_t* WdT() const { return (bf16_t*)(ws + OFF_WDT); }
  __device__ __forceinline__ bf16_t* h() const { return (bf16_t*)(ws + OFF_H); }
  __device__ __forceinline__ bf16_t* q() const { return (bf16_t*)(ws + OFF_Q); }
  __device__ __forceinline__ bf16_t* k() const { return (bf16_t*)(ws + OFF_K); }
  __device__ __forceinline__ bf16_t* vT() const { return (bf16_t*)(ws + OFF_VT); }
  __device__ __forceinline__ bf16_t* u() const { return (bf16_t*)(ws + OFF_U); }
  __device__ __forceinline__ bf16_t* attn() const { return (bf16_t*)(ws + OFF_ATTN); }
  __device__ __forceinline__ bf16_t* y() const { return (bf16_t*)(ws + OFF_Y); }
  __device__ __forceinline__ bf16_t* ssm() const { return (bf16_t*)(ws + OFF_SSM); }
  __device__ __forceinline__ bf16_t* act() const { return (bf16_t*)(ws + OFF_ACT); }
  __device__ __forceinline__ float* ssqa() const { return (float*)(ws + OFF_SSQA); }
  __device__ __forceinline__ float* ssqs() const { return (float*)(ws + OFF_SSQS); }
  __device__ __forceinline__ bf16_t* x1() const { return (bf16_t*)(ws + OFF_X1); }
  __device__ __forceinline__ bf16_t* xmid() const { return (bf16_t*)(ws + OFF_XMID); }
};

constexpr int TT_WIN = 8 * 20, TT_GLU = 4 * 8, TT_OUT = 8 * 16, TT_EXP = 16 * 64;
constexpr int TT_LAYER = TT_WIN + TT_GLU + TT_OUT + 3 * TT_EXP;
constexpr int P0_MOD = DEPTH * 192;
constexpr int P0_TR = DEPTH * TT_LAYER;
constexpr int P0_CS = T * 32 / 256;
constexpr int P0_SSM = DEPTH * SG;
constexpr int P0_MISC = P0_MOD + P0_CS + P0_SSM + 1;

__device__ void phase0_item(const MP& p, int it, char* smem) {
  const int tid = launder(threadIdx.x);
  float* ldsf = (float*)smem;
  if (it < P0_MOD) {
    const int l = it / 192, j0 = (it % 192) * 32;
    float* sc = ldsf;
    float* red = ldsf + 8192;
    for (int i = tid; i < 8192; i += NTHR) { float v = p.in.c[i]; sc[i] = v / (1.f + __expf(-v)); }
    __syncthreads();
    const int kg = tid >> 3, cq = (tid & 7) * 4;
    float acc[8][4];
#pragma unroll
    for (int b = 0; b < 8; ++b)
#pragma unroll
      for (int j = 0; j < 4; ++j) acc[b][j] = 0.f;
    const float* w = p.in.ada_w + (size_t)l * 1024 * 6144 + j0 + cq;
#pragma unroll 8
    for (int kk = 0; kk < 32; ++kk) {
      const int k = kg * 32 + kk;
      const float4 wv = *(const float4*)(w + (size_t)k * 6144);
#pragma unroll
      for (int b = 0; b < 8; ++b) { const float s = sc[b * 1024 + k]; acc[b][0] += s * wv.x; acc[b][1] += s * wv.y; acc[b][2] += s * wv.z; acc[b][3] += s * wv.w; }
    }
#pragma unroll
    for (int b = 0; b < 8; ++b) *(float4*)(red + (kg * 8 + b) * 32 + cq) = make_float4(acc[b][0], acc[b][1], acc[b][2], acc[b][3]);
    __syncthreads();
    {
      const int b = tid >> 5, c = tid & 31;
      float v = 0.f;
#pragma unroll 8
      for (int g = 0; g < 32; ++g) v += red[(g * 8 + b) * 32 + c];
      p.mod()[(size_t)(l * 8 + b) * 6144 + j0 + c] = v + p.in.ada_b[l * 6144 + j0 + c];
    }
    __syncthreads();
    return;
  }
  it -= P0_MOD;
  if (it < P0_CS) {
    const int i = it * 256 + tid, t = i >> 5, f = i & 31;
    const float freq = powf(10000.f, -(float)f / 32.f);
    const float ang = (float)p.in.pos[t] * freq;
    float sn, cn; sincosf(ang, &sn, &cn);
    p.cs()[i] = make_float2(cn, sn);
    return;
  }
  it -= P0_CS;
  if (it < P0_SSM) {
    const int lg = it;
    if (tid < 64) {
      const int pp = tid;
      const float dt = expf(p.in.log_dt[lg]);
      const float lr = p.in.lam_re[lg * SP + pp], li = p.in.lam_im[lg * SP + pp];
      const float mag = expf(lr * dt);
      float sn, cn; sincosf(li * dt, &sn, &cn);
      const float ar = mag * cn, ai = mag * sn;
      const float den = lr * lr + li * li;
      const float fr = ((ar - 1.f) * lr + ai * li) / den, fi = (ai * lr - (ar - 1.f) * li) / den;
      p.ssmL()[(lg * SP + pp) * 2] = ar; p.ssmL()[(lg * SP + pp) * 2 + 1] = ai;
      unsigned wr[8], wi[8];
#pragma unroll
      for (int hh = 0; hh < 8; ++hh) {
        const float br0 = p.in.b_re[((size_t)lg * SP + pp) * SCH + 2 * hh], bi0 = p.in.b_im[((size_t)lg * SP + pp) * SCH + 2 * hh];
        const float br1 = p.in.b_re[((size_t)lg * SP + pp) * SCH + 2 * hh + 1], bi1 = p.in.b_im[((size_t)lg * SP + pp) * SCH + 2 * hh + 1];
        wr[hh] = pack2(fr * br0 - fi * bi0, fr * br1 - fi * bi1);
        wi[hh] = pack2(fr * bi0 + fi * br0, fr * bi1 + fi * br1);
      }
      u32x4* dr = (u32x4*)(p.ssmB() + ((size_t)lg * 128 + pp) * 16);
      u32x4* di = (u32x4*)(p.ssmB() + ((size_t)lg * 128 + 64 + pp) * 16);
      dr[0] = (u32x4){wr[0], wr[1], wr[2], wr[3]}; dr[1] = (u32x4){wr[4], wr[5], wr[6], wr[7]};
      di[0] = (u32x4){wi[0], wi[1], wi[2], wi[3]}; di[1] = (u32x4){wi[4], wi[5], wi[6], wi[7]};
    }
    for (int o = tid; o < 16 * 64; o += NTHR) {
      const int hh = o >> 6, pp = o & 63;
      const float cr = p.in.c_re[(size_t)lg * SCH * SP + o], ci = p.in.c_im[(size_t)lg * SCH * SP + o];
      *(unsigned*)(p.ssmC() + ((size_t)lg * 16 + hh) * 128 + 2 * pp) = pack2(cr, -ci);
    }
    return;
  }
  for (int i = tid; i < 256 * DEPTH; i += NTHR) p.cnt()[i] = 0;
}

struct TrDesc { const float* src; bf16_t* dst; const float* gain; int N, K, k0, n0; };
__device__ __forceinline__ void tr_decode(const MP& p, int it, TrDesc& d) {
  const int l = it / TT_LAYER; int r = it % TT_LAYER;
  d.gain = nullptr;
  if (r < TT_WIN) { d.src = p.in.w_in + (size_t)l * D * INW; d.N = INW; d.dst = p.WinT() + (size_t)l * INW * D; d.K = D; d.k0 = (r / 20) * 128; d.n0 = (r % 20) * 64; return; }
  r -= TT_WIN;
  if (r < TT_GLU) { d.src = p.in.w_glu + (size_t)l * SW * SW; d.N = SW; d.dst = p.WgluT() + (size_t)l * SW * SW; d.K = SW; d.k0 = (r / 8) * 128; d.n0 = (r % 8) * 64; return; }
  r -= TT_GLU;
  if (r < TT_OUT) {
    d.k0 = (r / 16) * 128; d.n0 = (r % 16) * 64;
    d.gain = d.k0 < 512 ? (p.in.attn_out_g + l * AW) : (p.in.ssm_out_g + l * SW - 512);
    d.src = p.in.w_out + (size_t)l * D * D; d.N = D; d.dst = p.WoutT() + (size_t)l * D * D; d.K = D; return; }
  r -= TT_OUT;
  const int kind = r / TT_EXP; r %= TT_EXP;
  const int e = r / 64, tt = r % 64;
  if (kind == 0) { d.src = p.in.w_gate + (size_t)(l * NE + e) * D * DFF; d.N = DFF; d.dst = p.WgT() + (size_t)(l * NE + e) * DFF * D; d.K = D; d.k0 = (tt / 8) * 128; d.n0 = (tt % 8) * 64; return; }
  if (kind == 1) { d.src = p.in.w_up + (size_t)(l * NE + e) * D * DFF; d.N = DFF; d.dst = p.WuT() + (size_t)(l * NE + e) * DFF * D; d.K = D; d.k0 = (tt / 8) * 128; d.n0 = (tt % 8) * 64; return; }
  d.src = p.in.w_down + (size_t)(l * NE + e) * DFF * D; d.N = D; d.dst = p.WdT() + (size_t)(l * NE + e) * D * DFF; d.K = DFF; d.k0 = (tt / 16) * 128; d.n0 = (tt % 16) * 64;
}
__device__ void phase0_transposes(const MP& p, char* smem) {
  const int tid = launder(threadIdx.x);
  float* lds = (float*)smem;
  const int r = tid >> 4, c4 = (tid & 15) * 4;
  const int n = tid >> 2, kq = (tid & 3) * 32;
  TrDesc cur, nxt;
  float4 v[8]; float gg[8];
  auto load = [&](const TrDesc& d) {
#pragma unroll
    for (int i = 0; i < 8; ++i) v[i] = *(const float4*)(d.src + (size_t)(d.k0 + r + 16 * i) * d.N + d.n0 + c4);
    if (d.gain) {
#pragma unroll
      for (int i = 0; i < 8; ++i) gg[i] = d.gain[d.k0 + r + 16 * i];
    } else {
#pragma unroll
      for (int i = 0; i < 8; ++i) gg[i] = 1.f;
    }
  };
  int it = blockIdx.x;
  if (it < P0_TR) { tr_decode(p, it, cur); load(cur); nxt = cur; }
  for (; it < P0_TR; it += gridDim.x) {
#pragma unroll
    for (int i = 0; i < 8; ++i) {
      float* d = lds + (r + 16 * i) * 65 + c4;
      d[0] = v[i].x * gg[i]; d[1] = v[i].y * gg[i]; d[2] = v[i].z * gg[i]; d[3] = v[i].w * gg[i];
    }
    __syncthreads();
    const int nit = it + gridDim.x;
    if (nit < P0_TR) { tr_decode(p, nit, nxt); load(nxt); }
    unsigned w[16];
#pragma unroll
    for (int j = 0; j < 16; ++j) w[j] = pack2(lds[(kq + 2 * j) * 65 + n], lds[(kq + 2 * j + 1) * 65 + n]);
    u32x4* dd = (u32x4*)(cur.dst + (size_t)(cur.n0 + n) * cur.K + cur.k0 + kq);
#pragma unroll
    for (int j = 0; j < 4; ++j) dd[j] = (u32x4){w[4 * j], w[4 * j + 1], w[4 * j + 2], w[4 * j + 3]};
    __syncthreads();
    cur = nxt;
  }
}

template <bool F32IN>
__device__ __forceinline__ float4 load_x4(const MP& p, size_t idx) {
  if (F32IN) return *(const float4*)(p.in.x + idx);
  const u32x2 r = *(const u32x2*)(p.xmid() + idx);
  return make_float4(bf_lo(r[0]), bf_hi(r[0]), bf_lo(r[1]), bf_hi(r[1]));
}
template <bool F32IN>
__device__ void phase_norm1(const MP& p, int l) {
  const int tid = launder(threadIdx.x);
  const int wave = tid >> 6, lane = tid & 63;
  const float* modl = p.mod() + (size_t)l * 8 * 6144;
  const float* g = p.in.norm1_g + l * D;
  for (int t = blockIdx.x * 4 + wave; t < T; t += gridDim.x * 4) {
    const int b = t / S;
    const float* sh = modl + (size_t)b * 6144; const float* sc = sh + 1024;
    float4 v[4]; float ss = 0.f;
#pragma unroll
    for (int i = 0; i < 4; ++i) { v[i] = load_x4<F32IN>(p, (size_t)t * D + lane * 4 + 256 * i); ss += v[i].x * v[i].x + v[i].y * v[i].y + v[i].z * v[i].z + v[i].w * v[i].w; }
    ss = wave_sum(ss);
    const float rinv = rsqrtf(ss * (1.f / D) + EPS);
#pragma unroll
    for (int i = 0; i < 4; ++i) {
      const int d = lane * 4 + 256 * i;
      const float4 gg = *(const float4*)(g + d), s1 = *(const float4*)(sc + d), s0 = *(const float4*)(sh + d);
      const float h0 = v[i].x * rinv * gg.x * (1.f + s1.x) + s0.x, h1 = v[i].y * rinv * gg.y * (1.f + s1.y) + s0.y;
      const float h2 = v[i].z * rinv * gg.z * (1.f + s1.z) + s0.z, h3 = v[i].w * rinv * gg.w * (1.f + s1.w) + s0.w;
      *(u32x2*)(p.h() + (size_t)t * D + d) = (u32x2){pack2(h0, h1), pack2(h2, h3)};
    }
  }
}

struct GemmTile {
  const bf16_t* A0; const bf16_t* A1; long lda; int ksA;
  int arow[4];
  const bf16_t* Blo0; const bf16_t* Bhi0;
  const bf16_t* Blo1; const bf16_t* Bhi1;
  long ldb; int ksB;
  int K;
};

__device__ __forceinline__ int lds_off(int row, int chunk) { return row * 128 + ((chunk ^ ((row >> 1) & 7)) << 4); }

template <bool BSPLIT, bool MID>
__device__ __forceinline__ void gemm_mainloop_t(const GemmTile& g, const GemmTile& gnext, bool hasnext, bool preloaded, char* smem, f32x4 (&acc)[4][4],
                                                int ktmid, const float (&mids)[4]) {
  const int tid = launder(threadIdx.x), lane = tid & 63, wave = tid >> 6, wr = wave >> 1, wc = wave & 1, fr = lane & 15, fq = lane >> 4;
  const int r0 = tid >> 3, c8 = tid & 7;
  const int csrc = (c8 ^ ((r0 >> 1) & 7)) * 8;
#pragma unroll
  for (int m = 0; m < 4; ++m)
#pragma unroll
    for (int n = 0; n < 4; ++n) acc[m][n] = (f32x4){0.f, 0.f, 0.f, 0.f};
  auto stage = [&](const GemmTile& gg, int kt, int buf) {
    const int kk = kt * 64;
    const bf16_t* Ab = kk < gg.ksA ? gg.A0 + kk : gg.A1 + (kk - gg.ksA);
    const bool bs = kk < gg.ksB; const int kb = bs ? kk : kk - gg.ksB;
    char* As = smem + buf * 32768 + tid * 16; char* Bs = As + 16384;
#pragma unroll
    for (int i = 0; i < 4; ++i) {
      __builtin_amdgcn_global_load_lds((const void*)(Ab + (size_t)gg.arow[i] * gg.lda + csrc), (void*)(As + i * 4096), 16, 0, 0);
      const bf16_t* Bb = bs ? (i < 2 ? gg.Blo0 : gg.Bhi0) : (i < 2 ? gg.Blo1 : gg.Bhi1);
      __builtin_amdgcn_global_load_lds((const void*)(Bb + (size_t)(r0 + 32 * (i & 1)) * gg.ldb + kb + csrc), (void*)(Bs + i * 4096), 16, 0, 0);
    }
  };
  const int nk = g.K / 64;
  if (!preloaded) {
    stage(g, 0, 0);
    asm volatile("s_waitcnt vmcnt(0)" ::: "memory");
    __syncthreads();
  }
  for (int kt = 0; kt < nk; ++kt) {
    if (kt + 1 < nk) stage(g, kt + 1, (kt + 1) & 1);
    else if (hasnext) stage(gnext, 0, 0);
    if (MID && kt == ktmid) {
#pragma unroll
      for (int m = 0; m < 4; ++m)
#pragma unroll
        for (int n = 0; n < 4; ++n) acc[m][n] *= mids[m];
    }
    const char* As = smem + (kt & 1) * 32768; const char* Bs = As + 16384;
    {
      bf16x8 af[2][4], bfr[2][4];
#pragma unroll
      for (int ks = 0; ks < 2; ++ks) {
#pragma unroll
        for (int m = 0; m < 4; ++m) af[ks][m] = *(const bf16x8*)(As + lds_off(wr * 64 + 16 * m + fr, ks * 4 + fq));
#pragma unroll
        for (int n = 0; n < 4; ++n) {
          const int brow = BSPLIT ? ((n >> 1) * 64 + wc * 32 + (n & 1) * 16 + fr) : (wc * 64 + 16 * n + fr);
          bfr[ks][n] = *(const bf16x8*)(Bs + lds_off(brow, ks * 4 + fq));
        }
      }
#pragma unroll
      for (int ks = 0; ks < 2; ++ks)
#pragma unroll
        for (int m = 0; m < 4; ++m)
#pragma unroll
          for (int n = 0; n < 4; ++n) acc[m][n] = __builtin_amdgcn_mfma_f32_16x16x32_bf16(bfr[ks][n], af[ks][m], acc[m][n], 0, 0, 0);
      __builtin_amdgcn_sched_group_barrier(0x100, 8, 0);
#pragma unroll
      for (int i = 0; i < 8; ++i) { __builtin_amdgcn_sched_group_barrier(0x008, 2, 0); __builtin_amdgcn_sched_group_barrier(0x100, 1, 0); }
      __builtin_amdgcn_sched_group_barrier(0x008, 16, 0);
    }
    __builtin_amdgcn_sched_barrier(0);
    asm volatile("s_waitcnt vmcnt(0)" ::: "memory");
    __syncthreads();
  }
}
template <bool BSPLIT>
__device__ __forceinline__ void gemm_mainloop(const GemmTile& g, const GemmTile& gnext, bool hasnext, bool preloaded, char* smem, f32x4 (&acc)[4][4]) {
  const float dummy[4] = {1.f, 1.f, 1.f, 1.f};
  gemm_mainloop_t<BSPLIT, false>(g, gnext, hasnext, preloaded, smem, acc, -1, dummy);
}

struct TileMap { int base, ntl, lb, nlb; };
__device__ __forceinline__ TileMap tm_init(int nMt, int nNt) {
  TileMap t;
  if ((gridDim.x & 7) == 0) {
    const int xcd = blockIdx.x & 7;
    t.lb = blockIdx.x >> 3; t.nlb = gridDim.x >> 3;
    const int mlo = (nMt * xcd) >> 3, mhi = (nMt * (xcd + 1)) >> 3;
    t.base = mlo * nNt; t.ntl = (mhi - mlo) * nNt;
  } else { t.lb = blockIdx.x; t.nlb = gridDim.x; t.base = 0; t.ntl = nMt * nNt; }
  return t;
}
__device__ __forceinline__ int tm_tile(const TileMap& t, int j) { const int li = t.lb + t.nlb * j; return li < t.ntl ? t.base + li : -1; }
__device__ void phase_inproj(const MP& p, int l, char* smem) {
  const int tid = launder(threadIdx.x), lane = tid & 63, wave = tid >> 6, wr = wave >> 1, wc = wave & 1, fr = lane & 15, fq = lane >> 4;
  const int r0 = tid >> 3;
  const int ntiles = (T / 128) * (INW / 128);
  const bf16_t* W = p.WinT() + (size_t)l * INW * D;
  auto make = [&](int tile, GemmTile& g) {
    const int m0 = (tile / 10) * 128, n0 = (tile % 10) * 128;
    g.A0 = p.h(); g.A1 = p.h(); g.lda = D; g.ksA = D; g.K = D;
#pragma unroll
    for (int i = 0; i < 4; ++i) g.arow[i] = m0 + r0 + 32 * i;
    g.Blo0 = W + (size_t)n0 * D; g.Bhi0 = g.Blo0 + (size_t)64 * D; g.Blo1 = g.Blo0; g.Bhi1 = g.Bhi0;
    g.ldb = D; g.ksB = D;
  };
  GemmTile g, gn; bool pre = false;
  const TileMap tmap = tm_init(T / 128, INW / 128);
  { const int t0 = tm_tile(tmap, 0); if (t0 >= 0) { make(t0, g); gn = g; } }
  for (int jt = 0; ; ++jt) {
    const int tile = tm_tile(tmap, jt); if (tile < 0) break;
    const int mt = tile / 10, nt = tile % 10, m0 = mt * 128;
    const int nxt = tm_tile(tmap, jt + 1); const bool hasn = nxt >= 0;
    if (hasn) make(nxt, gn);
    f32x4 acc[4][4];
    gemm_mainloop<false>(g, gn, hasn, pre, smem, acc);
    pre = hasn; g = gn;
    const int rowb = m0 + wr * 64 + fr;
    if (nt <= 4) {
      const float* gv = (nt < 4 ? p.in.q_norm_g : p.in.k_norm_g) + l * HD;
      const float scl = nt < 4 ? 0.125f : 1.f;
      f32x4 g1[2], g2[2];
#pragma unroll
      for (int n = 0; n < 2; ++n) { g1[n] = *(const f32x4*)(gv + 16 * n + 4 * fq); g2[n] = *(const f32x4*)(gv + 32 + 16 * n + 4 * fq); }
#pragma unroll
      for (int m = 0; m < 4; ++m) {
        const int t = rowb + 16 * m;
        float ss = 0.f;
#pragma unroll
        for (int n = 0; n < 4; ++n)
#pragma unroll
          for (int j = 0; j < 4; ++j) ss += acc[m][n][j] * acc[m][n][j];
        ss += __shfl_xor(ss, 16); ss += __shfl_xor(ss, 32);
        const float rinv = rsqrtf(ss * (1.f / 64.f) + EPS) * scl;
        bf16_t* dst = nt < 4 ? (p.q() + (size_t)t * AW + (2 * nt + wc) * 64) : (p.k() + (size_t)t * 128 + wc * 64);
#pragma unroll
        for (int n = 0; n < 2; ++n) {
          const int c = 16 * n + 4 * fq;
          const f32x4 csa = *(const f32x4*)((const float*)p.cs() + ((size_t)t * 32 + c) * 2);
          const f32x4 csb = *(const f32x4*)((const float*)p.cs() + ((size_t)t * 32 + c + 2) * 2);
          const float cn[4] = {csa[0], csa[2], csb[0], csb[2]}, sn[4] = {csa[1], csa[3], csb[1], csb[3]};
          float o1[4], o2[4];
#pragma unroll
          for (int j = 0; j < 4; ++j) {
            const float x1 = acc[m][n][j] * rinv * g1[n][j], x2 = acc[m][n + 2][j] * rinv * g2[n][j];
            o1[j] = x1 * cn[j] - x2 * sn[j]; o2[j] = x2 * cn[j] + x1 * sn[j];
          }
          *(u32x2*)(dst + c) = (u32x2){pack2(o1[0], o1[1]), pack2(o1[2], o1[3])};
          *(u32x2*)(dst + 32 + c) = (u32x2){pack2(o2[0], o2[1]), pack2(o2[2], o2[3])};
        }
      }
    } else if (nt == 5) {
      const int b = m0 / S;
#pragma unroll
      for (int m = 0; m < 4; ++m) {
        const int s = (rowb + 16 * m) % S;
        const int k16 = s & 15;
        const int sp = (s & ~15) | (k16 & 3) | (((k16 >> 3) & 1) << 2) | (((k16 >> 2) & 1) << 3);
#pragma unroll
        for (int n = 0; n < 4; ++n)
#pragma unroll
          for (int j = 0; j < 4; ++j) {
            const int d = 16 * n + 4 * fq + j;
            p.vT()[((size_t)(b * 2 + wc) * 64 + d) * S + sp] = (bf16_t)(pack2(acc[m][n][j], 0.f) & 0xffffu);
          }
      }
    } else {
#pragma unroll
      for (int m = 0; m < 4; ++m) {
        const int t = rowb + 16 * m;
#pragma unroll
        for (int n = 0; n < 4; ++n)
          *(u32x2*)(p.u() + (size_t)t * SW + (nt - 6) * 128 + wc * 64 + 16 * n + 4 * fq) = (u32x2){pack2(acc[m][n][0], acc[m][n][1]), pack2(acc[m][n][2], acc[m][n][3])};
      }
    }
  }
}

__device__ __forceinline__ int crow32(int r, int hf) { return (r & 3) + 8 * (r >> 2) + 4 * hf; }
__device__ void attn_task(const MP& p, int l, int task, int lane) {
  lane = launder(lane);
  task = __builtin_amdgcn_readfirstlane(task);
  const int h = task & 7, qt = (task >> 3) & 63, b = task >> 9, kvh = h >> 2;
  const int s0 = qt * 32, t0 = b * S + s0, ql = lane & 31, hf = lane >> 5;
  int kst[5];
#pragma unroll
  for (int kt = 0; kt < 5; ++kt) { const int ks = s0 - 128 + 32 * kt; kst[kt] = ks < 0 ? 0 : ks; }
  bf16x8 qf[4], kf[5][4];
#pragma unroll
  for (int st = 0; st < 4; ++st) qf[st] = *(const bf16x8*)(p.q() + (size_t)(t0 + ql) * AW + h * 64 + 16 * st + 8 * hf);
#pragma unroll
  for (int kt = 0; kt < 5; ++kt)
#pragma unroll
    for (int st = 0; st < 4; ++st) kf[kt][st] = *(const bf16x8*)(p.k() + (size_t)(b * S + kst[kt] + ql) * 128 + kvh * 64 + 8 * hf + 16 * st);
  f32x16 sc[5];
#pragma unroll
  for (int kt = 0; kt < 5; ++kt) {
#pragma unroll
    for (int r = 0; r < 16; ++r) sc[kt][r] = 0.f;
#pragma unroll
    for (int st = 0; st < 4; ++st) sc[kt] = __builtin_amdgcn_mfma_f32_32x32x16_bf16(kf[kt][st], qf[st], sc[kt], 0, 0, 0);
  }
  bf16x8 vb[5][2][2];
#pragma unroll
  for (int kt = 0; kt < 5; ++kt)
#pragma unroll
    for (int s = 0; s < 2; ++s)
#pragma unroll
      for (int dt = 0; dt < 2; ++dt)
        vb[kt][s][dt] = *(const bf16x8*)(p.vT() + ((size_t)(b * 2 + kvh) * 64 + 32 * dt + ql) * S + kst[kt] + 16 * s + 8 * hf);
  const float sink = p.in.attn_sink[l * NQ + h];
  float mx = sink;
#pragma unroll
  for (int kt = 0; kt < 5; ++kt) {
#pragma unroll
    for (int r = 0; r < 16; ++r) {
      const int kp = s0 - 128 + 32 * kt + crow32(r, hf);
      const int dk = kp - (s0 + ql);
      const bool valid = kp >= 0 && dk <= 0 && dk > -128;
      sc[kt][r] = valid ? sc[kt][r] : -1e30f;
      mx = fmaxf(mx, sc[kt][r]);
    }
  }
  mx = fmaxf(mx, __shfl_xor(mx, 32));
  float lsum = 0.f;
#pragma unroll
  for (int kt = 0; kt < 5; ++kt) {
#pragma unroll
    for (int r = 0; r < 16; ++r) { const float e = __expf(sc[kt][r] - mx); sc[kt][r] = e; lsum += e; }
  }
  lsum += __shfl_xor(lsum, 32);
  lsum += __expf(sink - mx);
  const float inv = 1.f / lsum;
  f32x16 o[2];
#pragma unroll
  for (int r = 0; r < 16; ++r) { o[0][r] = 0.f; o[1][r] = 0.f; }
#pragma unroll
  for (int kt = 0; kt < 5; ++kt) {
#pragma unroll
    for (int s = 0; s < 2; ++s) {
      u32x4 pw;
#pragma unroll
      for (int j = 0; j < 4; ++j) pw[j] = pack2(sc[kt][8 * s + 2 * j] * inv, sc[kt][8 * s + 2 * j + 1] * inv);
      const bf16x8 pa = __builtin_bit_cast(bf16x8, pw);
#pragma unroll
      for (int dt = 0; dt < 2; ++dt) o[dt] = __builtin_amdgcn_mfma_f32_32x32x16_bf16(pa, vb[kt][s][dt], o[dt], 0, 0, 0);
    }
  }
#pragma unroll
  for (int r = 0; r < 16; ++r) {
    const int t = t0 + crow32(r, hf);
    bf16_t* dst = p.attn() + (size_t)t * AW + h * 64 + ql;
    const unsigned w = pack2(o[0][r], o[1][r]);
    dst[0] = (bf16_t)(w & 0xffffu); dst[32] = (bf16_t)(w >> 16);
    float v = o[0][r] * o[0][r] + o[1][r] * o[1][r];
    v = row_sum32_dpp(v);
    if (ql == 31) p.ssqa()[(size_t)t * 8 + h] = v;
  }
}
constexpr int SSEG = 4, SEGLEN = S / SSEG, SEGCH = SEGLEN / 32;

__device__ __forceinline__ void ssm_bu(const bf16x8& ua, const bf16x8 (&bB)[4], f32x16 (&bu)[4]) {
#pragma unroll
  for (int nt = 0; nt < 4; ++nt) {
#pragma unroll
    for (int r = 0; r < 16; ++r) bu[nt][r] = 0.f;
    bu[nt] = __builtin_amdgcn_mfma_f32_32x32x16_bf16(ua, bB[nt], bu[nt], 0, 0, 0);
  }
  asm volatile("s_nop 15\n\ts_nop 7" : "+v"(bu[0]), "+v"(bu[1]), "+v"(bu[2]), "+v"(bu[3]));
#pragma unroll
  for (int r = 0; r < 16; ++r) {
    auto s0 = __builtin_amdgcn_permlane32_swap(__float_as_uint(bu[0][r]), __float_as_uint(bu[1][r]), false, false);
    bu[0][r] = __uint_as_float(s0[0]); bu[1][r] = __uint_as_float(s0[1]);
    auto s1 = __builtin_amdgcn_permlane32_swap(__float_as_uint(bu[2][r]), __float_as_uint(bu[3][r]), false, false);
    bu[2][r] = __uint_as_float(s1[0]); bu[3][r] = __uint_as_float(s1[1]);
  }
}

__device__ void ssm_block(const MP& p, int l, int b, int g, int tid, char* smem) {
  const int lane = tid & 63, seg = tid >> 6;
  char* wl = smem + seg * 8192;
  float* fin = (float*)(smem + 4 * 8192);
  const int lg = l * SG + g, hf = lane >> 5, fr = lane & 15, fq = lane >> 4;
  const float ar = p.ssmL()[(lg * SP + lane) * 2], ai = p.ssmL()[(lg * SP + lane) * 2 + 1];
  bf16x8 bB[4], cB[4];
#pragma unroll
  for (int nt = 0; nt < 4; ++nt) bB[nt] = *(const bf16x8*)(p.ssmB() + ((size_t)lg * 128 + nt * 32 + (lane & 31)) * 16 + 8 * hf);
#pragma unroll
  for (int ks = 0; ks < 4; ++ks) cB[ks] = *(const bf16x8*)(p.ssmC() + ((size_t)lg * 16 + fr) * 128 + 32 * ks + 8 * fq);
  const float dsk = p.in.ssm_d[l * SW + g * 16 + fr];
  const int t0 = b * S + seg * SEGLEN;
  const bf16_t* urow = p.u() + (size_t)(t0 + (lane & 31)) * SW + g * 16 + 8 * hf;
  float xr = 0.f, xi = 0.f;
  if (seg < SSEG - 1) {
    bf16x8 ua = *(const bf16x8*)(urow);
    for (int c = 0; c < SEGCH; ++c) {
      const bf16x8 un = *(const bf16x8*)(urow + (size_t)((c + 1 < SEGCH ? c + 1 : c) * 32) * SW);
      f32x16 bu[4];
      ssm_bu(ua, bB, bu);
#pragma unroll
      for (int r4 = 0; r4 < 4; ++r4)
#pragma unroll
        for (int half = 0; half < 2; ++half)
#pragma unroll
          for (int j = 0; j < 4; ++j) {
            const int r = 4 * r4 + j;
            const float bre = half ? bu[1][r] : bu[0][r], bim = half ? bu[3][r] : bu[2][r];
            const float nr = ar * xr - ai * xi + bre, ni = ar * xi + ai * xr + bim;
            xr = nr; xi = ni;
          }
      ua = un;
    }
  }
  fin[(seg * 64 + lane) * 2] = xr; fin[(seg * 64 + lane) * 2 + 1] = xi;
  __syncthreads();
  {
    float pr = ar, pi = ai;
#pragma unroll
    for (int i = 0; i < 9; ++i) { const float nr = pr * pr - pi * pi, ni = 2.f * pr * pi; pr = nr; pi = ni; }
    static_assert(SEGLEN == 512, "lam^SEGLEN squaring count");
    float cr = 0.f, ci = 0.f;
    for (int j = 0; j < seg; ++j) {
      const float fr_ = fin[(j * 64 + lane) * 2], fi_ = fin[(j * 64 + lane) * 2 + 1];
      const float nr = pr * cr - pi * ci + fr_, ni = pr * ci + pi * cr + fi_;
      cr = nr; ci = ni;
    }
    xr = cr; xi = ci;
  }
  const int wbase = (lane & 3) * 4;
  const int pch = lane >> 2;
  const bf16_t* uep = p.u() + (size_t)(t0 + 4 * fq) * SW + g * 16 + fr;
  bf16x8 ua = *(const bf16x8*)(urow);
  bf16_t uraw[8];
#pragma unroll
  for (int i = 0; i < 8; ++i) uraw[i] = uep[(size_t)(16 * (i >> 2) + (i & 3)) * SW];
  for (int c = 0; c < SEGCH; ++c) {
    const int tb = t0 + c * 32;
    const int cn = (c + 1 < SEGCH ? c + 1 : c) * 32;
    const bf16x8 un = *(const bf16x8*)(urow + (size_t)cn * SW);
    bf16_t unraw[8];
#pragma unroll
    for (int i = 0; i < 8; ++i) unraw[i] = uep[(size_t)(cn + 16 * (i >> 2) + (i & 3)) * SW];
    f32x16 bu[4];
    ssm_bu(ua, bB, bu);
#pragma unroll
    for (int r4 = 0; r4 < 4; ++r4) {
#pragma unroll
      for (int half = 0; half < 2; ++half) {
#pragma unroll
        for (int j = 0; j < 4; ++j) {
          const int t = 8 * r4 + 4 * half + j, r = 4 * r4 + j;
          const float bre = half ? bu[1][r] : bu[0][r], bim = half ? bu[3][r] : bu[2][r];
          const float nr = ar * xr - ai * xi + bre, ni = ar * xi + ai * xr + bim;
          xr = nr; xi = ni;
          *(unsigned*)(wl + t * 256 + ((pch ^ (t & 15)) << 4) + wbase) = pack2(nr, ni);
        }
      }
    }
    asm volatile("s_waitcnt lgkmcnt(0)" ::: "memory");
#pragma unroll
    for (int mt = 0; mt < 2; ++mt) {
      f32x4 acc = {0.f, 0.f, 0.f, 0.f};
      const int t = 16 * mt + fr;
#pragma unroll
      for (int ks = 0; ks < 4; ++ks) {
        const bf16x8 af = *(const bf16x8*)(wl + t * 256 + (((4 * ks + fq) ^ (t & 15)) << 4));
        acc = __builtin_amdgcn_mfma_f32_16x16x32_bf16(af, cB[ks], acc, 0, 0, 0);
      }
#pragma unroll
      for (int j = 0; j < 4; ++j) {
        const int tt = tb + 16 * mt + 4 * fq + j;
        const float uu = bf1(uraw[4 * mt + j]);
        const float v = acc[j] + dsk * uu;
        const float z2 = 1.5957691216057308f * (v + 0.044715f * v * v * v);
        const float ge = v * __builtin_amdgcn_rcpf(1.f + __expf(-z2));
        p.y()[(size_t)tt * SW + g * 16 + fr] = (bf16_t)(pack2(ge, 0.f) & 0xffffu);
      }
    }
    asm volatile("s_waitcnt lgkmcnt(0)" ::: "memory");
    ua = un;
#pragma unroll
    for (int i = 0; i < 8; ++i) uraw[i] = unraw[i];
  }
}

__device__ void phase_attn(const MP& p, int l) {
  const int tid = launder(threadIdx.x);
  const int wave = tid >> 6, lane = tid & 63;
  for (int task = blockIdx.x * 4 + wave; task < NB * 64 * 8; task += gridDim.x * 4) attn_task(p, l, task, lane);
}
__device__ void phase_ssm(const MP& p, int l, char* smem, int wid) {
  const int tid = launder(threadIdx.x);
  if (wid < 0) return;
  const int nw = (int)__hip_atomic_load(p.claim() + 4096, __ATOMIC_RELAXED, __HIP_MEMORY_SCOPE_AGENT);
  for (int task = wid; task < NB * SG; task += nw) {
    ssm_block(p, l, task / SG, task % SG, tid, smem);
    __syncthreads();
  }
}
__device__ void phase_glu(const MP& p, int l, char* smem) {
  const int tid = launder(threadIdx.x), lane = tid & 63, wave = tid >> 6, wr = wave >> 1, wc = wave & 1, fr = lane & 15, fq = lane >> 4;
  const int r0 = tid >> 3;
  const int ntiles = (T / 128) * (SW / 128);
  const bf16_t* W = p.WgluT() + (size_t)l * SW * SW;
  auto make = [&](int tile, GemmTile& g) {
    const int m0 = (tile >> 2) * 128, n0 = (tile & 3) * 128;
    g.A0 = p.y(); g.A1 = p.y(); g.lda = SW; g.ksA = SW; g.K = SW;
#pragma unroll
    for (int i = 0; i < 4; ++i) g.arow[i] = m0 + r0 + 32 * i;
    g.Blo0 = W + (size_t)n0 * SW; g.Bhi0 = g.Blo0 + (size_t)64 * SW; g.Blo1 = g.Blo0; g.Bhi1 = g.Bhi0;
    g.ldb = SW; g.ksB = SW;
  };
  GemmTile g, gn; bool pre = false;
  const TileMap tmap = tm_init(T / 128, SW / 128);
  { const int t0 = tm_tile(tmap, 0); if (t0 >= 0) { make(t0, g); gn = g; } }
  for (int jt = 0; ; ++jt) {
    const int tile = tm_tile(tmap, jt); if (tile < 0) break;
    const int mt = tile >> 2, nt = tile & 3, m0 = mt * 128, n0 = nt * 128;
    const int nxt = tm_tile(tmap, jt + 1); const bool hasn = nxt >= 0;
    if (hasn) make(nxt, gn);
    f32x4 acc[4][4];
    gemm_mainloop<false>(g, gn, hasn, pre, smem, acc);
    pre = hasn; g = gn;
#pragma unroll
    for (int m = 0; m < 4; ++m) {
      const int t = m0 + wr * 64 + 16 * m + fr;
      float ss = 0.f;
#pragma unroll
      for (int n = 0; n < 4; ++n) {
        const int col = n0 + wc * 64 + 16 * n + 4 * fq;
        const u32x2 yr = *(const u32x2*)(p.y() + (size_t)t * SW + col);
        const float yv[4] = {bf_lo(yr[0]), bf_hi(yr[0]), bf_lo(yr[1]), bf_hi(yr[1])};
        float o[4];
#pragma unroll
        for (int j = 0; j < 4; ++j) { o[j] = yv[j] * __builtin_amdgcn_rcpf(1.f + __expf(-acc[m][n][j])); ss += o[j] * o[j]; }
        *(u32x2*)(p.ssm() + (size_t)t * SW + col) = (u32x2){pack2(o[0], o[1]), pack2(o[2], o[3])};
      }
      ss += __shfl_xor(ss, 16); ss += __shfl_xor(ss, 32);
      if (fq == 0) p.ssqs()[(size_t)t * 8 + nt * 2 + wc] = ss;
    }
  }
}

template <bool F32IN>
__device__ void phase_out(const MP& p, int l, char* smem) {
  const int tid = launder(threadIdx.x), lane = tid & 63, wave = tid >> 6, wr = wave >> 1, wc = wave & 1, fr = lane & 15, fq = lane >> 4;
  const int r0 = tid >> 3;
  const float* modl = p.mod() + (size_t)l * 8 * 6144;
  const int ntiles = (T / 128) * (D / 128);
  const bf16_t* W = p.WoutT() + (size_t)l * D * D;
  auto make = [&](int tile, GemmTile& g) {
    const int m0 = (tile >> 3) * 128, n0 = (tile & 7) * 128;
    g.A0 = p.attn(); g.A1 = p.ssm(); g.lda = AW; g.ksA = AW; g.K = D;
#pragma unroll
    for (int i = 0; i < 4; ++i) g.arow[i] = m0 + r0 + 32 * i;
    g.Blo0 = W + (size_t)n0 * D; g.Bhi0 = g.Blo0 + (size_t)64 * D; g.Blo1 = g.Blo0; g.Bhi1 = g.Bhi0;
    g.ldb = D; g.ksB = D;
  };
  GemmTile g, gn; bool pre = false;
  const TileMap tmap = tm_init(T / 128, D / 128);
  { const int t0 = tm_tile(tmap, 0); if (t0 >= 0) { make(t0, g); gn = g; } }
  for (int jt = 0; ; ++jt) {
    const int tile = tm_tile(tmap, jt); if (tile < 0) break;
    const int mt = tile >> 3, nt = tile & 7, m0 = mt * 128, n0 = nt * 128, b = m0 / S;
    const int nxt = tm_tile(tmap, jt + 1); const bool hasn = nxt >= 0;
    if (hasn) make(nxt, gn);
    float mids[4], rs[4];
#pragma unroll
    for (int m = 0; m < 4; ++m) {
      const int t = m0 + wr * 64 + 16 * m + fr;
      const f32x4 a0 = *(const f32x4*)(p.ssqa() + (size_t)t * 8), a1 = *(const f32x4*)(p.ssqa() + (size_t)t * 8 + 4);
      const f32x4 s0 = *(const f32x4*)(p.ssqs() + (size_t)t * 8), s1 = *(const f32x4*)(p.ssqs() + (size_t)t * 8 + 4);
      const float sa = ((a0[0] + a0[1]) + (a0[2] + a0[3])) + ((a1[0] + a1[1]) + (a1[2] + a1[3]));
      const float sq = ((s0[0] + s0[1]) + (s0[2] + s0[3])) + ((s1[0] + s1[1]) + (s1[2] + s1[3]));
      const float ra = rsqrtf(sa * (1.f / 512.f) + EPS);
      rs[m] = rsqrtf(sq * (1.f / 512.f) + EPS);
      mids[m] = ra / rs[m];
    }
    f32x4 acc[4][4];
    gemm_mainloop_t<false, true>(g, gn, hasn, pre, smem, acc, 8, mids);
    pre = hasn; g = gn;
#pragma unroll
    for (int m = 0; m < 4; ++m) {
      const int t = m0 + wr * 64 + 16 * m + fr;
#pragma unroll
      for (int n = 0; n < 4; ++n) {
        const int col = n0 + wc * 64 + 16 * n + 4 * fq;
        const float4 xq = load_x4<F32IN>(p, (size_t)t * D + col);
        const f32x4 xv = {xq.x, xq.y, xq.z, xq.w};
        const f32x4 g1 = *(const f32x4*)(modl + (size_t)b * 6144 + 2 * 1024 + col);
        f32x4 o;
#pragma unroll
        for (int j = 0; j < 4; ++j) o[j] = xv[j] + g1[j] * (acc[m][n][j] * rs[m]);
        *(u32x2*)(p.x1() + (size_t)t * D + col) = (u32x2){pack2(o[0], o[1]), pack2(o[2], o[3])};
      }
    }
  }
}
__device__ void phase_norm2_route(const MP& p, int l, char* smem) {
  const int tid = launder(threadIdx.x);
  const int wave = tid >> 6, lane = tid & 63;
  float* wrT = (float*)smem;
  for (int i = tid; i < 1024 * 4; i += NTHR) {
    const int k = i >> 2, e4 = (i & 3) * 4;
    const float4 v = *(const float4*)(p.in.w_router + (size_t)k * 16 + e4);
    wrT[(e4 + 0) * 1024 + k] = v.x; wrT[(e4 + 1) * 1024 + k] = v.y; wrT[(e4 + 2) * 1024 + k] = v.z; wrT[(e4 + 3) * 1024 + k] = v.w;
  }
  __syncthreads();
  const float* modl = p.mod() + (size_t)l * 8 * 6144;
  float rb[16];
#pragma unroll
  for (int e = 0; e < 16; ++e) rb[e] = p.in.router_bias[e];
  int* cntl = p.cnt() + l * 256;
  int my_t = -1, my_bucket = 0; float my_wlo = 0.f, my_whi = 0.f;
  const float* g2n = p.in.norm2_g + l * D;
  const int tstep = gridDim.x * 4;
  int t = blockIdx.x * 4 + wave;
  float4 xv[4];
  if (t < T) {
#pragma unroll
    for (int i = 0; i < 4; ++i) { const u32x2 r = *(const u32x2*)(p.x1() + (size_t)t * D + lane * 4 + 256 * i); xv[i] = make_float4(bf_lo(r[0]), bf_hi(r[0]), bf_lo(r[1]), bf_hi(r[1])); }
  }
  for (int slot = 0; t < T; t += tstep, ++slot) {
    const int b = t / S;
    float4 xn[4];
    const int tn = t + tstep < T ? t + tstep : t;
#pragma unroll
    for (int i = 0; i < 4; ++i) { const u32x2 r = *(const u32x2*)(p.x1() + (size_t)tn * D + lane * 4 + 256 * i); xn[i] = make_float4(bf_lo(r[0]), bf_hi(r[0]), bf_lo(r[1]), bf_hi(r[1])); }
    float ss = 0.f;
#pragma unroll
    for (int i = 0; i < 4; ++i) ss += xv[i].x * xv[i].x + xv[i].y * xv[i].y + xv[i].z * xv[i].z + xv[i].w * xv[i].w;
    ss = wave_sum(ss);
    const float rinv = rsqrtf(ss * (1.f / D) + EPS);
    const float* sh = modl + (size_t)b * 6144 + 3 * 1024; const float* sc = modl + (size_t)b * 6144 + 4 * 1024;
    float hv[16];
#pragma unroll
    for (int i = 0; i < 4; ++i) {
      const int d = lane * 4 + 256 * i;
      const float4 gg = *(const float4*)(g2n + d), s1 = *(const float4*)(sc + d), s0 = *(const float4*)(sh + d);
      hv[4 * i + 0] = xv[i].x * rinv * gg.x * (1.f + s1.x) + s0.x;
      hv[4 * i + 1] = xv[i].y * rinv * gg.y * (1.f + s1.y) + s0.y;
      hv[4 * i + 2] = xv[i].z * rinv * gg.z * (1.f + s1.z) + s0.z;
      hv[4 * i + 3] = xv[i].w * rinv * gg.w * (1.f + s1.w) + s0.w;
      *(u32x2*)(p.h() + (size_t)t * D + d) = (u32x2){pack2(hv[4 * i], hv[4 * i + 1]), pack2(hv[4 * i + 2], hv[4 * i + 3])};
    }
    float a[16];
    const int loff = launder(lane * 4);
#pragma unroll
    for (int e = 0; e < 16; ++e) {
      float s = 0.f;
#pragma unroll
      for (int i = 0; i < 4; ++i) {
        const f32x4 w = *(const f32x4*)(wrT + e * 1024 + loff + 256 * i);
        s += hv[4 * i] * w[0] + hv[4 * i + 1] * w[1] + hv[4 * i + 2] * w[2] + hv[4 * i + 3] * w[3];
      }
      a[e] = s;
    }
    float lg[16];
#pragma unroll
    for (int e = 0; e < 16; ++e) lg[e] = wave_sum(a[e]);
    float mx = lg[0];
#pragma unroll
    for (int e = 1; e < 16; ++e) mx = fmaxf(mx, lg[e]);
    float pr[16], sel[16]; float sum = 0.f;
#pragma unroll
    for (int e = 0; e < 16; ++e) { pr[e] = __expf(lg[e] - mx); sum += pr[e]; }
    const float inv = 1.f / sum;
#pragma unroll
    for (int e = 0; e < 16; ++e) { pr[e] *= inv; sel[e] = pr[e] + rb[e]; }
    int gbest = 0; float gbs = -1e30f;
#pragma unroll
    for (int g = 0; g < 4; ++g) {
      float m1 = -1e30f, m2 = -1e30f;
#pragma unroll
      for (int j = 0; j < 4; ++j) { const float v = sel[g * 4 + j]; if (v > m1) { m2 = m1; m1 = v; } else if (v > m2) m2 = v; }
      const float gs = m1 + m2;
      if (gs > gbs) { gbs = gs; gbest = g; }
    }
    float s4[4], p4[4];
#pragma unroll
    for (int j = 0; j < 4; ++j) { s4[j] = sel[j]; p4[j] = pr[j]; }
#pragma unroll
    for (int g = 1; g < 4; ++g) if (g == gbest) {
#pragma unroll
      for (int j = 0; j < 4; ++j) { s4[j] = sel[g * 4 + j]; p4[j] = pr[g * 4 + j]; }
    }
    int i0 = 0; float b0 = s4[0];
#pragma unroll
    for (int j = 1; j < 4; ++j) if (s4[j] > b0) { b0 = s4[j]; i0 = j; }
    int i1 = -1; float bb1 = -1e30f;
#pragma unroll
    for (int j = 0; j < 4; ++j) if (j != i0 && s4[j] > bb1) { bb1 = s4[j]; i1 = j; }
    float p0 = 0.f, p1 = 0.f;
#pragma unroll
    for (int j = 0; j < 4; ++j) { if (j == i0) p0 = p4[j]; if (j == i1) p1 = p4[j]; }
    const float w0 = p0 / (p0 + p1), w1 = p1 / (p0 + p1);
    const int lo = i0 < i1 ? i0 : i1, hi = i0 < i1 ? i1 : i0;
    const float wlo = i0 < i1 ? w0 : w1, whi = i0 < i1 ? w1 : w0;
    const int pidx = (lo == 0) ? (hi - 1) : (lo == 1 ? (hi + 1) : 5);
    const int bucket = gbest * 6 + pidx;
    if (lane == slot) { my_t = t; my_bucket = bucket; my_wlo = wlo; my_whi = whi; }
#pragma unroll
    for (int i = 0; i < 4; ++i) xv[i] = xn[i];
  }
  if (my_t >= 0) {
    const int sl = my_bucket * NSUBL + (blockIdx.x & (NSUBL - 1));
    const int pos = atomicAdd(&cntl[sl], 1);
    p.list()[(size_t)sl * T + pos] = my_t;
    p.tokw()[my_t] = make_float2(my_wlo, my_whi);
  }
  __syncthreads();
}

__device__ __forceinline__ void bucket_experts2(int bucket, int& elo, int& ehi) {
  const int g = bucket / 6, pi = bucket % 6;
  const int lo = pi < 3 ? 0 : (pi < 5 ? 1 : 2);
  const int hi = pi < 3 ? pi + 1 : (pi < 5 ? pi - 1 : 3);
  elo = g * 4 + lo; ehi = g * 4 + hi;
}
__device__ __forceinline__ void moe_map_build(const int* cnt, int* mm, int tid) {
  if (tid < NBUCKET) {
    int acc = 0;
#pragma unroll
    for (int x = 0; x < NSUBL; ++x) { mm[32 + 16 * tid + x] = acc; acc += cnt[tid * NSUBL + x]; }
    mm[32 + 16 * tid + 8] = acc;
  }
  __syncthreads();
  if (tid == 0) {
    int acc = 0;
    for (int bk = 0; bk < NBUCKET; ++bk) { mm[bk] = acc; acc += (mm[32 + 16 * bk + 8] + TM - 1) / TM; }
    mm[NBUCKET] = acc;
  }
  __syncthreads();
}
__device__ __forceinline__ void moe_find_tile(const int* mm, int mt, int& bucket, int& tib, int& nrow) {
  int bk = 0;
#pragma unroll
  for (int j = 1; j < NBUCKET; ++j) bk += (mt >= mm[j]) ? 1 : 0;
  bucket = bk; tib = mt - mm[bk]; nrow = mm[32 + 16 * bk + 8] - tib * TM;
}
__device__ __forceinline__ int moe_token(const int* list, const int* mm, int bk, int q) {
  const int* sp = mm + 32 + 16 * bk;
  int x = 0, s = 0;
#pragma unroll
  for (int j = 1; j < NSUBL; ++j) { const int v = sp[j]; const bool ge = q >= v; x += ge ? 1 : 0; s = ge ? v : s; }
  return list[(size_t)(bk * NSUBL + x) * T + (q - s)];
}

__device__ void phase_moe_gu(const MP& p, int l, char* smem) {
  const int tid = launder(threadIdx.x), lane = tid & 63, wave = tid >> 6, wr = wave >> 1, wc = wave & 1, fr = lane & 15, fq = lane >> 4;
  const int r0 = tid >> 3;
  int* mm = (int*)(smem + SMEM_MM);
  moe_map_build(p.cnt() + l * 256, mm, tid);
  const int nmt = mm[NBUCKET];
  const int ntiles = nmt * 16;
  auto make = [&](int tile, GemmTile& g) {
    const int mt = tile >> 4, nt = tile & 15;
    int bucket, tib, nrow;
    moe_find_tile(mm, mt, bucket, tib, nrow);
    int elo, ehi; bucket_experts2(bucket, elo, ehi);
    const int e = nt < 8 ? elo : ehi, f0 = (nt & 7) * 64;
    g.A0 = p.h(); g.A1 = p.h(); g.lda = D; g.ksA = D; g.K = D;
    const bf16_t* Wg = p.WgT() + ((size_t)(l * NE + e) * DFF + f0) * D;
    const bf16_t* Wu = p.WuT() + ((size_t)(l * NE + e) * DFF + f0) * D;
#pragma unroll
    for (int i = 0; i < 4; ++i) {
      const int r = r0 + 32 * i;
      g.arow[i] = moe_token(p.list(), mm, bucket, tib * TM + (r < nrow ? r : nrow - 1));
    }
    g.Blo0 = Wg; g.Bhi0 = Wu; g.Blo1 = Wg; g.Bhi1 = Wu;
    g.ldb = D; g.ksB = D;
  };
  GemmTile g, gn; bool pre = false;
  const TileMap tmap = tm_init(nmt, 16);
  { const int t0 = tm_tile(tmap, 0); if (t0 >= 0) { make(t0, g); gn = g; } }
  for (int jt = 0; ; ++jt) {
    const int tile = tm_tile(tmap, jt); if (tile < 0) break;
    const int mt = tile >> 4, nt = tile & 15;
    int bucket, tib, nrow;
    moe_find_tile(mm, mt, bucket, tib, nrow);
    const int f0 = (nt & 7) * 64;
    const int nxt = tm_tile(tmap, jt + 1); const bool hasn = nxt >= 0;
    if (hasn) make(nxt, gn);
    float wv[4];
#pragma unroll
    for (int m = 0; m < 4; ++m) {
      const int r = wr * 64 + 16 * m + fr;
      const float2 ww = p.tokw()[moe_token(p.list(), mm, bucket, tib * TM + (r < nrow ? r : nrow - 1))];
      wv[m] = r < nrow ? (nt < 8 ? ww.x : ww.y) : 0.f;
    }
    f32x4 acc[4][4];
    gemm_mainloop<true>(g, gn, hasn, pre, smem, acc);
    pre = hasn; g = gn;
#pragma unroll
    for (int m = 0; m < 4; ++m) {
      const int r = wr * 64 + 16 * m + fr;
      const float w = wv[m];
      bf16_t* dst = p.act() + (size_t)(mt * TM + r) * D + (nt < 8 ? 0 : 512) + f0 + wc * 32 + 4 * fq;
#pragma unroll
      for (int n = 0; n < 2; ++n) {
        float o[4];
#pragma unroll
        for (int j = 0; j < 4; ++j) { const float gv = acc[m][n][j], uv = acc[m][n + 2][j]; o[j] = gv * __builtin_amdgcn_rcpf(1.f + __expf(-gv)) * uv * w; }
        *(u32x2*)(dst + 16 * n) = (u32x2){pack2(o[0], o[1]), pack2(o[2], o[3])};
      }
    }
  }
}

template <bool LAST>
__device__ void phase_moe_down(const MP& p, int l, char* smem) {
  const int tid = launder(threadIdx.x), lane = tid & 63, wave = tid >> 6, wr = wave >> 1, wc = wave & 1, fr = lane & 15, fq = lane >> 4;
  const int r0 = tid >> 3;
  int* mm = (int*)(smem + SMEM_MM);
  moe_map_build(p.cnt() + l * 256, mm, tid);
  const float* modl = p.mod() + (size_t)l * 8 * 6144;
  const int nmt = mm[NBUCKET];
  const int ntiles = nmt * 8;
  auto make = [&](int tile, GemmTile& g) {
    const int mt = tile >> 3, n0 = (tile & 7) * 128;
    int bucket, tib, nrow;
    moe_find_tile(mm, mt, bucket, tib, nrow);
    int elo, ehi; bucket_experts2(bucket, elo, ehi);
    g.A0 = p.act(); g.A1 = p.act(); g.lda = D; g.ksA = D; g.K = D;
    const bf16_t* Wlo = p.WdT() + ((size_t)(l * NE + elo) * D + n0) * DFF;
    const bf16_t* Whi = p.WdT() + ((size_t)(l * NE + ehi) * D + n0) * DFF;
#pragma unroll
    for (int i = 0; i < 4; ++i) {
      g.arow[i] = mt * TM + r0 + 32 * i;
    }
    g.Blo0 = Wlo; g.Bhi0 = Wlo + (size_t)64 * DFF; g.Blo1 = Whi; g.Bhi1 = Whi + (size_t)64 * DFF;
    g.ldb = DFF; g.ksB = DFF;
  };
  GemmTile g, gn; bool pre = false;
  const TileMap tmap = tm_init(nmt, 8);
  { const int t0 = tm_tile(tmap, 0); if (t0 >= 0) { make(t0, g); gn = g; } }
  for (int jt = 0; ; ++jt) {
    const int tile = tm_tile(tmap, jt); if (tile < 0) break;
    const int mt = tile >> 3, nt = tile & 7, n0 = nt * 128;
    int bucket, tib, nrow;
    moe_find_tile(mm, mt, bucket, tib, nrow);
    const int nxt = tm_tile(tmap, jt + 1); const bool hasn = nxt >= 0;
    if (hasn) make(nxt, gn);
    int tkv[4];
#pragma unroll
    for (int m = 0; m < 4; ++m) {
      const int r = wr * 64 + 16 * m + fr;
      tkv[m] = moe_token(p.list(), mm, bucket, tib * TM + (r < nrow ? r : nrow - 1));
    }
    f32x4 acc[4][4];
    gemm_mainloop<false>(g, gn, hasn, pre, smem, acc);
    pre = hasn; g = gn;
#pragma unroll
    for (int m = 0; m < 4; ++m) {
      const int r = wr * 64 + 16 * m + fr;
      const int tk = tkv[m], b = tk / S;
      f32x4 o[4];
#pragma unroll
      for (int n = 0; n < 4; ++n) {
        const int col = n0 + wc * 64 + 16 * n + 4 * fq;
        const u32x2 xr = *(const u32x2*)(p.x1() + (size_t)tk * D + col);
        const f32x4 xv = {bf_lo(xr[0]), bf_hi(xr[0]), bf_lo(xr[1]), bf_hi(xr[1])};
        const f32x4 g2 = *(const f32x4*)(modl + (size_t)b * 6144 + 5 * 1024 + col);
#pragma unroll
        for (int j = 0; j < 4; ++j) o[n][j] = xv[j] + g2[j] * acc[m][n][j];
      }
      if (r < nrow) {
        if (!LAST) {
#pragma unroll
          for (int n = 0; n < 4; ++n) *(u32x2*)(p.xmid() + (size_t)tk * D + n0 + wc * 64 + 16 * n + 4 * fq) = (u32x2){pack2(o[n][0], o[n][1]), pack2(o[n][2], o[n][3])};
        } else {
#pragma unroll
          for (int n = 0; n < 4; ++n) *(f32x4*)(p.out + (size_t)tk * D + n0 + wc * 64 + 16 * n + 4 * fq) = o[n];
        }
      }
    }
  }
}
#define XB_TMO      128
#define XB_XCNT(j)  (256  + 64 * (j))
#define XB_XSUB(j)  (1280 + 64 * (j))
#define XB_XGEN(j)  (2304 + 64 * (j))
#define XB_TOP      3328
#define XB_TOPGEN   3392
#define XCD_BAR_WORDS 3456
#define XB_SPIN_CAP (1u << 22)
#define LAS __attribute__((address_space(3)))

__device__ __forceinline__ unsigned xb_ld(unsigned* p)              { return __hip_atomic_load(p, __ATOMIC_RELAXED, __HIP_MEMORY_SCOPE_AGENT); }
__device__ __forceinline__ unsigned xb_add(unsigned* p, unsigned v) { return __hip_atomic_fetch_add(p, v, __ATOMIC_RELAXED, __HIP_MEMORY_SCOPE_AGENT); }
__device__ __forceinline__ unsigned xb_xcc_id() { return (unsigned)__builtin_amdgcn_s_getreg((3 << 11) | 20) & 0xFu; }
#define XB_SPIN(cond, bar) do { unsigned _sp = 0; while (cond) { __builtin_amdgcn_s_sleep(1); \
    if ((++_sp & 255u) == 0u) { if (xb_ld(&(bar)[XB_TMO])) break; if (_sp > XB_SPIN_CAP) { atomicAdd(&(bar)[XB_TMO], 1u); break; } } } } while (0)

struct XcdBarrier { unsigned* bar; unsigned x; volatile LAS unsigned* st; };

__device__ __forceinline__ XcdBarrier xcd_barrier_post(unsigned* bar, volatile LAS unsigned* st) {
  XcdBarrier b; b.bar = bar; b.x = xb_xcc_id(); b.st = st;
  if (threadIdx.x == 0) (void)xb_add(&bar[XB_XCNT(b.x)], 1u);
  return b;
}
__device__ __forceinline__ void xcd_barrier_complete(unsigned* bar, unsigned x, unsigned& nloc, unsigned& nx) {
  const unsigned G = gridDim.x * gridDim.y * gridDim.z;
  unsigned sum, cnt, mine, sp = 0u;
  for (;;) {
    sum = 0u; cnt = 0u; mine = 0u;
#pragma unroll
    for (unsigned j = 0; j < 16; ++j) { const unsigned c = xb_ld(&bar[XB_XCNT(j)]); sum += c; cnt += (c > 0u) ? 1u : 0u; mine = (j == x) ? c : mine; }
    if (sum == G) break;
    __builtin_amdgcn_s_sleep(1);
    if ((++sp & 255u) == 0u) { if (xb_ld(&bar[XB_TMO])) break; if (sp > XB_SPIN_CAP) { atomicAdd(&bar[XB_TMO], 1u); break; } }
  }
  nloc = mine > 0u ? mine : 1u; nx = cnt > 0u ? cnt : 1u;
}
__device__ __forceinline__ void xcd_barrier(const XcdBarrier& b) {
  asm volatile("s_waitcnt vmcnt(0)" ::: "memory");
  __syncthreads();
  if (threadIdx.x == 0) {
    unsigned* bar = b.bar;
    __builtin_amdgcn_s_waitcnt(0);
    unsigned nloc = b.st[0], nx = b.st[1];
    if (nloc == 0u) { xcd_barrier_complete(bar, b.x, nloc, nx); b.st[0] = nloc; b.st[1] = nx; }
    const unsigned old = xb_add(&bar[XB_XSUB(b.x)], 1u);
    const unsigned gen = old / nloc;
    if (old + 1u == (gen + 1u) * nloc) {
      __builtin_amdgcn_fence(__ATOMIC_RELEASE, "agent");
      asm volatile("s_waitcnt vmcnt(0)" ::: "memory");
      const unsigned og = xb_add(&bar[XB_TOP], 1u);
      const unsigned tg = og / nx;
      if (og + 1u == (tg + 1u) * nx) xb_add(&bar[XB_TOPGEN], 1u);
      else XB_SPIN(xb_ld(&bar[XB_TOPGEN]) == tg, bar);
      __builtin_amdgcn_fence(__ATOMIC_ACQUIRE, "agent");
      xb_add(&bar[XB_XGEN(b.x)], 1u);
      asm volatile("s_waitcnt vmcnt(0)" ::: "memory");
    } else {
      XB_SPIN(xb_ld(&bar[XB_XGEN(b.x)]) == gen, bar);
      __builtin_amdgcn_fence(__ATOMIC_ACQUIRE, "agent");
      asm volatile("s_waitcnt vmcnt(0)" ::: "memory");
    }
  }
  __syncthreads();
}

constexpr int NSUB = 9;

__global__ void __launch_bounds__(NTHR, 2) mega(MP p) {
  __shared__ __attribute__((aligned(16))) char smem[65536 + 16 + 2048];
  unsigned* xb_words = (unsigned*)(smem + 65536);
  if (threadIdx.x < 4) xb_words[threadIdx.x] = 0u;
  __syncthreads();
  const XcdBarrier xb = xcd_barrier_post(p.bar(), (volatile LAS unsigned*)xb_words);
  if (threadIdx.x == 0) {
    const unsigned key = (xb_xcc_id() << 8) | ((unsigned)__builtin_amdgcn_s_getreg((7 << 11) | (8 << 6) | 4) & 0xffu);
    const unsigned rank = xb_add(p.claim() + key, 1u);
    xb_words[2] = rank == 0u ? xb_add(p.claim() + 4096, 1u) : 0xffffffffu;
  }
  __syncthreads();
  const int ssm_wid = (int)xb_words[2];
  for (int it = blockIdx.x; it < P0_MISC; it += gridDim.x) phase0_item(p, it, smem);
  phase0_transposes(p, smem);
  xcd_barrier(xb);
  for (int l = 0; l < DEPTH; ++l) {
    if (l == 0) phase_norm1<true>(p, l); else phase_norm1<false>(p, l);
    xcd_barrier(xb);
    phase_inproj(p, l, smem);        xcd_barrier(xb);
    phase_attn(p, l);                xcd_barrier(xb);
    phase_ssm(p, l, smem, ssm_wid);  xcd_barrier(xb);
    phase_glu(p, l, smem);           xcd_barrier(xb);
    if (l == 0) phase_out<true>(p, l, smem); else phase_out<false>(p, l, smem);
    xcd_barrier(xb);
    phase_norm2_route(p, l, smem);   xcd_barrier(xb);
    phase_moe_gu(p, l, smem);        xcd_barrier(xb);
    if (l + 1 < DEPTH) phase_moe_down<false>(p, l, smem); else phase_moe_down<true>(p, l, smem);
    if (l + 1 < DEPTH) xcd_barrier(xb);
  }
}

}

extern "C" void kernel_launch(void* const* d_in, const int* in_sizes, int n_in, void* d_out, int out_size, void* d_ws,
                              size_t ws_size, hipStream_t stream) {
  MP p; memset(&p, 0, sizeof(p));
  Ptrs& P = p.in;
  P.x = (const float*)d_in[0]; P.c = (const float*)d_in[1]; P.pos = (const int*)d_in[2];
  P.ada_w = (const float*)d_in[3]; P.ada_b = (const float*)d_in[4]; P.norm1_g = (const float*)d_in[5];
  P.w_in = (const float*)d_in[6]; P.q_norm_g = (const float*)d_in[7]; P.k_norm_g = (const float*)d_in[8];
  P.attn_sink = (const float*)d_in[9]; P.lam_re = (const float*)d_in[10]; P.lam_im = (const float*)d_in[11];
  P.b_re = (const float*)d_in[12]; P.b_im = (const float*)d_in[13]; P.c_re = (const float*)d_in[14]; P.c_im = (const float*)d_in[15];
  P.ssm_d = (const float*)d_in[16]; P.log_dt = (const float*)d_in[17]; P.w_glu = (const float*)d_in[18];
  P.attn_out_g = (const float*)d_in[19]; P.ssm_out_g = (const float*)d_in[20]; P.w_out = (const float*)d_in[21];
  P.norm2_g = (const float*)d_in[22]; P.w_router = (const float*)d_in[23]; P.router_bias = (const float*)d_in[24];
  P.w_gate = (const float*)d_in[25]; P.w_up = (const float*)d_in[26]; P.w_down = (const float*)d_in[27];
  p.out = (float*)d_out;

  p.ws = (char*)d_ws;
  if (WS_TOTAL > ws_size) { fprintf(stderr, "workspace too small: need %zu have %zu\n", (size_t)WS_TOTAL, ws_size); return; }
  (void)in_sizes; (void)n_in; (void)out_size;

  static int grid_blocks = 0;
  if (!grid_blocks) {
    int dev = 0, cus = 0, per_cu = 0;
    (void)hipGetDevice(&dev);
    (void)hipDeviceGetAttribute(&cus, hipDeviceAttributeMultiprocessorCount, dev);
    (void)hipOccupancyMaxActiveBlocksPerMultiprocessor(&per_cu, mega, NTHR, 0);
    if (per_cu > 2) per_cu = 2;
    if (per_cu < 1) per_cu = 1;
    grid_blocks = cus * per_cu;
  }
  (void)hipMemsetAsync(p.ws + OFF_BAR, 0, OFF_MOD - OFF_BAR, stream);
  void* args[] = {&p};
  hipError_t e = hipLaunchCooperativeKernel((void*)mega, dim3(grid_blocks), dim3(NTHR), args, 0, stream);
  if (e != hipSuccess) fprintf(stderr, "cooperative launch failed: %s (grid %d)\n", hipGetErrorString(e), grid_blocks);
}
```

```cpp
#include <hip/hip_runtime.h>
#include <hip/hip_cooperative_groups.h>
#include <stdint.h>
#include <cstdio>
#include <cstring>

namespace {
constexpr int D = 1024, NB = 8, S = 2048, T = NB * S, DEPTH = 2;
constexpr int AW = 512, HD = 64, NQ = 8, NKV = 2, INW = 1280;
constexpr int SG = 32, SCH = 16, SP = 64, SW = 512;
constexpr int NE = 16, DFF = 512;
constexpr int NBUCKET = 24;
constexpr float EPS = 1e-6f;

struct Ptrs {
  const float *x, *c; const int* pos; const float *ada_w, *ada_b, *norm1_g, *w_in, *q_norm_g, *k_norm_g, *attn_sink,
      *lam_re, *lam_im, *b_re, *b_im, *c_re, *c_im, *ssm_d, *log_dt, *w_glu, *attn_out_g, *ssm_out_g, *w_out, *norm2_g,
      *w_router, *router_bias, *w_gate, *w_up, *w_down;
};

__device__ __forceinline__ float row_sum32_dpp(float v) {
  v += __int_as_float(__builtin_amdgcn_update_dpp(0, __float_as_int(v), 0xB1, 0xF, 0xF, true));
  v += __int_as_float(__builtin_amdgcn_update_dpp(0, __float_as_int(v), 0x4E, 0xF, 0xF, true));
  v += __int_as_float(__builtin_amdgcn_update_dpp(0, __float_as_int(v), 0x141, 0xF, 0xF, true));
  v += __int_as_float(__builtin_amdgcn_update_dpp(0, __float_as_int(v), 0x140, 0xF, 0xF, true));
  v += __int_as_float(__builtin_amdgcn_update_dpp(0, __float_as_int(v), 0x142, 0xA, 0xF, false));
  return v;
}
__device__ __forceinline__ float wave_sum(float v) {
  v = row_sum32_dpp(v);
  return __int_as_float(__builtin_amdgcn_readlane(__float_as_int(v), 31)) + __int_as_float(__builtin_amdgcn_readlane(__float_as_int(v), 63));
}
__device__ __forceinline__ float xhalf_sum(float v) {
  const auto r = __builtin_amdgcn_permlane32_swap(__float_as_uint(v), __float_as_uint(v), false, false);
  return __uint_as_float(r[0]) + __uint_as_float(r[1]);
}
__device__ __forceinline__ float xhalf_max(float v) {
  const auto r = __builtin_amdgcn_permlane32_swap(__float_as_uint(v), __float_as_uint(v), false, false);
  return fmaxf(__uint_as_float(r[0]), __uint_as_float(r[1]));
}

typedef unsigned short bf16_t;
typedef short bf16x8 __attribute__((ext_vector_type(8)));
typedef float f32x4 __attribute__((ext_vector_type(4)));
typedef float f32x16 __attribute__((ext_vector_type(16)));
typedef float f32x2 __attribute__((ext_vector_type(2)));
typedef __bf16 bf16x2_t __attribute__((ext_vector_type(2)));
typedef unsigned u32x4 __attribute__((ext_vector_type(4)));
typedef unsigned u32x2 __attribute__((ext_vector_type(2)));

constexpr int NTHR = 256;
constexpr int TM = 128;
constexpr int MAXMT = T / TM + NBUCKET;
constexpr int NSUBL = 8;
constexpr int SMEM_MM = 65536 + 16;

__device__ __forceinline__ unsigned pack2(float lo, float hi) {
  f32x2 v = {lo, hi};
  return __builtin_bit_cast(unsigned, __builtin_convertvector(v, bf16x2_t));
}
__device__ __forceinline__ int launder(int x) { asm volatile("" : "+v"(x)); return x; }
__device__ __forceinline__ int launder_s(int x) { asm volatile("" : "+s"(x)); return x; }
__device__ __forceinline__ float bf_lo(unsigned u) { return __uint_as_float(u << 16); }
__device__ __forceinline__ float bf_hi(unsigned u) { return __uint_as_float(u & 0xffff0000u); }
__device__ __forceinline__ float bf1(bf16_t u) { return __uint_as_float(((unsigned)u) << 16); }

constexpr size_t al256(size_t x) { return (x + 255) & ~(size_t)255; }
constexpr size_t OFF_BAR = 0;
constexpr size_t OFF_CLAIM = OFF_BAR + al256(4096 * 4);
constexpr size_t OFF_MOD = OFF_CLAIM + al256(4096 * 4 + 256);
constexpr size_t OFF_CS = OFF_MOD + al256((size_t)DEPTH * 8 * 6144 * 4);
constexpr size_t OFF_CNT = OFF_CS + al256((size_t)T * 32 * 8);
constexpr size_t OFF_LIST = OFF_CNT + al256(256 * 4 * DEPTH);
constexpr size_t OFF_TOKW = OFF_LIST + al256((size_t)NBUCKET * NSUBL * T * 4);
constexpr size_t OFF_SSMB = OFF_TOKW + al256((size_t)T * 8);
constexpr size_t OFF_SSMC = OFF_SSMB + al256((size_t)DEPTH * SG * 128 * 16 * 2);
constexpr size_t OFF_SSML = OFF_SSMC + al256((size_t)DEPTH * SG * 16 * 128 * 2);
constexpr size_t OFF_WINT = OFF_SSML + al256((size_t)DEPTH * SG * SP * 2 * 4);
constexpr size_t OFF_WGLUT = OFF_WINT + al256((size_t)DEPTH * INW * D * 2);
constexpr size_t OFF_WOUTT = OFF_WGLUT + al256((size_t)DEPTH * SW * SW * 2);
constexpr size_t OFF_H = OFF_WOUTT + al256((size_t)DEPTH * D * D * 2);
constexpr size_t OFF_Q = OFF_H + al256((size_t)T * D * 2);
constexpr size_t OFF_K = OFF_Q + al256((size_t)T * AW * 2);
constexpr size_t OFF_VT = OFF_K + al256((size_t)T * 128 * 2);
constexpr size_t OFF_U = OFF_VT + al256((size_t)T * 128 * 2);
constexpr size_t OFF_ATTN = OFF_U + al256((size_t)T * SW * 2);
constexpr size_t OFF_ACT = OFF_Q;
static_assert((size_t)MAXMT * TM * D * 2 <= OFF_ATTN - OFF_Q, "act overlay too small");
constexpr size_t OFF_SSQA = OFF_ATTN + al256((size_t)T * AW * 2);
constexpr size_t OFF_Y = OFF_SSQA + al256((size_t)T * 8 * 4);
constexpr size_t OFF_SSM = OFF_Y + al256((size_t)T * SW * 2);
constexpr size_t OFF_SSQS = OFF_SSM + al256((size_t)T * SW * 2);
constexpr size_t OFF_X1 = OFF_SSQS + al256((size_t)T * 8 * 4);
constexpr size_t OFF_WGT = OFF_X1 + al256((size_t)T * D * 4);
constexpr size_t OFF_WUT = OFF_WGT + al256((size_t)DEPTH * NE * DFF * D * 2);
constexpr size_t OFF_WDT = OFF_WUT + al256((size_t)DEPTH * NE * DFF * D * 2);
constexpr size_t WS_TOTAL = OFF_WDT + al256((size_t)DEPTH * NE * DFF * D * 2);

struct MP {
  Ptrs in;
  float* out;
  char* ws;
  __device__ __forceinline__ unsigned* bar() const { return (unsigned*)(ws + OFF_BAR); }
  __device__ __forceinline__ unsigned* claim() const { return (unsigned*)(ws + OFF_CLAIM); }
  __device__ __forceinline__ float* mod() const { return (float*)(ws + OFF_MOD); }
  __device__ __forceinline__ float2* cs() const { return (float2*)(ws + OFF_CS); }
  __device__ __forceinline__ int* cnt() const { return (int*)(ws + OFF_CNT); }
  __device__ __forceinline__ int* list() const { return (int*)(ws + OFF_LIST); }
  __device__ __forceinline__ float2* tokw() const { return (float2*)(ws + OFF_TOKW); }
  __device__ __forceinline__ bf16_t* ssmB() const { return (bf16_t*)(ws + OFF_SSMB); }
  __device__ __forceinline__ bf16_t* ssmC() const { return (bf16_t*)(ws + OFF_SSMC); }
  __device__ __forceinline__ float* ssmL() const { return (float*)(ws + OFF_SSML); }
  __device__ __forceinline__ bf16_t* WinT() const { return (bf16_t*)(ws + OFF_WINT); }
  __device__ __forceinline__ bf16_t* WgluT() const { return (bf16_t*)(ws + OFF_WGLUT); }
  __device__ __forceinline__ bf16_t* WoutT() const { return (bf16_t*)(ws + OFF_WOUTT); }
  __device__ __forceinline__ bf16_t* WgT() const { return (bf16_t*)(ws + OFF_WGT); }
  __device__ __forceinline__ bf16_t* WuT() const { return (bf16_t*)(ws + OFF_WUT); }
  __device__ __forceinline__ bf16_t* WdT() const { return (bf16_t*)(ws + OFF_WDT); }
  __device__ __forceinline__ bf16_t* h() const { return (bf16_t*)(ws + OFF_H); }
  __device__ __forceinline__ bf16_t* q() const { return (bf16_t*)(ws + OFF_Q); }
  __device__ __forceinline__ bf16_t* k() const { return (bf16_t*)(ws + OFF_K); }
  __device__ __forceinline__ bf16_t* vT() const { return (bf16_t*)(ws + OFF_VT); }
  __device__ __forceinline__ bf16_t* u() const { return (bf16_t*)(ws + OFF_U); }
  __device__ __forceinline__ bf16_t* attn() const { return (bf16_t*)(ws + OFF_ATTN); }
  __device__ __forceinline__ bf16_t* y() const { return (bf16_t*)(ws + OFF_Y); }
  __device__ __forceinline__ bf16_t* ssm() const { return (bf16_t*)(ws + OFF_SSM); }
  __device__ __forceinline__ bf16_t* act() const { return (bf16_t*)(ws + OFF_ACT); }
  __device__ __forceinline__ float* ssqa() const { return (float*)(ws + OFF_SSQA); }
  __device__ __forceinline__ float* ssqs() const { return (float*)(ws + OFF_SSQS); }
  __device__ __forceinline__ bf16_t* x1() const { return (bf16_t*)(ws + OFF_X1); }
};

constexpr int TT_WIN = 8 * 20, TT_GLU = 4 * 8, TT_OUT = 8 * 16, TT_EXP = 16 * 64;
constexpr int TT_LAYER = TT_WIN + TT_GLU + TT_OUT + 3 * TT_EXP;
constexpr int P0_MOD = DEPTH * 192;
constexpr int P0_TR = DEPTH * TT_LAYER;
constexpr int P0_CS = T * 32 / 256;
constexpr int P0_SSM = DEPTH * SG;
constexpr int P0_MISC = P0_MOD + P0_CS + P0_SSM + 1;

__device__ void phase0_item(const MP& p, int it, char* smem) {
  const int tid = launder(threadIdx.x);
  float* ldsf = (float*)smem;
  if (it < P0_MOD) {
    const int l = it / 192, j0 = (it % 192) * 32;
    float* sc = ldsf;
    float* red = ldsf + 8192;
    for (int i = tid; i < 8192; i += NTHR) { float v = p.in.c[i]; sc[i] = v / (1.f + __expf(-v)); }
    __syncthreads();
    const int kg = tid >> 3, cq = (tid & 7) * 4;
    float acc[8][4];
#pragma unroll
    for (int b = 0; b < 8; ++b)
#pragma unroll
      for (int j = 0; j < 4; ++j) acc[b][j] = 0.f;
    const float* w = p.in.ada_w + (size_t)l * 1024 * 6144 + j0 + cq;
#pragma unroll 8
    for (int kk = 0; kk < 32; ++kk) {
      const int k = kg * 32 + kk;
      const float4 wv = *(const float4*)(w + (size_t)k * 6144);
#pragma unroll
      for (int b = 0; b < 8; ++b) { const float s = sc[b * 1024 + k]; acc[b][0] += s * wv.x; acc[b][1] += s * wv.y; acc[b][2] += s * wv.z; acc[b][3] += s * wv.w; }
    }
#pragma unroll
    for (int b = 0; b < 8; ++b) *(float4*)(red + (kg * 8 + b) * 32 + cq) = make_float4(acc[b][0], acc[b][1], acc[b][2], acc[b][3]);
    __syncthreads();
    {
      const int b = tid >> 5, c = tid & 31;
      float v = 0.f;
#pragma unroll 8
      for (int g = 0; g < 32; ++g) v += red[(g * 8 + b) * 32 + c];
      p.mod()[(size_t)(l * 8 + b) * 6144 + j0 + c] = v + p.in.ada_b[l * 6144 + j0 + c];
    }
    __syncthreads();
    return;
  }
  it -= P0_MOD;
  if (it < P0_CS) {
    const int i = it * 256 + tid, t = i >> 5, f = i & 31;
    const float freq = powf(10000.f, -(float)f / 32.f);
    const float ang = (float)p.in.pos[t] * freq;
    float sn, cn; sincosf(ang, &sn, &cn);
    p.cs()[i] = make_float2(cn, sn);
    return;
  }
  it -= P0_CS;
  if (it < P0_SSM) {
    const int lg = it;
    if (tid < 64) {
      const int pp = tid;
      const float dt = expf(p.in.log_dt[lg]);
      const float lr = p.in.lam_re[lg * SP + pp], li = p.in.lam_im[lg * SP + pp];
      const float mag = expf(lr * dt);
      float sn, cn; sincosf(li * dt, &sn, &cn);
      const float ar = mag * cn, ai = mag * sn;
      const float den = lr * lr + li * li;
      const float fr = ((ar - 1.f) * lr + ai * li) / den, fi = (ai * lr - (ar - 1.f) * li) / den;
      p.ssmL()[(lg * SP + pp) * 2] = ar; p.ssmL()[(lg * SP + pp) * 2 + 1] = ai;
      unsigned wr[8], wi[8];
#pragma unroll
      for (int hh = 0; hh < 8; ++hh) {
        const float br0 = p.in.b_re[((size_t)lg * SP + pp) * SCH + 2 * hh], bi0 = p.in.b_im[((size_t)lg * SP + pp) * SCH + 2 * hh];
        const float br1 = p.in.b_re[((size_t)lg * SP + pp) * SCH + 2 * hh + 1], bi1 = p.in.b_im[((size_t)lg * SP + pp) * SCH + 2 * hh + 1];
        wr[hh] = pack2(fr * br0 - fi * bi0, fr * br1 - fi * bi1);
        wi[hh] = pack2(fr * bi0 + fi * br0, fr * bi1 + fi * br1);
      }
      u32x4* dr = (u32x4*)(p.ssmB() + ((size_t)lg * 128 + pp) * 16);
      u32x4* di = (u32x4*)(p.ssmB() + ((size_t)lg * 128 + 64 + pp) * 16);
      dr[0] = (u32x4){wr[0], wr[1], wr[2], wr[3]}; dr[1] = (u32x4){wr[4], wr[5], wr[6], wr[7]};
      di[0] = (u32x4){wi[0], wi[1], wi[2], wi[3]}; di[1] = (u32x4){wi[4], wi[5], wi[6], wi[7]};
    }
    for (int o = tid; o < 16 * 64; o += NTHR) {
      const int hh = o >> 6, pp = o & 63;
      const float cr = p.in.c_re[(size_t)lg * SCH * SP + o], ci = p.in.c_im[(size_t)lg * SCH * SP + o];
      *(unsigned*)(p.ssmC() + ((size_t)lg * 16 + hh) * 128 + 2 * pp) = pack2(cr, -ci);
    }
    return;
  }
  for (int i = tid; i < 256 * DEPTH; i += NTHR) p.cnt()[i] = 0;
}

struct TrDesc { const float* src; bf16_t* dst; const float* gain; int N, K, k0, n0; };
__device__ __forceinline__ void tr_decode(const MP& p, int it, TrDesc& d) {
  const int l = it / TT_LAYER; int r = it % TT_LAYER;
  d.gain = nullptr;
  if (r < TT_WIN) { d.src = p.in.w_in + (size_t)l * D * INW; d.N = INW; d.dst = p.WinT() + (size_t)l * INW * D; d.K = D; d.k0 = (r / 20) * 128; d.n0 = (r % 20) * 64; return; }
  r -= TT_WIN;
  if (r < TT_GLU) { d.src = p.in.w_glu + (size_t)l * SW * SW; d.N = SW; d.dst = p.WgluT() + (size_t)l * SW * SW; d.K = SW; d.k0 = (r / 8) * 128; d.n0 = (r % 8) * 64; return; }
  r -= TT_GLU;
  if (r < TT_OUT) {
    d.k0 = (r / 16) * 128; d.n0 = (r % 16) * 64;
    d.gain = d.k0 < 512 ? (p.in.attn_out_g + l * AW) : (p.in.ssm_out_g + l * SW - 512);
    d.src = p.in.w_out + (size_t)l * D * D; d.N = D; d.dst = p.WoutT() + (size_t)l * D * D; d.K = D; return; }
  r -= TT_OUT;
  const int kind = r / TT_EXP; r %= TT_EXP;
  const int e = r / 64, tt = r % 64;
  if (kind == 0) { d.src = p.in.w_gate + (size_t)(l * NE + e) * D * DFF; d.N = DFF; d.dst = p.WgT() + (size_t)(l * NE + e) * DFF * D; d.K = D; d.k0 = (tt / 8) * 128; d.n0 = (tt % 8) * 64; return; }
  if (kind == 1) { d.src = p.in.w_up + (size_t)(l * NE + e) * D * DFF; d.N = DFF; d.dst = p.WuT() + (size_t)(l * NE + e) * DFF * D; d.K = D; d.k0 = (tt / 8) * 128; d.n0 = (tt % 8) * 64; return; }
  d.src = p.in.w_down + (size_t)(l * NE + e) * DFF * D; d.N = D; d.dst = p.WdT() + (size_t)(l * NE + e) * D * DFF; d.K = DFF; d.k0 = (tt / 16) * 128; d.n0 = (tt % 16) * 64;
}
__device__ void phase0_transposes(const MP& p, char* smem, int first, int last, int brank, int nblk) {
  const int tid = launder(threadIdx.x);
  float* lds = (float*)smem;
  const int r = tid >> 4, c4 = (tid & 15) * 4;
  const int n = tid >> 2, kq = (tid & 3) * 32;
  TrDesc cur, nxt;
  float4 v[8]; float gg[8];
  auto load = [&](const TrDesc& d) {
#pragma unroll
    for (int i = 0; i < 8; ++i) v[i] = *(const float4*)(d.src + (size_t)(d.k0 + r + 16 * i) * d.N + d.n0 + c4);
    if (d.gain) {
#pragma unroll
      for (int i = 0; i < 8; ++i) gg[i] = d.gain[d.k0 + r + 16 * i];
    } else {
#pragma unroll
      for (int i = 0; i < 8; ++i) gg[i] = 1.f;
    }
  };
  int it = first + brank;
  if (it < last) { tr_decode(p, it, cur); load(cur); nxt = cur; }
  for (; it < last; it += nblk) {
#pragma unroll
    for (int i = 0; i < 8; ++i) {
      float* d = lds + (r + 16 * i) * 65 + c4;
      d[0] = v[i].x * gg[i]; d[1] = v[i].y * gg[i]; d[2] = v[i].z * gg[i]; d[3] = v[i].w * gg[i];
    }
    __syncthreads();
    const int nit = it + nblk;
    if (nit < last) { tr_decode(p, nit, nxt); load(nxt); }
    unsigned w[16];
#pragma unroll
    for (int j = 0; j < 16; ++j) w[j] = pack2(lds[(kq + 2 * j) * 65 + n], lds[(kq + 2 * j + 1) * 65 + n]);
    u32x4* dd = (u32x4*)(cur.dst + (size_t)(cur.n0 + n) * cur.K + cur.k0 + kq);
#pragma unroll
    for (int j = 0; j < 4; ++j) dd[j] = (u32x4){w[4 * j], w[4 * j + 1], w[4 * j + 2], w[4 * j + 3]};
    __syncthreads();
    cur = nxt;
  }
}

__device__ __forceinline__ void norm_token(const float* __restrict__ xr, const float* __restrict__ g, const float* __restrict__ sh,
                                           const float* __restrict__ sc, bf16_t* __restrict__ hr, int lane, float (&hv)[16]) {
  float4 v[4]; float ss = 0.f;
#pragma unroll
  for (int i = 0; i < 4; ++i) { v[i] = *(const float4*)(xr + lane * 4 + 256 * i); ss += v[i].x * v[i].x + v[i].y * v[i].y + v[i].z * v[i].z + v[i].w * v[i].w; }
  ss = wave_sum(ss);
  const float rinv = rsqrtf(ss * (1.f / D) + EPS);
#pragma unroll
  for (int i = 0; i < 4; ++i) {
    const int d = lane * 4 + 256 * i;
    const float4 gg = *(const float4*)(g + d), s1 = *(const float4*)(sc + d), s0 = *(const float4*)(sh + d);
    hv[4 * i + 0] = v[i].x * rinv * gg.x * (1.f + s1.x) + s0.x;
    hv[4 * i + 1] = v[i].y * rinv * gg.y * (1.f + s1.y) + s0.y;
    hv[4 * i + 2] = v[i].z * rinv * gg.z * (1.f + s1.z) + s0.z;
    hv[4 * i + 3] = v[i].w * rinv * gg.w * (1.f + s1.w) + s0.w;
    *(u32x2*)(hr + d) = (u32x2){pack2(hv[4 * i], hv[4 * i + 1]), pack2(hv[4 * i + 2], hv[4 * i + 3])};
  }
}

__device__ void phase_norm1(const MP& p, int l, const float* xin) {
  const int tid = launder(threadIdx.x);
  const int wave = tid >> 6, lane = tid & 63;
  const float* modl = p.mod() + (size_t)l * 8 * 6144;
  for (int t = blockIdx.x * 4 + wave; t < T; t += gridDim.x * 4) {
    const int b = t / S; float hv[16];
    norm_token(xin + (size_t)t * D, p.in.norm1_g + l * D, modl + (size_t)b * 6144, modl + (size_t)b * 6144 + 1024, p.h() + (size_t)t * D, lane, hv);
  }
}

struct GemmTile {
  const bf16_t* A0; const bf16_t* A1; long lda; int ksA;
  int arow[4];
  const bf16_t* Blo0; const bf16_t* Bhi0;
  const bf16_t* Blo1; const bf16_t* Bhi1;
  long ldb; int ksB;
  int K;
};

__device__ __forceinline__ int lds_off(int row, int chunk) { return row * 128 + ((chunk ^ ((row >> 1) & 7)) << 4); }

template <bool BSPLIT, bool MID>
__device__ __forceinline__ void gemm_mainloop_t(const GemmTile& g, const GemmTile& gnext, bool hasnext, bool preloaded, char* smem, f32x4 (&acc)[4][4],
                                                int ktmid, const float (&mids)[4]) {
  const int tid = launder(threadIdx.x), lane = tid & 63, wave = tid >> 6, wr = wave >> 1, wc = wave & 1, fr = lane & 15, fq = lane >> 4;
  const int r0 = tid >> 3, c8 = tid & 7;
  const int csrc = (c8 ^ ((r0 >> 1) & 7)) * 8;
#pragma unroll
  for (int m = 0; m < 4; ++m)
#pragma unroll
    for (int n = 0; n < 4; ++n) acc[m][n] = (f32x4){0.f, 0.f, 0.f, 0.f};
  auto stage = [&](const GemmTile& gg, int kt, int buf) {
    const int kk = kt * 64;
    const bf16_t* Ab = kk < gg.ksA ? gg.A0 + kk : gg.A1 + (kk - gg.ksA);
    const bool bs = kk < gg.ksB; const int kb = bs ? kk : kk - gg.ksB;
    char* As = smem + buf * 32768 + tid * 16; char* Bs = As + 16384;
#pragma unroll
    for (int i = 0; i < 4; ++i) {
      __builtin_amdgcn_global_load_lds((const void*)(Ab + (size_t)gg.arow[i] * gg.lda + csrc), (void*)(As + i * 4096), 16, 0, 0);
      const bf16_t* Bb = bs ? (i < 2 ? gg.Blo0 : gg.Bhi0) : (i < 2 ? gg.Blo1 : gg.Bhi1);
      __builtin_amdgcn_global_load_lds((const void*)(Bb + (size_t)(r0 + 32 * (i & 1)) * gg.ldb + kb + csrc), (void*)(Bs + i * 4096), 16, 0, 0);
    }
  };
  const int nk = g.K / 64;
  if (!preloaded) {
    stage(g, 0, 0);
    asm volatile("s_waitcnt vmcnt(0)" ::: "memory");
    __syncthreads();
  }
  for (int kt = 0; kt < nk; ++kt) {
    if (kt + 1 < nk) stage(g, kt + 1, (kt + 1) & 1);
    else if (hasnext) stage(gnext, 0, 0);
    if (MID && kt == ktmid) {
#pragma unroll
      for (int m = 0; m < 4; ++m)
#pragma unroll
        for (int n = 0; n < 4; ++n) acc[m][n] *= mids[m];
    }
    const char* As = smem + (kt & 1) * 32768; const char* Bs = As + 16384;
    {
      bf16x8 af[2][4], bfr[2][4];
#pragma unroll
      for (int ks = 0; ks < 2; ++ks) {
#pragma unroll
        for (int m = 0; m < 4; ++m) af[ks][m] = *(const bf16x8*)(As + lds_off(wr * 64 + 16 * m + fr, ks * 4 + fq));
#pragma unroll
        for (int n = 0; n < 4; ++n) {
          const int brow = BSPLIT ? ((n >> 1) * 64 + wc * 32 + (n & 1) * 16 + fr) : (wc * 64 + 16 * n + fr);
          bfr[ks][n] = *(const bf16x8*)(Bs + lds_off(brow, ks * 4 + fq));
        }
      }
#pragma unroll
      for (int ks = 0; ks < 2; ++ks)
#pragma unroll
        for (int m = 0; m < 4; ++m)
#pragma unroll
          for (int n = 0; n < 4; ++n) acc[m][n] = __builtin_amdgcn_mfma_f32_16x16x32_bf16(bfr[ks][n], af[ks][m], acc[m][n], 0, 0, 0);
      __builtin_amdgcn_sched_group_barrier(0x100, 8, 0);
#pragma unroll
      for (int i = 0; i < 8; ++i) { __builtin_amdgcn_sched_group_barrier(0x008, 2, 0); __builtin_amdgcn_sched_group_barrier(0x100, 1, 0); }
      __builtin_amdgcn_sched_group_barrier(0x008, 16, 0);
    }
    __builtin_amdgcn_sched_barrier(0);
    asm volatile("s_waitcnt vmcnt(0)" ::: "memory");
    __syncthreads();
  }
}
template <bool BSPLIT>
__device__ __forceinline__ void gemm_mainloop(const GemmTile& g, const GemmTile& gnext, bool hasnext, bool preloaded, char* smem, f32x4 (&acc)[4][4]) {
  const float dummy[4] = {1.f, 1.f, 1.f, 1.f};
  gemm_mainloop_t<BSPLIT, false>(g, gnext, hasnext, preloaded, smem, acc, -1, dummy);
}

struct TileMap { int base, ntl, lb, nlb; };
__device__ __forceinline__ TileMap tm_init(int nMt, int nNt) {
  TileMap t;
  if ((gridDim.x & 7) == 0) {
    const int xcd = blockIdx.x & 7;
    t.lb = blockIdx.x >> 3; t.nlb = gridDim.x >> 3;
    const int mlo = (nMt * xcd) >> 3, mhi = (nMt * (xcd + 1)) >> 3;
    t.base = mlo * nNt; t.ntl = (mhi - mlo) * nNt;
  } else { t.lb = blockIdx.x; t.nlb = gridDim.x; t.base = 0; t.ntl = nMt * nNt; }
  return t;
}
__device__ __forceinline__ int tm_tile(const TileMap& t, int j) { const int li = t.lb + t.nlb * j; return li < t.ntl ? t.base + li : -1; }
__device__ void phase_inproj(const MP& p, int l, char* smem) {
  const int tid = launder(threadIdx.x), lane = tid & 63, wave = tid >> 6, wr = wave >> 1, wc = wave & 1, fr = lane & 15, fq = lane >> 4;
  const int r0 = tid >> 3;
  const int ntiles = (T / 128) * (INW / 128);
  const bf16_t* W = p.WinT() + (size_t)l * INW * D;
  auto make = [&](int tile, GemmTile& g) {
    const int m0 = (tile / 10) * 128, n0 = (tile % 10) * 128;
    g.A0 = p.h(); g.A1 = p.h(); g.lda = D; g.ksA = D; g.K = D;
#pragma unroll
    for (int i = 0; i < 4; ++i) g.arow[i] = m0 + r0 + 32 * i;
    g.Blo0 = W + (size_t)n0 * D; g.Bhi0 = g.Blo0 + (size_t)64 * D; g.Blo1 = g.Blo0; g.Bhi1 = g.Bhi0;
    g.ldb = D; g.ksB = D;
  };
  GemmTile g, gn; bool pre = false;
  const TileMap tmap = tm_init(T / 128, INW / 128);
  { const int t0 = tm_tile(tmap, 0); if (t0 >= 0) { make(t0, g); gn = g; } }
  for (int jt = 0; ; ++jt) {
    const int tile = tm_tile(tmap, jt); if (tile < 0) break;
    const int mt = tile / 10, nt = tile % 10, m0 = mt * 128;
    const int nxt = tm_tile(tmap, jt + 1); const bool hasn = nxt >= 0;
    if (hasn) make(nxt, gn);
    f32x4 acc[4][4];
    gemm_mainloop<false>(g, gn, hasn, pre, smem, acc);
    pre = hasn; g = gn;
    const int rowb = m0 + wr * 64 + fr;
    if (nt <= 4) {
      const float* gv = (nt < 4 ? p.in.q_norm_g : p.in.k_norm_g) + l * HD;
      const float scl = nt < 4 ? 0.125f : 1.f;
      f32x4 g1[2], g2[2];
#pragma unroll
      for (int n = 0; n < 2; ++n) { g1[n] = *(const f32x4*)(gv + 16 * n + 4 * fq); g2[n] = *(const f32x4*)(gv + 32 + 16 * n + 4 * fq); }
#pragma unroll
      for (int m = 0; m < 4; ++m) {
        const int t = rowb + 16 * m;
        float ss = 0.f;
#pragma unroll
        for (int n = 0; n < 4; ++n)
#pragma unroll
          for (int j = 0; j < 4; ++j) ss += acc[m][n][j] * acc[m][n][j];
        ss += __shfl_xor(ss, 16); ss += __shfl_xor(ss, 32);
        const float rinv = rsqrtf(ss * (1.f / 64.f) + EPS) * scl;
        bf16_t* dst = nt < 4 ? (p.q() + (size_t)t * AW + (2 * nt + wc) * 64) : (p.k() + (size_t)t * 128 + wc * 64);
#pragma unroll
        for (int n = 0; n < 2; ++n) {
          const int c = 16 * n + 4 * fq;
          const f32x4 csa = *(const f32x4*)((const float*)p.cs() + ((size_t)t * 32 + c) * 2);
          const f32x4 csb = *(const f32x4*)((const float*)p.cs() + ((size_t)t * 32 + c + 2) * 2);
          const float cn[4] = {csa[0], csa[2], csb[0], csb[2]}, sn[4] = {csa[1], csa[3], csb[1], csb[3]};
          float o1[4], o2[4];
#pragma unroll
          for (int j = 0; j < 4; ++j) {
            const float x1 = acc[m][n][j] * rinv * g1[n][j], x2 = acc[m][n + 2][j] * rinv * g2[n][j];
            o1[j] = x1 * cn[j] - x2 * sn[j]; o2[j] = x2 * cn[j] + x1 * sn[j];
          }
          *(u32x2*)(dst + c) = (u32x2){pack2(o1[0], o1[1]), pack2(o1[2], o1[3])};
          *(u32x2*)(dst + 32 + c) = (u32x2){pack2(o2[0], o2[1]), pack2(o2[2], o2[3])};
        }
      }
    } else if (nt == 5) {
      const int b = m0 / S;
#pragma unroll
      for (int m = 0; m < 4; ++m) {
        const int s = (rowb + 16 * m) % S;
        const int k16 = s & 15;
        const int sp = (s & ~15) | (k16 & 3) | (((k16 >> 3) & 1) << 2) | (((k16 >> 2) & 1) << 3);
#pragma unroll
        for (int n = 0; n < 4; ++n)
#pragma unroll
          for (int j = 0; j < 4; ++j) {
            const int d = 16 * n + 4 * fq + j;
            p.vT()[((size_t)(b * 2 + wc) * 64 + d) * S + sp] = (bf16_t)(pack2(acc[m][n][j], 0.f) & 0xffffu);
          }
      }
    } else {
#pragma unroll
      for (int m = 0; m < 4; ++m) {
        const int t = rowb + 16 * m;
#pragma unroll
        for (int n = 0; n < 4; ++n)
          *(u32x2*)(p.u() + (size_t)t * SW + (nt - 6) * 128 + wc * 64 + 16 * n + 4 * fq) = (u32x2){pack2(acc[m][n][0], acc[m][n][1]), pack2(acc[m][n][2], acc[m][n][3])};
      }
    }
  }
}

__device__ __forceinline__ int crow32(int r, int hf) { return (r & 3) + 8 * (r >> 2) + 4 * hf; }
__device__ void attn_task(const MP& p, int l, int task, int lane) {
  lane = launder(lane);
  task = __builtin_amdgcn_readfirstlane(task);
  const int h = task & 7, qt = (task >> 3) & 63, b = task >> 9, kvh = h >> 2;
  const int s0 = qt * 32, t0 = b * S + s0, ql = lane & 31, hf = lane >> 5;
  int kst[5];
#pragma unroll
  for (int kt = 0; kt < 5; ++kt) { const int ks = s0 - 128 + 32 * kt; kst[kt] = ks < 0 ? 0 : ks; }
  bf16x8 qf[4], kf[5][4];
#pragma unroll
  for (int st = 0; st < 4; ++st) qf[st] = *(const bf16x8*)(p.q() + (size_t)(t0 + ql) * AW + h * 64 + 16 * st + 8 * hf);
#pragma unroll
  for (int kt = 0; kt < 5; ++kt)
#pragma unroll
    for (int st = 0; st < 4; ++st) kf[kt][st] = *(const bf16x8*)(p.k() + (size_t)(b * S + kst[kt] + ql) * 128 + kvh * 64 + 8 * hf + 16 * st);
  f32x16 sc[5];
#pragma unroll
  for (int kt = 0; kt < 5; ++kt) {
#pragma unroll
    for (int r = 0; r < 16; ++r) sc[kt][r] = 0.f;
#pragma unroll
    for (int st = 0; st < 4; ++st) sc[kt] = __builtin_amdgcn_mfma_f32_32x32x16_bf16(kf[kt][st], qf[st], sc[kt], 0, 0, 0);
  }
  bf16x8 vb[5][2][2];
#pragma unroll
  for (int kt = 0; kt < 5; ++kt)
#pragma unroll
    for (int s = 0; s < 2; ++s)
#pragma unroll
      for (int dt = 0; dt < 2; ++dt)
        vb[kt][s][dt] = *(const bf16x8*)(p.vT() + ((size_t)(b * 2 + kvh) * 64 + 32 * dt + ql) * S + kst[kt] + 16 * s + 8 * hf);
  const float sink = p.in.attn_sink[l * NQ + h];
  float mx = sink;
#pragma unroll
  for (int kt = 0; kt < 5; ++kt) {
#pragma unroll
    for (int r = 0; r < 16; ++r) {
      const int kp = s0 - 128 + 32 * kt + crow32(r, hf);
      const int dk = kp - (s0 + ql);
      const bool valid = kp >= 0 && dk <= 0 && dk > -128;
      sc[kt][r] = valid ? sc[kt][r] : -1e30f;
      mx = fmaxf(mx, sc[kt][r]);
    }
  }
  mx = xhalf_max(mx);
  float lsum = 0.f;
#pragma unroll
  for (int kt = 0; kt < 5; ++kt) {
#pragma unroll
    for (int r = 0; r < 16; ++r) { const float e = __expf(sc[kt][r] - mx); sc[kt][r] = e; lsum += e; }
  }
  lsum = xhalf_sum(lsum);
  lsum += __expf(sink - mx);
  const float inv = 1.f / lsum;
  f32x16 o[2];
#pragma unroll
  for (int r = 0; r < 16; ++r) { o[0][r] = 0.f; o[1][r] = 0.f; }
#pragma unroll
  for (int kt = 0; kt < 5; ++kt) {
#pragma unroll
    for (int s = 0; s < 2; ++s) {
      u32x4 pw;
#pragma unroll
      for (int j = 0; j < 4; ++j) pw[j] = pack2(sc[kt][8 * s + 2 * j], sc[kt][8 * s + 2 * j + 1]);
      const bf16x8 pa = __builtin_bit_cast(bf16x8, pw);
#pragma unroll
      for (int dt = 0; dt < 2; ++dt) o[dt] = __builtin_amdgcn_mfma_f32_32x32x16_bf16(vb[kt][s][dt], pa, o[dt], 0, 0, 0);
    }
  }
  bf16_t* dst = p.attn() + (size_t)(t0 + ql) * AW + h * 64 + 4 * hf;
  float ssq = 0.f;
#pragma unroll
  for (int dt = 0; dt < 2; ++dt)
#pragma unroll
    for (int g4 = 0; g4 < 4; ++g4) {
      const float a0 = o[dt][4 * g4] * inv, a1 = o[dt][4 * g4 + 1] * inv, a2 = o[dt][4 * g4 + 2] * inv, a3 = o[dt][4 * g4 + 3] * inv;
      ssq += (a0 * a0 + a1 * a1) + (a2 * a2 + a3 * a3);
      *(u32x2*)(dst + 32 * dt + 8 * g4) = (u32x2){pack2(a0, a1), pack2(a2, a3)};
    }
  ssq = xhalf_sum(ssq);
  if (hf == 0) p.ssqa()[(size_t)(t0 + ql) * 8 + h] = ssq;
}
constexpr int SSEG = 4, SEGLEN = S / SSEG, SEGCH = SEGLEN / 32;

__device__ __forceinline__ void ssm_bu(const bf16x8& ua, const bf16x8 (&bB)[4], f32x16 (&bu)[4]) {
#pragma unroll
  for (int nt = 0; nt < 4; ++nt) {
#pragma unroll
    for (int r = 0; r < 16; ++r) bu[nt][r] = 0.f;
    bu[nt] = __builtin_amdgcn_mfma_f32_32x32x16_bf16(ua, bB[nt], bu[nt], 0, 0, 0);
  }
  asm volatile("s_nop 15\n\ts_nop 7" : "+v"(bu[0]), "+v"(bu[1]), "+v"(bu[2]), "+v"(bu[3]));
#pragma unroll
  for (int r = 0; r < 16; ++r) {
    auto s0 = __builtin_amdgcn_permlane32_swap(__float_as_uint(bu[0][r]), __float_as_uint(bu[1][r]), false, false);
    bu[0][r] = __uint_as_float(s0[0]); bu[1][r] = __uint_as_float(s0[1]);
    auto s1 = __builtin_amdgcn_permlane32_swap(__float_as_uint(bu[2][r]), __float_as_uint(bu[3][r]), false, false);
    bu[2][r] = __uint_as_float(s1[0]); bu[3][r] = __uint_as_float(s1[1]);
  }
}

__device__ void ssm_block(const MP& p, int l, int b, int g, int tid, char* smem) {
  const int lane = tid & 63, seg = tid >> 6;
  char* wl = smem + seg * 8192;
  float* fin = (float*)(smem + 4 * 8192);
  const int lg = l * SG + g, hf = lane >> 5, fr = lane & 15, fq = lane >> 4;
  const float ar = p.ssmL()[(lg * SP + lane) * 2], ai = p.ssmL()[(lg * SP + lane) * 2 + 1];
  bf16x8 bB[4], cB[4];
#pragma unroll
  for (int nt = 0; nt < 4; ++nt) bB[nt] = *(const bf16x8*)(p.ssmB() + ((size_t)lg * 128 + nt * 32 + (lane & 31)) * 16 + 8 * hf);
#pragma unroll
  for (int ks = 0; ks < 4; ++ks) cB[ks] = *(const bf16x8*)(p.ssmC() + ((size_t)lg * 16 + fr) * 128 + 32 * ks + 8 * fq);
  const f32x4 dsk = *(const f32x4*)(p.in.ssm_d + l * SW + g * 16 + 4 * fq);
  const int t0 = b * S + seg * SEGLEN;
  const bf16_t* urow = p.u() + (size_t)(t0 + (lane & 31)) * SW + g * 16 + 8 * hf;
  float xr = 0.f, xi = 0.f;
  if (seg < SSEG - 1) {
    bf16x8 ua = *(const bf16x8*)(urow);
    for (int c = 0; c < SEGCH; ++c) {
      const bf16x8 un = *(const bf16x8*)(urow + (size_t)((c + 1 < SEGCH ? c + 1 : c) * 32) * SW);
      f32x16 bu[4];
      ssm_bu(ua, bB, bu);
#pragma unroll
      for (int r4 = 0; r4 < 4; ++r4)
#pragma unroll
        for (int half = 0; half < 2; ++half)
#pragma unroll
          for (int j = 0; j < 4; ++j) {
            const int r = 4 * r4 + j;
            const float bre = half ? bu[1][r] : bu[0][r], bim = half ? bu[3][r] : bu[2][r];
            const float nr = ar * xr - ai * xi + bre, ni = ar * xi + ai * xr + bim;
            xr = nr; xi = ni;
          }
      ua = un;
    }
  }
  fin[(seg * 64 + lane) * 2] = xr; fin[(seg * 64 + lane) * 2 + 1] = xi;
  __syncthreads();
  {
    float pr = ar, pi = ai;
#pragma unroll
    for (int i = 0; i < 9; ++i) { const float nr = pr * pr - pi * pi, ni = 2.f * pr * pi; pr = nr; pi = ni; }
    static_assert(SEGLEN == 512, "lam^SEGLEN squaring count");
    float cr = 0.f, ci = 0.f;
    for (int j = 0; j < seg; ++j) {
      const float fr_ = fin[(j * 64 + lane) * 2], fi_ = fin[(j * 64 + lane) * 2 + 1];
      const float nr = pr * cr - pi * ci + fr_, ni = pr * ci + pi * cr + fi_;
      cr = nr; ci = ni;
    }
    xr = cr; xi = ci;
  }
  const int wbase = (lane & 3) * 4;
  const int pch = lane >> 2;
  const bf16_t* uep = p.u() + (size_t)(t0 + fr) * SW + g * 16 + 4 * fq;
  bf16x8 ua = *(const bf16x8*)(urow);
  u32x2 uraw[2];
#pragma unroll
  for (int i = 0; i < 2; ++i) uraw[i] = *(const u32x2*)(uep + (size_t)(16 * i) * SW);
  for (int c = 0; c < SEGCH; ++c) {
    const int tb = t0 + c * 32;
    const int cn = (c + 1 < SEGCH ? c + 1 : c) * 32;
    const bf16x8 un = *(const bf16x8*)(urow + (size_t)cn * SW);
    u32x2 unraw[2];
#pragma unroll
    for (int i = 0; i < 2; ++i) unraw[i] = *(const u32x2*)(uep + (size_t)(cn + 16 * i) * SW);
    f32x16 bu[4];
    ssm_bu(ua, bB, bu);
#pragma unroll
    for (int r4 = 0; r4 < 4; ++r4) {
#pragma unroll
      for (int half = 0; half < 2; ++half) {
#pragma unroll
        for (int j = 0; j < 4; ++j) {
          const int t = 8 * r4 + 4 * half + j, r = 4 * r4 + j;
          const float bre = half ? bu[1][r] : bu[0][r], bim = half ? bu[3][r] : bu[2][r];
          const float nr = ar * xr - ai * xi + bre, ni = ar * xi + ai * xr + bim;
          xr = nr; xi = ni;
          *(unsigned*)(wl + t * 256 + ((pch ^ (t & 15)) << 4) + wbase) = pack2(nr, ni);
        }
      }
    }
    asm volatile("s_waitcnt lgkmcnt(0)" ::: "memory");
#pragma unroll
    for (int mt = 0; mt < 2; ++mt) {
      f32x4 acc = {0.f, 0.f, 0.f, 0.f};
      const int t = 16 * mt + fr;
#pragma unroll
      for (int ks = 0; ks < 4; ++ks) {
        const bf16x8 af = *(const bf16x8*)(wl + t * 256 + (((4 * ks + fq) ^ (t & 15)) << 4));
        acc = __builtin_amdgcn_mfma_f32_16x16x32_bf16(cB[ks], af, acc, 0, 0, 0);
      }
      const float uu[4] = {bf_lo(uraw[mt][0]), bf_hi(uraw[mt][0]), bf_lo(uraw[mt][1]), bf_hi(uraw[mt][1])};
      float ge[4];
#pragma unroll
      for (int j = 0; j < 4; ++j) {
        const float v = acc[j] + dsk[j] * uu[j];
        const float z2 = 1.5957691216057308f * (v + 0.044715f * v * v * v);
        ge[j] = v * __builtin_amdgcn_rcpf(1.f + __expf(-z2));
      }
      *(u32x2*)(p.y() + (size_t)(tb + t) * SW + g * 16 + 4 * fq) = (u32x2){pack2(ge[0], ge[1]), pack2(ge[2], ge[3])};
    }
    asm volatile("s_waitcnt lgkmcnt(0)" ::: "memory");
    ua = un;
#pragma unroll
    for (int i = 0; i < 2; ++i) uraw[i] = unraw[i];
  }
}

__device__ void phase_attn(const MP& p, int l) {
  const int tid = launder(threadIdx.x);
  const int wave = tid >> 6, lane = tid & 63;
  for (int task = blockIdx.x * 4 + wave; task < NB * 64 * 8; task += gridDim.x * 4) attn_task(p, l, task, lane);
}
__device__ void phase_ssm(const MP& p, int l, char* smem, int wid) {
  const int tid = launder(threadIdx.x);
  if (wid < 0) return;
  const int nw = (int)__hip_atomic_load(p.claim() + 4096, __ATOMIC_RELAXED, __HIP_MEMORY_SCOPE_AGENT);
  for (int task = wid; task < NB * SG; task += nw) {
    ssm_block(p, l, task / SG, task % SG, tid, smem);
    __syncthreads();
  }
}
__device__ void phase_glu(const MP& p, int l, char* smem) {
  const int tid = launder(threadIdx.x), lane = tid & 63, wave = tid >> 6, wr = wave >> 1, wc = wave & 1, fr = lane & 15, fq = lane >> 4;
  const int r0 = tid >> 3;
  const int ntiles = (T / 128) * (SW / 128);
  const bf16_t* W = p.WgluT() + (size_t)l * SW * SW;
  auto make = [&](int tile, GemmTile& g) {
    const int m0 = (tile >> 2) * 128, n0 = (tile & 3) * 128;
    g.A0 = p.y(); g.A1 = p.y(); g.lda = SW; g.ksA = SW; g.K = SW;
#pragma unroll
    for (int i = 0; i < 4; ++i) g.arow[i] = m0 + r0 + 32 * i;
    g.Blo0 = W + (size_t)n0 * SW; g.Bhi0 = g.Blo0 + (size_t)64 * SW; g.Blo1 = g.Blo0; g.Bhi1 = g.Bhi0;
    g.ldb = SW; g.ksB = SW;
  };
  GemmTile g, gn; bool pre = false;
  const TileMap tmap = tm_init(T / 128, SW / 128);
  { const int t0 = tm_tile(tmap, 0); if (t0 >= 0) { make(t0, g); gn = g; } }
  for (int jt = 0; ; ++jt) {
    const int tile = tm_tile(tmap, jt); if (tile < 0) break;
    const int mt = tile >> 2, nt = tile & 3, m0 = mt * 128, n0 = nt * 128;
    const int nxt = tm_tile(tmap, jt + 1); const bool hasn = nxt >= 0;
    if (hasn) make(nxt, gn);
    f32x4 acc[4][4];
    gemm_mainloop<false>(g, gn, hasn, pre, smem, acc);
    pre = hasn; g = gn;
#pragma unroll
    for (int m = 0; m < 4; ++m) {
      const int t = m0 + wr * 64 + 16 * m + fr;
      float ss = 0.f;
#pragma unroll
      for (int n = 0; n < 4; ++n) {
        const int col = n0 + wc * 64 + 16 * n + 4 * fq;
        const u32x2 yr = *(const u32x2*)(p.y() + (size_t)t * SW + col);
        const float yv[4] = {bf_lo(yr[0]), bf_hi(yr[0]), bf_lo(yr[1]), bf_hi(yr[1])};
        float o[4];
#pragma unroll
        for (int j = 0; j < 4; ++j) { o[j] = yv[j] * __builtin_amdgcn_rcpf(1.f + __expf(-acc[m][n][j])); ss += o[j] * o[j]; }
        *(u32x2*)(p.ssm() + (size_t)t * SW + col) = (u32x2){pack2(o[0], o[1]), pack2(o[2], o[3])};
      }
      ss += __shfl_xor(ss, 16); ss += __shfl_xor(ss, 32);
      if (fq == 0) p.ssqs()[(size_t)t * 8 + nt * 2 + wc] = ss;
    }
  }
}

__device__ void phase_out(const MP& p, int l, char* smem, const float* xin) {
  const int tid = launder(threadIdx.x), lane = tid & 63, wave = tid >> 6, wr = wave >> 1, wc = wave & 1, fr = lane & 15, fq = lane >> 4;
  const int r0 = tid >> 3;
  const float* modl = p.mod() + (size_t)l * 8 * 6144;
  const int ntiles = (T / 128) * (D / 128);
  const bf16_t* W = p.WoutT() + (size_t)l * D * D;
  auto make = [&](int tile, GemmTile& g) {
    const int m0 = (tile >> 3) * 128, n0 = (tile & 7) * 128;
    g.A0 = p.attn(); g.A1 = p.ssm(); g.lda = AW; g.ksA = AW; g.K = D;
#pragma unroll
    for (int i = 0; i < 4; ++i) g.arow[i] = m0 + r0 + 32 * i;
    g.Blo0 = W + (size_t)n0 * D; g.Bhi0 = g.Blo0 + (size_t)64 * D; g.Blo1 = g.Blo0; g.Bhi1 = g.Bhi0;
    g.ldb = D; g.ksB = D;
  };
  GemmTile g, gn; bool pre = false;
  const TileMap tmap = tm_init(T / 128, D / 128);
  { const int t0 = tm_tile(tmap, 0); if (t0 >= 0) { make(t0, g); gn = g; } }
  for (int jt = 0; ; ++jt) {
    const int tile = tm_tile(tmap, jt); if (tile < 0) break;
    const int mt = tile >> 3, nt = tile & 7, m0 = mt * 128, n0 = nt * 128, b = m0 / S;
    const int nxt = tm_tile(tmap, jt + 1); const bool hasn = nxt >= 0;
    if (hasn) make(nxt, gn);
    float mids[4], rs[4];
#pragma unroll
    for (int m = 0; m < 4; ++m) {
      const int t = m0 + wr * 64 + 16 * m + fr;
      const f32x4 a0 = *(const f32x4*)(p.ssqa() + (size_t)t * 8), a1 = *(const f32x4*)(p.ssqa() + (size_t)t * 8 + 4);
      const f32x4 s0 = *(const f32x4*)(p.ssqs() + (size_t)t * 8), s1 = *(const f32x4*)(p.ssqs() + (size_t)t * 8 + 4);
      const float sa = ((a0[0] + a0[1]) + (a0[2] + a0[3])) + ((a1[0] + a1[1]) + (a1[2] + a1[3]));
      const float sq = ((s0[0] + s0[1]) + (s0[2] + s0[3])) + ((s1[0] + s1[1]) + (s1[2] + s1[3]));
      const float ra = rsqrtf(sa * (1.f / 512.f) + EPS);
      rs[m] = rsqrtf(sq * (1.f / 512.f) + EPS);
      mids[m] = ra / rs[m];
    }
    f32x4 acc[4][4];
    gemm_mainloop_t<false, true>(g, gn, hasn, pre, smem, acc, 8, mids);
    pre = hasn; g = gn;
#pragma unroll
    for (int m = 0; m < 4; ++m) {
      const int t = m0 + wr * 64 + 16 * m + fr;
#pragma unroll
      for (int n = 0; n < 4; ++n) {
        const int col = n0 + wc * 64 + 16 * n + 4 * fq;
        const f32x4 xv = *(const f32x4*)(xin + (size_t)t * D + col);
        const f32x4 g1 = *(const f32x4*)(modl + (size_t)b * 6144 + 2 * 1024 + col);
        f32x4 o;
#pragma unroll
        for (int j = 0; j < 4; ++j) o[j] = xv[j] + g1[j] * (acc[m][n][j] * rs[m]);
        *(u32x2*)(p.x1() + (size_t)t * D + col) = (u32x2){pack2(o[0], o[1]), pack2(o[2], o[3])};
      }
    }
  }
}
__device__ void phase_norm2_route(const MP& p, int l, char* smem) {
  const int tid = launder(threadIdx.x);
  const int wave = tid >> 6, lane = tid & 63;
  float* wrT = (float*)smem;
  for (int i = tid; i < 1024 * 4; i += NTHR) {
    const int k = i >> 2, e4 = (i & 3) * 4;
    const float4 v = *(const float4*)(p.in.w_router + (size_t)k * 16 + e4);
    wrT[(e4 + 0) * 1024 + k] = v.x; wrT[(e4 + 1) * 1024 + k] = v.y; wrT[(e4 + 2) * 1024 + k] = v.z; wrT[(e4 + 3) * 1024 + k] = v.w;
  }
  __syncthreads();
  const float* modl = p.mod() + (size_t)l * 8 * 6144;
  float rb[16];
#pragma unroll
  for (int e = 0; e < 16; ++e) rb[e] = p.in.router_bias[e];
  int* cntl = p.cnt() + l * 256;
  int my_t = -1, my_bucket = 0; float my_wlo = 0.f, my_whi = 0.f;
  const float* g2n = p.in.norm2_g + l * D;
  const int tstep = gridDim.x * 4;
  int t = blockIdx.x * 4 + wave;
  float4 xv[4];
  if (t < T) {
#pragma unroll
    for (int i = 0; i < 4; ++i) { const u32x2 r = *(const u32x2*)(p.x1() + (size_t)t * D + lane * 4 + 256 * i); xv[i] = make_float4(bf_lo(r[0]), bf_hi(r[0]), bf_lo(r[1]), bf_hi(r[1])); }
  }
  for (int slot = 0; t < T; t += tstep, ++slot) {
    const int b = t / S;
    float4 xn[4];
    const int tn = t + tstep < T ? t + tstep : t;
#pragma unroll
    for (int i = 0; i < 4; ++i) { const u32x2 r = *(const u32x2*)(p.x1() + (size_t)tn * D + lane * 4 + 256 * i); xn[i] = make_float4(bf_lo(r[0]), bf_hi(r[0]), bf_lo(r[1]), bf_hi(r[1])); }
    float ss = 0.f;
#pragma unroll
    for (int i = 0; i < 4; ++i) ss += xv[i].x * xv[i].x + xv[i].y * xv[i].y + xv[i].z * xv[i].z + xv[i].w * xv[i].w;
    ss = wave_sum(ss);
    const float rinv = rsqrtf(ss * (1.f / D) + EPS);
    const float* sh = modl + (size_t)b * 6144 + 3 * 1024; const float* sc = modl + (size_t)b * 6144 + 4 * 1024;
    float hv[16];
#pragma unroll
    for (int i = 0; i < 4; ++i) {
      const int d = lane * 4 + 256 * i;
      const float4 gg = *(const float4*)(g2n + d), s1 = *(const float4*)(sc + d), s0 = *(const float4*)(sh + d);
      hv[4 * i + 0] = xv[i].x * rinv * gg.x * (1.f + s1.x) + s0.x;
      hv[4 * i + 1] = xv[i].y * rinv * gg.y * (1.f + s1.y) + s0.y;
      hv[4 * i + 2] = xv[i].z * rinv * gg.z * (1.f + s1.z) + s0.z;
      hv[4 * i + 3] = xv[i].w * rinv * gg.w * (1.f + s1.w) + s0.w;
      *(u32x2*)(p.h() + (size_t)t * D + d) = (u32x2){pack2(hv[4 * i], hv[4 * i + 1]), pack2(hv[4 * i + 2], hv[4 * i + 3])};
    }
    float a[16];
    const int loff = launder(lane * 4);
#pragma unroll
    for (int e = 0; e < 16; ++e) {
      float s = 0.f;
#pragma unroll
      for (int i = 0; i < 4; ++i) {
        const f32x4 w = *(const f32x4*)(wrT + e * 1024 + loff + 256 * i);
        s += hv[4 * i] * w[0] + hv[4 * i + 1] * w[1] + hv[4 * i + 2] * w[2] + hv[4 * i + 3] * w[3];
      }
      a[e] = s;
    }
    float lg[16];
#pragma unroll
    for (int e = 0; e < 16; ++e) lg[e] = wave_sum(a[e]);
    float mx = lg[0];
#pragma unroll
    for (int e = 1; e < 16; ++e) mx = fmaxf(mx, lg[e]);
    float pr[16], sel[16]; float sum = 0.f;
#pragma unroll
    for (int e = 0; e < 16; ++e) { pr[e] = __expf(lg[e] - mx); sum += pr[e]; }
    const float inv = 1.f / sum;
#pragma unroll
    for (int e = 0; e < 16; ++e) { pr[e] *= inv; sel[e] = pr[e] + rb[e]; }
    int gbest = 0; float gbs = -1e30f;
#pragma unroll
    for (int g = 0; g < 4; ++g) {
      float m1 = -1e30f, m2 = -1e30f;
#pragma unroll
      for (int j = 0; j < 4; ++j) { const float v = sel[g * 4 + j]; if (v > m1) { m2 = m1; m1 = v; } else if (v > m2) m2 = v; }
      const float gs = m1 + m2;
      if (gs > gbs) { gbs = gs; gbest = g; }
    }
    float s4[4], p4[4];
#pragma unroll
    for (int j = 0; j < 4; ++j) { s4[j] = sel[j]; p4[j] = pr[j]; }
#pragma unroll
    for (int g = 1; g < 4; ++g) if (g == gbest) {
#pragma unroll
      for (int j = 0; j < 4; ++j) { s4[j] = sel[g * 4 + j]; p4[j] = pr[g * 4 + j]; }
    }
    int i0 = 0; float b0 = s4[0];
#pragma unroll
    for (int j = 1; j < 4; ++j) if (s4[j] > b0) { b0 = s4[j]; i0 = j; }
    int i1 = -1; float bb1 = -1e30f;
#pragma unroll
    for (int j = 0; j < 4; ++j) if (j != i0 && s4[j] > bb1) { bb1 = s4[j]; i1 = j; }
    float p0 = 0.f, p1 = 0.f;
#pragma unroll
    for (int j = 0; j < 4; ++j) { if (j == i0) p0 = p4[j]; if (j == i1) p1 = p4[j]; }
    const float w0 = p0 / (p0 + p1), w1 = p1 / (p0 + p1);
    const int lo = i0 < i1 ? i0 : i1, hi = i0 < i1 ? i1 : i0;
    const float wlo = i0 < i1 ? w0 : w1, whi = i0 < i1 ? w1 : w0;
    const int pidx = (lo == 0) ? (hi - 1) : (lo == 1 ? (hi + 1) : 5);
    const int bucket = gbest * 6 + pidx;
    if (lane == slot) { my_t = t; my_bucket = bucket; my_wlo = wlo; my_whi = whi; }
#pragma unroll
    for (int i = 0; i < 4; ++i) xv[i] = xn[i];
  }
  if (my_t >= 0) {
    const int sl = my_bucket * NSUBL + (blockIdx.x & (NSUBL - 1));
    const int pos = atomicAdd(&cntl[sl], 1);
    p.list()[(size_t)sl * T + pos] = my_t;
    p.tokw()[my_t] = make_float2(my_wlo, my_whi);
  }
  __syncthreads();
}

__device__ __forceinline__ void bucket_experts2(int bucket, int& elo, int& ehi) {
  const int g = bucket / 6, pi = bucket % 6;
  const int lo = pi < 3 ? 0 : (pi < 5 ? 1 : 2);
  const int hi = pi < 3 ? pi + 1 : (pi < 5 ? pi - 1 : 3);
  elo = g * 4 + lo; ehi = g * 4 + hi;
}
__device__ __forceinline__ void moe_map_build(const int* cnt, int* mm, int tid) {
  if (tid < NBUCKET) {
    int acc = 0;
#pragma unroll
    for (int x = 0; x < NSUBL; ++x) { mm[32 + 16 * tid + x] = acc; acc += cnt[tid * NSUBL + x]; }
    mm[32 + 16 * tid + 8] = acc;
  }
  __syncthreads();
  if (tid == 0) {
    int acc = 0;
    for (int bk = 0; bk < NBUCKET; ++bk) { mm[bk] = acc; acc += (mm[32 + 16 * bk + 8] + TM - 1) / TM; }
    mm[NBUCKET] = acc;
  }
  __syncthreads();
}
__device__ __forceinline__ void moe_find_tile(const int* mm, int mt, int& bucket, int& tib, int& nrow) {
  int bk = 0;
#pragma unroll
  for (int j = 1; j < NBUCKET; ++j) bk += (mt >= mm[j]) ? 1 : 0;
  bucket = bk; tib = mt - mm[bk]; nrow = mm[32 + 16 * bk + 8] - tib * TM;
}
__device__ __forceinline__ int moe_token(const int* list, const int* mm, int bk, int q) {
  const int* sp = mm + 32 + 16 * bk;
  int x = 0, s = 0;
#pragma unroll
  for (int j = 1; j < NSUBL; ++j) { const int v = sp[j]; const bool ge = q >= v; x += ge ? 1 : 0; s = ge ? v : s; }
  return list[(size_t)(bk * NSUBL + x) * T + (q - s)];
}

__device__ void phase_moe_gu(const MP& p, int l, char* smem) {
  const int tid = launder(threadIdx.x), lane = tid & 63, wave = tid >> 6, wr = wave >> 1, wc = wave & 1, fr = lane & 15, fq = lane >> 4;
  const int r0 = tid >> 3;
  int* mm = (int*)(smem + SMEM_MM);
  moe_map_build(p.cnt() + l * 256, mm, tid);
  const int nmt = mm[NBUCKET];
  const int ntiles = nmt * 16;
  auto make = [&](int tile, GemmTile& g) {
    const int mt = tile >> 4, nt = tile & 15;
    int bucket, tib, nrow;
    moe_find_tile(mm, mt, bucket, tib, nrow);
    int elo, ehi; bucket_experts2(bucket, elo, ehi);
    const int e = nt < 8 ? elo : ehi, f0 = (nt & 7) * 64;
    g.A0 = p.h(); g.A1 = p.h(); g.lda = D; g.ksA = D; g.K = D;
    const bf16_t* Wg = p.WgT() + ((size_t)(l * NE + e) * DFF + f0) * D;
    const bf16_t* Wu = p.WuT() + ((size_t)(l * NE + e) * DFF + f0) * D;
#pragma unroll
    for (int i = 0; i < 4; ++i) {
      const int r = r0 + 32 * i;
      g.arow[i] = moe_token(p.list(), mm, bucket, tib * TM + (r < nrow ? r : nrow - 1));
    }
    g.Blo0 = Wg; g.Bhi0 = Wu; g.Blo1 = Wg; g.Bhi1 = Wu;
    g.ldb = D; g.ksB = D;
  };
  GemmTile g, gn; bool pre = false;
  const TileMap tmap = tm_init(nmt, 16);
  { const int t0 = tm_tile(tmap, 0); if (t0 >= 0) { make(t0, g); gn = g; } }
  for (int jt = 0; ; ++jt) {
    const int tile = tm_tile(tmap, jt); if (tile < 0) break;
    const int mt = tile >> 4, nt = tile & 15;
    int bucket, tib, nrow;
    moe_find_tile(mm, mt, bucket, tib, nrow);
    const int f0 = (nt & 7) * 64;
    const int nxt = tm_tile(tmap, jt + 1); const bool hasn = nxt >= 0;
    if (hasn) make(nxt, gn);
    float wv[4];
#pragma unroll
    for (int m = 0; m < 4; ++m) {
      const int r = wr * 64 + 16 * m + fr;
      const float2 ww = p.tokw()[moe_token(p.list(), mm, bucket, tib * TM + (r < nrow ? r : nrow - 1))];
      wv[m] = r < nrow ? (nt < 8 ? ww.x : ww.y) : 0.f;
    }
    f32x4 acc[4][4];
    gemm_mainloop<true>(g, gn, hasn, pre, smem, acc);
    pre = hasn; g = gn;
#pragma unroll
    for (int m = 0; m < 4; ++m) {
      const int r = wr * 64 + 16 * m + fr;
      const float w = wv[m];
      bf16_t* dst = p.act() + (size_t)(mt * TM + r) * D + (nt < 8 ? 0 : 512) + f0 + wc * 32 + 4 * fq;
#pragma unroll
      for (int n = 0; n < 2; ++n) {
        float o[4];
#pragma unroll
        for (int j = 0; j < 4; ++j) { const float gv = acc[m][n][j], uv = acc[m][n + 2][j]; o[j] = gv * __builtin_amdgcn_rcpf(1.f + __expf(-gv)) * uv * w; }
        *(u32x2*)(dst + 16 * n) = (u32x2){pack2(o[0], o[1]), pack2(o[2], o[3])};
      }
    }
  }
}

__device__ void phase_moe_down(const MP& p, int l, char* smem) {
  const int tid = launder(threadIdx.x), lane = tid & 63, wave = tid >> 6, wr = wave >> 1, wc = wave & 1, fr = lane & 15, fq = lane >> 4;
  const int r0 = tid >> 3;
  int* mm = (int*)(smem + SMEM_MM);
  moe_map_build(p.cnt() + l * 256, mm, tid);
  const float* modl = p.mod() + (size_t)l * 8 * 6144;
  const int nmt = mm[NBUCKET];
  const int ntiles = nmt * 8;
  auto make = [&](int tile, GemmTile& g) {
    const int mt = tile >> 3, n0 = (tile & 7) * 128;
    int bucket, tib, nrow;
    moe_find_tile(mm, mt, bucket, tib, nrow);
    int elo, ehi; bucket_experts2(bucket, elo, ehi);
    g.A0 = p.act(); g.A1 = p.act(); g.lda = D; g.ksA = D; g.K = D;
    const bf16_t* Wlo = p.WdT() + ((size_t)(l * NE + elo) * D + n0) * DFF;
    const bf16_t* Whi = p.WdT() + ((size_t)(l * NE + ehi) * D + n0) * DFF;
#pragma unroll
    for (int i = 0; i < 4; ++i) {
      g.arow[i] = mt * TM + r0 + 32 * i;
    }
    g.Blo0 = Wlo; g.Bhi0 = Wlo + (size_t)64 * DFF; g.Blo1 = Whi; g.Bhi1 = Whi + (size_t)64 * DFF;
    g.ldb = DFF; g.ksB = DFF;
  };
  GemmTile g, gn; bool pre = false;
  const TileMap tmap = tm_init(nmt, 8);
  { const int t0 = tm_tile(tmap, 0); if (t0 >= 0) { make(t0, g); gn = g; } }
  for (int jt = 0; ; ++jt) {
    const int tile = tm_tile(tmap, jt); if (tile < 0) break;
    const int mt = tile >> 3, nt = tile & 7, n0 = nt * 128;
    int bucket, tib, nrow;
    moe_find_tile(mm, mt, bucket, tib, nrow);
    const int nxt = tm_tile(tmap, jt + 1); const bool hasn = nxt >= 0;
    if (hasn) make(nxt, gn);
    int tkv[4];
#pragma unroll
    for (int m = 0; m < 4; ++m) {
      const int r = wr * 64 + 16 * m + fr;
      tkv[m] = moe_token(p.list(), mm, bucket, tib * TM + (r < nrow ? r : nrow - 1));
    }
    f32x4 acc[4][4];
    gemm_mainloop<false>(g, gn, hasn, pre, smem, acc);
    pre = hasn; g = gn;
#pragma unroll
    for (int m = 0; m < 4; ++m) {
      const int r = wr * 64 + 16 * m + fr;
      const int tk = tkv[m], b = tk / S;
      f32x4 o[4];
#pragma unroll
      for (int n = 0; n < 4; ++n) {
        const int col = n0 + wc * 64 + 16 * n + 4 * fq;
        const u32x2 xr = *(const u32x2*)(p.x1() + (size_t)tk * D + col);
        const f32x4 xv = {bf_lo(xr[0]), bf_hi(xr[0]), bf_lo(xr[1]), bf_hi(xr[1])};
        const f32x4 g2 = *(const f32x4*)(modl + (size_t)b * 6144 + 5 * 1024 + col);
#pragma unroll
        for (int j = 0; j < 4; ++j) o[n][j] = xv[j] + g2[j] * acc[m][n][j];
      }
      if (r < nrow) {
#pragma unroll
        for (int n = 0; n < 4; ++n) *(f32x4*)(p.out + (size_t)tk * D + n0 + wc * 64 + 16 * n + 4 * fq) = o[n];
      }
    }
  }
}
#define XB_TMO      128
#define XB_XCNT(j)  (256  + 64 * (j))
#define XB_XSUB(j)  (1280 + 64 * (j))
#define XB_XGEN(j)  (2304 + 64 * (j))
#define XB_TOP      3328
#define XB_TOPGEN   3392
#define XCD_BAR_WORDS 3456
#define XB_SPIN_CAP (1u << 22)
#define LAS __attribute__((address_space(3)))

__device__ __forceinline__ unsigned xb_ld(unsigned* p)              { return __hip_atomic_load(p, __ATOMIC_RELAXED, __HIP_MEMORY_SCOPE_AGENT); }
__device__ __forceinline__ unsigned xb_add(unsigned* p, unsigned v) { return __hip_atomic_fetch_add(p, v, __ATOMIC_RELAXED, __HIP_MEMORY_SCOPE_AGENT); }
__device__ __forceinline__ unsigned xb_xcc_id() { return (unsigned)__builtin_amdgcn_s_getreg((3 << 11) | 20) & 0xFu; }
#define XB_SPIN(cond, bar) do { unsigned _sp = 0; while (cond) { __builtin_amdgcn_s_sleep(1); \
    if ((++_sp & 255u) == 0u) { if (xb_ld(&(bar)[XB_TMO])) break; if (_sp > XB_SPIN_CAP) { atomicAdd(&(bar)[XB_TMO], 1u); break; } } } } while (0)

struct XcdBarrier { unsigned* bar; unsigned x; volatile LAS unsigned* st; };

__device__ __forceinline__ XcdBarrier xcd_barrier_post(unsigned* bar, volatile LAS unsigned* st) {
  XcdBarrier b; b.bar = bar; b.x = xb_xcc_id(); b.st = st;
  if (threadIdx.x == 0) (void)xb_add(&bar[XB_XCNT(b.x)], 1u);
  return b;
}
__device__ __forceinline__ void xcd_barrier_complete(unsigned* bar, unsigned x, unsigned& nloc, unsigned& nx) {
  const unsigned G = gridDim.x * gridDim.y * gridDim.z;
  unsigned sum, cnt, mine, sp = 0u;
  for (;;) {
    sum = 0u; cnt = 0u; mine = 0u;
#pragma unroll
    for (unsigned j = 0; j < 16; ++j) { const unsigned c = xb_ld(&bar[XB_XCNT(j)]); sum += c; cnt += (c > 0u) ? 1u : 0u; mine = (j == x) ? c : mine; }
    if (sum == G) break;
    __builtin_amdgcn_s_sleep(1);
    if ((++sp & 255u) == 0u) { if (xb_ld(&bar[XB_TMO])) break; if (sp > XB_SPIN_CAP) { atomicAdd(&bar[XB_TMO], 1u); break; } }
  }
  nloc = mine > 0u ? mine : 1u; nx = cnt > 0u ? cnt : 1u;
}
__device__ __forceinline__ void xcd_barrier(const XcdBarrier& b) {
  asm volatile("s_waitcnt vmcnt(0)" ::: "memory");
  __syncthreads();
  if (threadIdx.x == 0) {
    unsigned* bar = b.bar;
    __builtin_amdgcn_s_waitcnt(0);
    unsigned nloc = b.st[0], nx = b.st[1];
    if (nloc == 0u) { xcd_barrier_complete(bar, b.x, nloc, nx); b.st[0] = nloc; b.st[1] = nx; }
    const unsigned old = xb_add(&bar[XB_XSUB(b.x)], 1u);
    const unsigned gen = old / nloc;
    if (old + 1u == (gen + 1u) * nloc) {
      __builtin_amdgcn_fence(__ATOMIC_RELEASE, "agent");
      asm volatile("s_waitcnt vmcnt(0)" ::: "memory");
      const unsigned og = xb_add(&bar[XB_TOP], 1u);
      const unsigned tg = og / nx;
      if (og + 1u == (tg + 1u) * nx) xb_add(&bar[XB_TOPGEN], 1u);
      else XB_SPIN(xb_ld(&bar[XB_TOPGEN]) == tg, bar);
      __builtin_amdgcn_fence(__ATOMIC_ACQUIRE, "agent");
      xb_add(&bar[XB_XGEN(b.x)], 1u);
      asm volatile("s_waitcnt vmcnt(0)" ::: "memory");
    } else {
      XB_SPIN(xb_ld(&bar[XB_XGEN(b.x)]) == gen, bar);
      __builtin_amdgcn_fence(__ATOMIC_ACQUIRE, "agent");
      asm volatile("s_waitcnt vmcnt(0)" ::: "memory");
    }
  }
  __syncthreads();
}

constexpr int NSUB = 9;

template <int L>
__device__ __forceinline__ void run_layer(const MP& p, char* smem, const XcdBarrier& xb, int ssm_wid, int idle_id) {
  constexpr int l = L;
  const float* xin = L == 0 ? p.in.x : p.out;
  phase_norm1(p, l, xin);          xcd_barrier(xb);
  phase_inproj(p, l, smem);        xcd_barrier(xb);
  phase_attn(p, l);                xcd_barrier(xb);
  phase_ssm(p, l, smem, ssm_wid);
  if (L == 0) {
    const int nidle = (int)__hip_atomic_load(p.claim() + 4097, __ATOMIC_RELAXED, __HIP_MEMORY_SCOPE_AGENT);
    if (nidle == 0) phase0_transposes(p, smem, TT_LAYER, P0_TR, blockIdx.x, gridDim.x);
    else if (idle_id >= 0) phase0_transposes(p, smem, TT_LAYER, P0_TR, launder_s(__builtin_amdgcn_readfirstlane(idle_id)), nidle);
  }
  xcd_barrier(xb);
  phase_glu(p, l, smem);           xcd_barrier(xb);
  phase_out(p, l, smem, xin);      xcd_barrier(xb);
  phase_norm2_route(p, l, smem);   xcd_barrier(xb);
  phase_moe_gu(p, l, smem);        xcd_barrier(xb);
  phase_moe_down(p, l, smem);
  if (L + 1 < DEPTH) xcd_barrier(xb);
}

__global__ void __launch_bounds__(NTHR, 2) mega(MP p) {
  __shared__ __attribute__((aligned(16))) char smem[65536 + 16 + 2048];
  unsigned* xb_words = (unsigned*)(smem + 65536);
  if (threadIdx.x < 4) xb_words[threadIdx.x] = 0u;
  __syncthreads();
  const XcdBarrier xb = xcd_barrier_post(p.bar(), (volatile LAS unsigned*)xb_words);
  if (threadIdx.x == 0) {
    const unsigned key = (xb_xcc_id() << 8) | ((unsigned)__builtin_amdgcn_s_getreg((7 << 11) | (8 << 6) | 4) & 0xffu);
    const unsigned rank = xb_add(p.claim() + key, 1u);
    xb_words[2] = rank == 0u ? xb_add(p.claim() + 4096, 1u) : 0xffffffffu;
    xb_words[3] = rank == 0u ? 0xffffffffu : xb_add(p.claim() + 4097, 1u);
  }
  __syncthreads();
  const int ssm_wid = (int)xb_words[2], idle_id = (int)xb_words[3];
  for (int it = blockIdx.x; it < P0_MISC; it += gridDim.x) phase0_item(p, it, smem);
  phase0_transposes(p, smem, 0, TT_LAYER, blockIdx.x, gridDim.x);
  xcd_barrier(xb);
  run_layer<0>(p, smem, xb, ssm_wid, idle_id);
  run_layer<1>(p, smem, xb, ssm_wid, idle_id);
  static_assert(DEPTH == 2, "two layers instantiated");
}

}

extern "C" void kernel_launch(void* const* d_in, const int* in_sizes, int n_in, void* d_out, int out_size, void* d_ws,
                              size_t ws_size, hipStream_t stream) {
  MP p; memset(&p, 0, sizeof(p));
  Ptrs& P = p.in;
  P.x = (const float*)d_in[0]; P.c = (const float*)d_in[1]; P.pos = (const int*)d_in[2];
  P.ada_w = (const float*)d_in[3]; P.ada_b = (const float*)d_in[4]; P.norm1_g = (const float*)d_in[5];
  P.w_in = (const float*)d_in[6]; P.q_norm_g = (const float*)d_in[7]; P.k_norm_g = (const float*)d_in[8];
  P.attn_sink = (const float*)d_in[9]; P.lam_re = (const float*)d_in[10]; P.lam_im = (const float*)d_in[11];
  P.b_re = (const float*)d_in[12]; P.b_im = (const float*)d_in[13]; P.c_re = (const float*)d_in[14]; P.c_im = (const float*)d_in[15];
  P.ssm_d = (const float*)d_in[16]; P.log_dt = (const float*)d_in[17]; P.w_glu = (const float*)d_in[18];
  P.attn_out_g = (const float*)d_in[19]; P.ssm_out_g = (const float*)d_in[20]; P.w_out = (const float*)d_in[21];
  P.norm2_g = (const float*)d_in[22]; P.w_router = (const float*)d_in[23]; P.router_bias = (const float*)d_in[24];
  P.w_gate = (const float*)d_in[25]; P.w_up = (const float*)d_in[26]; P.w_down = (const float*)d_in[27];
  p.out = (float*)d_out;

  p.ws = (char*)d_ws;
  if (WS_TOTAL > ws_size) { fprintf(stderr, "workspace too small: need %zu have %zu\n", (size_t)WS_TOTAL, ws_size); return; }
  (void)in_sizes; (void)n_in; (void)out_size;

  static int grid_blocks = 0;
  if (!grid_blocks) {
    int dev = 0, cus = 0, per_cu = 0;
    (void)hipGetDevice(&dev);
    (void)hipDeviceGetAttribute(&cus, hipDeviceAttributeMultiprocessorCount, dev);
    (void)hipOccupancyMaxActiveBlocksPerMultiprocessor(&per_cu, mega, NTHR, 0);
    if (per_cu > 2) per_cu = 2;
    if (per_cu < 1) per_cu = 1;
    grid_blocks = cus * per_cu;
  }
  (void)hipMemsetAsync(p.ws + OFF_BAR, 0, OFF_MOD - OFF_BAR, stream);
  void* args[] = {&p};
  hipError_t e = hipLaunchCooperativeKernel((void*)mega, dim3(grid_blocks), dim3(NTHR), args, 0, stream);
  if (e != hipSuccess) fprintf(stderr, "cooperative launch failed: %s (grid %d)\n", hipGetErrorString(e), grid_blocks);
}
```

```cpp
#include <hip/hip_runtime.h>
#include <hip/hip_cooperative_groups.h>
#include <stdint.h>
#include <cstdio>
#include <cstring>

namespace {
constexpr int D = 1024, NB = 8, S = 2048, T = NB * S, DEPTH = 2;
constexpr int AW = 512, HD = 64, NQ = 8, NKV = 2, INW = 1280;
constexpr int SG = 32, SCH = 16, SP = 64, SW = 512;
constexpr int NE = 16, DFF = 512;
constexpr int NBUCKET = 24;
constexpr float EPS = 1e-6f;

struct Ptrs {
  const float *x, *c; const int* pos; const float *ada_w, *ada_b, *norm1_g, *w_in, *q_norm_g, *k_norm_g, *attn_sink,
      *lam_re, *lam_im, *b_re, *b_im, *c_re, *c_im, *ssm_d, *log_dt, *w_glu, *attn_out_g, *ssm_out_g, *w_out, *norm2_g,
      *w_router, *router_bias, *w_gate, *w_up, *w_down;
};

__device__ __forceinline__ float row_sum32_dpp(float v) {
  v += __int_as_float(__builtin_amdgcn_update_dpp(0, __float_as_int(v), 0xB1, 0xF, 0xF, true));
  v += __int_as_float(__builtin_amdgcn_update_dpp(0, __float_as_int(v), 0x4E, 0xF, 0xF, true));
  v += __int_as_float(__builtin_amdgcn_update_dpp(0, __float_as_int(v), 0x141, 0xF, 0xF, true));
  v += __int_as_float(__builtin_amdgcn_update_dpp(0, __float_as_int(v), 0x140, 0xF, 0xF, true));
  v += __int_as_float(__builtin_amdgcn_update_dpp(0, __float_as_int(v), 0x142, 0xA, 0xF, false));
  return v;
}
__device__ __forceinline__ float wave_sum(float v) {
  v = row_sum32_dpp(v);
  return __int_as_float(__builtin_amdgcn_readlane(__float_as_int(v), 31)) + __int_as_float(__builtin_amdgcn_readlane(__float_as_int(v), 63));
}
__device__ __forceinline__ float xhalf_sum(float v) {
  const auto r = __builtin_amdgcn_permlane32_swap(__float_as_uint(v), __float_as_uint(v), false, false);
  return __uint_as_float(r[0]) + __uint_as_float(r[1]);
}
__device__ __forceinline__ float xhalf_max(float v) {
  const auto r = __builtin_amdgcn_permlane32_swap(__float_as_uint(v), __float_as_uint(v), false, false);
  return fmaxf(__uint_as_float(r[0]), __uint_as_float(r[1]));
}

typedef unsigned short bf16_t;
typedef short bf16x8 __attribute__((ext_vector_type(8)));
typedef float f32x4 __attribute__((ext_vector_type(4)));
typedef float f32x16 __attribute__((ext_vector_type(16)));
typedef float f32x2 __attribute__((ext_vector_type(2)));
typedef __bf16 bf16x2_t __attribute__((ext_vector_type(2)));
typedef unsigned u32x4 __attribute__((ext_vector_type(4)));
typedef unsigned u32x2 __attribute__((ext_vector_type(2)));

constexpr int NTHR = 256;
constexpr int TM = 128;
constexpr int MAXMT = T / TM + NBUCKET;
constexpr int NSUBL = 8;
constexpr int SMEM_MM = 65536 + 16;

__device__ __forceinline__ unsigned pack2(float lo, float hi) {
  f32x2 v = {lo, hi};
  return __builtin_bit_cast(unsigned, __builtin_convertvector(v, bf16x2_t));
}
__device__ __forceinline__ int launder(int x) { asm volatile("" : "+v"(x)); return x; }
__device__ __forceinline__ int launder_s(int x) { asm volatile("" : "+s"(x)); return x; }
__device__ __forceinline__ float bf_lo(unsigned u) { return __uint_as_float(u << 16); }
__device__ __forceinline__ float bf_hi(unsigned u) { return __uint_as_float(u & 0xffff0000u); }
__device__ __forceinline__ float bf1(bf16_t u) { return __uint_as_float(((unsigned)u) << 16); }

constexpr size_t al256(size_t x) { return (x + 255) & ~(size_t)255; }
constexpr size_t OFF_BAR = 0;
constexpr size_t OFF_CLAIM = OFF_BAR + al256(4096 * 4);
constexpr size_t OFF_MOD = OFF_CLAIM + al256(4096 * 4 + 256);
constexpr size_t OFF_CS = OFF_MOD + al256((size_t)DEPTH * 8 * 6144 * 4);
constexpr size_t OFF_CNT = OFF_CS + al256((size_t)T * 32 * 8);
constexpr size_t OFF_LIST = OFF_CNT + al256(256 * 4 * DEPTH);
constexpr size_t OFF_TOKW = OFF_LIST + al256((size_t)NBUCKET * NSUBL * T * 4);
constexpr size_t OFF_SSMB = OFF_TOKW + al256((size_t)T * 8);
constexpr size_t OFF_SSMC = OFF_SSMB + al256((size_t)DEPTH * SG * 128 * 16 * 2);
constexpr size_t OFF_SSML = OFF_SSMC + al256((size_t)DEPTH * SG * 16 * 128 * 2);
constexpr size_t OFF_WINT = OFF_SSML + al256((size_t)DEPTH * SG * SP * 2 * 4);
constexpr size_t OFF_WGLUT = OFF_WINT + al256((size_t)DEPTH * INW * D * 2);
constexpr size_t OFF_WOUTT = OFF_WGLUT + al256((size_t)DEPTH * SW * SW * 2);
constexpr size_t OFF_H = OFF_WOUTT + al256((size_t)DEPTH * D * D * 2);
constexpr size_t OFF_Q = OFF_H + al256((size_t)T * D * 2);
constexpr size_t OFF_K = OFF_Q + al256((size_t)T * AW * 2);
constexpr size_t OFF_VT = OFF_K + al256((size_t)T * 128 * 2);
constexpr size_t OFF_U = OFF_VT + al256((size_t)T * 128 * 2);
constexpr size_t OFF_ATTN = OFF_U + al256((size_t)T * SW * 2);
constexpr size_t OFF_ACT = OFF_Q;
static_assert((size_t)MAXMT * TM * D * 2 <= OFF_ATTN - OFF_Q, "act overlay too small");
constexpr size_t OFF_SSQA = OFF_ATTN + al256((size_t)T * AW * 2);
constexpr size_t OFF_Y = OFF_SSQA + al256((size_t)T * 8 * 4);
constexpr size_t OFF_SSM = OFF_Y + al256((size_t)T * SW * 2);
constexpr size_t OFF_SSQS = OFF_SSM + al256((size_t)T * SW * 2);
constexpr size_t OFF_X1 = OFF_SSQS + al256((size_t)T * 8 * 4);
constexpr size_t OFF_WGT = OFF_X1 + al256((size_t)T * D * 4);
constexpr size_t OFF_WUT = OFF_WGT + al256((size_t)DEPTH * NE * DFF * D * 2);
constexpr size_t OFF_WDT = OFF_WUT + al256((size_t)DEPTH * NE * DFF * D * 2);
constexpr size_t WS_TOTAL = OFF_WDT + al256((size_t)DEPTH * NE * DFF * D * 2);

struct MP {
  Ptrs in;
  float* out;
  char* ws;
  __device__ __forceinline__ unsigned* bar() const { return (unsigned*)(ws + OFF_BAR); }
  __device__ __forceinline__ unsigned* claim() const { return (unsigned*)(ws + OFF_CLAIM); }
  __device__ __forceinline__ float* mod() const { return (float*)(ws + OFF_MOD); }
  __device__ __forceinline__ float2* cs() const { return (float2*)(ws + OFF_CS); }
  __device__ __forceinline__ int* cnt() const { return (int*)(ws + OFF_CNT); }
  __device__ __forceinline__ int* list() const { return (int*)(ws + OFF_LIST); }
  __device__ __forceinline__ float2* tokw() const { return (float2*)(ws + OFF_TOKW); }
  __device__ __forceinline__ bf16_t* ssmB() const { return (bf16_t*)(ws + OFF_SSMB); }
  __device__ __forceinline__ bf16_t* ssmC() const { return (bf16_t*)(ws + OFF_SSMC); }
  __device__ __forceinline__ float* ssmL() const { return (float*)(ws + OFF_SSML); }
  __device__ __forceinline__ bf16_t* WinT() const { return (bf16_t*)(ws + OFF_WINT); }
  __device__ __forceinline__ bf16_t* WgluT() const { return (bf16_t*)(ws + OFF_WGLUT); }
  __device__ __forceinline__ bf16_t* WoutT() const { return (bf16_t*)(ws + OFF_WOUTT); }
  __device__ __forceinline__ bf16_t* WgT() const { return (bf16_t*)(ws + OFF_WGT); }
  __device__ __forceinline__ bf16_t* WuT() const { return (bf16_t*)(ws + OFF_WUT); }
  __device__ __forceinline__ bf16_t* WdT() const { return (bf16_t*)(ws + OFF_WDT); }
  __device__ __forceinline__ bf16_t* h() const { return (bf16_t*)(ws + OFF_H); }
  __device__ __forceinline__ bf16_t* q() const { return (bf16_t*)(ws + OFF_Q); }
  __device__ __forceinline__ bf16_t* k() const { return (bf16_t*)(ws + OFF_K); }
  __device__ __forceinline__ bf16_t* vT() const { return (bf16_t*)(ws + OFF_VT); }
  __device__ __forceinline__ bf16_t* u() const { return (bf16_t*)(ws + OFF_U); }
  __device__ __forceinline__ bf16_t* attn() const { return (bf16_t*)(ws + OFF_ATTN); }
  __device__ __forceinline__ bf16_t* y() const { return (bf16_t*)(ws + OFF_Y); }
  __device__ __forceinline__ bf16_t* ssm() const { return (bf16_t*)(ws + OFF_SSM); }
  __device__ __forceinline__ bf16_t* act() const { return (bf16_t*)(ws + OFF_ACT); }
  __device__ __forceinline__ float* ssqa() const { return (float*)(ws + OFF_SSQA); }
  __device__ __forceinline__ float* ssqs() const { return (float*)(ws + OFF_SSQS); }
  __device__ __forceinline__ bf16_t* x1() const { return (bf16_t*)(ws + OFF_X1); }
};

constexpr int TT_WIN = 8 * 20, TT_GLU = 4 * 8, TT_OUT = 8 * 16, TT_EXP = 16 * 64;
constexpr int TT_LAYER = TT_WIN + TT_GLU + TT_OUT + 3 * TT_EXP;
constexpr int P0_MOD = DEPTH * 192;
constexpr int P0_TR = DEPTH * TT_LAYER;
constexpr int P0_CS = T * 32 / 256;
constexpr int P0_SSM = DEPTH * SG;
constexpr int P0_MISC = P0_MOD + P0_CS + P0_SSM + 1;

__device__ __forceinline__ void phase0_item(const MP& p, int it, char* smem) {
  const int tid = launder(threadIdx.x);
  float* ldsf = (float*)smem;
  if (it < P0_MOD) {
    const int l = it / 192, j0 = (it % 192) * 32;
    float* sc = ldsf;
    float* red = ldsf + 8192;
    for (int i = tid; i < 8192; i += NTHR) { float v = p.in.c[i]; sc[i] = v / (1.f + __expf(-v)); }
    __syncthreads();
    const int kg = tid >> 3, cq = (tid & 7) * 4;
    float acc[8][4];
#pragma unroll
    for (int b = 0; b < 8; ++b)
#pragma unroll
      for (int j = 0; j < 4; ++j) acc[b][j] = 0.f;
    const float* w = p.in.ada_w + (size_t)l * 1024 * 6144 + j0 + cq;
#pragma unroll 8
    for (int kk = 0; kk < 32; ++kk) {
      const int k = kg * 32 + kk;
      const float4 wv = *(const float4*)(w + (size_t)k * 6144);
#pragma unroll
      for (int b = 0; b < 8; ++b) { const float s = sc[b * 1024 + k]; acc[b][0] += s * wv.x; acc[b][1] += s * wv.y; acc[b][2] += s * wv.z; acc[b][3] += s * wv.w; }
    }
#pragma unroll
    for (int b = 0; b < 8; ++b) *(float4*)(red + (kg * 8 + b) * 32 + cq) = make_float4(acc[b][0], acc[b][1], acc[b][2], acc[b][3]);
    __syncthreads();
    {
      const int b = tid >> 5, c = tid & 31;
      float v = 0.f;
#pragma unroll 8
      for (int g = 0; g < 32; ++g) v += red[(g * 8 + b) * 32 + c];
      p.mod()[(size_t)(l * 8 + b) * 6144 + j0 + c] = v + p.in.ada_b[l * 6144 + j0 + c];
    }
    __syncthreads();
    return;
  }
  it -= P0_MOD;
  if (it < P0_CS) {
    const int i = it * 256 + tid, t = i >> 5, f = i & 31;
    const float freq = powf(10000.f, -(float)f / 32.f);
    const float ang = (float)p.in.pos[t] * freq;
    float sn, cn; sincosf(ang, &sn, &cn);
    p.cs()[i] = make_float2(cn, sn);
    return;
  }
  it -= P0_CS;
  if (it < P0_SSM) {
    const int lg = it;
    if (tid < 64) {
      const int pp = tid;
      const float dt = expf(p.in.log_dt[lg]);
      const float lr = p.in.lam_re[lg * SP + pp], li = p.in.lam_im[lg * SP + pp];
      const float mag = expf(lr * dt);
      float sn, cn; sincosf(li * dt, &sn, &cn);
      const float ar = mag * cn, ai = mag * sn;
      const float den = lr * lr + li * li;
      const float fr = ((ar - 1.f) * lr + ai * li) / den, fi = (ai * lr - (ar - 1.f) * li) / den;
      p.ssmL()[(lg * SP + pp) * 2] = ar; p.ssmL()[(lg * SP + pp) * 2 + 1] = ai;
      unsigned wr[8], wi[8];
#pragma unroll
      for (int hh = 0; hh < 8; ++hh) {
        const float br0 = p.in.b_re[((size_t)lg * SP + pp) * SCH + 2 * hh], bi0 = p.in.b_im[((size_t)lg * SP + pp) * SCH + 2 * hh];
        const float br1 = p.in.b_re[((size_t)lg * SP + pp) * SCH + 2 * hh + 1], bi1 = p.in.b_im[((size_t)lg * SP + pp) * SCH + 2 * hh + 1];
        wr[hh] = pack2(fr * br0 - fi * bi0, fr * br1 - fi * bi1);
        wi[hh] = pack2(fr * bi0 + fi * br0, fr * bi1 + fi * br1);
      }
      u32x4* dr = (u32x4*)(p.ssmB() + ((size_t)lg * 128 + pp) * 16);
      u32x4* di = (u32x4*)(p.ssmB() + ((size_t)lg * 128 + 64 + pp) * 16);
      dr[0] = (u32x4){wr[0], wr[1], wr[2], wr[3]}; dr[1] = (u32x4){wr[4], wr[5], wr[6], wr[7]};
      di[0] = (u32x4){wi[0], wi[1], wi[2], wi[3]}; di[1] = (u32x4){wi[4], wi[5], wi[6], wi[7]};
    }
    for (int o = tid; o < 16 * 64; o += NTHR) {
      const int hh = o >> 6, pp = o & 63;
      const float cr = p.in.c_re[(size_t)lg * SCH * SP + o], ci = p.in.c_im[(size_t)lg * SCH * SP + o];
      *(unsigned*)(p.ssmC() + ((size_t)lg * 16 + hh) * 128 + 2 * pp) = pack2(cr, -ci);
    }
    return;
  }
  for (int i = tid; i < 256 * DEPTH; i += NTHR) p.cnt()[i] = 0;
}

struct TrDesc { const float* src; bf16_t* dst; const float* gain; int N, K, k0, n0; };
__device__ __forceinline__ void tr_decode(const MP& p, int it, TrDesc& d) {
  const int l = it / TT_LAYER; int r = it % TT_LAYER;
  d.gain = nullptr;
  if (r < TT_WIN) { d.src = p.in.w_in + (size_t)l * D * INW; d.N = INW; d.dst = p.WinT() + (size_t)l * INW * D; d.K = D; d.k0 = (r / 20) * 128; d.n0 = (r % 20) * 64; return; }
  r -= TT_WIN;
  if (r < TT_GLU) { d.src = p.in.w_glu + (size_t)l * SW * SW; d.N = SW; d.dst = p.WgluT() + (size_t)l * SW * SW; d.K = SW; d.k0 = (r / 8) * 128; d.n0 = (r % 8) * 64; return; }
  r -= TT_GLU;
  if (r < TT_OUT) {
    d.k0 = (r / 16) * 128; d.n0 = (r % 16) * 64;
    d.gain = d.k0 < 512 ? (p.in.attn_out_g + l * AW) : (p.in.ssm_out_g + l * SW - 512);
    d.src = p.in.w_out + (size_t)l * D * D; d.N = D; d.dst = p.WoutT() + (size_t)l * D * D; d.K = D; return; }
  r -= TT_OUT;
  const int kind = r / TT_EXP; r %= TT_EXP;
  const int e = r / 64, tt = r % 64;
  if (kind == 0) { d.src = p.in.w_gate + (size_t)(l * NE + e) * D * DFF; d.N = DFF; d.dst = p.WgT() + (size_t)(l * NE + e) * DFF * D; d.K = D; d.k0 = (tt / 8) * 128; d.n0 = (tt % 8) * 64; return; }
  if (kind == 1) { d.src = p.in.w_up + (size_t)(l * NE + e) * D * DFF; d.N = DFF; d.dst = p.WuT() + (size_t)(l * NE + e) * DFF * D; d.K = D; d.k0 = (tt / 8) * 128; d.n0 = (tt % 8) * 64; return; }
  d.src = p.in.w_down + (size_t)(l * NE + e) * DFF * D; d.N = D; d.dst = p.WdT() + (size_t)(l * NE + e) * D * DFF; d.K = DFF; d.k0 = (tt / 16) * 128; d.n0 = (tt % 16) * 64;
}
__device__ __forceinline__ void phase0_transposes(const MP& p, char* smem, int first, int last, int brank, int nblk) {
  const int tid = launder(threadIdx.x);
  float* lds = (float*)smem;
  const int r = tid >> 4, c4 = (tid & 15) * 4;
  const int n = tid >> 2, kq = (tid & 3) * 32;
  TrDesc cur, nxt;
  float4 v[8]; float gg[8];
  auto load = [&](const TrDesc& d) {
#pragma unroll
    for (int i = 0; i < 8; ++i) v[i] = *(const float4*)(d.src + (size_t)(d.k0 + r + 16 * i) * d.N + d.n0 + c4);
    if (d.gain) {
#pragma unroll
      for (int i = 0; i < 8; ++i) gg[i] = d.gain[d.k0 + r + 16 * i];
    } else {
#pragma unroll
      for (int i = 0; i < 8; ++i) gg[i] = 1.f;
    }
  };
  int it = first + brank;
  if (it < last) { tr_decode(p, it, cur); load(cur); nxt = cur; }
  for (; it < last; it += nblk) {
#pragma unroll
    for (int i = 0; i < 8; ++i) {
      float* d = lds + (r + 16 * i) * 65 + c4;
      d[0] = v[i].x * gg[i]; d[1] = v[i].y * gg[i]; d[2] = v[i].z * gg[i]; d[3] = v[i].w * gg[i];
    }
    __syncthreads();
    const int nit = it + nblk;
    if (nit < last) { tr_decode(p, nit, nxt); load(nxt); }
    unsigned w[16];
#pragma unroll
    for (int j = 0; j < 16; ++j) w[j] = pack2(lds[(kq + 2 * j) * 65 + n], lds[(kq + 2 * j + 1) * 65 + n]);
    u32x4* dd = (u32x4*)(cur.dst + (size_t)(cur.n0 + n) * cur.K + cur.k0 + kq);
#pragma unroll
    for (int j = 0; j < 4; ++j) dd[j] = (u32x4){w[4 * j], w[4 * j + 1], w[4 * j + 2], w[4 * j + 3]};
    __syncthreads();
    cur = nxt;
  }
}

__device__ __forceinline__ void norm_token(const float* __restrict__ xr, const float* __restrict__ g, const float* __restrict__ sh,
                                           const float* __restrict__ sc, bf16_t* __restrict__ hr, int lane, float (&hv)[16]) {
  float4 v[4]; float ss = 0.f;
#pragma unroll
  for (int i = 0; i < 4; ++i) { v[i] = *(const float4*)(xr + lane * 4 + 256 * i); ss += v[i].x * v[i].x + v[i].y * v[i].y + v[i].z * v[i].z + v[i].w * v[i].w; }
  ss = wave_sum(ss);
  const float rinv = rsqrtf(ss * (1.f / D) + EPS);
#pragma unroll
  for (int i = 0; i < 4; ++i) {
    const int d = lane * 4 + 256 * i;
    const float4 gg = *(const float4*)(g + d), s1 = *(const float4*)(sc + d), s0 = *(const float4*)(sh + d);
    hv[4 * i + 0] = v[i].x * rinv * gg.x * (1.f + s1.x) + s0.x;
    hv[4 * i + 1] = v[i].y * rinv * gg.y * (1.f + s1.y) + s0.y;
    hv[4 * i + 2] = v[i].z * rinv * gg.z * (1.f + s1.z) + s0.z;
    hv[4 * i + 3] = v[i].w * rinv * gg.w * (1.f + s1.w) + s0.w;
    *(u32x2*)(hr + d) = (u32x2){pack2(hv[4 * i], hv[4 * i + 1]), pack2(hv[4 * i + 2], hv[4 * i + 3])};
  }
}

__device__ __forceinline__ void phase_norm1(const MP& p, int l, const float* xin) {
  const int tid = launder(threadIdx.x);
  const int wave = tid >> 6, lane = tid & 63;
  const float* modl = p.mod() + (size_t)l * 8 * 6144;
  for (int t = blockIdx.x * 4 + wave; t < T; t += gridDim.x * 4) {
    const int b = t / S; float hv[16];
    norm_token(xin + (size_t)t * D, p.in.norm1_g + l * D, modl + (size_t)b * 6144, modl + (size_t)b * 6144 + 1024, p.h() + (size_t)t * D, lane, hv);
  }
}

struct GemmTile {
  const bf16_t* A0; const bf16_t* A1; long lda; int ksA;
  int arow[4];
  const bf16_t* Blo0; const bf16_t* Bhi0;
  const bf16_t* Blo1; const bf16_t* Bhi1;
  long ldb; int ksB;
  int K;
};

__device__ __forceinline__ int lds_off(int row, int chunk) { return row * 128 + ((chunk ^ ((row >> 1) & 7)) << 4); }

template <bool BSPLIT, bool MID>
__device__ __forceinline__ void gemm_mainloop_t(const GemmTile& g, const GemmTile& gnext, bool hasnext, bool preloaded, char* smem, f32x4 (&acc)[4][4],
                                                int ktmid, const float (&mids)[4]) {
  const int tid = launder(threadIdx.x), lane = tid & 63, wave = tid >> 6, wr = wave >> 1, wc = wave & 1, fr = lane & 15, fq = lane >> 4;
  const int r0 = tid >> 3, c8 = tid & 7;
  const int csrc = (c8 ^ ((r0 >> 1) & 7)) * 8;
#pragma unroll
  for (int m = 0; m < 4; ++m)
#pragma unroll
    for (int n = 0; n < 4; ++n) acc[m][n] = (f32x4){0.f, 0.f, 0.f, 0.f};
  auto stage = [&](const GemmTile& gg, int kt, int buf) {
    const int kk = kt * 64;
    const bf16_t* Ab = kk < gg.ksA ? gg.A0 + kk : gg.A1 + (kk - gg.ksA);
    const bool bs = kk < gg.ksB; const int kb = bs ? kk : kk - gg.ksB;
    char* As = smem + buf * 32768 + tid * 16; char* Bs = As + 16384;
#pragma unroll
    for (int i = 0; i < 4; ++i) {
      __builtin_amdgcn_global_load_lds((const void*)(Ab + (size_t)gg.arow[i] * gg.lda + csrc), (void*)(As + i * 4096), 16, 0, 0);
      const bf16_t* Bb = bs ? (i < 2 ? gg.Blo0 : gg.Bhi0) : (i < 2 ? gg.Blo1 : gg.Bhi1);
      __builtin_amdgcn_global_load_lds((const void*)(Bb + (size_t)(r0 + 32 * (i & 1)) * gg.ldb + kb + csrc), (void*)(Bs + i * 4096), 16, 0, 0);
    }
  };
  const int nk = g.K / 64;
  if (!preloaded) {
    stage(g, 0, 0);
    asm volatile("s_waitcnt vmcnt(0)" ::: "memory");
    __syncthreads();
  }
  for (int kt = 0; kt < nk; ++kt) {
    if (kt + 1 < nk) stage(g, kt + 1, (kt + 1) & 1);
    else if (hasnext) stage(gnext, 0, 0);
    if (MID && kt == ktmid) {
#pragma unroll
      for (int m = 0; m < 4; ++m)
#pragma unroll
        for (int n = 0; n < 4; ++n) acc[m][n] *= mids[m];
    }
    const char* As = smem + (kt & 1) * 32768; const char* Bs = As + 16384;
    {
      bf16x8 af[2][4], bfr[2][4];
#pragma unroll
      for (int ks = 0; ks < 2; ++ks) {
#pragma unroll
        for (int m = 0; m < 4; ++m) af[ks][m] = *(const bf16x8*)(As + lds_off(wr * 64 + 16 * m + fr, ks * 4 + fq));
#pragma unroll
        for (int n = 0; n < 4; ++n) {
          const int brow = BSPLIT ? ((n >> 1) * 64 + wc * 32 + (n & 1) * 16 + fr) : (wc * 64 + 16 * n + fr);
          bfr[ks][n] = *(const bf16x8*)(Bs + lds_off(brow, ks * 4 + fq));
        }
      }
#pragma unroll
      for (int ks = 0; ks < 2; ++ks)
#pragma unroll
        for (int m = 0; m < 4; ++m)
#pragma unroll
          for (int n = 0; n < 4; ++n) acc[m][n] = __builtin_amdgcn_mfma_f32_16x16x32_bf16(bfr[ks][n], af[ks][m], acc[m][n], 0, 0, 0);
      __builtin_amdgcn_sched_group_barrier(0x100, 8, 0);
#pragma unroll
      for (int i = 0; i < 8; ++i) { __builtin_amdgcn_sched_group_barrier(0x008, 2, 0); __builtin_amdgcn_sched_group_barrier(0x100, 1, 0); }
      __builtin_amdgcn_sched_group_barrier(0x008, 16, 0);
    }
    __builtin_amdgcn_sched_barrier(0);
    asm volatile("s_waitcnt vmcnt(0)" ::: "memory");
    __syncthreads();
  }
}
template <bool BSPLIT>
__device__ __forceinline__ void gemm_mainloop(const GemmTile& g, const GemmTile& gnext, bool hasnext, bool preloaded, char* smem, f32x4 (&acc)[4][4]) {
  const float dummy[4] = {1.f, 1.f, 1.f, 1.f};
  gemm_mainloop_t<BSPLIT, false>(g, gnext, hasnext, preloaded, smem, acc, -1, dummy);
}

struct TileMap { int base, ntl, lb, nlb; };
__device__ __forceinline__ TileMap tm_init(int nMt, int nNt) {
  TileMap t;
  if ((gridDim.x & 7) == 0) {
    const int xcd = blockIdx.x & 7;
    t.lb = blockIdx.x >> 3; t.nlb = gridDim.x >> 3;
    const int mlo = (nMt * xcd) >> 3, mhi = (nMt * (xcd + 1)) >> 3;
    t.base = mlo * nNt; t.ntl = (mhi - mlo) * nNt;
  } else { t.lb = blockIdx.x; t.nlb = gridDim.x; t.base = 0; t.ntl = nMt * nNt; }
  return t;
}
__device__ __forceinline__ int tm_tile(const TileMap& t, int j) { const int li = t.lb + t.nlb * j; return li < t.ntl ? t.base + li : -1; }
__device__ __forceinline__ void phase_inproj(const MP& p, int l, char* smem) {
  const int tid = launder(threadIdx.x), lane = tid & 63, wave = tid >> 6, wr = wave >> 1, wc = wave & 1, fr = lane & 15, fq = lane >> 4;
  const int r0 = tid >> 3;
  const int ntiles = (T / 128) * (INW / 128);
  const bf16_t* W = p.WinT() + (size_t)l * INW * D;
  auto make = [&](int tile, GemmTile& g) {
    const int m0 = (tile / 10) * 128, n0 = (tile % 10) * 128;
    g.A0 = p.h(); g.A1 = p.h(); g.lda = D; g.ksA = D; g.K = D;
#pragma unroll
    for (int i = 0; i < 4; ++i) g.arow[i] = m0 + r0 + 32 * i;
    g.Blo0 = W + (size_t)n0 * D; g.Bhi0 = g.Blo0 + (size_t)64 * D; g.Blo1 = g.Blo0; g.Bhi1 = g.Bhi0;
    g.ldb = D; g.ksB = D;
  };
  GemmTile g, gn; bool pre = false;
  const TileMap tmap = tm_init(T / 128, INW / 128);
  { const int t0 = tm_tile(tmap, 0); if (t0 >= 0) { make(t0, g); gn = g; } }
  for (int jt = 0; ; ++jt) {
    const int tile = tm_tile(tmap, jt); if (tile < 0) break;
    const int mt = tile / 10, nt = tile % 10, m0 = mt * 128;
    const int nxt = tm_tile(tmap, jt + 1); const bool hasn = nxt >= 0;
    if (hasn) make(nxt, gn);
    f32x4 acc[4][4];
    gemm_mainloop<false>(g, gn, hasn, pre, smem, acc);
    pre = hasn; g = gn;
    const int rowb = m0 + wr * 64 + fr;
    if (nt <= 4) {
      const float* gv = (nt < 4 ? p.in.q_norm_g : p.in.k_norm_g) + l * HD;
      const float scl = nt < 4 ? 0.125f : 1.f;
      f32x4 g1[2], g2[2];
#pragma unroll
      for (int n = 0; n < 2; ++n) { g1[n] = *(const f32x4*)(gv + 16 * n + 4 * fq); g2[n] = *(const f32x4*)(gv + 32 + 16 * n + 4 * fq); }
#pragma unroll
      for (int m = 0; m < 4; ++m) {
        const int t = rowb + 16 * m;
        float ss = 0.f;
#pragma unroll
        for (int n = 0; n < 4; ++n)
#pragma unroll
          for (int j = 0; j < 4; ++j) ss += acc[m][n][j] * acc[m][n][j];
        ss += __shfl_xor(ss, 16); ss += __shfl_xor(ss, 32);
        const float rinv = rsqrtf(ss * (1.f / 64.f) + EPS) * scl;
        bf16_t* dst = nt < 4 ? (p.q() + (size_t)t * AW + (2 * nt + wc) * 64) : (p.k() + (size_t)t * 128 + wc * 64);
#pragma unroll
        for (int n = 0; n < 2; ++n) {
          const int c = 16 * n + 4 * fq;
          const f32x4 csa = *(const f32x4*)((const float*)p.cs() + ((size_t)t * 32 + c) * 2);
          const f32x4 csb = *(const f32x4*)((const float*)p.cs() + ((size_t)t * 32 + c + 2) * 2);
          const float cn[4] = {csa[0], csa[2], csb[0], csb[2]}, sn[4] = {csa[1], csa[3], csb[1], csb[3]};
          float o1[4], o2[4];
#pragma unroll
          for (int j = 0; j < 4; ++j) {
            const float x1 = acc[m][n][j] * rinv * g1[n][j], x2 = acc[m][n + 2][j] * rinv * g2[n][j];
            o1[j] = x1 * cn[j] - x2 * sn[j]; o2[j] = x2 * cn[j] + x1 * sn[j];
          }
          *(u32x2*)(dst + c) = (u32x2){pack2(o1[0], o1[1]), pack2(o1[2], o1[3])};
          *(u32x2*)(dst + 32 + c) = (u32x2){pack2(o2[0], o2[1]), pack2(o2[2], o2[3])};
        }
      }
    } else if (nt == 5) {
      const int b = m0 / S;
#pragma unroll
      for (int m = 0; m < 4; ++m) {
        const int s = (rowb + 16 * m) % S;
        const int k16 = s & 15;
        const int sp = (s & ~15) | (k16 & 3) | (((k16 >> 3) & 1) << 2) | (((k16 >> 2) & 1) << 3);
#pragma unroll
        for (int n = 0; n < 4; ++n)
#pragma unroll
          for (int j = 0; j < 4; ++j) {
            const int d = 16 * n + 4 * fq + j;
            p.vT()[((size_t)(b * 2 + wc) * 64 + d) * S + sp] = (bf16_t)(pack2(acc[m][n][j], 0.f) & 0xffffu);
          }
      }
    } else {
#pragma unroll
      for (int m = 0; m < 4; ++m) {
        const int t = rowb + 16 * m;
#pragma unroll
        for (int n = 0; n < 4; ++n)
          *(u32x2*)(p.u() + (size_t)t * SW + (nt - 6) * 128 + wc * 64 + 16 * n + 4 * fq) = (u32x2){pack2(acc[m][n][0], acc[m][n][1]), pack2(acc[m][n][2], acc[m][n][3])};
      }
    }
  }
}

__device__ __forceinline__ int crow32(int r, int hf) { return (r & 3) + 8 * (r >> 2) + 4 * hf; }
__device__ __forceinline__ void attn_task(const MP& p, int l, int task, int lane) {
  lane = launder(lane);
  task = __builtin_amdgcn_readfirstlane(task);
  const int h = task & 7, qt = (task >> 3) & 63, b = task >> 9, kvh = h >> 2;
  const int s0 = qt * 32, t0 = b * S + s0, ql = lane & 31, hf = lane >> 5;
  int kst[5];
#pragma unroll
  for (int kt = 0; kt < 5; ++kt) { const int ks = s0 - 128 + 32 * kt; kst[kt] = ks < 0 ? 0 : ks; }
  bf16x8 qf[4], kf[5][4];
#pragma unroll
  for (int st = 0; st < 4; ++st) qf[st] = *(const bf16x8*)(p.q() + (size_t)(t0 + ql) * AW + h * 64 + 16 * st + 8 * hf);
#pragma unroll
  for (int kt = 0; kt < 5; ++kt)
#pragma unroll
    for (int st = 0; st < 4; ++st) kf[kt][st] = *(const bf16x8*)(p.k() + (size_t)(b * S + kst[kt] + ql) * 128 + kvh * 64 + 8 * hf + 16 * st);
  f32x16 sc[5];
#pragma unroll
  for (int kt = 0; kt < 5; ++kt) {
#pragma unroll
    for (int r = 0; r < 16; ++r) sc[kt][r] = 0.f;
#pragma unroll
    for (int st = 0; st < 4; ++st) sc[kt] = __builtin_amdgcn_mfma_f32_32x32x16_bf16(kf[kt][st], qf[st], sc[kt], 0, 0, 0);
  }
  bf16x8 vb[5][2][2];
#pragma unroll
  for (int kt = 0; kt < 5; ++kt)
#pragma unroll
    for (int s = 0; s < 2; ++s)
#pragma unroll
      for (int dt = 0; dt < 2; ++dt)
        vb[kt][s][dt] = *(const bf16x8*)(p.vT() + ((size_t)(b * 2 + kvh) * 64 + 32 * dt + ql) * S + kst[kt] + 16 * s + 8 * hf);
  const float sink = p.in.attn_sink[l * NQ + h];
  float mx = sink;
#pragma unroll
  for (int kt = 0; kt < 5; ++kt) {
#pragma unroll
    for (int r = 0; r < 16; ++r) {
      const int kp = s0 - 128 + 32 * kt + crow32(r, hf);
      const int dk = kp - (s0 + ql);
      const bool valid = kp >= 0 && dk <= 0 && dk > -128;
      sc[kt][r] = valid ? sc[kt][r] : -1e30f;
      mx = fmaxf(mx, sc[kt][r]);
    }
  }
  mx = xhalf_max(mx);
  float lsum = 0.f;
#pragma unroll
  for (int kt = 0; kt < 5; ++kt) {
#pragma unroll
    for (int r = 0; r < 16; ++r) { const float e = __expf(sc[kt][r] - mx); sc[kt][r] = e; lsum += e; }
  }
  lsum = xhalf_sum(lsum);
  lsum += __expf(sink - mx);
  const float inv = 1.f / lsum;
  f32x16 o[2];
#pragma unroll
  for (int r = 0; r < 16; ++r) { o[0][r] = 0.f; o[1][r] = 0.f; }
#pragma unroll
  for (int kt = 0; kt < 5; ++kt) {
#pragma unroll
    for (int s = 0; s < 2; ++s) {
      u32x4 pw;
#pragma unroll
      for (int j = 0; j < 4; ++j) pw[j] = pack2(sc[kt][8 * s + 2 * j], sc[kt][8 * s + 2 * j + 1]);
      const bf16x8 pa = __builtin_bit_cast(bf16x8, pw);
#pragma unroll
      for (int dt = 0; dt < 2; ++dt) o[dt] = __builtin_amdgcn_mfma_f32_32x32x16_bf16(vb[kt][s][dt], pa, o[dt], 0, 0, 0);
    }
  }
  bf16_t* dst = p.attn() + (size_t)(t0 + ql) * AW + h * 64 + 4 * hf;
  float ssq = 0.f;
#pragma unroll
  for (int dt = 0; dt < 2; ++dt)
#pragma unroll
    for (int g4 = 0; g4 < 4; ++g4) {
      const float a0 = o[dt][4 * g4] * inv, a1 = o[dt][4 * g4 + 1] * inv, a2 = o[dt][4 * g4 + 2] * inv, a3 = o[dt][4 * g4 + 3] * inv;
      ssq += (a0 * a0 + a1 * a1) + (a2 * a2 + a3 * a3);
      *(u32x2*)(dst + 32 * dt + 8 * g4) = (u32x2){pack2(a0, a1), pack2(a2, a3)};
    }
  ssq = xhalf_sum(ssq);
  if (hf == 0) p.ssqa()[(size_t)(t0 + ql) * 8 + h] = ssq;
}
constexpr int SSEG = 4, SEGLEN = S / SSEG, SEGCH = SEGLEN / 32;

__device__ __forceinline__ void ssm_bu(const bf16x8& ua, const bf16x8 (&bB)[4], f32x16 (&bu)[4]) {
#pragma unroll
  for (int nt = 0; nt < 4; ++nt) {
#pragma unroll
    for (int r = 0; r < 16; ++r) bu[nt][r] = 0.f;
    bu[nt] = __builtin_amdgcn_mfma_f32_32x32x16_bf16(ua, bB[nt], bu[nt], 0, 0, 0);
  }
  asm volatile("s_nop 15\n\ts_nop 7" : "+v"(bu[0]), "+v"(bu[1]), "+v"(bu[2]), "+v"(bu[3]));
#pragma unroll
  for (int r = 0; r < 16; ++r) {
    auto s0 = __builtin_amdgcn_permlane32_swap(__float_as_uint(bu[0][r]), __float_as_uint(bu[1][r]), false, false);
    bu[0][r] = __uint_as_float(s0[0]); bu[1][r] = __uint_as_float(s0[1]);
    auto s1 = __builtin_amdgcn_permlane32_swap(__float_as_uint(bu[2][r]), __float_as_uint(bu[3][r]), false, false);
    bu[2][r] = __uint_as_float(s1[0]); bu[3][r] = __uint_as_float(s1[1]);
  }
}

__device__ __forceinline__ void ssm_block(const MP& p, int l, int b, int g, int tid, char* smem) {
  const int lane = tid & 63, seg = tid >> 6;
  char* wl = smem + seg * 8192;
  float* fin = (float*)(smem + 4 * 8192);
  const int lg = l * SG + g, hf = lane >> 5, fr = lane & 15, fq = lane >> 4;
  const float ar = p.ssmL()[(lg * SP + lane) * 2], ai = p.ssmL()[(lg * SP + lane) * 2 + 1];
  bf16x8 bB[4], cB[4];
#pragma unroll
  for (int nt = 0; nt < 4; ++nt) bB[nt] = *(const bf16x8*)(p.ssmB() + ((size_t)lg * 128 + nt * 32 + (lane & 31)) * 16 + 8 * hf);
#pragma unroll
  for (int ks = 0; ks < 4; ++ks) cB[ks] = *(const bf16x8*)(p.ssmC() + ((size_t)lg * 16 + fr) * 128 + 32 * ks + 8 * fq);
  const f32x4 dsk = *(const f32x4*)(p.in.ssm_d + l * SW + g * 16 + 4 * fq);
  const int t0 = b * S + seg * SEGLEN;
  const bf16_t* urow = p.u() + (size_t)(t0 + (lane & 31)) * SW + g * 16 + 8 * hf;
  float xr = 0.f, xi = 0.f;
  if (seg < SSEG - 1) {
    bf16x8 ua = *(const bf16x8*)(urow);
    for (int c = 0; c < SEGCH; ++c) {
      const bf16x8 un = *(const bf16x8*)(urow + (size_t)((c + 1 < SEGCH ? c + 1 : c) * 32) * SW);
      f32x16 bu[4];
      ssm_bu(ua, bB, bu);
#pragma unroll
      for (int r4 = 0; r4 < 4; ++r4)
#pragma unroll
        for (int half = 0; half < 2; ++half)
#pragma unroll
          for (int j = 0; j < 4; ++j) {
            const int r = 4 * r4 + j;
            const float bre = half ? bu[1][r] : bu[0][r], bim = half ? bu[3][r] : bu[2][r];
            const float nr = ar * xr - ai * xi + bre, ni = ar * xi + ai * xr + bim;
            xr = nr; xi = ni;
          }
      ua = un;
    }
  }
  fin[(seg * 64 + lane) * 2] = xr; fin[(seg * 64 + lane) * 2 + 1] = xi;
  __syncthreads();
  {
    float pr = ar, pi = ai;
#pragma unroll
    for (int i = 0; i < 9; ++i) { const float nr = pr * pr - pi * pi, ni = 2.f * pr * pi; pr = nr; pi = ni; }
    static_assert(SEGLEN == 512, "lam^SEGLEN squaring count");
    float cr = 0.f, ci = 0.f;
    for (int j = 0; j < seg; ++j) {
      const float fr_ = fin[(j * 64 + lane) * 2], fi_ = fin[(j * 64 + lane) * 2 + 1];
      const float nr = pr * cr - pi * ci + fr_, ni = pr * ci + pi * cr + fi_;
      cr = nr; ci = ni;
    }
    xr = cr; xi = ci;
  }
  const int wbase = (lane & 3) * 4;
  const int pch = lane >> 2;
  const bf16_t* uep = p.u() + (size_t)(t0 + fr) * SW + g * 16 + 4 * fq;
  bf16x8 ua = *(const bf16x8*)(urow);
  u32x2 uraw[2];
#pragma unroll
  for (int i = 0; i < 2; ++i) uraw[i] = *(const u32x2*)(uep + (size_t)(16 * i) * SW);
  for (int c = 0; c < SEGCH; ++c) {
    const int tb = t0 + c * 32;
    const int cn = (c + 1 < SEGCH ? c + 1 : c) * 32;
    const bf16x8 un = *(const bf16x8*)(urow + (size_t)cn * SW);
    u32x2 unraw[2];
#pragma unroll
    for (int i = 0; i < 2; ++i) unraw[i] = *(const u32x2*)(uep + (size_t)(cn + 16 * i) * SW);
    f32x16 bu[4];
    ssm_bu(ua, bB, bu);
#pragma unroll
    for (int r4 = 0; r4 < 4; ++r4) {
#pragma unroll
      for (int half = 0; half < 2; ++half) {
#pragma unroll
        for (int j = 0; j < 4; ++j) {
          const int t = 8 * r4 + 4 * half + j, r = 4 * r4 + j;
          const float bre = half ? bu[1][r] : bu[0][r], bim = half ? bu[3][r] : bu[2][r];
          const float nr = ar * xr - ai * xi + bre, ni = ar * xi + ai * xr + bim;
          xr = nr; xi = ni;
          *(unsigned*)(wl + t * 256 + ((pch ^ (t & 15)) << 4) + wbase) = pack2(nr, ni);
        }
      }
    }
    asm volatile("s_waitcnt lgkmcnt(0)" ::: "memory");
#pragma unroll
    for (int mt = 0; mt < 2; ++mt) {
      f32x4 acc = {0.f, 0.f, 0.f, 0.f};
      const int t = 16 * mt + fr;
#pragma unroll
      for (int ks = 0; ks < 4; ++ks) {
        const bf16x8 af = *(const bf16x8*)(wl + t * 256 + (((4 * ks + fq) ^ (t & 15)) << 4));
        acc = __builtin_amdgcn_mfma_f32_16x16x32_bf16(cB[ks], af, acc, 0, 0, 0);
      }
      const float uu[4] = {bf_lo(uraw[mt][0]), bf_hi(uraw[mt][0]), bf_lo(uraw[mt][1]), bf_hi(uraw[mt][1])};
      float ge[4];
#pragma unroll
      for (int j = 0; j < 4; ++j) {
        const float v = acc[j] + dsk[j] * uu[j];
        const float z2 = 1.5957691216057308f * (v + 0.044715f * v * v * v);
        ge[j] = v * __builtin_amdgcn_rcpf(1.f + __expf(-z2));
      }
      *(u32x2*)(p.y() + (size_t)(tb + t) * SW + g * 16 + 4 * fq) = (u32x2){pack2(ge[0], ge[1]), pack2(ge[2], ge[3])};
    }
    asm volatile("s_waitcnt lgkmcnt(0)" ::: "memory");
    ua = un;
#pragma unroll
    for (int i = 0; i < 2; ++i) uraw[i] = unraw[i];
  }
}

__device__ __forceinline__ void phase_attn(const MP& p, int l) {
  const int tid = launder(threadIdx.x);
  const int wave = tid >> 6, lane = tid & 63;
  for (int task = blockIdx.x * 4 + wave; task < NB * 64 * 8; task += gridDim.x * 4) attn_task(p, l, task, lane);
}
__device__ __forceinline__ void phase_ssm(const MP& p, int l, char* smem, int wid) {
  const int tid = launder(threadIdx.x);
  if (wid < 0) return;
  const int nw = (int)__hip_atomic_load(p.claim() + 4096, __ATOMIC_RELAXED, __HIP_MEMORY_SCOPE_AGENT);
  for (int task = wid; task < NB * SG; task += nw) {
    ssm_block(p, l, task / SG, task % SG, tid, smem);
    __syncthreads();
  }
}
__device__ __forceinline__ void phase_glu(const MP& p, int l, char* smem) {
  const int tid = launder(threadIdx.x), lane = tid & 63, wave = tid >> 6, wr = wave >> 1, wc = wave & 1, fr = lane & 15, fq = lane >> 4;
  const int r0 = tid >> 3;
  const int ntiles = (T / 128) * (SW / 128);
  const bf16_t* W = p.WgluT() + (size_t)l * SW * SW;
  auto make = [&](int tile, GemmTile& g) {
    const int m0 = (tile >> 2) * 128, n0 = (tile & 3) * 128;
    g.A0 = p.y(); g.A1 = p.y(); g.lda = SW; g.ksA = SW; g.K = SW;
#pragma unroll
    for (int i = 0; i < 4; ++i) g.arow[i] = m0 + r0 + 32 * i;
    g.Blo0 = W + (size_t)n0 * SW; g.Bhi0 = g.Blo0 + (size_t)64 * SW; g.Blo1 = g.Blo0; g.Bhi1 = g.Bhi0;
    g.ldb = SW; g.ksB = SW;
  };
  GemmTile g, gn; bool pre = false;
  const TileMap tmap = tm_init(T / 128, SW / 128);
  { const int t0 = tm_tile(tmap, 0); if (t0 >= 0) { make(t0, g); gn = g; } }
  for (int jt = 0; ; ++jt) {
    const int tile = tm_tile(tmap, jt); if (tile < 0) break;
    const int mt = tile >> 2, nt = tile & 3, m0 = mt * 128, n0 = nt * 128;
    const int nxt = tm_tile(tmap, jt + 1); const bool hasn = nxt >= 0;
    if (hasn) make(nxt, gn);
    f32x4 acc[4][4];
    gemm_mainloop<false>(g, gn, hasn, pre, smem, acc);
    pre = hasn; g = gn;
#pragma unroll
    for (int m = 0; m < 4; ++m) {
      const int t = m0 + wr * 64 + 16 * m + fr;
      float ss = 0.f;
#pragma unroll
      for (int n = 0; n < 4; ++n) {
        const int col = n0 + wc * 64 + 16 * n + 4 * fq;
        const u32x2 yr = *(const u32x2*)(p.y() + (size_t)t * SW + col);
        const float yv[4] = {bf_lo(yr[0]), bf_hi(yr[0]), bf_lo(yr[1]), bf_hi(yr[1])};
        float o[4];
#pragma unroll
        for (int j = 0; j < 4; ++j) { o[j] = yv[j] * __builtin_amdgcn_rcpf(1.f + __expf(-acc[m][n][j])); ss += o[j] * o[j]; }
        *(u32x2*)(p.ssm() + (size_t)t * SW + col) = (u32x2){pack2(o[0], o[1]), pack2(o[2], o[3])};
      }
      ss += __shfl_xor(ss, 16); ss += __shfl_xor(ss, 32);
      if (fq == 0) p.ssqs()[(size_t)t * 8 + nt * 2 + wc] = ss;
    }
  }
}

__device__ __forceinline__ void phase_out(const MP& p, int l, char* smem, const float* xin) {
  const int tid = launder(threadIdx.x), lane = tid & 63, wave = tid >> 6, wr = wave >> 1, wc = wave & 1, fr = lane & 15, fq = lane >> 4;
  const int r0 = tid >> 3;
  const float* modl = p.mod() + (size_t)l * 8 * 6144;
  const int ntiles = (T / 128) * (D / 128);
  const bf16_t* W = p.WoutT() + (size_t)l * D * D;
  auto make = [&](int tile, GemmTile& g) {
    const int m0 = (tile >> 3) * 128, n0 = (tile & 7) * 128;
    g.A0 = p.attn(); g.A1 = p.ssm(); g.lda = AW; g.ksA = AW; g.K = D;
#pragma unroll
    for (int i = 0; i < 4; ++i) g.arow[i] = m0 + r0 + 32 * i;
    g.Blo0 = W + (size_t)n0 * D; g.Bhi0 = g.Blo0 + (size_t)64 * D; g.Blo1 = g.Blo0; g.Bhi1 = g.Bhi0;
    g.ldb = D; g.ksB = D;
  };
  GemmTile g, gn; bool pre = false;
  const TileMap tmap = tm_init(T / 128, D / 128);
  { const int t0 = tm_tile(tmap, 0); if (t0 >= 0) { make(t0, g); gn = g; } }
  for (int jt = 0; ; ++jt) {
    const int tile = tm_tile(tmap, jt); if (tile < 0) break;
    const int mt = tile >> 3, nt = tile & 7, m0 = mt * 128, n0 = nt * 128, b = m0 / S;
    const int nxt = tm_tile(tmap, jt + 1); const bool hasn = nxt >= 0;
    if (hasn) make(nxt, gn);
    float mids[4], rs[4];
#pragma unroll
    for (int m = 0; m < 4; ++m) {
      const int t = m0 + wr * 64 + 16 * m + fr;
      const f32x4 a0 = *(const f32x4*)(p.ssqa() + (size_t)t * 8), a1 = *(const f32x4*)(p.ssqa() + (size_t)t * 8 + 4);
      const f32x4 s0 = *(const f32x4*)(p.ssqs() + (size_t)t * 8), s1 = *(const f32x4*)(p.ssqs() + (size_t)t * 8 + 4);
      const float sa = ((a0[0] + a0[1]) + (a0[2] + a0[3])) + ((a1[0] + a1[1]) + (a1[2] + a1[3]));
      const float sq = ((s0[0] + s0[1]) + (s0[2] + s0[3])) + ((s1[0] + s1[1]) + (s1[2] + s1[3]));
      const float ra = rsqrtf(sa * (1.f / 512.f) + EPS);
      rs[m] = rsqrtf(sq * (1.f / 512.f) + EPS);
      mids[m] = ra / rs[m];
    }
    f32x4 acc[4][4];
    gemm_mainloop_t<false, true>(g, gn, hasn, pre, smem, acc, 8, mids);
    pre = hasn; g = gn;
#pragma unroll
    for (int m = 0; m < 4; ++m) {
      const int t = m0 + wr * 64 + 16 * m + fr;
#pragma unroll
      for (int n = 0; n < 4; ++n) {
        const int col = n0 + wc * 64 + 16 * n + 4 * fq;
        const f32x4 xv = *(const f32x4*)(xin + (size_t)t * D + col);
        const f32x4 g1 = *(const f32x4*)(modl + (size_t)b * 6144 + 2 * 1024 + col);
        f32x4 o;
#pragma unroll
        for (int j = 0; j < 4; ++j) o[j] = xv[j] + g1[j] * (acc[m][n][j] * rs[m]);
        *(u32x2*)(p.x1() + (size_t)t * D + col) = (u32x2){pack2(o[0], o[1]), pack2(o[2], o[3])};
      }
    }
  }
}
__device__ __forceinline__ void phase_norm2_route(const MP& p, int l, char* smem) {
  const int tid = launder(threadIdx.x);
  const int wave = tid >> 6, lane = tid & 63;
  float* wrT = (float*)smem;
  for (int i = tid; i < 1024 * 4; i += NTHR) {
    const int k = i >> 2, e4 = (i & 3) * 4;
    const float4 v = *(const float4*)(p.in.w_router + (size_t)k * 16 + e4);
    wrT[(e4 + 0) * 1024 + k] = v.x; wrT[(e4 + 1) * 1024 + k] = v.y; wrT[(e4 + 2) * 1024 + k] = v.z; wrT[(e4 + 3) * 1024 + k] = v.w;
  }
  __syncthreads();
  const float* modl = p.mod() + (size_t)l * 8 * 6144;
  float rb[16];
#pragma unroll
  for (int e = 0; e < 16; ++e) rb[e] = p.in.router_bias[e];
  int* cntl = p.cnt() + l * 256;
  int my_t = -1, my_bucket = 0; float my_wlo = 0.f, my_whi = 0.f;
  const float* g2n = p.in.norm2_g + l * D;
  const int tstep = gridDim.x * 4;
  int t = blockIdx.x * 4 + wave;
  float4 xv[4];
  if (t < T) {
#pragma unroll
    for (int i = 0; i < 4; ++i) { const u32x2 r = *(const u32x2*)(p.x1() + (size_t)t * D + lane * 4 + 256 * i); xv[i] = make_float4(bf_lo(r[0]), bf_hi(r[0]), bf_lo(r[1]), bf_hi(r[1])); }
  }
  for (int slot = 0; t < T; t += tstep, ++slot) {
    const int b = t / S;
    float4 xn[4];
    const int tn = t + tstep < T ? t + tstep : t;
#pragma unroll
    for (int i = 0; i < 4; ++i) { const u32x2 r = *(const u32x2*)(p.x1() + (size_t)tn * D + lane * 4 + 256 * i); xn[i] = make_float4(bf_lo(r[0]), bf_hi(r[0]), bf_lo(r[1]), bf_hi(r[1])); }
    float ss = 0.f;
#pragma unroll
    for (int i = 0; i < 4; ++i) ss += xv[i].x * xv[i].x + xv[i].y * xv[i].y + xv[i].z * xv[i].z + xv[i].w * xv[i].w;
    ss = wave_sum(ss);
    const float rinv = rsqrtf(ss * (1.f / D) + EPS);
    const float* sh = modl + (size_t)b * 6144 + 3 * 1024; const float* sc = modl + (size_t)b * 6144 + 4 * 1024;
    float hv[16];
#pragma unroll
    for (int i = 0; i < 4; ++i) {
      const int d = lane * 4 + 256 * i;
      const float4 gg = *(const float4*)(g2n + d), s1 = *(const float4*)(sc + d), s0 = *(const float4*)(sh + d);
      hv[4 * i + 0] = xv[i].x * rinv * gg.x * (1.f + s1.x) + s0.x;
      hv[4 * i + 1] = xv[i].y * rinv * gg.y * (1.f + s1.y) + s0.y;
      hv[4 * i + 2] = xv[i].z * rinv * gg.z * (1.f + s1.z) + s0.z;
      hv[4 * i + 3] = xv[i].w * rinv * gg.w * (1.f + s1.w) + s0.w;
      *(u32x2*)(p.h() + (size_t)t * D + d) = (u32x2){pack2(hv[4 * i], hv[4 * i + 1]), pack2(hv[4 * i + 2], hv[4 * i + 3])};
    }
    float a[16];
    const int loff = launder(lane * 4);
#pragma unroll
    for (int e = 0; e < 16; ++e) {
      float s = 0.f;
#pragma unroll
      for (int i = 0; i < 4; ++i) {
        const f32x4 w = *(const f32x4*)(wrT + e * 1024 + loff + 256 * i);
        s += hv[4 * i] * w[0] + hv[4 * i + 1] * w[1] + hv[4 * i + 2] * w[2] + hv[4 * i + 3] * w[3];
      }
      a[e] = s;
    }
    float lg[16];
#pragma unroll
    for (int e = 0; e < 16; ++e) lg[e] = wave_sum(a[e]);
    float mx = lg[0];
#pragma unroll
    for (int e = 1; e < 16; ++e) mx = fmaxf(mx, lg[e]);
    float pr[16], sel[16]; float sum = 0.f;
#pragma unroll
    for (int e = 0; e < 16; ++e) { pr[e] = __expf(lg[e] - mx); sum += pr[e]; }
    const float inv = 1.f / sum;
#pragma unroll
    for (int e = 0; e < 16; ++e) { pr[e] *= inv; sel[e] = pr[e] + rb[e]; }
    int gbest = 0; float gbs = -1e30f;
#pragma unroll
    for (int g = 0; g < 4; ++g) {
      float m1 = -1e30f, m2 = -1e30f;
#pragma unroll
      for (int j = 0; j < 4; ++j) { const float v = sel[g * 4 + j]; if (v > m1) { m2 = m1; m1 = v; } else if (v > m2) m2 = v; }
      const float gs = m1 + m2;
      if (gs > gbs) { gbs = gs; gbest = g; }
    }
    float s4[4], p4[4];
#pragma unroll
    for (int j = 0; j < 4; ++j) { s4[j] = sel[j]; p4[j] = pr[j]; }
#pragma unroll
    for (int g = 1; g < 4; ++g) if (g == gbest) {
#pragma unroll
      for (int j = 0; j < 4; ++j) { s4[j] = sel[g * 4 + j]; p4[j] = pr[g * 4 + j]; }
    }
    int i0 = 0; float b0 = s4[0];
#pragma unroll
    for (int j = 1; j < 4; ++j) if (s4[j] > b0) { b0 = s4[j]; i0 = j; }
    int i1 = -1; float bb1 = -1e30f;
#pragma unroll
    for (int j = 0; j < 4; ++j) if (j != i0 && s4[j] > bb1) { bb1 = s4[j]; i1 = j; }
    float p0 = 0.f, p1 = 0.f;
#pragma unroll
    for (int j = 0; j < 4; ++j) { if (j == i0) p0 = p4[j]; if (j == i1) p1 = p4[j]; }
    const float w0 = p0 / (p0 + p1), w1 = p1 / (p0 + p1);
    const int lo = i0 < i1 ? i0 : i1, hi = i0 < i1 ? i1 : i0;
    const float wlo = i0 < i1 ? w0 : w1, whi = i0 < i1 ? w1 : w0;
    const int pidx = (lo == 0) ? (hi - 1) : (lo == 1 ? (hi + 1) : 5);
    const int bucket = gbest * 6 + pidx;
    if (lane == slot) { my_t = t; my_bucket = bucket; my_wlo = wlo; my_whi = whi; }
#pragma unroll
    for (int i = 0; i < 4; ++i) xv[i] = xn[i];
  }
  if (my_t >= 0) {
    const int sl = my_bucket * NSUBL + (blockIdx.x & (NSUBL - 1));
    const int pos = atomicAdd(&cntl[sl], 1);
    p.list()[(size_t)sl * T + pos] = my_t;
    p.tokw()[my_t] = make_float2(my_wlo, my_whi);
  }
  __syncthreads();
}

__device__ __forceinline__ void bucket_experts2(int bucket, int& elo, int& ehi) {
  const int g = bucket / 6, pi = bucket % 6;
  const int lo = pi < 3 ? 0 : (pi < 5 ? 1 : 2);
  const int hi = pi < 3 ? pi + 1 : (pi < 5 ? pi - 1 : 3);
  elo = g * 4 + lo; ehi = g * 4 + hi;
}
__device__ __forceinline__ void moe_map_build(const int* cnt, int* mm, int tid) {
  if (tid < NBUCKET) {
    int acc = 0;
#pragma unroll
    for (int x = 0; x < NSUBL; ++x) { mm[32 + 16 * tid + x] = acc; acc += cnt[tid * NSUBL + x]; }
    mm[32 + 16 * tid + 8] = acc;
  }
  __syncthreads();
  if (tid == 0) {
    int acc = 0;
    for (int bk = 0; bk < NBUCKET; ++bk) { mm[bk] = acc; acc += (mm[32 + 16 * bk + 8] + TM - 1) / TM; }
    mm[NBUCKET] = acc;
  }
  __syncthreads();
}
__device__ __forceinline__ void moe_find_tile(const int* mm, int mt, int& bucket, int& tib, int& nrow) {
  int bk = 0;
#pragma unroll
  for (int j = 1; j < NBUCKET; ++j) bk += (mt >= mm[j]) ? 1 : 0;
  bucket = bk; tib = mt - mm[bk]; nrow = mm[32 + 16 * bk + 8] - tib * TM;
}
__device__ __forceinline__ int moe_token(const int* list, const int* mm, int bk, int q) {
  const int* sp = mm + 32 + 16 * bk;
  int x = 0, s = 0;
#pragma unroll
  for (int j = 1; j < NSUBL; ++j) { const int v = sp[j]; const bool ge = q >= v; x += ge ? 1 : 0; s = ge ? v : s; }
  return list[(size_t)(bk * NSUBL + x) * T + (q - s)];
}

__device__ __forceinline__ void phase_moe_gu(const MP& p, int l, char* smem) {
  const int tid = launder(threadIdx.x), lane = tid & 63, wave = tid >> 6, wr = wave >> 1, wc = wave & 1, fr = lane & 15, fq = lane >> 4;
  const int r0 = tid >> 3;
  int* mm = (int*)(smem + SMEM_MM);
  moe_map_build(p.cnt() + l * 256, mm, tid);
  const int nmt = mm[NBUCKET];
  const int ntiles = nmt * 16;
  auto make = [&](int tile, GemmTile& g) {
    const int mt = tile >> 4, nt = tile & 15;
    int bucket, tib, nrow;
    moe_find_tile(mm, mt, bucket, tib, nrow);
    int elo, ehi; bucket_experts2(bucket, elo, ehi);
    const int e = nt < 8 ? elo : ehi, f0 = (nt & 7) * 64;
    g.A0 = p.h(); g.A1 = p.h(); g.lda = D; g.ksA = D; g.K = D;
    const bf16_t* Wg = p.WgT() + ((size_t)(l * NE + e) * DFF + f0) * D;
    const bf16_t* Wu = p.WuT() + ((size_t)(l * NE + e) * DFF + f0) * D;
#pragma unroll
    for (int i = 0; i < 4; ++i) {
      const int r = r0 + 32 * i;
      g.arow[i] = moe_token(p.list(), mm, bucket, tib * TM + (r < nrow ? r : nrow - 1));
    }
    g.Blo0 = Wg; g.Bhi0 = Wu; g.Blo1 = Wg; g.Bhi1 = Wu;
    g.ldb = D; g.ksB = D;
  };
  GemmTile g, gn; bool pre = false;
  const TileMap tmap = tm_init(nmt, 16);
  { const int t0 = tm_tile(tmap, 0); if (t0 >= 0) { make(t0, g); gn = g; } }
  for (int jt = 0; ; ++jt) {
    const int tile = tm_tile(tmap, jt); if (tile < 0) break;
    const int mt = tile >> 4, nt = tile & 15;
    int bucket, tib, nrow;
    moe_find_tile(mm, mt, bucket, tib, nrow);
    const int f0 = (nt & 7) * 64;
    const int nxt = tm_tile(tmap, jt + 1); const bool hasn = nxt >= 0;
    if (hasn) make(nxt, gn);
    float wv[4];
#pragma unroll
    for (int m = 0; m < 4; ++m) {
      const int r = wr * 64 + 16 * m + fr;
      const float2 ww = p.tokw()[moe_token(p.list(), mm, bucket, tib * TM + (r < nrow ? r : nrow - 1))];
      wv[m] = r < nrow ? (nt < 8 ? ww.x : ww.y) : 0.f;
    }
    f32x4 acc[4][4];
    gemm_mainloop<true>(g, gn, hasn, pre, smem, acc);
    pre = hasn; g = gn;
#pragma unroll
    for (int m = 0; m < 4; ++m) {
      const int r = wr * 64 + 16 * m + fr;
      const float w = wv[m];
      bf16_t* dst = p.act() + (size_t)(mt * TM + r) * D + (nt < 8 ? 0 : 512) + f0 + wc * 32 + 4 * fq;
#pragma unroll
      for (int n = 0; n < 2; ++n) {
        float o[4];
#pragma unroll
        for (int j = 0; j < 4; ++j) { const float gv = acc[m][n][j], uv = acc[m][n + 2][j]; o[j] = gv * __builtin_amdgcn_rcpf(1.f + __expf(-gv)) * uv * w; }
        *(u32x2*)(dst + 16 * n) = (u32x2){pack2(o[0], o[1]), pack2(o[2], o[3])};
      }
    }
  }
}

__device__ __forceinline__ void phase_moe_down(const MP& p, int l, char* smem) {
  const int tid = launder(threadIdx.x), lane = tid & 63, wave = tid >> 6, wr = wave >> 1, wc = wave & 1, fr = lane & 15, fq = lane >> 4;
  const int r0 = tid >> 3;
  int* mm = (int*)(smem + SMEM_MM);
  moe_map_build(p.cnt() + l * 256, mm, tid);
  const float* modl = p.mod() + (size_t)l * 8 * 6144;
  const int nmt = mm[NBUCKET];
  const int ntiles = nmt * 8;
  auto make = [&](int tile, GemmTile& g) {
    const int mt = tile >> 3, n0 = (tile & 7) * 128;
    int bucket, tib, nrow;
    moe_find_tile(mm, mt, bucket, tib, nrow);
    int elo, ehi; bucket_experts2(bucket, elo, ehi);
    g.A0 = p.act(); g.A1 = p.act(); g.lda = D; g.ksA = D; g.K = D;
    const bf16_t* Wlo = p.WdT() + ((size_t)(l * NE + elo) * D + n0) * DFF;
    const bf16_t* Whi = p.WdT() + ((size_t)(l * NE + ehi) * D + n0) * DFF;
#pragma unroll
    for (int i = 0; i < 4; ++i) {
      g.arow[i] = mt * TM + r0 + 32 * i;
    }
    g.Blo0 = Wlo; g.Bhi0 = Wlo + (size_t)64 * DFF; g.Blo1 = Whi; g.Bhi1 = Whi + (size_t)64 * DFF;
    g.ldb = DFF; g.ksB = DFF;
  };
  GemmTile g, gn; bool pre = false;
  const TileMap tmap = tm_init(nmt, 8);
  { const int t0 = tm_tile(tmap, 0); if (t0 >= 0) { make(t0, g); gn = g; } }
  for (int jt = 0; ; ++jt) {
    const int tile = tm_tile(tmap, jt); if (tile < 0) break;
    const int mt = tile >> 3, nt = tile & 7, n0 = nt * 128;
    int bucket, tib, nrow;
    moe_find_tile(mm, mt, bucket, tib, nrow);
    const int nxt = tm_tile(tmap, jt + 1); const bool hasn = nxt >= 0;
    if (hasn) make(nxt, gn);
    int tkv[4];
#pragma unroll
    for (int m = 0; m < 4; ++m) {
      const int r = wr * 64 + 16 * m + fr;
      tkv[m] = moe_token(p.list(), mm, bucket, tib * TM + (r < nrow ? r : nrow - 1));
    }
    f32x4 acc[4][4];
    gemm_mainloop<false>(g, gn, hasn, pre, smem, acc);
    pre = hasn; g = gn;
#pragma unroll
    for (int m = 0; m < 4; ++m) {
      const int r = wr * 64 + 16 * m + fr;
      const int tk = tkv[m], b = tk / S;
      f32x4 o[4];
#pragma unroll
      for (int n = 0; n < 4; ++n) {
        const int col = n0 + wc * 64 + 16 * n + 4 * fq;
        const u32x2 xr = *(const u32x2*)(p.x1() + (size_t)tk * D + col);
        const f32x4 xv = {bf_lo(xr[0]), bf_hi(xr[0]), bf_lo(xr[1]), bf_hi(xr[1])};
        const f32x4 g2 = *(const f32x4*)(modl + (size_t)b * 6144 + 5 * 1024 + col);
#pragma unroll
        for (int j = 0; j < 4; ++j) o[n][j] = xv[j] + g2[j] * acc[m][n][j];
      }
      if (r < nrow) {
#pragma unroll
        for (int n = 0; n < 4; ++n) *(f32x4*)(p.out + (size_t)tk * D + n0 + wc * 64 + 16 * n + 4 * fq) = o[n];
      }
    }
  }
}
#define XB_TMO      128
#define XB_XCNT(j)  (256  + 64 * (j))
#define XB_XSUB(j)  (1280 + 64 * (j))
#define XB_XGEN(j)  (2304 + 64 * (j))
#define XB_TOP      3328
#define XB_TOPGEN   3392
#define XCD_BAR_WORDS 3456
#define XB_SPIN_CAP (1u << 22)
#define LAS __attribute__((address_space(3)))

__device__ __forceinline__ unsigned xb_ld(unsigned* p)              { return __hip_atomic_load(p, __ATOMIC_RELAXED, __HIP_MEMORY_SCOPE_AGENT); }
__device__ __forceinline__ unsigned xb_add(unsigned* p, unsigned v) { return __hip_atomic_fetch_add(p, v, __ATOMIC_RELAXED, __HIP_MEMORY_SCOPE_AGENT); }
__device__ __forceinline__ unsigned xb_xcc_id() { return (unsigned)__builtin_amdgcn_s_getreg((3 << 11) | 20) & 0xFu; }
#define XB_SPIN(cond, bar) do { unsigned _sp = 0; while (cond) { __builtin_amdgcn_s_sleep(1); \
    if ((++_sp & 255u) == 0u) { if (xb_ld(&(bar)[XB_TMO])) break; if (_sp > XB_SPIN_CAP) { atomicAdd(&(bar)[XB_TMO], 1u); break; } } } } while (0)

struct XcdBarrier { unsigned* bar; unsigned x; volatile LAS unsigned* st; };

__device__ __forceinline__ XcdBarrier xcd_barrier_post(unsigned* bar, volatile LAS unsigned* st) {
  XcdBarrier b; b.bar = bar; b.x = xb_xcc_id(); b.st = st;
  if (threadIdx.x == 0) (void)xb_add(&bar[XB_XCNT(b.x)], 1u);
  return b;
}
__device__ __forceinline__ void xcd_barrier_complete(unsigned* bar, unsigned x, unsigned& nloc, unsigned& nx) {
  const unsigned G = gridDim.x * gridDim.y * gridDim.z;
  unsigned sum, cnt, mine, sp = 0u;
  for (;;) {
    sum = 0u; cnt = 0u; mine = 0u;
#pragma unroll
    for (unsigned j = 0; j < 16; ++j) { const unsigned c = xb_ld(&bar[XB_XCNT(j)]); sum += c; cnt += (c > 0u) ? 1u : 0u; mine = (j == x) ? c : mine; }
    if (sum == G) break;
    __builtin_amdgcn_s_sleep(1);
    if ((++sp & 255u) == 0u) { if (xb_ld(&bar[XB_TMO])) break; if (sp > XB_SPIN_CAP) { atomicAdd(&bar[XB_TMO], 1u); break; } }
  }
  nloc = mine > 0u ? mine : 1u; nx = cnt > 0u ? cnt : 1u;
}
__device__ __forceinline__ void xcd_barrier(const XcdBarrier& b) {
  asm volatile("s_waitcnt vmcnt(0)" ::: "memory");
  __syncthreads();
  if (threadIdx.x == 0) {
    unsigned* bar = b.bar;
    __builtin_amdgcn_s_waitcnt(0);
    unsigned nloc = b.st[0], nx = b.st[1];
    if (nloc == 0u) { xcd_barrier_complete(bar, b.x, nloc, nx); b.st[0] = nloc; b.st[1] = nx; }
    const unsigned old = xb_add(&bar[XB_XSUB(b.x)], 1u);
    const unsigned gen = old / nloc;
    if (old + 1u == (gen + 1u) * nloc) {
      __builtin_amdgcn_fence(__ATOMIC_RELEASE, "agent");
      asm volatile("s_waitcnt vmcnt(0)" ::: "memory");
      const unsigned og = xb_add(&bar[XB_TOP], 1u);
      const unsigned tg = og / nx;
      if (og + 1u == (tg + 1u) * nx) xb_add(&bar[XB_TOPGEN], 1u);
      else XB_SPIN(xb_ld(&bar[XB_TOPGEN]) == tg, bar);
      __builtin_amdgcn_fence(__ATOMIC_ACQUIRE, "agent");
      xb_add(&bar[XB_XGEN(b.x)], 1u);
      asm volatile("s_waitcnt vmcnt(0)" ::: "memory");
    } else {
      XB_SPIN(xb_ld(&bar[XB_XGEN(b.x)]) == gen, bar);
      __builtin_amdgcn_fence(__ATOMIC_ACQUIRE, "agent");
      asm volatile("s_waitcnt vmcnt(0)" ::: "memory");
    }
  }
  __syncthreads();
}

constexpr int NSUB = 9;

template <int L>
__device__ __forceinline__ void run_layer(const MP& p, char* smem, const XcdBarrier& xb, int ssm_wid, int idle_id) {
  constexpr int l = L;
  const float* xin = L == 0 ? p.in.x : p.out;
  phase_norm1(p, l, xin);          xcd_barrier(xb);
  phase_inproj(p, l, smem);        xcd_barrier(xb);
  phase_attn(p, l);                xcd_barrier(xb);
  phase_ssm(p, l, smem, ssm_wid);
  {
    constexpr int TT_SMALL = TT_WIN + TT_GLU + TT_OUT;
    const int nidle = (int)__hip_atomic_load(p.claim() + 4097, __ATOMIC_RELAXED, __HIP_MEMORY_SCOPE_AGENT);
    if (nidle == 0) phase0_transposes(p, smem, L * TT_LAYER + TT_SMALL, (L + 1) * TT_LAYER, blockIdx.x, gridDim.x);
    else if (idle_id >= 0) phase0_transposes(p, smem, L * TT_LAYER + TT_SMALL, (L + 1) * TT_LAYER, launder_s(__builtin_amdgcn_readfirstlane(idle_id)), nidle);
  }
  xcd_barrier(xb);
  phase_glu(p, l, smem);           xcd_barrier(xb);
  phase_out(p, l, smem, xin);      xcd_barrier(xb);
  phase_norm2_route(p, l, smem);   xcd_barrier(xb);
  phase_moe_gu(p, l, smem);        xcd_barrier(xb);
  phase_moe_down(p, l, smem);
  if (L + 1 < DEPTH) xcd_barrier(xb);
}

__global__ void __launch_bounds__(NTHR, 2) mega(MP p) {
  __shared__ __attribute__((aligned(16))) char smem[65536 + 16 + 2048];
  unsigned* xb_words = (unsigned*)(smem + 65536);
  if (threadIdx.x < 4) xb_words[threadIdx.x] = 0u;
  __syncthreads();
  const XcdBarrier xb = xcd_barrier_post(p.bar(), (volatile LAS unsigned*)xb_words);
  if (threadIdx.x == 0) {
    const unsigned key = (xb_xcc_id() << 8) | ((unsigned)__builtin_amdgcn_s_getreg((7 << 11) | (8 << 6) | 4) & 0xffu);
    const unsigned rank = xb_add(p.claim() + key, 1u);
    xb_words[2] = rank == 0u ? xb_add(p.claim() + 4096, 1u) : 0xffffffffu;
    xb_words[3] = rank == 0u ? 0xffffffffu : xb_add(p.claim() + 4097, 1u);
  }
  __syncthreads();
  const int ssm_wid = (int)xb_words[2], idle_id = (int)xb_words[3];
  for (int it = blockIdx.x; it < P0_MISC; it += gridDim.x) phase0_item(p, it, smem);
  phase0_transposes(p, smem, 0, TT_WIN + TT_GLU + TT_OUT, blockIdx.x, gridDim.x);
  phase0_transposes(p, smem, TT_LAYER, TT_LAYER + TT_WIN + TT_GLU + TT_OUT, blockIdx.x, gridDim.x);
  xcd_barrier(xb);
  run_layer<0>(p, smem, xb, ssm_wid, idle_id);
  run_layer<1>(p, smem, xb, ssm_wid, idle_id);
  static_assert(DEPTH == 2, "two layers instantiated");
}

}

extern "C" void kernel_launch(void* const* d_in, const int* in_sizes, int n_in, void* d_out, int out_size, void* d_ws,
                              size_t ws_size, hipStream_t stream) {
  MP p; memset(&p, 0, sizeof(p));
  Ptrs& P = p.in;
  P.x = (const float*)d_in[0]; P.c = (const float*)d_in[1]; P.pos = (const int*)d_in[2];
  P.ada_w = (const float*)d_in[3]; P.ada_b = (const float*)d_in[4]; P.norm1_g = (const float*)d_in[5];
  P.w_in = (const float*)d_in[6]; P.q_norm_g = (const float*)d_in[7]; P.k_norm_g = (const float*)d_in[8];
  P.attn_sink = (const float*)d_in[9]; P.lam_re = (const float*)d_in[10]; P.lam_im = (const float*)d_in[11];
  P.b_re = (const float*)d_in[12]; P.b_im = (const float*)d_in[13]; P.c_re = (const float*)d_in[14]; P.c_im = (const float*)d_in[15];
  P.ssm_d = (const float*)d_in[16]; P.log_dt = (const float*)d_in[17]; P.w_glu = (const float*)d_in[18];
  P.attn_out_g = (const float*)d_in[19]; P.ssm_out_g = (const float*)d_in[20]; P.w_out = (const float*)d_in[21];
  P.norm2_g = (const float*)d_in[22]; P.w_router = (const float*)d_in[23]; P.router_bias = (const float*)d_in[24];
  P.w_gate = (const float*)d_in[25]; P.w_up = (const float*)d_in[26]; P.w_down = (const float*)d_in[27];
  p.out = (float*)d_out;

  p.ws = (char*)d_ws;
  if (WS_TOTAL > ws_size) { fprintf(stderr, "workspace too small: need %zu have %zu\n", (size_t)WS_TOTAL, ws_size); return; }
  (void)in_sizes; (void)n_in; (void)out_size;

  static int grid_blocks = 0;
  if (!grid_blocks) {
    int dev = 0, cus = 0, per_cu = 0;
    (void)hipGetDevice(&dev);
    (void)hipDeviceGetAttribute(&cus, hipDeviceAttributeMultiprocessorCount, dev);
    (void)hipOccupancyMaxActiveBlocksPerMultiprocessor(&per_cu, mega, NTHR, 0);
    if (per_cu > 2) per_cu = 2;
    if (per_cu < 1) per_cu = 1;
    grid_blocks = cus * per_cu;
  }
  (void)hipMemsetAsync(p.ws + OFF_BAR, 0, OFF_MOD - OFF_BAR, stream);
  void* args[] = {&p};
  hipError_t e = hipLaunchCooperativeKernel((void*)mega, dim3(grid_blocks), dim3(NTHR), args, 0, stream);
  if (e != hipSuccess) fprintf(stderr, "cooperative launch failed: %s (grid %d)\n", hipGetErrorString(e), grid_blocks);
}
```

```cpp
#include <hip/hip_runtime.h>
#include <hip/hip_cooperative_groups.h>
#include <stdint.h>
#include <cstdio>
#include <cstring>

namespace {
constexpr int D = 1024, NB = 8, S = 2048, T = NB * S, DEPTH = 2;
constexpr int AW = 512, HD = 64, NQ = 8, NKV = 2, INW = 1280;
constexpr int SG = 32, SCH = 16, SP = 64, SW = 512;
constexpr int NE = 16, DFF = 512;
constexpr int NBUCKET = 24;
constexpr float EPS = 1e-6f;

struct Ptrs {
  const float *x, *c; const int* pos; const float *ada_w, *ada_b, *norm1_g, *w_in, *q_norm_g, *k_norm_g, *attn_sink,
      *lam_re, *lam_im, *b_re, *b_im, *c_re, *c_im, *ssm_d, *log_dt, *w_glu, *attn_out_g, *ssm_out_g, *w_out, *norm2_g,
      *w_router, *router_bias, *w_gate, *w_up, *w_down;
};

__device__ __forceinline__ float row_sum32_dpp(float v) {
  v += __int_as_float(__builtin_amdgcn_update_dpp(0, __float_as_int(v), 0xB1, 0xF, 0xF, true));
  v += __int_as_float(__builtin_amdgcn_update_dpp(0, __float_as_int(v), 0x4E, 0xF, 0xF, true));
  v += __int_as_float(__builtin_amdgcn_update_dpp(0, __float_as_int(v), 0x141, 0xF, 0xF, true));
  v += __int_as_float(__builtin_amdgcn_update_dpp(0, __float_as_int(v), 0x140, 0xF, 0xF, true));
  v += __int_as_float(__builtin_amdgcn_update_dpp(0, __float_as_int(v), 0x142, 0xA, 0xF, false));
  return v;
}
__device__ __forceinline__ float wave_sum(float v) {
  v = row_sum32_dpp(v);
  return __int_as_float(__builtin_amdgcn_readlane(__float_as_int(v), 31)) + __int_as_float(__builtin_amdgcn_readlane(__float_as_int(v), 63));
}
__device__ __forceinline__ float xhalf_sum(float v) {
  const auto r = __builtin_amdgcn_permlane32_swap(__float_as_uint(v), __float_as_uint(v), false, false);
  return __uint_as_float(r[0]) + __uint_as_float(r[1]);
}
__device__ __forceinline__ float xhalf_max(float v) {
  const auto r = __builtin_amdgcn_permlane32_swap(__float_as_uint(v), __float_as_uint(v), false, false);
  return fmaxf(__uint_as_float(r[0]), __uint_as_float(r[1]));
}

typedef unsigned short bf16_t;
typedef short bf16x8 __attribute__((ext_vector_type(8)));
typedef float f32x4 __attribute__((ext_vector_type(4)));
typedef float f32x16 __attribute__((ext_vector_type(16)));
typedef float f32x2 __attribute__((ext_vector_type(2)));
typedef __bf16 bf16x2_t __attribute__((ext_vector_type(2)));
typedef unsigned u32x4 __attribute__((ext_vector_type(4)));
typedef unsigned u32x2 __attribute__((ext_vector_type(2)));

constexpr int NTHR = 256;
constexpr int TM = 128;
constexpr int MAXMT = T / TM + NBUCKET;
constexpr int NSUBL = 8;
constexpr int SMEM_MM = 65536 + 16;

__device__ __forceinline__ unsigned pack2(float lo, float hi) {
  f32x2 v = {lo, hi};
  return __builtin_bit_cast(unsigned, __builtin_convertvector(v, bf16x2_t));
}
__device__ __forceinline__ int launder(int x) { asm volatile("" : "+v"(x)); return x; }
__device__ __forceinline__ int launder_s(int x) { asm volatile("" : "+s"(x)); return x; }
__device__ __forceinline__ float bf_lo(unsigned u) { return __uint_as_float(u << 16); }
__device__ __forceinline__ float bf_hi(unsigned u) { return __uint_as_float(u & 0xffff0000u); }
__device__ __forceinline__ float bf1(bf16_t u) { return __uint_as_float(((unsigned)u) << 16); }

constexpr size_t al256(size_t x) { return (x + 255) & ~(size_t)255; }
constexpr size_t OFF_BAR = 0;
constexpr size_t OFF_CLAIM = OFF_BAR + al256(4096 * 4);
constexpr size_t OFF_MOD = OFF_CLAIM + al256(4096 * 4 + 256);
constexpr size_t OFF_CS = OFF_MOD + al256((size_t)DEPTH * 8 * 6144 * 4);
constexpr size_t OFF_CNT = OFF_CS + al256((size_t)T * 32 * 8);
constexpr size_t OFF_LIST = OFF_CNT + al256(256 * 4 * DEPTH);
constexpr size_t OFF_TOKW = OFF_LIST + al256((size_t)NBUCKET * NSUBL * T * 4);
constexpr size_t OFF_SSMB = OFF_TOKW + al256((size_t)T * 8);
constexpr size_t OFF_SSMC = OFF_SSMB + al256((size_t)DEPTH * SG * 128 * 16 * 2);
constexpr size_t OFF_SSML = OFF_SSMC + al256((size_t)DEPTH * SG * 16 * 128 * 2);
constexpr size_t OFF_WINT = OFF_SSML + al256((size_t)DEPTH * SG * SP * 2 * 4);
constexpr size_t OFF_WGLUT = OFF_WINT + al256((size_t)DEPTH * INW * D * 2);
constexpr size_t OFF_WOUTT = OFF_WGLUT + al256((size_t)DEPTH * SW * SW * 2);
constexpr size_t OFF_H = OFF_WOUTT + al256((size_t)DEPTH * D * D * 2);
constexpr size_t OFF_Q = OFF_H + al256((size_t)T * D * 2);
constexpr size_t OFF_K = OFF_Q + al256((size_t)T * AW * 2);
constexpr size_t OFF_VT = OFF_K + al256((size_t)T * 128 * 2);
constexpr size_t OFF_U = OFF_VT + al256((size_t)T * 128 * 2);
constexpr size_t OFF_ATTN = OFF_U + al256((size_t)T * SW * 2);
constexpr size_t OFF_ACT = OFF_Q;
static_assert((size_t)MAXMT * TM * D * 2 <= OFF_ATTN - OFF_Q, "act overlay too small");
constexpr size_t OFF_SSQA = OFF_ATTN + al256((size_t)T * AW * 2);
constexpr size_t OFF_Y = OFF_SSQA + al256((size_t)T * 8 * 4);
constexpr size_t OFF_SSM = OFF_Y + al256((size_t)T * SW * 2);
constexpr size_t OFF_SSQS = OFF_SSM + al256((size_t)T * SW * 2);
constexpr size_t OFF_X1 = OFF_SSQS + al256((size_t)T * 8 * 4);
constexpr size_t OFF_WGT = OFF_X1 + al256((size_t)T * D * 4);
constexpr size_t OFF_WUT = OFF_WGT + al256((size_t)DEPTH * NE * DFF * D * 2);
constexpr size_t OFF_WDT = OFF_WUT + al256((size_t)DEPTH * NE * DFF * D * 2);
constexpr size_t WS_TOTAL = OFF_WDT + al256((size_t)DEPTH * NE * DFF * D * 2);

struct MP {
  Ptrs in;
  float* out;
  char* ws;
  __device__ __forceinline__ unsigned* bar() const { return (unsigned*)(ws + OFF_BAR); }
  __device__ __forceinline__ unsigned* claim() const { return (unsigned*)(ws + OFF_CLAIM); }
  __device__ __forceinline__ float* mod() const { return (float*)(ws + OFF_MOD); }
  __device__ __forceinline__ float2* cs() const { return (float2*)(ws + OFF_CS); }
  __device__ __forceinline__ int* cnt() const { return (int*)(ws + OFF_CNT); }
  __device__ __forceinline__ int* list() const { return (int*)(ws + OFF_LIST); }
  __device__ __forceinline__ float2* tokw() const { return (float2*)(ws + OFF_TOKW); }
  __device__ __forceinline__ bf16_t* ssmB() const { return (bf16_t*)(ws + OFF_SSMB); }
  __device__ __forceinline__ bf16_t* ssmC() const { return (bf16_t*)(ws + OFF_SSMC); }
  __device__ __forceinline__ float* ssmL() const { return (float*)(ws + OFF_SSML); }
  __device__ __forceinline__ bf16_t* WinT() const { return (bf16_t*)(ws + OFF_WINT); }
  __device__ __forceinline__ bf16_t* WgluT() const { return (bf16_t*)(ws + OFF_WGLUT); }
  __device__ __forceinline__ bf16_t* WoutT() const { return (bf16_t*)(ws + OFF_WOUTT); }
  __device__ __forceinline__ bf16_t* WgT() const { return (bf16_t*)(ws + OFF_WGT); }
  __device__ __forceinline__ bf16_t* WuT() const { return (bf16_t*)(ws + OFF_WUT); }
  __device__ __forceinline__ bf16_t* WdT() const { return (bf16_t*)(ws + OFF_WDT); }
  __device__ __forceinline__ bf16_t* h() const { return (bf16_t*)(ws + OFF_H); }
  __device__ __forceinline__ bf16_t* q() const { return (bf16_t*)(ws + OFF_Q); }
  __device__ __forceinline__ bf16_t* k() const { return (bf16_t*)(ws + OFF_K); }
  __device__ __forceinline__ bf16_t* vT() const { return (bf16_t*)(ws + OFF_VT); }
  __device__ __forceinline__ bf16_t* u() const { return (bf16_t*)(ws + OFF_U); }
  __device__ __forceinline__ bf16_t* attn() const { return (bf16_t*)(ws + OFF_ATTN); }
  __device__ __forceinline__ bf16_t* y() const { return (bf16_t*)(ws + OFF_Y); }
  __device__ __forceinline__ bf16_t* ssm() const { return (bf16_t*)(ws + OFF_SSM); }
  __device__ __forceinline__ bf16_t* act() const { return (bf16_t*)(ws + OFF_ACT); }
  __device__ __forceinline__ float* ssqa() const { return (float*)(ws + OFF_SSQA); }
  __device__ __forceinline__ float* ssqs() const { return (float*)(ws + OFF_SSQS); }
  __device__ __forceinline__ bf16_t* x1() const { return (bf16_t*)(ws + OFF_X1); }
};

constexpr int TT_WIN = 8 * 20, TT_GLU = 4 * 8, TT_OUT = 8 * 16, TT_EXP = 16 * 64;
constexpr int TT_LAYER = TT_WIN + TT_GLU + TT_OUT + 3 * TT_EXP;
constexpr int P0_MOD = DEPTH * 192;
constexpr int P0_TR = DEPTH * TT_LAYER;
constexpr int P0_CS = T * 32 / 256;
constexpr int P0_SSM = DEPTH * SG;
constexpr int P0_MISC = P0_MOD + P0_CS + P0_SSM + 1;

__device__ __forceinline__ void phase0_item(const MP& p, int it, char* smem) {
  const int tid = launder(threadIdx.x);
  float* ldsf = (float*)smem;
  if (it < P0_MOD) {
    const int l = it / 192, j0 = (it % 192) * 32;
    float* sc = ldsf;
    float* red = ldsf + 8192;
    for (int i = tid; i < 8192; i += NTHR) { float v = p.in.c[i]; sc[i] = v / (1.f + __expf(-v)); }
    __syncthreads();
    const int kg = tid >> 3, cq = (tid & 7) * 4;
    float acc[8][4];
#pragma unroll
    for (int b = 0; b < 8; ++b)
#pragma unroll
      for (int j = 0; j < 4; ++j) acc[b][j] = 0.f;
    const float* w = p.in.ada_w + (size_t)l * 1024 * 6144 + j0 + cq;
#pragma unroll 8
    for (int kk = 0; kk < 32; ++kk) {
      const int k = kg * 32 + kk;
      const float4 wv = *(const float4*)(w + (size_t)k * 6144);
#pragma unroll
      for (int b = 0; b < 8; ++b) { const float s = sc[b * 1024 + k]; acc[b][0] += s * wv.x; acc[b][1] += s * wv.y; acc[b][2] += s * wv.z; acc[b][3] += s * wv.w; }
    }
#pragma unroll
    for (int b = 0; b < 8; ++b) *(float4*)(red + (kg * 8 + b) * 32 + cq) = make_float4(acc[b][0], acc[b][1], acc[b][2], acc[b][3]);
    __syncthreads();
    {
      const int b = tid >> 5, c = tid & 31;
      float v = 0.f;
#pragma unroll 8
      for (int g = 0; g < 32; ++g) v += red[(g * 8 + b) * 32 + c];
      p.mod()[(size_t)(l * 8 + b) * 6144 + j0 + c] = v + p.in.ada_b[l * 6144 + j0 + c];
    }
    __syncthreads();
    return;
  }
  it -= P0_MOD;
  if (it < P0_CS) {
    const int i = it * 256 + tid, t = i >> 5, f = i & 31;
    const float freq = powf(10000.f, -(float)f / 32.f);
    const float ang = (float)p.in.pos[t] * freq;
    float sn, cn; sincosf(ang, &sn, &cn);
    p.cs()[i] = make_float2(cn, sn);
    return;
  }
  it -= P0_CS;
  if (it < P0_SSM) {
    const int lg = it;
    if (tid < 64) {
      const int pp = tid;
      const float dt = expf(p.in.log_dt[lg]);
      const float lr = p.in.lam_re[lg * SP + pp], li = p.in.lam_im[lg * SP + pp];
      const float mag = expf(lr * dt);
      float sn, cn; sincosf(li * dt, &sn, &cn);
      const float ar = mag * cn, ai = mag * sn;
      const float den = lr * lr + li * li;
      const float fr = ((ar - 1.f) * lr + ai * li) / den, fi = (ai * lr - (ar - 1.f) * li) / den;
      p.ssmL()[(lg * SP + pp) * 2] = ar; p.ssmL()[(lg * SP + pp) * 2 + 1] = ai;
      unsigned wr[8], wi[8];
#pragma unroll
      for (int hh = 0; hh < 8; ++hh) {
        const float br0 = p.in.b_re[((size_t)lg * SP + pp) * SCH + 2 * hh], bi0 = p.in.b_im[((size_t)lg * SP + pp) * SCH + 2 * hh];
        const float br1 = p.in.b_re[((size_t)lg * SP + pp) * SCH + 2 * hh + 1], bi1 = p.in.b_im[((size_t)lg * SP + pp) * SCH + 2 * hh + 1];
        wr[hh] = pack2(fr * br0 - fi * bi0, fr * br1 - fi * bi1);
        wi[hh] = pack2(fr * bi0 + fi * br0, fr * bi1 + fi * br1);
      }
      u32x4* dr = (u32x4*)(p.ssmB() + ((size_t)lg * 128 + pp) * 16);
      u32x4* di = (u32x4*)(p.ssmB() + ((size_t)lg * 128 + 64 + pp) * 16);
      dr[0] = (u32x4){wr[0], wr[1], wr[2], wr[3]}; dr[1] = (u32x4){wr[4], wr[5], wr[6], wr[7]};
      di[0] = (u32x4){wi[0], wi[1], wi[2], wi[3]}; di[1] = (u32x4){wi[4], wi[5], wi[6], wi[7]};
    }
    for (int o = tid; o < 16 * 64; o += NTHR) {
      const int hh = o >> 6, pp = o & 63;
      const float cr = p.in.c_re[(size_t)lg * SCH * SP + o], ci = p.in.c_im[(size_t)lg * SCH * SP + o];
      *(unsigned*)(p.ssmC() + ((size_t)lg * 16 + hh) * 128 + 2 * pp) = pack2(cr, -ci);
    }
    return;
  }
  for (int i = tid; i < 256 * DEPTH; i += NTHR) p.cnt()[i] = 0;
}

struct TrDesc { const float* src; bf16_t* dst; const float* gain; int N, K, k0, n0; };
__device__ __forceinline__ void tr_decode(const MP& p, int it, TrDesc& d) {
  const int l = it / TT_LAYER; int r = it % TT_LAYER;
  d.gain = nullptr;
  if (r < TT_WIN) { d.src = p.in.w_in + (size_t)l * D * INW; d.N = INW; d.dst = p.WinT() + (size_t)l * INW * D; d.K = D; d.k0 = (r / 20) * 128; d.n0 = (r % 20) * 64; return; }
  r -= TT_WIN;
  if (r < TT_GLU) { d.src = p.in.w_glu + (size_t)l * SW * SW; d.N = SW; d.dst = p.WgluT() + (size_t)l * SW * SW; d.K = SW; d.k0 = (r / 8) * 128; d.n0 = (r % 8) * 64; return; }
  r -= TT_GLU;
  if (r < TT_OUT) {
    d.k0 = (r / 16) * 128; d.n0 = (r % 16) * 64;
    d.gain = d.k0 < 512 ? (p.in.attn_out_g + l * AW) : (p.in.ssm_out_g + l * SW - 512);
    d.src = p.in.w_out + (size_t)l * D * D; d.N = D; d.dst = p.WoutT() + (size_t)l * D * D; d.K = D; return; }
  r -= TT_OUT;
  const int kind = r / TT_EXP; r %= TT_EXP;
  const int e = r / 64, tt = r % 64;
  if (kind == 0) { d.src = p.in.w_gate + (size_t)(l * NE + e) * D * DFF; d.N = DFF; d.dst = p.WgT() + (size_t)(l * NE + e) * DFF * D; d.K = D; d.k0 = (tt / 8) * 128; d.n0 = (tt % 8) * 64; return; }
  if (kind == 1) { d.src = p.in.w_up + (size_t)(l * NE + e) * D * DFF; d.N = DFF; d.dst = p.WuT() + (size_t)(l * NE + e) * DFF * D; d.K = D; d.k0 = (tt / 8) * 128; d.n0 = (tt % 8) * 64; return; }
  d.src = p.in.w_down + (size_t)(l * NE + e) * DFF * D; d.N = D; d.dst = p.WdT() + (size_t)(l * NE + e) * D * DFF; d.K = DFF; d.k0 = (tt / 16) * 128; d.n0 = (tt % 16) * 64;
}
__device__ __forceinline__ void phase0_transposes(const MP& p, char* smem, int first, int last, int brank, int nblk) {
  const int tid = launder(threadIdx.x);
  float* lds = (float*)smem;
  const int r = tid >> 4, c4 = (tid & 15) * 4;
  const int n = tid >> 2, kq = (tid & 3) * 32;
  TrDesc cur, nxt;
  float4 v[8]; float gg[8];
  auto load = [&](const TrDesc& d) {
#pragma unroll
    for (int i = 0; i < 8; ++i) v[i] = *(const float4*)(d.src + (size_t)(d.k0 + r + 16 * i) * d.N + d.n0 + c4);
    if (d.gain) {
#pragma unroll
      for (int i = 0; i < 8; ++i) gg[i] = d.gain[d.k0 + r + 16 * i];
    } else {
#pragma unroll
      for (int i = 0; i < 8; ++i) gg[i] = 1.f;
    }
  };
  int it = first + brank;
  if (it < last) { tr_decode(p, it, cur); load(cur); nxt = cur; }
  for (; it < last; it += nblk) {
#pragma unroll
    for (int i = 0; i < 8; ++i) {
      float* d = lds + (r + 16 * i) * 65 + c4;
      d[0] = v[i].x * gg[i]; d[1] = v[i].y * gg[i]; d[2] = v[i].z * gg[i]; d[3] = v[i].w * gg[i];
    }
    __syncthreads();
    const int nit = it + nblk;
    if (nit < last) { tr_decode(p, nit, nxt); load(nxt); }
    unsigned w[16];
#pragma unroll
    for (int j = 0; j < 16; ++j) w[j] = pack2(lds[(kq + 2 * j) * 65 + n], lds[(kq + 2 * j + 1) * 65 + n]);
    u32x4* dd = (u32x4*)(cur.dst + (size_t)(cur.n0 + n) * cur.K + cur.k0 + kq);
#pragma unroll
    for (int j = 0; j < 4; ++j) dd[j] = (u32x4){w[4 * j], w[4 * j + 1], w[4 * j + 2], w[4 * j + 3]};
    __syncthreads();
    cur = nxt;
  }
}

__device__ __forceinline__ void norm_token(const float* __restrict__ xr, const float* __restrict__ g, const float* __restrict__ sh,
                                           const float* __restrict__ sc, bf16_t* __restrict__ hr, int lane, float (&hv)[16]) {
  float4 v[4]; float ss = 0.f;
#pragma unroll
  for (int i = 0; i < 4; ++i) { v[i] = *(const float4*)(xr + lane * 4 + 256 * i); ss += v[i].x * v[i].x + v[i].y * v[i].y + v[i].z * v[i].z + v[i].w * v[i].w; }
  ss = wave_sum(ss);
  const float rinv = rsqrtf(ss * (1.f / D) + EPS);
#pragma unroll
  for (int i = 0; i < 4; ++i) {
    const int d = lane * 4 + 256 * i;
    const float4 gg = *(const float4*)(g + d), s1 = *(const float4*)(sc + d), s0 = *(const float4*)(sh + d);
    hv[4 * i + 0] = v[i].x * rinv * gg.x * (1.f + s1.x) + s0.x;
    hv[4 * i + 1] = v[i].y * rinv * gg.y * (1.f + s1.y) + s0.y;
    hv[4 * i + 2] = v[i].z * rinv * gg.z * (1.f + s1.z) + s0.z;
    hv[4 * i + 3] = v[i].w * rinv * gg.w * (1.f + s1.w) + s0.w;
    *(u32x2*)(hr + d) = (u32x2){pack2(hv[4 * i], hv[4 * i + 1]), pack2(hv[4 * i + 2], hv[4 * i + 3])};
  }
}

struct TokRange { int t0, step, end; };
__device__ __forceinline__ TokRange tok_range(int wave) {
  TokRange r;
  if ((gridDim.x & 7) == 0) { const int xcd = blockIdx.x & 7, lb = blockIdx.x >> 3, nlb = gridDim.x >> 3; r.t0 = xcd * S + lb * 4 + wave; r.step = nlb * 4; r.end = (xcd + 1) * S; }
  else { r.t0 = blockIdx.x * 4 + wave; r.step = gridDim.x * 4; r.end = T; }
  return r;
}
__device__ __forceinline__ void phase_norm1(const MP& p, int l, const float* xin) {
  const int tid = launder(threadIdx.x);
  const int wave = tid >> 6, lane = tid & 63;
  const float* modl = p.mod() + (size_t)l * 8 * 6144;
  const TokRange tr = tok_range(wave);
  for (int t = tr.t0; t < tr.end; t += tr.step) {
    const int b = t / S; float hv[16];
    norm_token(xin + (size_t)t * D, p.in.norm1_g + l * D, modl + (size_t)b * 6144, modl + (size_t)b * 6144 + 1024, p.h() + (size_t)t * D, lane, hv);
  }
}

struct GemmTile {
  const bf16_t* A0; const bf16_t* A1; long lda; int ksA;
  int arow[4];
  const bf16_t* Blo0; const bf16_t* Bhi0;
  const bf16_t* Blo1; const bf16_t* Bhi1;
  long ldb; int ksB;
  int K;
};

__device__ __forceinline__ int lds_off(int row, int chunk) { return row * 128 + ((chunk ^ ((row >> 1) & 7)) << 4); }

template <bool BSPLIT, bool MID>
__device__ __forceinline__ void gemm_mainloop_t(const GemmTile& g, const GemmTile& gnext, bool hasnext, bool preloaded, char* smem, f32x4 (&acc)[4][4],
                                                int ktmid, const float (&mids)[4]) {
  const int tid = launder(threadIdx.x), lane = tid & 63, wave = tid >> 6, wr = wave >> 1, wc = wave & 1, fr = lane & 15, fq = lane >> 4;
  const int r0 = tid >> 3, c8 = tid & 7;
  const int csrc = (c8 ^ ((r0 >> 1) & 7)) * 8;
#pragma unroll
  for (int m = 0; m < 4; ++m)
#pragma unroll
    for (int n = 0; n < 4; ++n) acc[m][n] = (f32x4){0.f, 0.f, 0.f, 0.f};
  auto stage = [&](const GemmTile& gg, int kt, int buf) {
    const int kk = kt * 64;
    const bf16_t* Ab = kk < gg.ksA ? gg.A0 + kk : gg.A1 + (kk - gg.ksA);
    const bool bs = kk < gg.ksB; const int kb = bs ? kk : kk - gg.ksB;
    char* As = smem + buf * 32768 + tid * 16; char* Bs = As + 16384;
#pragma unroll
    for (int i = 0; i < 4; ++i) {
      __builtin_amdgcn_global_load_lds((const void*)(Ab + (size_t)gg.arow[i] * gg.lda + csrc), (void*)(As + i * 4096), 16, 0, 0);
      const bf16_t* Bb = bs ? (i < 2 ? gg.Blo0 : gg.Bhi0) : (i < 2 ? gg.Blo1 : gg.Bhi1);
      __builtin_amdgcn_global_load_lds((const void*)(Bb + (size_t)(r0 + 32 * (i & 1)) * gg.ldb + kb + csrc), (void*)(Bs + i * 4096), 16, 0, 0);
    }
  };
  const int nk = g.K / 64;
  if (!preloaded) {
    stage(g, 0, 0);
    asm volatile("s_waitcnt vmcnt(0)" ::: "memory");
    __syncthreads();
  }
  for (int kt = 0; kt < nk; ++kt) {
    if (kt + 1 < nk) stage(g, kt + 1, (kt + 1) & 1);
    else if (hasnext) stage(gnext, 0, 0);
    if (MID && kt == ktmid) {
#pragma unroll
      for (int m = 0; m < 4; ++m)
#pragma unroll
        for (int n = 0; n < 4; ++n) acc[m][n] *= mids[m];
    }
    const char* As = smem + (kt & 1) * 32768; const char* Bs = As + 16384;
    {
      bf16x8 af[2][4], bfr[2][4];
#pragma unroll
      for (int ks = 0; ks < 2; ++ks) {
#pragma unroll
        for (int m = 0; m < 4; ++m) af[ks][m] = *(const bf16x8*)(As + lds_off(wr * 64 + 16 * m + fr, ks * 4 + fq));
#pragma unroll
        for (int n = 0; n < 4; ++n) {
          const int brow = BSPLIT ? ((n >> 1) * 64 + wc * 32 + (n & 1) * 16 + fr) : (wc * 64 + 16 * n + fr);
          bfr[ks][n] = *(const bf16x8*)(Bs + lds_off(brow, ks * 4 + fq));
        }
      }
#pragma unroll
      for (int ks = 0; ks < 2; ++ks)
#pragma unroll
        for (int m = 0; m < 4; ++m)
#pragma unroll
          for (int n = 0; n < 4; ++n) acc[m][n] = __builtin_amdgcn_mfma_f32_16x16x32_bf16(bfr[ks][n], af[ks][m], acc[m][n], 0, 0, 0);
      __builtin_amdgcn_sched_group_barrier(0x100, 8, 0);
#pragma unroll
      for (int i = 0; i < 8; ++i) { __builtin_amdgcn_sched_group_barrier(0x008, 2, 0); __builtin_amdgcn_sched_group_barrier(0x100, 1, 0); }
      __builtin_amdgcn_sched_group_barrier(0x008, 16, 0);
    }
    __builtin_amdgcn_sched_barrier(0);
    asm volatile("s_waitcnt vmcnt(0)" ::: "memory");
    __syncthreads();
  }
}
template <bool BSPLIT>
__device__ __forceinline__ void gemm_mainloop(const GemmTile& g, const GemmTile& gnext, bool hasnext, bool preloaded, char* smem, f32x4 (&acc)[4][4]) {
  const float dummy[4] = {1.f, 1.f, 1.f, 1.f};
  gemm_mainloop_t<BSPLIT, false>(g, gnext, hasnext, preloaded, smem, acc, -1, dummy);
}

struct TileMap { int base, ntl, lb, nlb; };
__device__ __forceinline__ TileMap tm_init(int nMt, int nNt) {
  TileMap t;
  if ((gridDim.x & 7) == 0) {
    const int xcd = blockIdx.x & 7;
    t.lb = blockIdx.x >> 3; t.nlb = gridDim.x >> 3;
    const int mlo = (nMt * xcd) >> 3, mhi = (nMt * (xcd + 1)) >> 3;
    t.base = mlo * nNt; t.ntl = (mhi - mlo) * nNt;
  } else { t.lb = blockIdx.x; t.nlb = gridDim.x; t.base = 0; t.ntl = nMt * nNt; }
  return t;
}
__device__ __forceinline__ int tm_tile(const TileMap& t, int j) { const int li = t.lb + t.nlb * j; return li < t.ntl ? t.base + li : -1; }
__device__ __forceinline__ void phase_inproj(const MP& p, int l, char* smem) {
  const int tid = launder(threadIdx.x), lane = tid & 63, wave = tid >> 6, wr = wave >> 1, wc = wave & 1, fr = lane & 15, fq = lane >> 4;
  const int r0 = tid >> 3;
  const int ntiles = (T / 128) * (INW / 128);
  const bf16_t* W = p.WinT() + (size_t)l * INW * D;
  auto make = [&](int tile, GemmTile& g) {
    const int m0 = (tile / 10) * 128, n0 = (tile % 10) * 128;
    g.A0 = p.h(); g.A1 = p.h(); g.lda = D; g.ksA = D; g.K = D;
#pragma unroll
    for (int i = 0; i < 4; ++i) g.arow[i] = m0 + r0 + 32 * i;
    g.Blo0 = W + (size_t)n0 * D; g.Bhi0 = g.Blo0 + (size_t)64 * D; g.Blo1 = g.Blo0; g.Bhi1 = g.Bhi0;
    g.ldb = D; g.ksB = D;
  };
  GemmTile g, gn; bool pre = false;
  const TileMap tmap = tm_init(T / 128, INW / 128);
  { const int t0 = tm_tile(tmap, 0); if (t0 >= 0) { make(t0, g); gn = g; } }
  for (int jt = 0; ; ++jt) {
    const int tile = tm_tile(tmap, jt); if (tile < 0) break;
    const int mt = tile / 10, nt = tile % 10, m0 = mt * 128;
    const int nxt = tm_tile(tmap, jt + 1); const bool hasn = nxt >= 0;
    if (hasn) make(nxt, gn);
    f32x4 acc[4][4];
    gemm_mainloop<false>(g, gn, hasn, pre, smem, acc);
    pre = hasn; g = gn;
    const int rowb = m0 + wr * 64 + fr;
    if (nt <= 4) {
      const float* gv = (nt < 4 ? p.in.q_norm_g : p.in.k_norm_g) + l * HD;
      const float scl = nt < 4 ? 0.125f : 1.f;
      f32x4 g1[2], g2[2];
#pragma unroll
      for (int n = 0; n < 2; ++n) { g1[n] = *(const f32x4*)(gv + 16 * n + 4 * fq); g2[n] = *(const f32x4*)(gv + 32 + 16 * n + 4 * fq); }
#pragma unroll
      for (int m = 0; m < 4; ++m) {
        const int t = rowb + 16 * m;
        float ss = 0.f;
#pragma unroll
        for (int n = 0; n < 4; ++n)
#pragma unroll
          for (int j = 0; j < 4; ++j) ss += acc[m][n][j] * acc[m][n][j];
        ss += __shfl_xor(ss, 16); ss += __shfl_xor(ss, 32);
        const float rinv = rsqrtf(ss * (1.f / 64.f) + EPS) * scl;
        bf16_t* dst = nt < 4 ? (p.q() + (size_t)t * AW + (2 * nt + wc) * 64) : (p.k() + (size_t)t * 128 + wc * 64);
#pragma unroll
        for (int n = 0; n < 2; ++n) {
          const int c = 16 * n + 4 * fq;
          const f32x4 csa = *(const f32x4*)((const float*)p.cs() + ((size_t)t * 32 + c) * 2);
          const f32x4 csb = *(const f32x4*)((const float*)p.cs() + ((size_t)t * 32 + c + 2) * 2);
          const float cn[4] = {csa[0], csa[2], csb[0], csb[2]}, sn[4] = {csa[1], csa[3], csb[1], csb[3]};
          float o1[4], o2[4];
#pragma unroll
          for (int j = 0; j < 4; ++j) {
            const float x1 = acc[m][n][j] * rinv * g1[n][j], x2 = acc[m][n + 2][j] * rinv * g2[n][j];
            o1[j] = x1 * cn[j] - x2 * sn[j]; o2[j] = x2 * cn[j] + x1 * sn[j];
          }
          *(u32x2*)(dst + c) = (u32x2){pack2(o1[0], o1[1]), pack2(o1[2], o1[3])};
          *(u32x2*)(dst + 32 + c) = (u32x2){pack2(o2[0], o2[1]), pack2(o2[2], o2[3])};
        }
      }
    } else if (nt == 5) {
      const int b = m0 / S;
#pragma unroll
      for (int m = 0; m < 4; ++m) {
        const int s = (rowb + 16 * m) % S;
        const int k16 = s & 15;
        const int sp = (s & ~15) | (k16 & 3) | (((k16 >> 3) & 1) << 2) | (((k16 >> 2) & 1) << 3);
#pragma unroll
        for (int n = 0; n < 4; ++n)
#pragma unroll
          for (int j = 0; j < 4; ++j) {
            const int d = 16 * n + 4 * fq + j;
            p.vT()[((size_t)(b * 2 + wc) * 64 + d) * S + sp] = (bf16_t)(pack2(acc[m][n][j], 0.f) & 0xffffu);
          }
      }
    } else {
#pragma unroll
      for (int m = 0; m < 4; ++m) {
        const int t = rowb + 16 * m;
#pragma unroll
        for (int n = 0; n < 4; ++n)
          *(u32x2*)(p.u() + (size_t)t * SW + (nt - 6) * 128 + wc * 64 + 16 * n + 4 * fq) = (u32x2){pack2(acc[m][n][0], acc[m][n][1]), pack2(acc[m][n][2], acc[m][n][3])};
      }
    }
  }
}

__device__ __forceinline__ int crow32(int r, int hf) { return (r & 3) + 8 * (r >> 2) + 4 * hf; }
__device__ __forceinline__ void attn_task(const MP& p, int l, int task, int lane) {
  lane = launder(lane);
  task = __builtin_amdgcn_readfirstlane(task);
  const int h = task & 7, qt = (task >> 3) & 63, b = task >> 9, kvh = h >> 2;
  const int s0 = qt * 32, t0 = b * S + s0, ql = lane & 31, hf = lane >> 5;
  int kst[5];
#pragma unroll
  for (int kt = 0; kt < 5; ++kt) { const int ks = s0 - 128 + 32 * kt; kst[kt] = ks < 0 ? 0 : ks; }
  bf16x8 qf[4], kf[5][4];
#pragma unroll
  for (int st = 0; st < 4; ++st) qf[st] = *(const bf16x8*)(p.q() + (size_t)(t0 + ql) * AW + h * 64 + 16 * st + 8 * hf);
#pragma unroll
  for (int kt = 0; kt < 5; ++kt)
#pragma unroll
    for (int st = 0; st < 4; ++st) kf[kt][st] = *(const bf16x8*)(p.k() + (size_t)(b * S + kst[kt] + ql) * 128 + kvh * 64 + 8 * hf + 16 * st);
  f32x16 sc[5];
#pragma unroll
  for (int kt = 0; kt < 5; ++kt) {
#pragma unroll
    for (int r = 0; r < 16; ++r) sc[kt][r] = 0.f;
#pragma unroll
    for (int st = 0; st < 4; ++st) sc[kt] = __builtin_amdgcn_mfma_f32_32x32x16_bf16(kf[kt][st], qf[st], sc[kt], 0, 0, 0);
  }
  bf16x8 vb[5][2][2];
#pragma unroll
  for (int kt = 0; kt < 5; ++kt)
#pragma unroll
    for (int s = 0; s < 2; ++s)
#pragma unroll
      for (int dt = 0; dt < 2; ++dt)
        vb[kt][s][dt] = *(const bf16x8*)(p.vT() + ((size_t)(b * 2 + kvh) * 64 + 32 * dt + ql) * S + kst[kt] + 16 * s + 8 * hf);
  const float sink = p.in.attn_sink[l * NQ + h];
  float mx = sink;
#pragma unroll
  for (int kt = 0; kt < 5; ++kt) {
#pragma unroll
    for (int r = 0; r < 16; ++r) {
      const int kp = s0 - 128 + 32 * kt + crow32(r, hf);
      const int dk = kp - (s0 + ql);
      const bool valid = kp >= 0 && dk <= 0 && dk > -128;
      sc[kt][r] = valid ? sc[kt][r] : -1e30f;
      mx = fmaxf(mx, sc[kt][r]);
    }
  }
  mx = xhalf_max(mx);
  float lsum = 0.f;
#pragma unroll
  for (int kt = 0; kt < 5; ++kt) {
#pragma unroll
    for (int r = 0; r < 16; ++r) { const float e = __expf(sc[kt][r] - mx); sc[kt][r] = e; lsum += e; }
  }
  lsum = xhalf_sum(lsum);
  lsum += __expf(sink - mx);
  const float inv = 1.f / lsum;
  f32x16 o[2];
#pragma unroll
  for (int r = 0; r < 16; ++r) { o[0][r] = 0.f; o[1][r] = 0.f; }
#pragma unroll
  for (int kt = 0; kt < 5; ++kt) {
#pragma unroll
    for (int s = 0; s < 2; ++s) {
      u32x4 pw;
#pragma unroll
      for (int j = 0; j < 4; ++j) pw[j] = pack2(sc[kt][8 * s + 2 * j], sc[kt][8 * s + 2 * j + 1]);
      const bf16x8 pa = __builtin_bit_cast(bf16x8, pw);
#pragma unroll
      for (int dt = 0; dt < 2; ++dt) o[dt] = __builtin_amdgcn_mfma_f32_32x32x16_bf16(vb[kt][s][dt], pa, o[dt], 0, 0, 0);
    }
  }
  bf16_t* dst = p.attn() + (size_t)(t0 + ql) * AW + h * 64 + 4 * hf;
  float ssq = 0.f;
#pragma unroll
  for (int dt = 0; dt < 2; ++dt)
#pragma unroll
    for (int g4 = 0; g4 < 4; ++g4) {
      const float a0 = o[dt][4 * g4] * inv, a1 = o[dt][4 * g4 + 1] * inv, a2 = o[dt][4 * g4 + 2] * inv, a3 = o[dt][4 * g4 + 3] * inv;
      ssq += (a0 * a0 + a1 * a1) + (a2 * a2 + a3 * a3);
      *(u32x2*)(dst + 32 * dt + 8 * g4) = (u32x2){pack2(a0, a1), pack2(a2, a3)};
    }
  ssq = xhalf_sum(ssq);
  if (hf == 0) p.ssqa()[(size_t)(t0 + ql) * 8 + h] = ssq;
}
constexpr int SSEG = 4, SEGLEN = S / SSEG, SEGCH = SEGLEN / 32;

__device__ __forceinline__ void ssm_bu(const bf16x8& ua, const bf16x8 (&bB)[4], f32x16 (&bu)[4]) {
#pragma unroll
  for (int nt = 0; nt < 4; ++nt) {
#pragma unroll
    for (int r = 0; r < 16; ++r) bu[nt][r] = 0.f;
    bu[nt] = __builtin_amdgcn_mfma_f32_32x32x16_bf16(ua, bB[nt], bu[nt], 0, 0, 0);
  }
  asm volatile("s_nop 15\n\ts_nop 7" : "+v"(bu[0]), "+v"(bu[1]), "+v"(bu[2]), "+v"(bu[3]));
#pragma unroll
  for (int r = 0; r < 16; ++r) {
    auto s0 = __builtin_amdgcn_permlane32_swap(__float_as_uint(bu[0][r]), __float_as_uint(bu[1][r]), false, false);
    bu[0][r] = __uint_as_float(s0[0]); bu[1][r] = __uint_as_float(s0[1]);
    auto s1 = __builtin_amdgcn_permlane32_swap(__float_as_uint(bu[2][r]), __float_as_uint(bu[3][r]), false, false);
    bu[2][r] = __uint_as_float(s1[0]); bu[3][r] = __uint_as_float(s1[1]);
  }
}

__device__ __forceinline__ void ssm_block(const MP& p, int l, int b, int g, int tid, char* smem) {
  const int lane = tid & 63, seg = tid >> 6;
  char* wl = smem + seg * 8192;
  float* fin = (float*)(smem + 4 * 8192);
  const int lg = l * SG + g, hf = lane >> 5, fr = lane & 15, fq = lane >> 4;
  const float ar = p.ssmL()[(lg * SP + lane) * 2], ai = p.ssmL()[(lg * SP + lane) * 2 + 1];
  bf16x8 bB[4], cB[4];
#pragma unroll
  for (int nt = 0; nt < 4; ++nt) bB[nt] = *(const bf16x8*)(p.ssmB() + ((size_t)lg * 128 + nt * 32 + (lane & 31)) * 16 + 8 * hf);
#pragma unroll
  for (int ks = 0; ks < 4; ++ks) cB[ks] = *(const bf16x8*)(p.ssmC() + ((size_t)lg * 16 + fr) * 128 + 32 * ks + 8 * fq);
  const f32x4 dsk = *(const f32x4*)(p.in.ssm_d + l * SW + g * 16 + 4 * fq);
  const int t0 = b * S + seg * SEGLEN;
  const bf16_t* urow = p.u() + (size_t)(t0 + (lane & 31)) * SW + g * 16 + 8 * hf;
  float xr = 0.f, xi = 0.f;
  if (seg < SSEG - 1) {
    bf16x8 ua = *(const bf16x8*)(urow);
    for (int c = 0; c < SEGCH; ++c) {
      const bf16x8 un = *(const bf16x8*)(urow + (size_t)((c + 1 < SEGCH ? c + 1 : c) * 32) * SW);
      f32x16 bu[4];
      ssm_bu(ua, bB, bu);
#pragma unroll
      for (int r4 = 0; r4 < 4; ++r4)
#pragma unroll
        for (int half = 0; half < 2; ++half)
#pragma unroll
          for (int j = 0; j < 4; ++j) {
            const int r = 4 * r4 + j;
            const float bre = half ? bu[1][r] : bu[0][r], bim = half ? bu[3][r] : bu[2][r];
            const float nr = ar * xr - ai * xi + bre, ni = ar * xi + ai * xr + bim;
            xr = nr; xi = ni;
          }
      ua = un;
    }
  }
  fin[(seg * 64 + lane) * 2] = xr; fin[(seg * 64 + lane) * 2 + 1] = xi;
  __syncthreads();
  {
    float pr = ar, pi = ai;
#pragma unroll
    for (int i = 0; i < 9; ++i) { const float nr = pr * pr - pi * pi, ni = 2.f * pr * pi; pr = nr; pi = ni; }
    static_assert(SEGLEN == 512, "lam^SEGLEN squaring count");
    float cr = 0.f, ci = 0.f;
    for (int j = 0; j < seg; ++j) {
      const float fr_ = fin[(j * 64 + lane) * 2], fi_ = fin[(j * 64 + lane) * 2 + 1];
      const float nr = pr * cr - pi * ci + fr_, ni = pr * ci + pi * cr + fi_;
      cr = nr; ci = ni;
    }
    xr = cr; xi = ci;
  }
  const int wbase = (lane & 3) * 4;
  const int pch = lane >> 2;
  const bf16_t* uep = p.u() + (size_t)(t0 + fr) * SW + g * 16 + 4 * fq;
  bf16x8 ua = *(const bf16x8*)(urow);
  u32x2 uraw[2];
#pragma unroll
  for (int i = 0; i < 2; ++i) uraw[i] = *(const u32x2*)(uep + (size_t)(16 * i) * SW);
  for (int c = 0; c < SEGCH; ++c) {
    const int tb = t0 + c * 32;
    const int cn = (c + 1 < SEGCH ? c + 1 : c) * 32;
    const bf16x8 un = *(const bf16x8*)(urow + (size_t)cn * SW);
    u32x2 unraw[2];
#pragma unroll
    for (int i = 0; i < 2; ++i) unraw[i] = *(const u32x2*)(uep + (size_t)(cn + 16 * i) * SW);
    f32x16 bu[4];
    ssm_bu(ua, bB, bu);
#pragma unroll
    for (int r4 = 0; r4 < 4; ++r4) {
#pragma unroll
      for (int half = 0; half < 2; ++half) {
#pragma unroll
        for (int j = 0; j < 4; ++j) {
          const int t = 8 * r4 + 4 * half + j, r = 4 * r4 + j;
          const float bre = half ? bu[1][r] : bu[0][r], bim = half ? bu[3][r] : bu[2][r];
          const float nr = ar * xr - ai * xi + bre, ni = ar * xi + ai * xr + bim;
          xr = nr; xi = ni;
          *(unsigned*)(wl + t * 256 + ((pch ^ (t & 15)) << 4) + wbase) = pack2(nr, ni);
        }
      }
    }
    asm volatile("s_waitcnt lgkmcnt(0)" ::: "memory");
#pragma unroll
    for (int mt = 0; mt < 2; ++mt) {
      f32x4 acc = {0.f, 0.f, 0.f, 0.f};
      const int t = 16 * mt + fr;
#pragma unroll
      for (int ks = 0; ks < 4; ++ks) {
        const bf16x8 af = *(const bf16x8*)(wl + t * 256 + (((4 * ks + fq) ^ (t & 15)) << 4));
        acc = __builtin_amdgcn_mfma_f32_16x16x32_bf16(cB[ks], af, acc, 0, 0, 0);
      }
      const float uu[4] = {bf_lo(uraw[mt][0]), bf_hi(uraw[mt][0]), bf_lo(uraw[mt][1]), bf_hi(uraw[mt][1])};
      float ge[4];
#pragma unroll
      for (int j = 0; j < 4; ++j) {
        const float v = acc[j] + dsk[j] * uu[j];
        const float z2 = 1.5957691216057308f * (v + 0.044715f * v * v * v);
        ge[j] = v * __builtin_amdgcn_rcpf(1.f + __expf(-z2));
      }
      *(u32x2*)(p.y() + (size_t)(tb + t) * SW + g * 16 + 4 * fq) = (u32x2){pack2(ge[0], ge[1]), pack2(ge[2], ge[3])};
    }
    asm volatile("s_waitcnt lgkmcnt(0)" ::: "memory");
    ua = un;
#pragma unroll
    for (int i = 0; i < 2; ++i) uraw[i] = unraw[i];
  }
}

__device__ __forceinline__ void phase_attn(const MP& p, int l) {
  const int tid = launder(threadIdx.x);
  const int wave = tid >> 6, lane = tid & 63;
  if ((gridDim.x & 7) == 0) {
    const int xcd = blockIdx.x & 7, lb = blockIdx.x >> 3, nlb = gridDim.x >> 3;
    for (int lt = lb * 4 + wave; lt < 64 * 8; lt += nlb * 4) attn_task(p, l, (xcd << 9) | lt, lane);
  } else {
    for (int task = blockIdx.x * 4 + wave; task < NB * 64 * 8; task += gridDim.x * 4) attn_task(p, l, task, lane);
  }
}
__device__ __forceinline__ void phase_ssm(const MP& p, int l, char* smem, int wid) {
  const int tid = launder(threadIdx.x);
  if (wid < 0) return;
  const int nw = (int)__hip_atomic_load(p.claim() + 4096, __ATOMIC_RELAXED, __HIP_MEMORY_SCOPE_AGENT);
  for (int task = wid; task < NB * SG; task += nw) {
    ssm_block(p, l, task / SG, task % SG, tid, smem);
    __syncthreads();
  }
}
__device__ __forceinline__ void phase_glu(const MP& p, int l, char* smem) {
  const int tid = launder(threadIdx.x), lane = tid & 63, wave = tid >> 6, wr = wave >> 1, wc = wave & 1, fr = lane & 15, fq = lane >> 4;
  const int r0 = tid >> 3;
  const int ntiles = (T / 128) * (SW / 128);
  const bf16_t* W = p.WgluT() + (size_t)l * SW * SW;
  auto make = [&](int tile, GemmTile& g) {
    const int m0 = (tile >> 2) * 128, n0 = (tile & 3) * 128;
    g.A0 = p.y(); g.A1 = p.y(); g.lda = SW; g.ksA = SW; g.K = SW;
#pragma unroll
    for (int i = 0; i < 4; ++i) g.arow[i] = m0 + r0 + 32 * i;
    g.Blo0 = W + (size_t)n0 * SW; g.Bhi0 = g.Blo0 + (size_t)64 * SW; g.Blo1 = g.Blo0; g.Bhi1 = g.Bhi0;
    g.ldb = SW; g.ksB = SW;
  };
  GemmTile g, gn; bool pre = false;
  const TileMap tmap = tm_init(T / 128, SW / 128);
  { const int t0 = tm_tile(tmap, 0); if (t0 >= 0) { make(t0, g); gn = g; } }
  for (int jt = 0; ; ++jt) {
    const int tile = tm_tile(tmap, jt); if (tile < 0) break;
    const int mt = tile >> 2, nt = tile & 3, m0 = mt * 128, n0 = nt * 128;
    const int nxt = tm_tile(tmap, jt + 1); const bool hasn = nxt >= 0;
    if (hasn) make(nxt, gn);
    f32x4 acc[4][4];
    gemm_mainloop<false>(g, gn, hasn, pre, smem, acc);
    pre = hasn; g = gn;
#pragma unroll
    for (int m = 0; m < 4; ++m) {
      const int t = m0 + wr * 64 + 16 * m + fr;
      float ss = 0.f;
#pragma unroll
      for (int n = 0; n < 4; ++n) {
        const int col = n0 + wc * 64 + 16 * n + 4 * fq;
        const u32x2 yr = *(const u32x2*)(p.y() + (size_t)t * SW + col);
        const float yv[4] = {bf_lo(yr[0]), bf_hi(yr[0]), bf_lo(yr[1]), bf_hi(yr[1])};
        float o[4];
#pragma unroll
        for (int j = 0; j < 4; ++j) { o[j] = yv[j] * __builtin_amdgcn_rcpf(1.f + __expf(-acc[m][n][j])); ss += o[j] * o[j]; }
        *(u32x2*)(p.ssm() + (size_t)t * SW + col) = (u32x2){pack2(o[0], o[1]), pack2(o[2], o[3])};
      }
      ss += __shfl_xor(ss, 16); ss += __shfl_xor(ss, 32);
      if (fq == 0) p.ssqs()[(size_t)t * 8 + nt * 2 + wc] = ss;
    }
  }
}

__device__ __forceinline__ void phase_out(const MP& p, int l, char* smem, const float* xin) {
  const int tid = launder(threadIdx.x), lane = tid & 63, wave = tid >> 6, wr = wave >> 1, wc = wave & 1, fr = lane & 15, fq = lane >> 4;
  const int r0 = tid >> 3;
  const float* modl = p.mod() + (size_t)l * 8 * 6144;
  const int ntiles = (T / 128) * (D / 128);
  const bf16_t* W = p.WoutT() + (size_t)l * D * D;
  auto make = [&](int tile, GemmTile& g) {
    const int m0 = (tile >> 3) * 128, n0 = (tile & 7) * 128;
    g.A0 = p.attn(); g.A1 = p.ssm(); g.lda = AW; g.ksA = AW; g.K = D;
#pragma unroll
    for (int i = 0; i < 4; ++i) g.arow[i] = m0 + r0 + 32 * i;
    g.Blo0 = W + (size_t)n0 * D; g.Bhi0 = g.Blo0 + (size_t)64 * D; g.Blo1 = g.Blo0; g.Bhi1 = g.Bhi0;
    g.ldb = D; g.ksB = D;
  };
  GemmTile g, gn; bool pre = false;
  const TileMap tmap = tm_init(T / 128, D / 128);
  { const int t0 = tm_tile(tmap, 0); if (t0 >= 0) { make(t0, g); gn = g; } }
  for (int jt = 0; ; ++jt) {
    const int tile = tm_tile(tmap, jt); if (tile < 0) break;
    const int mt = tile >> 3, nt = tile & 7, m0 = mt * 128, n0 = nt * 128, b = m0 / S;
    const int nxt = tm_tile(tmap, jt + 1); const bool hasn = nxt >= 0;
    if (hasn) make(nxt, gn);
    float mids[4], rs[4];
#pragma unroll
    for (int m = 0; m < 4; ++m) {
      const int t = m0 + wr * 64 + 16 * m + fr;
      const f32x4 a0 = *(const f32x4*)(p.ssqa() + (size_t)t * 8), a1 = *(const f32x4*)(p.ssqa() + (size_t)t * 8 + 4);
      const f32x4 s0 = *(const f32x4*)(p.ssqs() + (size_t)t * 8), s1 = *(const f32x4*)(p.ssqs() + (size_t)t * 8 + 4);
      const float sa = ((a0[0] + a0[1]) + (a0[2] + a0[3])) + ((a1[0] + a1[1]) + (a1[2] + a1[3]));
      const float sq = ((s0[0] + s0[1]) + (s0[2] + s0[3])) + ((s1[0] + s1[1]) + (s1[2] + s1[3]));
      const float ra = rsqrtf(sa * (1.f / 512.f) + EPS);
      rs[m] = rsqrtf(sq * (1.f / 512.f) + EPS);
      mids[m] = ra / rs[m];
    }
    f32x4 acc[4][4];
    gemm_mainloop_t<false, true>(g, gn, hasn, pre, smem, acc, 8, mids);
    pre = hasn; g = gn;
#pragma unroll
    for (int m = 0; m < 4; ++m) {
      const int t = m0 + wr * 64 + 16 * m + fr;
#pragma unroll
      for (int n = 0; n < 4; ++n) {
        const int col = n0 + wc * 64 + 16 * n + 4 * fq;
        const f32x4 xv = *(const f32x4*)(xin + (size_t)t * D + col);
        const f32x4 g1 = *(const f32x4*)(modl + (size_t)b * 6144 + 2 * 1024 + col);
        f32x4 o;
#pragma unroll
        for (int j = 0; j < 4; ++j) o[j] = xv[j] + g1[j] * (acc[m][n][j] * rs[m]);
        *(u32x2*)(p.x1() + (size_t)t * D + col) = (u32x2){pack2(o[0], o[1]), pack2(o[2], o[3])};
      }
    }
  }
}
__device__ __forceinline__ void phase_norm2_route(const MP& p, int l, char* smem) {
  const int tid = launder(threadIdx.x);
  const int wave = tid >> 6, lane = tid & 63;
  float* wrT = (float*)smem;
  for (int i = tid; i < 1024 * 4; i += NTHR) {
    const int k = i >> 2, e4 = (i & 3) * 4;
    const float4 v = *(const float4*)(p.in.w_router + (size_t)k * 16 + e4);
    wrT[(e4 + 0) * 1024 + k] = v.x; wrT[(e4 + 1) * 1024 + k] = v.y; wrT[(e4 + 2) * 1024 + k] = v.z; wrT[(e4 + 3) * 1024 + k] = v.w;
  }
  __syncthreads();
  const float* modl = p.mod() + (size_t)l * 8 * 6144;
  float rb[16];
#pragma unroll
  for (int e = 0; e < 16; ++e) rb[e] = p.in.router_bias[e];
  int* cntl = p.cnt() + l * 256;
  int my_t = -1, my_bucket = 0; float my_wlo = 0.f, my_whi = 0.f;
  const float* g2n = p.in.norm2_g + l * D;
  const TokRange trg = tok_range(wave);
  const int tstep = trg.step, tend = trg.end;
  int t = trg.t0;
  float4 xv[4];
  if (t < tend) {
#pragma unroll
    for (int i = 0; i < 4; ++i) { const u32x2 r = *(const u32x2*)(p.x1() + (size_t)t * D + lane * 4 + 256 * i); xv[i] = make_float4(bf_lo(r[0]), bf_hi(r[0]), bf_lo(r[1]), bf_hi(r[1])); }
  }
  for (int slot = 0; t < tend; t += tstep, ++slot) {
    const int b = t / S;
    float4 xn[4];
    const int tn = t + tstep < tend ? t + tstep : t;
#pragma unroll
    for (int i = 0; i < 4; ++i) { const u32x2 r = *(const u32x2*)(p.x1() + (size_t)tn * D + lane * 4 + 256 * i); xn[i] = make_float4(bf_lo(r[0]), bf_hi(r[0]), bf_lo(r[1]), bf_hi(r[1])); }
    float ss = 0.f;
#pragma unroll
    for (int i = 0; i < 4; ++i) ss += xv[i].x * xv[i].x + xv[i].y * xv[i].y + xv[i].z * xv[i].z + xv[i].w * xv[i].w;
    ss = wave_sum(ss);
    const float rinv = rsqrtf(ss * (1.f / D) + EPS);
    const float* sh = modl + (size_t)b * 6144 + 3 * 1024; const float* sc = modl + (size_t)b * 6144 + 4 * 1024;
    float hv[16];
#pragma unroll
    for (int i = 0; i < 4; ++i) {
      const int d = lane * 4 + 256 * i;
      const float4 gg = *(const float4*)(g2n + d), s1 = *(const float4*)(sc + d), s0 = *(const float4*)(sh + d);
      hv[4 * i + 0] = xv[i].x * rinv * gg.x * (1.f + s1.x) + s0.x;
      hv[4 * i + 1] = xv[i].y * rinv * gg.y * (1.f + s1.y) + s0.y;
      hv[4 * i + 2] = xv[i].z * rinv * gg.z * (1.f + s1.z) + s0.z;
      hv[4 * i + 3] = xv[i].w * rinv * gg.w * (1.f + s1.w) + s0.w;
      *(u32x2*)(p.h() + (size_t)t * D + d) = (u32x2){pack2(hv[4 * i], hv[4 * i + 1]), pack2(hv[4 * i + 2], hv[4 * i + 3])};
    }
    float a[16];
    const int loff = launder(lane * 4);
#pragma unroll
    for (int e = 0; e < 16; ++e) {
      float s = 0.f;
#pragma unroll
      for (int i = 0; i < 4; ++i) {
        const f32x4 w = *(const f32x4*)(wrT + e * 1024 + loff + 256 * i);
        s += hv[4 * i] * w[0] + hv[4 * i + 1] * w[1] + hv[4 * i + 2] * w[2] + hv[4 * i + 3] * w[3];
      }
      a[e] = s;
    }
    float lg[16];
#pragma unroll
    for (int e = 0; e < 16; ++e) lg[e] = wave_sum(a[e]);
    float mx = lg[0];
#pragma unroll
    for (int e = 1; e < 16; ++e) mx = fmaxf(mx, lg[e]);
    float pr[16], sel[16]; float sum = 0.f;
#pragma unroll
    for (int e = 0; e < 16; ++e) { pr[e] = __expf(lg[e] - mx); sum += pr[e]; }
    const float inv = 1.f / sum;
#pragma unroll
    for (int e = 0; e < 16; ++e) { pr[e] *= inv; sel[e] = pr[e] + rb[e]; }
    int gbest = 0; float gbs = -1e30f;
#pragma unroll
    for (int g = 0; g < 4; ++g) {
      float m1 = -1e30f, m2 = -1e30f;
#pragma unroll
      for (int j = 0; j < 4; ++j) { const float v = sel[g * 4 + j]; if (v > m1) { m2 = m1; m1 = v; } else if (v > m2) m2 = v; }
      const float gs = m1 + m2;
      if (gs > gbs) { gbs = gs; gbest = g; }
    }
    float s4[4], p4[4];
#pragma unroll
    for (int j = 0; j < 4; ++j) { s4[j] = sel[j]; p4[j] = pr[j]; }
#pragma unroll
    for (int g = 1; g < 4; ++g) if (g == gbest) {
#pragma unroll
      for (int j = 0; j < 4; ++j) { s4[j] = sel[g * 4 + j]; p4[j] = pr[g * 4 + j]; }
    }
    int i0 = 0; float b0 = s4[0];
#pragma unroll
    for (int j = 1; j < 4; ++j) if (s4[j] > b0) { b0 = s4[j]; i0 = j; }
    int i1 = -1; float bb1 = -1e30f;
#pragma unroll
    for (int j = 0; j < 4; ++j) if (j != i0 && s4[j] > bb1) { bb1 = s4[j]; i1 = j; }
    float p0 = 0.f, p1 = 0.f;
#pragma unroll
    for (int j = 0; j < 4; ++j) { if (j == i0) p0 = p4[j]; if (j == i1) p1 = p4[j]; }
    const float w0 = p0 / (p0 + p1), w1 = p1 / (p0 + p1);
    const int lo = i0 < i1 ? i0 : i1, hi = i0 < i1 ? i1 : i0;
    const float wlo = i0 < i1 ? w0 : w1, whi = i0 < i1 ? w1 : w0;
    const int pidx = (lo == 0) ? (hi - 1) : (lo == 1 ? (hi + 1) : 5);
    const int bucket = gbest * 6 + pidx;
    if (lane == slot) { my_t = t; my_bucket = bucket; my_wlo = wlo; my_whi = whi; }
#pragma unroll
    for (int i = 0; i < 4; ++i) xv[i] = xn[i];
  }
  if (my_t >= 0) {
    const int sl = my_bucket * NSUBL + (blockIdx.x & (NSUBL - 1));
    const int pos = atomicAdd(&cntl[sl], 1);
    p.list()[(size_t)sl * T + pos] = my_t;
    p.tokw()[my_t] = make_float2(my_wlo, my_whi);
  }
  __syncthreads();
}

__device__ __forceinline__ void bucket_experts2(int bucket, int& elo, int& ehi) {
  const int g = bucket / 6, pi = bucket % 6;
  const int lo = pi < 3 ? 0 : (pi < 5 ? 1 : 2);
  const int hi = pi < 3 ? pi + 1 : (pi < 5 ? pi - 1 : 3);
  elo = g * 4 + lo; ehi = g * 4 + hi;
}
__device__ __forceinline__ void moe_map_build(const int* cnt, int* mm, int tid) {
  if (tid < NBUCKET) {
    int acc = 0;
#pragma unroll
    for (int x = 0; x < NSUBL; ++x) { mm[32 + 16 * tid + x] = acc; acc += cnt[tid * NSUBL + x]; }
    mm[32 + 16 * tid + 8] = acc;
  }
  __syncthreads();
  if (tid == 0) {
    int acc = 0;
    for (int bk = 0; bk < NBUCKET; ++bk) { mm[bk] = acc; acc += (mm[32 + 16 * bk + 8] + TM - 1) / TM; }
    mm[NBUCKET] = acc;
  }
  __syncthreads();
}
__device__ __forceinline__ void moe_find_tile(const int* mm, int mt, int& bucket, int& tib, int& nrow) {
  int bk = 0;
#pragma unroll
  for (int j = 1; j < NBUCKET; ++j) bk += (mt >= mm[j]) ? 1 : 0;
  bucket = bk; tib = mt - mm[bk]; nrow = mm[32 + 16 * bk + 8] - tib * TM;
}
__device__ __forceinline__ int moe_token(const int* list, const int* mm, int bk, int q) {
  const int* sp = mm + 32 + 16 * bk;
  int x = 0, s = 0;
#pragma unroll
  for (int j = 1; j < NSUBL; ++j) { const int v = sp[j]; const bool ge = q >= v; x += ge ? 1 : 0; s = ge ? v : s; }
  return list[(size_t)(bk * NSUBL + x) * T + (q - s)];
}

__device__ __forceinline__ void phase_moe_gu(const MP& p, int l, char* smem) {
  const int tid = launder(threadIdx.x), lane = tid & 63, wave = tid >> 6, wr = wave >> 1, wc = wave & 1, fr = lane & 15, fq = lane >> 4;
  const int r0 = tid >> 3;
  int* mm = (int*)(smem + SMEM_MM);
  moe_map_build(p.cnt() + l * 256, mm, tid);
  const int nmt = mm[NBUCKET];
  const int ntiles = nmt * 16;
  auto make = [&](int tile, GemmTile& g) {
    const int mt = tile >> 4, nt = tile & 15;
    int bucket, tib, nrow;
    moe_find_tile(mm, mt, bucket, tib, nrow);
    int elo, ehi; bucket_experts2(bucket, elo, ehi);
    const int e = nt < 8 ? elo : ehi, f0 = (nt & 7) * 64;
    g.A0 = p.h(); g.A1 = p.h(); g.lda = D; g.ksA = D; g.K = D;
    const bf16_t* Wg = p.WgT() + ((size_t)(l * NE + e) * DFF + f0) * D;
    const bf16_t* Wu = p.WuT() + ((size_t)(l * NE + e) * DFF + f0) * D;
#pragma unroll
    for (int i = 0; i < 4; ++i) {
      const int r = r0 + 32 * i;
      g.arow[i] = moe_token(p.list(), mm, bucket, tib * TM + (r < nrow ? r : nrow - 1));
    }
    g.Blo0 = Wg; g.Bhi0 = Wu; g.Blo1 = Wg; g.Bhi1 = Wu;
    g.ldb = D; g.ksB = D;
  };
  GemmTile g, gn; bool pre = false;
  const TileMap tmap = tm_init(nmt, 16);
  { const int t0 = tm_tile(tmap, 0); if (t0 >= 0) { make(t0, g); gn = g; } }
  for (int jt = 0; ; ++jt) {
    const int tile = tm_tile(tmap, jt); if (tile < 0) break;
    const int mt = tile >> 4, nt = tile & 15;
    int bucket, tib, nrow;
    moe_find_tile(mm, mt, bucket, tib, nrow);
    const int f0 = (nt & 7) * 64;
    const int nxt = tm_tile(tmap, jt + 1); const bool hasn = nxt >= 0;
    if (hasn) make(nxt, gn);
    float wv[4];
#pragma unroll
    for (int m = 0; m < 4; ++m) {
      const int r = wr * 64 + 16 * m + fr;
      const float2 ww = p.tokw()[moe_token(p.list(), mm, bucket, tib * TM + (r < nrow ? r : nrow - 1))];
      wv[m] = r < nrow ? (nt < 8 ? ww.x : ww.y) : 0.f;
    }
    f32x4 acc[4][4];
    gemm_mainloop<true>(g, gn, hasn, pre, smem, acc);
    pre = hasn; g = gn;
#pragma unroll
    for (int m = 0; m < 4; ++m) {
      const int r = wr * 64 + 16 * m + fr;
      const float w = wv[m];
      bf16_t* dst = p.act() + (size_t)(mt * TM + r) * D + (nt < 8 ? 0 : 512) + f0 + wc * 32 + 4 * fq;
#pragma unroll
      for (int n = 0; n < 2; ++n) {
        float o[4];
#pragma unroll
        for (int j = 0; j < 4; ++j) { const float gv = acc[m][n][j], uv = acc[m][n + 2][j]; o[j] = gv * __builtin_amdgcn_rcpf(1.f + __expf(-gv)) * uv * w; }
        *(u32x2*)(dst + 16 * n) = (u32x2){pack2(o[0], o[1]), pack2(o[2], o[3])};
      }
    }
  }
}

__device__ __forceinline__ void phase_moe_down(const MP& p, int l, char* smem) {
  const int tid = launder(threadIdx.x), lane = tid & 63, wave = tid >> 6, wr = wave >> 1, wc = wave & 1, fr = lane & 15, fq = lane >> 4;
  const int r0 = tid >> 3;
  int* mm = (int*)(smem + SMEM_MM);
  moe_map_build(p.cnt() + l * 256, mm, tid);
  const float* modl = p.mod() + (size_t)l * 8 * 6144;
  const int nmt = mm[NBUCKET];
  const int ntiles = nmt * 8;
  auto make = [&](int tile, GemmTile& g) {
    const int mt = tile >> 3, n0 = (tile & 7) * 128;
    int bucket, tib, nrow;
    moe_find_tile(mm, mt, bucket, tib, nrow);
    int elo, ehi; bucket_experts2(bucket, elo, ehi);
    g.A0 = p.act(); g.A1 = p.act(); g.lda = D; g.ksA = D; g.K = D;
    const bf16_t* Wlo = p.WdT() + ((size_t)(l * NE + elo) * D + n0) * DFF;
    const bf16_t* Whi = p.WdT() + ((size_t)(l * NE + ehi) * D + n0) * DFF;
#pragma unroll
    for (int i = 0; i < 4; ++i) {
      g.arow[i] = mt * TM + r0 + 32 * i;
    }
    g.Blo0 = Wlo; g.Bhi0 = Wlo + (size_t)64 * DFF; g.Blo1 = Whi; g.Bhi1 = Whi + (size_t)64 * DFF;
    g.ldb = DFF; g.ksB = DFF;
  };
  GemmTile g, gn; bool pre = false;
  const TileMap tmap = tm_init(nmt, 8);
  { const int t0 = tm_tile(tmap, 0); if (t0 >= 0) { make(t0, g); gn = g; } }
  for (int jt = 0; ; ++jt) {
    const int tile = tm_tile(tmap, jt); if (tile < 0) break;
    const int mt = tile >> 3, nt = tile & 7, n0 = nt * 128;
    int bucket, tib, nrow;
    moe_find_tile(mm, mt, bucket, tib, nrow);
    const int nxt = tm_tile(tmap, jt + 1); const bool hasn = nxt >= 0;
    if (hasn) make(nxt, gn);
    int tkv[4];
#pragma unroll
    for (int m = 0; m < 4; ++m) {
      const int r = wr * 64 + 16 * m + fr;
      tkv[m] = moe_token(p.list(), mm, bucket, tib * TM + (r < nrow ? r : nrow - 1));
    }
    f32x4 acc[4][4];
    gemm_mainloop<false>(g, gn, hasn, pre, smem, acc);
    pre = hasn; g = gn;
#pragma unroll
    for (int m = 0; m < 4; ++m) {
      const int r = wr * 64 + 16 * m + fr;
      const int tk = tkv[m], b = tk / S;
      f32x4 o[4];
#pragma unroll
      for (int n = 0; n < 4; ++n) {
        const int col = n0 + wc * 64 + 16 * n + 4 * fq;
        const u32x2 xr = *(const u32x2*)(p.x1() + (size_t)tk * D + col);
        const f32x4 xv = {bf_lo(xr[0]), bf_hi(xr[0]), bf_lo(xr[1]), bf_hi(xr[1])};
        const f32x4 g2 = *(const f32x4*)(modl + (size_t)b * 6144 + 5 * 1024 + col);
#pragma unroll
        for (int j = 0; j < 4; ++j) o[n][j] = xv[j] + g2[j] * acc[m][n][j];
      }
      if (r < nrow) {
#pragma unroll
        for (int n = 0; n < 4; ++n) *(f32x4*)(p.out + (size_t)tk * D + n0 + wc * 64 + 16 * n + 4 * fq) = o[n];
      }
    }
  }
}
#define XB_TMO      128
#define XB_XCNT(j)  (256  + 64 * (j))
#define XB_XSUB(j)  (1280 + 64 * (j))
#define XB_XGEN(j)  (2304 + 64 * (j))
#define XB_TOP      3328
#define XB_TOPGEN   3392
#define XCD_BAR_WORDS 3456
#define XB_SPIN_CAP (1u << 22)
#define LAS __attribute__((address_space(3)))

__device__ __forceinline__ unsigned xb_ld(unsigned* p)              { return __hip_atomic_load(p, __ATOMIC_RELAXED, __HIP_MEMORY_SCOPE_AGENT); }
__device__ __forceinline__ unsigned xb_add(unsigned* p, unsigned v) { return __hip_atomic_fetch_add(p, v, __ATOMIC_RELAXED, __HIP_MEMORY_SCOPE_AGENT); }
__device__ __forceinline__ unsigned xb_xcc_id() { return (unsigned)__builtin_amdgcn_s_getreg((3 << 11) | 20) & 0xFu; }
#define XB_SPIN(cond, bar) do { unsigned _sp = 0; while (cond) { __builtin_amdgcn_s_sleep(1); \
    if ((++_sp & 255u) == 0u) { if (xb_ld(&(bar)[XB_TMO])) break; if (_sp > XB_SPIN_CAP) { atomicAdd(&(bar)[XB_TMO], 1u); break; } } } } while (0)

struct XcdBarrier { unsigned* bar; unsigned x; volatile LAS unsigned* st; };

__device__ __forceinline__ XcdBarrier xcd_barrier_post(unsigned* bar, volatile LAS unsigned* st) {
  XcdBarrier b; b.bar = bar; b.x = xb_xcc_id(); b.st = st;
  if (threadIdx.x == 0) (void)xb_add(&bar[XB_XCNT(b.x)], 1u);
  return b;
}
__device__ __forceinline__ void xcd_barrier_complete(unsigned* bar, unsigned x, unsigned& nloc, unsigned& nx) {
  const unsigned G = gridDim.x * gridDim.y * gridDim.z;
  unsigned sum, cnt, mine, sp = 0u;
  for (;;) {
    sum = 0u; cnt = 0u; mine = 0u;
#pragma unroll
    for (unsigned j = 0; j < 16; ++j) { const unsigned c = xb_ld(&bar[XB_XCNT(j)]); sum += c; cnt += (c > 0u) ? 1u : 0u; mine = (j == x) ? c : mine; }
    if (sum == G) break;
    __builtin_amdgcn_s_sleep(1);
    if ((++sp & 255u) == 0u) { if (xb_ld(&bar[XB_TMO])) break; if (sp > XB_SPIN_CAP) { atomicAdd(&bar[XB_TMO], 1u); break; } }
  }
  nloc = mine > 0u ? mine : 1u; nx = cnt > 0u ? cnt : 1u;
}
__device__ __forceinline__ void xcd_barrier(const XcdBarrier& b) {
  asm volatile("s_waitcnt vmcnt(0)" ::: "memory");
  __syncthreads();
  if (threadIdx.x == 0) {
    unsigned* bar = b.bar;
    __builtin_amdgcn_s_waitcnt(0);
    unsigned nloc = b.st[0], nx = b.st[1];
    if (nloc == 0u) { xcd_barrier_complete(bar, b.x, nloc, nx); b.st[0] = nloc; b.st[1] = nx; }
    const unsigned old = xb_add(&bar[XB_XSUB(b.x)], 1u);
    const unsigned gen = old / nloc;
    if (old + 1u == (gen + 1u) * nloc) {
      __builtin_amdgcn_fence(__ATOMIC_RELEASE, "agent");
      asm volatile("s_waitcnt vmcnt(0)" ::: "memory");
      const unsigned og = xb_add(&bar[XB_TOP], 1u);
      const unsigned tg = og / nx;
      if (og + 1u == (tg + 1u) * nx) xb_add(&bar[XB_TOPGEN], 1u);
      else XB_SPIN(xb_ld(&bar[XB_TOPGEN]) == tg, bar);
      __builtin_amdgcn_fence(__ATOMIC_ACQUIRE, "agent");
      xb_add(&bar[XB_XGEN(b.x)], 1u);
      asm volatile("s_waitcnt vmcnt(0)" ::: "memory");
    } else {
      XB_SPIN(xb_ld(&bar[XB_XGEN(b.x)]) == gen, bar);
      __builtin_amdgcn_fence(__ATOMIC_ACQUIRE, "agent");
      asm volatile("s_waitcnt vmcnt(0)" ::: "memory");
    }
  }
  __syncthreads();
}

constexpr int NSUB = 9;

template <int L>
__device__ __forceinline__ void run_layer(const MP& p, char* smem, const XcdBarrier& xb, int ssm_wid, int idle_id) {
  constexpr int l = L;
  const float* xin = L == 0 ? p.in.x : p.out;
  phase_norm1(p, l, xin);          xcd_barrier(xb);
  phase_inproj(p, l, smem);        xcd_barrier(xb);
  phase_attn(p, l);                xcd_barrier(xb);
  phase_ssm(p, l, smem, ssm_wid);
  {
    constexpr int TT_SMALL = TT_WIN + TT_GLU + TT_OUT;
    const int nidle = (int)__hip_atomic_load(p.claim() + 4097, __ATOMIC_RELAXED, __HIP_MEMORY_SCOPE_AGENT);
    if (nidle == 0) phase0_transposes(p, smem, L * TT_LAYER + TT_SMALL, (L + 1) * TT_LAYER, blockIdx.x, gridDim.x);
    else if (idle_id >= 0) phase0_transposes(p, smem, L * TT_LAYER + TT_SMALL, (L + 1) * TT_LAYER, launder_s(__builtin_amdgcn_readfirstlane(idle_id)), nidle);
  }
  xcd_barrier(xb);
  phase_glu(p, l, smem);           xcd_barrier(xb);
  phase_out(p, l, smem, xin);      xcd_barrier(xb);
  phase_norm2_route(p, l, smem);   xcd_barrier(xb);
  phase_moe_gu(p, l, smem);        xcd_barrier(xb);
  phase_moe_down(p, l, smem);
  if (L + 1 < DEPTH) xcd_barrier(xb);
}

__global__ void __launch_bounds__(NTHR, 2) mega(MP p) {
  __shared__ __attribute__((aligned(16))) char smem[65536 + 16 + 2048];
  unsigned* xb_words = (unsigned*)(smem + 65536);
  if (threadIdx.x < 4) xb_words[threadIdx.x] = 0u;
  __syncthreads();
  const XcdBarrier xb = xcd_barrier_post(p.bar(), (volatile LAS unsigned*)xb_words);
  if (threadIdx.x == 0) {
    const unsigned key = (xb_xcc_id() << 8) | ((unsigned)__builtin_amdgcn_s_getreg((7 << 11) | (8 << 6) | 4) & 0xffu);
    const unsigned rank = xb_add(p.claim() + key, 1u);
    xb_words[2] = rank == 0u ? xb_add(p.claim() + 4096, 1u) : 0xffffffffu;
    xb_words[3] = rank == 0u ? 0xffffffffu : xb_add(p.claim() + 4097, 1u);
  }
  __syncthreads();
  const int ssm_wid = (int)xb_words[2], idle_id = (int)xb_words[3];
  for (int it = blockIdx.x; it < P0_MISC; it += gridDim.x) phase0_item(p, it, smem);
  phase0_transposes(p, smem, 0, TT_WIN + TT_GLU + TT_OUT, blockIdx.x, gridDim.x);
  phase0_transposes(p, smem, TT_LAYER, TT_LAYER + TT_WIN + TT_GLU + TT_OUT, blockIdx.x, gridDim.x);
  xcd_barrier(xb);
  run_layer<0>(p, smem, xb, ssm_wid, idle_id);
  run_layer<1>(p, smem, xb, ssm_wid, idle_id);
  static_assert(DEPTH == 2, "two layers instantiated");
}

}

extern "C" void kernel_launch(void* const* d_in, const int* in_sizes, int n_in, void* d_out, int out_size, void* d_ws,
                              size_t ws_size, hipStream_t stream) {
  MP p; memset(&p, 0, sizeof(p));
  Ptrs& P = p.in;
  P.x = (const float*)d_in[0]; P.c = (const float*)d_in[1]; P.pos = (const int*)d_in[2];
  P.ada_w = (const float*)d_in[3]; P.ada_b = (const float*)d_in[4]; P.norm1_g = (const float*)d_in[5];
  P.w_in = (const float*)d_in[6]; P.q_norm_g = (const float*)d_in[7]; P.k_norm_g = (const float*)d_in[8];
  P.attn_sink = (const float*)d_in[9]; P.lam_re = (const float*)d_in[10]; P.lam_im = (const float*)d_in[11];
  P.b_re = (const float*)d_in[12]; P.b_im = (const float*)d_in[13]; P.c_re = (const float*)d_in[14]; P.c_im = (const float*)d_in[15];
  P.ssm_d = (const float*)d_in[16]; P.log_dt = (const float*)d_in[17]; P.w_glu = (const float*)d_in[18];
  P.attn_out_g = (const float*)d_in[19]; P.ssm_out_g = (const float*)d_in[20]; P.w_out = (const float*)d_in[21];
  P.norm2_g = (const float*)d_in[22]; P.w_router = (const float*)d_in[23]; P.router_bias = (const float*)d_in[24];
  P.w_gate = (const float*)d_in[25]; P.w_up = (const float*)d_in[26]; P.w_down = (const float*)d_in[27];
  p.out = (float*)d_out;

  p.ws = (char*)d_ws;
  if (WS_TOTAL > ws_size) { fprintf(stderr, "workspace too small: need %zu have %zu\n", (size_t)WS_TOTAL, ws_size); return; }
  (void)in_sizes; (void)n_in; (void)out_size;

  static int grid_blocks = 0;
  if (!grid_blocks) {
    int dev = 0, cus = 0, per_cu = 0;
    (void)hipGetDevice(&dev);
    (void)hipDeviceGetAttribute(&cus, hipDeviceAttributeMultiprocessorCount, dev);
    (void)hipOccupancyMaxActiveBlocksPerMultiprocessor(&per_cu, mega, NTHR, 0);
    if (per_cu > 2) per_cu = 2;
    if (per_cu < 1) per_cu = 1;
    grid_blocks = cus * per_cu;
  }
  (void)hipMemsetAsync(p.ws + OFF_BAR, 0, OFF_MOD - OFF_BAR, stream);
  void* args[] = {&p};
  hipError_t e = hipLaunchCooperativeKernel((void*)mega, dim3(grid_blocks), dim3(NTHR), args, 0, stream);
  if (e != hipSuccess) fprintf(stderr, "cooperative launch failed: %s (grid %d)\n", hipGetErrorString(e), grid_blocks);
}
```

```cpp
#include <hip/hip_runtime.h>
#include <hip/hip_cooperative_groups.h>
#include <stdint.h>
#include <cstdio>
#include <cstring>

namespace {
constexpr int D = 1024, NB = 8, S = 2048, T = NB * S, DEPTH = 2;
constexpr int AW = 512, HD = 64, NQ = 8, NKV = 2, INW = 1280;
constexpr int SG = 32, SCH = 16, SP = 64, SW = 512;
constexpr int NE = 16, DFF = 512;
constexpr int NBUCKET = 24;
constexpr float EPS = 1e-6f;

struct Ptrs {
  const float *x, *c; const int* pos; const float *ada_w, *ada_b, *norm1_g, *w_in, *q_norm_g, *k_norm_g, *attn_sink,
      *lam_re, *lam_im, *b_re, *b_im, *c_re, *c_im, *ssm_d, *log_dt, *w_glu, *attn_out_g, *ssm_out_g, *w_out, *norm2_g,
      *w_router, *router_bias, *w_gate, *w_up, *w_down;
};

__device__ __forceinline__ float row_sum32_dpp(float v) {
  v += __int_as_float(__builtin_amdgcn_update_dpp(0, __float_as_int(v), 0xB1, 0xF, 0xF, true));
  v += __int_as_float(__builtin_amdgcn_update_dpp(0, __float_as_int(v), 0x4E, 0xF, 0xF, true));
  v += __int_as_float(__builtin_amdgcn_update_dpp(0, __float_as_int(v), 0x141, 0xF, 0xF, true));
  v += __int_as_float(__builtin_amdgcn_update_dpp(0, __float_as_int(v), 0x140, 0xF, 0xF, true));
  v += __int_as_float(__builtin_amdgcn_update_dpp(0, __float_as_int(v), 0x142, 0xA, 0xF, false));
  return v;
}
__device__ __forceinline__ float wave_sum(float v) {
  v = row_sum32_dpp(v);
  return __int_as_float(__builtin_amdgcn_readlane(__float_as_int(v), 31)) + __int_as_float(__builtin_amdgcn_readlane(__float_as_int(v), 63));
}
__device__ __forceinline__ float xhalf_sum(float v) {
  const auto r = __builtin_amdgcn_permlane32_swap(__float_as_uint(v), __float_as_uint(v), false, false);
  return __uint_as_float(r[0]) + __uint_as_float(r[1]);
}
__device__ __forceinline__ float xhalf_max(float v) {
  const auto r = __builtin_amdgcn_permlane32_swap(__float_as_uint(v), __float_as_uint(v), false, false);
  return fmaxf(__uint_as_float(r[0]), __uint_as_float(r[1]));
}

typedef unsigned short bf16_t;
typedef short bf16x8 __attribute__((ext_vector_type(8)));
typedef float f32x4 __attribute__((ext_vector_type(4)));
typedef float f32x16 __attribute__((ext_vector_type(16)));
typedef float f32x2 __attribute__((ext_vector_type(2)));
typedef __bf16 bf16x2_t __attribute__((ext_vector_type(2)));
typedef unsigned u32x4 __attribute__((ext_vector_type(4)));
typedef unsigned u32x2 __attribute__((ext_vector_type(2)));

constexpr int NTHR = 256;
constexpr int TM = 128;
constexpr int MAXMT = T / TM + NBUCKET;
constexpr int NSUBL = 8;
constexpr int SMEM_MM = 65536 + 32;

__device__ __forceinline__ unsigned pack2(float lo, float hi) {
  f32x2 v = {lo, hi};
  return __builtin_bit_cast(unsigned, __builtin_convertvector(v, bf16x2_t));
}
__device__ __forceinline__ int launder(int x) { asm volatile("" : "+v"(x)); return x; }
__device__ __forceinline__ int launder_s(int x) { asm volatile("" : "+s"(x)); return x; }
__device__ __forceinline__ float bf_lo(unsigned u) { return __uint_as_float(u << 16); }
__device__ __forceinline__ float bf_hi(unsigned u) { return __uint_as_float(u & 0xffff0000u); }
__device__ __forceinline__ float bf1(bf16_t u) { return __uint_as_float(((unsigned)u) << 16); }

constexpr size_t al256(size_t x) { return (x + 255) & ~(size_t)255; }
constexpr size_t OFF_BAR = 0;
constexpr size_t OFF_CLAIM = OFF_BAR + al256(4096 * 4);
constexpr size_t OFF_MOD = OFF_CLAIM + al256(4096 * 4 + 256);
constexpr size_t OFF_CS = OFF_MOD + al256((size_t)DEPTH * 8 * 6144 * 4);
constexpr size_t OFF_CNT = OFF_CS + al256((size_t)T * 32 * 8);
constexpr size_t OFF_LIST = OFF_CNT + al256(256 * 4 * DEPTH);
constexpr size_t OFF_TOKW = OFF_LIST + al256((size_t)NBUCKET * NSUBL * T * 4);
constexpr size_t OFF_SSMB = OFF_TOKW + al256((size_t)T * 8);
constexpr size_t OFF_SSMC = OFF_SSMB + al256((size_t)DEPTH * SG * 128 * 16 * 2);
constexpr size_t OFF_SSML = OFF_SSMC + al256((size_t)DEPTH * SG * 16 * 128 * 2);
constexpr size_t OFF_WINT = OFF_SSML + al256((size_t)DEPTH * SG * SP * 2 * 4);
constexpr size_t OFF_WGLUT = OFF_WINT + al256((size_t)DEPTH * INW * D * 2);
constexpr size_t OFF_WOUTT = OFF_WGLUT + al256((size_t)DEPTH * SW * SW * 2);
constexpr size_t OFF_H = OFF_WOUTT + al256((size_t)DEPTH * D * D * 2);
constexpr size_t OFF_Q = OFF_H + al256((size_t)T * D * 2);
constexpr size_t OFF_K = OFF_Q + al256((size_t)T * AW * 2);
constexpr size_t OFF_VT = OFF_K + al256((size_t)T * 128 * 2);
constexpr size_t OFF_U = OFF_VT + al256((size_t)T * 128 * 2);
constexpr size_t OFF_ATTN = OFF_U + al256((size_t)T * SW * 2);
constexpr size_t OFF_ACT = OFF_Q;
static_assert((size_t)MAXMT * TM * D * 2 <= OFF_ATTN - OFF_Q, "act overlay too small");
constexpr size_t OFF_SSQA = OFF_ATTN + al256((size_t)T * AW * 2);
constexpr size_t OFF_Y = OFF_SSQA + al256((size_t)T * 8 * 4);
constexpr size_t OFF_SSM = OFF_Y + al256((size_t)T * SW * 2);
constexpr size_t OFF_SSQS = OFF_SSM + al256((size_t)T * SW * 2);
constexpr size_t OFF_X1 = OFF_SSQS + al256((size_t)T * 8 * 4);
constexpr size_t OFF_WGT = OFF_X1 + al256((size_t)T * D * 4);
constexpr size_t OFF_WUT = OFF_WGT + al256((size_t)DEPTH * NE * DFF * D * 2);
constexpr size_t OFF_WDT = OFF_WUT + al256((size_t)DEPTH * NE * DFF * D * 2);
constexpr size_t WS_TOTAL = OFF_WDT + al256((size_t)DEPTH * NE * DFF * D * 2);

struct MP {
  Ptrs in;
  float* out;
  char* ws;
  __device__ __forceinline__ unsigned* bar() const { return (unsigned*)(ws + OFF_BAR); }
  __device__ __forceinline__ unsigned* claim() const { return (unsigned*)(ws + OFF_CLAIM); }
  __device__ __forceinline__ float* mod() const { return (float*)(ws + OFF_MOD); }
  __device__ __forceinline__ float2* cs() const { return (float2*)(ws + OFF_CS); }
  __device__ __forceinline__ int* cnt() const { return (int*)(ws + OFF_CNT); }
  __device__ __forceinline__ int* list() const { return (int*)(ws + OFF_LIST); }
  __device__ __forceinline__ float2* tokw() const { return (float2*)(ws + OFF_TOKW); }
  __device__ __forceinline__ bf16_t* ssmB() const { return (bf16_t*)(ws + OFF_SSMB); }
  __device__ __forceinline__ bf16_t* ssmC() const { return (bf16_t*)(ws + OFF_SSMC); }
  __device__ __forceinline__ float* ssmL() const { return (float*)(ws + OFF_SSML); }
  __device__ __forceinline__ bf16_t* WinT() const { return (bf16_t*)(ws + OFF_WINT); }
  __device__ __forceinline__ bf16_t* WgluT() const { return (bf16_t*)(ws + OFF_WGLUT); }
  __device__ __forceinline__ bf16_t* WoutT() const { return (bf16_t*)(ws + OFF_WOUTT); }
  __device__ __forceinline__ bf16_t* WgT() const { return (bf16_t*)(ws + OFF_WGT); }
  __device__ __forceinline__ bf16_t* WuT() const { return (bf16_t*)(ws + OFF_WUT); }
  __device__ __forceinline__ bf16_t* WdT() const { return (bf16_t*)(ws + OFF_WDT); }
  __device__ __forceinline__ bf16_t* h() const { return (bf16_t*)(ws + OFF_H); }
  __device__ __forceinline__ bf16_t* q() const { return (bf16_t*)(ws + OFF_Q); }
  __device__ __forceinline__ bf16_t* k() const { return (bf16_t*)(ws + OFF_K); }
  __device__ __forceinline__ bf16_t* vT() const { return (bf16_t*)(ws + OFF_VT); }
  __device__ __forceinline__ bf16_t* u() const { return (bf16_t*)(ws + OFF_U); }
  __device__ __forceinline__ bf16_t* attn() const { return (bf16_t*)(ws + OFF_ATTN); }
  __device__ __forceinline__ bf16_t* y() const { return (bf16_t*)(ws + OFF_Y); }
  __device__ __forceinline__ bf16_t* ssm() const { return (bf16_t*)(ws + OFF_SSM); }
  __device__ __forceinline__ bf16_t* act() const { return (bf16_t*)(ws + OFF_ACT); }
  __device__ __forceinline__ float* ssqa() const { return (float*)(ws + OFF_SSQA); }
  __device__ __forceinline__ float* ssqs() const { return (float*)(ws + OFF_SSQS); }
  __device__ __forceinline__ bf16_t* x1() const { return (bf16_t*)(ws + OFF_X1); }
};

constexpr int TT_WIN = 8 * 20, TT_GLU = 4 * 8, TT_OUT = 8 * 16, TT_EXP = 16 * 64;
constexpr int TT_LAYER = TT_WIN + TT_GLU + TT_OUT + 3 * TT_EXP;
constexpr int P0_MOD = DEPTH * 192;
constexpr int P0_TR = DEPTH * TT_LAYER;
constexpr int P0_CS = T * 32 / 256;
constexpr int P0_SSM = DEPTH * SG;
constexpr int P0_MISC = P0_MOD + P0_CS + P0_SSM + 1;

__device__ __forceinline__ void phase0_item(const MP& p, int it, char* smem) {
  const int tid = launder(threadIdx.x);
  float* ldsf = (float*)smem;
  if (it < P0_MOD) {
    const int l = it / 192, j0 = (it % 192) * 32;
    float* sc = ldsf;
    float* red = ldsf + 8192;
    for (int i = tid; i < 8192; i += NTHR) { float v = p.in.c[i]; sc[i] = v / (1.f + __expf(-v)); }
    __syncthreads();
    const int kg = tid >> 3, cq = (tid & 7) * 4;
    float acc[8][4];
#pragma unroll
    for (int b = 0; b < 8; ++b)
#pragma unroll
      for (int j = 0; j < 4; ++j) acc[b][j] = 0.f;
    const float* w = p.in.ada_w + (size_t)l * 1024 * 6144 + j0 + cq;
#pragma unroll 8
    for (int kk = 0; kk < 32; ++kk) {
      const int k = kg * 32 + kk;
      const float4 wv = *(const float4*)(w + (size_t)k * 6144);
#pragma unroll
      for (int b = 0; b < 8; ++b) { const float s = sc[b * 1024 + k]; acc[b][0] += s * wv.x; acc[b][1] += s * wv.y; acc[b][2] += s * wv.z; acc[b][3] += s * wv.w; }
    }
#pragma unroll
    for (int b = 0; b < 8; ++b) *(float4*)(red + (kg * 8 + b) * 32 + cq) = make_float4(acc[b][0], acc[b][1], acc[b][2], acc[b][3]);
    __syncthreads();
    {
      const int b = tid >> 5, c = tid & 31;
      float v = 0.f;
#pragma unroll 8
      for (int g = 0; g < 32; ++g) v += red[(g * 8 + b) * 32 + c];
      p.mod()[(size_t)(l * 8 + b) * 6144 + j0 + c] = v + p.in.ada_b[l * 6144 + j0 + c];
    }
    __syncthreads();
    return;
  }
  it -= P0_MOD;
  if (it < P0_CS) {
    const int i = it * 256 + tid, t = i >> 5, f = i & 31;
    const float freq = powf(10000.f, -(float)f / 32.f);
    const float ang = (float)p.in.pos[t] * freq;
    float sn, cn; sincosf(ang, &sn, &cn);
    p.cs()[i] = make_float2(cn, sn);
    return;
  }
  it -= P0_CS;
  if (it < P0_SSM) {
    const int lg = it;
    if (tid < 64) {
      const int pp = tid;
      const float dt = expf(p.in.log_dt[lg]);
      const float lr = p.in.lam_re[lg * SP + pp], li = p.in.lam_im[lg * SP + pp];
      const float mag = expf(lr * dt);
      float sn, cn; sincosf(li * dt, &sn, &cn);
      const float ar = mag * cn, ai = mag * sn;
      const float den = lr * lr + li * li;
      const float fr = ((ar - 1.f) * lr + ai * li) / den, fi = (ai * lr - (ar - 1.f) * li) / den;
      p.ssmL()[(lg * SP + pp) * 2] = ar; p.ssmL()[(lg * SP + pp) * 2 + 1] = ai;
      unsigned wr[8], wi[8];
#pragma unroll
      for (int hh = 0; hh < 8; ++hh) {
        const float br0 = p.in.b_re[((size_t)lg * SP + pp) * SCH + 2 * hh], bi0 = p.in.b_im[((size_t)lg * SP + pp) * SCH + 2 * hh];
        const float br1 = p.in.b_re[((size_t)lg * SP + pp) * SCH + 2 * hh + 1], bi1 = p.in.b_im[((size_t)lg * SP + pp) * SCH + 2 * hh + 1];
        wr[hh] = pack2(fr * br0 - fi * bi0, fr * br1 - fi * bi1);
        wi[hh] = pack2(fr * bi0 + fi * br0, fr * bi1 + fi * br1);
      }
      u32x4* dr = (u32x4*)(p.ssmB() + ((size_t)lg * 128 + pp) * 16);
      u32x4* di = (u32x4*)(p.ssmB() + ((size_t)lg * 128 + 64 + pp) * 16);
      dr[0] = (u32x4){wr[0], wr[1], wr[2], wr[3]}; dr[1] = (u32x4){wr[4], wr[5], wr[6], wr[7]};
      di[0] = (u32x4){wi[0], wi[1], wi[2], wi[3]}; di[1] = (u32x4){wi[4], wi[5], wi[6], wi[7]};
    }
    for (int o = tid; o < 16 * 64; o += NTHR) {
      const int hh = o >> 6, pp = o & 63;
      const float cr = p.in.c_re[(size_t)lg * SCH * SP + o], ci = p.in.c_im[(size_t)lg * SCH * SP + o];
      *(unsigned*)(p.ssmC() + ((size_t)lg * 16 + hh) * 128 + 2 * pp) = pack2(cr, -ci);
    }
    return;
  }
  for (int i = tid; i < 256 * DEPTH; i += NTHR) p.cnt()[i] = 0;
}

struct TrDesc { const float* src; bf16_t* dst; const float* gain; int N, K, k0, n0; };
__device__ __forceinline__ void tr_decode(const MP& p, int it, TrDesc& d) {
  const int l = it / TT_LAYER; int r = it % TT_LAYER;
  d.gain = nullptr;
  if (r < TT_WIN) { d.src = p.in.w_in + (size_t)l * D * INW; d.N = INW; d.dst = p.WinT() + (size_t)l * INW * D; d.K = D; d.k0 = (r / 20) * 128; d.n0 = (r % 20) * 64; return; }
  r -= TT_WIN;
  if (r < TT_GLU) { d.src = p.in.w_glu + (size_t)l * SW * SW; d.N = SW; d.dst = p.WgluT() + (size_t)l * SW * SW; d.K = SW; d.k0 = (r / 8) * 128; d.n0 = (r % 8) * 64; return; }
  r -= TT_GLU;
  if (r < TT_OUT) {
    d.k0 = (r / 16) * 128; d.n0 = (r % 16) * 64;
    d.gain = d.k0 < 512 ? (p.in.attn_out_g + l * AW) : (p.in.ssm_out_g + l * SW - 512);
    d.src = p.in.w_out + (size_t)l * D * D; d.N = D; d.dst = p.WoutT() + (size_t)l * D * D; d.K = D; return; }
  r -= TT_OUT;
  const int kind = r / TT_EXP; r %= TT_EXP;
  const int e = r / 64, tt = r % 64;
  if (kind == 0) { d.src = p.in.w_gate + (size_t)(l * NE + e) * D * DFF; d.N = DFF; d.dst = p.WgT() + (size_t)(l * NE + e) * DFF * D; d.K = D; d.k0 = (tt / 8) * 128; d.n0 = (tt % 8) * 64; return; }
  if (kind == 1) { d.src = p.in.w_up + (size_t)(l * NE + e) * D * DFF; d.N = DFF; d.dst = p.WuT() + (size_t)(l * NE + e) * DFF * D; d.K = D; d.k0 = (tt / 8) * 128; d.n0 = (tt % 8) * 64; return; }
  d.src = p.in.w_down + (size_t)(l * NE + e) * DFF * D; d.N = D; d.dst = p.WdT() + (size_t)(l * NE + e) * D * DFF; d.K = DFF; d.k0 = (tt / 16) * 128; d.n0 = (tt % 16) * 64;
}
__device__ __forceinline__ void phase0_transposes(const MP& p, char* smem, int first, int last, int brank, int nblk) {
  const int tid = launder(threadIdx.x);
  float* lds = (float*)smem;
  const int r = tid >> 4, c4 = (tid & 15) * 4;
  const int n = tid >> 2, kq = (tid & 3) * 32;
  TrDesc cur, nxt;
  float4 v[8]; float gg[8];
  auto load = [&](const TrDesc& d) {
#pragma unroll
    for (int i = 0; i < 8; ++i) v[i] = *(const float4*)(d.src + (size_t)(d.k0 + r + 16 * i) * d.N + d.n0 + c4);
    if (d.gain) {
#pragma unroll
      for (int i = 0; i < 8; ++i) gg[i] = d.gain[d.k0 + r + 16 * i];
    } else {
#pragma unroll
      for (int i = 0; i < 8; ++i) gg[i] = 1.f;
    }
  };
  int it = first + brank;
  if (it < last) { tr_decode(p, it, cur); load(cur); nxt = cur; }
  for (; it < last; it += nblk) {
#pragma unroll
    for (int i = 0; i < 8; ++i) {
      float* d = lds + (r + 16 * i) * 65 + c4;
      d[0] = v[i].x * gg[i]; d[1] = v[i].y * gg[i]; d[2] = v[i].z * gg[i]; d[3] = v[i].w * gg[i];
    }
    __syncthreads();
    const int nit = it + nblk;
    if (nit < last) { tr_decode(p, nit, nxt); load(nxt); }
    unsigned w[16];
#pragma unroll
    for (int j = 0; j < 16; ++j) w[j] = pack2(lds[(kq + 2 * j) * 65 + n], lds[(kq + 2 * j + 1) * 65 + n]);
    u32x4* dd = (u32x4*)(cur.dst + (size_t)(cur.n0 + n) * cur.K + cur.k0 + kq);
#pragma unroll
    for (int j = 0; j < 4; ++j) dd[j] = (u32x4){w[4 * j], w[4 * j + 1], w[4 * j + 2], w[4 * j + 3]};
    __syncthreads();
    cur = nxt;
  }
}

__device__ __forceinline__ void norm_token(const float* __restrict__ xr, const float* __restrict__ g, const float* __restrict__ sh,
                                           const float* __restrict__ sc, bf16_t* __restrict__ hr, int lane, float (&hv)[16]) {
  float4 v[4]; float ss = 0.f;
#pragma unroll
  for (int i = 0; i < 4; ++i) { v[i] = *(const float4*)(xr + lane * 4 + 256 * i); ss += v[i].x * v[i].x + v[i].y * v[i].y + v[i].z * v[i].z + v[i].w * v[i].w; }
  ss = wave_sum(ss);
  const float rinv = rsqrtf(ss * (1.f / D) + EPS);
#pragma unroll
  for (int i = 0; i < 4; ++i) {
    const int d = lane * 4 + 256 * i;
    const float4 gg = *(const float4*)(g + d), s1 = *(const float4*)(sc + d), s0 = *(const float4*)(sh + d);
    hv[4 * i + 0] = v[i].x * rinv * gg.x * (1.f + s1.x) + s0.x;
    hv[4 * i + 1] = v[i].y * rinv * gg.y * (1.f + s1.y) + s0.y;
    hv[4 * i + 2] = v[i].z * rinv * gg.z * (1.f + s1.z) + s0.z;
    hv[4 * i + 3] = v[i].w * rinv * gg.w * (1.f + s1.w) + s0.w;
    *(u32x2*)(hr + d) = (u32x2){pack2(hv[4 * i], hv[4 * i + 1]), pack2(hv[4 * i + 2], hv[4 * i + 3])};
  }
}

struct TokRange { int t0, step, end; };
__device__ __forceinline__ TokRange tok_range(int wave) {
  TokRange r;
  if ((gridDim.x & 7) == 0) { const int xcd = blockIdx.x & 7, lb = blockIdx.x >> 3, nlb = gridDim.x >> 3; r.t0 = xcd * S + lb * 4 + wave; r.step = nlb * 4; r.end = (xcd + 1) * S; }
  else { r.t0 = blockIdx.x * 4 + wave; r.step = gridDim.x * 4; r.end = T; }
  return r;
}
__device__ __forceinline__ void phase_norm1(const MP& p, int l, const float* xin) {
  const int tid = launder(threadIdx.x);
  const int wave = tid >> 6, lane = tid & 63;
  const float* modl = p.mod() + (size_t)l * 8 * 6144;
  const TokRange tr = tok_range(wave);
  for (int t = tr.t0; t < tr.end; t += tr.step) {
    const int b = t / S; float hv[16];
    norm_token(xin + (size_t)t * D, p.in.norm1_g + l * D, modl + (size_t)b * 6144, modl + (size_t)b * 6144 + 1024, p.h() + (size_t)t * D, lane, hv);
  }
}

struct GemmTile {
  const bf16_t* A0; const bf16_t* A1; long lda; int ksA;
  int arow[4];
  const bf16_t* Blo0; const bf16_t* Bhi0;
  const bf16_t* Blo1; const bf16_t* Bhi1;
  long ldb; int ksB;
  int K;
};

__device__ __forceinline__ int lds_off(int row, int chunk) { return row * 128 + ((chunk ^ ((row >> 1) & 7)) << 4); }

template <bool BSPLIT, bool MID>
__device__ __forceinline__ void gemm_mainloop_t(const GemmTile& g, const GemmTile& gnext, bool hasnext, bool preloaded, char* smem, f32x4 (&acc)[4][4],
                                                int ktmid, const float (&mids)[4]) {
  const int tid = launder(threadIdx.x), lane = tid & 63, wave = tid >> 6, wr = wave >> 1, wc = wave & 1, fr = lane & 15, fq = lane >> 4;
  const int r0 = tid >> 3, c8 = tid & 7;
  const int csrc = (c8 ^ ((r0 >> 1) & 7)) * 8;
  const int wbase = __builtin_amdgcn_readfirstlane(wave) * 1024;
#pragma unroll
  for (int m = 0; m < 4; ++m)
#pragma unroll
    for (int n = 0; n < 4; ++n) acc[m][n] = (f32x4){0.f, 0.f, 0.f, 0.f};
  auto stage = [&](const GemmTile& gg, int kt, int buf) {
    const int kk = kt * 64;
    const bf16_t* Ab = kk < gg.ksA ? gg.A0 + kk : gg.A1 + (kk - gg.ksA);
    const bool bs = kk < gg.ksB; const int kb = bs ? kk : kk - gg.ksB;
    char* As = smem + buf * 32768 + wbase; char* Bs = As + 16384;
#pragma unroll
    for (int i = 0; i < 4; ++i) {
      __builtin_amdgcn_global_load_lds((const void*)(Ab + (size_t)gg.arow[i] * gg.lda + csrc), (void*)(As + i * 4096), 16, 0, 0);
      const bf16_t* Bb = bs ? (i < 2 ? gg.Blo0 : gg.Bhi0) : (i < 2 ? gg.Blo1 : gg.Bhi1);
      __builtin_amdgcn_global_load_lds((const void*)(Bb + (size_t)(r0 + 32 * (i & 1)) * gg.ldb + kb + csrc), (void*)(Bs + i * 4096), 16, 0, 0);
    }
  };
  const int nk = g.K / 64;
  if (!preloaded) {
    stage(g, 0, 0);
    asm volatile("s_waitcnt vmcnt(0)" ::: "memory");
    __syncthreads();
  }
  for (int kt = 0; kt < nk; ++kt) {
    if (kt + 1 < nk) stage(g, kt + 1, (kt + 1) & 1);
    else if (hasnext) stage(gnext, 0, 0);
    if (MID && kt == ktmid) {
#pragma unroll
      for (int m = 0; m < 4; ++m)
#pragma unroll
        for (int n = 0; n < 4; ++n) acc[m][n] *= mids[m];
    }
    const char* As = smem + (kt & 1) * 32768; const char* Bs = As + 16384;
    {
      bf16x8 af[2][4], bfr[2][4];
#pragma unroll
      for (int ks = 0; ks < 2; ++ks) {
#pragma unroll
        for (int m = 0; m < 4; ++m) af[ks][m] = *(const bf16x8*)(As + lds_off(wr * 64 + 16 * m + fr, ks * 4 + fq));
#pragma unroll
        for (int n = 0; n < 4; ++n) {
          const int brow = BSPLIT ? ((n >> 1) * 64 + wc * 32 + (n & 1) * 16 + fr) : (wc * 64 + 16 * n + fr);
          bfr[ks][n] = *(const bf16x8*)(Bs + lds_off(brow, ks * 4 + fq));
        }
      }
#pragma unroll
      for (int ks = 0; ks < 2; ++ks)
#pragma unroll
        for (int m = 0; m < 4; ++m)
#pragma unroll
          for (int n = 0; n < 4; ++n) acc[m][n] = __builtin_amdgcn_mfma_f32_16x16x32_bf16(bfr[ks][n], af[ks][m], acc[m][n], 0, 0, 0);
      __builtin_amdgcn_sched_group_barrier(0x100, 8, 0);
#pragma unroll
      for (int i = 0; i < 8; ++i) { __builtin_amdgcn_sched_group_barrier(0x008, 2, 0); __builtin_amdgcn_sched_group_barrier(0x100, 1, 0); }
      __builtin_amdgcn_sched_group_barrier(0x008, 16, 0);
    }
    __builtin_amdgcn_sched_barrier(0);
    asm volatile("s_waitcnt vmcnt(0)" ::: "memory");
    __syncthreads();
  }
}
template <bool BSPLIT>
__device__ __forceinline__ void gemm_mainloop(const GemmTile& g, const GemmTile& gnext, bool hasnext, bool preloaded, char* smem, f32x4 (&acc)[4][4]) {
  const float dummy[4] = {1.f, 1.f, 1.f, 1.f};
  gemm_mainloop_t<BSPLIT, false>(g, gnext, hasnext, preloaded, smem, acc, -1, dummy);
}

struct TileMap { int base, ntl, lb, nlb; };
__device__ __forceinline__ TileMap tm_init(int nMt, int nNt) {
  TileMap t;
  if ((gridDim.x & 7) == 0) {
    const int xcd = blockIdx.x & 7;
    t.lb = blockIdx.x >> 3; t.nlb = gridDim.x >> 3;
    const int mlo = (nMt * xcd) >> 3, mhi = (nMt * (xcd + 1)) >> 3;
    t.base = mlo * nNt; t.ntl = (mhi - mlo) * nNt;
  } else { t.lb = blockIdx.x; t.nlb = gridDim.x; t.base = 0; t.ntl = nMt * nNt; }
  return t;
}
__device__ __forceinline__ int tm_tile(const TileMap& t, int j) { const int li = t.lb + t.nlb * j; return li < t.ntl ? t.base + li : -1; }
__device__ __forceinline__ void phase_inproj(const MP& p, int l, char* smem) {
  const int tid = launder(threadIdx.x), lane = tid & 63, wave = tid >> 6, wr = wave >> 1, wc = wave & 1, fr = lane & 15, fq = lane >> 4;
  const int r0 = tid >> 3;
  const int ntiles = (T / 128) * (INW / 128);
  const bf16_t* W = p.WinT() + (size_t)l * INW * D;
  auto make = [&](int tile, GemmTile& g) {
    const int m0 = (tile / 10) * 128, n0 = (tile % 10) * 128;
    g.A0 = p.h(); g.A1 = p.h(); g.lda = D; g.ksA = D; g.K = D;
#pragma unroll
    for (int i = 0; i < 4; ++i) g.arow[i] = m0 + r0 + 32 * i;
    g.Blo0 = W + (size_t)n0 * D; g.Bhi0 = g.Blo0 + (size_t)64 * D; g.Blo1 = g.Blo0; g.Bhi1 = g.Bhi0;
    g.ldb = D; g.ksB = D;
  };
  GemmTile g, gn; bool pre = false;
  const TileMap tmap = tm_init(T / 128, INW / 128);
  { const int t0 = tm_tile(tmap, 0); if (t0 >= 0) { make(t0, g); gn = g; } }
  for (int jt = 0; ; ++jt) {
    const int tile = tm_tile(tmap, jt); if (tile < 0) break;
    const int mt = tile / 10, nt = tile % 10, m0 = mt * 128;
    const int nxt = tm_tile(tmap, jt + 1); const bool hasn = nxt >= 0;
    if (hasn) make(nxt, gn);
    f32x4 acc[4][4];
    gemm_mainloop<false>(g, gn, hasn, pre, smem, acc);
    pre = hasn; g = gn;
    const int rowb = m0 + wr * 64 + fr;
    if (nt <= 4) {
      const float* gv = (nt < 4 ? p.in.q_norm_g : p.in.k_norm_g) + l * HD;
      const float scl = nt < 4 ? 0.125f : 1.f;
      f32x4 g1[2], g2[2];
#pragma unroll
      for (int n = 0; n < 2; ++n) { g1[n] = *(const f32x4*)(gv + 16 * n + 4 * fq); g2[n] = *(const f32x4*)(gv + 32 + 16 * n + 4 * fq); }
#pragma unroll
      for (int m = 0; m < 4; ++m) {
        const int t = rowb + 16 * m;
        float ss = 0.f;
#pragma unroll
        for (int n = 0; n < 4; ++n)
#pragma unroll
          for (int j = 0; j < 4; ++j) ss += acc[m][n][j] * acc[m][n][j];
        ss += __shfl_xor(ss, 16); ss += __shfl_xor(ss, 32);
        const float rinv = rsqrtf(ss * (1.f / 64.f) + EPS) * scl;
        bf16_t* dst = nt < 4 ? (p.q() + (size_t)t * AW + (2 * nt + wc) * 64) : (p.k() + (size_t)t * 128 + wc * 64);
#pragma unroll
        for (int n = 0; n < 2; ++n) {
          const int c = 16 * n + 4 * fq;
          const f32x4 csa = *(const f32x4*)((const float*)p.cs() + ((size_t)t * 32 + c) * 2);
          const f32x4 csb = *(const f32x4*)((const float*)p.cs() + ((size_t)t * 32 + c + 2) * 2);
          const float cn[4] = {csa[0], csa[2], csb[0], csb[2]}, sn[4] = {csa[1], csa[3], csb[1], csb[3]};
          float o1[4], o2[4];
#pragma unroll
          for (int j = 0; j < 4; ++j) {
            const float x1 = acc[m][n][j] * rinv * g1[n][j], x2 = acc[m][n + 2][j] * rinv * g2[n][j];
            o1[j] = x1 * cn[j] - x2 * sn[j]; o2[j] = x2 * cn[j] + x1 * sn[j];
          }
          *(u32x2*)(dst + c) = (u32x2){pack2(o1[0], o1[1]), pack2(o1[2], o1[3])};
          *(u32x2*)(dst + 32 + c) = (u32x2){pack2(o2[0], o2[1]), pack2(o2[2], o2[3])};
        }
      }
    } else if (nt == 5) {
      const int b = m0 / S;
#pragma unroll
      for (int m = 0; m < 4; ++m) {
        const int s = (rowb + 16 * m) % S;
        const int k16 = s & 15;
        const int sp = (s & ~15) | (k16 & 3) | (((k16 >> 3) & 1) << 2) | (((k16 >> 2) & 1) << 3);
#pragma unroll
        for (int n = 0; n < 4; ++n)
#pragma unroll
          for (int j = 0; j < 4; ++j) {
            const int d = 16 * n + 4 * fq + j;
            p.vT()[((size_t)(b * 2 + wc) * 64 + d) * S + sp] = (bf16_t)(pack2(acc[m][n][j], 0.f) & 0xffffu);
          }
      }
    } else {
#pragma unroll
      for (int m = 0; m < 4; ++m) {
        const int t = rowb + 16 * m;
#pragma unroll
        for (int n = 0; n < 4; ++n)
          *(u32x2*)(p.u() + (size_t)t * SW + (nt - 6) * 128 + wc * 64 + 16 * n + 4 * fq) = (u32x2){pack2(acc[m][n][0], acc[m][n][1]), pack2(acc[m][n][2], acc[m][n][3])};
      }
    }
  }
}

__device__ __forceinline__ int crow32(int r, int hf) { return (r & 3) + 8 * (r >> 2) + 4 * hf; }
__device__ __forceinline__ void attn_task(const MP& p, int l, int task, int lane) {
  lane = launder(lane);
  task = __builtin_amdgcn_readfirstlane(task);
  const int h = task & 7, qt = (task >> 3) & 63, b = task >> 9, kvh = h >> 2;
  const int s0 = qt * 32, t0 = b * S + s0, ql = lane & 31, hf = lane >> 5;
  int kst[5];
#pragma unroll
  for (int kt = 0; kt < 5; ++kt) { const int ks = s0 - 128 + 32 * kt; kst[kt] = ks < 0 ? 0 : ks; }
  bf16x8 qf[4], kf[5][4];
#pragma unroll
  for (int st = 0; st < 4; ++st) qf[st] = *(const bf16x8*)(p.q() + (size_t)(t0 + ql) * AW + h * 64 + 16 * st + 8 * hf);
#pragma unroll
  for (int kt = 0; kt < 5; ++kt)
#pragma unroll
    for (int st = 0; st < 4; ++st) kf[kt][st] = *(const bf16x8*)(p.k() + (size_t)(b * S + kst[kt] + ql) * 128 + kvh * 64 + 8 * hf + 16 * st);
  f32x16 sc[5];
#pragma unroll
  for (int kt = 0; kt < 5; ++kt) {
#pragma unroll
    for (int r = 0; r < 16; ++r) sc[kt][r] = 0.f;
#pragma unroll
    for (int st = 0; st < 4; ++st) sc[kt] = __builtin_amdgcn_mfma_f32_32x32x16_bf16(kf[kt][st], qf[st], sc[kt], 0, 0, 0);
  }
  bf16x8 vb[5][2][2];
#pragma unroll
  for (int kt = 0; kt < 5; ++kt)
#pragma unroll
    for (int s = 0; s < 2; ++s)
#pragma unroll
      for (int dt = 0; dt < 2; ++dt)
        vb[kt][s][dt] = *(const bf16x8*)(p.vT() + ((size_t)(b * 2 + kvh) * 64 + 32 * dt + ql) * S + kst[kt] + 16 * s + 8 * hf);
  const float sink = p.in.attn_sink[l * NQ + h];
  float mx = sink;
#pragma unroll
  for (int kt = 0; kt < 5; ++kt) {
#pragma unroll
    for (int r = 0; r < 16; ++r) {
      const int kp = s0 - 128 + 32 * kt + crow32(r, hf);
      const int dk = kp - (s0 + ql);
      const bool valid = kp >= 0 && dk <= 0 && dk > -128;
      sc[kt][r] = valid ? sc[kt][r] : -1e30f;
      mx = fmaxf(mx, sc[kt][r]);
    }
  }
  mx = xhalf_max(mx);
  float lsum = 0.f;
#pragma unroll
  for (int kt = 0; kt < 5; ++kt) {
#pragma unroll
    for (int r = 0; r < 16; ++r) { const float e = __expf(sc[kt][r] - mx); sc[kt][r] = e; lsum += e; }
  }
  lsum = xhalf_sum(lsum);
  lsum += __expf(sink - mx);
  const float inv = 1.f / lsum;
  f32x16 o[2];
#pragma unroll
  for (int r = 0; r < 16; ++r) { o[0][r] = 0.f; o[1][r] = 0.f; }
#pragma unroll
  for (int kt = 0; kt < 5; ++kt) {
#pragma unroll
    for (int s = 0; s < 2; ++s) {
      u32x4 pw;
#pragma unroll
      for (int j = 0; j < 4; ++j) pw[j] = pack2(sc[kt][8 * s + 2 * j], sc[kt][8 * s + 2 * j + 1]);
      const bf16x8 pa = __builtin_bit_cast(bf16x8, pw);
#pragma unroll
      for (int dt = 0; dt < 2; ++dt) o[dt] = __builtin_amdgcn_mfma_f32_32x32x16_bf16(vb[kt][s][dt], pa, o[dt], 0, 0, 0);
    }
  }
  bf16_t* dst = p.attn() + (size_t)(t0 + ql) * AW + h * 64 + 4 * hf;
  float ssq = 0.f;
#pragma unroll
  for (int dt = 0; dt < 2; ++dt)
#pragma unroll
    for (int g4 = 0; g4 < 4; ++g4) {
      const float a0 = o[dt][4 * g4] * inv, a1 = o[dt][4 * g4 + 1] * inv, a2 = o[dt][4 * g4 + 2] * inv, a3 = o[dt][4 * g4 + 3] * inv;
      ssq += (a0 * a0 + a1 * a1) + (a2 * a2 + a3 * a3);
      *(u32x2*)(dst + 32 * dt + 8 * g4) = (u32x2){pack2(a0, a1), pack2(a2, a3)};
    }
  ssq = xhalf_sum(ssq);
  if (hf == 0) p.ssqa()[(size_t)(t0 + ql) * 8 + h] = ssq;
}
constexpr int SSEG = 4, SEGLEN = S / SSEG, SEGCH = SEGLEN / 32;

__device__ __forceinline__ void ssm_bu(const bf16x8& ua, const bf16x8 (&bB)[4], f32x16 (&bu)[4]) {
#pragma unroll
  for (int nt = 0; nt < 4; ++nt) {
#pragma unroll
    for (int r = 0; r < 16; ++r) bu[nt][r] = 0.f;
    bu[nt] = __builtin_amdgcn_mfma_f32_32x32x16_bf16(ua, bB[nt], bu[nt], 0, 0, 0);
  }
  asm volatile("s_nop 15\n\ts_nop 7" : "+v"(bu[0]), "+v"(bu[1]), "+v"(bu[2]), "+v"(bu[3]));
#pragma unroll
  for (int r = 0; r < 16; ++r) {
    auto s0 = __builtin_amdgcn_permlane32_swap(__float_as_uint(bu[0][r]), __float_as_uint(bu[1][r]), false, false);
    bu[0][r] = __uint_as_float(s0[0]); bu[1][r] = __uint_as_float(s0[1]);
    auto s1 = __builtin_amdgcn_permlane32_swap(__float_as_uint(bu[2][r]), __float_as_uint(bu[3][r]), false, false);
    bu[2][r] = __uint_as_float(s1[0]); bu[3][r] = __uint_as_float(s1[1]);
  }
}

__device__ __forceinline__ void ssm_block(const MP& p, int l, int b, int g, int tid, char* smem) {
  const int lane = tid & 63, seg = tid >> 6;
  char* wl = smem + seg * 8192;
  float* fin = (float*)(smem + 4 * 8192);
  const int lg = l * SG + g, hf = lane >> 5, fr = lane & 15, fq = lane >> 4;
  const float ar = p.ssmL()[(lg * SP + lane) * 2], ai = p.ssmL()[(lg * SP + lane) * 2 + 1];
  bf16x8 bB[4], cB[4];
#pragma unroll
  for (int nt = 0; nt < 4; ++nt) bB[nt] = *(const bf16x8*)(p.ssmB() + ((size_t)lg * 128 + nt * 32 + (lane & 31)) * 16 + 8 * hf);
#pragma unroll
  for (int ks = 0; ks < 4; ++ks) cB[ks] = *(const bf16x8*)(p.ssmC() + ((size_t)lg * 16 + fr) * 128 + 32 * ks + 8 * fq);
  const f32x4 dsk = *(const f32x4*)(p.in.ssm_d + l * SW + g * 16 + 4 * fq);
  const int t0 = b * S + seg * SEGLEN;
  const bf16_t* urow = p.u() + (size_t)(t0 + (lane & 31)) * SW + g * 16 + 8 * hf;
  float xr = 0.f, xi = 0.f;
  if (seg < SSEG - 1) {
    bf16x8 ua = *(const bf16x8*)(urow);
    for (int c = 0; c < SEGCH; ++c) {
      const bf16x8 un = *(const bf16x8*)(urow + (size_t)((c + 1 < SEGCH ? c + 1 : c) * 32) * SW);
      f32x16 bu[4];
      ssm_bu(ua, bB, bu);
#pragma unroll
      for (int r4 = 0; r4 < 4; ++r4)
#pragma unroll
        for (int half = 0; half < 2; ++half)
#pragma unroll
          for (int j = 0; j < 4; ++j) {
            const int r = 4 * r4 + j;
            const float bre = half ? bu[1][r] : bu[0][r], bim = half ? bu[3][r] : bu[2][r];
            const float nr = ar * xr - ai * xi + bre, ni = ar * xi + ai * xr + bim;
            xr = nr; xi = ni;
          }
      ua = un;
    }
  }
  fin[(seg * 64 + lane) * 2] = xr; fin[(seg * 64 + lane) * 2 + 1] = xi;
  __syncthreads();
  {
    float pr = ar, pi = ai;
#pragma unroll
    for (int i = 0; i < 9; ++i) { const float nr = pr * pr - pi * pi, ni = 2.f * pr * pi; pr = nr; pi = ni; }
    static_assert(SEGLEN == 512, "lam^SEGLEN squaring count");
    float cr = 0.f, ci = 0.f;
    for (int j = 0; j < seg; ++j) {
      const float fr_ = fin[(j * 64 + lane) * 2], fi_ = fin[(j * 64 + lane) * 2 + 1];
      const float nr = pr * cr - pi * ci + fr_, ni = pr * ci + pi * cr + fi_;
      cr = nr; ci = ni;
    }
    xr = cr; xi = ci;
  }
  const int wbase = (lane & 3) * 4;
  const int pch = lane >> 2;
  const bf16_t* uep = p.u() + (size_t)(t0 + fr) * SW + g * 16 + 4 * fq;
  bf16x8 ua = *(const bf16x8*)(urow);
  u32x2 uraw[2];
#pragma unroll
  for (int i = 0; i < 2; ++i) uraw[i] = *(const u32x2*)(uep + (size_t)(16 * i) * SW);
  for (int c = 0; c < SEGCH; ++c) {
    const int tb = t0 + c * 32;
    const int cn = (c + 1 < SEGCH ? c + 1 : c) * 32;
    const bf16x8 un = *(const bf16x8*)(urow + (size_t)cn * SW);
    u32x2 unraw[2];
#pragma unroll
    for (int i = 0; i < 2; ++i) unraw[i] = *(const u32x2*)(uep + (size_t)(cn + 16 * i) * SW);
    f32x16 bu[4];
    ssm_bu(ua, bB, bu);
#pragma unroll
    for (int r4 = 0; r4 < 4; ++r4) {
#pragma unroll
      for (int half = 0; half < 2; ++half) {
#pragma unroll
        for (int j = 0; j < 4; ++j) {
          const int t = 8 * r4 + 4 * half + j, r = 4 * r4 + j;
          const float bre = half ? bu[1][r] : bu[0][r], bim = half ? bu[3][r] : bu[2][r];
          const float nr = ar * xr - ai * xi + bre, ni = ar * xi + ai * xr + bim;
          xr = nr; xi = ni;
          *(unsigned*)(wl + t * 256 + ((pch ^ (t & 15)) << 4) + wbase) = pack2(nr, ni);
        }
      }
    }
    asm volatile("s_waitcnt lgkmcnt(0)" ::: "memory");
#pragma unroll
    for (int mt = 0; mt < 2; ++mt) {
      f32x4 acc = {0.f, 0.f, 0.f, 0.f};
      const int t = 16 * mt + fr;
#pragma unroll
      for (int ks = 0; ks < 4; ++ks) {
        const bf16x8 af = *(const bf16x8*)(wl + t * 256 + (((4 * ks + fq) ^ (t & 15)) << 4));
        acc = __builtin_amdgcn_mfma_f32_16x16x32_bf16(cB[ks], af, acc, 0, 0, 0);
      }
      const float uu[4] = {bf_lo(uraw[mt][0]), bf_hi(uraw[mt][0]), bf_lo(uraw[mt][1]), bf_hi(uraw[mt][1])};
      float ge[4];
#pragma unroll
      for (int j = 0; j < 4; ++j) {
        const float v = acc[j] + dsk[j] * uu[j];
        const float z2 = 1.5957691216057308f * (v + 0.044715f * v * v * v);
        ge[j] = v * __builtin_amdgcn_rcpf(1.f + __expf(-z2));
      }
      *(u32x2*)(p.y() + (size_t)(tb + t) * SW + g * 16 + 4 * fq) = (u32x2){pack2(ge[0], ge[1]), pack2(ge[2], ge[3])};
    }
    asm volatile("s_waitcnt lgkmcnt(0)" ::: "memory");
    ua = un;
#pragma unroll
    for (int i = 0; i < 2; ++i) uraw[i] = unraw[i];
  }
}

__device__ __forceinline__ void phase_attn(const MP& p, int l) {
  const int tid = launder(threadIdx.x);
  const int wave = tid >> 6, lane = tid & 63;
  if ((gridDim.x & 7) == 0) {
    const int xcd = blockIdx.x & 7, lb = blockIdx.x >> 3, nlb = gridDim.x >> 3;
    for (int lt = lb * 4 + wave; lt < 64 * 8; lt += nlb * 4) attn_task(p, l, (xcd << 9) | lt, lane);
  } else {
    for (int task = blockIdx.x * 4 + wave; task < NB * 64 * 8; task += gridDim.x * 4) attn_task(p, l, task, lane);
  }
}
__device__ __forceinline__ void phase_ssm(const MP& p, int l, char* smem, int wid, int lrank) {
  const int tid = launder(threadIdx.x);
  if (wid < 0) return;
  unsigned nwl = 0; bool all = (gridDim.x & 7) == 0;
#pragma unroll
  for (int x = 0; x < 8; ++x) {
    const unsigned c = __hip_atomic_load(p.claim() + 4104 + x, __ATOMIC_RELAXED, __HIP_MEMORY_SCOPE_AGENT);
    all = all && c > 0u; nwl = (x == (int)(blockIdx.x & 7)) ? c : nwl;
  }
  if (all) {
    const int b = blockIdx.x & 7;
    for (int g = lrank; g < SG; g += (int)nwl) { ssm_block(p, l, b, g, tid, smem); __syncthreads(); }
  } else {
    const int nw = (int)__hip_atomic_load(p.claim() + 4096, __ATOMIC_RELAXED, __HIP_MEMORY_SCOPE_AGENT);
    for (int task = wid; task < NB * SG; task += nw) { ssm_block(p, l, task / SG, task % SG, tid, smem); __syncthreads(); }
  }
}
__device__ __forceinline__ void phase_glu(const MP& p, int l, char* smem) {
  const int tid = launder(threadIdx.x), lane = tid & 63, wave = tid >> 6, wr = wave >> 1, wc = wave & 1, fr = lane & 15, fq = lane >> 4;
  const int r0 = tid >> 3;
  const int ntiles = (T / 128) * (SW / 128);
  const bf16_t* W = p.WgluT() + (size_t)l * SW * SW;
  auto make = [&](int tile, GemmTile& g) {
    const int m0 = (tile >> 2) * 128, n0 = (tile & 3) * 128;
    g.A0 = p.y(); g.A1 = p.y(); g.lda = SW; g.ksA = SW; g.K = SW;
#pragma unroll
    for (int i = 0; i < 4; ++i) g.arow[i] = m0 + r0 + 32 * i;
    g.Blo0 = W + (size_t)n0 * SW; g.Bhi0 = g.Blo0 + (size_t)64 * SW; g.Blo1 = g.Blo0; g.Bhi1 = g.Bhi0;
    g.ldb = SW; g.ksB = SW;
  };
  GemmTile g, gn; bool pre = false;
  const TileMap tmap = tm_init(T / 128, SW / 128);
  { const int t0 = tm_tile(tmap, 0); if (t0 >= 0) { make(t0, g); gn = g; } }
  for (int jt = 0; ; ++jt) {
    const int tile = tm_tile(tmap, jt); if (tile < 0) break;
    const int mt = tile >> 2, nt = tile & 3, m0 = mt * 128, n0 = nt * 128;
    const int nxt = tm_tile(tmap, jt + 1); const bool hasn = nxt >= 0;
    if (hasn) make(nxt, gn);
    f32x4 acc[4][4];
    gemm_mainloop<false>(g, gn, hasn, pre, smem, acc);
    pre = hasn; g = gn;
#pragma unroll
    for (int m = 0; m < 4; ++m) {
      const int t = m0 + wr * 64 + 16 * m + fr;
      float ss = 0.f;
#pragma unroll
      for (int n = 0; n < 4; ++n) {
        const int col = n0 + wc * 64 + 16 * n + 4 * fq;
        const u32x2 yr = *(const u32x2*)(p.y() + (size_t)t * SW + col);
        const float yv[4] = {bf_lo(yr[0]), bf_hi(yr[0]), bf_lo(yr[1]), bf_hi(yr[1])};
        float o[4];
#pragma unroll
        for (int j = 0; j < 4; ++j) { o[j] = yv[j] * __builtin_amdgcn_rcpf(1.f + __expf(-acc[m][n][j])); ss += o[j] * o[j]; }
        *(u32x2*)(p.ssm() + (size_t)t * SW + col) = (u32x2){pack2(o[0], o[1]), pack2(o[2], o[3])};
      }
      ss += __shfl_xor(ss, 16); ss += __shfl_xor(ss, 32);
      if (fq == 0) p.ssqs()[(size_t)t * 8 + nt * 2 + wc] = ss;
    }
  }
}

__device__ __forceinline__ void phase_out(const MP& p, int l, char* smem, const float* xin) {
  const int tid = launder(threadIdx.x), lane = tid & 63, wave = tid >> 6, wr = wave >> 1, wc = wave & 1, fr = lane & 15, fq = lane >> 4;
  const int r0 = tid >> 3;
  const float* modl = p.mod() + (size_t)l * 8 * 6144;
  const int ntiles = (T / 128) * (D / 128);
  const bf16_t* W = p.WoutT() + (size_t)l * D * D;
  auto make = [&](int tile, GemmTile& g) {
    const int m0 = (tile >> 3) * 128, n0 = (tile & 7) * 128;
    g.A0 = p.attn(); g.A1 = p.ssm(); g.lda = AW; g.ksA = AW; g.K = D;
#pragma unroll
    for (int i = 0; i < 4; ++i) g.arow[i] = m0 + r0 + 32 * i;
    g.Blo0 = W + (size_t)n0 * D; g.Bhi0 = g.Blo0 + (size_t)64 * D; g.Blo1 = g.Blo0; g.Bhi1 = g.Bhi0;
    g.ldb = D; g.ksB = D;
  };
  GemmTile g, gn; bool pre = false;
  const TileMap tmap = tm_init(T / 128, D / 128);
  { const int t0 = tm_tile(tmap, 0); if (t0 >= 0) { make(t0, g); gn = g; } }
  for (int jt = 0; ; ++jt) {
    const int tile = tm_tile(tmap, jt); if (tile < 0) break;
    const int mt = tile >> 3, nt = tile & 7, m0 = mt * 128, n0 = nt * 128, b = m0 / S;
    const int nxt = tm_tile(tmap, jt + 1); const bool hasn = nxt >= 0;
    if (hasn) make(nxt, gn);
    float mids[4], rs[4];
#pragma unroll
    for (int m = 0; m < 4; ++m) {
      const int t = m0 + wr * 64 + 16 * m + fr;
      const f32x4 a0 = *(const f32x4*)(p.ssqa() + (size_t)t * 8), a1 = *(const f32x4*)(p.ssqa() + (size_t)t * 8 + 4);
      const f32x4 s0 = *(const f32x4*)(p.ssqs() + (size_t)t * 8), s1 = *(const f32x4*)(p.ssqs() + (size_t)t * 8 + 4);
      const float sa = ((a0[0] + a0[1]) + (a0[2] + a0[3])) + ((a1[0] + a1[1]) + (a1[2] + a1[3]));
      const float sq = ((s0[0] + s0[1]) + (s0[2] + s0[3])) + ((s1[0] + s1[1]) + (s1[2] + s1[3]));
      const float ra = rsqrtf(sa * (1.f / 512.f) + EPS);
      rs[m] = rsqrtf(sq * (1.f / 512.f) + EPS);
      mids[m] = ra / rs[m];
    }
    f32x4 acc[4][4];
    gemm_mainloop_t<false, true>(g, gn, hasn, pre, smem, acc, 8, mids);
    pre = hasn; g = gn;
#pragma unroll
    for (int m = 0; m < 4; ++m) {
      const int t = m0 + wr * 64 + 16 * m + fr;
#pragma unroll
      for (int n = 0; n < 4; ++n) {
        const int col = n0 + wc * 64 + 16 * n + 4 * fq;
        const f32x4 xv = *(const f32x4*)(xin + (size_t)t * D + col);
        const f32x4 g1 = *(const f32x4*)(modl + (size_t)b * 6144 + 2 * 1024 + col);
        f32x4 o;
#pragma unroll
        for (int j = 0; j < 4; ++j) o[j] = xv[j] + g1[j] * (acc[m][n][j] * rs[m]);
        *(u32x2*)(p.x1() + (size_t)t * D + col) = (u32x2){pack2(o[0], o[1]), pack2(o[2], o[3])};
      }
    }
  }
}
__device__ __forceinline__ void phase_norm2_route(const MP& p, int l, char* smem) {
  const int tid = launder(threadIdx.x);
  const int wave = tid >> 6, lane = tid & 63;
  float* wrT = (float*)smem;
  for (int i = tid; i < 1024 * 4; i += NTHR) {
    const int k = i >> 2, e4 = (i & 3) * 4;
    const float4 v = *(const float4*)(p.in.w_router + (size_t)k * 16 + e4);
    wrT[(e4 + 0) * 1024 + k] = v.x; wrT[(e4 + 1) * 1024 + k] = v.y; wrT[(e4 + 2) * 1024 + k] = v.z; wrT[(e4 + 3) * 1024 + k] = v.w;
  }
  __syncthreads();
  const float* modl = p.mod() + (size_t)l * 8 * 6144;
  float rb[16];
#pragma unroll
  for (int e = 0; e < 16; ++e) rb[e] = p.in.router_bias[e];
  int* cntl = p.cnt() + l * 256;
  int my_t = -1, my_bucket = 0; float my_wlo = 0.f, my_whi = 0.f;
  const float* g2n = p.in.norm2_g + l * D;
  const TokRange trg = tok_range(wave);
  const int tstep = trg.step, tend = trg.end;
  int t = trg.t0;
  float4 xv[4];
  if (t < tend) {
#pragma unroll
    for (int i = 0; i < 4; ++i) { const u32x2 r = *(const u32x2*)(p.x1() + (size_t)t * D + lane * 4 + 256 * i); xv[i] = make_float4(bf_lo(r[0]), bf_hi(r[0]), bf_lo(r[1]), bf_hi(r[1])); }
  }
  for (int slot = 0; t < tend; t += tstep, ++slot) {
    const int b = t / S;
    float4 xn[4];
    const int tn = t + tstep < tend ? t + tstep : t;
#pragma unroll
    for (int i = 0; i < 4; ++i) { const u32x2 r = *(const u32x2*)(p.x1() + (size_t)tn * D + lane * 4 + 256 * i); xn[i] = make_float4(bf_lo(r[0]), bf_hi(r[0]), bf_lo(r[1]), bf_hi(r[1])); }
    float ss = 0.f;
#pragma unroll
    for (int i = 0; i < 4; ++i) ss += xv[i].x * xv[i].x + xv[i].y * xv[i].y + xv[i].z * xv[i].z + xv[i].w * xv[i].w;
    ss = wave_sum(ss);
    const float rinv = rsqrtf(ss * (1.f / D) + EPS);
    const float* sh = modl + (size_t)b * 6144 + 3 * 1024; const float* sc = modl + (size_t)b * 6144 + 4 * 1024;
    float hv[16];
#pragma unroll
    for (int i = 0; i < 4; ++i) {
      const int d = lane * 4 + 256 * i;
      const float4 gg = *(const float4*)(g2n + d), s1 = *(const float4*)(sc + d), s0 = *(const float4*)(sh + d);
      hv[4 * i + 0] = xv[i].x * rinv * gg.x * (1.f + s1.x) + s0.x;
      hv[4 * i + 1] = xv[i].y * rinv * gg.y * (1.f + s1.y) + s0.y;
      hv[4 * i + 2] = xv[i].z * rinv * gg.z * (1.f + s1.z) + s0.z;
      hv[4 * i + 3] = xv[i].w * rinv * gg.w * (1.f + s1.w) + s0.w;
      *(u32x2*)(p.h() + (size_t)t * D + d) = (u32x2){pack2(hv[4 * i], hv[4 * i + 1]), pack2(hv[4 * i + 2], hv[4 * i + 3])};
    }
    float a[16];
    const int loff = launder(lane * 4);
#pragma unroll
    for (int e = 0; e < 16; ++e) {
      float s = 0.f;
#pragma unroll
      for (int i = 0; i < 4; ++i) {
        const f32x4 w = *(const f32x4*)(wrT + e * 1024 + loff + 256 * i);
        s += hv[4 * i] * w[0] + hv[4 * i + 1] * w[1] + hv[4 * i + 2] * w[2] + hv[4 * i + 3] * w[3];
      }
      a[e] = s;
    }
    float lg[16];
#pragma unroll
    for (int e = 0; e < 16; ++e) lg[e] = wave_sum(a[e]);
    float mx = lg[0];
#pragma unroll
    for (int e = 1; e < 16; ++e) mx = fmaxf(mx, lg[e]);
    float pr[16], sel[16]; float sum = 0.f;
#pragma unroll
    for (int e = 0; e < 16; ++e) { pr[e] = __expf(lg[e] - mx); sum += pr[e]; }
    const float inv = 1.f / sum;
#pragma unroll
    for (int e = 0; e < 16; ++e) { pr[e] *= inv; sel[e] = pr[e] + rb[e]; }
    int gbest = 0; float gbs = -1e30f;
#pragma unroll
    for (int g = 0; g < 4; ++g) {
      float m1 = -1e30f, m2 = -1e30f;
#pragma unroll
      for (int j = 0; j < 4; ++j) { const float v = sel[g * 4 + j]; if (v > m1) { m2 = m1; m1 = v; } else if (v > m2) m2 = v; }
      const float gs = m1 + m2;
      if (gs > gbs) { gbs = gs; gbest = g; }
    }
    float s4[4], p4[4];
#pragma unroll
    for (int j = 0; j < 4; ++j) { s4[j] = sel[j]; p4[j] = pr[j]; }
#pragma unroll
    for (int g = 1; g < 4; ++g) if (g == gbest) {
#pragma unroll
      for (int j = 0; j < 4; ++j) { s4[j] = sel[g * 4 + j]; p4[j] = pr[g * 4 + j]; }
    }
    int i0 = 0; float b0 = s4[0];
#pragma unroll
    for (int j = 1; j < 4; ++j) if (s4[j] > b0) { b0 = s4[j]; i0 = j; }
    int i1 = -1; float bb1 = -1e30f;
#pragma unroll
    for (int j = 0; j < 4; ++j) if (j != i0 && s4[j] > bb1) { bb1 = s4[j]; i1 = j; }
    float p0 = 0.f, p1 = 0.f;
#pragma unroll
    for (int j = 0; j < 4; ++j) { if (j == i0) p0 = p4[j]; if (j == i1) p1 = p4[j]; }
    const float w0 = p0 / (p0 + p1), w1 = p1 / (p0 + p1);
    const int lo = i0 < i1 ? i0 : i1, hi = i0 < i1 ? i1 : i0;
    const float wlo = i0 < i1 ? w0 : w1, whi = i0 < i1 ? w1 : w0;
    const int pidx = (lo == 0) ? (hi - 1) : (lo == 1 ? (hi + 1) : 5);
    const int bucket = gbest * 6 + pidx;
    if (lane == slot) { my_t = t; my_bucket = bucket; my_wlo = wlo; my_whi = whi; }
#pragma unroll
    for (int i = 0; i < 4; ++i) xv[i] = xn[i];
  }
  if (my_t >= 0) {
    const int sl = my_bucket * NSUBL + (blockIdx.x & (NSUBL - 1));
    const int pos = atomicAdd(&cntl[sl], 1);
    p.list()[(size_t)sl * T + pos] = my_t;
    p.tokw()[my_t] = make_float2(my_wlo, my_whi);
  }
  __syncthreads();
}

__device__ __forceinline__ void bucket_experts2(int bucket, int& elo, int& ehi) {
  const int g = bucket / 6, pi = bucket % 6;
  const int lo = pi < 3 ? 0 : (pi < 5 ? 1 : 2);
  const int hi = pi < 3 ? pi + 1 : (pi < 5 ? pi - 1 : 3);
  elo = g * 4 + lo; ehi = g * 4 + hi;
}
__device__ __forceinline__ void moe_map_build(const int* cnt, int* mm, int tid) {
  if (tid < NBUCKET) {
    int acc = 0;
#pragma unroll
    for (int x = 0; x < NSUBL; ++x) { mm[32 + 16 * tid + x] = acc; acc += cnt[tid * NSUBL + x]; }
    mm[32 + 16 * tid + 8] = acc;
  }
  __syncthreads();
  if (tid == 0) {
    int acc = 0;
    for (int bk = 0; bk < NBUCKET; ++bk) { mm[bk] = acc; acc += (mm[32 + 16 * bk + 8] + TM - 1) / TM; }
    mm[NBUCKET] = acc;
  }
  __syncthreads();
}
__device__ __forceinline__ void moe_find_tile(const int* mm, int mt, int& bucket, int& tib, int& nrow) {
  int bk = 0;
#pragma unroll
  for (int j = 1; j < NBUCKET; ++j) bk += (mt >= mm[j]) ? 1 : 0;
  bucket = bk; tib = mt - mm[bk]; nrow = mm[32 + 16 * bk + 8] - tib * TM;
}
__device__ __forceinline__ int moe_token(const int* list, const int* mm, int bk, int q) {
  const int* sp = mm + 32 + 16 * bk;
  int x = 0, s = 0;
#pragma unroll
  for (int j = 1; j < NSUBL; ++j) { const int v = sp[j]; const bool ge = q >= v; x += ge ? 1 : 0; s = ge ? v : s; }
  return list[(size_t)(bk * NSUBL + x) * T + (q - s)];
}

__device__ __forceinline__ void phase_moe_gu(const MP& p, int l, char* smem) {
  const int tid = launder(threadIdx.x), lane = tid & 63, wave = tid >> 6, wr = wave >> 1, wc = wave & 1, fr = lane & 15, fq = lane >> 4;
  const int r0 = tid >> 3;
  int* mm = (int*)(smem + SMEM_MM);
  moe_map_build(p.cnt() + l * 256, mm, tid);
  const int nmt = mm[NBUCKET];
  const int ntiles = nmt * 16;
  auto make = [&](int tile, GemmTile& g) {
    const int mt = tile >> 4, nt = tile & 15;
    int bucket, tib, nrow;
    moe_find_tile(mm, mt, bucket, tib, nrow);
    int elo, ehi; bucket_experts2(bucket, elo, ehi);
    const int e = nt < 8 ? elo : ehi, f0 = (nt & 7) * 64;
    g.A0 = p.h(); g.A1 = p.h(); g.lda = D; g.ksA = D; g.K = D;
    const bf16_t* Wg = p.WgT() + ((size_t)(l * NE + e) * DFF + f0) * D;
    const bf16_t* Wu = p.WuT() + ((size_t)(l * NE + e) * DFF + f0) * D;
#pragma unroll
    for (int i = 0; i < 4; ++i) {
      const int r = r0 + 32 * i;
      g.arow[i] = moe_token(p.list(), mm, bucket, tib * TM + (r < nrow ? r : nrow - 1));
    }
    g.Blo0 = Wg; g.Bhi0 = Wu; g.Blo1 = Wg; g.Bhi1 = Wu;
    g.ldb = D; g.ksB = D;
  };
  GemmTile g, gn; bool pre = false;
  const TileMap tmap = tm_init(nmt, 16);
  { const int t0 = tm_tile(tmap, 0); if (t0 >= 0) { make(t0, g); gn = g; } }
  for (int jt = 0; ; ++jt) {
    const int tile = tm_tile(tmap, jt); if (tile < 0) break;
    const int mt = tile >> 4, nt = tile & 15;
    int bucket, tib, nrow;
    moe_find_tile(mm, mt, bucket, tib, nrow);
    const int f0 = (nt & 7) * 64;
    const int nxt = tm_tile(tmap, jt + 1); const bool hasn = nxt >= 0;
    if (hasn) make(nxt, gn);
    float wv[4];
#pragma unroll
    for (int m = 0; m < 4; ++m) {
      const int r = wr * 64 + 16 * m + fr;
      const float2 ww = p.tokw()[moe_token(p.list(), mm, bucket, tib * TM + (r < nrow ? r : nrow - 1))];
      wv[m] = r < nrow ? (nt < 8 ? ww.x : ww.y) : 0.f;
    }
    f32x4 acc[4][4];
    gemm_mainloop<true>(g, gn, hasn, pre, smem, acc);
    pre = hasn; g = gn;
#pragma unroll
    for (int m = 0; m < 4; ++m) {
      const int r = wr * 64 + 16 * m + fr;
      const float w = wv[m];
      bf16_t* dst = p.act() + (size_t)(mt * TM + r) * D + (nt < 8 ? 0 : 512) + f0 + wc * 32 + 4 * fq;
#pragma unroll
      for (int n = 0; n < 2; ++n) {
        float o[4];
#pragma unroll
        for (int j = 0; j < 4; ++j) { const float gv = acc[m][n][j], uv = acc[m][n + 2][j]; o[j] = gv * __builtin_amdgcn_rcpf(1.f + __expf(-gv)) * uv * w; }
        *(u32x2*)(dst + 16 * n) = (u32x2){pack2(o[0], o[1]), pack2(o[2], o[3])};
      }
    }
  }
}

__device__ __forceinline__ void phase_moe_down(const MP& p, int l, char* smem) {
  const int tid = launder(threadIdx.x), lane = tid & 63, wave = tid >> 6, wr = wave >> 1, wc = wave & 1, fr = lane & 15, fq = lane >> 4;
  const int r0 = tid >> 3;
  int* mm = (int*)(smem + SMEM_MM);
  moe_map_build(p.cnt() + l * 256, mm, tid);
  const float* modl = p.mod() + (size_t)l * 8 * 6144;
  const int nmt = mm[NBUCKET];
  const int ntiles = nmt * 8;
  auto make = [&](int tile, GemmTile& g) {
    const int mt = tile >> 3, n0 = (tile & 7) * 128;
    int bucket, tib, nrow;
    moe_find_tile(mm, mt, bucket, tib, nrow);
    int elo, ehi; bucket_experts2(bucket, elo, ehi);
    g.A0 = p.act(); g.A1 = p.act(); g.lda = D; g.ksA = D; g.K = D;
    const bf16_t* Wlo = p.WdT() + ((size_t)(l * NE + elo) * D + n0) * DFF;
    const bf16_t* Whi = p.WdT() + ((size_t)(l * NE + ehi) * D + n0) * DFF;
#pragma unroll
    for (int i = 0; i < 4; ++i) {
      g.arow[i] = mt * TM + r0 + 32 * i;
    }
    g.Blo0 = Wlo; g.Bhi0 = Wlo + (size_t)64 * DFF; g.Blo1 = Whi; g.Bhi1 = Whi + (size_t)64 * DFF;
    g.ldb = DFF; g.ksB = DFF;
  };
  GemmTile g, gn; bool pre = false;
  const TileMap tmap = tm_init(nmt, 8);
  { const int t0 = tm_tile(tmap, 0); if (t0 >= 0) { make(t0, g); gn = g; } }
  for (int jt = 0; ; ++jt) {
    const int tile = tm_tile(tmap, jt); if (tile < 0) break;
    const int mt = tile >> 3, nt = tile & 7, n0 = nt * 128;
    int bucket, tib, nrow;
    moe_find_tile(mm, mt, bucket, tib, nrow);
    const int nxt = tm_tile(tmap, jt + 1); const bool hasn = nxt >= 0;
    if (hasn) make(nxt, gn);
    int tkv[4];
#pragma unroll
    for (int m = 0; m < 4; ++m) {
      const int r = wr * 64 + 16 * m + fr;
      tkv[m] = moe_token(p.list(), mm, bucket, tib * TM + (r < nrow ? r : nrow - 1));
    }
    f32x4 acc[4][4];
    gemm_mainloop<false>(g, gn, hasn, pre, smem, acc);
    pre = hasn; g = gn;
#pragma unroll
    for (int m = 0; m < 4; ++m) {
      const int r = wr * 64 + 16 * m + fr;
      const int tk = tkv[m], b = tk / S;
      f32x4 o[4];
#pragma unroll
      for (int n = 0; n < 4; ++n) {
        const int col = n0 + wc * 64 + 16 * n + 4 * fq;
        const u32x2 xr = *(const u32x2*)(p.x1() + (size_t)tk * D + col);
        const f32x4 xv = {bf_lo(xr[0]), bf_hi(xr[0]), bf_lo(xr[1]), bf_hi(xr[1])};
        const f32x4 g2 = *(const f32x4*)(modl + (size_t)b * 6144 + 5 * 1024 + col);
#pragma unroll
        for (int j = 0; j < 4; ++j) o[n][j] = xv[j] + g2[j] * acc[m][n][j];
      }
      if (r < nrow) {
#pragma unroll
        for (int n = 0; n < 4; ++n) *(f32x4*)(p.out + (size_t)tk * D + n0 + wc * 64 + 16 * n + 4 * fq) = o[n];
      }
    }
  }
}
#define XB_TMO      128
#define XB_XCNT(j)  (256  + 64 * (j))
#define XB_XSUB(j)  (1280 + 64 * (j))
#define XB_XGEN(j)  (2304 + 64 * (j))
#define XB_TOP      3328
#define XB_TOPGEN   3392
#define XCD_BAR_WORDS 3456
#define XB_SPIN_CAP (1u << 22)
#define LAS __attribute__((address_space(3)))

__device__ __forceinline__ unsigned xb_ld(unsigned* p)              { return __hip_atomic_load(p, __ATOMIC_RELAXED, __HIP_MEMORY_SCOPE_AGENT); }
__device__ __forceinline__ unsigned xb_add(unsigned* p, unsigned v) { return __hip_atomic_fetch_add(p, v, __ATOMIC_RELAXED, __HIP_MEMORY_SCOPE_AGENT); }
__device__ __forceinline__ unsigned xb_xcc_id() { return (unsigned)__builtin_amdgcn_s_getreg((3 << 11) | 20) & 0xFu; }
#define XB_SPIN(cond, bar) do { unsigned _sp = 0; while (cond) { __builtin_amdgcn_s_sleep(1); \
    if ((++_sp & 255u) == 0u) { if (xb_ld(&(bar)[XB_TMO])) break; if (_sp > XB_SPIN_CAP) { atomicAdd(&(bar)[XB_TMO], 1u); break; } } } } while (0)

struct XcdBarrier { unsigned* bar; unsigned x; volatile LAS unsigned* st; };

__device__ __forceinline__ XcdBarrier xcd_barrier_post(unsigned* bar, volatile LAS unsigned* st) {
  XcdBarrier b; b.bar = bar; b.x = xb_xcc_id(); b.st = st;
  if (threadIdx.x == 0) (void)xb_add(&bar[XB_XCNT(b.x)], 1u);
  return b;
}
__device__ __forceinline__ void xcd_barrier_complete(unsigned* bar, unsigned x, unsigned& nloc, unsigned& nx) {
  const unsigned G = gridDim.x * gridDim.y * gridDim.z;
  unsigned sum, cnt, mine, sp = 0u;
  for (;;) {
    sum = 0u; cnt = 0u; mine = 0u;
#pragma unroll
    for (unsigned j = 0; j < 16; ++j) { const unsigned c = xb_ld(&bar[XB_XCNT(j)]); sum += c; cnt += (c > 0u) ? 1u : 0u; mine = (j == x) ? c : mine; }
    if (sum == G) break;
    __builtin_amdgcn_s_sleep(1);
    if ((++sp & 255u) == 0u) { if (xb_ld(&bar[XB_TMO])) break; if (sp > XB_SPIN_CAP) { atomicAdd(&bar[XB_TMO], 1u); break; } }
  }
  nloc = mine > 0u ? mine : 1u; nx = cnt > 0u ? cnt : 1u;
}
__device__ __forceinline__ void xcd_barrier(const XcdBarrier& b) {
  asm volatile("s_waitcnt vmcnt(0)" ::: "memory");
  __syncthreads();
  if (threadIdx.x == 0) {
    unsigned* bar = b.bar;
    __builtin_amdgcn_s_waitcnt(0);
    unsigned nloc = b.st[0], nx = b.st[1];
    if (nloc == 0u) { xcd_barrier_complete(bar, b.x, nloc, nx); b.st[0] = nloc; b.st[1] = nx; }
    const unsigned old = xb_add(&bar[XB_XSUB(b.x)], 1u);
    const unsigned gen = old / nloc;
    if (old + 1u == (gen + 1u) * nloc) {
      __builtin_amdgcn_fence(__ATOMIC_RELEASE, "agent");
      asm volatile("s_waitcnt vmcnt(0)" ::: "memory");
      const unsigned og = xb_add(&bar[XB_TOP], 1u);
      const unsigned tg = og / nx;
      if (og + 1u == (tg + 1u) * nx) xb_add(&bar[XB_TOPGEN], 1u);
      else XB_SPIN(xb_ld(&bar[XB_TOPGEN]) == tg, bar);
      __builtin_amdgcn_fence(__ATOMIC_ACQUIRE, "agent");
      xb_add(&bar[XB_XGEN(b.x)], 1u);
      asm volatile("s_waitcnt vmcnt(0)" ::: "memory");
    } else {
      XB_SPIN(xb_ld(&bar[XB_XGEN(b.x)]) == gen, bar);
      __builtin_amdgcn_fence(__ATOMIC_ACQUIRE, "agent");
      asm volatile("s_waitcnt vmcnt(0)" ::: "memory");
    }
  }
  __syncthreads();
}

constexpr int NSUB = 9;

template <int L>
__device__ __forceinline__ void run_layer(const MP& p, char* smem, const XcdBarrier& xb, int ssm_wid, int idle_id, int ssm_lrank) {
  constexpr int l = L;
  const float* xin = L == 0 ? p.in.x : p.out;
  phase_norm1(p, l, xin);          xcd_barrier(xb);
  phase_inproj(p, l, smem);        xcd_barrier(xb);
  phase_attn(p, l);                xcd_barrier(xb);
  phase_ssm(p, l, smem, ssm_wid, ssm_lrank);
  {
    constexpr int TT_SMALL = TT_WIN + TT_GLU + TT_OUT;
    const int nidle = (int)__hip_atomic_load(p.claim() + 4097, __ATOMIC_RELAXED, __HIP_MEMORY_SCOPE_AGENT);
    if (nidle == 0) phase0_transposes(p, smem, L * TT_LAYER + TT_SMALL, (L + 1) * TT_LAYER, blockIdx.x, gridDim.x);
    else if (idle_id >= 0) phase0_transposes(p, smem, L * TT_LAYER + TT_SMALL, (L + 1) * TT_LAYER, launder_s(__builtin_amdgcn_readfirstlane(idle_id)), nidle);
  }
  xcd_barrier(xb);
  phase_glu(p, l, smem);           xcd_barrier(xb);
  phase_out(p, l, smem, xin);      xcd_barrier(xb);
  phase_norm2_route(p, l, smem);   xcd_barrier(xb);
  phase_moe_gu(p, l, smem);        xcd_barrier(xb);
  phase_moe_down(p, l, smem);
  if (L + 1 < DEPTH) xcd_barrier(xb);
}

__global__ void __launch_bounds__(NTHR, 2) mega(MP p) {
  __shared__ __attribute__((aligned(16))) char smem[65536 + 32 + 2048];
  unsigned* xb_words = (unsigned*)(smem + 65536);
  if (threadIdx.x < 8) xb_words[threadIdx.x] = 0u;
  __syncthreads();
  const XcdBarrier xb = xcd_barrier_post(p.bar(), (volatile LAS unsigned*)xb_words);
  if (threadIdx.x == 0) {
    const unsigned key = (xb_xcc_id() << 8) | ((unsigned)__builtin_amdgcn_s_getreg((7 << 11) | (8 << 6) | 4) & 0xffu);
    const unsigned rank = xb_add(p.claim() + key, 1u);
    xb_words[2] = rank == 0u ? xb_add(p.claim() + 4096, 1u) : 0xffffffffu;
    xb_words[3] = rank == 0u ? 0xffffffffu : xb_add(p.claim() + 4097, 1u);
    xb_words[4] = rank == 0u ? xb_add(p.claim() + 4104 + (blockIdx.x & 7), 1u) : 0xffffffffu;
  }
  __syncthreads();
  const int ssm_wid = (int)xb_words[2], idle_id = (int)xb_words[3], ssm_lrank = (int)xb_words[4];
  for (int it = blockIdx.x; it < P0_MISC; it += gridDim.x) phase0_item(p, it, smem);
  phase0_transposes(p, smem, 0, TT_WIN + TT_GLU + TT_OUT, blockIdx.x, gridDim.x);
  phase0_transposes(p, smem, TT_LAYER, TT_LAYER + TT_WIN + TT_GLU + TT_OUT, blockIdx.x, gridDim.x);
  xcd_barrier(xb);
  run_layer<0>(p, smem, xb, ssm_wid, idle_id, ssm_lrank);
  run_layer<1>(p, smem, xb, ssm_wid, idle_id, ssm_lrank);
  static_assert(DEPTH == 2, "two layers instantiated");
}

}

extern "C" void kernel_launch(void* const* d_in, const int* in_sizes, int n_in, void* d_out, int out_size, void* d_ws,
                              size_t ws_size, hipStream_t stream) {
  MP p; memset(&p, 0, sizeof(p));
  Ptrs& P = p.in;
  P.x = (const float*)d_in[0]; P.c = (const float*)d_in[1]; P.pos = (const int*)d_in[2];
  P.ada_w = (const float*)d_in[3]; P.ada_b = (const float*)d_in[4]; P.norm1_g = (const float*)d_in[5];
  P.w_in = (const float*)d_in[6]; P.q_norm_g = (const float*)d_in[7]; P.k_norm_g = (const float*)d_in[8];
  P.attn_sink = (const float*)d_in[9]; P.lam_re = (const float*)d_in[10]; P.lam_im = (const float*)d_in[11];
  P.b_re = (const float*)d_in[12]; P.b_im = (const float*)d_in[13]; P.c_re = (const float*)d_in[14]; P.c_im = (const float*)d_in[15];
  P.ssm_d = (const float*)d_in[16]; P.log_dt = (const float*)d_in[17]; P.w_glu = (const float*)d_in[18];
  P.attn_out_g = (const float*)d_in[19]; P.ssm_out_g = (const float*)d_in[20]; P.w_out = (const float*)d_in[21];
  P.norm2_g = (const float*)d_in[22]; P.w_router = (const float*)d_in[23]; P.router_bias = (const float*)d_in[24];
  P.w_gate = (const float*)d_in[25]; P.w_up = (const float*)d_in[26]; P.w_down = (const float*)d_in[27];
  p.out = (float*)d_out;

  p.ws = (char*)d_ws;
  if (WS_TOTAL > ws_size) { fprintf(stderr, "workspace too small: need %zu have %zu\n", (size_t)WS_TOTAL, ws_size); return; }
  (void)in_sizes; (void)n_in; (void)out_size;

  static int grid_blocks = 0;
  if (!grid_blocks) {
    int dev = 0, cus = 0, per_cu = 0;
    (void)hipGetDevice(&dev);
    (void)hipDeviceGetAttribute(&cus, hipDeviceAttributeMultiprocessorCount, dev);
    (void)hipOccupancyMaxActiveBlocksPerMultiprocessor(&per_cu, mega, NTHR, 0);
    if (per_cu > 2) per_cu = 2;
    if (per_cu < 1) per_cu = 1;
    grid_blocks = cus * per_cu;
  }
  (void)hipMemsetAsync(p.ws + OFF_BAR, 0, OFF_MOD - OFF_BAR, stream);
  void* args[] = {&p};
  hipError_t e = hipLaunchCooperativeKernel((void*)mega, dim3(grid_blocks), dim3(NTHR), args, 0, stream);
  if (e != hipSuccess) fprintf(stderr, "cooperative launch failed: %s (grid %d)\n", hipGetErrorString(e), grid_blocks);
}
```

```cpp
#include <hip/hip_runtime.h>
#include <hip/hip_cooperative_groups.h>
#include <stdint.h>
#include <cstdio>
#include <cstring>

namespace {
constexpr int D = 1024, NB = 8, S = 2048, T = NB * S, DEPTH = 2;
constexpr int AW = 512, HD = 64, NQ = 8, NKV = 2, INW = 1280;
constexpr int SG = 32, SCH = 16, SP = 64, SW = 512;
constexpr int NE = 16, DFF = 512;
constexpr int NBUCKET = 24;
constexpr float EPS = 1e-6f;

struct Ptrs {
  const float *x, *c; const int* pos; const float *ada_w, *ada_b, *norm1_g, *w_in, *q_norm_g, *k_norm_g, *attn_sink,
      *lam_re, *lam_im, *b_re, *b_im, *c_re, *c_im, *ssm_d, *log_dt, *w_glu, *attn_out_g, *ssm_out_g, *w_out, *norm2_g,
      *w_router, *router_bias, *w_gate, *w_up, *w_down;
};

__device__ __forceinline__ float row_sum32_dpp(float v) {
  v += __int_as_float(__builtin_amdgcn_update_dpp(0, __float_as_int(v), 0xB1, 0xF, 0xF, true));
  v += __int_as_float(__builtin_amdgcn_update_dpp(0, __float_as_int(v), 0x4E, 0xF, 0xF, true));
  v += __int_as_float(__builtin_amdgcn_update_dpp(0, __float_as_int(v), 0x141, 0xF, 0xF, true));
  v += __int_as_float(__builtin_amdgcn_update_dpp(0, __float_as_int(v), 0x140, 0xF, 0xF, true));
  v += __int_as_float(__builtin_amdgcn_update_dpp(0, __float_as_int(v), 0x142, 0xA, 0xF, false));
  return v;
}
__device__ __forceinline__ float wave_sum(float v) {
  v = row_sum32_dpp(v);
  return __int_as_float(__builtin_amdgcn_readlane(__float_as_int(v), 31)) + __int_as_float(__builtin_amdgcn_readlane(__float_as_int(v), 63));
}
__device__ __forceinline__ float xhalf_sum(float v) {
  const auto r = __builtin_amdgcn_permlane32_swap(__float_as_uint(v), __float_as_uint(v), false, false);
  return __uint_as_float(r[0]) + __uint_as_float(r[1]);
}
__device__ __forceinline__ float xhalf_max(float v) {
  const auto r = __builtin_amdgcn_permlane32_swap(__float_as_uint(v), __float_as_uint(v), false, false);
  return fmaxf(__uint_as_float(r[0]), __uint_as_float(r[1]));
}

#ifndef ROT_OF
#define ROT_OF(mt, nt) ((mt) & 15)
#endif

typedef unsigned short bf16_t;
typedef short bf16x8 __attribute__((ext_vector_type(8)));
typedef float f32x4 __attribute__((ext_vector_type(4)));
typedef float f32x16 __attribute__((ext_vector_type(16)));
typedef float f32x2 __attribute__((ext_vector_type(2)));
typedef __bf16 bf16x2_t __attribute__((ext_vector_type(2)));
typedef unsigned u32x4 __attribute__((ext_vector_type(4)));
typedef unsigned u32x2 __attribute__((ext_vector_type(2)));

constexpr int NTHR = 256;
constexpr int TM = 128;
constexpr int MAXMT = T / TM + NBUCKET;
constexpr int NSUBL = 8;
constexpr int SMEM_MM = 65536 + 32;

__device__ __forceinline__ unsigned pack2(float lo, float hi) {
  f32x2 v = {lo, hi};
  return __builtin_bit_cast(unsigned, __builtin_convertvector(v, bf16x2_t));
}
__device__ __forceinline__ int launder(int x) { asm volatile("" : "+v"(x)); return x; }
__device__ __forceinline__ int launder_s(int x) { asm volatile("" : "+s"(x)); return x; }
__device__ __forceinline__ float bf_lo(unsigned u) { return __uint_as_float(u << 16); }
__device__ __forceinline__ float bf_hi(unsigned u) { return __uint_as_float(u & 0xffff0000u); }
__device__ __forceinline__ float bf1(bf16_t u) { return __uint_as_float(((unsigned)u) << 16); }

constexpr size_t al256(size_t x) { return (x + 255) & ~(size_t)255; }
constexpr size_t OFF_BAR = 0;
constexpr size_t OFF_CLAIM = OFF_BAR + al256(4096 * 4);
constexpr size_t OFF_MOD = OFF_CLAIM + al256(4096 * 4 + 256);
constexpr size_t OFF_CS = OFF_MOD + al256((size_t)DEPTH * 8 * 6144 * 4);
constexpr size_t OFF_CNT = OFF_CS + al256((size_t)T * 32 * 8);
constexpr size_t OFF_LIST = OFF_CNT + al256(256 * 4 * DEPTH);
constexpr size_t OFF_TOKW = OFF_LIST + al256((size_t)NBUCKET * NSUBL * T * 4);
constexpr size_t OFF_SSMB = OFF_TOKW + al256((size_t)T * 8);
constexpr size_t OFF_SSMC = OFF_SSMB + al256((size_t)DEPTH * SG * 128 * 16 * 2);
constexpr size_t OFF_SSML = OFF_SSMC + al256((size_t)DEPTH * SG * 16 * 128 * 2);
constexpr size_t OFF_WINT = OFF_SSML + al256((size_t)DEPTH * SG * SP * 2 * 4);
constexpr size_t OFF_WGLUT = OFF_WINT + al256((size_t)DEPTH * INW * D * 2);
constexpr size_t OFF_WOUTT = OFF_WGLUT + al256((size_t)DEPTH * SW * SW * 2);
constexpr size_t OFF_H = OFF_WOUTT + al256((size_t)DEPTH * D * D * 2);
constexpr size_t OFF_Q = OFF_H + al256((size_t)T * D * 2);
constexpr size_t OFF_K = OFF_Q + al256((size_t)T * AW * 2);
constexpr size_t OFF_VT = OFF_K + al256((size_t)T * 128 * 2);
constexpr size_t OFF_U = OFF_VT + al256((size_t)T * 128 * 2);
constexpr size_t OFF_ATTN = OFF_U + al256((size_t)T * SW * 2);
constexpr size_t OFF_ACT = OFF_Q;
static_assert((size_t)MAXMT * TM * D * 2 <= OFF_ATTN - OFF_Q, "act overlay too small");
constexpr size_t OFF_SSQA = OFF_ATTN + al256((size_t)T * AW * 2);
constexpr size_t OFF_Y = OFF_SSQA + al256((size_t)T * 8 * 4);
constexpr size_t OFF_SSM = OFF_Y + al256((size_t)T * SW * 2);
constexpr size_t OFF_SSQS = OFF_SSM + al256((size_t)T * SW * 2);
constexpr size_t OFF_X1 = OFF_SSQS + al256((size_t)T * 8 * 4);
constexpr size_t OFF_WGT = OFF_X1 + al256((size_t)T * D * 4);
constexpr size_t OFF_WUT = OFF_WGT + al256((size_t)DEPTH * NE * DFF * D * 2);
constexpr size_t OFF_WDT = OFF_WUT + al256((size_t)DEPTH * NE * DFF * D * 2);
constexpr size_t WS_TOTAL = OFF_WDT + al256((size_t)DEPTH * NE * DFF * D * 2);

struct MP {
  Ptrs in;
  float* out;
  char* ws;
  __device__ __forceinline__ unsigned* bar() const { return (unsigned*)(ws + OFF_BAR); }
  __device__ __forceinline__ unsigned* claim() const { return (unsigned*)(ws + OFF_CLAIM); }
  __device__ __forceinline__ float* mod() const { return (float*)(ws + OFF_MOD); }
  __device__ __forceinline__ float2* cs() const { return (float2*)(ws + OFF_CS); }
  __device__ __forceinline__ int* cnt() const { return (int*)(ws + OFF_CNT); }
  __device__ __forceinline__ int* list() const { return (int*)(ws + OFF_LIST); }
  __device__ __forceinline__ float2* tokw() const { return (float2*)(ws + OFF_TOKW); }
  __device__ __forceinline__ bf16_t* ssmB() const { return (bf16_t*)(ws + OFF_SSMB); }
  __device__ __forceinline__ bf16_t* ssmC() const { return (bf16_t*)(ws + OFF_SSMC); }
  __device__ __forceinline__ float* ssmL() const { return (float*)(ws + OFF_SSML); }
  __device__ __forceinline__ bf16_t* WinT() const { return (bf16_t*)(ws + OFF_WINT); }
  __device__ __forceinline__ bf16_t* WgluT() const { return (bf16_t*)(ws + OFF_WGLUT); }
  __device__ __forceinline__ bf16_t* WoutT() const { return (bf16_t*)(ws + OFF_WOUTT); }
  __device__ __forceinline__ bf16_t* WgT() const { return (bf16_t*)(ws + OFF_WGT); }
  __device__ __forceinline__ bf16_t* WuT() const { return (bf16_t*)(ws + OFF_WUT); }
  __device__ __forceinline__ bf16_t* WdT() const { return (bf16_t*)(ws + OFF_WDT); }
  __device__ __forceinline__ bf16_t* h() const { return (bf16_t*)(ws + OFF_H); }
  __device__ __forceinline__ bf16_t* q() const { return (bf16_t*)(ws + OFF_Q); }
  __device__ __forceinline__ bf16_t* k() const { return (bf16_t*)(ws + OFF_K); }
  __device__ __forceinline__ bf16_t* vT() const { return (bf16_t*)(ws + OFF_VT); }
  __device__ __forceinline__ bf16_t* u() const { return (bf16_t*)(ws + OFF_U); }
  __device__ __forceinline__ bf16_t* attn() const { return (bf16_t*)(ws + OFF_ATTN); }
  __device__ __forceinline__ bf16_t* y() const { return (bf16_t*)(ws + OFF_Y); }
  __device__ __forceinline__ bf16_t* ssm() const { return (bf16_t*)(ws + OFF_SSM); }
  __device__ __forceinline__ bf16_t* act() const { return (bf16_t*)(ws + OFF_ACT); }
  __device__ __forceinline__ float* ssqa() const { return (float*)(ws + OFF_SSQA); }
  __device__ __forceinline__ float* ssqs() const { return (float*)(ws + OFF_SSQS); }
  __device__ __forceinline__ bf16_t* x1() const { return (bf16_t*)(ws + OFF_X1); }
  __device__ __forceinline__ bf16_t* xb() const { return (bf16_t*)(ws + OFF_X1 + (size_t)T * D * 2); }
};

constexpr int TT_WIN = 8 * 20, TT_GLU = 4 * 8, TT_OUT = 8 * 16, TT_EXP = 16 * 64;
constexpr int TT_LAYER = TT_WIN + TT_GLU + TT_OUT + 3 * TT_EXP;
constexpr int P0_MOD = DEPTH * 192;
constexpr int P0_TR = DEPTH * TT_LAYER;
constexpr int P0_CS = T * 32 / 256;
constexpr int P0_SSM = DEPTH * SG;
constexpr int P0_MISC = P0_MOD + P0_CS + P0_SSM + 1;

__device__ __forceinline__ void phase0_item(const MP& p, int it, char* smem) {
  const int tid = launder(threadIdx.x);
  float* ldsf = (float*)smem;
  if (it < P0_MOD) {
    const int l = it / 192, j0 = (it % 192) * 32;
    float* sc = ldsf;
    float* red = ldsf + 8192;
    for (int i = tid; i < 8192; i += NTHR) { float v = p.in.c[i]; sc[i] = v / (1.f + __expf(-v)); }
    __syncthreads();
    const int kg = tid >> 3, cq = (tid & 7) * 4;
    float acc[8][4];
#pragma unroll
    for (int b = 0; b < 8; ++b)
#pragma unroll
      for (int j = 0; j < 4; ++j) acc[b][j] = 0.f;
    const float* w = p.in.ada_w + (size_t)l * 1024 * 6144 + j0 + cq;
#pragma unroll 8
    for (int kk = 0; kk < 32; ++kk) {
      const int k = kg * 32 + kk;
      const float4 wv = *(const float4*)(w + (size_t)k * 6144);
#pragma unroll
      for (int b = 0; b < 8; ++b) { const float s = sc[b * 1024 + k]; acc[b][0] += s * wv.x; acc[b][1] += s * wv.y; acc[b][2] += s * wv.z; acc[b][3] += s * wv.w; }
    }
#pragma unroll
    for (int b = 0; b < 8; ++b) *(float4*)(red + (kg * 8 + b) * 32 + cq) = make_float4(acc[b][0], acc[b][1], acc[b][2], acc[b][3]);
    __syncthreads();
    {
      const int b = tid >> 5, c = tid & 31;
      float v = 0.f;
#pragma unroll 8
      for (int g = 0; g < 32; ++g) v += red[(g * 8 + b) * 32 + c];
      p.mod()[(size_t)(l * 8 + b) * 6144 + j0 + c] = v + p.in.ada_b[l * 6144 + j0 + c];
    }
    __syncthreads();
    return;
  }
  it -= P0_MOD;
  if (it < P0_CS) {
    const int i = it * 256 + tid, t = i >> 5, f = i & 31;
    const float freq = powf(10000.f, -(float)f / 32.f);
    const float ang = (float)p.in.pos[t] * freq;
    float sn, cn; sincosf(ang, &sn, &cn);
    p.cs()[i] = make_float2(cn, sn);
    return;
  }
  it -= P0_CS;
  if (it < P0_SSM) {
    const int lg = it;
    if (tid < 64) {
      const int pp = tid;
      const float dt = expf(p.in.log_dt[lg]);
      const float lr = p.in.lam_re[lg * SP + pp], li = p.in.lam_im[lg * SP + pp];
      const float mag = expf(lr * dt);
      float sn, cn; sincosf(li * dt, &sn, &cn);
      const float ar = mag * cn, ai = mag * sn;
      const float den = lr * lr + li * li;
      const float fr = ((ar - 1.f) * lr + ai * li) / den, fi = (ai * lr - (ar - 1.f) * li) / den;
      p.ssmL()[(lg * SP + pp) * 2] = ar; p.ssmL()[(lg * SP + pp) * 2 + 1] = ai;
      unsigned wr[8], wi[8];
#pragma unroll
      for (int hh = 0; hh < 8; ++hh) {
        const float br0 = p.in.b_re[((size_t)lg * SP + pp) * SCH + 2 * hh], bi0 = p.in.b_im[((size_t)lg * SP + pp) * SCH + 2 * hh];
        const float br1 = p.in.b_re[((size_t)lg * SP + pp) * SCH + 2 * hh + 1], bi1 = p.in.b_im[((size_t)lg * SP + pp) * SCH + 2 * hh + 1];
        wr[hh] = pack2(fr * br0 - fi * bi0, fr * br1 - fi * bi1);
        wi[hh] = pack2(fr * bi0 + fi * br0, fr * bi1 + fi * br1);
      }
      u32x4* dr = (u32x4*)(p.ssmB() + ((size_t)lg * 128 + pp) * 16);
      u32x4* di = (u32x4*)(p.ssmB() + ((size_t)lg * 128 + 64 + pp) * 16);
      dr[0] = (u32x4){wr[0], wr[1], wr[2], wr[3]}; dr[1] = (u32x4){wr[4], wr[5], wr[6], wr[7]};
      di[0] = (u32x4){wi[0], wi[1], wi[2], wi[3]}; di[1] = (u32x4){wi[4], wi[5], wi[6], wi[7]};
    }
    for (int o = tid; o < 16 * 64; o += NTHR) {
      const int hh = o >> 6, pp = o & 63;
      const float cr = p.in.c_re[(size_t)lg * SCH * SP + o], ci = p.in.c_im[(size_t)lg * SCH * SP + o];
      *(unsigned*)(p.ssmC() + ((size_t)lg * 16 + hh) * 128 + 2 * pp) = pack2(cr, -ci);
    }
    return;
  }
  for (int i = tid; i < 256 * DEPTH; i += NTHR) p.cnt()[i] = 0;
}

struct TrDesc { const float* src; bf16_t* dst; const float* gain; int N, K, k0, n0; };
__device__ __forceinline__ void tr_decode(const MP& p, int it, TrDesc& d) {
  const int l = it / TT_LAYER; int r = it % TT_LAYER;
  d.gain = nullptr;
  if (r < TT_WIN) { d.src = p.in.w_in + (size_t)l * D * INW; d.N = INW; d.dst = p.WinT() + (size_t)l * INW * D; d.K = D; d.k0 = (r / 20) * 128; d.n0 = (r % 20) * 64; return; }
  r -= TT_WIN;
  if (r < TT_GLU) { d.src = p.in.w_glu + (size_t)l * SW * SW; d.N = SW; d.dst = p.WgluT() + (size_t)l * SW * SW; d.K = SW; d.k0 = (r / 8) * 128; d.n0 = (r % 8) * 64; return; }
  r -= TT_GLU;
  if (r < TT_OUT) {
    d.k0 = (r / 16) * 128; d.n0 = (r % 16) * 64;
    d.gain = d.k0 < 512 ? (p.in.attn_out_g + l * AW) : (p.in.ssm_out_g + l * SW - 512);
    d.src = p.in.w_out + (size_t)l * D * D; d.N = D; d.dst = p.WoutT() + (size_t)l * D * D; d.K = D; return; }
  r -= TT_OUT;
  const int kind = r / TT_EXP; r %= TT_EXP;
  const int e = r / 64, tt = r % 64;
  if (kind == 0) { d.src = p.in.w_gate + (size_t)(l * NE + e) * D * DFF; d.N = DFF; d.dst = p.WgT() + (size_t)(l * NE + e) * DFF * D; d.K = D; d.k0 = (tt / 8) * 128; d.n0 = (tt % 8) * 64; return; }
  if (kind == 1) { d.src = p.in.w_up + (size_t)(l * NE + e) * D * DFF; d.N = DFF; d.dst = p.WuT() + (size_t)(l * NE + e) * DFF * D; d.K = D; d.k0 = (tt / 8) * 128; d.n0 = (tt % 8) * 64; return; }
  d.src = p.in.w_down + (size_t)(l * NE + e) * DFF * D; d.N = D; d.dst = p.WdT() + (size_t)(l * NE + e) * D * DFF; d.K = DFF; d.k0 = (tt / 16) * 128; d.n0 = (tt % 16) * 64;
}
__device__ __forceinline__ void phase0_transposes(const MP& p, char* smem, int first, int last, int brank, int nblk) {
  const int tid = launder(threadIdx.x);
  float* lds = (float*)smem;
  const int r = tid >> 4, c4 = (tid & 15) * 4;
  const int n = tid >> 2, kq = (tid & 3) * 32;
  TrDesc cur, nxt;
  float4 v[8]; float gg[8];
  auto load = [&](const TrDesc& d) {
#pragma unroll
    for (int i = 0; i < 8; ++i) v[i] = *(const float4*)(d.src + (size_t)(d.k0 + r + 16 * i) * d.N + d.n0 + c4);
    if (d.gain) {
#pragma unroll
      for (int i = 0; i < 8; ++i) gg[i] = d.gain[d.k0 + r + 16 * i];
    } else {
#pragma unroll
      for (int i = 0; i < 8; ++i) gg[i] = 1.f;
    }
  };
  int it = first + brank;
  if (it < last) { tr_decode(p, it, cur); load(cur); nxt = cur; }
  for (; it < last; it += nblk) {
#pragma unroll
    for (int i = 0; i < 8; ++i) {
      float* d = lds + (r + 16 * i) * 65 + c4;
      d[0] = v[i].x * gg[i]; d[1] = v[i].y * gg[i]; d[2] = v[i].z * gg[i]; d[3] = v[i].w * gg[i];
    }
    __syncthreads();
    const int nit = it + nblk;
    if (nit < last) { tr_decode(p, nit, nxt); load(nxt); }
    unsigned w[16];
#pragma unroll
    for (int j = 0; j < 16; ++j) w[j] = pack2(lds[(kq + 2 * j) * 65 + n], lds[(kq + 2 * j + 1) * 65 + n]);
    u32x4* dd = (u32x4*)(cur.dst + (size_t)(cur.n0 + n) * cur.K + cur.k0 + kq);
#pragma unroll
    for (int j = 0; j < 4; ++j) dd[j] = (u32x4){w[4 * j], w[4 * j + 1], w[4 * j + 2], w[4 * j + 3]};
    __syncthreads();
    cur = nxt;
  }
}

template <bool XB>
__device__ __forceinline__ void norm_token(const void* __restrict__ xrow, const float* __restrict__ g, const float* __restrict__ sh,
                                           const float* __restrict__ sc, bf16_t* __restrict__ hr, int lane, float (&hv)[16]) {
  float4 v[4]; float ss = 0.f;
#pragma unroll
  for (int i = 0; i < 4; ++i) {
    if (XB) { const u32x2 r = *(const u32x2*)((const bf16_t*)xrow + lane * 4 + 256 * i); v[i] = make_float4(bf_lo(r[0]), bf_hi(r[0]), bf_lo(r[1]), bf_hi(r[1])); }
    else v[i] = *(const float4*)((const float*)xrow + lane * 4 + 256 * i);
    ss += v[i].x * v[i].x + v[i].y * v[i].y + v[i].z * v[i].z + v[i].w * v[i].w;
  }
  ss = wave_sum(ss);
  const float rinv = rsqrtf(ss * (1.f / D) + EPS);
#pragma unroll
  for (int i = 0; i < 4; ++i) {
    const int d = lane * 4 + 256 * i;
    const float4 gg = *(const float4*)(g + d), s1 = *(const float4*)(sc + d), s0 = *(const float4*)(sh + d);
    hv[4 * i + 0] = v[i].x * rinv * gg.x * (1.f + s1.x) + s0.x;
    hv[4 * i + 1] = v[i].y * rinv * gg.y * (1.f + s1.y) + s0.y;
    hv[4 * i + 2] = v[i].z * rinv * gg.z * (1.f + s1.z) + s0.z;
    hv[4 * i + 3] = v[i].w * rinv * gg.w * (1.f + s1.w) + s0.w;
    *(u32x2*)(hr + d) = (u32x2){pack2(hv[4 * i], hv[4 * i + 1]), pack2(hv[4 * i + 2], hv[4 * i + 3])};
  }
}

struct TokRange { int t0, step, end; };
__device__ __forceinline__ TokRange tok_range(int wave) {
  TokRange r;
  if ((gridDim.x & 7) == 0) { const int xcd = blockIdx.x & 7, lb = blockIdx.x >> 3, nlb = gridDim.x >> 3; r.t0 = xcd * S + lb * 4 + wave; r.step = nlb * 4; r.end = (xcd + 1) * S; }
  else { r.t0 = blockIdx.x * 4 + wave; r.step = gridDim.x * 4; r.end = T; }
  return r;
}
template <bool XB>
__device__ __forceinline__ void phase_norm1(const MP& p, int l, const float* xin) {
  const int tid = launder(threadIdx.x);
  const int wave = tid >> 6, lane = tid & 63;
  const float* modl = p.mod() + (size_t)l * 8 * 6144;
  const TokRange tr = tok_range(wave);
  for (int t = tr.t0; t < tr.end; t += tr.step) {
    const int b = t / S; float hv[16];
    norm_token<XB>(XB ? (const void*)(p.xb() + (size_t)t * D) : (const void*)(xin + (size_t)t * D), p.in.norm1_g + l * D, modl + (size_t)b * 6144, modl + (size_t)b * 6144 + 1024, p.h() + (size_t)t * D, lane, hv);
  }
}

struct GemmTile {
  const bf16_t* A0; const bf16_t* A1; long lda; int ksA;
  int arow[4];
  const bf16_t* Blo0; const bf16_t* Bhi0;
  const bf16_t* Blo1; const bf16_t* Bhi1;
  long ldb; int ksB;
  int K; int rot;
};

__device__ __forceinline__ int lds_off(int row, int chunk) { return row * 128 + ((chunk ^ ((row >> 1) & 7)) << 4); }

template <bool BSPLIT, bool MID>
__device__ __forceinline__ void gemm_mainloop_t(const GemmTile& g, const GemmTile& gnext, bool hasnext, bool preloaded, char* smem, f32x4 (&acc)[4][4],
                                                int ktmid, const float (&mids)[4]) {
  const int tid = launder(threadIdx.x), lane = tid & 63, wave = tid >> 6, wr = wave >> 1, wc = wave & 1, fr = lane & 15, fq = lane >> 4;
  const int r0 = tid >> 3, c8 = tid & 7;
  const int csrc = (c8 ^ ((r0 >> 1) & 7)) * 8;
  const int wbase = __builtin_amdgcn_readfirstlane(wave) * 1024;
#pragma unroll
  for (int m = 0; m < 4; ++m)
#pragma unroll
    for (int n = 0; n < 4; ++n) acc[m][n] = (f32x4){0.f, 0.f, 0.f, 0.f};
  auto stage = [&](const GemmTile& gg, int kt, int buf) {
    const int kk = ((kt + gg.rot) & (gg.K / 64 - 1)) * 64;
    const bf16_t* Ab = kk < gg.ksA ? gg.A0 + kk : gg.A1 + (kk - gg.ksA);
    const bool bs = kk < gg.ksB; const int kb = bs ? kk : kk - gg.ksB;
    char* As = smem + buf * 32768 + wbase; char* Bs = As + 16384;
#pragma unroll
    for (int i = 0; i < 4; ++i) {
      __builtin_amdgcn_global_load_lds((const void*)(Ab + (size_t)gg.arow[i] * gg.lda + csrc), (void*)(As + i * 4096), 16, 0, 0);
      const bf16_t* Bb = bs ? (i < 2 ? gg.Blo0 : gg.Bhi0) : (i < 2 ? gg.Blo1 : gg.Bhi1);
      __builtin_amdgcn_global_load_lds((const void*)(Bb + (size_t)(r0 + 32 * (i & 1)) * gg.ldb + kb + csrc), (void*)(Bs + i * 4096), 16, 0, 0);
    }
  };
  const int nk = g.K / 64;
  if (!preloaded) {
    stage(g, 0, 0);
    asm volatile("s_waitcnt vmcnt(0)" ::: "memory");
    __syncthreads();
  }
  for (int kt = 0; kt < nk; ++kt) {
    if (kt + 1 < nk) stage(g, kt + 1, (kt + 1) & 1);
    else if (hasnext) stage(gnext, 0, 0);
    if (MID && kt == ktmid) {
#pragma unroll
      for (int m = 0; m < 4; ++m)
#pragma unroll
        for (int n = 0; n < 4; ++n) acc[m][n] *= mids[m];
    }
    const char* As = smem + (kt & 1) * 32768; const char* Bs = As + 16384;
    {
      bf16x8 af[2][4], bfr[2][4];
#pragma unroll
      for (int ks = 0; ks < 2; ++ks) {
#pragma unroll
        for (int m = 0; m < 4; ++m) af[ks][m] = *(const bf16x8*)(As + lds_off(wr * 64 + 16 * m + fr, ks * 4 + fq));
#pragma unroll
        for (int n = 0; n < 4; ++n) {
          const int brow = BSPLIT ? ((n >> 1) * 64 + wc * 32 + (n & 1) * 16 + fr) : (wc * 64 + 16 * n + fr);
          bfr[ks][n] = *(const bf16x8*)(Bs + lds_off(brow, ks * 4 + fq));
        }
      }
#pragma unroll
      for (int ks = 0; ks < 2; ++ks)
#pragma unroll
        for (int m = 0; m < 4; ++m)
#pragma unroll
          for (int n = 0; n < 4; ++n) acc[m][n] = __builtin_amdgcn_mfma_f32_16x16x32_bf16(bfr[ks][n], af[ks][m], acc[m][n], 0, 0, 0);
      __builtin_amdgcn_sched_group_barrier(0x100, 8, 0);
#pragma unroll
      for (int i = 0; i < 8; ++i) { __builtin_amdgcn_sched_group_barrier(0x008, 2, 0); __builtin_amdgcn_sched_group_barrier(0x100, 1, 0); }
      __builtin_amdgcn_sched_group_barrier(0x008, 16, 0);
    }
    __builtin_amdgcn_sched_barrier(0);
    asm volatile("s_waitcnt vmcnt(0)" ::: "memory");
    __syncthreads();
  }
}
template <bool BSPLIT>
__device__ __forceinline__ void gemm_mainloop(const GemmTile& g, const GemmTile& gnext, bool hasnext, bool preloaded, char* smem, f32x4 (&acc)[4][4]) {
  const float dummy[4] = {1.f, 1.f, 1.f, 1.f};
  gemm_mainloop_t<BSPLIT, false>(g, gnext, hasnext, preloaded, smem, acc, -1, dummy);
}

struct TileMap { int base, ntl, lb, nlb; };
__device__ __forceinline__ TileMap tm_init(int nMt, int nNt) {
  TileMap t;
  if ((gridDim.x & 7) == 0) {
    const int xcd = blockIdx.x & 7;
    t.lb = blockIdx.x >> 3; t.nlb = gridDim.x >> 3;
    const int mlo = (nMt * xcd) >> 3, mhi = (nMt * (xcd + 1)) >> 3;
    t.base = mlo * nNt; t.ntl = (mhi - mlo) * nNt;
  } else { t.lb = blockIdx.x; t.nlb = gridDim.x; t.base = 0; t.ntl = nMt * nNt; }
  return t;
}
__device__ __forceinline__ int tm_tile(const TileMap& t, int j) { const int li = t.lb + t.nlb * j; return li < t.ntl ? t.base + li : -1; }
__device__ __forceinline__ void phase_inproj(const MP& p, int l, char* smem) {
  const int tid = launder(threadIdx.x), lane = tid & 63, wave = tid >> 6, wr = wave >> 1, wc = wave & 1, fr = lane & 15, fq = lane >> 4;
  const int r0 = tid >> 3;
  const int ntiles = (T / 128) * (INW / 128);
  const bf16_t* W = p.WinT() + (size_t)l * INW * D;
  auto make = [&](int tile, GemmTile& g) {
    const int m0 = (tile / 10) * 128, n0 = (tile % 10) * 128;
    g.A0 = p.h(); g.A1 = p.h(); g.lda = D; g.ksA = D; g.K = D;
#pragma unroll
    for (int i = 0; i < 4; ++i) g.arow[i] = m0 + r0 + 32 * i;
    g.Blo0 = W + (size_t)n0 * D; g.Bhi0 = g.Blo0 + (size_t)64 * D; g.Blo1 = g.Blo0; g.Bhi1 = g.Bhi0;
    g.ldb = D; g.ksB = D; g.rot = ROT_OF(tile / 10, tile % 10);
  };
  GemmTile g, gn; bool pre = false;
  const TileMap tmap = tm_init(T / 128, INW / 128);
  { const int t0 = tm_tile(tmap, 0); if (t0 >= 0) { make(t0, g); gn = g; } }
  for (int jt = 0; ; ++jt) {
    const int tile = tm_tile(tmap, jt); if (tile < 0) break;
    const int mt = tile / 10, nt = tile % 10, m0 = mt * 128;
    const int nxt = tm_tile(tmap, jt + 1); const bool hasn = nxt >= 0;
    if (hasn) make(nxt, gn);
    f32x4 acc[4][4];
    gemm_mainloop<false>(g, gn, hasn, pre, smem, acc);
    pre = hasn; g = gn;
    const int rowb = m0 + wr * 64 + fr;
    if (nt <= 4) {
      const float* gv = (nt < 4 ? p.in.q_norm_g : p.in.k_norm_g) + l * HD;
      const float scl = nt < 4 ? 0.125f : 1.f;
      f32x4 g1[2], g2[2];
#pragma unroll
      for (int n = 0; n < 2; ++n) { g1[n] = *(const f32x4*)(gv + 16 * n + 4 * fq); g2[n] = *(const f32x4*)(gv + 32 + 16 * n + 4 * fq); }
      f32x4 csv[4][2][2];
#pragma unroll
      for (int m = 0; m < 4; ++m)
#pragma unroll
        for (int n = 0; n < 2; ++n) {
          const float* cp = (const float*)p.cs() + ((size_t)(rowb + 16 * m) * 32 + 16 * n + 4 * fq) * 2;
          csv[m][n][0] = *(const f32x4*)cp; csv[m][n][1] = *(const f32x4*)(cp + 4);
        }
#pragma unroll
      for (int m = 0; m < 4; ++m) {
        const int t = rowb + 16 * m;
        float ss = 0.f;
#pragma unroll
        for (int n = 0; n < 4; ++n)
#pragma unroll
          for (int j = 0; j < 4; ++j) ss += acc[m][n][j] * acc[m][n][j];
        ss += __shfl_xor(ss, 16); ss += __shfl_xor(ss, 32);
        const float rinv = rsqrtf(ss * (1.f / 64.f) + EPS) * scl;
        bf16_t* dst = nt < 4 ? (p.q() + (size_t)t * AW + (2 * nt + wc) * 64) : (p.k() + (size_t)t * 128 + wc * 64);
#pragma unroll
        for (int n = 0; n < 2; ++n) {
          const int c = 16 * n + 4 * fq;
          const f32x4 csa = csv[m][n][0], csb = csv[m][n][1];
          const float cn[4] = {csa[0], csa[2], csb[0], csb[2]}, sn[4] = {csa[1], csa[3], csb[1], csb[3]};
          float o1[4], o2[4];
#pragma unroll
          for (int j = 0; j < 4; ++j) {
            const float x1 = acc[m][n][j] * rinv * g1[n][j], x2 = acc[m][n + 2][j] * rinv * g2[n][j];
            o1[j] = x1 * cn[j] - x2 * sn[j]; o2[j] = x2 * cn[j] + x1 * sn[j];
          }
          *(u32x2*)(dst + c) = (u32x2){pack2(o1[0], o1[1]), pack2(o1[2], o1[3])};
          *(u32x2*)(dst + 32 + c) = (u32x2){pack2(o2[0], o2[1]), pack2(o2[2], o2[3])};
        }
      }
    } else if (nt == 5) {
      const int b = m0 / S;
#pragma unroll
      for (int m = 0; m < 4; ++m) {
        const int s = (rowb + 16 * m) % S;
        const int k16 = s & 15;
        const int sp = (s & ~15) | (k16 & 3) | (((k16 >> 3) & 1) << 2) | (((k16 >> 2) & 1) << 3);
#pragma unroll
        for (int n = 0; n < 4; ++n)
#pragma unroll
          for (int j = 0; j < 4; ++j) {
            const int d = 16 * n + 4 * fq + j;
            p.vT()[((size_t)(b * 2 + wc) * 64 + d) * S + sp] = (bf16_t)(pack2(acc[m][n][j], 0.f) & 0xffffu);
          }
      }
    } else {
#pragma unroll
      for (int m = 0; m < 4; ++m) {
        const int t = rowb + 16 * m;
#pragma unroll
        for (int n = 0; n < 4; ++n)
          *(u32x2*)(p.u() + (size_t)t * SW + (nt - 6) * 128 + wc * 64 + 16 * n + 4 * fq) = (u32x2){pack2(acc[m][n][0], acc[m][n][1]), pack2(acc[m][n][2], acc[m][n][3])};
      }
    }
  }
}

__device__ __forceinline__ int crow32(int r, int hf) { return (r & 3) + 8 * (r >> 2) + 4 * hf; }
__device__ __forceinline__ void attn_task(const MP& p, int l, int task, int lane) {
  lane = launder(lane);
  task = __builtin_amdgcn_readfirstlane(task);
  const int h = task & 7, qt = (task >> 3) & 63, b = task >> 9, kvh = h >> 2;
  const int s0 = qt * 32, t0 = b * S + s0, ql = lane & 31, hf = lane >> 5;
  int kst[5];
#pragma unroll
  for (int kt = 0; kt < 5; ++kt) { const int ks = s0 - 128 + 32 * kt; kst[kt] = ks < 0 ? 0 : ks; }
  bf16x8 qf[4], kf[5][4];
#pragma unroll
  for (int st = 0; st < 4; ++st) qf[st] = *(const bf16x8*)(p.q() + (size_t)(t0 + ql) * AW + h * 64 + 16 * st + 8 * hf);
#pragma unroll
  for (int kt = 0; kt < 5; ++kt)
#pragma unroll
    for (int st = 0; st < 4; ++st) kf[kt][st] = *(const bf16x8*)(p.k() + (size_t)(b * S + kst[kt] + ql) * 128 + kvh * 64 + 8 * hf + 16 * st);
  f32x16 sc[5];
#pragma unroll
  for (int kt = 0; kt < 5; ++kt) {
#pragma unroll
    for (int r = 0; r < 16; ++r) sc[kt][r] = 0.f;
#pragma unroll
    for (int st = 0; st < 4; ++st) sc[kt] = __builtin_amdgcn_mfma_f32_32x32x16_bf16(kf[kt][st], qf[st], sc[kt], 0, 0, 0);
  }
  bf16x8 vb[5][2][2];
#pragma unroll
  for (int kt = 0; kt < 5; ++kt)
#pragma unroll
    for (int s = 0; s < 2; ++s)
#pragma unroll
      for (int dt = 0; dt < 2; ++dt)
        vb[kt][s][dt] = *(const bf16x8*)(p.vT() + ((size_t)(b * 2 + kvh) * 64 + 32 * dt + ql) * S + kst[kt] + 16 * s + 8 * hf);
  const float sink = p.in.attn_sink[l * NQ + h];
  float mx = sink;
#pragma unroll
  for (int kt = 0; kt < 5; ++kt) {
#pragma unroll
    for (int r = 0; r < 16; ++r) {
      const int kp = s0 - 128 + 32 * kt + crow32(r, hf);
      const int dk = kp - (s0 + ql);
      const bool valid = kp >= 0 && dk <= 0 && dk > -128;
      sc[kt][r] = valid ? sc[kt][r] : -1e30f;
      mx = fmaxf(mx, sc[kt][r]);
    }
  }
  mx = xhalf_max(mx);
  float lsum = 0.f;
#pragma unroll
  for (int kt = 0; kt < 5; ++kt) {
#pragma unroll
    for (int r = 0; r < 16; ++r) { const float e = __expf(sc[kt][r] - mx); sc[kt][r] = e; lsum += e; }
  }
  lsum = xhalf_sum(lsum);
  lsum += __expf(sink - mx);
  const float inv = 1.f / lsum;
  f32x16 o[2];
#pragma unroll
  for (int r = 0; r < 16; ++r) { o[0][r] = 0.f; o[1][r] = 0.f; }
#pragma unroll
  for (int kt = 0; kt < 5; ++kt) {
#pragma unroll
    for (int s = 0; s < 2; ++s) {
      u32x4 pw;
#pragma unroll
      for (int j = 0; j < 4; ++j) pw[j] = pack2(sc[kt][8 * s + 2 * j], sc[kt][8 * s + 2 * j + 1]);
      const bf16x8 pa = __builtin_bit_cast(bf16x8, pw);
#pragma unroll
      for (int dt = 0; dt < 2; ++dt) o[dt] = __builtin_amdgcn_mfma_f32_32x32x16_bf16(vb[kt][s][dt], pa, o[dt], 0, 0, 0);
    }
  }
  bf16_t* dst = p.attn() + (size_t)(t0 + ql) * AW + h * 64 + 4 * hf;
  float ssq = 0.f;
#pragma unroll
  for (int dt = 0; dt < 2; ++dt)
#pragma unroll
    for (int g4 = 0; g4 < 4; ++g4) {
      const float a0 = o[dt][4 * g4] * inv, a1 = o[dt][4 * g4 + 1] * inv, a2 = o[dt][4 * g4 + 2] * inv, a3 = o[dt][4 * g4 + 3] * inv;
      ssq += (a0 * a0 + a1 * a1) + (a2 * a2 + a3 * a3);
      *(u32x2*)(dst + 32 * dt + 8 * g4) = (u32x2){pack2(a0, a1), pack2(a2, a3)};
    }
  ssq = xhalf_sum(ssq);
  if (hf == 0) p.ssqa()[(size_t)(t0 + ql) * 8 + h] = ssq;
}
constexpr int SSEG = 4, SEGLEN = S / SSEG, SEGCH = SEGLEN / 32;

__device__ __forceinline__ void ssm_bu(const bf16x8& ua, const bf16x8 (&bB)[4], f32x16 (&bu)[4]) {
#pragma unroll
  for (int nt = 0; nt < 4; ++nt) {
#pragma unroll
    for (int r = 0; r < 16; ++r) bu[nt][r] = 0.f;
    bu[nt] = __builtin_amdgcn_mfma_f32_32x32x16_bf16(ua, bB[nt], bu[nt], 0, 0, 0);
  }
  asm volatile("s_nop 15\n\ts_nop 7" : "+v"(bu[0]), "+v"(bu[1]), "+v"(bu[2]), "+v"(bu[3]));
#pragma unroll
  for (int r = 0; r < 16; ++r) {
    auto s0 = __builtin_amdgcn_permlane32_swap(__float_as_uint(bu[0][r]), __float_as_uint(bu[1][r]), false, false);
    bu[0][r] = __uint_as_float(s0[0]); bu[1][r] = __uint_as_float(s0[1]);
    auto s1 = __builtin_amdgcn_permlane32_swap(__float_as_uint(bu[2][r]), __float_as_uint(bu[3][r]), false, false);
    bu[2][r] = __uint_as_float(s1[0]); bu[3][r] = __uint_as_float(s1[1]);
  }
}

__device__ __forceinline__ void ssm_block(const MP& p, int l, int b, int g, int tid, char* smem) {
  const int lane = tid & 63, seg = tid >> 6;
  char* wl = smem + seg * 8192;
  float* fin = (float*)(smem + 4 * 8192);
  const int lg = l * SG + g, hf = lane >> 5, fr = lane & 15, fq = lane >> 4;
  const float ar = p.ssmL()[(lg * SP + lane) * 2], ai = p.ssmL()[(lg * SP + lane) * 2 + 1];
  bf16x8 bB[4], cB[4];
#pragma unroll
  for (int nt = 0; nt < 4; ++nt) bB[nt] = *(const bf16x8*)(p.ssmB() + ((size_t)lg * 128 + nt * 32 + (lane & 31)) * 16 + 8 * hf);
#pragma unroll
  for (int ks = 0; ks < 4; ++ks) cB[ks] = *(const bf16x8*)(p.ssmC() + ((size_t)lg * 16 + fr) * 128 + 32 * ks + 8 * fq);
  const f32x4 dsk = *(const f32x4*)(p.in.ssm_d + l * SW + g * 16 + 4 * fq);
  const int t0 = b * S + seg * SEGLEN;
  const bf16_t* urow = p.u() + (size_t)(t0 + (lane & 31)) * SW + g * 16 + 8 * hf;
  float xr = 0.f, xi = 0.f;
  if (seg < SSEG - 1) {
    bf16x8 ua = *(const bf16x8*)(urow);
    for (int c = 0; c < SEGCH; ++c) {
      const bf16x8 un = *(const bf16x8*)(urow + (size_t)((c + 1 < SEGCH ? c + 1 : c) * 32) * SW);
      f32x16 bu[4];
      ssm_bu(ua, bB, bu);
#pragma unroll
      for (int r4 = 0; r4 < 4; ++r4)
#pragma unroll
        for (int half = 0; half < 2; ++half)
#pragma unroll
          for (int j = 0; j < 4; ++j) {
            const int r = 4 * r4 + j;
            const float bre = half ? bu[1][r] : bu[0][r], bim = half ? bu[3][r] : bu[2][r];
            const float nr = ar * xr - ai * xi + bre, ni = ar * xi + ai * xr + bim;
            xr = nr; xi = ni;
          }
      ua = un;
    }
  }
  fin[(seg * 64 + lane) * 2] = xr; fin[(seg * 64 + lane) * 2 + 1] = xi;
  __syncthreads();
  {
    float pr = ar, pi = ai;
#pragma unroll
    for (int i = 0; i < 9; ++i) { const float nr = pr * pr - pi * pi, ni = 2.f * pr * pi; pr = nr; pi = ni; }
    static_assert(SEGLEN == 512, "lam^SEGLEN squaring count");
    float cr = 0.f, ci = 0.f;
    for (int j = 0; j < seg; ++j) {
      const float fr_ = fin[(j * 64 + lane) * 2], fi_ = fin[(j * 64 + lane) * 2 + 1];
      const float nr = pr * cr - pi * ci + fr_, ni = pr * ci + pi * cr + fi_;
      cr = nr; ci = ni;
    }
    xr = cr; xi = ci;
  }
  const int wbase = (lane & 3) * 4;
  const int pch = lane >> 2;
  const bf16_t* uep = p.u() + (size_t)(t0 + fr) * SW + g * 16 + 4 * fq;
  bf16x8 ua = *(const bf16x8*)(urow);
  u32x2 uraw[2];
#pragma unroll
  for (int i = 0; i < 2; ++i) uraw[i] = *(const u32x2*)(uep + (size_t)(16 * i) * SW);
  for (int c = 0; c < SEGCH; ++c) {
    const int tb = t0 + c * 32;
    const int cn = (c + 1 < SEGCH ? c + 1 : c) * 32;
    const bf16x8 un = *(const bf16x8*)(urow + (size_t)cn * SW);
    u32x2 unraw[2];
#pragma unroll
    for (int i = 0; i < 2; ++i) unraw[i] = *(const u32x2*)(uep + (size_t)(cn + 16 * i) * SW);
    f32x16 bu[4];
    ssm_bu(ua, bB, bu);
#pragma unroll
    for (int r4 = 0; r4 < 4; ++r4) {
#pragma unroll
      for (int half = 0; half < 2; ++half) {
#pragma unroll
        for (int j = 0; j < 4; ++j) {
          const int t = 8 * r4 + 4 * half + j, r = 4 * r4 + j;
          const float bre = half ? bu[1][r] : bu[0][r], bim = half ? bu[3][r] : bu[2][r];
          const float nr = ar * xr - ai * xi + bre, ni = ar * xi + ai * xr + bim;
          xr = nr; xi = ni;
          *(unsigned*)(wl + t * 256 + ((pch ^ (t & 15)) << 4) + wbase) = pack2(nr, ni);
        }
      }
    }
    asm volatile("s_waitcnt lgkmcnt(0)" ::: "memory");
#pragma unroll
    for (int mt = 0; mt < 2; ++mt) {
      f32x4 acc = {0.f, 0.f, 0.f, 0.f};
      const int t = 16 * mt + fr;
#pragma unroll
      for (int ks = 0; ks < 4; ++ks) {
        const bf16x8 af = *(const bf16x8*)(wl + t * 256 + (((4 * ks + fq) ^ (t & 15)) << 4));
        acc = __builtin_amdgcn_mfma_f32_16x16x32_bf16(cB[ks], af, acc, 0, 0, 0);
      }
      const float uu[4] = {bf_lo(uraw[mt][0]), bf_hi(uraw[mt][0]), bf_lo(uraw[mt][1]), bf_hi(uraw[mt][1])};
      float ge[4];
#pragma unroll
      for (int j = 0; j < 4; ++j) {
        const float v = acc[j] + dsk[j] * uu[j];
        const float z2 = 1.5957691216057308f * (v + 0.044715f * v * v * v);
        ge[j] = v * __builtin_amdgcn_rcpf(1.f + __expf(-z2));
      }
      *(u32x2*)(p.y() + (size_t)(tb + t) * SW + g * 16 + 4 * fq) = (u32x2){pack2(ge[0], ge[1]), pack2(ge[2], ge[3])};
    }
    asm volatile("s_waitcnt lgkmcnt(0)" ::: "memory");
    ua = un;
#pragma unroll
    for (int i = 0; i < 2; ++i) uraw[i] = unraw[i];
  }
}

__device__ __forceinline__ void phase_attn(const MP& p, int l) {
  const int tid = launder(threadIdx.x);
  const int wave = tid >> 6, lane = tid & 63;
  if ((gridDim.x & 7) == 0) {
    const int xcd = blockIdx.x & 7, lb = blockIdx.x >> 3, nlb = gridDim.x >> 3;
    for (int lt = lb * 4 + wave; lt < 64 * 8; lt += nlb * 4) attn_task(p, l, (xcd << 9) | lt, lane);
  } else {
    for (int task = blockIdx.x * 4 + wave; task < NB * 64 * 8; task += gridDim.x * 4) attn_task(p, l, task, lane);
  }
}
__device__ __forceinline__ void phase_ssm(const MP& p, int l, char* smem, int wid, int lrank) {
  const int tid = launder(threadIdx.x);
  if (wid < 0) return;
  unsigned nwl = 0; bool all = (gridDim.x & 7) == 0;
#pragma unroll
  for (int x = 0; x < 8; ++x) {
    const unsigned c = __hip_atomic_load(p.claim() + 4104 + x, __ATOMIC_RELAXED, __HIP_MEMORY_SCOPE_AGENT);
    all = all && c > 0u; nwl = (x == (int)(blockIdx.x & 7)) ? c : nwl;
  }
  if (all) {
    const int b = blockIdx.x & 7;
    for (int g = lrank; g < SG; g += (int)nwl) { ssm_block(p, l, b, g, tid, smem); __syncthreads(); }
  } else {
    const int nw = (int)__hip_atomic_load(p.claim() + 4096, __ATOMIC_RELAXED, __HIP_MEMORY_SCOPE_AGENT);
    for (int task = wid; task < NB * SG; task += nw) { ssm_block(p, l, task / SG, task % SG, tid, smem); __syncthreads(); }
  }
}
__device__ __forceinline__ void phase_glu(const MP& p, int l, char* smem) {
  const int tid = launder(threadIdx.x), lane = tid & 63, wave = tid >> 6, wr = wave >> 1, wc = wave & 1, fr = lane & 15, fq = lane >> 4;
  const int r0 = tid >> 3;
  const int ntiles = (T / 128) * (SW / 128);
  const bf16_t* W = p.WgluT() + (size_t)l * SW * SW;
  auto make = [&](int tile, GemmTile& g) {
    const int m0 = (tile >> 2) * 128, n0 = (tile & 3) * 128;
    g.A0 = p.y(); g.A1 = p.y(); g.lda = SW; g.ksA = SW; g.K = SW;
#pragma unroll
    for (int i = 0; i < 4; ++i) g.arow[i] = m0 + r0 + 32 * i;
    g.Blo0 = W + (size_t)n0 * SW; g.Bhi0 = g.Blo0 + (size_t)64 * SW; g.Blo1 = g.Blo0; g.Bhi1 = g.Bhi0;
    g.ldb = SW; g.ksB = SW; g.rot = ROT_OF(tile >> 2, tile & 3) & 7;
  };
  GemmTile g, gn; bool pre = false;
  const TileMap tmap = tm_init(T / 128, SW / 128);
  { const int t0 = tm_tile(tmap, 0); if (t0 >= 0) { make(t0, g); gn = g; } }
  for (int jt = 0; ; ++jt) {
    const int tile = tm_tile(tmap, jt); if (tile < 0) break;
    const int mt = tile >> 2, nt = tile & 3, m0 = mt * 128, n0 = nt * 128;
    const int nxt = tm_tile(tmap, jt + 1); const bool hasn = nxt >= 0;
    if (hasn) make(nxt, gn);
    f32x4 acc[4][4];
    gemm_mainloop<false>(g, gn, hasn, pre, smem, acc);
    pre = hasn; g = gn;
    u32x2 yrv[4][4];
#pragma unroll
    for (int m = 0; m < 4; ++m)
#pragma unroll
      for (int n = 0; n < 4; ++n) yrv[m][n] = *(const u32x2*)(p.y() + (size_t)(m0 + wr * 64 + 16 * m + fr) * SW + n0 + wc * 64 + 16 * n + 4 * fq);
#pragma unroll
    for (int m = 0; m < 4; ++m) {
      const int t = m0 + wr * 64 + 16 * m + fr;
      float ss = 0.f;
#pragma unroll
      for (int n = 0; n < 4; ++n) {
        const int col = n0 + wc * 64 + 16 * n + 4 * fq;
        const u32x2 yr = yrv[m][n];
        const float yv[4] = {bf_lo(yr[0]), bf_hi(yr[0]), bf_lo(yr[1]), bf_hi(yr[1])};
        float o[4];
#pragma unroll
        for (int j = 0; j < 4; ++j) { o[j] = yv[j] * __builtin_amdgcn_rcpf(1.f + __expf(-acc[m][n][j])); ss += o[j] * o[j]; }
        *(u32x2*)(p.ssm() + (size_t)t * SW + col) = (u32x2){pack2(o[0], o[1]), pack2(o[2], o[3])};
      }
      ss += __shfl_xor(ss, 16); ss += __shfl_xor(ss, 32);
      if (fq == 0) p.ssqs()[(size_t)t * 8 + nt * 2 + wc] = ss;
    }
  }
}

template <bool XB>
__device__ __forceinline__ void phase_out(const MP& p, int l, char* smem, const float* xin) {
  const int tid = launder(threadIdx.x), lane = tid & 63, wave = tid >> 6, wr = wave >> 1, wc = wave & 1, fr = lane & 15, fq = lane >> 4;
  const int r0 = tid >> 3;
  const float* modl = p.mod() + (size_t)l * 8 * 6144;
  const int ntiles = (T / 128) * (D / 128);
  const bf16_t* W = p.WoutT() + (size_t)l * D * D;
  auto make = [&](int tile, GemmTile& g) {
    const int m0 = (tile >> 3) * 128, n0 = (tile & 7) * 128;
    g.A0 = p.attn(); g.A1 = p.ssm(); g.lda = AW; g.ksA = AW; g.K = D;
#pragma unroll
    for (int i = 0; i < 4; ++i) g.arow[i] = m0 + r0 + 32 * i;
    g.Blo0 = W + (size_t)n0 * D; g.Bhi0 = g.Blo0 + (size_t)64 * D; g.Blo1 = g.Blo0; g.Bhi1 = g.Bhi0;
    g.ldb = D; g.ksB = D; g.rot = 0;
  };
  GemmTile g, gn; bool pre = false;
  const TileMap tmap = tm_init(T / 128, D / 128);
  { const int t0 = tm_tile(tmap, 0); if (t0 >= 0) { make(t0, g); gn = g; } }
  for (int jt = 0; ; ++jt) {
    const int tile = tm_tile(tmap, jt); if (tile < 0) break;
    const int mt = tile >> 3, nt = tile & 7, m0 = mt * 128, n0 = nt * 128, b = m0 / S;
    const int nxt = tm_tile(tmap, jt + 1); const bool hasn = nxt >= 0;
    if (hasn) make(nxt, gn);
    float mids[4], rs[4];
#pragma unroll
    for (int m = 0; m < 4; ++m) {
      const int t = m0 + wr * 64 + 16 * m + fr;
      const f32x4 a0 = *(const f32x4*)(p.ssqa() + (size_t)t * 8), a1 = *(const f32x4*)(p.ssqa() + (size_t)t * 8 + 4);
      const f32x4 s0 = *(const f32x4*)(p.ssqs() + (size_t)t * 8), s1 = *(const f32x4*)(p.ssqs() + (size_t)t * 8 + 4);
      const float sa = ((a0[0] + a0[1]) + (a0[2] + a0[3])) + ((a1[0] + a1[1]) + (a1[2] + a1[3]));
      const float sq = ((s0[0] + s0[1]) + (s0[2] + s0[3])) + ((s1[0] + s1[1]) + (s1[2] + s1[3]));
      const float ra = rsqrtf(sa * (1.f / 512.f) + EPS);
      rs[m] = rsqrtf(sq * (1.f / 512.f) + EPS);
      mids[m] = ra / rs[m];
    }
    f32x4 acc[4][4];
    gemm_mainloop_t<false, true>(g, gn, hasn, pre, smem, acc, 8, mids);
    pre = hasn; g = gn;
    f32x4 g1v[4], xvv[4][4]; u32x2 xbv[4][4];
#pragma unroll
    for (int n = 0; n < 4; ++n) g1v[n] = *(const f32x4*)(modl + (size_t)b * 6144 + 2 * 1024 + n0 + wc * 64 + 16 * n + 4 * fq);
#pragma unroll
    for (int m = 0; m < 4; ++m)
#pragma unroll
      for (int n = 0; n < 4; ++n) {
        const size_t xo = (size_t)(m0 + wr * 64 + 16 * m + fr) * D + n0 + wc * 64 + 16 * n + 4 * fq;
        if (XB) xbv[m][n] = *(const u32x2*)(p.xb() + xo); else xvv[m][n] = *(const f32x4*)(xin + xo);
      }
#pragma unroll
    for (int m = 0; m < 4; ++m) {
      const int t = m0 + wr * 64 + 16 * m + fr;
#pragma unroll
      for (int n = 0; n < 4; ++n) {
        const int col = n0 + wc * 64 + 16 * n + 4 * fq;
        const f32x4 xv = XB ? (f32x4){bf_lo(xbv[m][n][0]), bf_hi(xbv[m][n][0]), bf_lo(xbv[m][n][1]), bf_hi(xbv[m][n][1])} : xvv[m][n];
        const f32x4 g1 = g1v[n];
        f32x4 o;
#pragma unroll
        for (int j = 0; j < 4; ++j) o[j] = xv[j] + g1[j] * (acc[m][n][j] * rs[m]);
        *(u32x2*)(p.x1() + (size_t)t * D + col) = (u32x2){pack2(o[0], o[1]), pack2(o[2], o[3])};
      }
    }
  }
}
__device__ __forceinline__ void phase_norm2_route(const MP& p, int l, char* smem) {
  const int tid = launder(threadIdx.x);
  const int wave = tid >> 6, lane = tid & 63;
  float* wrT = (float*)smem;
  for (int i = tid; i < 1024 * 4; i += NTHR) {
    const int k = i >> 2, e4 = (i & 3) * 4;
    const float4 v = *(const float4*)(p.in.w_router + (size_t)k * 16 + e4);
    wrT[(e4 + 0) * 1024 + k] = v.x; wrT[(e4 + 1) * 1024 + k] = v.y; wrT[(e4 + 2) * 1024 + k] = v.z; wrT[(e4 + 3) * 1024 + k] = v.w;
  }
  __syncthreads();
  const float* modl = p.mod() + (size_t)l * 8 * 6144;
  float rb[16];
#pragma unroll
  for (int e = 0; e < 16; ++e) rb[e] = p.in.router_bias[e];
  int* cntl = p.cnt() + l * 256;
  int my_t = -1, my_bucket = 0; float my_wlo = 0.f, my_whi = 0.f;
  const float* g2n = p.in.norm2_g + l * D;
  const TokRange trg = tok_range(wave);
  const int tstep = trg.step, tend = trg.end;
  int t = trg.t0;
  float4 xv[4];
  if (t < tend) {
#pragma unroll
    for (int i = 0; i < 4; ++i) { const u32x2 r = *(const u32x2*)(p.x1() + (size_t)t * D + lane * 4 + 256 * i); xv[i] = make_float4(bf_lo(r[0]), bf_hi(r[0]), bf_lo(r[1]), bf_hi(r[1])); }
  }
  for (int slot = 0; t < tend; t += tstep, ++slot) {
    const int b = t / S;
    float4 xn[4];
    const int tn = t + tstep < tend ? t + tstep : t;
#pragma unroll
    for (int i = 0; i < 4; ++i) { const u32x2 r = *(const u32x2*)(p.x1() + (size_t)tn * D + lane * 4 + 256 * i); xn[i] = make_float4(bf_lo(r[0]), bf_hi(r[0]), bf_lo(r[1]), bf_hi(r[1])); }
    float ss = 0.f;
#pragma unroll
    for (int i = 0; i < 4; ++i) ss += xv[i].x * xv[i].x + xv[i].y * xv[i].y + xv[i].z * xv[i].z + xv[i].w * xv[i].w;
    ss = wave_sum(ss);
    const float rinv = rsqrtf(ss * (1.f / D) + EPS);
    const float* sh = modl + (size_t)b * 6144 + 3 * 1024; const float* sc = modl + (size_t)b * 6144 + 4 * 1024;
    float hv[16];
#pragma unroll
    for (int i = 0; i < 4; ++i) {
      const int d = lane * 4 + 256 * i;
      const float4 gg = *(const float4*)(g2n + d), s1 = *(const float4*)(sc + d), s0 = *(const float4*)(sh + d);
      hv[4 * i + 0] = xv[i].x * rinv * gg.x * (1.f + s1.x) + s0.x;
      hv[4 * i + 1] = xv[i].y * rinv * gg.y * (1.f + s1.y) + s0.y;
      hv[4 * i + 2] = xv[i].z * rinv * gg.z * (1.f + s1.z) + s0.z;
      hv[4 * i + 3] = xv[i].w * rinv * gg.w * (1.f + s1.w) + s0.w;
      *(u32x2*)(p.h() + (size_t)t * D + d) = (u32x2){pack2(hv[4 * i], hv[4 * i + 1]), pack2(hv[4 * i + 2], hv[4 * i + 3])};
    }
    float a[16];
    const int loff = launder(lane * 4);
#pragma unroll
    for (int e = 0; e < 16; ++e) {
      float s = 0.f;
#pragma unroll
      for (int i = 0; i < 4; ++i) {
        const f32x4 w = *(const f32x4*)(wrT + e * 1024 + loff + 256 * i);
        s += hv[4 * i] * w[0] + hv[4 * i + 1] * w[1] + hv[4 * i + 2] * w[2] + hv[4 * i + 3] * w[3];
      }
      a[e] = s;
    }
    float lg[16];
#pragma unroll
    for (int e = 0; e < 16; ++e) lg[e] = wave_sum(a[e]);
    float mx = lg[0];
#pragma unroll
    for (int e = 1; e < 16; ++e) mx = fmaxf(mx, lg[e]);
    float pr[16], sel[16]; float sum = 0.f;
#pragma unroll
    for (int e = 0; e < 16; ++e) { pr[e] = __expf(lg[e] - mx); sum += pr[e]; }
    const float inv = 1.f / sum;
#pragma unroll
    for (int e = 0; e < 16; ++e) { pr[e] *= inv; sel[e] = pr[e] + rb[e]; }
    int gbest = 0; float gbs = -1e30f;
#pragma unroll
    for (int g = 0; g < 4; ++g) {
      float m1 = -1e30f, m2 = -1e30f;
#pragma unroll
      for (int j = 0; j < 4; ++j) { const float v = sel[g * 4 + j]; if (v > m1) { m2 = m1; m1 = v; } else if (v > m2) m2 = v; }
      const float gs = m1 + m2;
      if (gs > gbs) { gbs = gs; gbest = g; }
    }
    float s4[4], p4[4];
#pragma unroll
    for (int j = 0; j < 4; ++j) { s4[j] = sel[j]; p4[j] = pr[j]; }
#pragma unroll
    for (int g = 1; g < 4; ++g) if (g == gbest) {
#pragma unroll
      for (int j = 0; j < 4; ++j) { s4[j] = sel[g * 4 + j]; p4[j] = pr[g * 4 + j]; }
    }
    int i0 = 0; float b0 = s4[0];
#pragma unroll
    for (int j = 1; j < 4; ++j) if (s4[j] > b0) { b0 = s4[j]; i0 = j; }
    int i1 = -1; float bb1 = -1e30f;
#pragma unroll
    for (int j = 0; j < 4; ++j) if (j != i0 && s4[j] > bb1) { bb1 = s4[j]; i1 = j; }
    float p0 = 0.f, p1 = 0.f;
#pragma unroll
    for (int j = 0; j < 4; ++j) { if (j == i0) p0 = p4[j]; if (j == i1) p1 = p4[j]; }
    const float w0 = p0 / (p0 + p1), w1 = p1 / (p0 + p1);
    const int lo = i0 < i1 ? i0 : i1, hi = i0 < i1 ? i1 : i0;
    const float wlo = i0 < i1 ? w0 : w1, whi = i0 < i1 ? w1 : w0;
    const int pidx = (lo == 0) ? (hi - 1) : (lo == 1 ? (hi + 1) : 5);
    const int bucket = gbest * 6 + pidx;
    if (lane == slot) { my_t = t; my_bucket = bucket; my_wlo = wlo; my_whi = whi; }
#pragma unroll
    for (int i = 0; i < 4; ++i) xv[i] = xn[i];
  }
  if (my_t >= 0) {
    const int sl = my_bucket * NSUBL + (blockIdx.x & (NSUBL - 1));
    const int pos = atomicAdd(&cntl[sl], 1);
    p.list()[(size_t)sl * T + pos] = my_t;
    p.tokw()[my_t] = make_float2(my_wlo, my_whi);
  }
  __syncthreads();
}

__device__ __forceinline__ void bucket_experts2(int bucket, int& elo, int& ehi) {
  const int g = bucket / 6, pi = bucket % 6;
  const int lo = pi < 3 ? 0 : (pi < 5 ? 1 : 2);
  const int hi = pi < 3 ? pi + 1 : (pi < 5 ? pi - 1 : 3);
  elo = g * 4 + lo; ehi = g * 4 + hi;
}
__device__ __forceinline__ void moe_map_build(const int* cnt, int* mm, int tid) {
  if (tid < NBUCKET) {
    int acc = 0;
#pragma unroll
    for (int x = 0; x < NSUBL; ++x) { mm[32 + 16 * tid + x] = acc; acc += cnt[tid * NSUBL + x]; }
    mm[32 + 16 * tid + 8] = acc;
  }
  __syncthreads();
  if (tid == 0) {
    int acc = 0;
    for (int bk = 0; bk < NBUCKET; ++bk) { mm[bk] = acc; acc += (mm[32 + 16 * bk + 8] + TM - 1) / TM; }
    mm[NBUCKET] = acc;
  }
  __syncthreads();
}
__device__ __forceinline__ void moe_find_tile(const int* mm, int mt, int& bucket, int& tib, int& nrow) {
  int bk = 0;
#pragma unroll
  for (int j = 1; j < NBUCKET; ++j) bk += (mt >= mm[j]) ? 1 : 0;
  bucket = bk; tib = mt - mm[bk]; nrow = mm[32 + 16 * bk + 8] - tib * TM;
}
__device__ __forceinline__ int moe_token(const int* list, const int* mm, int bk, int q) {
  const int* sp = mm + 32 + 16 * bk;
  int x = 0, s = 0;
#pragma unroll
  for (int j = 1; j < NSUBL; ++j) { const int v = sp[j]; const bool ge = q >= v; x += ge ? 1 : 0; s = ge ? v : s; }
  return list[(size_t)(bk * NSUBL + x) * T + (q - s)];
}

__device__ __forceinline__ void phase_moe_gu(const MP& p, int l, char* smem) {
  const int tid = launder(threadIdx.x), lane = tid & 63, wave = tid >> 6, wr = wave >> 1, wc = wave & 1, fr = lane & 15, fq = lane >> 4;
  const int r0 = tid >> 3;
  int* mm = (int*)(smem + SMEM_MM);
  moe_map_build(p.cnt() + l * 256, mm, tid);
  const int nmt = mm[NBUCKET];
  const int ntiles = nmt * 16;
  auto make = [&](int tile, GemmTile& g) {
    const int mt = tile >> 4, nt = tile & 15;
    int bucket, tib, nrow;
    moe_find_tile(mm, mt, bucket, tib, nrow);
    int elo, ehi; bucket_experts2(bucket, elo, ehi);
    const int e = nt < 8 ? elo : ehi, f0 = (nt & 7) * 64;
    g.A0 = p.h(); g.A1 = p.h(); g.lda = D; g.ksA = D; g.K = D;
    const bf16_t* Wg = p.WgT() + ((size_t)(l * NE + e) * DFF + f0) * D;
    const bf16_t* Wu = p.WuT() + ((size_t)(l * NE + e) * DFF + f0) * D;
#pragma unroll
    for (int i = 0; i < 4; ++i) {
      const int r = r0 + 32 * i;
      g.arow[i] = moe_token(p.list(), mm, bucket, tib * TM + (r < nrow ? r : nrow - 1));
    }
    g.Blo0 = Wg; g.Bhi0 = Wu; g.Blo1 = Wg; g.Bhi1 = Wu;
    g.ldb = D; g.ksB = D; g.rot = ROT_OF(bucket, nt);
  };
  GemmTile g, gn; bool pre = false;
  const TileMap tmap = tm_init(nmt, 16);
  { const int t0 = tm_tile(tmap, 0); if (t0 >= 0) { make(t0, g); gn = g; } }
  for (int jt = 0; ; ++jt) {
    const int tile = tm_tile(tmap, jt); if (tile < 0) break;
    const int mt = tile >> 4, nt = tile & 15;
    int bucket, tib, nrow;
    moe_find_tile(mm, mt, bucket, tib, nrow);
    const int f0 = (nt & 7) * 64;
    const int nxt = tm_tile(tmap, jt + 1); const bool hasn = nxt >= 0;
    if (hasn) make(nxt, gn);
    float wv[4];
#pragma unroll
    for (int m = 0; m < 4; ++m) {
      const int r = wr * 64 + 16 * m + fr;
      const float2 ww = p.tokw()[moe_token(p.list(), mm, bucket, tib * TM + (r < nrow ? r : nrow - 1))];
      wv[m] = r < nrow ? (nt < 8 ? ww.x : ww.y) : 0.f;
    }
    f32x4 acc[4][4];
    gemm_mainloop<true>(g, gn, hasn, pre, smem, acc);
    pre = hasn; g = gn;
#pragma unroll
    for (int m = 0; m < 4; ++m) {
      const int r = wr * 64 + 16 * m + fr;
      const float w = wv[m];
      bf16_t* dst = p.act() + (size_t)(mt * TM + r) * D + (nt < 8 ? 0 : 512) + f0 + wc * 32 + 4 * fq;
#pragma unroll
      for (int n = 0; n < 2; ++n) {
        float o[4];
#pragma unroll
        for (int j = 0; j < 4; ++j) { const float gv = acc[m][n][j], uv = acc[m][n + 2][j]; o[j] = gv * __builtin_amdgcn_rcpf(1.f + __expf(-gv)) * uv * w; }
        *(u32x2*)(dst + 16 * n) = (u32x2){pack2(o[0], o[1]), pack2(o[2], o[3])};
      }
    }
  }
}

template <bool XBOUT>
__device__ __forceinline__ void phase_moe_down(const MP& p, int l, char* smem) {
  const int tid = launder(threadIdx.x), lane = tid & 63, wave = tid >> 6, wr = wave >> 1, wc = wave & 1, fr = lane & 15, fq = lane >> 4;
  const int r0 = tid >> 3;
  int* mm = (int*)(smem + SMEM_MM);
  moe_map_build(p.cnt() + l * 256, mm, tid);
  const float* modl = p.mod() + (size_t)l * 8 * 6144;
  const int nmt = mm[NBUCKET];
  const int ntiles = nmt * 8;
  auto make = [&](int tile, GemmTile& g) {
    const int mt = tile >> 3, n0 = (tile & 7) * 128;
    int bucket, tib, nrow;
    moe_find_tile(mm, mt, bucket, tib, nrow);
    int elo, ehi; bucket_experts2(bucket, elo, ehi);
    g.A0 = p.act(); g.A1 = p.act(); g.lda = D; g.ksA = D; g.K = D;
    const bf16_t* Wlo = p.WdT() + ((size_t)(l * NE + elo) * D + n0) * DFF;
    const bf16_t* Whi = p.WdT() + ((size_t)(l * NE + ehi) * D + n0) * DFF;
#pragma unroll
    for (int i = 0; i < 4; ++i) {
      g.arow[i] = mt * TM + r0 + 32 * i;
    }
    g.Blo0 = Wlo; g.Bhi0 = Wlo + (size_t)64 * DFF; g.Blo1 = Whi; g.Bhi1 = Whi + (size_t)64 * DFF;
    g.ldb = DFF; g.ksB = DFF; g.rot = ROT_OF(bucket, tile & 7);
  };
  GemmTile g, gn; bool pre = false;
  const TileMap tmap = tm_init(nmt, 8);
  { const int t0 = tm_tile(tmap, 0); if (t0 >= 0) { make(t0, g); gn = g; } }
  for (int jt = 0; ; ++jt) {
    const int tile = tm_tile(tmap, jt); if (tile < 0) break;
    const int mt = tile >> 3, nt = tile & 7, n0 = nt * 128;
    int bucket, tib, nrow;
    moe_find_tile(mm, mt, bucket, tib, nrow);
    const int nxt = tm_tile(tmap, jt + 1); const bool hasn = nxt >= 0;
    if (hasn) make(nxt, gn);
    int tkv[4];
#pragma unroll
    for (int m = 0; m < 4; ++m) {
      const int r = wr * 64 + 16 * m + fr;
      tkv[m] = moe_token(p.list(), mm, bucket, tib * TM + (r < nrow ? r : nrow - 1));
    }
    f32x4 acc[4][4];
    gemm_mainloop<false>(g, gn, hasn, pre, smem, acc);
    pre = hasn; g = gn;
    u32x2 xrv[4][4]; f32x4 g2v[4][4];
#pragma unroll
    for (int m = 0; m < 4; ++m)
#pragma unroll
      for (int n = 0; n < 4; ++n) {
        const int col = n0 + wc * 64 + 16 * n + 4 * fq;
        xrv[m][n] = *(const u32x2*)(p.x1() + (size_t)tkv[m] * D + col);
        g2v[m][n] = *(const f32x4*)(modl + (size_t)(tkv[m] / S) * 6144 + 5 * 1024 + col);
      }
#pragma unroll
    for (int m = 0; m < 4; ++m) {
      const int r = wr * 64 + 16 * m + fr;
      const int tk = tkv[m];
      f32x4 o[4];
#pragma unroll
      for (int n = 0; n < 4; ++n) {
        const u32x2 xr = xrv[m][n];
        const f32x4 xv = {bf_lo(xr[0]), bf_hi(xr[0]), bf_lo(xr[1]), bf_hi(xr[1])};
        const f32x4 g2 = g2v[m][n];
#pragma unroll
        for (int j = 0; j < 4; ++j) o[n][j] = xv[j] + g2[j] * acc[m][n][j];
      }
      if (r < nrow) {
#pragma unroll
        for (int n = 0; n < 4; ++n) {
          const size_t oo = (size_t)tk * D + n0 + wc * 64 + 16 * n + 4 * fq;
          if (XBOUT) *(u32x2*)(p.xb() + oo) = (u32x2){pack2(o[n][0], o[n][1]), pack2(o[n][2], o[n][3])};
          else *(f32x4*)(p.out + oo) = o[n];
        }
      }
    }
  }
}
#define XB_TMO      128
#define XB_XCNT(j)  (256  + 64 * (j))
#define XB_XSUB(j)  (1280 + 64 * (j))
#define XB_XGEN(j)  (2304 + 64 * (j))
#define XB_TOP      3328
#define XB_TOPGEN   3392
#define XCD_BAR_WORDS 3456
#define XB_SPIN_CAP (1u << 22)
#define LAS __attribute__((address_space(3)))

__device__ __forceinline__ unsigned xb_ld(unsigned* p)              { return __hip_atomic_load(p, __ATOMIC_RELAXED, __HIP_MEMORY_SCOPE_AGENT); }
__device__ __forceinline__ unsigned xb_add(unsigned* p, unsigned v) { return __hip_atomic_fetch_add(p, v, __ATOMIC_RELAXED, __HIP_MEMORY_SCOPE_AGENT); }
__device__ __forceinline__ unsigned xb_xcc_id() { return (unsigned)__builtin_amdgcn_s_getreg((3 << 11) | 20) & 0xFu; }
#define XB_SPIN(cond, bar) do { unsigned _sp = 0; while (cond) { __builtin_amdgcn_s_sleep(1); \
    if ((++_sp & 255u) == 0u) { if (xb_ld(&(bar)[XB_TMO])) break; if (_sp > XB_SPIN_CAP) { atomicAdd(&(bar)[XB_TMO], 1u); break; } } } } while (0)

struct XcdBarrier { unsigned* bar; unsigned x; volatile LAS unsigned* st; };

__device__ __forceinline__ XcdBarrier xcd_barrier_post(unsigned* bar, volatile LAS unsigned* st) {
  XcdBarrier b; b.bar = bar; b.x = xb_xcc_id(); b.st = st;
  if (threadIdx.x == 0) (void)xb_add(&bar[XB_XCNT(b.x)], 1u);
  return b;
}
__device__ __forceinline__ void xcd_barrier_complete(unsigned* bar, unsigned x, unsigned& nloc, unsigned& nx) {
  const unsigned G = gridDim.x * gridDim.y * gridDim.z;
  unsigned sum, cnt, mine, sp = 0u;
  for (;;) {
    sum = 0u; cnt = 0u; mine = 0u;
#pragma unroll
    for (unsigned j = 0; j < 16; ++j) { const unsigned c = xb_ld(&bar[XB_XCNT(j)]); sum += c; cnt += (c > 0u) ? 1u : 0u; mine = (j == x) ? c : mine; }
    if (sum == G) break;
    __builtin_amdgcn_s_sleep(1);
    if ((++sp & 255u) == 0u) { if (xb_ld(&bar[XB_TMO])) break; if (sp > XB_SPIN_CAP) { atomicAdd(&bar[XB_TMO], 1u); break; } }
  }
  nloc = mine > 0u ? mine : 1u; nx = cnt > 0u ? cnt : 1u;
}
__device__ __forceinline__ void xcd_barrier(const XcdBarrier& b) {
  asm volatile("s_waitcnt vmcnt(0)" ::: "memory");
  __syncthreads();
  if (threadIdx.x == 0) {
    unsigned* bar = b.bar;
    __builtin_amdgcn_s_waitcnt(0);
    unsigned nloc = b.st[0], nx = b.st[1];
    if (nloc == 0u) { xcd_barrier_complete(bar, b.x, nloc, nx); b.st[0] = nloc; b.st[1] = nx; }
    const unsigned old = xb_add(&bar[XB_XSUB(b.x)], 1u);
    const unsigned gen = old / nloc;
    if (old + 1u == (gen + 1u) * nloc) {
      __builtin_amdgcn_fence(__ATOMIC_RELEASE, "agent");
      asm volatile("s_waitcnt vmcnt(0)" ::: "memory");
      const unsigned og = xb_add(&bar[XB_TOP], 1u);
      const unsigned tg = og / nx;
      if (og + 1u == (tg + 1u) * nx) xb_add(&bar[XB_TOPGEN], 1u);
      else XB_SPIN(xb_ld(&bar[XB_TOPGEN]) == tg, bar);
      __builtin_amdgcn_fence(__ATOMIC_ACQUIRE, "agent");
      xb_add(&bar[XB_XGEN(b.x)], 1u);
      asm volatile("s_waitcnt vmcnt(0)" ::: "memory");
    } else {
      XB_SPIN(xb_ld(&bar[XB_XGEN(b.x)]) == gen, bar);
      __builtin_amdgcn_fence(__ATOMIC_ACQUIRE, "agent");
      asm volatile("s_waitcnt vmcnt(0)" ::: "memory");
    }
  }
  __syncthreads();
}

constexpr int NSUB = 9;

template <int L>
__device__ __forceinline__ void run_layer(const MP& p, char* smem, const XcdBarrier& xb, int ssm_wid, int idle_id, int ssm_lrank) {
  constexpr int l = L;
  const float* xin = L == 0 ? p.in.x : p.out;
  phase_norm1<(L > 0)>(p, l, xin);          xcd_barrier(xb);
  phase_inproj(p, l, smem);        xcd_barrier(xb);
  phase_ssm(p, l, smem, ssm_wid, ssm_lrank);
  {
    constexpr int TT_SMALL = TT_WIN + TT_GLU + TT_OUT;
    const int nidle = (int)__hip_atomic_load(p.claim() + 4097, __ATOMIC_RELAXED, __HIP_MEMORY_SCOPE_AGENT);
    if (nidle == 0) phase0_transposes(p, smem, L * TT_LAYER + TT_SMALL, (L + 1) * TT_LAYER, blockIdx.x, gridDim.x);
    else if (idle_id >= 0) phase0_transposes(p, smem, L * TT_LAYER + TT_SMALL, (L + 1) * TT_LAYER, launder_s(__builtin_amdgcn_readfirstlane(idle_id)), nidle);
  }
  xcd_barrier(xb);
#pragma unroll 1
  for (int step = 0; step < 2; ++step) {
    if ((step == 0) == (ssm_wid >= 0)) phase_glu(p, l, smem);
    else phase_attn(p, l);
  }
  xcd_barrier(xb);
  phase_out<(L > 0)>(p, l, smem, xin);      xcd_barrier(xb);
  phase_norm2_route(p, l, smem);   xcd_barrier(xb);
  phase_moe_gu(p, l, smem);        xcd_barrier(xb);
  phase_moe_down<(L + 1 < DEPTH)>(p, l, smem);
  if (L + 1 < DEPTH) xcd_barrier(xb);
}

__global__ void __launch_bounds__(NTHR, 2) mega(MP p) {
  __shared__ __attribute__((aligned(16))) char smem[65536 + 32 + 2048];
  unsigned* xb_words = (unsigned*)(smem + 65536);
  if (threadIdx.x < 8) xb_words[threadIdx.x] = 0u;
  __syncthreads();
  const XcdBarrier xb = xcd_barrier_post(p.bar(), (volatile LAS unsigned*)xb_words);
  if (threadIdx.x == 0) {
    const unsigned key = (xb_xcc_id() << 8) | ((unsigned)__builtin_amdgcn_s_getreg((7 << 11) | (8 << 6) | 4) & 0xffu);
    const unsigned rank = xb_add(p.claim() + key, 1u);
    xb_words[2] = rank == 0u ? xb_add(p.claim() + 4096, 1u) : 0xffffffffu;
    xb_words[3] = rank == 0u ? 0xffffffffu : xb_add(p.claim() + 4097, 1u);
    xb_words[4] = rank == 0u ? xb_add(p.claim() + 4104 + (blockIdx.x & 7), 1u) : 0xffffffffu;
  }
  __syncthreads();
  const int ssm_wid = (int)xb_words[2], idle_id = (int)xb_words[3], ssm_lrank = (int)xb_words[4];
  for (int it = blockIdx.x; it < P0_MISC; it += gridDim.x) phase0_item(p, it, smem);
  phase0_transposes(p, smem, 0, TT_WIN + TT_GLU + TT_OUT, blockIdx.x, gridDim.x);
  phase0_transposes(p, smem, TT_LAYER, TT_LAYER + TT_WIN + TT_GLU + TT_OUT, blockIdx.x, gridDim.x);
  xcd_barrier(xb);
  run_layer<0>(p, smem, xb, ssm_wid, idle_id, ssm_lrank);
  run_layer<1>(p, smem, xb, ssm_wid, idle_id, ssm_lrank);
  static_assert(DEPTH == 2, "two layers instantiated");
}

}

extern "C" void kernel_launch(void* const* d_in, const int* in_sizes, int n_in, void* d_out, int out_size, void* d_ws,
                              size_t ws_size, hipStream_t stream) {
  MP p; memset(&p, 0, sizeof(p));
  Ptrs& P = p.in;
  P.x = (const float*)d_in[0]; P.c = (const float*)d_in[1]; P.pos = (const int*)d_in[2];
  P.ada_w = (const float*)d_in[3]; P.ada_b = (const float*)d_in[4]; P.norm1_g = (const float*)d_in[5];
  P.w_in = (const float*)d_in[6]; P.q_norm_g = (const float*)d_in[7]; P.k_norm_g = (const float*)d_in[8];
  P.attn_sink = (const float*)d_in[9]; P.lam_re = (const float*)d_in[10]; P.lam_im = (const float*)d_in[11];
  P.b_re = (const float*)d_in[12]; P.b_im = (const float*)d_in[13]; P.c_re = (const float*)d_in[14]; P.c_im = (const float*)d_in[15];
  P.ssm_d = (const float*)d_in[16]; P.log_dt = (const float*)d_in[17]; P.w_glu = (const float*)d_in[18];
  P.attn_out_g = (const float*)d_in[19]; P.ssm_out_g = (const float*)d_in[20]; P.w_out = (const float*)d_in[21];
  P.norm2_g = (const float*)d_in[22]; P.w_router = (const float*)d_in[23]; P.router_bias = (const float*)d_in[24];
  P.w_gate = (const float*)d_in[25]; P.w_up = (const float*)d_in[26]; P.w_down = (const float*)d_in[27];
  p.out = (float*)d_out;

  p.ws = (char*)d_ws;
  if (WS_TOTAL > ws_size) { fprintf(stderr, "workspace too small: need %zu have %zu\n", (size_t)WS_TOTAL, ws_size); return; }
  (void)in_sizes; (void)n_in; (void)out_size;

  static int grid_blocks = 0;
  if (!grid_blocks) {
    int dev = 0, cus = 0, per_cu = 0;
    (void)hipGetDevice(&dev);
    (void)hipDeviceGetAttribute(&cus, hipDeviceAttributeMultiprocessorCount, dev);
    (void)hipOccupancyMaxActiveBlocksPerMultiprocessor(&per_cu, mega, NTHR, 0);
    if (per_cu > 2) per_cu = 2;
    if (per_cu < 1) per_cu = 1;
    grid_blocks = cus * per_cu;
  }
  (void)hipMemsetAsync(p.ws + OFF_BAR, 0, OFF_MOD - OFF_BAR, stream);
  void* args[] = {&p};
  hipError_t e = hipLaunchCooperativeKernel((void*)mega, dim3(grid_blocks), dim3(NTHR), args, 0, stream);
  if (e != hipSuccess) fprintf(stderr, "cooperative launch failed: %s (grid %d)\n", hipGetErrorString(e), grid_blocks);
}
```

```cpp
#include <hip/hip_runtime.h>
#include <hip/hip_cooperative_groups.h>
#include <stdint.h>
#include <cstdio>
#include <cstring>

namespace {
constexpr int D = 1024, NB = 8, S = 2048, T = NB * S, DEPTH = 2;
constexpr int AW = 512, HD = 64, NQ = 8, NKV = 2, INW = 1280;
constexpr int SG = 32, SCH = 16, SP = 64, SW = 512;
constexpr int NE = 16, DFF = 512;
constexpr int NBUCKET = 24;
constexpr float EPS = 1e-6f;

struct Ptrs {
  const float *x, *c; const int* pos; const float *ada_w, *ada_b, *norm1_g, *w_in, *q_norm_g, *k_norm_g, *attn_sink,
      *lam_re, *lam_im, *b_re, *b_im, *c_re, *c_im, *ssm_d, *log_dt, *w_glu, *attn_out_g, *ssm_out_g, *w_out, *norm2_g,
      *w_router, *router_bias, *w_gate, *w_up, *w_down;
};

__device__ __forceinline__ float row_sum32_dpp(float v) {
  v += __int_as_float(__builtin_amdgcn_update_dpp(0, __float_as_int(v), 0xB1, 0xF, 0xF, true));
  v += __int_as_float(__builtin_amdgcn_update_dpp(0, __float_as_int(v), 0x4E, 0xF, 0xF, true));
  v += __int_as_float(__builtin_amdgcn_update_dpp(0, __float_as_int(v), 0x141, 0xF, 0xF, true));
  v += __int_as_float(__builtin_amdgcn_update_dpp(0, __float_as_int(v), 0x140, 0xF, 0xF, true));
  v += __int_as_float(__builtin_amdgcn_update_dpp(0, __float_as_int(v), 0x142, 0xA, 0xF, false));
  return v;
}
__device__ __forceinline__ float wave_sum(float v) {
  v = row_sum32_dpp(v);
  return __int_as_float(__builtin_amdgcn_readlane(__float_as_int(v), 31)) + __int_as_float(__builtin_amdgcn_readlane(__float_as_int(v), 63));
}
__device__ __forceinline__ float xhalf_sum(float v) {
  const auto r = __builtin_amdgcn_permlane32_swap(__float_as_uint(v), __float_as_uint(v), false, false);
  return __uint_as_float(r[0]) + __uint_as_float(r[1]);
}
__device__ __forceinline__ float xhalf_max(float v) {
  const auto r = __builtin_amdgcn_permlane32_swap(__float_as_uint(v), __float_as_uint(v), false, false);
  return fmaxf(__uint_as_float(r[0]), __uint_as_float(r[1]));
}

#ifndef ROT_OF
#define ROT_OF(mt, nt) ((mt) & 15)
#endif

typedef unsigned short bf16_t;
typedef short bf16x8 __attribute__((ext_vector_type(8)));
typedef float f32x4 __attribute__((ext_vector_type(4)));
typedef float f32x16 __attribute__((ext_vector_type(16)));
typedef float f32x2 __attribute__((ext_vector_type(2)));
typedef __bf16 bf16x2_t __attribute__((ext_vector_type(2)));
typedef unsigned u32x4 __attribute__((ext_vector_type(4)));
typedef unsigned u32x2 __attribute__((ext_vector_type(2)));

constexpr int NTHR = 256;
constexpr int TM = 128;
constexpr int MAXMT = T / TM + NBUCKET;
constexpr int NSUBL = 8;
constexpr int SMEM_MM = 65536 + 32;

__device__ __forceinline__ unsigned pack2(float lo, float hi) {
  f32x2 v = {lo, hi};
  return __builtin_bit_cast(unsigned, __builtin_convertvector(v, bf16x2_t));
}
__device__ __forceinline__ int launder(int x) { asm volatile("" : "+v"(x)); return x; }
__device__ __forceinline__ int launder_s(int x) { asm volatile("" : "+s"(x)); return x; }
__device__ __forceinline__ float bf_lo(unsigned u) { return __uint_as_float(u << 16); }
__device__ __forceinline__ float bf_hi(unsigned u) { return __uint_as_float(u & 0xffff0000u); }
__device__ __forceinline__ float bf1(bf16_t u) { return __uint_as_float(((unsigned)u) << 16); }

constexpr size_t al256(size_t x) { return (x + 255) & ~(size_t)255; }
constexpr size_t OFF_BAR = 0;
constexpr size_t OFF_CLAIM = OFF_BAR + al256(4096 * 4);
constexpr size_t OFF_MOD = OFF_CLAIM + al256(4096 * 4 + 256);
constexpr size_t OFF_CS = OFF_MOD + al256((size_t)DEPTH * 8 * 6144 * 4);
constexpr size_t OFF_CNT = OFF_CS + al256((size_t)T * 32 * 8);
constexpr size_t OFF_LIST = OFF_CNT + al256(256 * 4 * DEPTH);
constexpr size_t OFF_TOKW = OFF_LIST + al256((size_t)NBUCKET * NSUBL * T * 4);
constexpr size_t OFF_SSMB = OFF_TOKW + al256((size_t)T * 8);
constexpr size_t OFF_SSMC = OFF_SSMB + al256((size_t)DEPTH * SG * 128 * 16 * 2);
constexpr size_t OFF_SSML = OFF_SSMC + al256((size_t)DEPTH * SG * 16 * 128 * 2);
constexpr size_t OFF_WINT = OFF_SSML + al256((size_t)DEPTH * SG * SP * 2 * 4);
constexpr size_t OFF_WGLUT = OFF_WINT + al256((size_t)DEPTH * INW * D * 2);
constexpr size_t OFF_WOUTT = OFF_WGLUT + al256((size_t)DEPTH * SW * SW * 2);
constexpr size_t OFF_H = OFF_WOUTT + al256((size_t)DEPTH * D * D * 2);
constexpr size_t OFF_Q = OFF_H + al256((size_t)T * D * 2);
constexpr size_t OFF_K = OFF_Q + al256((size_t)T * AW * 2);
constexpr size_t OFF_VT = OFF_K + al256((size_t)T * 128 * 2);
constexpr size_t OFF_U = OFF_VT + al256((size_t)T * 128 * 2);
constexpr size_t OFF_ATTN = OFF_U + al256((size_t)T * SW * 2);
constexpr size_t OFF_ACT = OFF_Q;
static_assert((size_t)MAXMT * TM * D * 2 <= OFF_ATTN - OFF_Q, "act overlay too small");
constexpr size_t OFF_SSQA = OFF_ATTN + al256((size_t)T * AW * 2);
constexpr size_t OFF_Y = OFF_SSQA + al256((size_t)T * 8 * 4);
constexpr size_t OFF_SSM = OFF_Y + al256((size_t)T * SW * 2);
constexpr size_t OFF_SSQS = OFF_SSM + al256((size_t)T * SW * 2);
constexpr size_t OFF_X1 = OFF_SSQS + al256((size_t)T * 8 * 4);
constexpr size_t OFF_WGT = OFF_X1 + al256((size_t)T * D * 4);
constexpr size_t OFF_WUT = OFF_WGT + al256((size_t)DEPTH * NE * DFF * D * 2);
constexpr size_t OFF_WDT = OFF_WUT + al256((size_t)DEPTH * NE * DFF * D * 2);
constexpr size_t OFF_WRF = OFF_WDT + al256((size_t)DEPTH * NE * DFF * D * 2);
constexpr size_t WS_TOTAL = OFF_WRF + al256((size_t)32 * 2 * 64 * 16);

struct MP {
  Ptrs in;
  float* out;
  char* ws;
  __device__ __forceinline__ unsigned* bar() const { return (unsigned*)(ws + OFF_BAR); }
  __device__ __forceinline__ unsigned* claim() const { return (unsigned*)(ws + OFF_CLAIM); }
  __device__ __forceinline__ float* mod() const { return (float*)(ws + OFF_MOD); }
  __device__ __forceinline__ float2* cs() const { return (float2*)(ws + OFF_CS); }
  __device__ __forceinline__ int* cnt() const { return (int*)(ws + OFF_CNT); }
  __device__ __forceinline__ int* list() const { return (int*)(ws + OFF_LIST); }
  __device__ __forceinline__ float2* tokw() const { return (float2*)(ws + OFF_TOKW); }
  __device__ __forceinline__ bf16_t* ssmB() const { return (bf16_t*)(ws + OFF_SSMB); }
  __device__ __forceinline__ bf16_t* ssmC() const { return (bf16_t*)(ws + OFF_SSMC); }
  __device__ __forceinline__ float* ssmL() const { return (float*)(ws + OFF_SSML); }
  __device__ __forceinline__ bf16_t* WinT() const { return (bf16_t*)(ws + OFF_WINT); }
  __device__ __forceinline__ bf16_t* WgluT() const { return (bf16_t*)(ws + OFF_WGLUT); }
  __device__ __forceinline__ bf16_t* WoutT() const { return (bf16_t*)(ws + OFF_WOUTT); }
  __device__ __forceinline__ bf16_t* WgT() const { return (bf16_t*)(ws + OFF_WGT); }
  __device__ __forceinline__ bf16_t* WuT() const { return (bf16_t*)(ws + OFF_WUT); }
  __device__ __forceinline__ bf16_t* WdT() const { return (bf16_t*)(ws + OFF_WDT); }
  __device__ __forceinline__ bf16_t* h() const { return (bf16_t*)(ws + OFF_H); }
  __device__ __forceinline__ bf16_t* q() const { return (bf16_t*)(ws + OFF_Q); }
  __device__ __forceinline__ bf16_t* k() const { return (bf16_t*)(ws + OFF_K); }
  __device__ __forceinline__ bf16_t* vT() const { return (bf16_t*)(ws + OFF_VT); }
  __device__ __forceinline__ bf16_t* u() const { return (bf16_t*)(ws + OFF_U); }
  __device__ __forceinline__ bf16_t* attn() const { return (bf16_t*)(ws + OFF_ATTN); }
  __device__ __forceinline__ bf16_t* y() const { return (bf16_t*)(ws + OFF_Y); }
  __device__ __forceinline__ bf16_t* ssm() const { return (bf16_t*)(ws + OFF_SSM); }
  __device__ __forceinline__ bf16_t* act() const { return (bf16_t*)(ws + OFF_ACT); }
  __device__ __forceinline__ float* ssqa() const { return (float*)(ws + OFF_SSQA); }
  __device__ __forceinline__ float* ssqs() const { return (float*)(ws + OFF_SSQS); }
  __device__ __forceinline__ u32x4* wrf() const { return (u32x4*)(ws + OFF_WRF); }
  __device__ __forceinline__ bf16_t* x1() const { return (bf16_t*)(ws + OFF_X1); }
  __device__ __forceinline__ bf16_t* xb() const { return (bf16_t*)(ws + OFF_X1 + (size_t)T * D * 2); }
};

constexpr int TT_WIN = 8 * 20, TT_GLU = 4 * 8, TT_OUT = 8 * 16, TT_EXP = 16 * 64;
constexpr int TT_LAYER = TT_WIN + TT_GLU + TT_OUT + 3 * TT_EXP;
constexpr int P0_MOD = DEPTH * 192;
constexpr int P0_TR = DEPTH * TT_LAYER;
constexpr int P0_CS = T * 32 / 256;
constexpr int P0_SSM = DEPTH * SG;
constexpr int P0_WRF = 32 * 64 / 256;
constexpr int P0_MISC = P0_MOD + P0_CS + P0_SSM + P0_WRF + 1;

__device__ __forceinline__ void phase0_item(const MP& p, int it, char* smem) {
  const int tid = launder(threadIdx.x);
  float* ldsf = (float*)smem;
  if (it < P0_MOD) {
    const int l = it / 192, j0 = (it % 192) * 32;
    float* sc = ldsf;
    float* red = ldsf + 8192;
    for (int i = tid; i < 8192; i += NTHR) { float v = p.in.c[i]; sc[i] = v / (1.f + __expf(-v)); }
    __syncthreads();
    const int kg = tid >> 3, cq = (tid & 7) * 4;
    float acc[8][4];
#pragma unroll
    for (int b = 0; b < 8; ++b)
#pragma unroll
      for (int j = 0; j < 4; ++j) acc[b][j] = 0.f;
    const float* w = p.in.ada_w + (size_t)l * 1024 * 6144 + j0 + cq;
#pragma unroll 2
    for (int k4 = 0; k4 < 8; ++k4) {
      const int k = kg * 32 + k4 * 4;
      float4 wv[4];
#pragma unroll
      for (int i = 0; i < 4; ++i) wv[i] = *(const float4*)(w + (size_t)(k + i) * 6144);
#pragma unroll
      for (int b = 0; b < 8; ++b) {
        const f32x4 s = *(const f32x4*)(sc + b * 1024 + k);
#pragma unroll
        for (int i = 0; i < 4; ++i) { acc[b][0] += s[i] * wv[i].x; acc[b][1] += s[i] * wv[i].y; acc[b][2] += s[i] * wv[i].z; acc[b][3] += s[i] * wv[i].w; }
      }
    }
#pragma unroll
    for (int b = 0; b < 8; ++b) *(float4*)(red + (kg * 8 + b) * 32 + cq) = make_float4(acc[b][0], acc[b][1], acc[b][2], acc[b][3]);
    __syncthreads();
    {
      const int b = tid >> 5, c = tid & 31;
      float v = 0.f;
#pragma unroll 8
      for (int g = 0; g < 32; ++g) v += red[(g * 8 + b) * 32 + c];
      p.mod()[(size_t)(l * 8 + b) * 6144 + j0 + c] = v + p.in.ada_b[l * 6144 + j0 + c];
    }
    __syncthreads();
    return;
  }
  it -= P0_MOD;
  if (it < P0_CS) {
    const int i = it * 256 + tid, t = i >> 5, f = i & 31;
    const float freq = __builtin_amdgcn_exp2f(-(float)f * (13.287712379549449f / 32.f));
    const float ang = (float)p.in.pos[t] * freq;
    const float rev = ang * 0.15915494309189535f;
    const float r = rev - floorf(rev);
    p.cs()[i] = make_float2(__builtin_amdgcn_cosf(r), __builtin_amdgcn_sinf(r));
    return;
  }
  it -= P0_CS;
  if (it < P0_SSM) {
    const int lg = it;
    if (tid < 64) {
      const int pp = tid;
      const float dt = expf(p.in.log_dt[lg]);
      const float lr = p.in.lam_re[lg * SP + pp], li = p.in.lam_im[lg * SP + pp];
      const float mag = expf(lr * dt);
      float sn, cn; sincosf(li * dt, &sn, &cn);
      const float ar = mag * cn, ai = mag * sn;
      const float den = lr * lr + li * li;
      const float fr = ((ar - 1.f) * lr + ai * li) / den, fi = (ai * lr - (ar - 1.f) * li) / den;
      p.ssmL()[(lg * SP + pp) * 2] = ar; p.ssmL()[(lg * SP + pp) * 2 + 1] = ai;
      unsigned wr[8], wi[8];
#pragma unroll
      for (int hh = 0; hh < 8; ++hh) {
        const float br0 = p.in.b_re[((size_t)lg * SP + pp) * SCH + 2 * hh], bi0 = p.in.b_im[((size_t)lg * SP + pp) * SCH + 2 * hh];
        const float br1 = p.in.b_re[((size_t)lg * SP + pp) * SCH + 2 * hh + 1], bi1 = p.in.b_im[((size_t)lg * SP + pp) * SCH + 2 * hh + 1];
        wr[hh] = pack2(fr * br0 - fi * bi0, fr * br1 - fi * bi1);
        wi[hh] = pack2(fr * bi0 + fi * br0, fr * bi1 + fi * br1);
      }
      u32x4* dr = (u32x4*)(p.ssmB() + ((size_t)lg * 128 + pp) * 16);
      u32x4* di = (u32x4*)(p.ssmB() + ((size_t)lg * 128 + 64 + pp) * 16);
      dr[0] = (u32x4){wr[0], wr[1], wr[2], wr[3]}; dr[1] = (u32x4){wr[4], wr[5], wr[6], wr[7]};
      di[0] = (u32x4){wi[0], wi[1], wi[2], wi[3]}; di[1] = (u32x4){wi[4], wi[5], wi[6], wi[7]};
    }
    for (int o = tid; o < 16 * 64; o += NTHR) {
      const int hh = o >> 6, pp = o & 63;
      const float cr = p.in.c_re[(size_t)lg * SCH * SP + o], ci = p.in.c_im[(size_t)lg * SCH * SP + o];
      *(unsigned*)(p.ssmC() + ((size_t)lg * 16 + hh) * 128 + 2 * pp) = pack2(cr, -ci);
    }
    return;
  }
  it -= P0_SSM;
  if (it < P0_WRF) {
    const int i = it * 256 + tid, ks = i >> 6, ln = i & 63;
    const float* w = p.in.w_router + ((size_t)32 * ks + 8 * (ln >> 4)) * NE + (ln & 15);
    unsigned hi[4], lo[4];
#pragma unroll
    for (int j = 0; j < 4; ++j) {
      const float w0 = w[(2 * j) * NE], w1 = w[(2 * j + 1) * NE];
      hi[j] = pack2(w0, w1);
      lo[j] = pack2(w0 - bf_lo(hi[j]), w1 - bf_hi(hi[j]));
    }
    u32x4* dst = p.wrf() + ((size_t)ks * 2) * 64 + ln;
    dst[0] = (u32x4){hi[0], hi[1], hi[2], hi[3]}; dst[64] = (u32x4){lo[0], lo[1], lo[2], lo[3]};
    return;
  }
  for (int i = tid; i < 256 * DEPTH; i += NTHR) p.cnt()[i] = 0;
}

struct TrDesc { const float* src; bf16_t* dst; const float* gain; int N, K, k0, n0; };
__device__ __forceinline__ void tr_decode(const MP& p, int it, TrDesc& d) {
  const int l = it / TT_LAYER; int r = it % TT_LAYER;
  d.gain = nullptr;
  if (r < TT_WIN) { d.src = p.in.w_in + (size_t)l * D * INW; d.N = INW; d.dst = p.WinT() + (size_t)l * INW * D; d.K = D; d.k0 = (r / 20) * 128; d.n0 = (r % 20) * 64; return; }
  r -= TT_WIN;
  if (r < TT_GLU) { d.src = p.in.w_glu + (size_t)l * SW * SW; d.N = SW; d.dst = p.WgluT() + (size_t)l * SW * SW; d.K = SW; d.k0 = (r / 8) * 128; d.n0 = (r % 8) * 64; return; }
  r -= TT_GLU;
  if (r < TT_OUT) {
    d.k0 = (r / 16) * 128; d.n0 = (r % 16) * 64;
    d.gain = d.k0 < 512 ? (p.in.attn_out_g + l * AW) : (p.in.ssm_out_g + l * SW - 512);
    d.src = p.in.w_out + (size_t)l * D * D; d.N = D; d.dst = p.WoutT() + (size_t)l * D * D; d.K = D; return; }
  r -= TT_OUT;
  const int kind = r / TT_EXP; r %= TT_EXP;
  const int e = r / 64, tt = r % 64;
  if (kind == 0) { d.src = p.in.w_gate + (size_t)(l * NE + e) * D * DFF; d.N = DFF; d.dst = p.WgT() + (size_t)(l * NE + e) * DFF * D; d.K = D; d.k0 = (tt / 8) * 128; d.n0 = (tt % 8) * 64; return; }
  if (kind == 1) { d.src = p.in.w_up + (size_t)(l * NE + e) * D * DFF; d.N = DFF; d.dst = p.WuT() + (size_t)(l * NE + e) * DFF * D; d.K = D; d.k0 = (tt / 8) * 128; d.n0 = (tt % 8) * 64; return; }
  d.src = p.in.w_down + (size_t)(l * NE + e) * DFF * D; d.N = D; d.dst = p.WdT() + (size_t)(l * NE + e) * D * DFF; d.K = DFF; d.k0 = (tt / 16) * 128; d.n0 = (tt % 16) * 64;
}
__device__ __forceinline__ void phase0_transposes(const MP& p, char* smem, int first, int last, int brank, int nblk) {
  const int tid = launder(threadIdx.x);
  float* lds = (float*)smem;
  const int r = tid >> 4, c4 = (tid & 15) * 4;
  const int n = tid >> 2, kq = (tid & 3) * 32;
  TrDesc cur, nxt;
  float4 v[8]; float gg[8];
  auto load = [&](const TrDesc& d) {
#pragma unroll
    for (int i = 0; i < 8; ++i) v[i] = *(const float4*)(d.src + (size_t)(d.k0 + r + 16 * i) * d.N + d.n0 + c4);
    if (d.gain) {
#pragma unroll
      for (int i = 0; i < 8; ++i) gg[i] = d.gain[d.k0 + r + 16 * i];
    } else {
#pragma unroll
      for (int i = 0; i < 8; ++i) gg[i] = 1.f;
    }
  };
  int it = first + brank;
  if (it < last) { tr_decode(p, it, cur); load(cur); nxt = cur; }
  for (; it < last; it += nblk) {
#pragma unroll
    for (int i = 0; i < 8; ++i) {
      float* d = lds + (r + 16 * i) * 65 + c4;
      d[0] = v[i].x * gg[i]; d[1] = v[i].y * gg[i]; d[2] = v[i].z * gg[i]; d[3] = v[i].w * gg[i];
    }
    __syncthreads();
    const int nit = it + nblk;
    if (nit < last) { tr_decode(p, nit, nxt); load(nxt); }
    unsigned w[16];
#pragma unroll
    for (int j = 0; j < 16; ++j) w[j] = pack2(lds[(kq + 2 * j) * 65 + n], lds[(kq + 2 * j + 1) * 65 + n]);
    u32x4* dd = (u32x4*)(cur.dst + (size_t)(cur.n0 + n) * cur.K + cur.k0 + kq);
#pragma unroll
    for (int j = 0; j < 4; ++j) dd[j] = (u32x4){w[4 * j], w[4 * j + 1], w[4 * j + 2], w[4 * j + 3]};
    __syncthreads();
    cur = nxt;
  }
}

template <bool XB>
__device__ __forceinline__ void norm_token(const void* __restrict__ xrow, const float* __restrict__ g, const float* __restrict__ sh,
                                           const float* __restrict__ sc, bf16_t* __restrict__ hr, int lane, float (&hv)[16]) {
  float4 v[4]; float ss = 0.f;
#pragma unroll
  for (int i = 0; i < 4; ++i) {
    if (XB) { const u32x2 r = *(const u32x2*)((const bf16_t*)xrow + lane * 4 + 256 * i); v[i] = make_float4(bf_lo(r[0]), bf_hi(r[0]), bf_lo(r[1]), bf_hi(r[1])); }
    else v[i] = *(const float4*)((const float*)xrow + lane * 4 + 256 * i);
    ss += v[i].x * v[i].x + v[i].y * v[i].y + v[i].z * v[i].z + v[i].w * v[i].w;
  }
  ss = wave_sum(ss);
  const float rinv = rsqrtf(ss * (1.f / D) + EPS);
#pragma unroll
  for (int i = 0; i < 4; ++i) {
    const int d = lane * 4 + 256 * i;
    const float4 gg = *(const float4*)(g + d), s1 = *(const float4*)(sc + d), s0 = *(const float4*)(sh + d);
    hv[4 * i + 0] = v[i].x * rinv * gg.x * (1.f + s1.x) + s0.x;
    hv[4 * i + 1] = v[i].y * rinv * gg.y * (1.f + s1.y) + s0.y;
    hv[4 * i + 2] = v[i].z * rinv * gg.z * (1.f + s1.z) + s0.z;
    hv[4 * i + 3] = v[i].w * rinv * gg.w * (1.f + s1.w) + s0.w;
    *(u32x2*)(hr + d) = (u32x2){pack2(hv[4 * i], hv[4 * i + 1]), pack2(hv[4 * i + 2], hv[4 * i + 3])};
  }
}

struct TokRange { int t0, step, end; };
__device__ __forceinline__ TokRange tok_range(int wave) {
  TokRange r;
  if ((gridDim.x & 7) == 0) { const int xcd = blockIdx.x & 7, lb = blockIdx.x >> 3, nlb = gridDim.x >> 3; r.t0 = xcd * S + lb * 4 + wave; r.step = nlb * 4; r.end = (xcd + 1) * S; }
  else { r.t0 = blockIdx.x * 4 + wave; r.step = gridDim.x * 4; r.end = T; }
  return r;
}
template <bool XB>
__device__ __forceinline__ void phase_norm1(const MP& p, int l, const float* xin) {
  const int tid = launder(threadIdx.x);
  const int wave = tid >> 6, lane = tid & 63;
  const float* modl = p.mod() + (size_t)l * 8 * 6144;
  const TokRange tr = tok_range(wave);
  for (int t = tr.t0; t < tr.end; t += tr.step) {
    const int b = t / S; float hv[16];
    norm_token<XB>(XB ? (const void*)(p.xb() + (size_t)t * D) : (const void*)(xin + (size_t)t * D), p.in.norm1_g + l * D, modl + (size_t)b * 6144, modl + (size_t)b * 6144 + 1024, p.h() + (size_t)t * D, lane, hv);
  }
}

struct GemmTile {
  const bf16_t* A0; const bf16_t* A1; long lda; int ksA;
  int arow[4];
  const bf16_t* Blo0; const bf16_t* Bhi0;
  const bf16_t* Blo1; const bf16_t* Bhi1;
  long ldb; int ksB;
  int K; int rot;
};

__device__ __forceinline__ int lds_off(int row, int chunk) { return row * 128 + ((chunk ^ ((row >> 1) & 7)) << 4); }

template <bool BSPLIT, bool MID>
__device__ __forceinline__ void gemm_mainloop_t(const GemmTile& g, const GemmTile& gnext, bool hasnext, bool preloaded, char* smem, f32x4 (&acc)[4][4],
                                                int ktmid, const float (&mids)[4]) {
  const int tid = launder(threadIdx.x), lane = tid & 63, wave = tid >> 6, wr = wave >> 1, wc = wave & 1, fr = lane & 15, fq = lane >> 4;
  const int r0 = tid >> 3, c8 = tid & 7;
  const int csrc = (c8 ^ ((r0 >> 1) & 7)) * 8;
  const int wbase = __builtin_amdgcn_readfirstlane(wave) * 1024;
#pragma unroll
  for (int m = 0; m < 4; ++m)
#pragma unroll
    for (int n = 0; n < 4; ++n) acc[m][n] = (f32x4){0.f, 0.f, 0.f, 0.f};
  auto stage = [&](const GemmTile& gg, int kt, int buf) {
    const int kk = ((kt + gg.rot) & (gg.K / 64 - 1)) * 64;
    const bf16_t* Ab = kk < gg.ksA ? gg.A0 + kk : gg.A1 + (kk - gg.ksA);
    const bool bs = kk < gg.ksB; const int kb = bs ? kk : kk - gg.ksB;
    char* As = smem + buf * 32768 + wbase; char* Bs = As + 16384;
#pragma unroll
    for (int i = 0; i < 4; ++i) {
      __builtin_amdgcn_global_load_lds((const void*)(Ab + (size_t)gg.arow[i] * gg.lda + csrc), (void*)(As + i * 4096), 16, 0, 0);
      const bf16_t* Bb = bs ? (i < 2 ? gg.Blo0 : gg.Bhi0) : (i < 2 ? gg.Blo1 : gg.Bhi1);
      __builtin_amdgcn_global_load_lds((const void*)(Bb + (size_t)(r0 + 32 * (i & 1)) * gg.ldb + kb + csrc), (void*)(Bs + i * 4096), 16, 0, 0);
    }
  };
  const int nk = g.K / 64;
  if (!preloaded) {
    stage(g, 0, 0);
    asm volatile("s_waitcnt vmcnt(0)" ::: "memory");
    __syncthreads();
  }
  for (int kt = 0; kt < nk; ++kt) {
    if (kt + 1 < nk) stage(g, kt + 1, (kt + 1) & 1);
    else if (hasnext) stage(gnext, 0, 0);
    if (MID && kt == ktmid) {
#pragma unroll
      for (int m = 0; m < 4; ++m)
#pragma unroll
        for (int n = 0; n < 4; ++n) acc[m][n] *= mids[m];
    }
    const char* As = smem + (kt & 1) * 32768; const char* Bs = As + 16384;
    {
      bf16x8 af[2][4], bfr[2][4];
#pragma unroll
      for (int ks = 0; ks < 2; ++ks) {
#pragma unroll
        for (int m = 0; m < 4; ++m) af[ks][m] = *(const bf16x8*)(As + lds_off(wr * 64 + 16 * m + fr, ks * 4 + fq));
#pragma unroll
        for (int n = 0; n < 4; ++n) {
          const int brow = BSPLIT ? ((n >> 1) * 64 + wc * 32 + (n & 1) * 16 + fr) : (wc * 64 + 16 * n + fr);
          bfr[ks][n] = *(const bf16x8*)(Bs + lds_off(brow, ks * 4 + fq));
        }
      }
#pragma unroll
      for (int ks = 0; ks < 2; ++ks)
#pragma unroll
        for (int m = 0; m < 4; ++m)
#pragma unroll
          for (int n = 0; n < 4; ++n) acc[m][n] = __builtin_amdgcn_mfma_f32_16x16x32_bf16(bfr[ks][n], af[ks][m], acc[m][n], 0, 0, 0);
      __builtin_amdgcn_sched_group_barrier(0x100, 8, 0);
#pragma unroll
      for (int i = 0; i < 8; ++i) { __builtin_amdgcn_sched_group_barrier(0x008, 2, 0); __builtin_amdgcn_sched_group_barrier(0x100, 1, 0); }
      __builtin_amdgcn_sched_group_barrier(0x008, 16, 0);
    }
    __builtin_amdgcn_sched_barrier(0);
    asm volatile("s_waitcnt vmcnt(0)" ::: "memory");
    __syncthreads();
  }
}
template <bool BSPLIT>
__device__ __forceinline__ void gemm_mainloop(const GemmTile& g, const GemmTile& gnext, bool hasnext, bool preloaded, char* smem, f32x4 (&acc)[4][4]) {
  const float dummy[4] = {1.f, 1.f, 1.f, 1.f};
  gemm_mainloop_t<BSPLIT, false>(g, gnext, hasnext, preloaded, smem, acc, -1, dummy);
}

struct TileMap { int base, ntl, lb, nlb; };
__device__ __forceinline__ TileMap tm_init(int nMt, int nNt) {
  TileMap t;
  if ((gridDim.x & 7) == 0) {
    const int xcd = blockIdx.x & 7;
    t.lb = blockIdx.x >> 3; t.nlb = gridDim.x >> 3;
    const int mlo = (nMt * xcd) >> 3, mhi = (nMt * (xcd + 1)) >> 3;
    t.base = mlo * nNt; t.ntl = (mhi - mlo) * nNt;
  } else { t.lb = blockIdx.x; t.nlb = gridDim.x; t.base = 0; t.ntl = nMt * nNt; }
  return t;
}
__device__ __forceinline__ int tm_tile(const TileMap& t, int j) { const int li = t.lb + t.nlb * j; return li < t.ntl ? t.base + li : -1; }
__device__ __forceinline__ void phase_inproj(const MP& p, int l, char* smem) {
  const int tid = launder(threadIdx.x), lane = tid & 63, wave = tid >> 6, wr = wave >> 1, wc = wave & 1, fr = lane & 15, fq = lane >> 4;
  const int r0 = tid >> 3;
  const int ntiles = (T / 128) * (INW / 128);
  const bf16_t* W = p.WinT() + (size_t)l * INW * D;
  auto make = [&](int tile, GemmTile& g) {
    const int m0 = (tile / 10) * 128, n0 = (tile % 10) * 128;
    g.A0 = p.h(); g.A1 = p.h(); g.lda = D; g.ksA = D; g.K = D;
#pragma unroll
    for (int i = 0; i < 4; ++i) g.arow[i] = m0 + r0 + 32 * i;
    g.Blo0 = W + (size_t)n0 * D; g.Bhi0 = g.Blo0 + (size_t)64 * D; g.Blo1 = g.Blo0; g.Bhi1 = g.Bhi0;
    g.ldb = D; g.ksB = D; g.rot = ROT_OF(tile / 10, tile % 10);
  };
  GemmTile g, gn; bool pre = false;
  const TileMap tmap = tm_init(T / 128, INW / 128);
  { const int t0 = tm_tile(tmap, 0); if (t0 >= 0) { make(t0, g); gn = g; } }
  for (int jt = 0; ; ++jt) {
    const int tile = tm_tile(tmap, jt); if (tile < 0) break;
    const int mt = tile / 10, nt = tile % 10, m0 = mt * 128;
    const int nxt = tm_tile(tmap, jt + 1); const bool hasn = nxt >= 0;
    if (hasn) make(nxt, gn);
    f32x4 acc[4][4];
    gemm_mainloop<false>(g, gn, hasn, pre, smem, acc);
    pre = hasn; g = gn;
    const int rowb = m0 + wr * 64 + fr;
    if (nt <= 4) {
      const float* gv = (nt < 4 ? p.in.q_norm_g : p.in.k_norm_g) + l * HD;
      const float scl = nt < 4 ? 0.125f : 1.f;
      f32x4 g1[2], g2[2];
#pragma unroll
      for (int n = 0; n < 2; ++n) { g1[n] = *(const f32x4*)(gv + 16 * n + 4 * fq); g2[n] = *(const f32x4*)(gv + 32 + 16 * n + 4 * fq); }
      f32x4 csv[4][2][2];
#pragma unroll
      for (int m = 0; m < 4; ++m)
#pragma unroll
        for (int n = 0; n < 2; ++n) {
          const float* cp = (const float*)p.cs() + ((size_t)(rowb + 16 * m) * 32 + 16 * n + 4 * fq) * 2;
          csv[m][n][0] = *(const f32x4*)cp; csv[m][n][1] = *(const f32x4*)(cp + 4);
        }
#pragma unroll
      for (int m = 0; m < 4; ++m) {
        const int t = rowb + 16 * m;
        float ss = 0.f;
#pragma unroll
        for (int n = 0; n < 4; ++n)
#pragma unroll
          for (int j = 0; j < 4; ++j) ss += acc[m][n][j] * acc[m][n][j];
        ss += __shfl_xor(ss, 16); ss += __shfl_xor(ss, 32);
        const float rinv = rsqrtf(ss * (1.f / 64.f) + EPS) * scl;
        bf16_t* dst = nt < 4 ? (p.q() + (size_t)t * AW + (2 * nt + wc) * 64) : (p.k() + (size_t)t * 128 + wc * 64);
#pragma unroll
        for (int n = 0; n < 2; ++n) {
          const int c = 16 * n + 4 * fq;
          const f32x4 csa = csv[m][n][0], csb = csv[m][n][1];
          const float cn[4] = {csa[0], csa[2], csb[0], csb[2]}, sn[4] = {csa[1], csa[3], csb[1], csb[3]};
          float o1[4], o2[4];
#pragma unroll
          for (int j = 0; j < 4; ++j) {
            const float x1 = acc[m][n][j] * rinv * g1[n][j], x2 = acc[m][n + 2][j] * rinv * g2[n][j];
            o1[j] = x1 * cn[j] - x2 * sn[j]; o2[j] = x2 * cn[j] + x1 * sn[j];
          }
          *(u32x2*)(dst + c) = (u32x2){pack2(o1[0], o1[1]), pack2(o1[2], o1[3])};
          *(u32x2*)(dst + 32 + c) = (u32x2){pack2(o2[0], o2[1]), pack2(o2[2], o2[3])};
        }
      }
    } else if (nt == 5) {
      const int b = m0 / S;
#pragma unroll
      for (int m = 0; m < 4; ++m) {
        const int s = (rowb + 16 * m) % S;
        const int k16 = s & 15;
        const int sp = (s & ~15) | (k16 & 3) | (((k16 >> 3) & 1) << 2) | (((k16 >> 2) & 1) << 3);
#pragma unroll
        for (int n = 0; n < 4; ++n)
#pragma unroll
          for (int j = 0; j < 4; ++j) {
            const int d = 16 * n + 4 * fq + j;
            p.vT()[((size_t)(b * 2 + wc) * 64 + d) * S + sp] = (bf16_t)(pack2(acc[m][n][j], 0.f) & 0xffffu);
          }
      }
    } else {
#pragma unroll
      for (int m = 0; m < 4; ++m) {
        const int t = rowb + 16 * m;
#pragma unroll
        for (int n = 0; n < 4; ++n)
          *(u32x2*)(p.u() + (size_t)t * SW + (nt - 6) * 128 + wc * 64 + 16 * n + 4 * fq) = (u32x2){pack2(acc[m][n][0], acc[m][n][1]), pack2(acc[m][n][2], acc[m][n][3])};
      }
    }
  }
}

__device__ __forceinline__ int crow32(int r, int hf) { return (r & 3) + 8 * (r >> 2) + 4 * hf; }
__device__ __forceinline__ void attn_task(const MP& p, int l, int task, int lane) {
  lane = launder(lane);
  task = __builtin_amdgcn_readfirstlane(task);
  const int h = task & 7, qt = (task >> 3) & 63, b = task >> 9, kvh = h >> 2;
  const int s0 = qt * 32, t0 = b * S + s0, ql = lane & 31, hf = lane >> 5;
  int kst[5];
#pragma unroll
  for (int kt = 0; kt < 5; ++kt) { const int ks = s0 - 128 + 32 * kt; kst[kt] = ks < 0 ? 0 : ks; }
  bf16x8 qf[4], kf[5][4];
#pragma unroll
  for (int st = 0; st < 4; ++st) qf[st] = *(const bf16x8*)(p.q() + (size_t)(t0 + ql) * AW + h * 64 + 16 * st + 8 * hf);
#pragma unroll
  for (int kt = 0; kt < 5; ++kt)
#pragma unroll
    for (int st = 0; st < 4; ++st) kf[kt][st] = *(const bf16x8*)(p.k() + (size_t)(b * S + kst[kt] + ql) * 128 + kvh * 64 + 8 * hf + 16 * st);
  f32x16 sc[5];
#pragma unroll
  for (int kt = 0; kt < 5; ++kt) {
#pragma unroll
    for (int r = 0; r < 16; ++r) sc[kt][r] = 0.f;
#pragma unroll
    for (int st = 0; st < 4; ++st) sc[kt] = __builtin_amdgcn_mfma_f32_32x32x16_bf16(kf[kt][st], qf[st], sc[kt], 0, 0, 0);
  }
  bf16x8 vb[5][2][2];
#pragma unroll
  for (int kt = 0; kt < 5; ++kt)
#pragma unroll
    for (int s = 0; s < 2; ++s)
#pragma unroll
      for (int dt = 0; dt < 2; ++dt)
        vb[kt][s][dt] = *(const bf16x8*)(p.vT() + ((size_t)(b * 2 + kvh) * 64 + 32 * dt + ql) * S + kst[kt] + 16 * s + 8 * hf);
  const float sink = p.in.attn_sink[l * NQ + h];
  float mx = sink;
#pragma unroll
  for (int kt = 0; kt < 5; ++kt) {
#pragma unroll
    for (int r = 0; r < 16; ++r) {
      const int kp = s0 - 128 + 32 * kt + crow32(r, hf);
      const int dk = kp - (s0 + ql);
      const bool valid = kp >= 0 && dk <= 0 && dk > -128;
      sc[kt][r] = valid ? sc[kt][r] : -1e30f;
      mx = fmaxf(mx, sc[kt][r]);
    }
  }
  mx = xhalf_max(mx);
  float lsum = 0.f;
#pragma unroll
  for (int kt = 0; kt < 5; ++kt) {
#pragma unroll
    for (int r = 0; r < 16; ++r) { const float e = __expf(sc[kt][r] - mx); sc[kt][r] = e; lsum += e; }
  }
  lsum = xhalf_sum(lsum);
  lsum += __expf(sink - mx);
  const float inv = 1.f / lsum;
  f32x16 o[2];
#pragma unroll
  for (int r = 0; r < 16; ++r) { o[0][r] = 0.f; o[1][r] = 0.f; }
#pragma unroll
  for (int kt = 0; kt < 5; ++kt) {
#pragma unroll
    for (int s = 0; s < 2; ++s) {
      u32x4 pw;
#pragma unroll
      for (int j = 0; j < 4; ++j) pw[j] = pack2(sc[kt][8 * s + 2 * j], sc[kt][8 * s + 2 * j + 1]);
      const bf16x8 pa = __builtin_bit_cast(bf16x8, pw);
#pragma unroll
      for (int dt = 0; dt < 2; ++dt) o[dt] = __builtin_amdgcn_mfma_f32_32x32x16_bf16(vb[kt][s][dt], pa, o[dt], 0, 0, 0);
    }
  }
  bf16_t* dst = p.attn() + (size_t)(t0 + ql) * AW + h * 64 + 4 * hf;
  float ssq = 0.f;
#pragma unroll
  for (int dt = 0; dt < 2; ++dt)
#pragma unroll
    for (int g4 = 0; g4 < 4; ++g4) {
      const float a0 = o[dt][4 * g4] * inv, a1 = o[dt][4 * g4 + 1] * inv, a2 = o[dt][4 * g4 + 2] * inv, a3 = o[dt][4 * g4 + 3] * inv;
      ssq += (a0 * a0 + a1 * a1) + (a2 * a2 + a3 * a3);
      *(u32x2*)(dst + 32 * dt + 8 * g4) = (u32x2){pack2(a0, a1), pack2(a2, a3)};
    }
  ssq = xhalf_sum(ssq);
  if (hf == 0) p.ssqa()[(size_t)(t0 + ql) * 8 + h] = ssq;
}
constexpr int SSEG = 4, SEGLEN = S / SSEG, SEGCH = SEGLEN / 32;

__device__ __forceinline__ void ssm_bu(const bf16x8& ua, const bf16x8 (&bB)[4], f32x16 (&bu)[4]) {
#pragma unroll
  for (int nt = 0; nt < 4; ++nt) {
#pragma unroll
    for (int r = 0; r < 16; ++r) bu[nt][r] = 0.f;
    bu[nt] = __builtin_amdgcn_mfma_f32_32x32x16_bf16(ua, bB[nt], bu[nt], 0, 0, 0);
  }
  asm volatile("s_nop 15\n\ts_nop 7" : "+v"(bu[0]), "+v"(bu[1]), "+v"(bu[2]), "+v"(bu[3]));
#pragma unroll
  for (int r = 0; r < 16; ++r) {
    auto s0 = __builtin_amdgcn_permlane32_swap(__float_as_uint(bu[0][r]), __float_as_uint(bu[1][r]), false, false);
    bu[0][r] = __uint_as_float(s0[0]); bu[1][r] = __uint_as_float(s0[1]);
    auto s1 = __builtin_amdgcn_permlane32_swap(__float_as_uint(bu[2][r]), __float_as_uint(bu[3][r]), false, false);
    bu[2][r] = __uint_as_float(s1[0]); bu[3][r] = __uint_as_float(s1[1]);
  }
}

__device__ __forceinline__ void ssm_block(const MP& p, int l, int b, int g, int tid, char* smem) {
  const int lane = tid & 63, seg = tid >> 6;
  char* wl = smem + seg * 8192;
  float* fin = (float*)(smem + 4 * 8192);
  const int lg = l * SG + g, hf = lane >> 5, fr = lane & 15, fq = lane >> 4;
  const float ar = p.ssmL()[(lg * SP + lane) * 2], ai = p.ssmL()[(lg * SP + lane) * 2 + 1];
  bf16x8 bB[4], cB[4];
#pragma unroll
  for (int nt = 0; nt < 4; ++nt) bB[nt] = *(const bf16x8*)(p.ssmB() + ((size_t)lg * 128 + nt * 32 + (lane & 31)) * 16 + 8 * hf);
#pragma unroll
  for (int ks = 0; ks < 4; ++ks) cB[ks] = *(const bf16x8*)(p.ssmC() + ((size_t)lg * 16 + fr) * 128 + 32 * ks + 8 * fq);
  const f32x4 dsk = *(const f32x4*)(p.in.ssm_d + l * SW + g * 16 + 4 * fq);
  const int t0 = b * S + seg * SEGLEN;
  const bf16_t* urow = p.u() + (size_t)(t0 + (lane & 31)) * SW + g * 16 + 8 * hf;
  float xr = 0.f, xi = 0.f;
  if (seg < SSEG - 1) {
    bf16x8 ua = *(const bf16x8*)(urow);
    for (int c = 0; c < SEGCH; ++c) {
      const bf16x8 un = *(const bf16x8*)(urow + (size_t)((c + 1 < SEGCH ? c + 1 : c) * 32) * SW);
      f32x16 bu[4];
      ssm_bu(ua, bB, bu);
#pragma unroll
      for (int r4 = 0; r4 < 4; ++r4)
#pragma unroll
        for (int half = 0; half < 2; ++half)
#pragma unroll
          for (int j = 0; j < 4; ++j) {
            const int r = 4 * r4 + j;
            const float bre = half ? bu[1][r] : bu[0][r], bim = half ? bu[3][r] : bu[2][r];
            const float nr = ar * xr - ai * xi + bre, ni = ar * xi + ai * xr + bim;
            xr = nr; xi = ni;
          }
      ua = un;
    }
  }
  fin[(seg * 64 + lane) * 2] = xr; fin[(seg * 64 + lane) * 2 + 1] = xi;
  __syncthreads();
  {
    float pr = ar, pi = ai;
#pragma unroll
    for (int i = 0; i < 9; ++i) { const float nr = pr * pr - pi * pi, ni = 2.f * pr * pi; pr = nr; pi = ni; }
    static_assert(SEGLEN == 512, "lam^SEGLEN squaring count");
    float cr = 0.f, ci = 0.f;
    for (int j = 0; j < seg; ++j) {
      const float fr_ = fin[(j * 64 + lane) * 2], fi_ = fin[(j * 64 + lane) * 2 + 1];
      const float nr = pr * cr - pi * ci + fr_, ni = pr * ci + pi * cr + fi_;
      cr = nr; ci = ni;
    }
    xr = cr; xi = ci;
  }
  const int wbase = (lane & 3) * 4;
  const int pch = lane >> 2;
  const bf16_t* uep = p.u() + (size_t)(t0 + fr) * SW + g * 16 + 4 * fq;
  bf16x8 ua = *(const bf16x8*)(urow);
  u32x2 uraw[2];
#pragma unroll
  for (int i = 0; i < 2; ++i) uraw[i] = *(const u32x2*)(uep + (size_t)(16 * i) * SW);
  for (int c = 0; c < SEGCH; ++c) {
    const int tb = t0 + c * 32;
    const int cn = (c + 1 < SEGCH ? c + 1 : c) * 32;
    const bf16x8 un = *(const bf16x8*)(urow + (size_t)cn * SW);
    u32x2 unraw[2];
#pragma unroll
    for (int i = 0; i < 2; ++i) unraw[i] = *(const u32x2*)(uep + (size_t)(cn + 16 * i) * SW);
    f32x16 bu[4];
    ssm_bu(ua, bB, bu);
#pragma unroll
    for (int r4 = 0; r4 < 4; ++r4) {
#pragma unroll
      for (int half = 0; half < 2; ++half) {
#pragma unroll
        for (int j = 0; j < 4; ++j) {
          const int t = 8 * r4 + 4 * half + j, r = 4 * r4 + j;
          const float bre = half ? bu[1][r] : bu[0][r], bim = half ? bu[3][r] : bu[2][r];
          const float nr = ar * xr - ai * xi + bre, ni = ar * xi + ai * xr + bim;
          xr = nr; xi = ni;
          *(unsigned*)(wl + t * 256 + ((pch ^ (t & 15)) << 4) + wbase) = pack2(nr, ni);
        }
      }
    }
    asm volatile("s_waitcnt lgkmcnt(0)" ::: "memory");
#pragma unroll
    for (int mt = 0; mt < 2; ++mt) {
      f32x4 acc = {0.f, 0.f, 0.f, 0.f};
      const int t = 16 * mt + fr;
#pragma unroll
      for (int ks = 0; ks < 4; ++ks) {
        const bf16x8 af = *(const bf16x8*)(wl + t * 256 + (((4 * ks + fq) ^ (t & 15)) << 4));
        acc = __builtin_amdgcn_mfma_f32_16x16x32_bf16(cB[ks], af, acc, 0, 0, 0);
      }
      const float uu[4] = {bf_lo(uraw[mt][0]), bf_hi(uraw[mt][0]), bf_lo(uraw[mt][1]), bf_hi(uraw[mt][1])};
      float ge[4];
#pragma unroll
      for (int j = 0; j < 4; ++j) {
        const float v = acc[j] + dsk[j] * uu[j];
        const float z2 = 1.5957691216057308f * (v + 0.044715f * v * v * v);
        ge[j] = v * __builtin_amdgcn_rcpf(1.f + __expf(-z2));
      }
      *(u32x2*)(p.y() + (size_t)(tb + t) * SW + g * 16 + 4 * fq) = (u32x2){pack2(ge[0], ge[1]), pack2(ge[2], ge[3])};
    }
    asm volatile("s_waitcnt lgkmcnt(0)" ::: "memory");
    ua = un;
#pragma unroll
    for (int i = 0; i < 2; ++i) uraw[i] = unraw[i];
  }
}

constexpr int ATT_KBYTES = 160 * 128, ATT_VCH = 21, ATT_VBYTES = 64 * ATT_VCH * 16;
__device__ __forceinline__ void attn_block(const MP& p, int l, int b, int qt, int kvh, char* smem, int tid) {
  const int lane = tid & 63, wave = __builtin_amdgcn_readfirstlane(tid >> 6);
  const int h = kvh * 4 + wave;
  const int s0 = qt * 32, t0 = b * S + s0, ql = lane & 31, hf = lane >> 5;
  char* Ks = smem; char* Vs = smem + ATT_KBYTES;
  {
    const bf16_t* kb = p.k() + (size_t)b * S * 128 + kvh * 64;
#pragma unroll
    for (int j = 0; j < 5; ++j) {
      const int pc = wave + 4 * j;
      const int R = 8 * pc + (lane >> 3);
      int ks = s0 - 128 + R; ks = ks < 0 ? 0 : ks;
      const int c = (lane & 7) ^ ((R >> 1) & 7);
      __builtin_amdgcn_global_load_lds((const void*)(kb + (size_t)ks * 128 + c * 8), (void*)(Ks + pc * 1024), 16, 0, 0);
    }
    const bf16_t* vbp = p.vT() + (size_t)(b * 2 + kvh) * 64 * S;
#pragma unroll
    for (int j = 0; j < 6; ++j) {
      const int pc = wave + 4 * j;
      if (pc < ATT_VCH) {
        const int q = 64 * pc + lane, d = q / ATT_VCH, c = q - d * ATT_VCH;
        int ko = s0 - 128 + 8 * (c < 20 ? c : 19); ko = ko < 0 ? 0 : ko;
        __builtin_amdgcn_global_load_lds((const void*)(vbp + (size_t)d * S + ko), (void*)(Vs + pc * 1024), 16, 0, 0);
      }
    }
  }
  bf16x8 qf[4];
#pragma unroll
  for (int st = 0; st < 4; ++st) qf[st] = *(const bf16x8*)(p.q() + (size_t)(t0 + ql) * AW + h * 64 + 16 * st + 8 * hf);
  asm volatile("s_waitcnt vmcnt(0)" ::: "memory");
  __syncthreads();
  f32x16 sc[5];
#pragma unroll
  for (int kt = 0; kt < 5; ++kt) {
#pragma unroll
    for (int r = 0; r < 16; ++r) sc[kt][r] = 0.f;
#pragma unroll
    for (int st = 0; st < 4; ++st) {
      const int R = 32 * kt + ql, c = 2 * st + hf;
      const bf16x8 kf = *(const bf16x8*)(Ks + R * 128 + ((c ^ ((R >> 1) & 7)) << 4));
      sc[kt] = __builtin_amdgcn_mfma_f32_32x32x16_bf16(kf, qf[st], sc[kt], 0, 0, 0);
    }
  }
  const float sink = p.in.attn_sink[l * NQ + h];
  float mx = sink;
#pragma unroll
  for (int kt = 0; kt < 5; ++kt) {
#pragma unroll
    for (int r = 0; r < 16; ++r) {
      const int kp = s0 - 128 + 32 * kt + crow32(r, hf);
      const int dk = kp - (s0 + ql);
      const bool valid = kp >= 0 && dk <= 0 && dk > -128;
      sc[kt][r] = valid ? sc[kt][r] : -1e30f;
      mx = fmaxf(mx, sc[kt][r]);
    }
  }
  mx = xhalf_max(mx);
  float lsum = 0.f;
#pragma unroll
  for (int kt = 0; kt < 5; ++kt) {
#pragma unroll
    for (int r = 0; r < 16; ++r) { const float e = __expf(sc[kt][r] - mx); sc[kt][r] = e; lsum += e; }
  }
  lsum = xhalf_sum(lsum);
  lsum += __expf(sink - mx);
  const float inv = 1.f / lsum;
  f32x16 o[2];
#pragma unroll
  for (int r = 0; r < 16; ++r) { o[0][r] = 0.f; o[1][r] = 0.f; }
#pragma unroll
  for (int kt = 0; kt < 5; ++kt) {
#pragma unroll
    for (int s = 0; s < 2; ++s) {
      u32x4 pw;
#pragma unroll
      for (int j = 0; j < 4; ++j) pw[j] = pack2(sc[kt][8 * s + 2 * j], sc[kt][8 * s + 2 * j + 1]);
      const bf16x8 pa = __builtin_bit_cast(bf16x8, pw);
#pragma unroll
      for (int dt = 0; dt < 2; ++dt) {
        const bf16x8 vb = *(const bf16x8*)(Vs + ((32 * dt + ql) * ATT_VCH + 4 * kt + 2 * s + hf) * 16);
        o[dt] = __builtin_amdgcn_mfma_f32_32x32x16_bf16(vb, pa, o[dt], 0, 0, 0);
      }
    }
  }
  bf16_t* dst = p.attn() + (size_t)(t0 + ql) * AW + h * 64 + 4 * hf;
  float ssq = 0.f;
#pragma unroll
  for (int dt = 0; dt < 2; ++dt)
#pragma unroll
    for (int g4 = 0; g4 < 4; ++g4) {
      const float a0 = o[dt][4 * g4] * inv, a1 = o[dt][4 * g4 + 1] * inv, a2 = o[dt][4 * g4 + 2] * inv, a3 = o[dt][4 * g4 + 3] * inv;
      ssq += (a0 * a0 + a1 * a1) + (a2 * a2 + a3 * a3);
      *(u32x2*)(dst + 32 * dt + 8 * g4) = (u32x2){pack2(a0, a1), pack2(a2, a3)};
    }
  ssq = xhalf_sum(ssq);
  if (hf == 0) p.ssqa()[(size_t)(t0 + ql) * 8 + h] = ssq;
  __syncthreads();
}

__device__ __forceinline__ void phase_attn(const MP& p, int l, char* smem) {
  const int tid = launder(threadIdx.x);
  if ((gridDim.x & 7) == 0) {
    const int xcd = blockIdx.x & 7, lb = blockIdx.x >> 3, nlb = gridDim.x >> 3;
#pragma unroll 1
    for (int it = lb; it < 128; it += nlb) attn_block(p, l, xcd, it & 63, it >> 6, smem, tid);
  } else {
#pragma unroll 1
    for (int it = blockIdx.x; it < NB * 128; it += gridDim.x) attn_block(p, l, it >> 7, it & 63, (it >> 6) & 1, smem, tid);
  }
}
__device__ __forceinline__ void phase_ssm(const MP& p, int l, char* smem, int wid, int lrank) {
  const int tid = launder(threadIdx.x);
  if (wid < 0) return;
  unsigned nwl = 0; bool all = (gridDim.x & 7) == 0;
#pragma unroll
  for (int x = 0; x < 8; ++x) {
    const unsigned c = __hip_atomic_load(p.claim() + 4104 + x, __ATOMIC_RELAXED, __HIP_MEMORY_SCOPE_AGENT);
    all = all && c > 0u; nwl = (x == (int)(blockIdx.x & 7)) ? c : nwl;
  }
  if (all) {
    const int b = blockIdx.x & 7;
    for (int g = lrank; g < SG; g += (int)nwl) { ssm_block(p, l, b, g, tid, smem); __syncthreads(); }
  } else {
    const int nw = (int)__hip_atomic_load(p.claim() + 4096, __ATOMIC_RELAXED, __HIP_MEMORY_SCOPE_AGENT);
    for (int task = wid; task < NB * SG; task += nw) { ssm_block(p, l, task / SG, task % SG, tid, smem); __syncthreads(); }
  }
}
__device__ __forceinline__ void phase_glu(const MP& p, int l, char* smem) {
  const int tid = launder(threadIdx.x), lane = tid & 63, wave = tid >> 6, wr = wave >> 1, wc = wave & 1, fr = lane & 15, fq = lane >> 4;
  const int r0 = tid >> 3;
  const int ntiles = (T / 128) * (SW / 128);
  const bf16_t* W = p.WgluT() + (size_t)l * SW * SW;
  auto make = [&](int tile, GemmTile& g) {
    const int m0 = (tile >> 2) * 128, n0 = (tile & 3) * 128;
    g.A0 = p.y(); g.A1 = p.y(); g.lda = SW; g.ksA = SW; g.K = SW;
#pragma unroll
    for (int i = 0; i < 4; ++i) g.arow[i] = m0 + r0 + 32 * i;
    g.Blo0 = W + (size_t)n0 * SW; g.Bhi0 = g.Blo0 + (size_t)64 * SW; g.Blo1 = g.Blo0; g.Bhi1 = g.Bhi0;
    g.ldb = SW; g.ksB = SW; g.rot = ROT_OF(tile >> 2, tile & 3) & 7;
  };
  GemmTile g, gn; bool pre = false;
  const TileMap tmap = tm_init(T / 128, SW / 128);
  { const int t0 = tm_tile(tmap, 0); if (t0 >= 0) { make(t0, g); gn = g; } }
  for (int jt = 0; ; ++jt) {
    const int tile = tm_tile(tmap, jt); if (tile < 0) break;
    const int mt = tile >> 2, nt = tile & 3, m0 = mt * 128, n0 = nt * 128;
    const int nxt = tm_tile(tmap, jt + 1); const bool hasn = nxt >= 0;
    if (hasn) make(nxt, gn);
    f32x4 acc[4][4];
    gemm_mainloop<false>(g, gn, hasn, pre, smem, acc);
    pre = hasn; g = gn;
    u32x2 yrv[4][4];
#pragma unroll
    for (int m = 0; m < 4; ++m)
#pragma unroll
      for (int n = 0; n < 4; ++n) yrv[m][n] = *(const u32x2*)(p.y() + (size_t)(m0 + wr * 64 + 16 * m + fr) * SW + n0 + wc * 64 + 16 * n + 4 * fq);
#pragma unroll
    for (int m = 0; m < 4; ++m) {
      const int t = m0 + wr * 64 + 16 * m + fr;
      float ss = 0.f;
#pragma unroll
      for (int n = 0; n < 4; ++n) {
        const int col = n0 + wc * 64 + 16 * n + 4 * fq;
        const u32x2 yr = yrv[m][n];
        const float yv[4] = {bf_lo(yr[0]), bf_hi(yr[0]), bf_lo(yr[1]), bf_hi(yr[1])};
        float o[4];
#pragma unroll
        for (int j = 0; j < 4; ++j) { o[j] = yv[j] * __builtin_amdgcn_rcpf(1.f + __expf(-acc[m][n][j])); ss += o[j] * o[j]; }
        *(u32x2*)(p.ssm() + (size_t)t * SW + col) = (u32x2){pack2(o[0], o[1]), pack2(o[2], o[3])};
      }
      ss += __shfl_xor(ss, 16); ss += __shfl_xor(ss, 32);
      if (fq == 0) p.ssqs()[(size_t)t * 8 + nt * 2 + wc] = ss;
    }
  }
}

template <bool XB>
__device__ __forceinline__ void phase_out(const MP& p, int l, char* smem, const float* xin) {
  const int tid = launder(threadIdx.x), lane = tid & 63, wave = tid >> 6, wr = wave >> 1, wc = wave & 1, fr = lane & 15, fq = lane >> 4;
  const int r0 = tid >> 3;
  const float* modl = p.mod() + (size_t)l * 8 * 6144;
  const int ntiles = (T / 128) * (D / 128);
  const bf16_t* W = p.WoutT() + (size_t)l * D * D;
  auto make = [&](int tile, GemmTile& g) {
    const int m0 = (tile >> 3) * 128, n0 = (tile & 7) * 128;
    g.A0 = p.attn(); g.A1 = p.ssm(); g.lda = AW; g.ksA = AW; g.K = D;
#pragma unroll
    for (int i = 0; i < 4; ++i) g.arow[i] = m0 + r0 + 32 * i;
    g.Blo0 = W + (size_t)n0 * D; g.Bhi0 = g.Blo0 + (size_t)64 * D; g.Blo1 = g.Blo0; g.Bhi1 = g.Bhi0;
    g.ldb = D; g.ksB = D; g.rot = 0;
  };
  GemmTile g, gn; bool pre = false;
  const TileMap tmap = tm_init(T / 128, D / 128);
  { const int t0 = tm_tile(tmap, 0); if (t0 >= 0) { make(t0, g); gn = g; } }
  for (int jt = 0; ; ++jt) {
    const int tile = tm_tile(tmap, jt); if (tile < 0) break;
    const int mt = tile >> 3, nt = tile & 7, m0 = mt * 128, n0 = nt * 128, b = m0 / S;
    const int nxt = tm_tile(tmap, jt + 1); const bool hasn = nxt >= 0;
    if (hasn) make(nxt, gn);
    float mids[4], rs[4];
#pragma unroll
    for (int m = 0; m < 4; ++m) {
      const int t = m0 + wr * 64 + 16 * m + fr;
      const f32x4 a0 = *(const f32x4*)(p.ssqa() + (size_t)t * 8), a1 = *(const f32x4*)(p.ssqa() + (size_t)t * 8 + 4);
      const f32x4 s0 = *(const f32x4*)(p.ssqs() + (size_t)t * 8), s1 = *(const f32x4*)(p.ssqs() + (size_t)t * 8 + 4);
      const float sa = ((a0[0] + a0[1]) + (a0[2] + a0[3])) + ((a1[0] + a1[1]) + (a1[2] + a1[3]));
      const float sq = ((s0[0] + s0[1]) + (s0[2] + s0[3])) + ((s1[0] + s1[1]) + (s1[2] + s1[3]));
      const float ra = rsqrtf(sa * (1.f / 512.f) + EPS);
      rs[m] = rsqrtf(sq * (1.f / 512.f) + EPS);
      mids[m] = ra / rs[m];
    }
    f32x4 acc[4][4];
    gemm_mainloop_t<false, true>(g, gn, hasn, pre, smem, acc, 8, mids);
    pre = hasn; g = gn;
    f32x4 g1v[4], xvv[4][4]; u32x2 xbv[4][4];
#pragma unroll
    for (int n = 0; n < 4; ++n) g1v[n] = *(const f32x4*)(modl + (size_t)b * 6144 + 2 * 1024 + n0 + wc * 64 + 16 * n + 4 * fq);
#pragma unroll
    for (int m = 0; m < 4; ++m)
#pragma unroll
      for (int n = 0; n < 4; ++n) {
        const size_t xo = (size_t)(m0 + wr * 64 + 16 * m + fr) * D + n0 + wc * 64 + 16 * n + 4 * fq;
        if (XB) xbv[m][n] = *(const u32x2*)(p.xb() + xo); else xvv[m][n] = *(const f32x4*)(xin + xo);
      }
#pragma unroll
    for (int m = 0; m < 4; ++m) {
      const int t = m0 + wr * 64 + 16 * m + fr;
#pragma unroll
      for (int n = 0; n < 4; ++n) {
        const int col = n0 + wc * 64 + 16 * n + 4 * fq;
        const f32x4 xv = XB ? (f32x4){bf_lo(xbv[m][n][0]), bf_hi(xbv[m][n][0]), bf_lo(xbv[m][n][1]), bf_hi(xbv[m][n][1])} : xvv[m][n];
        const f32x4 g1 = g1v[n];
        f32x4 o;
#pragma unroll
        for (int j = 0; j < 4; ++j) o[j] = xv[j] + g1[j] * (acc[m][n][j] * rs[m]);
        *(u32x2*)(p.x1() + (size_t)t * D + col) = (u32x2){pack2(o[0], o[1]), pack2(o[2], o[3])};
      }
    }
  }
}
__device__ __forceinline__ void phase_norm2_route(const MP& p, int l, char* smem) {
  const int tid = launder(threadIdx.x);
  const int wave = tid >> 6, lane = tid & 63, fr = lane & 15, fq = lane >> 4;
  const float* modl = p.mod() + (size_t)l * 8 * 6144;
  const float* g2n = p.in.norm2_g + l * D;
  float* gsl = (float*)smem;
  float* shl = gsl + 1024;
  int* cntl = p.cnt() + l * 256;
  for (int s = blockIdx.x; s < 512; s += gridDim.x) {
    const int b = s & 7, q = s >> 3;
    __syncthreads();
    {
      const int d = tid * 4;
      const float4 gg = *(const float4*)(g2n + d), s1 = *(const float4*)(modl + (size_t)b * 6144 + 4 * 1024 + d), s0 = *(const float4*)(modl + (size_t)b * 6144 + 3 * 1024 + d);
      *(float4*)(gsl + d) = make_float4(gg.x * (1.f + s1.x), gg.y * (1.f + s1.y), gg.z * (1.f + s1.z), gg.w * (1.f + s1.w));
      *(float4*)(shl + d) = s0;
    }
    __syncthreads();
    {
      const int g = wave & 1, kh = wave >> 1;
      float* pss = (float*)(smem + 8192);
      f32x4* pacc = (f32x4*)(smem + 8192 + 256);
      const int t = b * S + (q * 2 + g) * 16 + fr;
      const bf16_t* xrow = p.x1() + (size_t)t * D + 512 * kh + 8 * fq;
      float ss = 0.f;
#pragma unroll 8
      for (int ks = 0; ks < 16; ++ks) {
        const u32x4 xr = *(const u32x4*)(xrow + 32 * ks);
#pragma unroll
        for (int j = 0; j < 4; ++j) { const float a = bf_lo(xr[j]), c = bf_hi(xr[j]); ss += a * a + c * c; }
      }
      ss += __shfl_xor(ss, 16); ss += __shfl_xor(ss, 32);
      if (fq == 0) pss[(g * 2 + kh) * 16 + fr] = ss;
      __syncthreads();
      ss = pss[(g * 2) * 16 + fr] + pss[(g * 2 + 1) * 16 + fr];
      const float rinv = rsqrtf(ss * (1.f / D) + EPS);
      const u32x4* wf = p.wrf() + (size_t)(kh * 16) * 2 * 64 + lane;
      bf16_t* hrow = p.h() + (size_t)t * D + 512 * kh + 8 * fq;
      const float* gq = gsl + 512 * kh + 8 * fq; const float* sq = shl + 512 * kh + 8 * fq;
      f32x4 acc = {0.f, 0.f, 0.f, 0.f};
#pragma unroll 4
      for (int ks = 0; ks < 16; ++ks) {
        const u32x4 xr = *(const u32x4*)(xrow + 32 * ks);
        const float* gp = gq + 32 * ks; const float* sp = sq + 32 * ks;
        const f32x4 ga = *(const f32x4*)gp, gb = *(const f32x4*)(gp + 4), sa = *(const f32x4*)sp, sb = *(const f32x4*)(sp + 4);
        const float gv[8] = {ga[0], ga[1], ga[2], ga[3], gb[0], gb[1], gb[2], gb[3]}, sv[8] = {sa[0], sa[1], sa[2], sa[3], sb[0], sb[1], sb[2], sb[3]};
        u32x4 hi, lo;
#pragma unroll
        for (int j = 0; j < 4; ++j) {
          const float h0 = bf_lo(xr[j]) * rinv * gv[2 * j] + sv[2 * j], h1 = bf_hi(xr[j]) * rinv * gv[2 * j + 1] + sv[2 * j + 1];
          hi[j] = pack2(h0, h1);
          lo[j] = pack2(h0 - bf_lo(hi[j]), h1 - bf_hi(hi[j]));
        }
        *(u32x4*)(hrow + 32 * ks) = hi;
        const bf16x8 whi = __builtin_bit_cast(bf16x8, wf[(ks * 2) * 64]), wlo = __builtin_bit_cast(bf16x8, wf[(ks * 2 + 1) * 64]);
        const bf16x8 hhi = __builtin_bit_cast(bf16x8, hi), hlo = __builtin_bit_cast(bf16x8, lo);
        acc = __builtin_amdgcn_mfma_f32_16x16x32_bf16(whi, hhi, acc, 0, 0, 0);
        acc = __builtin_amdgcn_mfma_f32_16x16x32_bf16(whi, hlo, acc, 0, 0, 0);
        acc = __builtin_amdgcn_mfma_f32_16x16x32_bf16(wlo, hhi, acc, 0, 0, 0);
      }
      if (kh == 1) pacc[g * 64 + lane] = acc;
      __syncthreads();
      if (kh == 0) {
      const f32x4 oth = pacc[g * 64 + lane];
#pragma unroll
      for (int j = 0; j < 4; ++j) acc[j] += oth[j];
      float mx = fmaxf(fmaxf(acc[0], acc[1]), fmaxf(acc[2], acc[3]));
      mx = fmaxf(mx, __shfl_xor(mx, 16)); mx = fmaxf(mx, __shfl_xor(mx, 32));
      float pr[4], sel[4]; float sum = 0.f;
#pragma unroll
      for (int j = 0; j < 4; ++j) { pr[j] = __expf(acc[j] - mx); sum += pr[j]; }
      sum += __shfl_xor(sum, 16); sum += __shfl_xor(sum, 32);
      const float inv = 1.f / sum;
      const f32x4 rb = *(const f32x4*)(p.in.router_bias + 4 * fq);
#pragma unroll
      for (int j = 0; j < 4; ++j) { pr[j] *= inv; sel[j] = pr[j] + rb[j]; }
      float m1 = -1e30f, m2 = -1e30f;
#pragma unroll
      for (int j = 0; j < 4; ++j) { const float v = sel[j]; if (v > m1) { m2 = m1; m1 = v; } else if (v > m2) m2 = v; }
      const float gs = m1 + m2;
      int gbest = 0; float gbs = -1e30f;
#pragma unroll
      for (int gg = 0; gg < 4; ++gg) { const float v = __shfl(gs, fr + 16 * gg); if (v > gbs) { gbs = v; gbest = gg; } }
      if (fq == gbest) {
        int i0 = 0; float b0 = sel[0];
#pragma unroll
        for (int j = 1; j < 4; ++j) if (sel[j] > b0) { b0 = sel[j]; i0 = j; }
        int i1 = -1; float bb1 = -1e30f;
#pragma unroll
        for (int j = 0; j < 4; ++j) if (j != i0 && sel[j] > bb1) { bb1 = sel[j]; i1 = j; }
        float p0 = 0.f, p1 = 0.f;
#pragma unroll
        for (int j = 0; j < 4; ++j) { if (j == i0) p0 = pr[j]; if (j == i1) p1 = pr[j]; }
        const float w0 = p0 / (p0 + p1), w1 = p1 / (p0 + p1);
        const int lo2 = i0 < i1 ? i0 : i1, hi2 = i0 < i1 ? i1 : i0;
        const float wlo = i0 < i1 ? w0 : w1, whi2 = i0 < i1 ? w1 : w0;
        const int pidx = (lo2 == 0) ? (hi2 - 1) : (lo2 == 1 ? (hi2 + 1) : 5);
        const int bucket = gbest * 6 + pidx;
        const int sl = bucket * NSUBL + (blockIdx.x & (NSUBL - 1));
        const int pos = atomicAdd(&cntl[sl], 1);
        p.list()[(size_t)sl * T + pos] = t;
        p.tokw()[t] = make_float2(wlo, whi2);
      }
      }
    }
  }
  __syncthreads();
}

__device__ __forceinline__ void bucket_experts2(int bucket, int& elo, int& ehi) {
  const int g = bucket / 6, pi = bucket % 6;
  const int lo = pi < 3 ? 0 : (pi < 5 ? 1 : 2);
  const int hi = pi < 3 ? pi + 1 : (pi < 5 ? pi - 1 : 3);
  elo = g * 4 + lo; ehi = g * 4 + hi;
}
__device__ __forceinline__ void moe_map_build(const int* cnt, int* mm, int tid) {
  if (tid < NBUCKET) {
    int acc = 0;
#pragma unroll
    for (int x = 0; x < NSUBL; ++x) { mm[32 + 16 * tid + x] = acc; acc += cnt[tid * NSUBL + x]; }
    mm[32 + 16 * tid + 8] = acc;
  }
  __syncthreads();
  if (tid == 0) {
    int acc = 0;
    for (int bk = 0; bk < NBUCKET; ++bk) { mm[bk] = acc; acc += (mm[32 + 16 * bk + 8] + TM - 1) / TM; }
    mm[NBUCKET] = acc;
  }
  __syncthreads();
}
__device__ __forceinline__ void moe_find_tile(const int* mm, int mt, int& bucket, int& tib, int& nrow) {
  int bk = 0;
#pragma unroll
  for (int j = 1; j < NBUCKET; ++j) bk += (mt >= mm[j]) ? 1 : 0;
  bucket = bk; tib = mt - mm[bk]; nrow = mm[32 + 16 * bk + 8] - tib * TM;
}
__device__ __forceinline__ int moe_token(const int* list, const int* mm, int bk, int q) {
  const int* sp = mm + 32 + 16 * bk;
  int x = 0, s = 0;
#pragma unroll
  for (int j = 1; j < NSUBL; ++j) { const int v = sp[j]; const bool ge = q >= v; x += ge ? 1 : 0; s = ge ? v : s; }
  return list[(size_t)(bk * NSUBL + x) * T + (q - s)];
}

__device__ __forceinline__ void phase_moe_gu(const MP& p, int l, char* smem) {
  const int tid = launder(threadIdx.x), lane = tid & 63, wave = tid >> 6, wr = wave >> 1, wc = wave & 1, fr = lane & 15, fq = lane >> 4;
  const int r0 = tid >> 3;
  int* mm = (int*)(smem + SMEM_MM);
  moe_map_build(p.cnt() + l * 256, mm, tid);
  const int nmt = mm[NBUCKET];
  const int ntiles = nmt * 16;
  auto make = [&](int tile, GemmTile& g) {
    const int mt = tile >> 4, nt = tile & 15;
    int bucket, tib, nrow;
    moe_find_tile(mm, mt, bucket, tib, nrow);
    int elo, ehi; bucket_experts2(bucket, elo, ehi);
    const int e = nt < 8 ? elo : ehi, f0 = (nt & 7) * 64;
    g.A0 = p.h(); g.A1 = p.h(); g.lda = D; g.ksA = D; g.K = D;
    const bf16_t* Wg = p.WgT() + ((size_t)(l * NE + e) * DFF + f0) * D;
    const bf16_t* Wu = p.WuT() + ((size_t)(l * NE + e) * DFF + f0) * D;
#pragma unroll
    for (int i = 0; i < 4; ++i) {
      const int r = r0 + 32 * i;
      g.arow[i] = moe_token(p.list(), mm, bucket, tib * TM + (r < nrow ? r : nrow - 1));
    }
    g.Blo0 = Wg; g.Bhi0 = Wu; g.Blo1 = Wg; g.Bhi1 = Wu;
    g.ldb = D; g.ksB = D; g.rot = ROT_OF(bucket, nt);
  };
  GemmTile g, gn; bool pre = false;
  const TileMap tmap = tm_init(nmt, 16);
  { const int t0 = tm_tile(tmap, 0); if (t0 >= 0) { make(t0, g); gn = g; } }
  for (int jt = 0; ; ++jt) {
    const int tile = tm_tile(tmap, jt); if (tile < 0) break;
    const int mt = tile >> 4, nt = tile & 15;
    int bucket, tib, nrow;
    moe_find_tile(mm, mt, bucket, tib, nrow);
    const int f0 = (nt & 7) * 64;
    const int nxt = tm_tile(tmap, jt + 1); const bool hasn = nxt >= 0;
    if (hasn) make(nxt, gn);
    float wv[4];
#pragma unroll
    for (int m = 0; m < 4; ++m) {
      const int r = wr * 64 + 16 * m + fr;
      const float2 ww = p.tokw()[moe_token(p.list(), mm, bucket, tib * TM + (r < nrow ? r : nrow - 1))];
      wv[m] = r < nrow ? (nt < 8 ? ww.x : ww.y) : 0.f;
    }
    f32x4 acc[4][4];
    gemm_mainloop<true>(g, gn, hasn, pre, smem, acc);
    pre = hasn; g = gn;
#pragma unroll
    for (int m = 0; m < 4; ++m) {
      const int r = wr * 64 + 16 * m + fr;
      const float w = wv[m];
      bf16_t* dst = p.act() + (size_t)(mt * TM + r) * D + (nt < 8 ? 0 : 512) + f0 + wc * 32 + 4 * fq;
#pragma unroll
      for (int n = 0; n < 2; ++n) {
        float o[4];
#pragma unroll
        for (int j = 0; j < 4; ++j) { const float gv = acc[m][n][j], uv = acc[m][n + 2][j]; o[j] = gv * __builtin_amdgcn_rcpf(1.f + __expf(-gv)) * uv * w; }
        *(u32x2*)(dst + 16 * n) = (u32x2){pack2(o[0], o[1]), pack2(o[2], o[3])};
      }
    }
  }
}

template <bool XBOUT>
__device__ __forceinline__ void phase_moe_down(const MP& p, int l, char* smem) {
  const int tid = launder(threadIdx.x), lane = tid & 63, wave = tid >> 6, wr = wave >> 1, wc = wave & 1, fr = lane & 15, fq = lane >> 4;
  const int r0 = tid >> 3;
  int* mm = (int*)(smem + SMEM_MM);
  moe_map_build(p.cnt() + l * 256, mm, tid);
  const float* modl = p.mod() + (size_t)l * 8 * 6144;
  const int nmt = mm[NBUCKET];
  const int ntiles = nmt * 8;
  auto make = [&](int tile, GemmTile& g) {
    const int mt = tile >> 3, n0 = (tile & 7) * 128;
    int bucket, tib, nrow;
    moe_find_tile(mm, mt, bucket, tib, nrow);
    int elo, ehi; bucket_experts2(bucket, elo, ehi);
    g.A0 = p.act(); g.A1 = p.act(); g.lda = D; g.ksA = D; g.K = D;
    const bf16_t* Wlo = p.WdT() + ((size_t)(l * NE + elo) * D + n0) * DFF;
    const bf16_t* Whi = p.WdT() + ((size_t)(l * NE + ehi) * D + n0) * DFF;
#pragma unroll
    for (int i = 0; i < 4; ++i) {
      g.arow[i] = mt * TM + r0 + 32 * i;
    }
    g.Blo0 = Wlo; g.Bhi0 = Wlo + (size_t)64 * DFF; g.Blo1 = Whi; g.Bhi1 = Whi + (size_t)64 * DFF;
    g.ldb = DFF; g.ksB = DFF; g.rot = ROT_OF(bucket, tile & 7);
  };
  GemmTile g, gn; bool pre = false;
  const TileMap tmap = tm_init(nmt, 8);
  { const int t0 = tm_tile(tmap, 0); if (t0 >= 0) { make(t0, g); gn = g; } }
  for (int jt = 0; ; ++jt) {
    const int tile = tm_tile(tmap, jt); if (tile < 0) break;
    const int mt = tile >> 3, nt = tile & 7, n0 = nt * 128;
    int bucket, tib, nrow;
    moe_find_tile(mm, mt, bucket, tib, nrow);
    const int nxt = tm_tile(tmap, jt + 1); const bool hasn = nxt >= 0;
    if (hasn) make(nxt, gn);
    int tkv[4];
#pragma unroll
    for (int m = 0; m < 4; ++m) {
      const int r = wr * 64 + 16 * m + fr;
      tkv[m] = moe_token(p.list(), mm, bucket, tib * TM + (r < nrow ? r : nrow - 1));
    }
    f32x4 acc[4][4];
    gemm_mainloop<false>(g, gn, hasn, pre, smem, acc);
    pre = hasn; g = gn;
    u32x2 xrv[4][4]; f32x4 g2v[4][4];
#pragma unroll
    for (int m = 0; m < 4; ++m)
#pragma unroll
      for (int n = 0; n < 4; ++n) {
        const int col = n0 + wc * 64 + 16 * n + 4 * fq;
        xrv[m][n] = *(const u32x2*)(p.x1() + (size_t)tkv[m] * D + col);
        g2v[m][n] = *(const f32x4*)(modl + (size_t)(tkv[m] / S) * 6144 + 5 * 1024 + col);
      }
#pragma unroll
    for (int m = 0; m < 4; ++m) {
      const int r = wr * 64 + 16 * m + fr;
      const int tk = tkv[m];
      f32x4 o[4];
#pragma unroll
      for (int n = 0; n < 4; ++n) {
        const u32x2 xr = xrv[m][n];
        const f32x4 xv = {bf_lo(xr[0]), bf_hi(xr[0]), bf_lo(xr[1]), bf_hi(xr[1])};
        const f32x4 g2 = g2v[m][n];
#pragma unroll
        for (int j = 0; j < 4; ++j) o[n][j] = xv[j] + g2[j] * acc[m][n][j];
      }
      if (r < nrow) {
#pragma unroll
        for (int n = 0; n < 4; ++n) {
          const size_t oo = (size_t)tk * D + n0 + wc * 64 + 16 * n + 4 * fq;
          if (XBOUT) *(u32x2*)(p.xb() + oo) = (u32x2){pack2(o[n][0], o[n][1]), pack2(o[n][2], o[n][3])};
          else *(f32x4*)(p.out + oo) = o[n];
        }
      }
    }
  }
}
#define XB_TMO      128
#define XB_XCNT(j)  (256  + 64 * (j))
#define XB_XSUB(j)  (1280 + 64 * (j))
#define XB_XGEN(j)  (2304 + 64 * (j))
#define XB_TOP      3328
#define XB_TOPGEN   3392
#define XCD_BAR_WORDS 3456
#define XB_SPIN_CAP (1u << 22)
#define LAS __attribute__((address_space(3)))

__device__ __forceinline__ unsigned xb_ld(unsigned* p)              { return __hip_atomic_load(p, __ATOMIC_RELAXED, __HIP_MEMORY_SCOPE_AGENT); }
__device__ __forceinline__ unsigned xb_add(unsigned* p, unsigned v) { return __hip_atomic_fetch_add(p, v, __ATOMIC_RELAXED, __HIP_MEMORY_SCOPE_AGENT); }
__device__ __forceinline__ unsigned xb_xcc_id() { return (unsigned)__builtin_amdgcn_s_getreg((3 << 11) | 20) & 0xFu; }
#define XB_SPIN(cond, bar) do { unsigned _sp = 0; while (cond) { __builtin_amdgcn_s_sleep(1); \
    if ((++_sp & 255u) == 0u) { if (xb_ld(&(bar)[XB_TMO])) break; if (_sp > XB_SPIN_CAP) { atomicAdd(&(bar)[XB_TMO], 1u); break; } } } } while (0)

struct XcdBarrier { unsigned* bar; unsigned x; volatile LAS unsigned* st; };

__device__ __forceinline__ XcdBarrier xcd_barrier_post(unsigned* bar, volatile LAS unsigned* st) {
  XcdBarrier b; b.bar = bar; b.x = xb_xcc_id(); b.st = st;
  if (threadIdx.x == 0) (void)xb_add(&bar[XB_XCNT(b.x)], 1u);
  return b;
}
__device__ __forceinline__ void xcd_barrier_complete(unsigned* bar, unsigned x, unsigned& nloc, unsigned& nx) {
  const unsigned G = gridDim.x * gridDim.y * gridDim.z;
  unsigned sum, cnt, mine, sp = 0u;
  for (;;) {
    sum = 0u; cnt = 0u; mine = 0u;
#pragma unroll
    for (unsigned j = 0; j < 16; ++j) { const unsigned c = xb_ld(&bar[XB_XCNT(j)]); sum += c; cnt += (c > 0u) ? 1u : 0u; mine = (j == x) ? c : mine; }
    if (sum == G) break;
    __builtin_amdgcn_s_sleep(1);
    if ((++sp & 255u) == 0u) { if (xb_ld(&bar[XB_TMO])) break; if (sp > XB_SPIN_CAP) { atomicAdd(&bar[XB_TMO], 1u); break; } }
  }
  nloc = mine > 0u ? mine : 1u; nx = cnt > 0u ? cnt : 1u;
}
__device__ __forceinline__ void xcd_barrier(const XcdBarrier& b) {
  asm volatile("s_waitcnt vmcnt(0)" ::: "memory");
  __syncthreads();
  if (threadIdx.x == 0) {
    unsigned* bar = b.bar;
    __builtin_amdgcn_s_waitcnt(0);
    unsigned nloc = b.st[0], nx = b.st[1];
    if (nloc == 0u) { xcd_barrier_complete(bar, b.x, nloc, nx); b.st[0] = nloc; b.st[1] = nx; }
    const unsigned old = xb_add(&bar[XB_XSUB(b.x)], 1u);
    const unsigned gen = old / nloc;
    if (old + 1u == (gen + 1u) * nloc) {
      __builtin_amdgcn_fence(__ATOMIC_RELEASE, "agent");
      asm volatile("s_waitcnt vmcnt(0)" ::: "memory");
      const unsigned og = xb_add(&bar[XB_TOP], 1u);
      const unsigned tg = og / nx;
      if (og + 1u == (tg + 1u) * nx) xb_add(&bar[XB_TOPGEN], 1u);
      else XB_SPIN(xb_ld(&bar[XB_TOPGEN]) == tg, bar);
      __builtin_amdgcn_fence(__ATOMIC_ACQUIRE, "agent");
      xb_add(&bar[XB_XGEN(b.x)], 1u);
      asm volatile("s_waitcnt vmcnt(0)" ::: "memory");
    } else {
      XB_SPIN(xb_ld(&bar[XB_XGEN(b.x)]) == gen, bar);
      __builtin_amdgcn_fence(__ATOMIC_ACQUIRE, "agent");
      asm volatile("s_waitcnt vmcnt(0)" ::: "memory");
    }
  }
  __syncthreads();
}

constexpr int NSUB = 9;

template <int L>
__device__ __forceinline__ void run_layer(const MP& p, char* smem, const XcdBarrier& xb, int ssm_wid, int idle_id, int ssm_lrank) {
  constexpr int l = L;
  const float* xin = L == 0 ? p.in.x : p.out;
  phase_norm1<(L > 0)>(p, l, xin);          xcd_barrier(xb);
  phase_inproj(p, l, smem);        xcd_barrier(xb);
  phase_ssm(p, l, smem, ssm_wid, ssm_lrank);
  {
    constexpr int TT_SMALL = TT_WIN + TT_GLU + TT_OUT;
    const int nidle = (int)__hip_atomic_load(p.claim() + 4097, __ATOMIC_RELAXED, __HIP_MEMORY_SCOPE_AGENT);
    if (nidle == 0) phase0_transposes(p, smem, L * TT_LAYER + TT_SMALL, (L + 1) * TT_LAYER, blockIdx.x, gridDim.x);
    else if (idle_id >= 0) phase0_transposes(p, smem, L * TT_LAYER + TT_SMALL, (L + 1) * TT_LAYER, launder_s(__builtin_amdgcn_readfirstlane(idle_id)), nidle);
  }
  xcd_barrier(xb);
#pragma unroll 1
  for (int step = 0; step < 2; ++step) {
    if ((step == 0) == (ssm_wid >= 0)) phase_glu(p, l, smem);
    else phase_attn(p, l, smem);
  }
  xcd_barrier(xb);
  phase_out<(L > 0)>(p, l, smem, xin);      xcd_barrier(xb);
  phase_norm2_route(p, l, smem);   xcd_barrier(xb);
  phase_moe_gu(p, l, smem);        xcd_barrier(xb);
  phase_moe_down<(L + 1 < DEPTH)>(p, l, smem);
  if (L + 1 < DEPTH) xcd_barrier(xb);
}

__global__ void __launch_bounds__(NTHR, 2) mega(MP p) {
  __shared__ __attribute__((aligned(16))) char smem[65536 + 32 + 2048];
  unsigned* xb_words = (unsigned*)(smem + 65536);
  if (threadIdx.x < 8) xb_words[threadIdx.x] = 0u;
  __syncthreads();
  const XcdBarrier xb = xcd_barrier_post(p.bar(), (volatile LAS unsigned*)xb_words);
  if (threadIdx.x == 0) {
    const unsigned key = (xb_xcc_id() << 8) | ((unsigned)__builtin_amdgcn_s_getreg((7 << 11) | (8 << 6) | 4) & 0xffu);
    const unsigned rank = xb_add(p.claim() + key, 1u);
    xb_words[2] = rank == 0u ? xb_add(p.claim() + 4096, 1u) : 0xffffffffu;
    xb_words[3] = rank == 0u ? 0xffffffffu : xb_add(p.claim() + 4097, 1u);
    xb_words[4] = rank == 0u ? xb_add(p.claim() + 4104 + (blockIdx.x & 7), 1u) : 0xffffffffu;
  }
  __syncthreads();
  const int ssm_wid = (int)xb_words[2], idle_id = (int)xb_words[3], ssm_lrank = (int)xb_words[4];
  for (int it = blockIdx.x; it < P0_MISC; it += gridDim.x) phase0_item(p, it, smem);
  {
    const int G = (int)gridDim.x, r1 = G - 1 - (int)blockIdx.x;
    int r2 = (G - 1 - (TT_WIN + TT_GLU + TT_OUT) % G) - (int)blockIdx.x; r2 += r2 < 0 ? G : 0;
    phase0_transposes(p, smem, 0, TT_WIN + TT_GLU + TT_OUT, r1, G);
    phase0_transposes(p, smem, TT_LAYER, TT_LAYER + TT_WIN + TT_GLU + TT_OUT, r2, G);
  }
  xcd_barrier(xb);
  run_layer<0>(p, smem, xb, ssm_wid, idle_id, ssm_lrank);
  run_layer<1>(p, smem, xb, ssm_wid, idle_id, ssm_lrank);
  static_assert(DEPTH == 2, "two layers instantiated");
}

}

extern "C" void kernel_launch(void* const* d_in, const int* in_sizes, int n_in, void* d_out, int out_size, void* d_ws,
                              size_t ws_size, hipStream_t stream) {
  MP p; memset(&p, 0, sizeof(p));
  Ptrs& P = p.in;
  P.x = (const float*)d_in[0]; P.c = (const float*)d_in[1]; P.pos = (const int*)d_in[2];
  P.ada_w = (const float*)d_in[3]; P.ada_b = (const float*)d_in[4]; P.norm1_g = (const float*)d_in[5];
  P.w_in = (const float*)d_in[6]; P.q_norm_g = (const float*)d_in[7]; P.k_norm_g = (const float*)d_in[8];
  P.attn_sink = (const float*)d_in[9]; P.lam_re = (const float*)d_in[10]; P.lam_im = (const float*)d_in[11];
  P.b_re = (const float*)d_in[12]; P.b_im = (const float*)d_in[13]; P.c_re = (const float*)d_in[14]; P.c_im = (const float*)d_in[15];
  P.ssm_d = (const float*)d_in[16]; P.log_dt = (const float*)d_in[17]; P.w_glu = (const float*)d_in[18];
  P.attn_out_g = (const float*)d_in[19]; P.ssm_out_g = (const float*)d_in[20]; P.w_out = (const float*)d_in[21];
  P.norm2_g = (const float*)d_in[22]; P.w_router = (const float*)d_in[23]; P.router_bias = (const float*)d_in[24];
  P.w_gate = (const float*)d_in[25]; P.w_up = (const float*)d_in[26]; P.w_down = (const float*)d_in[27];
  p.out = (float*)d_out;

  p.ws = (char*)d_ws;
  if (WS_TOTAL > ws_size) { fprintf(stderr, "workspace too small: need %zu have %zu\n", (size_t)WS_TOTAL, ws_size); return; }
  (void)in_sizes; (void)n_in; (void)out_size;

  static int grid_blocks = 0;
  if (!grid_blocks) {
    int dev = 0, cus = 0, per_cu = 0;
    (void)hipGetDevice(&dev);
    (void)hipDeviceGetAttribute(&cus, hipDeviceAttributeMultiprocessorCount, dev);
    (void)hipOccupancyMaxActiveBlocksPerMultiprocessor(&per_cu, mega, NTHR, 0);
    if (per_cu > 2) per_cu = 2;
    if (per_cu < 1) per_cu = 1;
    grid_blocks = cus * per_cu;
  }
  (void)hipMemsetAsync(p.ws + OFF_BAR, 0, OFF_MOD - OFF_BAR, stream);
  void* args[] = {&p};
  hipError_t e = hipLaunchCooperativeKernel((void*)mega, dim3(grid_blocks), dim3(NTHR), args, 0, stream);
  if (e != hipSuccess) fprintf(stderr, "cooperative launch failed: %s (grid %d)\n", hipGetErrorString(e), grid_blocks);
}
```

```cpp
#include <hip/hip_runtime.h>
#include <hip/hip_cooperative_groups.h>
#include <stdint.h>
#include <cstdio>
#include <cstring>

namespace {
constexpr int D = 1024, NB = 8, S = 2048, T = NB * S, DEPTH = 2;
constexpr int AW = 512, HD = 64, NQ = 8, NKV = 2, INW = 1280;
constexpr int SG = 32, SCH = 16, SP = 64, SW = 512;
constexpr int NE = 16, DFF = 512;
constexpr int NBUCKET = 24;
constexpr float EPS = 1e-6f;

struct Ptrs {
  const float *x, *c; const int* pos; const float *ada_w, *ada_b, *norm1_g, *w_in, *q_norm_g, *k_norm_g, *attn_sink,
      *lam_re, *lam_im, *b_re, *b_im, *c_re, *c_im, *ssm_d, *log_dt, *w_glu, *attn_out_g, *ssm_out_g, *w_out, *norm2_g,
      *w_router, *router_bias, *w_gate, *w_up, *w_down;
};

__device__ __forceinline__ float row_sum32_dpp(float v) {
  v += __int_as_float(__builtin_amdgcn_update_dpp(0, __float_as_int(v), 0xB1, 0xF, 0xF, true));
  v += __int_as_float(__builtin_amdgcn_update_dpp(0, __float_as_int(v), 0x4E, 0xF, 0xF, true));
  v += __int_as_float(__builtin_amdgcn_update_dpp(0, __float_as_int(v), 0x141, 0xF, 0xF, true));
  v += __int_as_float(__builtin_amdgcn_update_dpp(0, __float_as_int(v), 0x140, 0xF, 0xF, true));
  v += __int_as_float(__builtin_amdgcn_update_dpp(0, __float_as_int(v), 0x142, 0xA, 0xF, false));
  return v;
}
__device__ __forceinline__ float wave_sum(float v) {
  v = row_sum32_dpp(v);
  return __int_as_float(__builtin_amdgcn_readlane(__float_as_int(v), 31)) + __int_as_float(__builtin_amdgcn_readlane(__float_as_int(v), 63));
}
__device__ __forceinline__ float xhalf_sum(float v) {
  const auto r = __builtin_amdgcn_permlane32_swap(__float_as_uint(v), __float_as_uint(v), false, false);
  return __uint_as_float(r[0]) + __uint_as_float(r[1]);
}
__device__ __forceinline__ float xhalf_max(float v) {
  const auto r = __builtin_amdgcn_permlane32_swap(__float_as_uint(v), __float_as_uint(v), false, false);
  return fmaxf(__uint_as_float(r[0]), __uint_as_float(r[1]));
}

#ifndef ROT_OF
#define ROT_OF(mt, nt) ((mt) & 15)
#endif

typedef unsigned short bf16_t;
typedef short bf16x8 __attribute__((ext_vector_type(8)));
typedef float f32x4 __attribute__((ext_vector_type(4)));
typedef float f32x16 __attribute__((ext_vector_type(16)));
typedef float f32x2 __attribute__((ext_vector_type(2)));
typedef __bf16 bf16x2_t __attribute__((ext_vector_type(2)));
typedef unsigned u32x4 __attribute__((ext_vector_type(4)));
typedef unsigned u32x2 __attribute__((ext_vector_type(2)));

constexpr int NTHR = 256;
constexpr int TM = 128;
constexpr int MAXMT = T / TM + NBUCKET;
constexpr int NSUBL = 8;
constexpr int SMEM_MM = 65536 + 32;

__device__ __forceinline__ unsigned pack2(float lo, float hi) {
  f32x2 v = {lo, hi};
  return __builtin_bit_cast(unsigned, __builtin_convertvector(v, bf16x2_t));
}
__device__ __forceinline__ int launder(int x) { asm volatile("" : "+v"(x)); return x; }
__device__ __forceinline__ int launder_s(int x) { asm volatile("" : "+s"(x)); return x; }
__device__ __forceinline__ float bf_lo(unsigned u) { return __uint_as_float(u << 16); }
__device__ __forceinline__ float bf_hi(unsigned u) { return __uint_as_float(u & 0xffff0000u); }
__device__ __forceinline__ float bf1(bf16_t u) { return __uint_as_float(((unsigned)u) << 16); }

constexpr size_t al256(size_t x) { return (x + 255) & ~(size_t)255; }
constexpr size_t OFF_BAR = 0;
constexpr size_t OFF_CLAIM = OFF_BAR + al256(4096 * 4);
constexpr size_t OFF_MOD = OFF_CLAIM + al256(4096 * 4 + 256);
constexpr size_t OFF_CS = OFF_MOD + al256((size_t)DEPTH * 8 * 6144 * 4);
constexpr size_t OFF_CNT = OFF_CS + al256((size_t)T * 32 * 8);
constexpr size_t OFF_LIST = OFF_CNT + al256(256 * 4 * DEPTH);
constexpr size_t OFF_TOKW = OFF_LIST + al256((size_t)NBUCKET * NSUBL * T * 4);
constexpr size_t OFF_SSMB = OFF_TOKW + al256((size_t)T * 8);
constexpr size_t OFF_SSMC = OFF_SSMB + al256((size_t)DEPTH * SG * 128 * 16 * 2);
constexpr size_t OFF_SSML = OFF_SSMC + al256((size_t)DEPTH * SG * 16 * 128 * 2);
constexpr size_t OFF_WINT = OFF_SSML + al256((size_t)DEPTH * SG * SP * 2 * 4);
constexpr size_t OFF_WGLUT = OFF_WINT + al256((size_t)DEPTH * INW * D * 2);
constexpr size_t OFF_WOUTT = OFF_WGLUT + al256((size_t)DEPTH * SW * SW * 2);
constexpr size_t OFF_H = OFF_WOUTT + al256((size_t)DEPTH * D * D * 2);
constexpr size_t OFF_Q = OFF_H + al256((size_t)T * D * 2);
constexpr size_t OFF_K = OFF_Q + al256((size_t)T * AW * 2);
constexpr size_t OFF_VT = OFF_K + al256((size_t)T * 128 * 2);
constexpr size_t OFF_U = OFF_VT + al256((size_t)T * 128 * 2);
constexpr size_t OFF_ATTN = OFF_U + al256((size_t)T * SW * 2);
constexpr size_t OFF_ACT = OFF_Q;
static_assert((size_t)MAXMT * TM * D * 2 <= OFF_ATTN - OFF_Q, "act overlay too small");
constexpr size_t OFF_SSQA = OFF_ATTN + al256((size_t)T * AW * 2);
constexpr size_t OFF_Y = OFF_SSQA + al256((size_t)T * 8 * 4);
constexpr size_t OFF_SSM = OFF_Y + al256((size_t)T * SW * 2);
constexpr size_t OFF_SSQS = OFF_SSM + al256((size_t)T * SW * 2);
constexpr size_t OFF_X1 = OFF_SSQS + al256((size_t)T * 8 * 4);
constexpr size_t OFF_WGT = OFF_X1 + al256((size_t)T * D * 4);
constexpr size_t OFF_WUT = OFF_WGT + al256((size_t)DEPTH * NE * DFF * D * 2);
constexpr size_t OFF_WDT = OFF_WUT + al256((size_t)DEPTH * NE * DFF * D * 2);
constexpr size_t OFF_WRF = OFF_WDT + al256((size_t)DEPTH * NE * DFF * D * 2);
constexpr size_t WS_TOTAL = OFF_WRF + al256((size_t)32 * 2 * 64 * 16);

struct MP {
  Ptrs in;
  float* out;
  char* ws;
  __device__ __forceinline__ unsigned* bar() const { return (unsigned*)(ws + OFF_BAR); }
  __device__ __forceinline__ unsigned* claim() const { return (unsigned*)(ws + OFF_CLAIM); }
  __device__ __forceinline__ float* mod() const { return (float*)(ws + OFF_MOD); }
  __device__ __forceinline__ float2* cs() const { return (float2*)(ws + OFF_CS); }
  __device__ __forceinline__ int* cnt() const { return (int*)(ws + OFF_CNT); }
  __device__ __forceinline__ int* list() const { return (int*)(ws + OFF_LIST); }
  __device__ __forceinline__ float2* tokw() const { return (float2*)(ws + OFF_TOKW); }
  __device__ __forceinline__ bf16_t* ssmB() const { return (bf16_t*)(ws + OFF_SSMB); }
  __device__ __forceinline__ bf16_t* ssmC() const { return (bf16_t*)(ws + OFF_SSMC); }
  __device__ __forceinline__ float* ssmL() const { return (float*)(ws + OFF_SSML); }
  __device__ __forceinline__ bf16_t* WinT() const { return (bf16_t*)(ws + OFF_WINT); }
  __device__ __forceinline__ bf16_t* WgluT() const { return (bf16_t*)(ws + OFF_WGLUT); }
  __device__ __forceinline__ bf16_t* WoutT() const { return (bf16_t*)(ws + OFF_WOUTT); }
  __device__ __forceinline__ bf16_t* WgT() const { return (bf16_t*)(ws + OFF_WGT); }
  __device__ __forceinline__ bf16_t* WuT() const { return (bf16_t*)(ws + OFF_WUT); }
  __device__ __forceinline__ bf16_t* WdT() const { return (bf16_t*)(ws + OFF_WDT); }
  __device__ __forceinline__ bf16_t* h() const { return (bf16_t*)(ws + OFF_H); }
  __device__ __forceinline__ bf16_t* q() const { return (bf16_t*)(ws + OFF_Q); }
  __device__ __forceinline__ bf16_t* k() const { return (bf16_t*)(ws + OFF_K); }
  __device__ __forceinline__ bf16_t* vT() const { return (bf16_t*)(ws + OFF_VT); }
  __device__ __forceinline__ bf16_t* u() const { return (bf16_t*)(ws + OFF_U); }
  __device__ __forceinline__ bf16_t* attn() const { return (bf16_t*)(ws + OFF_ATTN); }
  __device__ __forceinline__ bf16_t* y() const { return (bf16_t*)(ws + OFF_Y); }
  __device__ __forceinline__ bf16_t* ssm() const { return (bf16_t*)(ws + OFF_SSM); }
  __device__ __forceinline__ bf16_t* act() const { return (bf16_t*)(ws + OFF_ACT); }
  __device__ __forceinline__ float* ssqa() const { return (float*)(ws + OFF_SSQA); }
  __device__ __forceinline__ float* ssqs() const { return (float*)(ws + OFF_SSQS); }
  __device__ __forceinline__ u32x4* wrf() const { return (u32x4*)(ws + OFF_WRF); }
  __device__ __forceinline__ bf16_t* x1() const { return (bf16_t*)(ws + OFF_X1); }
  __device__ __forceinline__ bf16_t* xb() const { return (bf16_t*)(ws + OFF_X1 + (size_t)T * D * 2); }
};

constexpr int TT_WIN = 8 * 20, TT_GLU = 4 * 8, TT_OUT = 8 * 16, TT_EXP = 16 * 64;
constexpr int TT_LAYER = TT_WIN + TT_GLU + TT_OUT + 3 * TT_EXP;
constexpr int P0_MOD = DEPTH * 192;
constexpr int P0_TR = DEPTH * TT_LAYER;
constexpr int P0_CS = T * 32 / 256;
constexpr int P0_SSM = DEPTH * SG;
constexpr int P0_WRF = 32 * 64 / 256;
constexpr int P0_MISC = P0_MOD + P0_CS + P0_SSM + P0_WRF + 1;

__device__ __forceinline__ void phase0_item(const MP& p, int it, char* smem) {
  const int tid = launder(threadIdx.x);
  float* ldsf = (float*)smem;
  if (it < P0_MOD) {
    const int l = it / 192, j0 = (it % 192) * 32;
    float* sc = ldsf;
    float* red = ldsf + 8192;
    for (int i = tid; i < 8192; i += NTHR) { float v = p.in.c[i]; sc[i] = v / (1.f + __expf(-v)); }
    __syncthreads();
    const int kg = tid >> 3, cq = (tid & 7) * 4;
    float acc[8][4];
#pragma unroll
    for (int b = 0; b < 8; ++b)
#pragma unroll
      for (int j = 0; j < 4; ++j) acc[b][j] = 0.f;
    const float* w = p.in.ada_w + (size_t)l * 1024 * 6144 + j0 + cq;
#pragma unroll 2
    for (int k4 = 0; k4 < 8; ++k4) {
      const int k = kg * 32 + k4 * 4;
      float4 wv[4];
#pragma unroll
      for (int i = 0; i < 4; ++i) wv[i] = *(const float4*)(w + (size_t)(k + i) * 6144);
#pragma unroll
      for (int b = 0; b < 8; ++b) {
        const f32x4 s = *(const f32x4*)(sc + b * 1024 + k);
#pragma unroll
        for (int i = 0; i < 4; ++i) { acc[b][0] += s[i] * wv[i].x; acc[b][1] += s[i] * wv[i].y; acc[b][2] += s[i] * wv[i].z; acc[b][3] += s[i] * wv[i].w; }
      }
    }
#pragma unroll
    for (int b = 0; b < 8; ++b) *(float4*)(red + (kg * 8 + b) * 32 + cq) = make_float4(acc[b][0], acc[b][1], acc[b][2], acc[b][3]);
    __syncthreads();
    {
      const int b = tid >> 5, c = tid & 31;
      float v = 0.f;
#pragma unroll 8
      for (int g = 0; g < 32; ++g) v += red[(g * 8 + b) * 32 + c];
      p.mod()[(size_t)(l * 8 + b) * 6144 + j0 + c] = v + p.in.ada_b[l * 6144 + j0 + c];
    }
    __syncthreads();
    return;
  }
  it -= P0_MOD;
  if (it < P0_CS) {
    const int i = it * 256 + tid, t = i >> 5, f = i & 31;
    const float freq = __builtin_amdgcn_exp2f(-(float)f * (13.287712379549449f / 32.f));
    const float ang = (float)p.in.pos[t] * freq;
    const float rev = ang * 0.15915494309189535f;
    const float r = rev - floorf(rev);
    p.cs()[i] = make_float2(__builtin_amdgcn_cosf(r), __builtin_amdgcn_sinf(r));
    return;
  }
  it -= P0_CS;
  if (it < P0_SSM) {
    const int lg = it;
    if (tid < 64) {
      const int pp = tid;
      const float dt = expf(p.in.log_dt[lg]);
      const float lr = p.in.lam_re[lg * SP + pp], li = p.in.lam_im[lg * SP + pp];
      const float mag = expf(lr * dt);
      float sn, cn; sincosf(li * dt, &sn, &cn);
      const float ar = mag * cn, ai = mag * sn;
      const float den = lr * lr + li * li;
      const float fr = ((ar - 1.f) * lr + ai * li) / den, fi = (ai * lr - (ar - 1.f) * li) / den;
      p.ssmL()[(lg * SP + pp) * 2] = ar; p.ssmL()[(lg * SP + pp) * 2 + 1] = ai;
      unsigned wr[8], wi[8];
#pragma unroll
      for (int hh = 0; hh < 8; ++hh) {
        const float br0 = p.in.b_re[((size_t)lg * SP + pp) * SCH + 2 * hh], bi0 = p.in.b_im[((size_t)lg * SP + pp) * SCH + 2 * hh];
        const float br1 = p.in.b_re[((size_t)lg * SP + pp) * SCH + 2 * hh + 1], bi1 = p.in.b_im[((size_t)lg * SP + pp) * SCH + 2 * hh + 1];
        wr[hh] = pack2(fr * br0 - fi * bi0, fr * br1 - fi * bi1);
        wi[hh] = pack2(fr * bi0 + fi * br0, fr * bi1 + fi * br1);
      }
      u32x4* dr = (u32x4*)(p.ssmB() + ((size_t)lg * 128 + pp) * 16);
      u32x4* di = (u32x4*)(p.ssmB() + ((size_t)lg * 128 + 64 + pp) * 16);
      dr[0] = (u32x4){wr[0], wr[1], wr[2], wr[3]}; dr[1] = (u32x4){wr[4], wr[5], wr[6], wr[7]};
      di[0] = (u32x4){wi[0], wi[1], wi[2], wi[3]}; di[1] = (u32x4){wi[4], wi[5], wi[6], wi[7]};
    }
    for (int o = tid; o < 16 * 64; o += NTHR) {
      const int hh = o >> 6, pp = o & 63;
      const float cr = p.in.c_re[(size_t)lg * SCH * SP + o], ci = p.in.c_im[(size_t)lg * SCH * SP + o];
      *(unsigned*)(p.ssmC() + ((size_t)lg * 16 + hh) * 128 + 2 * pp) = pack2(cr, -ci);
    }
    return;
  }
  it -= P0_SSM;
  if (it < P0_WRF) {
    const int i = it * 256 + tid, ks = i >> 6, ln = i & 63;
    const float* w = p.in.w_router + ((size_t)32 * ks + 8 * (ln >> 4)) * NE + (ln & 15);
    unsigned hi[4], lo[4];
#pragma unroll
    for (int j = 0; j < 4; ++j) {
      const float w0 = w[(2 * j) * NE], w1 = w[(2 * j + 1) * NE];
      hi[j] = pack2(w0, w1);
      lo[j] = pack2(w0 - bf_lo(hi[j]), w1 - bf_hi(hi[j]));
    }
    u32x4* dst = p.wrf() + ((size_t)ks * 2) * 64 + ln;
    dst[0] = (u32x4){hi[0], hi[1], hi[2], hi[3]}; dst[64] = (u32x4){lo[0], lo[1], lo[2], lo[3]};
    return;
  }
  for (int i = tid; i < 256 * DEPTH; i += NTHR) p.cnt()[i] = 0;
}

struct TrDesc { const float* src; bf16_t* dst; const float* gain; int N, K, k0, n0; };
__device__ __forceinline__ void tr_decode(const MP& p, int it, TrDesc& d) {
  const int l = it / TT_LAYER; int r = it % TT_LAYER;
  d.gain = nullptr;
  if (r < TT_WIN) { d.src = p.in.w_in + (size_t)l * D * INW; d.N = INW; d.dst = p.WinT() + (size_t)l * INW * D; d.K = D; d.k0 = (r / 20) * 128; d.n0 = (r % 20) * 64; return; }
  r -= TT_WIN;
  if (r < TT_GLU) { d.src = p.in.w_glu + (size_t)l * SW * SW; d.N = SW; d.dst = p.WgluT() + (size_t)l * SW * SW; d.K = SW; d.k0 = (r / 8) * 128; d.n0 = (r % 8) * 64; return; }
  r -= TT_GLU;
  if (r < TT_OUT) {
    d.k0 = (r / 16) * 128; d.n0 = (r % 16) * 64;
    d.gain = d.k0 < 512 ? (p.in.attn_out_g + l * AW) : (p.in.ssm_out_g + l * SW - 512);
    d.src = p.in.w_out + (size_t)l * D * D; d.N = D; d.dst = p.WoutT() + (size_t)l * D * D; d.K = D; return; }
  r -= TT_OUT;
  const int kind = r / TT_EXP; r %= TT_EXP;
  const int e = r / 64, tt = r % 64;
  if (kind == 0) { d.src = p.in.w_gate + (size_t)(l * NE + e) * D * DFF; d.N = DFF; d.dst = p.WgT() + (size_t)(l * NE + e) * DFF * D; d.K = D; d.k0 = (tt / 8) * 128; d.n0 = (tt % 8) * 64; return; }
  if (kind == 1) { d.src = p.in.w_up + (size_t)(l * NE + e) * D * DFF; d.N = DFF; d.dst = p.WuT() + (size_t)(l * NE + e) * DFF * D; d.K = D; d.k0 = (tt / 8) * 128; d.n0 = (tt % 8) * 64; return; }
  d.src = p.in.w_down + (size_t)(l * NE + e) * DFF * D; d.N = D; d.dst = p.WdT() + (size_t)(l * NE + e) * D * DFF; d.K = DFF; d.k0 = (tt / 16) * 128; d.n0 = (tt % 16) * 64;
}
__device__ __forceinline__ void phase0_transposes(const MP& p, char* smem, int first, int last, int brank, int nblk) {
  const int tid = launder(threadIdx.x);
  float* lds = (float*)smem;
  const int r = tid >> 4, c4 = (tid & 15) * 4;
  const int n = tid >> 2, kq = (tid & 3) * 32;
  TrDesc cur, nxt;
  float4 v[8]; float gg[8];
  auto load = [&](const TrDesc& d) {
#pragma unroll
    for (int i = 0; i < 8; ++i) v[i] = *(const float4*)(d.src + (size_t)(d.k0 + r + 16 * i) * d.N + d.n0 + c4);
    if (d.gain) {
#pragma unroll
      for (int i = 0; i < 8; ++i) gg[i] = d.gain[d.k0 + r + 16 * i];
    } else {
#pragma unroll
      for (int i = 0; i < 8; ++i) gg[i] = 1.f;
    }
  };
  int it = first + brank;
  if (it < last) { tr_decode(p, it, cur); load(cur); nxt = cur; }
  for (; it < last; it += nblk) {
#pragma unroll
    for (int i = 0; i < 8; ++i) {
      float* d = lds + (r + 16 * i) * 65 + c4;
      d[0] = v[i].x * gg[i]; d[1] = v[i].y * gg[i]; d[2] = v[i].z * gg[i]; d[3] = v[i].w * gg[i];
    }
    __syncthreads();
    const int nit = it + nblk;
    if (nit < last) { tr_decode(p, nit, nxt); load(nxt); }
    unsigned w[16];
#pragma unroll
    for (int j = 0; j < 16; ++j) w[j] = pack2(lds[(kq + 2 * j) * 65 + n], lds[(kq + 2 * j + 1) * 65 + n]);
    u32x4* dd = (u32x4*)(cur.dst + (size_t)(cur.n0 + n) * cur.K + cur.k0 + kq);
#pragma unroll
    for (int j = 0; j < 4; ++j) dd[j] = (u32x4){w[4 * j], w[4 * j + 1], w[4 * j + 2], w[4 * j + 3]};
    __syncthreads();
    cur = nxt;
  }
}

template <bool XB>
__device__ __forceinline__ void norm_token(const void* __restrict__ xrow, const float* __restrict__ g, const float* __restrict__ sh,
                                           const float* __restrict__ sc, bf16_t* __restrict__ hr, int lane, float (&hv)[16]) {
  float4 v[4]; float ss = 0.f;
#pragma unroll
  for (int i = 0; i < 4; ++i) {
    if (XB) { const u32x2 r = *(const u32x2*)((const bf16_t*)xrow + lane * 4 + 256 * i); v[i] = make_float4(bf_lo(r[0]), bf_hi(r[0]), bf_lo(r[1]), bf_hi(r[1])); }
    else v[i] = *(const float4*)((const float*)xrow + lane * 4 + 256 * i);
    ss += v[i].x * v[i].x + v[i].y * v[i].y + v[i].z * v[i].z + v[i].w * v[i].w;
  }
  ss = wave_sum(ss);
  const float rinv = rsqrtf(ss * (1.f / D) + EPS);
#pragma unroll
  for (int i = 0; i < 4; ++i) {
    const int d = lane * 4 + 256 * i;
    const float4 gg = *(const float4*)(g + d), s1 = *(const float4*)(sc + d), s0 = *(const float4*)(sh + d);
    hv[4 * i + 0] = v[i].x * rinv * gg.x * (1.f + s1.x) + s0.x;
    hv[4 * i + 1] = v[i].y * rinv * gg.y * (1.f + s1.y) + s0.y;
    hv[4 * i + 2] = v[i].z * rinv * gg.z * (1.f + s1.z) + s0.z;
    hv[4 * i + 3] = v[i].w * rinv * gg.w * (1.f + s1.w) + s0.w;
    *(u32x2*)(hr + d) = (u32x2){pack2(hv[4 * i], hv[4 * i + 1]), pack2(hv[4 * i + 2], hv[4 * i + 3])};
  }
}

struct TokRange { int t0, step, end; };
__device__ __forceinline__ TokRange tok_range(int wave) {
  TokRange r;
  if ((gridDim.x & 7) == 0) { const int xcd = blockIdx.x & 7, lb = blockIdx.x >> 3, nlb = gridDim.x >> 3; r.t0 = xcd * S + lb * 4 + wave; r.step = nlb * 4; r.end = (xcd + 1) * S; }
  else { r.t0 = blockIdx.x * 4 + wave; r.step = gridDim.x * 4; r.end = T; }
  return r;
}
template <bool XB>
__device__ __forceinline__ void phase_norm1(const MP& p, int l, const float* xin) {
  const int tid = launder(threadIdx.x);
  const int wave = tid >> 6, lane = tid & 63;
  const float* modl = p.mod() + (size_t)l * 8 * 6144;
  const TokRange tr = tok_range(wave);
  for (int t = tr.t0; t < tr.end; t += tr.step) {
    const int b = t / S; float hv[16];
    norm_token<XB>(XB ? (const void*)(p.xb() + (size_t)t * D) : (const void*)(xin + (size_t)t * D), p.in.norm1_g + l * D, modl + (size_t)b * 6144, modl + (size_t)b * 6144 + 1024, p.h() + (size_t)t * D, lane, hv);
  }
}

struct GemmTile {
  const bf16_t* A0; const bf16_t* A1; long lda; int ksA;
  int arow[4];
  const bf16_t* Blo0; const bf16_t* Bhi0;
  const bf16_t* Blo1; const bf16_t* Bhi1;
  long ldb; int ksB;
  int K; int rot;
};

__device__ __forceinline__ int lds_off(int row, int chunk) { return row * 128 + ((chunk ^ ((row >> 1) & 7)) << 4); }

template <bool BSPLIT, bool MID>
__device__ __forceinline__ void gemm_mainloop_t(const GemmTile& g, const GemmTile& gnext, bool hasnext, bool preloaded, char* smem, f32x4 (&acc)[4][4],
                                                int ktmid, const float (&mids)[4]) {
  const int tid = launder(threadIdx.x), lane = tid & 63, wave = tid >> 6, wr = wave >> 1, wc = wave & 1, fr = lane & 15, fq = lane >> 4;
  const int r0 = tid >> 3, c8 = tid & 7;
  const int csrc = (c8 ^ ((r0 >> 1) & 7)) * 8;
  const int wbase = __builtin_amdgcn_readfirstlane(wave) * 1024;
#pragma unroll
  for (int m = 0; m < 4; ++m)
#pragma unroll
    for (int n = 0; n < 4; ++n) acc[m][n] = (f32x4){0.f, 0.f, 0.f, 0.f};
  auto stage = [&](const GemmTile& gg, int kt, int buf) {
    const int kk = ((kt + gg.rot) & (gg.K / 64 - 1)) * 64;
    const bf16_t* Ab = kk < gg.ksA ? gg.A0 + kk : gg.A1 + (kk - gg.ksA);
    const bool bs = kk < gg.ksB; const int kb = bs ? kk : kk - gg.ksB;
    char* As = smem + buf * 32768 + wbase; char* Bs = As + 16384;
#pragma unroll
    for (int i = 0; i < 4; ++i) {
      __builtin_amdgcn_global_load_lds((const void*)(Ab + (size_t)gg.arow[i] * gg.lda + csrc), (void*)(As + i * 4096), 16, 0, 0);
      const bf16_t* Bb = bs ? (i < 2 ? gg.Blo0 : gg.Bhi0) : (i < 2 ? gg.Blo1 : gg.Bhi1);
      __builtin_amdgcn_global_load_lds((const void*)(Bb + (size_t)(r0 + 32 * (i & 1)) * gg.ldb + kb + csrc), (void*)(Bs + i * 4096), 16, 0, 0);
    }
  };
  const int nk = g.K / 64;
  if (!preloaded) {
    stage(g, 0, 0);
    asm volatile("s_waitcnt vmcnt(0)" ::: "memory");
    __syncthreads();
  }
  for (int kt = 0; kt < nk; ++kt) {
    if (kt + 1 < nk) stage(g, kt + 1, (kt + 1) & 1);
    else if (hasnext) stage(gnext, 0, 0);
    if (MID && kt == ktmid) {
#pragma unroll
      for (int m = 0; m < 4; ++m)
#pragma unroll
        for (int n = 0; n < 4; ++n) acc[m][n] *= mids[m];
    }
    const char* As = smem + (kt & 1) * 32768; const char* Bs = As + 16384;
    {
      bf16x8 af[2][4], bfr[2][4];
#pragma unroll
      for (int ks = 0; ks < 2; ++ks) {
#pragma unroll
        for (int m = 0; m < 4; ++m) af[ks][m] = *(const bf16x8*)(As + lds_off(wr * 64 + 16 * m + fr, ks * 4 + fq));
#pragma unroll
        for (int n = 0; n < 4; ++n) {
          const int brow = BSPLIT ? ((n >> 1) * 64 + wc * 32 + (n & 1) * 16 + fr) : (wc * 64 + 16 * n + fr);
          bfr[ks][n] = *(const bf16x8*)(Bs + lds_off(brow, ks * 4 + fq));
        }
      }
#pragma unroll
      for (int ks = 0; ks < 2; ++ks)
#pragma unroll
        for (int m = 0; m < 4; ++m)
#pragma unroll
          for (int n = 0; n < 4; ++n) acc[m][n] = __builtin_amdgcn_mfma_f32_16x16x32_bf16(bfr[ks][n], af[ks][m], acc[m][n], 0, 0, 0);
      __builtin_amdgcn_sched_group_barrier(0x100, 8, 0);
#pragma unroll
      for (int i = 0; i < 8; ++i) { __builtin_amdgcn_sched_group_barrier(0x008, 2, 0); __builtin_amdgcn_sched_group_barrier(0x100, 1, 0); }
      __builtin_amdgcn_sched_group_barrier(0x008, 16, 0);
    }
    __builtin_amdgcn_sched_barrier(0);
    asm volatile("s_waitcnt vmcnt(0)" ::: "memory");
    __syncthreads();
  }
}
template <bool BSPLIT>
__device__ __forceinline__ void gemm_mainloop(const GemmTile& g, const GemmTile& gnext, bool hasnext, bool preloaded, char* smem, f32x4 (&acc)[4][4]) {
  const float dummy[4] = {1.f, 1.f, 1.f, 1.f};
  gemm_mainloop_t<BSPLIT, false>(g, gnext, hasnext, preloaded, smem, acc, -1, dummy);
}

struct TileMap { int base, ntl, lb, nlb; };
__device__ __forceinline__ TileMap tm_init(int nMt, int nNt) {
  TileMap t;
  if ((gridDim.x & 7) == 0) {
    const int xcd = blockIdx.x & 7;
    t.lb = blockIdx.x >> 3; t.nlb = gridDim.x >> 3;
    const int mlo = (nMt * xcd) >> 3, mhi = (nMt * (xcd + 1)) >> 3;
    t.base = mlo * nNt; t.ntl = (mhi - mlo) * nNt;
  } else { t.lb = blockIdx.x; t.nlb = gridDim.x; t.base = 0; t.ntl = nMt * nNt; }
  return t;
}
__device__ __forceinline__ int tm_tile(const TileMap& t, int j) { const int li = t.lb + t.nlb * j; return li < t.ntl ? t.base + li : -1; }
__device__ __forceinline__ void phase_inproj(const MP& p, int l, char* smem, int wl_rank = -1, int wl_n = 0) {
  const int tid = launder(threadIdx.x), lane = tid & 63, wave = tid >> 6, wr = wave >> 1, wc = wave & 1, fr = lane & 15, fq = lane >> 4;
  const int r0 = tid >> 3;
  const int ntiles = (T / 128) * (INW / 128);
  const bf16_t* W = p.WinT() + (size_t)l * INW * D;
  auto make = [&](int tile, GemmTile& g) {
    const int m0 = (tile / 10) * 128, n0 = (tile % 10) * 128;
    g.A0 = p.h(); g.A1 = p.h(); g.lda = D; g.ksA = D; g.K = D;
#pragma unroll
    for (int i = 0; i < 4; ++i) g.arow[i] = m0 + r0 + 32 * i;
    g.Blo0 = W + (size_t)n0 * D; g.Bhi0 = g.Blo0 + (size_t)64 * D; g.Blo1 = g.Blo0; g.Bhi1 = g.Bhi0;
    g.ldb = D; g.ksB = D; g.rot = ROT_OF(tile / 10, tile % 10);
  };
  GemmTile g, gn; bool pre = false;
  TileMap tmap = tm_init(T / 128, INW / 128);
  if (wl_n > 0) { tmap.lb = wl_rank; tmap.nlb = wl_n; }
  { const int t0 = tm_tile(tmap, 0); if (t0 >= 0) { make(t0, g); gn = g; } }
  for (int jt = 0; ; ++jt) {
    const int tile = tm_tile(tmap, jt); if (tile < 0) break;
    const int mt = tile / 10, nt = tile % 10, m0 = mt * 128;
    const int nxt = tm_tile(tmap, jt + 1); const bool hasn = nxt >= 0;
    if (hasn) make(nxt, gn);
    f32x4 acc[4][4];
    gemm_mainloop<false>(g, gn, hasn, pre, smem, acc);
    pre = hasn; g = gn;
    const int rowb = m0 + wr * 64 + fr;
    if (nt <= 4) {
      const float* gv = (nt < 4 ? p.in.q_norm_g : p.in.k_norm_g) + l * HD;
      const float scl = nt < 4 ? 0.125f : 1.f;
      f32x4 g1[2], g2[2];
#pragma unroll
      for (int n = 0; n < 2; ++n) { g1[n] = *(const f32x4*)(gv + 16 * n + 4 * fq); g2[n] = *(const f32x4*)(gv + 32 + 16 * n + 4 * fq); }
      f32x4 csv[4][2][2];
#pragma unroll
      for (int m = 0; m < 4; ++m)
#pragma unroll
        for (int n = 0; n < 2; ++n) {
          const float* cp = (const float*)p.cs() + ((size_t)(rowb + 16 * m) * 32 + 16 * n + 4 * fq) * 2;
          csv[m][n][0] = *(const f32x4*)cp; csv[m][n][1] = *(const f32x4*)(cp + 4);
        }
#pragma unroll
      for (int m = 0; m < 4; ++m) {
        const int t = rowb + 16 * m;
        float ss = 0.f;
#pragma unroll
        for (int n = 0; n < 4; ++n)
#pragma unroll
          for (int j = 0; j < 4; ++j) ss += acc[m][n][j] * acc[m][n][j];
        ss += __shfl_xor(ss, 16); ss += __shfl_xor(ss, 32);
        const float rinv = rsqrtf(ss * (1.f / 64.f) + EPS) * scl;
        bf16_t* dst = nt < 4 ? (p.q() + (size_t)t * AW + (2 * nt + wc) * 64) : (p.k() + (size_t)t * 128 + wc * 64);
#pragma unroll
        for (int n = 0; n < 2; ++n) {
          const int c = 16 * n + 4 * fq;
          const f32x4 csa = csv[m][n][0], csb = csv[m][n][1];
          const float cn[4] = {csa[0], csa[2], csb[0], csb[2]}, sn[4] = {csa[1], csa[3], csb[1], csb[3]};
          float o1[4], o2[4];
#pragma unroll
          for (int j = 0; j < 4; ++j) {
            const float x1 = acc[m][n][j] * rinv * g1[n][j], x2 = acc[m][n + 2][j] * rinv * g2[n][j];
            o1[j] = x1 * cn[j] - x2 * sn[j]; o2[j] = x2 * cn[j] + x1 * sn[j];
          }
          *(u32x2*)(dst + c) = (u32x2){pack2(o1[0], o1[1]), pack2(o1[2], o1[3])};
          *(u32x2*)(dst + 32 + c) = (u32x2){pack2(o2[0], o2[1]), pack2(o2[2], o2[3])};
        }
      }
    } else if (nt == 5) {
      const int b = m0 / S;
      char* Tl = smem + 32768;
#pragma unroll
      for (int m = 0; m < 4; ++m) {
        const int r = wr * 64 + 16 * m + fr;
        const int k16 = r & 15;
        const int rp = (r & ~15) | (k16 & 3) | (((k16 >> 3) & 1) << 2) | (((k16 >> 2) & 1) << 3);
#pragma unroll
        for (int n = 0; n < 4; ++n)
#pragma unroll
          for (int j = 0; j < 4; ++j)
            *(bf16_t*)(Tl + (wc * 64 + 16 * n + 4 * fq + j) * 256 + rp * 2) = (bf16_t)(pack2(acc[m][n][j], 0.f) & 0xffffu);
      }
      __syncthreads();
      const int sb = m0 % S;
#pragma unroll
      for (int i = 0; i < 8; ++i) {
        const int ch = tid + 256 * i, dg = ch >> 4, c16 = ch & 15;
        const u32x4 v = *(const u32x4*)(Tl + dg * 256 + c16 * 16);
        *(u32x4*)(p.vT() + ((size_t)(b * 2) * 64 + dg) * S + sb + c16 * 8) = v;
      }
      __syncthreads();
    } else {
#pragma unroll
      for (int m = 0; m < 4; ++m) {
        const int t = rowb + 16 * m;
#pragma unroll
        for (int n = 0; n < 4; ++n)
          *(u32x2*)(p.u() + (size_t)t * SW + (nt - 6) * 128 + wc * 64 + 16 * n + 4 * fq) = (u32x2){pack2(acc[m][n][0], acc[m][n][1]), pack2(acc[m][n][2], acc[m][n][3])};
      }
    }
  }
}

__device__ __forceinline__ int crow32(int r, int hf) { return (r & 3) + 8 * (r >> 2) + 4 * hf; }
__device__ __forceinline__ void attn_task(const MP& p, int l, int task, int lane) {
  lane = launder(lane);
  task = __builtin_amdgcn_readfirstlane(task);
  const int h = task & 7, qt = (task >> 3) & 63, b = task >> 9, kvh = h >> 2;
  const int s0 = qt * 32, t0 = b * S + s0, ql = lane & 31, hf = lane >> 5;
  int kst[5];
#pragma unroll
  for (int kt = 0; kt < 5; ++kt) { const int ks = s0 - 128 + 32 * kt; kst[kt] = ks < 0 ? 0 : ks; }
  bf16x8 qf[4], kf[5][4];
#pragma unroll
  for (int st = 0; st < 4; ++st) qf[st] = *(const bf16x8*)(p.q() + (size_t)(t0 + ql) * AW + h * 64 + 16 * st + 8 * hf);
#pragma unroll
  for (int kt = 0; kt < 5; ++kt)
#pragma unroll
    for (int st = 0; st < 4; ++st) kf[kt][st] = *(const bf16x8*)(p.k() + (size_t)(b * S + kst[kt] + ql) * 128 + kvh * 64 + 8 * hf + 16 * st);
  f32x16 sc[5];
#pragma unroll
  for (int kt = 0; kt < 5; ++kt) {
#pragma unroll
    for (int r = 0; r < 16; ++r) sc[kt][r] = 0.f;
#pragma unroll
    for (int st = 0; st < 4; ++st) sc[kt] = __builtin_amdgcn_mfma_f32_32x32x16_bf16(kf[kt][st], qf[st], sc[kt], 0, 0, 0);
  }
  bf16x8 vb[5][2][2];
#pragma unroll
  for (int kt = 0; kt < 5; ++kt)
#pragma unroll
    for (int s = 0; s < 2; ++s)
#pragma unroll
      for (int dt = 0; dt < 2; ++dt)
        vb[kt][s][dt] = *(const bf16x8*)(p.vT() + ((size_t)(b * 2 + kvh) * 64 + 32 * dt + ql) * S + kst[kt] + 16 * s + 8 * hf);
  const float sink = p.in.attn_sink[l * NQ + h];
  float mx = sink;
#pragma unroll
  for (int kt = 0; kt < 5; ++kt) {
#pragma unroll
    for (int r = 0; r < 16; ++r) {
      const int kp = s0 - 128 + 32 * kt + crow32(r, hf);
      const int dk = kp - (s0 + ql);
      const bool valid = kp >= 0 && dk <= 0 && dk > -128;
      sc[kt][r] = valid ? sc[kt][r] : -1e30f;
      mx = fmaxf(mx, sc[kt][r]);
    }
  }
  mx = xhalf_max(mx);
  float lsum = 0.f;
#pragma unroll
  for (int kt = 0; kt < 5; ++kt) {
#pragma unroll
    for (int r = 0; r < 16; ++r) { const float e = __expf(sc[kt][r] - mx); sc[kt][r] = e; lsum += e; }
  }
  lsum = xhalf_sum(lsum);
  lsum += __expf(sink - mx);
  const float inv = 1.f / lsum;
  f32x16 o[2];
#pragma unroll
  for (int r = 0; r < 16; ++r) { o[0][r] = 0.f; o[1][r] = 0.f; }
#pragma unroll
  for (int kt = 0; kt < 5; ++kt) {
#pragma unroll
    for (int s = 0; s < 2; ++s) {
      u32x4 pw;
#pragma unroll
      for (int j = 0; j < 4; ++j) pw[j] = pack2(sc[kt][8 * s + 2 * j], sc[kt][8 * s + 2 * j + 1]);
      const bf16x8 pa = __builtin_bit_cast(bf16x8, pw);
#pragma unroll
      for (int dt = 0; dt < 2; ++dt) o[dt] = __builtin_amdgcn_mfma_f32_32x32x16_bf16(vb[kt][s][dt], pa, o[dt], 0, 0, 0);
    }
  }
  bf16_t* dst = p.attn() + (size_t)(t0 + ql) * AW + h * 64 + 4 * hf;
  float ssq = 0.f;
#pragma unroll
  for (int dt = 0; dt < 2; ++dt)
#pragma unroll
    for (int g4 = 0; g4 < 4; ++g4) {
      const float a0 = o[dt][4 * g4] * inv, a1 = o[dt][4 * g4 + 1] * inv, a2 = o[dt][4 * g4 + 2] * inv, a3 = o[dt][4 * g4 + 3] * inv;
      ssq += (a0 * a0 + a1 * a1) + (a2 * a2 + a3 * a3);
      *(u32x2*)(dst + 32 * dt + 8 * g4) = (u32x2){pack2(a0, a1), pack2(a2, a3)};
    }
  ssq = xhalf_sum(ssq);
  if (hf == 0) p.ssqa()[(size_t)(t0 + ql) * 8 + h] = ssq;
}
constexpr int SSEG = 4, SEGLEN = S / SSEG, SEGCH = SEGLEN / 32;

__device__ __forceinline__ void ssm_bu(const bf16x8& ua, const bf16x8 (&bB)[4], f32x16 (&bu)[4]) {
#pragma unroll
  for (int nt = 0; nt < 4; ++nt) {
#pragma unroll
    for (int r = 0; r < 16; ++r) bu[nt][r] = 0.f;
    bu[nt] = __builtin_amdgcn_mfma_f32_32x32x16_bf16(ua, bB[nt], bu[nt], 0, 0, 0);
  }
  asm volatile("s_nop 15\n\ts_nop 7" : "+v"(bu[0]), "+v"(bu[1]), "+v"(bu[2]), "+v"(bu[3]));
#pragma unroll
  for (int r = 0; r < 16; ++r) {
    auto s0 = __builtin_amdgcn_permlane32_swap(__float_as_uint(bu[0][r]), __float_as_uint(bu[1][r]), false, false);
    bu[0][r] = __uint_as_float(s0[0]); bu[1][r] = __uint_as_float(s0[1]);
    auto s1 = __builtin_amdgcn_permlane32_swap(__float_as_uint(bu[2][r]), __float_as_uint(bu[3][r]), false, false);
    bu[2][r] = __uint_as_float(s1[0]); bu[3][r] = __uint_as_float(s1[1]);
  }
}

__device__ __forceinline__ void ssm_block(const MP& p, int l, int b, int g, int tid, char* smem) {
  const int lane = tid & 63, seg = tid >> 6;
  char* wl = smem + seg * 8192;
  float* fin = (float*)(smem + 4 * 8192);
  const int lg = l * SG + g, hf = lane >> 5, fr = lane & 15, fq = lane >> 4;
  const float ar = p.ssmL()[(lg * SP + lane) * 2], ai = p.ssmL()[(lg * SP + lane) * 2 + 1];
  bf16x8 bB[4], cB[4];
#pragma unroll
  for (int nt = 0; nt < 4; ++nt) bB[nt] = *(const bf16x8*)(p.ssmB() + ((size_t)lg * 128 + nt * 32 + (lane & 31)) * 16 + 8 * hf);
#pragma unroll
  for (int ks = 0; ks < 4; ++ks) cB[ks] = *(const bf16x8*)(p.ssmC() + ((size_t)lg * 16 + fr) * 128 + 32 * ks + 8 * fq);
  const f32x4 dsk = *(const f32x4*)(p.in.ssm_d + l * SW + g * 16 + 4 * fq);
  const int t0 = b * S + seg * SEGLEN;
  const bf16_t* urow = p.u() + (size_t)(t0 + (lane & 31)) * SW + g * 16 + 8 * hf;
  float xr = 0.f, xi = 0.f;
  if (seg < SSEG - 1) {
    bf16x8 ua = *(const bf16x8*)(urow);
    for (int c = 0; c < SEGCH; ++c) {
      const bf16x8 un = *(const bf16x8*)(urow + (size_t)((c + 1 < SEGCH ? c + 1 : c) * 32) * SW);
      f32x16 bu[4];
      ssm_bu(ua, bB, bu);
#pragma unroll
      for (int r4 = 0; r4 < 4; ++r4)
#pragma unroll
        for (int half = 0; half < 2; ++half)
#pragma unroll
          for (int j = 0; j < 4; ++j) {
            const int r = 4 * r4 + j;
            const float bre = half ? bu[1][r] : bu[0][r], bim = half ? bu[3][r] : bu[2][r];
            const float nr = ar * xr - ai * xi + bre, ni = ar * xi + ai * xr + bim;
            xr = nr; xi = ni;
          }
      ua = un;
    }
  }
  fin[(seg * 64 + lane) * 2] = xr; fin[(seg * 64 + lane) * 2 + 1] = xi;
  __syncthreads();
  {
    float pr = ar, pi = ai;
#pragma unroll
    for (int i = 0; i < 9; ++i) { const float nr = pr * pr - pi * pi, ni = 2.f * pr * pi; pr = nr; pi = ni; }
    static_assert(SEGLEN == 512, "lam^SEGLEN squaring count");
    float cr = 0.f, ci = 0.f;
    for (int j = 0; j < seg; ++j) {
      const float fr_ = fin[(j * 64 + lane) * 2], fi_ = fin[(j * 64 + lane) * 2 + 1];
      const float nr = pr * cr - pi * ci + fr_, ni = pr * ci + pi * cr + fi_;
      cr = nr; ci = ni;
    }
    xr = cr; xi = ci;
  }
  const int wbase = (lane & 3) * 4;
  const int pch = lane >> 2;
  const bf16_t* uep = p.u() + (size_t)(t0 + fr) * SW + g * 16 + 4 * fq;
  bf16x8 ua = *(const bf16x8*)(urow);
  u32x2 uraw[2];
#pragma unroll
  for (int i = 0; i < 2; ++i) uraw[i] = *(const u32x2*)(uep + (size_t)(16 * i) * SW);
  for (int c = 0; c < SEGCH; ++c) {
    const int tb = t0 + c * 32;
    const int cn = (c + 1 < SEGCH ? c + 1 : c) * 32;
    const bf16x8 un = *(const bf16x8*)(urow + (size_t)cn * SW);
    u32x2 unraw[2];
#pragma unroll
    for (int i = 0; i < 2; ++i) unraw[i] = *(const u32x2*)(uep + (size_t)(cn + 16 * i) * SW);
    f32x16 bu[4];
    ssm_bu(ua, bB, bu);
#pragma unroll
    for (int r4 = 0; r4 < 4; ++r4) {
#pragma unroll
      for (int half = 0; half < 2; ++half) {
#pragma unroll
        for (int j = 0; j < 4; ++j) {
          const int t = 8 * r4 + 4 * half + j, r = 4 * r4 + j;
          const float bre = half ? bu[1][r] : bu[0][r], bim = half ? bu[3][r] : bu[2][r];
          const float nr = ar * xr - ai * xi + bre, ni = ar * xi + ai * xr + bim;
          xr = nr; xi = ni;
          *(unsigned*)(wl + t * 256 + ((pch ^ (t & 15)) << 4) + wbase) = pack2(nr, ni);
        }
      }
    }
    asm volatile("s_waitcnt lgkmcnt(0)" ::: "memory");
#pragma unroll
    for (int mt = 0; mt < 2; ++mt) {
      f32x4 acc = {0.f, 0.f, 0.f, 0.f};
      const int t = 16 * mt + fr;
#pragma unroll
      for (int ks = 0; ks < 4; ++ks) {
        const bf16x8 af = *(const bf16x8*)(wl + t * 256 + (((4 * ks + fq) ^ (t & 15)) << 4));
        acc = __builtin_amdgcn_mfma_f32_16x16x32_bf16(cB[ks], af, acc, 0, 0, 0);
      }
      const float uu[4] = {bf_lo(uraw[mt][0]), bf_hi(uraw[mt][0]), bf_lo(uraw[mt][1]), bf_hi(uraw[mt][1])};
      float ge[4];
#pragma unroll
      for (int j = 0; j < 4; ++j) {
        const float v = acc[j] + dsk[j] * uu[j];
        const float z2 = 1.5957691216057308f * (v + 0.044715f * v * v * v);
        ge[j] = v * __builtin_amdgcn_rcpf(1.f + __expf(-z2));
      }
      *(u32x2*)(p.y() + (size_t)(tb + t) * SW + g * 16 + 4 * fq) = (u32x2){pack2(ge[0], ge[1]), pack2(ge[2], ge[3])};
    }
    asm volatile("s_waitcnt lgkmcnt(0)" ::: "memory");
    ua = un;
#pragma unroll
    for (int i = 0; i < 2; ++i) uraw[i] = unraw[i];
  }
}

constexpr int ATT_KBYTES = 160 * 128, ATT_VCH = 21, ATT_VBYTES = 64 * ATT_VCH * 16;
__device__ __forceinline__ void attn_block(const MP& p, int l, int b, int qt, int kvh, char* smem, int tid) {
  const int lane = tid & 63, wave = __builtin_amdgcn_readfirstlane(tid >> 6);
  const int h = kvh * 4 + wave;
  const int s0 = qt * 32, t0 = b * S + s0, ql = lane & 31, hf = lane >> 5;
  char* Ks = smem; char* Vs = smem + ATT_KBYTES;
  {
    const bf16_t* kb = p.k() + (size_t)b * S * 128 + kvh * 64;
#pragma unroll
    for (int j = 0; j < 5; ++j) {
      const int pc = wave + 4 * j;
      const int R = 8 * pc + (lane >> 3);
      int ks = s0 - 128 + R; ks = ks < 0 ? 0 : ks;
      const int c = (lane & 7) ^ ((R >> 1) & 7);
      __builtin_amdgcn_global_load_lds((const void*)(kb + (size_t)ks * 128 + c * 8), (void*)(Ks + pc * 1024), 16, 0, 0);
    }
    const bf16_t* vbp = p.vT() + (size_t)(b * 2 + kvh) * 64 * S;
#pragma unroll
    for (int j = 0; j < 6; ++j) {
      const int pc = wave + 4 * j;
      if (pc < ATT_VCH) {
        const int q = 64 * pc + lane, d = q / ATT_VCH, c = q - d * ATT_VCH;
        int ko = s0 - 128 + 8 * (c < 20 ? c : 19); ko = ko < 0 ? 0 : ko;
        __builtin_amdgcn_global_load_lds((const void*)(vbp + (size_t)d * S + ko), (void*)(Vs + pc * 1024), 16, 0, 0);
      }
    }
  }
  bf16x8 qf[4];
#pragma unroll
  for (int st = 0; st < 4; ++st) qf[st] = *(const bf16x8*)(p.q() + (size_t)(t0 + ql) * AW + h * 64 + 16 * st + 8 * hf);
  asm volatile("s_waitcnt vmcnt(0)" ::: "memory");
  __syncthreads();
  f32x16 sc[5];
#pragma unroll
  for (int kt = 0; kt < 5; ++kt) {
#pragma unroll
    for (int r = 0; r < 16; ++r) sc[kt][r] = 0.f;
#pragma unroll
    for (int st = 0; st < 4; ++st) {
      const int R = 32 * kt + ql, c = 2 * st + hf;
      const bf16x8 kf = *(const bf16x8*)(Ks + R * 128 + ((c ^ ((R >> 1) & 7)) << 4));
      sc[kt] = __builtin_amdgcn_mfma_f32_32x32x16_bf16(kf, qf[st], sc[kt], 0, 0, 0);
    }
  }
  const float sink = p.in.attn_sink[l * NQ + h];
  float mx = sink;
#pragma unroll
  for (int kt = 0; kt < 5; ++kt) {
#pragma unroll
    for (int r = 0; r < 16; ++r) {
      const int kp = s0 - 128 + 32 * kt + crow32(r, hf);
      const int dk = kp - (s0 + ql);
      const bool valid = kp >= 0 && dk <= 0 && dk > -128;
      sc[kt][r] = valid ? sc[kt][r] : -1e30f;
      mx = fmaxf(mx, sc[kt][r]);
    }
  }
  mx = xhalf_max(mx);
  float lsum = 0.f;
#pragma unroll
  for (int kt = 0; kt < 5; ++kt) {
#pragma unroll
    for (int r = 0; r < 16; ++r) { const float e = __expf(sc[kt][r] - mx); sc[kt][r] = e; lsum += e; }
  }
  lsum = xhalf_sum(lsum);
  lsum += __expf(sink - mx);
  const float inv = 1.f / lsum;
  f32x16 o[2];
#pragma unroll
  for (int r = 0; r < 16; ++r) { o[0][r] = 0.f; o[1][r] = 0.f; }
#pragma unroll
  for (int kt = 0; kt < 5; ++kt) {
#pragma unroll
    for (int s = 0; s < 2; ++s) {
      u32x4 pw;
#pragma unroll
      for (int j = 0; j < 4; ++j) pw[j] = pack2(sc[kt][8 * s + 2 * j], sc[kt][8 * s + 2 * j + 1]);
      const bf16x8 pa = __builtin_bit_cast(bf16x8, pw);
#pragma unroll
      for (int dt = 0; dt < 2; ++dt) {
        const bf16x8 vb = *(const bf16x8*)(Vs + ((32 * dt + ql) * ATT_VCH + 4 * kt + 2 * s + hf) * 16);
        o[dt] = __builtin_amdgcn_mfma_f32_32x32x16_bf16(vb, pa, o[dt], 0, 0, 0);
      }
    }
  }
  bf16_t* dst = p.attn() + (size_t)(t0 + ql) * AW + h * 64 + 4 * hf;
  float ssq = 0.f;
#pragma unroll
  for (int dt = 0; dt < 2; ++dt)
#pragma unroll
    for (int g4 = 0; g4 < 4; ++g4) {
      const float a0 = o[dt][4 * g4] * inv, a1 = o[dt][4 * g4 + 1] * inv, a2 = o[dt][4 * g4 + 2] * inv, a3 = o[dt][4 * g4 + 3] * inv;
      ssq += (a0 * a0 + a1 * a1) + (a2 * a2 + a3 * a3);
      *(u32x2*)(dst + 32 * dt + 8 * g4) = (u32x2){pack2(a0, a1), pack2(a2, a3)};
    }
  ssq = xhalf_sum(ssq);
  if (hf == 0) p.ssqa()[(size_t)(t0 + ql) * 8 + h] = ssq;
  __syncthreads();
}

__device__ __forceinline__ void phase_attn(const MP& p, int l, char* smem) {
  const int tid = launder(threadIdx.x);
  if ((gridDim.x & 7) == 0) {
    const int xcd = blockIdx.x & 7, lb = blockIdx.x >> 3, nlb = gridDim.x >> 3;
#pragma unroll 1
    for (int it = lb; it < 128; it += nlb) attn_block(p, l, xcd, it & 63, it >> 6, smem, tid);
  } else {
#pragma unroll 1
    for (int it = blockIdx.x; it < NB * 128; it += gridDim.x) attn_block(p, l, it >> 7, it & 63, (it >> 6) & 1, smem, tid);
  }
}
__device__ __forceinline__ void phase_ssm(const MP& p, int l, char* smem, int wid, int lrank) {
  const int tid = launder(threadIdx.x);
  if (wid < 0) return;
  unsigned nwl = 0; bool all = (gridDim.x & 7) == 0;
#pragma unroll
  for (int x = 0; x < 8; ++x) {
    const unsigned c = __hip_atomic_load(p.claim() + 4104 + x, __ATOMIC_RELAXED, __HIP_MEMORY_SCOPE_AGENT);
    all = all && c > 0u; nwl = (x == (int)(blockIdx.x & 7)) ? c : nwl;
  }
  if (all) {
    const int b = blockIdx.x & 7;
    for (int g = lrank; g < SG; g += (int)nwl) { ssm_block(p, l, b, g, tid, smem); __syncthreads(); }
  } else {
    const int nw = (int)__hip_atomic_load(p.claim() + 4096, __ATOMIC_RELAXED, __HIP_MEMORY_SCOPE_AGENT);
    for (int task = wid; task < NB * SG; task += nw) { ssm_block(p, l, task / SG, task % SG, tid, smem); __syncthreads(); }
  }
}
__device__ __forceinline__ void phase_glu(const MP& p, int l, char* smem) {
  const int tid = launder(threadIdx.x), lane = tid & 63, wave = tid >> 6, wr = wave >> 1, wc = wave & 1, fr = lane & 15, fq = lane >> 4;
  const int r0 = tid >> 3;
  const int ntiles = (T / 128) * (SW / 128);
  const bf16_t* W = p.WgluT() + (size_t)l * SW * SW;
  auto make = [&](int tile, GemmTile& g) {
    const int m0 = (tile >> 2) * 128, n0 = (tile & 3) * 128;
    g.A0 = p.y(); g.A1 = p.y(); g.lda = SW; g.ksA = SW; g.K = SW;
#pragma unroll
    for (int i = 0; i < 4; ++i) g.arow[i] = m0 + r0 + 32 * i;
    g.Blo0 = W + (size_t)n0 * SW; g.Bhi0 = g.Blo0 + (size_t)64 * SW; g.Blo1 = g.Blo0; g.Bhi1 = g.Bhi0;
    g.ldb = SW; g.ksB = SW; g.rot = ROT_OF(tile >> 2, tile & 3) & 7;
  };
  GemmTile g, gn; bool pre = false;
  const TileMap tmap = tm_init(T / 128, SW / 128);
  { const int t0 = tm_tile(tmap, 0); if (t0 >= 0) { make(t0, g); gn = g; } }
  for (int jt = 0; ; ++jt) {
    const int tile = tm_tile(tmap, jt); if (tile < 0) break;
    const int mt = tile >> 2, nt = tile & 3, m0 = mt * 128, n0 = nt * 128;
    const int nxt = tm_tile(tmap, jt + 1); const bool hasn = nxt >= 0;
    if (hasn) make(nxt, gn);
    f32x4 acc[4][4];
    gemm_mainloop<false>(g, gn, hasn, pre, smem, acc);
    pre = hasn; g = gn;
    u32x2 yrv[4][4];
#pragma unroll
    for (int m = 0; m < 4; ++m)
#pragma unroll
      for (int n = 0; n < 4; ++n) yrv[m][n] = *(const u32x2*)(p.y() + (size_t)(m0 + wr * 64 + 16 * m + fr) * SW + n0 + wc * 64 + 16 * n + 4 * fq);
#pragma unroll
    for (int m = 0; m < 4; ++m) {
      const int t = m0 + wr * 64 + 16 * m + fr;
      float ss = 0.f;
#pragma unroll
      for (int n = 0; n < 4; ++n) {
        const int col = n0 + wc * 64 + 16 * n + 4 * fq;
        const u32x2 yr = yrv[m][n];
        const float yv[4] = {bf_lo(yr[0]), bf_hi(yr[0]), bf_lo(yr[1]), bf_hi(yr[1])};
        float o[4];
#pragma unroll
        for (int j = 0; j < 4; ++j) { o[j] = yv[j] * __builtin_amdgcn_rcpf(1.f + __expf(-acc[m][n][j])); ss += o[j] * o[j]; }
        *(u32x2*)(p.ssm() + (size_t)t * SW + col) = (u32x2){pack2(o[0], o[1]), pack2(o[2], o[3])};
      }
      ss += __shfl_xor(ss, 16); ss += __shfl_xor(ss, 32);
      if (fq == 0) p.ssqs()[(size_t)t * 8 + nt * 2 + wc] = ss;
    }
  }
}

template <bool XB>
__device__ __forceinline__ void phase_out(const MP& p, int l, char* smem, const float* xin) {
  const int tid = launder(threadIdx.x), lane = tid & 63, wave = tid >> 6, wr = wave >> 1, wc = wave & 1, fr = lane & 15, fq = lane >> 4;
  const int r0 = tid >> 3;
  const float* modl = p.mod() + (size_t)l * 8 * 6144;
  const int ntiles = (T / 128) * (D / 128);
  const bf16_t* W = p.WoutT() + (size_t)l * D * D;
  auto make = [&](int tile, GemmTile& g) {
    const int m0 = (tile >> 3) * 128, n0 = (tile & 7) * 128;
    g.A0 = p.attn(); g.A1 = p.ssm(); g.lda = AW; g.ksA = AW; g.K = D;
#pragma unroll
    for (int i = 0; i < 4; ++i) g.arow[i] = m0 + r0 + 32 * i;
    g.Blo0 = W + (size_t)n0 * D; g.Bhi0 = g.Blo0 + (size_t)64 * D; g.Blo1 = g.Blo0; g.Bhi1 = g.Bhi0;
    g.ldb = D; g.ksB = D; g.rot = 0;
  };
  GemmTile g, gn; bool pre = false;
  const TileMap tmap = tm_init(T / 128, D / 128);
  { const int t0 = tm_tile(tmap, 0); if (t0 >= 0) { make(t0, g); gn = g; } }
  for (int jt = 0; ; ++jt) {
    const int tile = tm_tile(tmap, jt); if (tile < 0) break;
    const int mt = tile >> 3, nt = tile & 7, m0 = mt * 128, n0 = nt * 128, b = m0 / S;
    const int nxt = tm_tile(tmap, jt + 1); const bool hasn = nxt >= 0;
    if (hasn) make(nxt, gn);
    float mids[4], rs[4];
#pragma unroll
    for (int m = 0; m < 4; ++m) {
      const int t = m0 + wr * 64 + 16 * m + fr;
      const f32x4 a0 = *(const f32x4*)(p.ssqa() + (size_t)t * 8), a1 = *(const f32x4*)(p.ssqa() + (size_t)t * 8 + 4);
      const f32x4 s0 = *(const f32x4*)(p.ssqs() + (size_t)t * 8), s1 = *(const f32x4*)(p.ssqs() + (size_t)t * 8 + 4);
      const float sa = ((a0[0] + a0[1]) + (a0[2] + a0[3])) + ((a1[0] + a1[1]) + (a1[2] + a1[3]));
      const float sq = ((s0[0] + s0[1]) + (s0[2] + s0[3])) + ((s1[0] + s1[1]) + (s1[2] + s1[3]));
      const float ra = rsqrtf(sa * (1.f / 512.f) + EPS);
      rs[m] = rsqrtf(sq * (1.f / 512.f) + EPS);
      mids[m] = ra / rs[m];
    }
    f32x4 acc[4][4];
    gemm_mainloop_t<false, true>(g, gn, hasn, pre, smem, acc, 8, mids);
    pre = hasn; g = gn;
    f32x4 g1v[4], xvv[4][4]; u32x2 xbv[4][4];
#pragma unroll
    for (int n = 0; n < 4; ++n) g1v[n] = *(const f32x4*)(modl + (size_t)b * 6144 + 2 * 1024 + n0 + wc * 64 + 16 * n + 4 * fq);
#pragma unroll
    for (int m = 0; m < 4; ++m)
#pragma unroll
      for (int n = 0; n < 4; ++n) {
        const size_t xo = (size_t)(m0 + wr * 64 + 16 * m + fr) * D + n0 + wc * 64 + 16 * n + 4 * fq;
        if (XB) xbv[m][n] = *(const u32x2*)(p.xb() + xo); else xvv[m][n] = *(const f32x4*)(xin + xo);
      }
#pragma unroll
    for (int m = 0; m < 4; ++m) {
      const int t = m0 + wr * 64 + 16 * m + fr;
#pragma unroll
      for (int n = 0; n < 4; ++n) {
        const int col = n0 + wc * 64 + 16 * n + 4 * fq;
        const f32x4 xv = XB ? (f32x4){bf_lo(xbv[m][n][0]), bf_hi(xbv[m][n][0]), bf_lo(xbv[m][n][1]), bf_hi(xbv[m][n][1])} : xvv[m][n];
        const f32x4 g1 = g1v[n];
        f32x4 o;
#pragma unroll
        for (int j = 0; j < 4; ++j) o[j] = xv[j] + g1[j] * (acc[m][n][j] * rs[m]);
        *(u32x2*)(p.x1() + (size_t)t * D + col) = (u32x2){pack2(o[0], o[1]), pack2(o[2], o[3])};
      }
    }
  }
}
__device__ __forceinline__ void phase_norm2_route(const MP& p, int l, char* smem) {
  const int tid = launder(threadIdx.x);
  const int wave = tid >> 6, lane = tid & 63, fr = lane & 15, fq = lane >> 4;
  const float* modl = p.mod() + (size_t)l * 8 * 6144;
  const float* g2n = p.in.norm2_g + l * D;
  float* gsl = (float*)smem;
  float* shl = gsl + 1024;
  int* cntl = p.cnt() + l * 256;
  for (int s = blockIdx.x; s < 512; s += gridDim.x) {
    const int b = s & 7, q = s >> 3;
    __syncthreads();
    {
      const int d = tid * 4;
      const float4 gg = *(const float4*)(g2n + d), s1 = *(const float4*)(modl + (size_t)b * 6144 + 4 * 1024 + d), s0 = *(const float4*)(modl + (size_t)b * 6144 + 3 * 1024 + d);
      *(float4*)(gsl + d) = make_float4(gg.x * (1.f + s1.x), gg.y * (1.f + s1.y), gg.z * (1.f + s1.z), gg.w * (1.f + s1.w));
      *(float4*)(shl + d) = s0;
    }
    __syncthreads();
    {
      const int g = wave & 1, kh = wave >> 1;
      float* pss = (float*)(smem + 8192);
      f32x4* pacc = (f32x4*)(smem + 8192 + 256);
      const int t = b * S + (q * 2 + g) * 16 + fr;
      const bf16_t* xrow = p.x1() + (size_t)t * D + 512 * kh + 8 * fq;
      float ss = 0.f;
#pragma unroll 8
      for (int ks = 0; ks < 16; ++ks) {
        const u32x4 xr = *(const u32x4*)(xrow + 32 * ks);
#pragma unroll
        for (int j = 0; j < 4; ++j) { const float a = bf_lo(xr[j]), c = bf_hi(xr[j]); ss += a * a + c * c; }
      }
      ss += __shfl_xor(ss, 16); ss += __shfl_xor(ss, 32);
      if (fq == 0) pss[(g * 2 + kh) * 16 + fr] = ss;
      __syncthreads();
      ss = pss[(g * 2) * 16 + fr] + pss[(g * 2 + 1) * 16 + fr];
      const float rinv = rsqrtf(ss * (1.f / D) + EPS);
      const u32x4* wf = p.wrf() + (size_t)(kh * 16) * 2 * 64 + lane;
      bf16_t* hrow = p.h() + (size_t)t * D + 512 * kh + 8 * fq;
      const float* gq = gsl + 512 * kh + 8 * fq; const float* sq = shl + 512 * kh + 8 * fq;
      f32x4 acc = {0.f, 0.f, 0.f, 0.f};
#pragma unroll 4
      for (int ks = 0; ks < 16; ++ks) {
        const u32x4 xr = *(const u32x4*)(xrow + 32 * ks);
        const float* gp = gq + 32 * ks; const float* sp = sq + 32 * ks;
        const f32x4 ga = *(const f32x4*)gp, gb = *(const f32x4*)(gp + 4), sa = *(const f32x4*)sp, sb = *(const f32x4*)(sp + 4);
        const float gv[8] = {ga[0], ga[1], ga[2], ga[3], gb[0], gb[1], gb[2], gb[3]}, sv[8] = {sa[0], sa[1], sa[2], sa[3], sb[0], sb[1], sb[2], sb[3]};
        u32x4 hi, lo;
#pragma unroll
        for (int j = 0; j < 4; ++j) {
          const float h0 = bf_lo(xr[j]) * rinv * gv[2 * j] + sv[2 * j], h1 = bf_hi(xr[j]) * rinv * gv[2 * j + 1] + sv[2 * j + 1];
          hi[j] = pack2(h0, h1);
          lo[j] = pack2(h0 - bf_lo(hi[j]), h1 - bf_hi(hi[j]));
        }
        *(u32x4*)(hrow + 32 * ks) = hi;
        const bf16x8 whi = __builtin_bit_cast(bf16x8, wf[(ks * 2) * 64]), wlo = __builtin_bit_cast(bf16x8, wf[(ks * 2 + 1) * 64]);
        const bf16x8 hhi = __builtin_bit_cast(bf16x8, hi), hlo = __builtin_bit_cast(bf16x8, lo);
        acc = __builtin_amdgcn_mfma_f32_16x16x32_bf16(whi, hhi, acc, 0, 0, 0);
        acc = __builtin_amdgcn_mfma_f32_16x16x32_bf16(whi, hlo, acc, 0, 0, 0);
        acc = __builtin_amdgcn_mfma_f32_16x16x32_bf16(wlo, hhi, acc, 0, 0, 0);
      }
      if (kh == 1) pacc[g * 64 + lane] = acc;
      __syncthreads();
      if (kh == 0) {
      const f32x4 oth = pacc[g * 64 + lane];
#pragma unroll
      for (int j = 0; j < 4; ++j) acc[j] += oth[j];
      float mx = fmaxf(fmaxf(acc[0], acc[1]), fmaxf(acc[2], acc[3]));
      mx = fmaxf(mx, __shfl_xor(mx, 16)); mx = fmaxf(mx, __shfl_xor(mx, 32));
      float pr[4], sel[4]; float sum = 0.f;
#pragma unroll
      for (int j = 0; j < 4; ++j) { pr[j] = __expf(acc[j] - mx); sum += pr[j]; }
      sum += __shfl_xor(sum, 16); sum += __shfl_xor(sum, 32);
      const float inv = 1.f / sum;
      const f32x4 rb = *(const f32x4*)(p.in.router_bias + 4 * fq);
#pragma unroll
      for (int j = 0; j < 4; ++j) { pr[j] *= inv; sel[j] = pr[j] + rb[j]; }
      float m1 = -1e30f, m2 = -1e30f;
#pragma unroll
      for (int j = 0; j < 4; ++j) { const float v = sel[j]; if (v > m1) { m2 = m1; m1 = v; } else if (v > m2) m2 = v; }
      const float gs = m1 + m2;
      int gbest = 0; float gbs = -1e30f;
#pragma unroll
      for (int gg = 0; gg < 4; ++gg) { const float v = __shfl(gs, fr + 16 * gg); if (v > gbs) { gbs = v; gbest = gg; } }
      if (fq == gbest) {
        int i0 = 0; float b0 = sel[0];
#pragma unroll
        for (int j = 1; j < 4; ++j) if (sel[j] > b0) { b0 = sel[j]; i0 = j; }
        int i1 = -1; float bb1 = -1e30f;
#pragma unroll
        for (int j = 0; j < 4; ++j) if (j != i0 && sel[j] > bb1) { bb1 = sel[j]; i1 = j; }
        float p0 = 0.f, p1 = 0.f;
#pragma unroll
        for (int j = 0; j < 4; ++j) { if (j == i0) p0 = pr[j]; if (j == i1) p1 = pr[j]; }
        const float w0 = p0 / (p0 + p1), w1 = p1 / (p0 + p1);
        const int lo2 = i0 < i1 ? i0 : i1, hi2 = i0 < i1 ? i1 : i0;
        const float wlo = i0 < i1 ? w0 : w1, whi2 = i0 < i1 ? w1 : w0;
        const int pidx = (lo2 == 0) ? (hi2 - 1) : (lo2 == 1 ? (hi2 + 1) : 5);
        const int bucket = gbest * 6 + pidx;
        const int sl = bucket * NSUBL + (blockIdx.x & (NSUBL - 1));
        const int pos = atomicAdd(&cntl[sl], 1);
        p.list()[(size_t)sl * T + pos] = t;
        p.tokw()[t] = make_float2(wlo, whi2);
      }
      }
    }
  }
  __syncthreads();
}

__device__ __forceinline__ void bucket_experts2(int bucket, int& elo, int& ehi) {
  const int g = bucket / 6, pi = bucket % 6;
  const int lo = pi < 3 ? 0 : (pi < 5 ? 1 : 2);
  const int hi = pi < 3 ? pi + 1 : (pi < 5 ? pi - 1 : 3);
  elo = g * 4 + lo; ehi = g * 4 + hi;
}
__device__ __forceinline__ void moe_map_build(const int* cnt, int* mm, int tid) {
  if (tid < NBUCKET) {
    int acc = 0;
#pragma unroll
    for (int x = 0; x < NSUBL; ++x) { mm[32 + 16 * tid + x] = acc; acc += cnt[tid * NSUBL + x]; }
    mm[32 + 16 * tid + 8] = acc;
  }
  __syncthreads();
  if (tid == 0) {
    int acc = 0;
    for (int bk = 0; bk < NBUCKET; ++bk) { mm[bk] = acc; acc += (mm[32 + 16 * bk + 8] + TM - 1) / TM; }
    mm[NBUCKET] = acc;
  }
  __syncthreads();
}
__device__ __forceinline__ void moe_find_tile(const int* mm, int mt, int& bucket, int& tib, int& nrow) {
  int bk = 0;
#pragma unroll
  for (int j = 1; j < NBUCKET; ++j) bk += (mt >= mm[j]) ? 1 : 0;
  bucket = bk; tib = mt - mm[bk]; nrow = mm[32 + 16 * bk + 8] - tib * TM;
}
__device__ __forceinline__ int moe_token(const int* list, const int* mm, int bk, int q) {
  const int* sp = mm + 32 + 16 * bk;
  int x = 0, s = 0;
#pragma unroll
  for (int j = 1; j < NSUBL; ++j) { const int v = sp[j]; const bool ge = q >= v; x += ge ? 1 : 0; s = ge ? v : s; }
  return list[(size_t)(bk * NSUBL + x) * T + (q - s)];
}

__device__ __forceinline__ void phase_moe_gu(const MP& p, int l, char* smem) {
  const int tid = launder(threadIdx.x), lane = tid & 63, wave = tid >> 6, wr = wave >> 1, wc = wave & 1, fr = lane & 15, fq = lane >> 4;
  const int r0 = tid >> 3;
  int* mm = (int*)(smem + SMEM_MM);
  moe_map_build(p.cnt() + l * 256, mm, tid);
  const int nmt = mm[NBUCKET];
  const int ntiles = nmt * 16;
  auto make = [&](int tile, GemmTile& g) {
    const int mt = tile >> 4, nt = tile & 15;
    int bucket, tib, nrow;
    moe_find_tile(mm, mt, bucket, tib, nrow);
    int elo, ehi; bucket_experts2(bucket, elo, ehi);
    const int e = nt < 8 ? elo : ehi, f0 = (nt & 7) * 64;
    g.A0 = p.h(); g.A1 = p.h(); g.lda = D; g.ksA = D; g.K = D;
    const bf16_t* Wg = p.WgT() + ((size_t)(l * NE + e) * DFF + f0) * D;
    const bf16_t* Wu = p.WuT() + ((size_t)(l * NE + e) * DFF + f0) * D;
#pragma unroll
    for (int i = 0; i < 4; ++i) {
      const int r = r0 + 32 * i;
      g.arow[i] = moe_token(p.list(), mm, bucket, tib * TM + (r < nrow ? r : nrow - 1));
    }
    g.Blo0 = Wg; g.Bhi0 = Wu; g.Blo1 = Wg; g.Bhi1 = Wu;
    g.ldb = D; g.ksB = D; g.rot = ROT_OF(bucket, nt);
  };
  GemmTile g, gn; bool pre = false;
  const TileMap tmap = tm_init(nmt, 16);
  { const int t0 = tm_tile(tmap, 0); if (t0 >= 0) { make(t0, g); gn = g; } }
  for (int jt = 0; ; ++jt) {
    const int tile = tm_tile(tmap, jt); if (tile < 0) break;
    const int mt = tile >> 4, nt = tile & 15;
    int bucket, tib, nrow;
    moe_find_tile(mm, mt, bucket, tib, nrow);
    const int f0 = (nt & 7) * 64;
    const int nxt = tm_tile(tmap, jt + 1); const bool hasn = nxt >= 0;
    if (hasn) make(nxt, gn);
    float wv[4];
#pragma unroll
    for (int m = 0; m < 4; ++m) {
      const int r = wr * 64 + 16 * m + fr;
      const float2 ww = p.tokw()[moe_token(p.list(), mm, bucket, tib * TM + (r < nrow ? r : nrow - 1))];
      wv[m] = r < nrow ? (nt < 8 ? ww.x : ww.y) : 0.f;
    }
    f32x4 acc[4][4];
    gemm_mainloop<true>(g, gn, hasn, pre, smem, acc);
    pre = hasn; g = gn;
#pragma unroll
    for (int m = 0; m < 4; ++m) {
      const int r = wr * 64 + 16 * m + fr;
      const float w = wv[m];
      bf16_t* dst = p.act() + (size_t)(mt * TM + r) * D + (nt < 8 ? 0 : 512) + f0 + wc * 32 + 4 * fq;
#pragma unroll
      for (int n = 0; n < 2; ++n) {
        float o[4];
#pragma unroll
        for (int j = 0; j < 4; ++j) { const float gv = acc[m][n][j], uv = acc[m][n + 2][j]; o[j] = gv * __builtin_amdgcn_rcpf(1.f + __expf(-gv)) * uv * w; }
        *(u32x2*)(dst + 16 * n) = (u32x2){pack2(o[0], o[1]), pack2(o[2], o[3])};
      }
    }
  }
}

template <bool XBOUT>
__device__ __forceinline__ void phase_moe_down(const MP& p, int l, char* smem) {
  const int tid = launder(threadIdx.x), lane = tid & 63, wave = tid >> 6, wr = wave >> 1, wc = wave & 1, fr = lane & 15, fq = lane >> 4;
  const int r0 = tid >> 3;
  int* mm = (int*)(smem + SMEM_MM);
  moe_map_build(p.cnt() + l * 256, mm, tid);
  const float* modl = p.mod() + (size_t)l * 8 * 6144;
  const int nmt = mm[NBUCKET];
  const int ntiles = nmt * 8;
  auto make = [&](int tile, GemmTile& g) {
    const int mt = tile >> 3, n0 = (tile & 7) * 128;
    int bucket, tib, nrow;
    moe_find_tile(mm, mt, bucket, tib, nrow);
    int elo, ehi; bucket_experts2(bucket, elo, ehi);
    g.A0 = p.act(); g.A1 = p.act(); g.lda = D; g.ksA = D; g.K = D;
    const bf16_t* Wlo = p.WdT() + ((size_t)(l * NE + elo) * D + n0) * DFF;
    const bf16_t* Whi = p.WdT() + ((size_t)(l * NE + ehi) * D + n0) * DFF;
#pragma unroll
    for (int i = 0; i < 4; ++i) {
      g.arow[i] = mt * TM + r0 + 32 * i;
    }
    g.Blo0 = Wlo; g.Bhi0 = Wlo + (size_t)64 * DFF; g.Blo1 = Whi; g.Bhi1 = Whi + (size_t)64 * DFF;
    g.ldb = DFF; g.ksB = DFF; g.rot = ROT_OF(bucket, tile & 7);
  };
  GemmTile g, gn; bool pre = false;
  const TileMap tmap = tm_init(nmt, 8);
  { const int t0 = tm_tile(tmap, 0); if (t0 >= 0) { make(t0, g); gn = g; } }
  for (int jt = 0; ; ++jt) {
    const int tile = tm_tile(tmap, jt); if (tile < 0) break;
    const int mt = tile >> 3, nt = tile & 7, n0 = nt * 128;
    int bucket, tib, nrow;
    moe_find_tile(mm, mt, bucket, tib, nrow);
    const int nxt = tm_tile(tmap, jt + 1); const bool hasn = nxt >= 0;
    if (hasn) make(nxt, gn);
    int tkv[4];
#pragma unroll
    for (int m = 0; m < 4; ++m) {
      const int r = wr * 64 + 16 * m + fr;
      tkv[m] = moe_token(p.list(), mm, bucket, tib * TM + (r < nrow ? r : nrow - 1));
    }
    f32x4 acc[4][4];
    gemm_mainloop<false>(g, gn, hasn, pre, smem, acc);
    pre = hasn; g = gn;
    u32x2 xrv[4][4]; f32x4 g2v[4][4];
#pragma unroll
    for (int m = 0; m < 4; ++m)
#pragma unroll
      for (int n = 0; n < 4; ++n) {
        const int col = n0 + wc * 64 + 16 * n + 4 * fq;
        xrv[m][n] = *(const u32x2*)(p.x1() + (size_t)tkv[m] * D + col);
        g2v[m][n] = *(const f32x4*)(modl + (size_t)(tkv[m] / S) * 6144 + 5 * 1024 + col);
      }
#pragma unroll
    for (int m = 0; m < 4; ++m) {
      const int r = wr * 64 + 16 * m + fr;
      const int tk = tkv[m];
      f32x4 o[4];
#pragma unroll
      for (int n = 0; n < 4; ++n) {
        const u32x2 xr = xrv[m][n];
        const f32x4 xv = {bf_lo(xr[0]), bf_hi(xr[0]), bf_lo(xr[1]), bf_hi(xr[1])};
        const f32x4 g2 = g2v[m][n];
#pragma unroll
        for (int j = 0; j < 4; ++j) o[n][j] = xv[j] + g2[j] * acc[m][n][j];
      }
      if (r < nrow) {
#pragma unroll
        for (int n = 0; n < 4; ++n) {
          const size_t oo = (size_t)tk * D + n0 + wc * 64 + 16 * n + 4 * fq;
          if (XBOUT) *(u32x2*)(p.xb() + oo) = (u32x2){pack2(o[n][0], o[n][1]), pack2(o[n][2], o[n][3])};
          else *(f32x4*)(p.out + oo) = o[n];
        }
      }
    }
  }
}
#define XB_TMO      128
#define XB_XCNT(j)  (256  + 64 * (j))
#define XB_XSUB(j)  (1280 + 64 * (j))
#define XB_XGEN(j)  (2304 + 64 * (j))
#define XB_TOP      3328
#define XB_TOPGEN   3392
#define XCD_BAR_WORDS 3456
#define XB_SPIN_CAP (1u << 22)
#define LAS __attribute__((address_space(3)))

__device__ __forceinline__ unsigned xb_ld(unsigned* p)              { return __hip_atomic_load(p, __ATOMIC_RELAXED, __HIP_MEMORY_SCOPE_AGENT); }
__device__ __forceinline__ unsigned xb_add(unsigned* p, unsigned v) { return __hip_atomic_fetch_add(p, v, __ATOMIC_RELAXED, __HIP_MEMORY_SCOPE_AGENT); }
__device__ __forceinline__ unsigned xb_xcc_id() { return (unsigned)__builtin_amdgcn_s_getreg((3 << 11) | 20) & 0xFu; }
#define XB_SPIN(cond, bar) do { unsigned _sp = 0; while (cond) { __builtin_amdgcn_s_sleep(1); \
    if ((++_sp & 255u) == 0u) { if (xb_ld(&(bar)[XB_TMO])) break; if (_sp > XB_SPIN_CAP) { atomicAdd(&(bar)[XB_TMO], 1u); break; } } } } while (0)

struct XcdBarrier { unsigned* bar; unsigned x; volatile LAS unsigned* st; };

__device__ __forceinline__ XcdBarrier xcd_barrier_post(unsigned* bar, volatile LAS unsigned* st) {
  XcdBarrier b; b.bar = bar; b.x = xb_xcc_id(); b.st = st;
  if (threadIdx.x == 0) (void)xb_add(&bar[XB_XCNT(b.x)], 1u);
  return b;
}
__device__ __forceinline__ void xcd_barrier_complete(unsigned* bar, unsigned x, unsigned& nloc, unsigned& nx) {
  const unsigned G = gridDim.x * gridDim.y * gridDim.z;
  unsigned sum, cnt, mine, sp = 0u;
  for (;;) {
    sum = 0u; cnt = 0u; mine = 0u;
#pragma unroll
    for (unsigned j = 0; j < 16; ++j) { const unsigned c = xb_ld(&bar[XB_XCNT(j)]); sum += c; cnt += (c > 0u) ? 1u : 0u; mine = (j == x) ? c : mine; }
    if (sum == G) break;
    __builtin_amdgcn_s_sleep(1);
    if ((++sp & 255u) == 0u) { if (xb_ld(&bar[XB_TMO])) break; if (sp > XB_SPIN_CAP) { atomicAdd(&bar[XB_TMO], 1u); break; } }
  }
  nloc = mine > 0u ? mine : 1u; nx = cnt > 0u ? cnt : 1u;
}
__device__ __forceinline__ void xcd_barrier(const XcdBarrier& b) {
  asm volatile("s_waitcnt vmcnt(0)" ::: "memory");
  __syncthreads();
  if (threadIdx.x == 0) {
    unsigned* bar = b.bar;
    __builtin_amdgcn_s_waitcnt(0);
    unsigned nloc = b.st[0], nx = b.st[1];
    if (nloc == 0u) { xcd_barrier_complete(bar, b.x, nloc, nx); b.st[0] = nloc; b.st[1] = nx; }
    const unsigned old = xb_add(&bar[XB_XSUB(b.x)], 1u);
    const unsigned gen = old / nloc;
    if (old + 1u == (gen + 1u) * nloc) {
      __builtin_amdgcn_fence(__ATOMIC_RELEASE, "agent");
      asm volatile("s_waitcnt vmcnt(0)" ::: "memory");
      const unsigned og = xb_add(&bar[XB_TOP], 1u);
      const unsigned tg = og / nx;
      if (og + 1u == (tg + 1u) * nx) xb_add(&bar[XB_TOPGEN], 1u);
      else XB_SPIN(xb_ld(&bar[XB_TOPGEN]) == tg, bar);
      __builtin_amdgcn_fence(__ATOMIC_ACQUIRE, "agent");
      xb_add(&bar[XB_XGEN(b.x)], 1u);
      asm volatile("s_waitcnt vmcnt(0)" ::: "memory");
    } else {
      XB_SPIN(xb_ld(&bar[XB_XGEN(b.x)]) == gen, bar);
      __builtin_amdgcn_fence(__ATOMIC_ACQUIRE, "agent");
      asm volatile("s_waitcnt vmcnt(0)" ::: "memory");
    }
  }
  __syncthreads();
}

constexpr int NSUB = 9;

template <int L>
__device__ __forceinline__ void run_layer(const MP& p, char* smem, const XcdBarrier& xb, int ssm_wid, int idle_id, int ssm_lrank) {
  constexpr int l = L;
  const float* xin = L == 0 ? p.in.x : p.out;
  phase_norm1<(L > 0)>(p, l, xin);          xcd_barrier(xb);
  phase_inproj(p, l, smem);        xcd_barrier(xb);
  phase_ssm(p, l, smem, ssm_wid, ssm_lrank);
  {
    constexpr int TT_SMALL = TT_WIN + TT_GLU + TT_OUT, E0 = L * TT_LAYER + TT_SMALL, NCH = 3 * TT_EXP / 4 / 8;
    const int x = blockIdx.x & 7;
    unsigned* ctr = p.claim() + 4128 + L * 8 + x;
    volatile int* bw = (volatile int*)(smem + SMEM_MM);
#pragma unroll 1
    for (;;) {
      __syncthreads();
      if (threadIdx.x == 0) bw[0] = (int)xb_add(ctr, 1u);
      __syncthreads();
      const int c = launder_s(__builtin_amdgcn_readfirstlane(bw[0]));
      if (c >= NCH) break;
      const int t0 = E0 + (x * NCH + c) * 4;
      phase0_transposes(p, smem, t0, t0 + 4, 0, 1);
    }
  }
  xcd_barrier(xb);
#pragma unroll 1
  for (int step = 0; step < 2; ++step) {
    if ((step == 0) == (ssm_wid >= 0)) phase_glu(p, l, smem);
    else phase_attn(p, l, smem);
  }
  xcd_barrier(xb);
  phase_out<(L > 0)>(p, l, smem, xin);      xcd_barrier(xb);
  phase_norm2_route(p, l, smem);   xcd_barrier(xb);
  phase_moe_gu(p, l, smem);        xcd_barrier(xb);
  phase_moe_down<(L + 1 < DEPTH)>(p, l, smem);
  if (L + 1 < DEPTH) xcd_barrier(xb);
}

__global__ void __launch_bounds__(NTHR, 2) mega(MP p) {
  __shared__ __attribute__((aligned(16))) char smem[65536 + 32 + 2048];
  unsigned* xb_words = (unsigned*)(smem + 65536);
  if (threadIdx.x < 8) xb_words[threadIdx.x] = 0u;
  __syncthreads();
  const XcdBarrier xb = xcd_barrier_post(p.bar(), (volatile LAS unsigned*)xb_words);
  if (threadIdx.x == 0) {
    const unsigned key = (xb_xcc_id() << 8) | ((unsigned)__builtin_amdgcn_s_getreg((7 << 11) | (8 << 6) | 4) & 0xffu);
    const unsigned rank = xb_add(p.claim() + key, 1u);
    xb_words[2] = rank == 0u ? xb_add(p.claim() + 4096, 1u) : 0xffffffffu;
    xb_words[3] = rank == 0u ? 0xffffffffu : xb_add(p.claim() + 4097, 1u);
    xb_words[4] = rank == 0u ? xb_add(p.claim() + 4104 + (blockIdx.x & 7), 1u) : 0xffffffffu;
  }
  __syncthreads();
  const int ssm_wid = (int)xb_words[2], idle_id = (int)xb_words[3], ssm_lrank = (int)xb_words[4];
  for (int it = blockIdx.x; it < P0_MISC; it += gridDim.x) phase0_item(p, it, smem);
  {
    const int G = (int)gridDim.x, r1 = G - 1 - (int)blockIdx.x;
    int r2 = (G - 1 - (TT_WIN + TT_GLU + TT_OUT) % G) - (int)blockIdx.x; r2 += r2 < 0 ? G : 0;
    phase0_transposes(p, smem, 0, TT_WIN + TT_GLU + TT_OUT, r1, G);
    phase0_transposes(p, smem, TT_LAYER, TT_LAYER + TT_WIN + TT_GLU + TT_OUT, r2, G);
  }
  xcd_barrier(xb);
  run_layer<0>(p, smem, xb, ssm_wid, idle_id, ssm_lrank);
  run_layer<1>(p, smem, xb, ssm_wid, idle_id, ssm_lrank);
  static_assert(DEPTH == 2, "two layers instantiated");
}

}

extern "C" void kernel_launch(void* const* d_in, const int* in_sizes, int n_in, void* d_out, int out_size, void* d_ws,
                              size_t ws_size, hipStream_t stream) {
  MP p; memset(&p, 0, sizeof(p));
  Ptrs& P = p.in;
  P.x = (const float*)d_in[0]; P.c = (const float*)d_in[1]; P.pos = (const int*)d_in[2];
  P.ada_w = (const float*)d_in[3]; P.ada_b = (const float*)d_in[4]; P.norm1_g = (const float*)d_in[5];
  P.w_in = (const float*)d_in[6]; P.q_norm_g = (const float*)d_in[7]; P.k_norm_g = (const float*)d_in[8];
  P.attn_sink = (const float*)d_in[9]; P.lam_re = (const float*)d_in[10]; P.lam_im = (const float*)d_in[11];
  P.b_re = (const float*)d_in[12]; P.b_im = (const float*)d_in[13]; P.c_re = (const float*)d_in[14]; P.c_im = (const float*)d_in[15];
  P.ssm_d = (const float*)d_in[16]; P.log_dt = (const float*)d_in[17]; P.w_glu = (const float*)d_in[18];
  P.attn_out_g = (const float*)d_in[19]; P.ssm_out_g = (const float*)d_in[20]; P.w_out = (const float*)d_in[21];
  P.norm2_g = (const float*)d_in[22]; P.w_router = (const float*)d_in[23]; P.router_bias = (const float*)d_in[24];
  P.w_gate = (const float*)d_in[25]; P.w_up = (const float*)d_in[26]; P.w_down = (const float*)d_in[27];
  p.out = (float*)d_out;

  p.ws = (char*)d_ws;
  if (WS_TOTAL > ws_size) { fprintf(stderr, "workspace too small: need %zu have %zu\n", (size_t)WS_TOTAL, ws_size); return; }
  (void)in_sizes; (void)n_in; (void)out_size;

  static int grid_blocks = 0;
  if (!grid_blocks) {
    int dev = 0, cus = 0, per_cu = 0;
    (void)hipGetDevice(&dev);
    (void)hipDeviceGetAttribute(&cus, hipDeviceAttributeMultiprocessorCount, dev);
    (void)hipOccupancyMaxActiveBlocksPerMultiprocessor(&per_cu, mega, NTHR, 0);
    if (per_cu > 2) per_cu = 2;
    if (per_cu < 1) per_cu = 1;
    grid_blocks = cus * per_cu;
  }
  (void)hipMemsetAsync(p.ws + OFF_BAR, 0, OFF_MOD - OFF_BAR, stream);
  void* args[] = {&p};
  hipError_t e = hipLaunchCooperativeKernel((void*)mega, dim3(grid_blocks), dim3(NTHR), args, 0, stream);
  if (e != hipSuccess) fprintf(stderr, "cooperative launch failed: %s (grid %d)\n", hipGetErrorString(e), grid_blocks);
}
```

```cpp
#include <hip/hip_runtime.h>
#include <hip/hip_cooperative_groups.h>
#include <stdint.h>
#include <cstdio>
#include <cstring>

namespace {
constexpr int D = 1024, NB = 8, S = 2048, T = NB * S, DEPTH = 2;
constexpr int AW = 512, HD = 64, NQ = 8, NKV = 2, INW = 1280;
constexpr int SG = 32, SCH = 16, SP = 64, SW = 512;
constexpr int NE = 16, DFF = 512;
constexpr int NBUCKET = 24;
constexpr float EPS = 1e-6f;

struct Ptrs {
  const float *x, *c; const int* pos; const float *ada_w, *ada_b, *norm1_g, *w_in, *q_norm_g, *k_norm_g, *attn_sink,
      *lam_re, *lam_im, *b_re, *b_im, *c_re, *c_im, *ssm_d, *log_dt, *w_glu, *attn_out_g, *ssm_out_g, *w_out, *norm2_g,
      *w_router, *router_bias, *w_gate, *w_up, *w_down;
};

__device__ __forceinline__ float row_sum32_dpp(float v) {
  v += __int_as_float(__builtin_amdgcn_update_dpp(0, __float_as_int(v), 0xB1, 0xF, 0xF, true));
  v += __int_as_float(__builtin_amdgcn_update_dpp(0, __float_as_int(v), 0x4E, 0xF, 0xF, true));
  v += __int_as_float(__builtin_amdgcn_update_dpp(0, __float_as_int(v), 0x141, 0xF, 0xF, true));
  v += __int_as_float(__builtin_amdgcn_update_dpp(0, __float_as_int(v), 0x140, 0xF, 0xF, true));
  v += __int_as_float(__builtin_amdgcn_update_dpp(0, __float_as_int(v), 0x142, 0xA, 0xF, false));
  return v;
}
__device__ __forceinline__ float wave_sum(float v) {
  v = row_sum32_dpp(v);
  return __int_as_float(__builtin_amdgcn_readlane(__float_as_int(v), 31)) + __int_as_float(__builtin_amdgcn_readlane(__float_as_int(v), 63));
}
__device__ __forceinline__ float xhalf_sum(float v) {
  const auto r = __builtin_amdgcn_permlane32_swap(__float_as_uint(v), __float_as_uint(v), false, false);
  return __uint_as_float(r[0]) + __uint_as_float(r[1]);
}
__device__ __forceinline__ float xhalf_max(float v) {
  const auto r = __builtin_amdgcn_permlane32_swap(__float_as_uint(v), __float_as_uint(v), false, false);
  return fmaxf(__uint_as_float(r[0]), __uint_as_float(r[1]));
}

#ifndef ROT_OF
#define ROT_OF(mt, nt) ((mt) & 15)
#endif

typedef unsigned short bf16_t;
typedef short bf16x8 __attribute__((ext_vector_type(8)));
typedef float f32x4 __attribute__((ext_vector_type(4)));
typedef float f32x16 __attribute__((ext_vector_type(16)));
typedef float f32x2 __attribute__((ext_vector_type(2)));
typedef __bf16 bf16x2_t __attribute__((ext_vector_type(2)));
typedef unsigned u32x4 __attribute__((ext_vector_type(4)));
typedef unsigned u32x2 __attribute__((ext_vector_type(2)));

constexpr int NTHR = 256;
constexpr int TM = 128;
constexpr int MAXMT = T / TM + NBUCKET;
constexpr int NSUBL = 8;
constexpr int SMEM_MM = 65536 + 32;

__device__ __forceinline__ unsigned pack2(float lo, float hi) {
  f32x2 v = {lo, hi};
  return __builtin_bit_cast(unsigned, __builtin_convertvector(v, bf16x2_t));
}
__device__ __forceinline__ int launder(int x) { asm volatile("" : "+v"(x)); return x; }
__device__ __forceinline__ int launder_s(int x) { asm volatile("" : "+s"(x)); return x; }
__device__ __forceinline__ float bf_lo(unsigned u) { return __uint_as_float(u << 16); }
__device__ __forceinline__ float bf_hi(unsigned u) { return __uint_as_float(u & 0xffff0000u); }
__device__ __forceinline__ float bf1(bf16_t u) { return __uint_as_float(((unsigned)u) << 16); }

constexpr size_t al256(size_t x) { return (x + 255) & ~(size_t)255; }
constexpr size_t OFF_BAR = 0;
constexpr size_t OFF_CLAIM = OFF_BAR + al256(4096 * 4);
constexpr size_t OFF_MOD = OFF_CLAIM + al256(4096 * 4 + 256);
constexpr size_t OFF_CS = OFF_MOD + al256((size_t)DEPTH * 8 * 6144 * 4);
constexpr size_t OFF_CNT = OFF_CS + al256((size_t)T * 32 * 8);
constexpr size_t OFF_LIST = OFF_CNT + al256(256 * 4 * DEPTH);
constexpr size_t OFF_TOKW = OFF_LIST + al256((size_t)NBUCKET * NSUBL * T * 4);
constexpr size_t OFF_SSMB = OFF_TOKW + al256((size_t)T * 8);
constexpr size_t OFF_SSMC = OFF_SSMB + al256((size_t)DEPTH * SG * 128 * 16 * 2);
constexpr size_t OFF_SSML = OFF_SSMC + al256((size_t)DEPTH * SG * 16 * 128 * 2);
constexpr size_t OFF_WINT = OFF_SSML + al256((size_t)DEPTH * SG * SP * 2 * 4);
constexpr size_t OFF_WGLUT = OFF_WINT + al256((size_t)DEPTH * INW * D * 2);
constexpr size_t OFF_WOUTT = OFF_WGLUT + al256((size_t)DEPTH * SW * SW * 2);
constexpr size_t OFF_H = OFF_WOUTT + al256((size_t)DEPTH * D * D * 2);
constexpr size_t OFF_Q = OFF_H + al256((size_t)T * D * 2);
constexpr size_t OFF_K = OFF_Q + al256((size_t)T * AW * 2);
constexpr size_t OFF_VT = OFF_K + al256((size_t)T * 128 * 2);
constexpr size_t OFF_U = OFF_VT + al256((size_t)T * 128 * 2);
constexpr size_t OFF_ATTN = OFF_U + al256((size_t)T * SW * 2);
constexpr size_t OFF_ACT = OFF_Q;
static_assert((size_t)MAXMT * TM * D * 2 <= OFF_ATTN - OFF_Q, "act overlay too small");
constexpr size_t OFF_SSQA = OFF_ATTN + al256((size_t)T * AW * 2);
constexpr size_t OFF_Y = OFF_SSQA + al256((size_t)T * 8 * 4);
constexpr size_t OFF_SSM = OFF_Y + al256((size_t)T * SW * 2);
constexpr size_t OFF_SSQS = OFF_SSM + al256((size_t)T * SW * 2);
constexpr size_t OFF_X1 = OFF_SSQS + al256((size_t)T * 8 * 4);
constexpr size_t OFF_WGT = OFF_X1 + al256((size_t)T * D * 4);
constexpr size_t OFF_WUT = OFF_WGT + al256((size_t)DEPTH * NE * DFF * D * 2);
constexpr size_t OFF_WDT = OFF_WUT + al256((size_t)DEPTH * NE * DFF * D * 2);
constexpr size_t OFF_WRF = OFF_WDT + al256((size_t)DEPTH * NE * DFF * D * 2);
static_assert((size_t)8 * INW * D * 2 <= OFF_SSM - OFF_ATTN, "folded in-proj weights overlay too small");
constexpr size_t WS_TOTAL = OFF_WRF + al256((size_t)32 * 2 * 64 * 16);

struct MP {
  Ptrs in;
  float* out;
  char* ws;
  __device__ __forceinline__ unsigned* bar() const { return (unsigned*)(ws + OFF_BAR); }
  __device__ __forceinline__ unsigned* claim() const { return (unsigned*)(ws + OFF_CLAIM); }
  __device__ __forceinline__ float* mod() const { return (float*)(ws + OFF_MOD); }
  __device__ __forceinline__ float2* cs() const { return (float2*)(ws + OFF_CS); }
  __device__ __forceinline__ int* cnt() const { return (int*)(ws + OFF_CNT); }
  __device__ __forceinline__ int* list() const { return (int*)(ws + OFF_LIST); }
  __device__ __forceinline__ float2* tokw() const { return (float2*)(ws + OFF_TOKW); }
  __device__ __forceinline__ bf16_t* ssmB() const { return (bf16_t*)(ws + OFF_SSMB); }
  __device__ __forceinline__ bf16_t* ssmC() const { return (bf16_t*)(ws + OFF_SSMC); }
  __device__ __forceinline__ float* ssmL() const { return (float*)(ws + OFF_SSML); }
  __device__ __forceinline__ bf16_t* WinT() const { return (bf16_t*)(ws + OFF_WINT); }
  __device__ __forceinline__ bf16_t* WgluT() const { return (bf16_t*)(ws + OFF_WGLUT); }
  __device__ __forceinline__ bf16_t* WoutT() const { return (bf16_t*)(ws + OFF_WOUTT); }
  __device__ __forceinline__ bf16_t* WgT() const { return (bf16_t*)(ws + OFF_WGT); }
  __device__ __forceinline__ bf16_t* WuT() const { return (bf16_t*)(ws + OFF_WUT); }
  __device__ __forceinline__ bf16_t* WdT() const { return (bf16_t*)(ws + OFF_WDT); }
  __device__ __forceinline__ bf16_t* h() const { return (bf16_t*)(ws + OFF_H); }
  __device__ __forceinline__ bf16_t* q() const { return (bf16_t*)(ws + OFF_Q); }
  __device__ __forceinline__ bf16_t* k() const { return (bf16_t*)(ws + OFF_K); }
  __device__ __forceinline__ bf16_t* vT() const { return (bf16_t*)(ws + OFF_VT); }
  __device__ __forceinline__ bf16_t* u() const { return (bf16_t*)(ws + OFF_U); }
  __device__ __forceinline__ bf16_t* attn() const { return (bf16_t*)(ws + OFF_ATTN); }
  __device__ __forceinline__ bf16_t* y() const { return (bf16_t*)(ws + OFF_Y); }
  __device__ __forceinline__ bf16_t* ssm() const { return (bf16_t*)(ws + OFF_SSM); }
  __device__ __forceinline__ bf16_t* act() const { return (bf16_t*)(ws + OFF_ACT); }
  __device__ __forceinline__ float* ssqa() const { return (float*)(ws + OFF_SSQA); }
  __device__ __forceinline__ float* ssqs() const { return (float*)(ws + OFF_SSQS); }
  __device__ __forceinline__ u32x4* wrf() const { return (u32x4*)(ws + OFF_WRF); }
  __device__ __forceinline__ bf16_t* w1b() const { return (bf16_t*)(ws + OFF_ATTN); }
  __device__ __forceinline__ float* ssqx() const { return (float*)(ws + OFF_SSM); }
  __device__ __forceinline__ float* bias1() const { return (float*)(ws + OFF_SSM + (size_t)T * 16 * 4); }
  __device__ __forceinline__ bf16_t* x1() const { return (bf16_t*)(ws + OFF_X1); }
  __device__ __forceinline__ bf16_t* xb() const { return (bf16_t*)(ws + OFF_X1 + (size_t)T * D * 2); }
};

constexpr int TT_WIN = 8 * 20, TT_GLU = 4 * 8, TT_OUT = 8 * 16, TT_EXP = 16 * 64;
constexpr int TT_LAYER = TT_WIN + TT_GLU + TT_OUT + 3 * TT_EXP;
constexpr int P0_MOD = DEPTH * 192;
constexpr int P0_TR = DEPTH * TT_LAYER;
constexpr int P0_CS = T * 32 / 256;
constexpr int P0_SSM = DEPTH * SG;
constexpr int P0_WRF = 32 * 64 / 256;
constexpr int P0_MISC = P0_MOD + P0_CS + P0_SSM + P0_WRF + 1;

__device__ __forceinline__ void phase0_item(const MP& p, int it, char* smem) {
  const int tid = launder(threadIdx.x);
  float* ldsf = (float*)smem;
  if (it < P0_MOD) {
    const int l = it / 192, j0 = (it % 192) * 32;
    float* sc = ldsf;
    float* red = ldsf + 8192;
    for (int i = tid; i < 8192; i += NTHR) { float v = p.in.c[i]; sc[i] = v / (1.f + __expf(-v)); }
    __syncthreads();
    const int kg = tid >> 3, cq = (tid & 7) * 4;
    float acc[8][4];
#pragma unroll
    for (int b = 0; b < 8; ++b)
#pragma unroll
      for (int j = 0; j < 4; ++j) acc[b][j] = 0.f;
    const float* w = p.in.ada_w + (size_t)l * 1024 * 6144 + j0 + cq;
#pragma unroll 2
    for (int k4 = 0; k4 < 8; ++k4) {
      const int k = kg * 32 + k4 * 4;
      float4 wv[4];
#pragma unroll
      for (int i = 0; i < 4; ++i) wv[i] = *(const float4*)(w + (size_t)(k + i) * 6144);
#pragma unroll
      for (int b = 0; b < 8; ++b) {
        const f32x4 s = *(const f32x4*)(sc + b * 1024 + k);
#pragma unroll
        for (int i = 0; i < 4; ++i) { acc[b][0] += s[i] * wv[i].x; acc[b][1] += s[i] * wv[i].y; acc[b][2] += s[i] * wv[i].z; acc[b][3] += s[i] * wv[i].w; }
      }
    }
#pragma unroll
    for (int b = 0; b < 8; ++b) *(float4*)(red + (kg * 8 + b) * 32 + cq) = make_float4(acc[b][0], acc[b][1], acc[b][2], acc[b][3]);
    __syncthreads();
    {
      const int b = tid >> 5, c = tid & 31;
      float v = 0.f;
#pragma unroll 8
      for (int g = 0; g < 32; ++g) v += red[(g * 8 + b) * 32 + c];
      p.mod()[(size_t)(l * 8 + b) * 6144 + j0 + c] = v + p.in.ada_b[l * 6144 + j0 + c];
    }
    __syncthreads();
    return;
  }
  it -= P0_MOD;
  if (it < P0_CS) {
    const int i = it * 256 + tid, t = i >> 5, f = i & 31;
    const float freq = __builtin_amdgcn_exp2f(-(float)f * (13.287712379549449f / 32.f));
    const float ang = (float)p.in.pos[t] * freq;
    const float rev = ang * 0.15915494309189535f;
    const float r = rev - floorf(rev);
    p.cs()[i] = make_float2(__builtin_amdgcn_cosf(r), __builtin_amdgcn_sinf(r));
    return;
  }
  it -= P0_CS;
  if (it < P0_SSM) {
    const int lg = it;
    if (tid < 64) {
      const int pp = tid;
      const float dt = expf(p.in.log_dt[lg]);
      const float lr = p.in.lam_re[lg * SP + pp], li = p.in.lam_im[lg * SP + pp];
      const float mag = expf(lr * dt);
      float sn, cn; sincosf(li * dt, &sn, &cn);
      const float ar = mag * cn, ai = mag * sn;
      const float den = lr * lr + li * li;
      const float fr = ((ar - 1.f) * lr + ai * li) / den, fi = (ai * lr - (ar - 1.f) * li) / den;
      p.ssmL()[(lg * SP + pp) * 2] = ar; p.ssmL()[(lg * SP + pp) * 2 + 1] = ai;
      unsigned wr[8], wi[8];
#pragma unroll
      for (int hh = 0; hh < 8; ++hh) {
        const float br0 = p.in.b_re[((size_t)lg * SP + pp) * SCH + 2 * hh], bi0 = p.in.b_im[((size_t)lg * SP + pp) * SCH + 2 * hh];
        const float br1 = p.in.b_re[((size_t)lg * SP + pp) * SCH + 2 * hh + 1], bi1 = p.in.b_im[((size_t)lg * SP + pp) * SCH + 2 * hh + 1];
        wr[hh] = pack2(fr * br0 - fi * bi0, fr * br1 - fi * bi1);
        wi[hh] = pack2(fr * bi0 + fi * br0, fr * bi1 + fi * br1);
      }
      u32x4* dr = (u32x4*)(p.ssmB() + ((size_t)lg * 128 + pp) * 16);
      u32x4* di = (u32x4*)(p.ssmB() + ((size_t)lg * 128 + 64 + pp) * 16);
      dr[0] = (u32x4){wr[0], wr[1], wr[2], wr[3]}; dr[1] = (u32x4){wr[4], wr[5], wr[6], wr[7]};
      di[0] = (u32x4){wi[0], wi[1], wi[2], wi[3]}; di[1] = (u32x4){wi[4], wi[5], wi[6], wi[7]};
    }
    for (int o = tid; o < 16 * 64; o += NTHR) {
      const int hh = o >> 6, pp = o & 63;
      const float cr = p.in.c_re[(size_t)lg * SCH * SP + o], ci = p.in.c_im[(size_t)lg * SCH * SP + o];
      *(unsigned*)(p.ssmC() + ((size_t)lg * 16 + hh) * 128 + 2 * pp) = pack2(cr, -ci);
    }
    return;
  }
  it -= P0_SSM;
  if (it < P0_WRF) {
    const int i = it * 256 + tid, ks = i >> 6, ln = i & 63;
    const float* w = p.in.w_router + ((size_t)32 * ks + 8 * (ln >> 4)) * NE + (ln & 15);
    unsigned hi[4], lo[4];
#pragma unroll
    for (int j = 0; j < 4; ++j) {
      const float w0 = w[(2 * j) * NE], w1 = w[(2 * j + 1) * NE];
      hi[j] = pack2(w0, w1);
      lo[j] = pack2(w0 - bf_lo(hi[j]), w1 - bf_hi(hi[j]));
    }
    u32x4* dst = p.wrf() + ((size_t)ks * 2) * 64 + ln;
    dst[0] = (u32x4){hi[0], hi[1], hi[2], hi[3]}; dst[64] = (u32x4){lo[0], lo[1], lo[2], lo[3]};
    return;
  }
  for (int i = tid; i < 256 * DEPTH; i += NTHR) p.cnt()[i] = 0;
}

struct TrDesc { const float* src; bf16_t* dst; const float* gain; int N, K, k0, n0; };
__device__ __forceinline__ void tr_decode(const MP& p, int it, TrDesc& d) {
  const int l = it / TT_LAYER; int r = it % TT_LAYER;
  d.gain = nullptr;
  if (r < TT_WIN) { d.src = p.in.w_in + (size_t)l * D * INW; d.N = INW; d.dst = p.WinT() + (size_t)l * INW * D; d.K = D; d.k0 = (r / 20) * 128; d.n0 = (r % 20) * 64; return; }
  r -= TT_WIN;
  if (r < TT_GLU) { d.src = p.in.w_glu + (size_t)l * SW * SW; d.N = SW; d.dst = p.WgluT() + (size_t)l * SW * SW; d.K = SW; d.k0 = (r / 8) * 128; d.n0 = (r % 8) * 64; return; }
  r -= TT_GLU;
  if (r < TT_OUT) {
    d.k0 = (r / 16) * 128; d.n0 = (r % 16) * 64;
    d.gain = d.k0 < 512 ? (p.in.attn_out_g + l * AW) : (p.in.ssm_out_g + l * SW - 512);
    d.src = p.in.w_out + (size_t)l * D * D; d.N = D; d.dst = p.WoutT() + (size_t)l * D * D; d.K = D; return; }
  r -= TT_OUT;
  const int kind = r / TT_EXP; r %= TT_EXP;
  const int e = r / 64, tt = r % 64;
  if (kind == 0) { d.src = p.in.w_gate + (size_t)(l * NE + e) * D * DFF; d.N = DFF; d.dst = p.WgT() + (size_t)(l * NE + e) * DFF * D; d.K = D; d.k0 = (tt / 8) * 128; d.n0 = (tt % 8) * 64; return; }
  if (kind == 1) { d.src = p.in.w_up + (size_t)(l * NE + e) * D * DFF; d.N = DFF; d.dst = p.WuT() + (size_t)(l * NE + e) * DFF * D; d.K = D; d.k0 = (tt / 8) * 128; d.n0 = (tt % 8) * 64; return; }
  d.src = p.in.w_down + (size_t)(l * NE + e) * DFF * D; d.N = D; d.dst = p.WdT() + (size_t)(l * NE + e) * D * DFF; d.K = DFF; d.k0 = (tt / 16) * 128; d.n0 = (tt % 16) * 64;
}
__device__ __forceinline__ void phase0_transposes(const MP& p, char* smem, int first, int last, int brank, int nblk) {
  const int tid = launder(threadIdx.x);
  float* lds = (float*)smem;
  const int r = tid >> 4, c4 = (tid & 15) * 4;
  const int n = tid >> 2, kq = (tid & 3) * 32;
  TrDesc cur, nxt;
  float4 v[8]; float gg[8];
  auto load = [&](const TrDesc& d) {
#pragma unroll
    for (int i = 0; i < 8; ++i) v[i] = *(const float4*)(d.src + (size_t)(d.k0 + r + 16 * i) * d.N + d.n0 + c4);
    if (d.gain) {
#pragma unroll
      for (int i = 0; i < 8; ++i) gg[i] = d.gain[d.k0 + r + 16 * i];
    } else {
#pragma unroll
      for (int i = 0; i < 8; ++i) gg[i] = 1.f;
    }
  };
  int it = first + brank;
  if (it < last) { tr_decode(p, it, cur); load(cur); nxt = cur; }
  for (; it < last; it += nblk) {
#pragma unroll
    for (int i = 0; i < 8; ++i) {
      float* d = lds + (r + 16 * i) * 65 + c4;
      d[0] = v[i].x * gg[i]; d[1] = v[i].y * gg[i]; d[2] = v[i].z * gg[i]; d[3] = v[i].w * gg[i];
    }
    __syncthreads();
    const int nit = it + nblk;
    if (nit < last) { tr_decode(p, nit, nxt); load(nxt); }
    unsigned w[16];
#pragma unroll
    for (int j = 0; j < 16; ++j) w[j] = pack2(lds[(kq + 2 * j) * 65 + n], lds[(kq + 2 * j + 1) * 65 + n]);
    u32x4* dd = (u32x4*)(cur.dst + (size_t)(cur.n0 + n) * cur.K + cur.k0 + kq);
#pragma unroll
    for (int j = 0; j < 4; ++j) dd[j] = (u32x4){w[4 * j], w[4 * j + 1], w[4 * j + 2], w[4 * j + 3]};
    __syncthreads();
    cur = nxt;
  }
}

template <bool XB>
__device__ __forceinline__ void norm_token(const void* __restrict__ xrow, const float* __restrict__ g, const float* __restrict__ sh,
                                           const float* __restrict__ sc, bf16_t* __restrict__ hr, int lane, float (&hv)[16]) {
  float4 v[4]; float ss = 0.f;
#pragma unroll
  for (int i = 0; i < 4; ++i) {
    if (XB) { const u32x2 r = *(const u32x2*)((const bf16_t*)xrow + lane * 4 + 256 * i); v[i] = make_float4(bf_lo(r[0]), bf_hi(r[0]), bf_lo(r[1]), bf_hi(r[1])); }
    else v[i] = *(const float4*)((const float*)xrow + lane * 4 + 256 * i);
    ss += v[i].x * v[i].x + v[i].y * v[i].y + v[i].z * v[i].z + v[i].w * v[i].w;
  }
  ss = wave_sum(ss);
  const float rinv = rsqrtf(ss * (1.f / D) + EPS);
#pragma unroll
  for (int i = 0; i < 4; ++i) {
    const int d = lane * 4 + 256 * i;
    const float4 gg = *(const float4*)(g + d), s1 = *(const float4*)(sc + d), s0 = *(const float4*)(sh + d);
    hv[4 * i + 0] = v[i].x * rinv * gg.x * (1.f + s1.x) + s0.x;
    hv[4 * i + 1] = v[i].y * rinv * gg.y * (1.f + s1.y) + s0.y;
    hv[4 * i + 2] = v[i].z * rinv * gg.z * (1.f + s1.z) + s0.z;
    hv[4 * i + 3] = v[i].w * rinv * gg.w * (1.f + s1.w) + s0.w;
    *(u32x2*)(hr + d) = (u32x2){pack2(hv[4 * i], hv[4 * i + 1]), pack2(hv[4 * i + 2], hv[4 * i + 3])};
  }
}

struct TokRange { int t0, step, end; };
__device__ __forceinline__ TokRange tok_range(int wave) {
  TokRange r;
  if ((gridDim.x & 7) == 0) { const int xcd = blockIdx.x & 7, lb = blockIdx.x >> 3, nlb = gridDim.x >> 3; r.t0 = xcd * S + lb * 4 + wave; r.step = nlb * 4; r.end = (xcd + 1) * S; }
  else { r.t0 = blockIdx.x * 4 + wave; r.step = gridDim.x * 4; r.end = T; }
  return r;
}
template <bool XB>
__device__ __forceinline__ void phase_norm1(const MP& p, int l, const float* xin) {
  const int tid = launder(threadIdx.x);
  const int wave = tid >> 6, lane = tid & 63;
  const float* modl = p.mod() + (size_t)l * 8 * 6144;
  const TokRange tr = tok_range(wave);
  for (int t = tr.t0; t < tr.end; t += tr.step) {
    const int b = t / S; float hv[16];
    norm_token<XB>(XB ? (const void*)(p.xb() + (size_t)t * D) : (const void*)(xin + (size_t)t * D), p.in.norm1_g + l * D, modl + (size_t)b * 6144, modl + (size_t)b * 6144 + 1024, p.h() + (size_t)t * D, lane, hv);
  }
}

struct GemmTile {
  const bf16_t* A0; const bf16_t* A1; long lda; int ksA;
  int arow[4];
  const bf16_t* Blo0; const bf16_t* Bhi0;
  const bf16_t* Blo1; const bf16_t* Bhi1;
  long ldb; int ksB;
  int K; int rot;
};

__device__ __forceinline__ int lds_off(int row, int chunk) { return row * 128 + ((chunk ^ ((row >> 1) & 7)) << 4); }

template <bool BSPLIT, bool MID>
__device__ __forceinline__ void gemm_mainloop_t(const GemmTile& g, const GemmTile& gnext, bool hasnext, bool preloaded, char* smem, f32x4 (&acc)[4][4],
                                                int ktmid, const float (&mids)[4]) {
  const int tid = launder(threadIdx.x), lane = tid & 63, wave = tid >> 6, wr = wave >> 1, wc = wave & 1, fr = lane & 15, fq = lane >> 4;
  const int r0 = tid >> 3, c8 = tid & 7;
  const int csrc = (c8 ^ ((r0 >> 1) & 7)) * 8;
  const int wbase = __builtin_amdgcn_readfirstlane(wave) * 1024;
#pragma unroll
  for (int m = 0; m < 4; ++m)
#pragma unroll
    for (int n = 0; n < 4; ++n) acc[m][n] = (f32x4){0.f, 0.f, 0.f, 0.f};
  auto stage = [&](const GemmTile& gg, int kt, int buf) {
    const int kk = ((kt + gg.rot) & (gg.K / 64 - 1)) * 64;
    const bf16_t* Ab = kk < gg.ksA ? gg.A0 + kk : gg.A1 + (kk - gg.ksA);
    const bool bs = kk < gg.ksB; const int kb = bs ? kk : kk - gg.ksB;
    char* As = smem + buf * 32768 + wbase; char* Bs = As + 16384;
#pragma unroll
    for (int i = 0; i < 4; ++i) {
      __builtin_amdgcn_global_load_lds((const void*)(Ab + (size_t)gg.arow[i] * gg.lda + csrc), (void*)(As + i * 4096), 16, 0, 0);
      const bf16_t* Bb = bs ? (i < 2 ? gg.Blo0 : gg.Bhi0) : (i < 2 ? gg.Blo1 : gg.Bhi1);
      __builtin_amdgcn_global_load_lds((const void*)(Bb + (size_t)(r0 + 32 * (i & 1)) * gg.ldb + kb + csrc), (void*)(Bs + i * 4096), 16, 0, 0);
    }
  };
  const int nk = g.K / 64;
  if (!preloaded) {
    stage(g, 0, 0);
    asm volatile("s_waitcnt vmcnt(0)" ::: "memory");
    __syncthreads();
  }
  for (int kt = 0; kt < nk; ++kt) {
    if (kt + 1 < nk) stage(g, kt + 1, (kt + 1) & 1);
    else if (hasnext) stage(gnext, 0, 0);
    if (MID && kt == ktmid) {
#pragma unroll
      for (int m = 0; m < 4; ++m)
#pragma unroll
        for (int n = 0; n < 4; ++n) acc[m][n] *= mids[m];
    }
    const char* As = smem + (kt & 1) * 32768; const char* Bs = As + 16384;
    {
      bf16x8 af[2][4], bfr[2][4];
#pragma unroll
      for (int ks = 0; ks < 2; ++ks) {
#pragma unroll
        for (int m = 0; m < 4; ++m) af[ks][m] = *(const bf16x8*)(As + lds_off(wr * 64 + 16 * m + fr, ks * 4 + fq));
#pragma unroll
        for (int n = 0; n < 4; ++n) {
          const int brow = BSPLIT ? ((n >> 1) * 64 + wc * 32 + (n & 1) * 16 + fr) : (wc * 64 + 16 * n + fr);
          bfr[ks][n] = *(const bf16x8*)(Bs + lds_off(brow, ks * 4 + fq));
        }
      }
#pragma unroll
      for (int ks = 0; ks < 2; ++ks)
#pragma unroll
        for (int m = 0; m < 4; ++m)
#pragma unroll
          for (int n = 0; n < 4; ++n) acc[m][n] = __builtin_amdgcn_mfma_f32_16x16x32_bf16(bfr[ks][n], af[ks][m], acc[m][n], 0, 0, 0);
      __builtin_amdgcn_sched_group_barrier(0x100, 8, 0);
#pragma unroll
      for (int i = 0; i < 8; ++i) { __builtin_amdgcn_sched_group_barrier(0x008, 2, 0); __builtin_amdgcn_sched_group_barrier(0x100, 1, 0); }
      __builtin_amdgcn_sched_group_barrier(0x008, 16, 0);
    }
    __builtin_amdgcn_sched_barrier(0);
    asm volatile("s_waitcnt vmcnt(0)" ::: "memory");
    __syncthreads();
  }
}
template <bool BSPLIT>
__device__ __forceinline__ void gemm_mainloop(const GemmTile& g, const GemmTile& gnext, bool hasnext, bool preloaded, char* smem, f32x4 (&acc)[4][4]) {
  const float dummy[4] = {1.f, 1.f, 1.f, 1.f};
  gemm_mainloop_t<BSPLIT, false>(g, gnext, hasnext, preloaded, smem, acc, -1, dummy);
}

struct TileMap { int base, ntl, lb, nlb; };
__device__ __forceinline__ TileMap tm_init(int nMt, int nNt) {
  TileMap t;
  if ((gridDim.x & 7) == 0) {
    const int xcd = blockIdx.x & 7;
    t.lb = blockIdx.x >> 3; t.nlb = gridDim.x >> 3;
    const int mlo = (nMt * xcd) >> 3, mhi = (nMt * (xcd + 1)) >> 3;
    t.base = mlo * nNt; t.ntl = (mhi - mlo) * nNt;
  } else { t.lb = blockIdx.x; t.nlb = gridDim.x; t.base = 0; t.ntl = nMt * nNt; }
  return t;
}
__device__ __forceinline__ int tm_tile(const TileMap& t, int j) { const int li = t.lb + t.nlb * j; return li < t.ntl ? t.base + li : -1; }
template <bool FUSEN>
__device__ __forceinline__ void phase_inproj(const MP& p, int l, char* smem) {
  const int tid = launder(threadIdx.x), lane = tid & 63, wave = tid >> 6, wr = wave >> 1, wc = wave & 1, fr = lane & 15, fq = lane >> 4;
  const int r0 = tid >> 3;
  const int ntiles = (T / 128) * (INW / 128);
  const bf16_t* W = p.WinT() + (size_t)l * INW * D;
  auto make = [&](int tile, GemmTile& g) {
    const int m0 = (tile / 10) * 128, n0 = (tile % 10) * 128;
    g.A0 = FUSEN ? p.xb() : p.h(); g.A1 = g.A0; g.lda = D; g.ksA = D; g.K = D;
#pragma unroll
    for (int i = 0; i < 4; ++i) g.arow[i] = m0 + r0 + 32 * i;
    const bf16_t* Wt = FUSEN ? p.w1b() + (size_t)(m0 / S) * INW * D : W;
    g.Blo0 = Wt + (size_t)n0 * D; g.Bhi0 = g.Blo0 + (size_t)64 * D; g.Blo1 = g.Blo0; g.Bhi1 = g.Bhi0;
    g.ldb = D; g.ksB = D; g.rot = ROT_OF(tile / 10, tile % 10);
  };
  GemmTile g, gn; bool pre = false;
  const TileMap tmap = tm_init(T / 128, INW / 128);
  { const int t0 = tm_tile(tmap, 0); if (t0 >= 0) { make(t0, g); gn = g; } }
  for (int jt = 0; ; ++jt) {
    const int tile = tm_tile(tmap, jt); if (tile < 0) break;
    const int mt = tile / 10, nt = tile % 10, m0 = mt * 128;
    const int nxt = tm_tile(tmap, jt + 1); const bool hasn = nxt >= 0;
    if (hasn) make(nxt, gn);
    f32x4 acc[4][4];
    gemm_mainloop<false>(g, gn, hasn, pre, smem, acc);
    pre = hasn; g = gn;
    const int rowb = m0 + wr * 64 + fr;
    if (FUSEN) {
      f32x4 sq[4][4], bz[4];
#pragma unroll
      for (int m = 0; m < 4; ++m)
#pragma unroll
        for (int i = 0; i < 4; ++i) sq[m][i] = *(const f32x4*)(p.ssqx() + (size_t)(rowb + 16 * m) * 16 + 4 * i);
#pragma unroll
      for (int n = 0; n < 4; ++n) bz[n] = *(const f32x4*)(p.bias1() + (size_t)(m0 / S) * INW + nt * 128 + wc * 64 + 16 * n + 4 * fq);
#pragma unroll
      for (int m = 0; m < 4; ++m) {
        float ssx = 0.f;
#pragma unroll
        for (int i = 0; i < 4; ++i) ssx += (sq[m][i][0] + sq[m][i][1]) + (sq[m][i][2] + sq[m][i][3]);
        const float rinv = rsqrtf(ssx * (1.f / D) + EPS);
#pragma unroll
        for (int n = 0; n < 4; ++n)
#pragma unroll
          for (int j = 0; j < 4; ++j) acc[m][n][j] = acc[m][n][j] * rinv + bz[n][j];
      }
    }
    if (nt <= 4) {
      const float* gv = (nt < 4 ? p.in.q_norm_g : p.in.k_norm_g) + l * HD;
      const float scl = nt < 4 ? 0.125f * 1.4426950408889634f : 1.f;
      f32x4 g1[2], g2[2];
#pragma unroll
      for (int n = 0; n < 2; ++n) { g1[n] = *(const f32x4*)(gv + 16 * n + 4 * fq); g2[n] = *(const f32x4*)(gv + 32 + 16 * n + 4 * fq); }
      f32x4 csv[4][2][2];
#pragma unroll
      for (int m = 0; m < 4; ++m)
#pragma unroll
        for (int n = 0; n < 2; ++n) {
          const float* cp = (const float*)p.cs() + ((size_t)(rowb + 16 * m) * 32 + 16 * n + 4 * fq) * 2;
          csv[m][n][0] = *(const f32x4*)cp; csv[m][n][1] = *(const f32x4*)(cp + 4);
        }
#pragma unroll
      for (int m = 0; m < 4; ++m) {
        const int t = rowb + 16 * m;
        float ss = 0.f;
#pragma unroll
        for (int n = 0; n < 4; ++n)
#pragma unroll
          for (int j = 0; j < 4; ++j) ss += acc[m][n][j] * acc[m][n][j];
        ss += __shfl_xor(ss, 16); ss += __shfl_xor(ss, 32);
        const float rinv = rsqrtf(ss * (1.f / 64.f) + EPS) * scl;
        bf16_t* dst = nt < 4 ? (p.q() + (size_t)t * AW + (2 * nt + wc) * 64) : (p.k() + (size_t)t * 128 + wc * 64);
#pragma unroll
        for (int n = 0; n < 2; ++n) {
          const int c = 16 * n + 4 * fq;
          const f32x4 csa = csv[m][n][0], csb = csv[m][n][1];
          const float cn[4] = {csa[0], csa[2], csb[0], csb[2]}, sn[4] = {csa[1], csa[3], csb[1], csb[3]};
          float o1[4], o2[4];
#pragma unroll
          for (int j = 0; j < 4; ++j) {
            const float x1 = acc[m][n][j] * rinv * g1[n][j], x2 = acc[m][n + 2][j] * rinv * g2[n][j];
            o1[j] = x1 * cn[j] - x2 * sn[j]; o2[j] = x2 * cn[j] + x1 * sn[j];
          }
          *(u32x2*)(dst + c) = (u32x2){pack2(o1[0], o1[1]), pack2(o1[2], o1[3])};
          *(u32x2*)(dst + 32 + c) = (u32x2){pack2(o2[0], o2[1]), pack2(o2[2], o2[3])};
        }
      }
    } else if (nt == 5) {
      const int b = m0 / S;
      char* Tl = smem + 32768;
#pragma unroll
      for (int m = 0; m < 4; ++m) {
        const int r = wr * 64 + 16 * m + fr;
        const int k16 = r & 15;
        const int rp = (r & ~15) | (k16 & 3) | (((k16 >> 3) & 1) << 2) | (((k16 >> 2) & 1) << 3);
#pragma unroll
        for (int n = 0; n < 4; ++n)
#pragma unroll
          for (int j = 0; j < 4; ++j)
            *(bf16_t*)(Tl + (wc * 64 + 16 * n + 4 * fq + j) * 256 + rp * 2) = (bf16_t)(pack2(acc[m][n][j], 0.f) & 0xffffu);
      }
      __syncthreads();
      const int sb = m0 % S;
#pragma unroll
      for (int i = 0; i < 8; ++i) {
        const int ch = tid + 256 * i, dg = ch >> 4, c16 = ch & 15;
        const u32x4 v = *(const u32x4*)(Tl + dg * 256 + c16 * 16);
        *(u32x4*)(p.vT() + ((size_t)(b * 2) * 64 + dg) * S + sb + c16 * 8) = v;
      }
      __syncthreads();
    } else {
#pragma unroll
      for (int m = 0; m < 4; ++m) {
        const int t = rowb + 16 * m;
#pragma unroll
        for (int n = 0; n < 4; ++n)
          *(u32x2*)(p.u() + (size_t)t * SW + (nt - 6) * 128 + wc * 64 + 16 * n + 4 * fq) = (u32x2){pack2(acc[m][n][0], acc[m][n][1]), pack2(acc[m][n][2], acc[m][n][3])};
      }
    }
  }
}

__device__ __forceinline__ int crow32(int r, int hf) { return (r & 3) + 8 * (r >> 2) + 4 * hf; }
__device__ __forceinline__ void attn_task(const MP& p, int l, int task, int lane) {
  lane = launder(lane);
  task = __builtin_amdgcn_readfirstlane(task);
  const int h = task & 7, qt = (task >> 3) & 63, b = task >> 9, kvh = h >> 2;
  const int s0 = qt * 32, t0 = b * S + s0, ql = lane & 31, hf = lane >> 5;
  int kst[5];
#pragma unroll
  for (int kt = 0; kt < 5; ++kt) { const int ks = s0 - 128 + 32 * kt; kst[kt] = ks < 0 ? 0 : ks; }
  bf16x8 qf[4], kf[5][4];
#pragma unroll
  for (int st = 0; st < 4; ++st) qf[st] = *(const bf16x8*)(p.q() + (size_t)(t0 + ql) * AW + h * 64 + 16 * st + 8 * hf);
#pragma unroll
  for (int kt = 0; kt < 5; ++kt)
#pragma unroll
    for (int st = 0; st < 4; ++st) kf[kt][st] = *(const bf16x8*)(p.k() + (size_t)(b * S + kst[kt] + ql) * 128 + kvh * 64 + 8 * hf + 16 * st);
  f32x16 sc[5];
#pragma unroll
  for (int kt = 0; kt < 5; ++kt) {
#pragma unroll
    for (int r = 0; r < 16; ++r) sc[kt][r] = 0.f;
#pragma unroll
    for (int st = 0; st < 4; ++st) sc[kt] = __builtin_amdgcn_mfma_f32_32x32x16_bf16(kf[kt][st], qf[st], sc[kt], 0, 0, 0);
  }
  bf16x8 vb[5][2][2];
#pragma unroll
  for (int kt = 0; kt < 5; ++kt)
#pragma unroll
    for (int s = 0; s < 2; ++s)
#pragma unroll
      for (int dt = 0; dt < 2; ++dt)
        vb[kt][s][dt] = *(const bf16x8*)(p.vT() + ((size_t)(b * 2 + kvh) * 64 + 32 * dt + ql) * S + kst[kt] + 16 * s + 8 * hf);
  const float sink = p.in.attn_sink[l * NQ + h];
  float mx = sink;
#pragma unroll
  for (int kt = 0; kt < 5; ++kt) {
#pragma unroll
    for (int r = 0; r < 16; ++r) {
      const int kp = s0 - 128 + 32 * kt + crow32(r, hf);
      const int dk = kp - (s0 + ql);
      const bool valid = kp >= 0 && dk <= 0 && dk > -128;
      sc[kt][r] = valid ? sc[kt][r] : -1e30f;
      mx = fmaxf(mx, sc[kt][r]);
    }
  }
  mx = xhalf_max(mx);
  float lsum = 0.f;
#pragma unroll
  for (int kt = 0; kt < 5; ++kt) {
#pragma unroll
    for (int r = 0; r < 16; ++r) { const float e = __expf(sc[kt][r] - mx); sc[kt][r] = e; lsum += e; }
  }
  lsum = xhalf_sum(lsum);
  lsum += __expf(sink - mx);
  const float inv = 1.f / lsum;
  f32x16 o[2];
#pragma unroll
  for (int r = 0; r < 16; ++r) { o[0][r] = 0.f; o[1][r] = 0.f; }
#pragma unroll
  for (int kt = 0; kt < 5; ++kt) {
#pragma unroll
    for (int s = 0; s < 2; ++s) {
      u32x4 pw;
#pragma unroll
      for (int j = 0; j < 4; ++j) pw[j] = pack2(sc[kt][8 * s + 2 * j], sc[kt][8 * s + 2 * j + 1]);
      const bf16x8 pa = __builtin_bit_cast(bf16x8, pw);
#pragma unroll
      for (int dt = 0; dt < 2; ++dt) o[dt] = __builtin_amdgcn_mfma_f32_32x32x16_bf16(vb[kt][s][dt], pa, o[dt], 0, 0, 0);
    }
  }
  bf16_t* dst = p.attn() + (size_t)(t0 + ql) * AW + h * 64 + 4 * hf;
  float ssq = 0.f;
#pragma unroll
  for (int dt = 0; dt < 2; ++dt)
#pragma unroll
    for (int g4 = 0; g4 < 4; ++g4) {
      const float a0 = o[dt][4 * g4] * inv, a1 = o[dt][4 * g4 + 1] * inv, a2 = o[dt][4 * g4 + 2] * inv, a3 = o[dt][4 * g4 + 3] * inv;
      ssq += (a0 * a0 + a1 * a1) + (a2 * a2 + a3 * a3);
      *(u32x2*)(dst + 32 * dt + 8 * g4) = (u32x2){pack2(a0, a1), pack2(a2, a3)};
    }
  ssq = xhalf_sum(ssq);
  if (hf == 0) p.ssqa()[(size_t)(t0 + ql) * 8 + h] = ssq;
}
constexpr int SSEG = 4, SEGLEN = S / SSEG, SEGCH = SEGLEN / 32;

__device__ __forceinline__ void ssm_bu(const bf16x8& ua, const bf16x8 (&bB)[4], f32x16 (&bu)[4]) {
#pragma unroll
  for (int nt = 0; nt < 4; ++nt) {
#pragma unroll
    for (int r = 0; r < 16; ++r) bu[nt][r] = 0.f;
    bu[nt] = __builtin_amdgcn_mfma_f32_32x32x16_bf16(ua, bB[nt], bu[nt], 0, 0, 0);
  }
  asm volatile("s_nop 15\n\ts_nop 7" : "+v"(bu[0]), "+v"(bu[1]), "+v"(bu[2]), "+v"(bu[3]));
#pragma unroll
  for (int r = 0; r < 16; ++r) {
    auto s0 = __builtin_amdgcn_permlane32_swap(__float_as_uint(bu[0][r]), __float_as_uint(bu[1][r]), false, false);
    bu[0][r] = __uint_as_float(s0[0]); bu[1][r] = __uint_as_float(s0[1]);
    auto s1 = __builtin_amdgcn_permlane32_swap(__float_as_uint(bu[2][r]), __float_as_uint(bu[3][r]), false, false);
    bu[2][r] = __uint_as_float(s1[0]); bu[3][r] = __uint_as_float(s1[1]);
  }
}

__device__ __forceinline__ void ssm_block(const MP& p, int l, int b, int g, int tid, char* smem) {
  const int lane = tid & 63, seg = tid >> 6;
  char* wl = smem + seg * 8192;
  float* fin = (float*)(smem + 4 * 8192);
  const int lg = l * SG + g, hf = lane >> 5, fr = lane & 15, fq = lane >> 4;
  const float ar = p.ssmL()[(lg * SP + lane) * 2], ai = p.ssmL()[(lg * SP + lane) * 2 + 1];
  bf16x8 bB[4], cB[4];
#pragma unroll
  for (int nt = 0; nt < 4; ++nt) bB[nt] = *(const bf16x8*)(p.ssmB() + ((size_t)lg * 128 + nt * 32 + (lane & 31)) * 16 + 8 * hf);
#pragma unroll
  for (int ks = 0; ks < 4; ++ks) cB[ks] = *(const bf16x8*)(p.ssmC() + ((size_t)lg * 16 + fr) * 128 + 32 * ks + 8 * fq);
  const f32x4 dsk = *(const f32x4*)(p.in.ssm_d + l * SW + g * 16 + 4 * fq);
  const int t0 = b * S + seg * SEGLEN;
  const bf16_t* urow = p.u() + (size_t)(t0 + (lane & 31)) * SW + g * 16 + 8 * hf;
  float xr = 0.f, xi = 0.f;
  if (seg < SSEG - 1) {
    bf16x8 ua = *(const bf16x8*)(urow);
    for (int c = 0; c < SEGCH; ++c) {
      const bf16x8 un = *(const bf16x8*)(urow + (size_t)((c + 1 < SEGCH ? c + 1 : c) * 32) * SW);
      f32x16 bu[4];
      ssm_bu(ua, bB, bu);
#pragma unroll
      for (int r4 = 0; r4 < 4; ++r4)
#pragma unroll
        for (int half = 0; half < 2; ++half)
#pragma unroll
          for (int j = 0; j < 4; ++j) {
            const int r = 4 * r4 + j;
            const float bre = half ? bu[1][r] : bu[0][r], bim = half ? bu[3][r] : bu[2][r];
            const float nr = ar * xr - ai * xi + bre, ni = ar * xi + ai * xr + bim;
            xr = nr; xi = ni;
          }
      ua = un;
    }
  }
  fin[(seg * 64 + lane) * 2] = xr; fin[(seg * 64 + lane) * 2 + 1] = xi;
  __syncthreads();
  {
    float pr = ar, pi = ai;
#pragma unroll
    for (int i = 0; i < 9; ++i) { const float nr = pr * pr - pi * pi, ni = 2.f * pr * pi; pr = nr; pi = ni; }
    static_assert(SEGLEN == 512, "lam^SEGLEN squaring count");
    float cr = 0.f, ci = 0.f;
    for (int j = 0; j < seg; ++j) {
      const float fr_ = fin[(j * 64 + lane) * 2], fi_ = fin[(j * 64 + lane) * 2 + 1];
      const float nr = pr * cr - pi * ci + fr_, ni = pr * ci + pi * cr + fi_;
      cr = nr; ci = ni;
    }
    xr = cr; xi = ci;
  }
  const int wbase = (lane & 3) * 4;
  const int pch = lane >> 2;
  const bf16_t* uep = p.u() + (size_t)(t0 + fr) * SW + g * 16 + 4 * fq;
  bf16x8 ua = *(const bf16x8*)(urow);
  u32x2 uraw[2];
#pragma unroll
  for (int i = 0; i < 2; ++i) uraw[i] = *(const u32x2*)(uep + (size_t)(16 * i) * SW);
  for (int c = 0; c < SEGCH; ++c) {
    const int tb = t0 + c * 32;
    const int cn = (c + 1 < SEGCH ? c + 1 : c) * 32;
    const bf16x8 un = *(const bf16x8*)(urow + (size_t)cn * SW);
    u32x2 unraw[2];
#pragma unroll
    for (int i = 0; i < 2; ++i) unraw[i] = *(const u32x2*)(uep + (size_t)(cn + 16 * i) * SW);
    f32x16 bu[4];
    ssm_bu(ua, bB, bu);
#pragma unroll
    for (int r4 = 0; r4 < 4; ++r4) {
#pragma unroll
      for (int half = 0; half < 2; ++half) {
#pragma unroll
        for (int j = 0; j < 4; ++j) {
          const int t = 8 * r4 + 4 * half + j, r = 4 * r4 + j;
          const float bre = half ? bu[1][r] : bu[0][r], bim = half ? bu[3][r] : bu[2][r];
          const float nr = ar * xr - ai * xi + bre, ni = ar * xi + ai * xr + bim;
          xr = nr; xi = ni;
          *(unsigned*)(wl + t * 256 + ((pch ^ (t & 15)) << 4) + wbase) = pack2(nr, ni);
        }
      }
    }
    asm volatile("s_waitcnt lgkmcnt(0)" ::: "memory");
#pragma unroll
    for (int mt = 0; mt < 2; ++mt) {
      f32x4 acc = {0.f, 0.f, 0.f, 0.f};
      const int t = 16 * mt + fr;
#pragma unroll
      for (int ks = 0; ks < 4; ++ks) {
        const bf16x8 af = *(const bf16x8*)(wl + t * 256 + (((4 * ks + fq) ^ (t & 15)) << 4));
        acc = __builtin_amdgcn_mfma_f32_16x16x32_bf16(cB[ks], af, acc, 0, 0, 0);
      }
      const float uu[4] = {bf_lo(uraw[mt][0]), bf_hi(uraw[mt][0]), bf_lo(uraw[mt][1]), bf_hi(uraw[mt][1])};
      float ge[4];
#pragma unroll
      for (int j = 0; j < 4; ++j) {
        const float v = acc[j] + dsk[j] * uu[j];
        const float z2 = 1.5957691216057308f * (v + 0.044715f * v * v * v);
        ge[j] = v * __builtin_amdgcn_rcpf(1.f + __expf(-z2));
      }
      *(u32x2*)(p.y() + (size_t)(tb + t) * SW + g * 16 + 4 * fq) = (u32x2){pack2(ge[0], ge[1]), pack2(ge[2], ge[3])};
    }
    asm volatile("s_waitcnt lgkmcnt(0)" ::: "memory");
    ua = un;
#pragma unroll
    for (int i = 0; i < 2; ++i) uraw[i] = unraw[i];
  }
}

constexpr int ATT_KBYTES = 160 * 128, ATT_VCH = 21, ATT_VBYTES = 64 * ATT_VCH * 16;
__device__ __forceinline__ void attn_block(const MP& p, int l, int b, int qt, int kvh, char* smem, int tid) {
  const int lane = tid & 63, wave = __builtin_amdgcn_readfirstlane(tid >> 6);
  const int h = kvh * 4 + wave;
  const int s0 = qt * 32, t0 = b * S + s0, ql = lane & 31, hf = lane >> 5;
  char* Ks = smem; char* Vs = smem + ATT_KBYTES;
  {
    const bf16_t* kb = p.k() + (size_t)b * S * 128 + kvh * 64;
#pragma unroll
    for (int j = 0; j < 5; ++j) {
      const int pc = wave + 4 * j;
      const int R = 8 * pc + (lane >> 3);
      int ks = s0 - 128 + R; ks = ks < 0 ? 0 : ks;
      const int c = (lane & 7) ^ ((R >> 1) & 7);
      __builtin_amdgcn_global_load_lds((const void*)(kb + (size_t)ks * 128 + c * 8), (void*)(Ks + pc * 1024), 16, 0, 0);
    }
    const bf16_t* vbp = p.vT() + (size_t)(b * 2 + kvh) * 64 * S;
#pragma unroll
    for (int j = 0; j < 6; ++j) {
      const int pc = wave + 4 * j;
      if (pc < ATT_VCH) {
        const int q = 64 * pc + lane, d = q / ATT_VCH, c = q - d * ATT_VCH;
        int ko = s0 - 128 + 8 * (c < 20 ? c : 19); ko = ko < 0 ? 0 : ko;
        __builtin_amdgcn_global_load_lds((const void*)(vbp + (size_t)d * S + ko), (void*)(Vs + pc * 1024), 16, 0, 0);
      }
    }
  }
  bf16x8 qf[4];
#pragma unroll
  for (int st = 0; st < 4; ++st) qf[st] = *(const bf16x8*)(p.q() + (size_t)(t0 + ql) * AW + h * 64 + 16 * st + 8 * hf);
  asm volatile("s_waitcnt vmcnt(0)" ::: "memory");
  __syncthreads();
  f32x16 sc[5];
#pragma unroll
  for (int kt = 0; kt < 5; ++kt) {
#pragma unroll
    for (int r = 0; r < 16; ++r) sc[kt][r] = 0.f;
#pragma unroll
    for (int st = 0; st < 4; ++st) {
      const int R = 32 * kt + ql, c = 2 * st + hf;
      const bf16x8 kf = *(const bf16x8*)(Ks + R * 128 + ((c ^ ((R >> 1) & 7)) << 4));
      sc[kt] = __builtin_amdgcn_mfma_f32_32x32x16_bf16(kf, qf[st], sc[kt], 0, 0, 0);
    }
  }
  const float sink = p.in.attn_sink[l * NQ + h] * 1.4426950408889634f;
  const int qlh = ql - 4 * hf;
  float mx = sink;
#pragma unroll
  for (int kt = 0; kt < 5; ++kt) {
    const float tbias = (s0 - 128 + 32 * kt) >= 0 ? 0.f : -1e30f;
#pragma unroll
    for (int r = 0; r < 16; ++r) {
      const int cr = (r & 3) + 8 * (r >> 2);
      float v = sc[kt][r];
      if (kt == 0) v = cr > qlh ? v + tbias : -1e30f;
      else if (kt == 4) v = cr <= qlh ? v : -1e30f;
      else v = v + tbias;
      sc[kt][r] = v;
      mx = fmaxf(mx, v);
    }
  }
  mx = xhalf_max(mx);
  float lsum = 0.f;
#pragma unroll
  for (int kt = 0; kt < 5; ++kt) {
#pragma unroll
    for (int r = 0; r < 16; ++r) { const float e = __builtin_amdgcn_exp2f(sc[kt][r] - mx); sc[kt][r] = e; lsum += e; }
  }
  lsum = xhalf_sum(lsum);
  lsum += __builtin_amdgcn_exp2f(sink - mx);
  const float inv = 1.f / lsum;
  f32x16 o[2];
#pragma unroll
  for (int r = 0; r < 16; ++r) { o[0][r] = 0.f; o[1][r] = 0.f; }
#pragma unroll
  for (int kt = 0; kt < 5; ++kt) {
#pragma unroll
    for (int s = 0; s < 2; ++s) {
      u32x4 pw;
#pragma unroll
      for (int j = 0; j < 4; ++j) pw[j] = pack2(sc[kt][8 * s + 2 * j], sc[kt][8 * s + 2 * j + 1]);
      const bf16x8 pa = __builtin_bit_cast(bf16x8, pw);
#pragma unroll
      for (int dt = 0; dt < 2; ++dt) {
        const bf16x8 vb = *(const bf16x8*)(Vs + ((32 * dt + ql) * ATT_VCH + 4 * kt + 2 * s + hf) * 16);
        o[dt] = __builtin_amdgcn_mfma_f32_32x32x16_bf16(vb, pa, o[dt], 0, 0, 0);
      }
    }
  }
  bf16_t* dst = p.attn() + (size_t)(t0 + ql) * AW + h * 64 + 4 * hf;
  float ssq = 0.f;
#pragma unroll
  for (int dt = 0; dt < 2; ++dt)
#pragma unroll
    for (int g4 = 0; g4 < 4; ++g4) {
      const float a0 = o[dt][4 * g4] * inv, a1 = o[dt][4 * g4 + 1] * inv, a2 = o[dt][4 * g4 + 2] * inv, a3 = o[dt][4 * g4 + 3] * inv;
      ssq += (a0 * a0 + a1 * a1) + (a2 * a2 + a3 * a3);
      *(u32x2*)(dst + 32 * dt + 8 * g4) = (u32x2){pack2(a0, a1), pack2(a2, a3)};
    }
  ssq = xhalf_sum(ssq);
  if (hf == 0) p.ssqa()[(size_t)(t0 + ql) * 8 + h] = ssq;
  __syncthreads();
}

__device__ __forceinline__ void phase_attn(const MP& p, int l, char* smem) {
  const int tid = launder(threadIdx.x);
  if ((gridDim.x & 7) == 0) {
    const int xcd = blockIdx.x & 7, lb = blockIdx.x >> 3, nlb = gridDim.x >> 3;
#pragma unroll 1
    for (int it = lb; it < 128; it += nlb) attn_block(p, l, xcd, it & 63, it >> 6, smem, tid);
  } else {
#pragma unroll 1
    for (int it = blockIdx.x; it < NB * 128; it += gridDim.x) attn_block(p, l, it >> 7, it & 63, (it >> 6) & 1, smem, tid);
  }
}
__device__ __forceinline__ void phase_ssm(const MP& p, int l, char* smem, int wid, int lrank) {
  const int tid = launder(threadIdx.x);
  if (wid < 0) return;
  unsigned nwl = 0; bool all = (gridDim.x & 7) == 0;
#pragma unroll
  for (int x = 0; x < 8; ++x) {
    const unsigned c = __hip_atomic_load(p.claim() + 4104 + x, __ATOMIC_RELAXED, __HIP_MEMORY_SCOPE_AGENT);
    all = all && c > 0u; nwl = (x == (int)(blockIdx.x & 7)) ? c : nwl;
  }
  if (all) {
    const int b = blockIdx.x & 7;
    for (int g = lrank; g < SG; g += (int)nwl) { ssm_block(p, l, b, g, tid, smem); __syncthreads(); }
  } else {
    const int nw = (int)__hip_atomic_load(p.claim() + 4096, __ATOMIC_RELAXED, __HIP_MEMORY_SCOPE_AGENT);
    for (int task = wid; task < NB * SG; task += nw) { ssm_block(p, l, task / SG, task % SG, tid, smem); __syncthreads(); }
  }
}
__device__ __forceinline__ void phase_glu(const MP& p, int l, char* smem) {
  const int tid = launder(threadIdx.x), lane = tid & 63, wave = tid >> 6, wr = wave >> 1, wc = wave & 1, fr = lane & 15, fq = lane >> 4;
  const int r0 = tid >> 3;
  const int ntiles = (T / 128) * (SW / 128);
  const bf16_t* W = p.WgluT() + (size_t)l * SW * SW;
  auto make = [&](int tile, GemmTile& g) {
    const int m0 = (tile >> 2) * 128, n0 = (tile & 3) * 128;
    g.A0 = p.y(); g.A1 = p.y(); g.lda = SW; g.ksA = SW; g.K = SW;
#pragma unroll
    for (int i = 0; i < 4; ++i) g.arow[i] = m0 + r0 + 32 * i;
    g.Blo0 = W + (size_t)n0 * SW; g.Bhi0 = g.Blo0 + (size_t)64 * SW; g.Blo1 = g.Blo0; g.Bhi1 = g.Bhi0;
    g.ldb = SW; g.ksB = SW; g.rot = ROT_OF(tile >> 2, tile & 3) & 7;
  };
  GemmTile g, gn; bool pre = false;
  const TileMap tmap = tm_init(T / 128, SW / 128);
  { const int t0 = tm_tile(tmap, 0); if (t0 >= 0) { make(t0, g); gn = g; } }
  for (int jt = 0; ; ++jt) {
    const int tile = tm_tile(tmap, jt); if (tile < 0) break;
    const int mt = tile >> 2, nt = tile & 3, m0 = mt * 128, n0 = nt * 128;
    const int nxt = tm_tile(tmap, jt + 1); const bool hasn = nxt >= 0;
    if (hasn) make(nxt, gn);
    f32x4 acc[4][4];
    gemm_mainloop<false>(g, gn, hasn, pre, smem, acc);
    pre = hasn; g = gn;
    u32x2 yrv[4][4];
#pragma unroll
    for (int m = 0; m < 4; ++m)
#pragma unroll
      for (int n = 0; n < 4; ++n) yrv[m][n] = *(const u32x2*)(p.y() + (size_t)(m0 + wr * 64 + 16 * m + fr) * SW + n0 + wc * 64 + 16 * n + 4 * fq);
#pragma unroll
    for (int m = 0; m < 4; ++m) {
      const int t = m0 + wr * 64 + 16 * m + fr;
      float ss = 0.f;
#pragma unroll
      for (int n = 0; n < 4; ++n) {
        const int col = n0 + wc * 64 + 16 * n + 4 * fq;
        const u32x2 yr = yrv[m][n];
        const float yv[4] = {bf_lo(yr[0]), bf_hi(yr[0]), bf_lo(yr[1]), bf_hi(yr[1])};
        float o[4];
#pragma unroll
        for (int j = 0; j < 4; ++j) { o[j] = yv[j] * __builtin_amdgcn_rcpf(1.f + __expf(-acc[m][n][j])); ss += o[j] * o[j]; }
        *(u32x2*)(p.ssm() + (size_t)t * SW + col) = (u32x2){pack2(o[0], o[1]), pack2(o[2], o[3])};
      }
      ss += __shfl_xor(ss, 16); ss += __shfl_xor(ss, 32);
      if (fq == 0) p.ssqs()[(size_t)t * 8 + nt * 2 + wc] = ss;
    }
  }
}

template <bool XB>
__device__ __forceinline__ void phase_out(const MP& p, int l, char* smem, const float* xin) {
  const int tid = launder(threadIdx.x), lane = tid & 63, wave = tid >> 6, wr = wave >> 1, wc = wave & 1, fr = lane & 15, fq = lane >> 4;
  const int r0 = tid >> 3;
  const float* modl = p.mod() + (size_t)l * 8 * 6144;
  const int ntiles = (T / 128) * (D / 128);
  const bf16_t* W = p.WoutT() + (size_t)l * D * D;
  auto make = [&](int tile, GemmTile& g) {
    const int m0 = (tile >> 3) * 128, n0 = (tile & 7) * 128;
    g.A0 = p.attn(); g.A1 = p.ssm(); g.lda = AW; g.ksA = AW; g.K = D;
#pragma unroll
    for (int i = 0; i < 4; ++i) g.arow[i] = m0 + r0 + 32 * i;
    g.Blo0 = W + (size_t)n0 * D; g.Bhi0 = g.Blo0 + (size_t)64 * D; g.Blo1 = g.Blo0; g.Bhi1 = g.Bhi0;
    g.ldb = D; g.ksB = D; g.rot = 0;
  };
  GemmTile g, gn; bool pre = false;
  const TileMap tmap = tm_init(T / 128, D / 128);
  { const int t0 = tm_tile(tmap, 0); if (t0 >= 0) { make(t0, g); gn = g; } }
  for (int jt = 0; ; ++jt) {
    const int tile = tm_tile(tmap, jt); if (tile < 0) break;
    const int mt = tile >> 3, nt = tile & 7, m0 = mt * 128, n0 = nt * 128, b = m0 / S;
    const int nxt = tm_tile(tmap, jt + 1); const bool hasn = nxt >= 0;
    if (hasn) make(nxt, gn);
    float mids[4], rs[4];
#pragma unroll
    for (int m = 0; m < 4; ++m) {
      const int t = m0 + wr * 64 + 16 * m + fr;
      const f32x4 a0 = *(const f32x4*)(p.ssqa() + (size_t)t * 8), a1 = *(const f32x4*)(p.ssqa() + (size_t)t * 8 + 4);
      const f32x4 s0 = *(const f32x4*)(p.ssqs() + (size_t)t * 8), s1 = *(const f32x4*)(p.ssqs() + (size_t)t * 8 + 4);
      const float sa = ((a0[0] + a0[1]) + (a0[2] + a0[3])) + ((a1[0] + a1[1]) + (a1[2] + a1[3]));
      const float sq = ((s0[0] + s0[1]) + (s0[2] + s0[3])) + ((s1[0] + s1[1]) + (s1[2] + s1[3]));
      const float ra = rsqrtf(sa * (1.f / 512.f) + EPS);
      rs[m] = rsqrtf(sq * (1.f / 512.f) + EPS);
      mids[m] = ra / rs[m];
    }
    f32x4 acc[4][4];
    gemm_mainloop_t<false, true>(g, gn, hasn, pre, smem, acc, 8, mids);
    pre = hasn; g = gn;
    f32x4 g1v[4], xvv[4][4]; u32x2 xbv[4][4];
#pragma unroll
    for (int n = 0; n < 4; ++n) g1v[n] = *(const f32x4*)(modl + (size_t)b * 6144 + 2 * 1024 + n0 + wc * 64 + 16 * n + 4 * fq);
#pragma unroll
    for (int m = 0; m < 4; ++m)
#pragma unroll
      for (int n = 0; n < 4; ++n) {
        const size_t xo = (size_t)(m0 + wr * 64 + 16 * m + fr) * D + n0 + wc * 64 + 16 * n + 4 * fq;
        if (XB) xbv[m][n] = *(const u32x2*)(p.xb() + xo); else xvv[m][n] = *(const f32x4*)(xin + xo);
      }
#pragma unroll
    for (int m = 0; m < 4; ++m) {
      const int t = m0 + wr * 64 + 16 * m + fr;
#pragma unroll
      for (int n = 0; n < 4; ++n) {
        const int col = n0 + wc * 64 + 16 * n + 4 * fq;
        const f32x4 xv = XB ? (f32x4){bf_lo(xbv[m][n][0]), bf_hi(xbv[m][n][0]), bf_lo(xbv[m][n][1]), bf_hi(xbv[m][n][1])} : xvv[m][n];
        const f32x4 g1 = g1v[n];
        f32x4 o;
#pragma unroll
        for (int j = 0; j < 4; ++j) o[j] = xv[j] + g1[j] * (acc[m][n][j] * rs[m]);
        *(u32x2*)(p.x1() + (size_t)t * D + col) = (u32x2){pack2(o[0], o[1]), pack2(o[2], o[3])};
      }
    }
  }
}
__device__ __forceinline__ void phase_norm2_route(const MP& p, int l, char* smem) {
  const int tid = launder(threadIdx.x);
  const int wave = tid >> 6, lane = tid & 63, fr = lane & 15, fq = lane >> 4;
  const float* modl = p.mod() + (size_t)l * 8 * 6144;
  const float* g2n = p.in.norm2_g + l * D;
  float* gsl = (float*)smem;
  float* shl = gsl + 1024;
  int* cntl = p.cnt() + l * 256;
  for (int s = blockIdx.x; s < 512; s += gridDim.x) {
    const int b = s & 7, q = s >> 3;
    __syncthreads();
    {
      const int d = tid * 4;
      const float4 gg = *(const float4*)(g2n + d), s1 = *(const float4*)(modl + (size_t)b * 6144 + 4 * 1024 + d), s0 = *(const float4*)(modl + (size_t)b * 6144 + 3 * 1024 + d);
      *(float4*)(gsl + d) = make_float4(gg.x * (1.f + s1.x), gg.y * (1.f + s1.y), gg.z * (1.f + s1.z), gg.w * (1.f + s1.w));
      *(float4*)(shl + d) = s0;
    }
    __syncthreads();
    {
      const int g = wave & 1, kh = wave >> 1;
      float* pss = (float*)(smem + 8192);
      f32x4* pacc = (f32x4*)(smem + 8192 + 256);
      const int t = b * S + (q * 2 + g) * 16 + fr;
      const bf16_t* xrow = p.x1() + (size_t)t * D + 512 * kh + 8 * fq;
      float ss = 0.f;
#pragma unroll 8
      for (int ks = 0; ks < 16; ++ks) {
        const u32x4 xr = *(const u32x4*)(xrow + 32 * ks);
#pragma unroll
        for (int j = 0; j < 4; ++j) { const float a = bf_lo(xr[j]), c = bf_hi(xr[j]); ss += a * a + c * c; }
      }
      ss += __shfl_xor(ss, 16); ss += __shfl_xor(ss, 32);
      if (fq == 0) pss[(g * 2 + kh) * 16 + fr] = ss;
      __syncthreads();
      ss = pss[(g * 2) * 16 + fr] + pss[(g * 2 + 1) * 16 + fr];
      const float rinv = rsqrtf(ss * (1.f / D) + EPS);
      const u32x4* wf = p.wrf() + (size_t)(kh * 16) * 2 * 64 + lane;
      bf16_t* hrow = p.h() + (size_t)t * D + 512 * kh + 8 * fq;
      const float* gq = gsl + 512 * kh + 8 * fq; const float* sq = shl + 512 * kh + 8 * fq;
      f32x4 acc = {0.f, 0.f, 0.f, 0.f};
#pragma unroll 4
      for (int ks = 0; ks < 16; ++ks) {
        const u32x4 xr = *(const u32x4*)(xrow + 32 * ks);
        const float* gp = gq + 32 * ks; const float* sp = sq + 32 * ks;
        const f32x4 ga = *(const f32x4*)gp, gb = *(const f32x4*)(gp + 4), sa = *(const f32x4*)sp, sb = *(const f32x4*)(sp + 4);
        const float gv[8] = {ga[0], ga[1], ga[2], ga[3], gb[0], gb[1], gb[2], gb[3]}, sv[8] = {sa[0], sa[1], sa[2], sa[3], sb[0], sb[1], sb[2], sb[3]};
        u32x4 hi, lo;
#pragma unroll
        for (int j = 0; j < 4; ++j) {
          const float h0 = bf_lo(xr[j]) * rinv * gv[2 * j] + sv[2 * j], h1 = bf_hi(xr[j]) * rinv * gv[2 * j + 1] + sv[2 * j + 1];
          hi[j] = pack2(h0, h1);
          lo[j] = pack2(h0 - bf_lo(hi[j]), h1 - bf_hi(hi[j]));
        }
        *(u32x4*)(hrow + 32 * ks) = hi;
        const bf16x8 whi = __builtin_bit_cast(bf16x8, wf[(ks * 2) * 64]), wlo = __builtin_bit_cast(bf16x8, wf[(ks * 2 + 1) * 64]);
        const bf16x8 hhi = __builtin_bit_cast(bf16x8, hi), hlo = __builtin_bit_cast(bf16x8, lo);
        acc = __builtin_amdgcn_mfma_f32_16x16x32_bf16(whi, hhi, acc, 0, 0, 0);
        acc = __builtin_amdgcn_mfma_f32_16x16x32_bf16(whi, hlo, acc, 0, 0, 0);
        acc = __builtin_amdgcn_mfma_f32_16x16x32_bf16(wlo, hhi, acc, 0, 0, 0);
      }
      if (kh == 1) pacc[g * 64 + lane] = acc;
      __syncthreads();
      if (kh == 0) {
      const f32x4 oth = pacc[g * 64 + lane];
#pragma unroll
      for (int j = 0; j < 4; ++j) acc[j] += oth[j];
      float mx = fmaxf(fmaxf(acc[0], acc[1]), fmaxf(acc[2], acc[3]));
      mx = fmaxf(mx, __shfl_xor(mx, 16)); mx = fmaxf(mx, __shfl_xor(mx, 32));
      float pr[4], sel[4]; float sum = 0.f;
#pragma unroll
      for (int j = 0; j < 4; ++j) { pr[j] = __expf(acc[j] - mx); sum += pr[j]; }
      sum += __shfl_xor(sum, 16); sum += __shfl_xor(sum, 32);
      const float inv = 1.f / sum;
      const f32x4 rb = *(const f32x4*)(p.in.router_bias + 4 * fq);
#pragma unroll
      for (int j = 0; j < 4; ++j) { pr[j] *= inv; sel[j] = pr[j] + rb[j]; }
      float m1 = -1e30f, m2 = -1e30f;
#pragma unroll
      for (int j = 0; j < 4; ++j) { const float v = sel[j]; if (v > m1) { m2 = m1; m1 = v; } else if (v > m2) m2 = v; }
      const float gs = m1 + m2;
      int gbest = 0; float gbs = -1e30f;
#pragma unroll
      for (int gg = 0; gg < 4; ++gg) { const float v = __shfl(gs, fr + 16 * gg); if (v > gbs) { gbs = v; gbest = gg; } }
      if (fq == gbest) {
        int i0 = 0; float b0 = sel[0];
#pragma unroll
        for (int j = 1; j < 4; ++j) if (sel[j] > b0) { b0 = sel[j]; i0 = j; }
        int i1 = -1; float bb1 = -1e30f;
#pragma unroll
        for (int j = 0; j < 4; ++j) if (j != i0 && sel[j] > bb1) { bb1 = sel[j]; i1 = j; }
        float p0 = 0.f, p1 = 0.f;
#pragma unroll
        for (int j = 0; j < 4; ++j) { if (j == i0) p0 = pr[j]; if (j == i1) p1 = pr[j]; }
        const float w0 = p0 / (p0 + p1), w1 = p1 / (p0 + p1);
        const int lo2 = i0 < i1 ? i0 : i1, hi2 = i0 < i1 ? i1 : i0;
        const float wlo = i0 < i1 ? w0 : w1, whi2 = i0 < i1 ? w1 : w0;
        const int pidx = (lo2 == 0) ? (hi2 - 1) : (lo2 == 1 ? (hi2 + 1) : 5);
        const int bucket = gbest * 6 + pidx;
        const int sl = bucket * NSUBL + (blockIdx.x & (NSUBL - 1));
        const int pos = atomicAdd(&cntl[sl], 1);
        p.list()[(size_t)sl * T + pos] = t;
        p.tokw()[t] = make_float2(wlo, whi2);
      }
      }
    }
  }
  __syncthreads();
}

__device__ __forceinline__ void bucket_experts2(int bucket, int& elo, int& ehi) {
  const int g = bucket / 6, pi = bucket % 6;
  const int lo = pi < 3 ? 0 : (pi < 5 ? 1 : 2);
  const int hi = pi < 3 ? pi + 1 : (pi < 5 ? pi - 1 : 3);
  elo = g * 4 + lo; ehi = g * 4 + hi;
}
__device__ __forceinline__ void moe_map_build(const int* cnt, int* mm, int tid) {
  if (tid < NBUCKET) {
    int acc = 0;
#pragma unroll
    for (int x = 0; x < NSUBL; ++x) { mm[32 + 16 * tid + x] = acc; acc += cnt[tid * NSUBL + x]; }
    mm[32 + 16 * tid + 8] = acc;
  }
  __syncthreads();
  if (tid == 0) {
    int acc = 0;
    for (int bk = 0; bk < NBUCKET; ++bk) { mm[bk] = acc; acc += (mm[32 + 16 * bk + 8] + TM - 1) / TM; }
    mm[NBUCKET] = acc;
  }
  __syncthreads();
}
__device__ __forceinline__ void moe_find_tile(const int* mm, int mt, int& bucket, int& tib, int& nrow) {
  int bk = 0;
#pragma unroll
  for (int j = 1; j < NBUCKET; ++j) bk += (mt >= mm[j]) ? 1 : 0;
  bucket = bk; tib = mt - mm[bk]; nrow = mm[32 + 16 * bk + 8] - tib * TM;
}
__device__ __forceinline__ int moe_token(const int* list, const int* mm, int bk, int q) {
  const int* sp = mm + 32 + 16 * bk;
  int x = 0, s = 0;
#pragma unroll
  for (int j = 1; j < NSUBL; ++j) { const int v = sp[j]; const bool ge = q >= v; x += ge ? 1 : 0; s = ge ? v : s; }
  return list[(size_t)(bk * NSUBL + x) * T + (q - s)];
}

__device__ __forceinline__ void fold_inproj_next(const MP& p, int ln) {
  const int tid = launder(threadIdx.x), wave = tid >> 6, lane = tid & 63;
  const float* modn = p.mod() + (size_t)ln * 8 * 6144;
  const float* gn = p.in.norm1_g + ln * D;
  const bf16_t* W = p.WinT() + (size_t)ln * INW * D;
  const int d = tid * 4;
  const float4 gg = *(const float4*)(gn + d);
  for (int u = blockIdx.x; u < 8 * INW; u += gridDim.x) {
    const int b = u / INW, n = u - b * INW;
    const float4 s1 = *(const float4*)(modn + (size_t)b * 6144 + 1024 + d);
    const u32x2 wr2 = *(const u32x2*)(W + (size_t)n * D + d);
    const float o0 = bf_lo(wr2[0]) * gg.x * (1.f + s1.x), o1 = bf_hi(wr2[0]) * gg.y * (1.f + s1.y);
    const float o2 = bf_lo(wr2[1]) * gg.z * (1.f + s1.z), o3 = bf_hi(wr2[1]) * gg.w * (1.f + s1.w);
    *(u32x2*)(p.w1b() + ((size_t)b * INW + n) * D + d) = (u32x2){pack2(o0, o1), pack2(o2, o3)};
  }
  for (int n = blockIdx.x * 4 + wave; n < INW; n += gridDim.x * 4) {
    float wv[16];
#pragma unroll
    for (int i = 0; i < 4; ++i) {
      const u32x2 r = *(const u32x2*)(W + (size_t)n * D + lane * 4 + 256 * i);
      wv[4 * i] = bf_lo(r[0]); wv[4 * i + 1] = bf_hi(r[0]); wv[4 * i + 2] = bf_lo(r[1]); wv[4 * i + 3] = bf_hi(r[1]);
    }
#pragma unroll 1
    for (int b = 0; b < 8; ++b) {
      float sacc = 0.f;
#pragma unroll
      for (int i = 0; i < 4; ++i) {
        const float4 sh = *(const float4*)(modn + (size_t)b * 6144 + lane * 4 + 256 * i);
        sacc += sh.x * wv[4 * i] + sh.y * wv[4 * i + 1] + sh.z * wv[4 * i + 2] + sh.w * wv[4 * i + 3];
      }
      sacc = wave_sum(sacc);
      if (lane == 0) p.bias1()[b * INW + n] = sacc;
    }
  }
}

__device__ __forceinline__ void phase_moe_gu(const MP& p, int l, char* smem) {
  const int tid = launder(threadIdx.x), lane = tid & 63, wave = tid >> 6, wr = wave >> 1, wc = wave & 1, fr = lane & 15, fq = lane >> 4;
  const int r0 = tid >> 3;
  int* mm = (int*)(smem + SMEM_MM);
  moe_map_build(p.cnt() + l * 256, mm, tid);
  const int nmt = mm[NBUCKET];
  const int ntiles = nmt * 16;
  auto make = [&](int tile, GemmTile& g) {
    const int mt = tile >> 4, nt = tile & 15;
    int bucket, tib, nrow;
    moe_find_tile(mm, mt, bucket, tib, nrow);
    int elo, ehi; bucket_experts2(bucket, elo, ehi);
    const int e = nt < 8 ? elo : ehi, f0 = (nt & 7) * 64;
    g.A0 = p.h(); g.A1 = p.h(); g.lda = D; g.ksA = D; g.K = D;
    const bf16_t* Wg = p.WgT() + ((size_t)(l * NE + e) * DFF + f0) * D;
    const bf16_t* Wu = p.WuT() + ((size_t)(l * NE + e) * DFF + f0) * D;
#pragma unroll
    for (int i = 0; i < 4; ++i) {
      const int r = r0 + 32 * i;
      g.arow[i] = moe_token(p.list(), mm, bucket, tib * TM + (r < nrow ? r : nrow - 1));
    }
    g.Blo0 = Wg; g.Bhi0 = Wu; g.Blo1 = Wg; g.Bhi1 = Wu;
    g.ldb = D; g.ksB = D; g.rot = ROT_OF(bucket, nt);
  };
  GemmTile g, gn; bool pre = false;
  const TileMap tmap = tm_init(nmt, 16);
  { const int t0 = tm_tile(tmap, 0); if (t0 >= 0) { make(t0, g); gn = g; } }
  for (int jt = 0; ; ++jt) {
    const int tile = tm_tile(tmap, jt); if (tile < 0) break;
    const int mt = tile >> 4, nt = tile & 15;
    int bucket, tib, nrow;
    moe_find_tile(mm, mt, bucket, tib, nrow);
    const int f0 = (nt & 7) * 64;
    const int nxt = tm_tile(tmap, jt + 1); const bool hasn = nxt >= 0;
    if (hasn) make(nxt, gn);
    float wv[4];
#pragma unroll
    for (int m = 0; m < 4; ++m) {
      const int r = wr * 64 + 16 * m + fr;
      const float2 ww = p.tokw()[moe_token(p.list(), mm, bucket, tib * TM + (r < nrow ? r : nrow - 1))];
      wv[m] = r < nrow ? (nt < 8 ? ww.x : ww.y) : 0.f;
    }
    f32x4 acc[4][4];
    gemm_mainloop<true>(g, gn, hasn, pre, smem, acc);
    pre = hasn; g = gn;
#pragma unroll
    for (int m = 0; m < 4; ++m) {
      const int r = wr * 64 + 16 * m + fr;
      const float w = wv[m];
      bf16_t* dst = p.act() + (size_t)(mt * TM + r) * D + (nt < 8 ? 0 : 512) + f0 + wc * 32 + 4 * fq;
#pragma unroll
      for (int n = 0; n < 2; ++n) {
        float o[4];
#pragma unroll
        for (int j = 0; j < 4; ++j) { const float gv = acc[m][n][j], uv = acc[m][n + 2][j]; o[j] = gv * __builtin_amdgcn_rcpf(1.f + __expf(-gv)) * uv * w; }
        *(u32x2*)(dst + 16 * n) = (u32x2){pack2(o[0], o[1]), pack2(o[2], o[3])};
      }
    }
  }
}

template <bool XBOUT>
__device__ __forceinline__ void phase_moe_down(const MP& p, int l, char* smem) {
  const int tid = launder(threadIdx.x), lane = tid & 63, wave = tid >> 6, wr = wave >> 1, wc = wave & 1, fr = lane & 15, fq = lane >> 4;
  const int r0 = tid >> 3;
  int* mm = (int*)(smem + SMEM_MM);
  moe_map_build(p.cnt() + l * 256, mm, tid);
  const float* modl = p.mod() + (size_t)l * 8 * 6144;
  const int nmt = mm[NBUCKET];
  const int ntiles = nmt * 8;
  auto make = [&](int tile, GemmTile& g) {
    const int mt = tile >> 3, n0 = (tile & 7) * 128;
    int bucket, tib, nrow;
    moe_find_tile(mm, mt, bucket, tib, nrow);
    int elo, ehi; bucket_experts2(bucket, elo, ehi);
    g.A0 = p.act(); g.A1 = p.act(); g.lda = D; g.ksA = D; g.K = D;
    const bf16_t* Wlo = p.WdT() + ((size_t)(l * NE + elo) * D + n0) * DFF;
    const bf16_t* Whi = p.WdT() + ((size_t)(l * NE + ehi) * D + n0) * DFF;
#pragma unroll
    for (int i = 0; i < 4; ++i) {
      g.arow[i] = mt * TM + r0 + 32 * i;
    }
    g.Blo0 = Wlo; g.Bhi0 = Wlo + (size_t)64 * DFF; g.Blo1 = Whi; g.Bhi1 = Whi + (size_t)64 * DFF;
    g.ldb = DFF; g.ksB = DFF; g.rot = ROT_OF(bucket, tile & 7);
  };
  GemmTile g, gn; bool pre = false;
  const TileMap tmap = tm_init(nmt, 8);
  { const int t0 = tm_tile(tmap, 0); if (t0 >= 0) { make(t0, g); gn = g; } }
  for (int jt = 0; ; ++jt) {
    const int tile = tm_tile(tmap, jt); if (tile < 0) break;
    const int mt = tile >> 3, nt = tile & 7, n0 = nt * 128;
    int bucket, tib, nrow;
    moe_find_tile(mm, mt, bucket, tib, nrow);
    const int nxt = tm_tile(tmap, jt + 1); const bool hasn = nxt >= 0;
    if (hasn) make(nxt, gn);
    int tkv[4];
#pragma unroll
    for (int m = 0; m < 4; ++m) {
      const int r = wr * 64 + 16 * m + fr;
      tkv[m] = moe_token(p.list(), mm, bucket, tib * TM + (r < nrow ? r : nrow - 1));
    }
    f32x4 acc[4][4];
    gemm_mainloop<false>(g, gn, hasn, pre, smem, acc);
    pre = hasn; g = gn;
    u32x2 xrv[4][4]; f32x4 g2v[4][4];
#pragma unroll
    for (int m = 0; m < 4; ++m)
#pragma unroll
      for (int n = 0; n < 4; ++n) {
        const int col = n0 + wc * 64 + 16 * n + 4 * fq;
        xrv[m][n] = *(const u32x2*)(p.x1() + (size_t)tkv[m] * D + col);
        g2v[m][n] = *(const f32x4*)(modl + (size_t)(tkv[m] / S) * 6144 + 5 * 1024 + col);
      }
#pragma unroll
    for (int m = 0; m < 4; ++m) {
      const int r = wr * 64 + 16 * m + fr;
      const int tk = tkv[m];
      f32x4 o[4];
#pragma unroll
      for (int n = 0; n < 4; ++n) {
        const u32x2 xr = xrv[m][n];
        const f32x4 xv = {bf_lo(xr[0]), bf_hi(xr[0]), bf_lo(xr[1]), bf_hi(xr[1])};
        const f32x4 g2 = g2v[m][n];
#pragma unroll
        for (int j = 0; j < 4; ++j) o[n][j] = xv[j] + g2[j] * acc[m][n][j];
      }
      if (XBOUT) {
        float ssr = 0.f;
#pragma unroll
        for (int n = 0; n < 4; ++n) ssr += (o[n][0] * o[n][0] + o[n][1] * o[n][1]) + (o[n][2] * o[n][2] + o[n][3] * o[n][3]);
        ssr += __shfl_xor(ssr, 16); ssr += __shfl_xor(ssr, 32);
        if (fq == 0 && r < nrow) p.ssqx()[(size_t)tk * 16 + nt * 2 + wc] = ssr;
      }
      if (r < nrow) {
#pragma unroll
        for (int n = 0; n < 4; ++n) {
          const size_t oo = (size_t)tk * D + n0 + wc * 64 + 16 * n + 4 * fq;
          if (XBOUT) *(u32x2*)(p.xb() + oo) = (u32x2){pack2(o[n][0], o[n][1]), pack2(o[n][2], o[n][3])};
          else *(f32x4*)(p.out + oo) = o[n];
        }
      }
    }
  }
}
#define XB_TMO      128
#define XB_XCNT(j)  (256  + 64 * (j))
#define XB_XSUB(j)  (1280 + 64 * (j))
#define XB_XGEN(j)  (2304 + 64 * (j))
#define XB_TOP      3328
#define XB_TOPGEN   3392
#define XCD_BAR_WORDS 3456
#define XB_SPIN_CAP (1u << 22)
#define LAS __attribute__((address_space(3)))

__device__ __forceinline__ unsigned xb_ld(unsigned* p)              { return __hip_atomic_load(p, __ATOMIC_RELAXED, __HIP_MEMORY_SCOPE_AGENT); }
__device__ __forceinline__ unsigned xb_add(unsigned* p, unsigned v) { return __hip_atomic_fetch_add(p, v, __ATOMIC_RELAXED, __HIP_MEMORY_SCOPE_AGENT); }
__device__ __forceinline__ unsigned xb_xcc_id() { return (unsigned)__builtin_amdgcn_s_getreg((3 << 11) | 20) & 0xFu; }
#define XB_SPIN(cond, bar) do { unsigned _sp = 0; while (cond) { __builtin_amdgcn_s_sleep(1); \
    if ((++_sp & 255u) == 0u) { if (xb_ld(&(bar)[XB_TMO])) break; if (_sp > XB_SPIN_CAP) { atomicAdd(&(bar)[XB_TMO], 1u); break; } } } } while (0)

struct XcdBarrier { unsigned* bar; unsigned x; volatile LAS unsigned* st; };

__device__ __forceinline__ XcdBarrier xcd_barrier_post(unsigned* bar, volatile LAS unsigned* st) {
  XcdBarrier b; b.bar = bar; b.x = xb_xcc_id(); b.st = st;
  if (threadIdx.x == 0) (void)xb_add(&bar[XB_XCNT(b.x)], 1u);
  return b;
}
__device__ __forceinline__ void xcd_barrier_complete(unsigned* bar, unsigned x, unsigned& nloc, unsigned& nx) {
  const unsigned G = gridDim.x * gridDim.y * gridDim.z;
  unsigned sum, cnt, mine, sp = 0u;
  for (;;) {
    sum = 0u; cnt = 0u; mine = 0u;
#pragma unroll
    for (unsigned j = 0; j < 16; ++j) { const unsigned c = xb_ld(&bar[XB_XCNT(j)]); sum += c; cnt += (c > 0u) ? 1u : 0u; mine = (j == x) ? c : mine; }
    if (sum == G) break;
    __builtin_amdgcn_s_sleep(1);
    if ((++sp & 255u) == 0u) { if (xb_ld(&bar[XB_TMO])) break; if (sp > XB_SPIN_CAP) { atomicAdd(&bar[XB_TMO], 1u); break; } }
  }
  nloc = mine > 0u ? mine : 1u; nx = cnt > 0u ? cnt : 1u;
}
__device__ __forceinline__ void xcd_barrier(const XcdBarrier& b) {
  asm volatile("s_waitcnt vmcnt(0)" ::: "memory");
  __syncthreads();
  if (threadIdx.x == 0) {
    unsigned* bar = b.bar;
    __builtin_amdgcn_s_waitcnt(0);
    unsigned nloc = b.st[0], nx = b.st[1];
    if (nloc == 0u) { xcd_barrier_complete(bar, b.x, nloc, nx); b.st[0] = nloc; b.st[1] = nx; }
    const unsigned old = xb_add(&bar[XB_XSUB(b.x)], 1u);
    const unsigned gen = old / nloc;
    if (old + 1u == (gen + 1u) * nloc) {
      __builtin_amdgcn_fence(__ATOMIC_RELEASE, "agent");
      asm volatile("s_waitcnt vmcnt(0)" ::: "memory");
      const unsigned og = xb_add(&bar[XB_TOP], 1u);
      const unsigned tg = og / nx;
      if (og + 1u == (tg + 1u) * nx) xb_add(&bar[XB_TOPGEN], 1u);
      else XB_SPIN(xb_ld(&bar[XB_TOPGEN]) == tg, bar);
      __builtin_amdgcn_fence(__ATOMIC_ACQUIRE, "agent");
      xb_add(&bar[XB_XGEN(b.x)], 1u);
      asm volatile("s_waitcnt vmcnt(0)" ::: "memory");
    } else {
      XB_SPIN(xb_ld(&bar[XB_XGEN(b.x)]) == gen, bar);
      __builtin_amdgcn_fence(__ATOMIC_ACQUIRE, "agent");
      asm volatile("s_waitcnt vmcnt(0)" ::: "memory");
    }
  }
  __syncthreads();
}

constexpr int NSUB = 9;

template <int L>
__device__ __forceinline__ void run_layer(const MP& p, char* smem, const XcdBarrier& xb, int ssm_wid, int idle_id, int ssm_lrank) {
  constexpr int l = L;
  const float* xin = L == 0 ? p.in.x : p.out;
  if (L == 0) { phase_norm1<false>(p, l, xin); xcd_barrier(xb); }
  phase_inproj<(L > 0)>(p, l, smem);        xcd_barrier(xb);
  phase_ssm(p, l, smem, ssm_wid, ssm_lrank);
  {
    constexpr int TT_SMALL = TT_WIN + TT_GLU + TT_OUT, E0 = L * TT_LAYER + TT_SMALL, NCH = 3 * TT_EXP / 4 / 8;
    const int x = blockIdx.x & 7;
    unsigned* ctr = p.claim() + 4128 + L * 8 + x;
    volatile int* bw = (volatile int*)(smem + SMEM_MM);
#pragma unroll 1
    for (;;) {
      __syncthreads();
      if (threadIdx.x == 0) bw[0] = (int)xb_add(ctr, 1u);
      __syncthreads();
      const int c = launder_s(__builtin_amdgcn_readfirstlane(bw[0]));
      if (c >= NCH) break;
      const int t0 = E0 + (x * NCH + c) * 4;
      phase0_transposes(p, smem, t0, t0 + 4, 0, 1);
    }
  }
  xcd_barrier(xb);
#pragma unroll 1
  for (int step = 0; step < 2; ++step) {
    if ((step == 0) == (ssm_wid >= 0)) phase_glu(p, l, smem);
    else phase_attn(p, l, smem);
  }
  xcd_barrier(xb);
  phase_out<(L > 0)>(p, l, smem, xin);      xcd_barrier(xb);
  phase_norm2_route(p, l, smem);
  if (L + 1 < DEPTH) fold_inproj_next(p, l + 1);
  xcd_barrier(xb);
  phase_moe_gu(p, l, smem);        xcd_barrier(xb);
  phase_moe_down<(L + 1 < DEPTH)>(p, l, smem);
  if (L + 1 < DEPTH) xcd_barrier(xb);
}

__global__ void __launch_bounds__(NTHR, 2) mega(MP p) {
  __shared__ __attribute__((aligned(16))) char smem[65536 + 32 + 2048];
  unsigned* xb_words = (unsigned*)(smem + 65536);
  if (threadIdx.x < 8) xb_words[threadIdx.x] = 0u;
  __syncthreads();
  const XcdBarrier xb = xcd_barrier_post(p.bar(), (volatile LAS unsigned*)xb_words);
  if (threadIdx.x == 0) {
    const unsigned key = (xb_xcc_id() << 8) | ((unsigned)__builtin_amdgcn_s_getreg((7 << 11) | (8 << 6) | 4) & 0xffu);
    const unsigned rank = xb_add(p.claim() + key, 1u);
    xb_words[2] = rank == 0u ? xb_add(p.claim() + 4096, 1u) : 0xffffffffu;
    xb_words[3] = rank == 0u ? 0xffffffffu : xb_add(p.claim() + 4097, 1u);
    xb_words[4] = rank == 0u ? xb_add(p.claim() + 4104 + (blockIdx.x & 7), 1u) : 0xffffffffu;
  }
  __syncthreads();
  const int ssm_wid = (int)xb_words[2], idle_id = (int)xb_words[3], ssm_lrank = (int)xb_words[4];
  for (int it = blockIdx.x; it < P0_MISC; it += gridDim.x) phase0_item(p, it, smem);
  {
    const int G = (int)gridDim.x, r1 = G - 1 - (int)blockIdx.x;
    int r2 = (G - 1 - (TT_WIN + TT_GLU + TT_OUT) % G) - (int)blockIdx.x; r2 += r2 < 0 ? G : 0;
    phase0_transposes(p, smem, 0, TT_WIN + TT_GLU + TT_OUT, r1, G);
    phase0_transposes(p, smem, TT_LAYER, TT_LAYER + TT_WIN + TT_GLU + TT_OUT, r2, G);
  }
  xcd_barrier(xb);
  run_layer<0>(p, smem, xb, ssm_wid, idle_id, ssm_lrank);
  run_layer<1>(p, smem, xb, ssm_wid, idle_id, ssm_lrank);
  static_assert(DEPTH == 2, "two layers instantiated");
}

}

extern "C" void kernel_launch(void* const* d_in, const int* in_sizes, int n_in, void* d_out, int out_size, void* d_ws,
                              size_t ws_size, hipStream_t stream) {
  MP p; memset(&p, 0, sizeof(p));
  Ptrs& P = p.in;
  P.x = (const float*)d_in[0]; P.c = (const float*)d_in[1]; P.pos = (const int*)d_in[2];
  P.ada_w = (const float*)d_in[3]; P.ada_b = (const float*)d_in[4]; P.norm1_g = (const float*)d_in[5];
  P.w_in = (const float*)d_in[6]; P.q_norm_g = (const float*)d_in[7]; P.k_norm_g = (const float*)d_in[8];
  P.attn_sink = (const float*)d_in[9]; P.lam_re = (const float*)d_in[10]; P.lam_im = (const float*)d_in[11];
  P.b_re = (const float*)d_in[12]; P.b_im = (const float*)d_in[13]; P.c_re = (const float*)d_in[14]; P.c_im = (const float*)d_in[15];
  P.ssm_d = (const float*)d_in[16]; P.log_dt = (const float*)d_in[17]; P.w_glu = (const float*)d_in[18];
  P.attn_out_g = (const float*)d_in[19]; P.ssm_out_g = (const float*)d_in[20]; P.w_out = (const float*)d_in[21];
  P.norm2_g = (const float*)d_in[22]; P.w_router = (const float*)d_in[23]; P.router_bias = (const float*)d_in[24];
  P.w_gate = (const float*)d_in[25]; P.w_up = (const float*)d_in[26]; P.w_down = (const float*)d_in[27];
  p.out = (float*)d_out;

  p.ws = (char*)d_ws;
  if (WS_TOTAL > ws_size) { fprintf(stderr, "workspace too small: need %zu have %zu\n", (size_t)WS_TOTAL, ws_size); return; }
  (void)in_sizes; (void)n_in; (void)out_size;

  static int grid_blocks = 0;
  if (!grid_blocks) {
    int dev = 0, cus = 0, per_cu = 0;
    (void)hipGetDevice(&dev);
    (void)hipDeviceGetAttribute(&cus, hipDeviceAttributeMultiprocessorCount, dev);
    (void)hipOccupancyMaxActiveBlocksPerMultiprocessor(&per_cu, mega, NTHR, 0);
    if (per_cu > 2) per_cu = 2;
    if (per_cu < 1) per_cu = 1;
    grid_blocks = cus * per_cu;
  }
  (void)hipMemsetAsync(p.ws + OFF_BAR, 0, OFF_MOD - OFF_BAR, stream);
  void* args[] = {&p};
  hipError_t e = hipLaunchCooperativeKernel((void*)mega, dim3(grid_blocks), dim3(NTHR), args, 0, stream);
  if (e != hipSuccess) fprintf(stderr, "cooperative launch failed: %s (grid %d)\n", hipGetErrorString(e), grid_blocks);
}
```

```cpp
#include <hip/hip_runtime.h>
#include <hip/hip_cooperative_groups.h>
#include <stdint.h>
#include <cstdio>
#include <cstring>

namespace {
constexpr int D = 1024, NB = 8, S = 2048, T = NB * S, DEPTH = 2;
constexpr int AW = 512, HD = 64, NQ = 8, NKV = 2, INW = 1280;
constexpr int SG = 32, SCH = 16, SP = 64, SW = 512;
constexpr int NE = 16, DFF = 512;
constexpr int NBUCKET = 24;
constexpr float EPS = 1e-6f;

struct Ptrs {
  const float *x, *c; const int* pos; const float *ada_w, *ada_b, *norm1_g, *w_in, *q_norm_g, *k_norm_g, *attn_sink,
      *lam_re, *lam_im, *b_re, *b_im, *c_re, *c_im, *ssm_d, *log_dt, *w_glu, *attn_out_g, *ssm_out_g, *w_out, *norm2_g,
      *w_router, *router_bias, *w_gate, *w_up, *w_down;
};

__device__ __forceinline__ float row_sum32_dpp(float v) {
  v += __int_as_float(__builtin_amdgcn_update_dpp(0, __float_as_int(v), 0xB1, 0xF, 0xF, true));
  v += __int_as_float(__builtin_amdgcn_update_dpp(0, __float_as_int(v), 0x4E, 0xF, 0xF, true));
  v += __int_as_float(__builtin_amdgcn_update_dpp(0, __float_as_int(v), 0x141, 0xF, 0xF, true));
  v += __int_as_float(__builtin_amdgcn_update_dpp(0, __float_as_int(v), 0x140, 0xF, 0xF, true));
  v += __int_as_float(__builtin_amdgcn_update_dpp(0, __float_as_int(v), 0x142, 0xA, 0xF, false));
  return v;
}
__device__ __forceinline__ float wave_sum(float v) {
  v = row_sum32_dpp(v);
  return __int_as_float(__builtin_amdgcn_readlane(__float_as_int(v), 31)) + __int_as_float(__builtin_amdgcn_readlane(__float_as_int(v), 63));
}
__device__ __forceinline__ float xhalf_sum(float v) {
  const auto r = __builtin_amdgcn_permlane32_swap(__float_as_uint(v), __float_as_uint(v), false, false);
  return __uint_as_float(r[0]) + __uint_as_float(r[1]);
}
__device__ __forceinline__ float xhalf_max(float v) {
  const auto r = __builtin_amdgcn_permlane32_swap(__float_as_uint(v), __float_as_uint(v), false, false);
  return fmaxf(__uint_as_float(r[0]), __uint_as_float(r[1]));
}

#ifndef ROT_OF
#define ROT_OF(mt, nt) ((mt) & 15)
#endif

typedef unsigned short bf16_t;
typedef short bf16x8 __attribute__((ext_vector_type(8)));
typedef float f32x4 __attribute__((ext_vector_type(4)));
typedef float f32x16 __attribute__((ext_vector_type(16)));
typedef float f32x2 __attribute__((ext_vector_type(2)));
typedef __bf16 bf16x2_t __attribute__((ext_vector_type(2)));
typedef unsigned u32x4 __attribute__((ext_vector_type(4)));
typedef unsigned u32x2 __attribute__((ext_vector_type(2)));

constexpr int NTHR = 256;
constexpr int TM = 128;
constexpr int MAXMT = T / TM + NBUCKET;
constexpr int NSUBL = 8;
constexpr int SMEM_MM = 65536 + 32;

__device__ __forceinline__ unsigned pack2(float lo, float hi) {
  f32x2 v = {lo, hi};
  return __builtin_bit_cast(unsigned, __builtin_convertvector(v, bf16x2_t));
}
__device__ __forceinline__ int launder(int x) { asm volatile("" : "+v"(x)); return x; }
__device__ __forceinline__ int launder_s(int x) { asm volatile("" : "+s"(x)); return x; }
__device__ __forceinline__ float bf_lo(unsigned u) { return __uint_as_float(u << 16); }
__device__ __forceinline__ float bf_hi(unsigned u) { return __uint_as_float(u & 0xffff0000u); }
__device__ __forceinline__ float bf1(bf16_t u) { return __uint_as_float(((unsigned)u) << 16); }

constexpr size_t al256(size_t x) { return (x + 255) & ~(size_t)255; }
constexpr size_t OFF_BAR = 0;
constexpr size_t OFF_CLAIM = OFF_BAR + al256(4096 * 4);
constexpr size_t OFF_MOD = OFF_CLAIM + al256(4096 * 4 + 256);
constexpr size_t OFF_CS = OFF_MOD + al256((size_t)DEPTH * 8 * 6144 * 4);
constexpr size_t OFF_CNT = OFF_CS + al256((size_t)T * 32 * 8);
constexpr size_t OFF_LIST = OFF_CNT + al256(256 * 4 * DEPTH);
constexpr size_t OFF_TOKW = OFF_LIST + al256((size_t)NBUCKET * NSUBL * T * 4);
constexpr size_t OFF_SSMB = OFF_TOKW + al256((size_t)T * 8);
constexpr size_t OFF_SSMC = OFF_SSMB + al256((size_t)DEPTH * SG * 128 * 16 * 2);
constexpr size_t OFF_SSML = OFF_SSMC + al256((size_t)DEPTH * SG * 16 * 128 * 2);
constexpr size_t OFF_WINT = OFF_SSML + al256((size_t)DEPTH * SG * SP * 2 * 4);
constexpr size_t OFF_WGLUT = OFF_WINT + al256((size_t)DEPTH * INW * D * 2);
constexpr size_t OFF_WOUTT = OFF_WGLUT + al256((size_t)DEPTH * SW * SW * 2);
constexpr size_t OFF_H = OFF_WOUTT + al256((size_t)DEPTH * D * D * 2);
constexpr size_t OFF_Q = OFF_H + al256((size_t)T * D * 2);
constexpr size_t OFF_K = OFF_Q + al256((size_t)T * AW * 2);
constexpr size_t OFF_VT = OFF_K + al256((size_t)T * 128 * 2);
constexpr size_t OFF_U = OFF_VT + al256((size_t)T * 128 * 2);
constexpr size_t OFF_ATTN = OFF_U + al256((size_t)T * SW * 2);
constexpr size_t OFF_ACT = OFF_Q;
static_assert((size_t)MAXMT * TM * D * 2 <= OFF_ATTN - OFF_Q, "act overlay too small");
constexpr size_t OFF_SSQA = OFF_ATTN + al256((size_t)T * AW * 2);
constexpr size_t OFF_Y = OFF_SSQA + al256((size_t)T * 8 * 4);
constexpr size_t OFF_SSM = OFF_Y + al256((size_t)T * SW * 2);
constexpr size_t OFF_SSQS = OFF_SSM + al256((size_t)T * SW * 2);
constexpr size_t OFF_X1 = OFF_SSQS + al256((size_t)T * 8 * 4);
constexpr size_t OFF_WGT = OFF_X1 + al256((size_t)T * D * 4);
constexpr size_t OFF_WUT = OFF_WGT + al256((size_t)DEPTH * NE * DFF * D * 2);
constexpr size_t OFF_WDT = OFF_WUT + al256((size_t)DEPTH * NE * DFF * D * 2);
constexpr size_t OFF_WRF = OFF_WDT + al256((size_t)DEPTH * NE * DFF * D * 2);
static_assert((size_t)8 * INW * D * 2 <= OFF_SSM - OFF_ATTN, "folded in-proj weights overlay too small");
constexpr size_t WS_TOTAL = OFF_WRF + al256((size_t)32 * 2 * 64 * 16);

struct MP {
  Ptrs in;
  float* out;
  char* ws;
  __device__ __forceinline__ unsigned* bar() const { return (unsigned*)(ws + OFF_BAR); }
  __device__ __forceinline__ unsigned* claim() const { return (unsigned*)(ws + OFF_CLAIM); }
  __device__ __forceinline__ float* mod() const { return (float*)(ws + OFF_MOD); }
  __device__ __forceinline__ float2* cs() const { return (float2*)(ws + OFF_CS); }
  __device__ __forceinline__ int* cnt() const { return (int*)(ws + OFF_CNT); }
  __device__ __forceinline__ int* list() const { return (int*)(ws + OFF_LIST); }
  __device__ __forceinline__ float2* tokw() const { return (float2*)(ws + OFF_TOKW); }
  __device__ __forceinline__ bf16_t* ssmB() const { return (bf16_t*)(ws + OFF_SSMB); }
  __device__ __forceinline__ bf16_t* ssmC() const { return (bf16_t*)(ws + OFF_SSMC); }
  __device__ __forceinline__ float* ssmL() const { return (float*)(ws + OFF_SSML); }
  __device__ __forceinline__ bf16_t* WinT() const { return (bf16_t*)(ws + OFF_WINT); }
  __device__ __forceinline__ bf16_t* WgluT() const { return (bf16_t*)(ws + OFF_WGLUT); }
  __device__ __forceinline__ bf16_t* WoutT() const { return (bf16_t*)(ws + OFF_WOUTT); }
  __device__ __forceinline__ bf16_t* WgT() const { return (bf16_t*)(ws + OFF_WGT); }
  __device__ __forceinline__ bf16_t* WuT() const { return (bf16_t*)(ws + OFF_WUT); }
  __device__ __forceinline__ bf16_t* WdT() const { return (bf16_t*)(ws + OFF_WDT); }
  __device__ __forceinline__ bf16_t* h() const { return (bf16_t*)(ws + OFF_H); }
  __device__ __forceinline__ bf16_t* q() const { return (bf16_t*)(ws + OFF_Q); }
  __device__ __forceinline__ bf16_t* k() const { return (bf16_t*)(ws + OFF_K); }
  __device__ __forceinline__ bf16_t* vT() const { return (bf16_t*)(ws + OFF_VT); }
  __device__ __forceinline__ bf16_t* u() const { return (bf16_t*)(ws + OFF_U); }
  __device__ __forceinline__ bf16_t* attn() const { return (bf16_t*)(ws + OFF_ATTN); }
  __device__ __forceinline__ bf16_t* y() const { return (bf16_t*)(ws + OFF_Y); }
  __device__ __forceinline__ bf16_t* ssm() const { return (bf16_t*)(ws + OFF_SSM); }
  __device__ __forceinline__ bf16_t* act() const { return (bf16_t*)(ws + OFF_ACT); }
  __device__ __forceinline__ float* ssqa() const { return (float*)(ws + OFF_SSQA); }
  __device__ __forceinline__ float* ssqs() const { return (float*)(ws + OFF_SSQS); }
  __device__ __forceinline__ u32x4* wrf() const { return (u32x4*)(ws + OFF_WRF); }
  __device__ __forceinline__ bf16_t* w1b() const { return (bf16_t*)(ws + OFF_ATTN); }
  __device__ __forceinline__ float* ssqx() const { return (float*)(ws + OFF_SSM); }
  __device__ __forceinline__ float* bias1() const { return (float*)(ws + OFF_SSM + (size_t)T * 16 * 4); }
  __device__ __forceinline__ bf16_t* x1() const { return (bf16_t*)(ws + OFF_X1); }
  __device__ __forceinline__ bf16_t* xb() const { return (bf16_t*)(ws + OFF_X1 + (size_t)T * D * 2); }
};

constexpr int TT_WIN = 8 * 20, TT_GLU = 4 * 8, TT_OUT = 8 * 16, TT_EXP = 16 * 64;
constexpr int TT_LAYER = TT_WIN + TT_GLU + TT_OUT + 3 * TT_EXP;
constexpr int P0_MOD = DEPTH * 192;
constexpr int P0_TR = DEPTH * TT_LAYER;
constexpr int P0_CS = 0;
constexpr int P0_SSM = DEPTH * SG;
constexpr int P0_WRF = 32 * 64 / 256;
constexpr int P0_MISC = P0_MOD + P0_CS + P0_SSM + P0_WRF + 1;

__device__ __forceinline__ void phase0_item(const MP& p, int it, char* smem) {
  const int tid = launder(threadIdx.x);
  float* ldsf = (float*)smem;
  if (it < P0_MOD) {
    const int l = it / 192, j0 = (it % 192) * 32;
    float* sc = ldsf;
    float* red = ldsf + 8192;
    for (int i = tid; i < 8192; i += NTHR) { float v = p.in.c[i]; sc[i] = v / (1.f + __expf(-v)); }
    __syncthreads();
    const int kg = tid >> 3, cq = (tid & 7) * 4;
    float acc[8][4];
#pragma unroll
    for (int b = 0; b < 8; ++b)
#pragma unroll
      for (int j = 0; j < 4; ++j) acc[b][j] = 0.f;
    const float* w = p.in.ada_w + (size_t)l * 1024 * 6144 + j0 + cq;
#pragma unroll 2
    for (int k4 = 0; k4 < 8; ++k4) {
      const int k = kg * 32 + k4 * 4;
      float4 wv[4];
#pragma unroll
      for (int i = 0; i < 4; ++i) wv[i] = *(const float4*)(w + (size_t)(k + i) * 6144);
#pragma unroll
      for (int b = 0; b < 8; ++b) {
        const f32x4 s = *(const f32x4*)(sc + b * 1024 + k);
#pragma unroll
        for (int i = 0; i < 4; ++i) { acc[b][0] += s[i] * wv[i].x; acc[b][1] += s[i] * wv[i].y; acc[b][2] += s[i] * wv[i].z; acc[b][3] += s[i] * wv[i].w; }
      }
    }
#pragma unroll
    for (int b = 0; b < 8; ++b) *(float4*)(red + (kg * 8 + b) * 32 + cq) = make_float4(acc[b][0], acc[b][1], acc[b][2], acc[b][3]);
    __syncthreads();
    {
      const int b = tid >> 5, c = tid & 31;
      float v = 0.f;
#pragma unroll 8
      for (int g = 0; g < 32; ++g) v += red[(g * 8 + b) * 32 + c];
      p.mod()[(size_t)(l * 8 + b) * 6144 + j0 + c] = v + p.in.ada_b[l * 6144 + j0 + c];
    }
    __syncthreads();
    return;
  }
  it -= P0_MOD;
  if (it < P0_CS) {
    const int i = it * 256 + tid, t = i >> 5, f = i & 31;
    const float freq = __builtin_amdgcn_exp2f(-(float)f * (13.287712379549449f / 32.f));
    const float ang = (float)p.in.pos[t] * freq;
    const float rev = ang * 0.15915494309189535f;
    const float r = rev - floorf(rev);
    p.cs()[i] = make_float2(__builtin_amdgcn_cosf(r), __builtin_amdgcn_sinf(r));
    return;
  }
  it -= P0_CS;
  if (it < P0_SSM) {
    const int lg = it;
    if (tid < 64) {
      const int pp = tid;
      const float dt = expf(p.in.log_dt[lg]);
      const float lr = p.in.lam_re[lg * SP + pp], li = p.in.lam_im[lg * SP + pp];
      const float mag = expf(lr * dt);
      float sn, cn; sincosf(li * dt, &sn, &cn);
      const float ar = mag * cn, ai = mag * sn;
      const float den = lr * lr + li * li;
      const float fr = ((ar - 1.f) * lr + ai * li) / den, fi = (ai * lr - (ar - 1.f) * li) / den;
      p.ssmL()[(lg * SP + pp) * 2] = ar; p.ssmL()[(lg * SP + pp) * 2 + 1] = ai;
      unsigned wr[8], wi[8];
#pragma unroll
      for (int hh = 0; hh < 8; ++hh) {
        const float br0 = p.in.b_re[((size_t)lg * SP + pp) * SCH + 2 * hh], bi0 = p.in.b_im[((size_t)lg * SP + pp) * SCH + 2 * hh];
        const float br1 = p.in.b_re[((size_t)lg * SP + pp) * SCH + 2 * hh + 1], bi1 = p.in.b_im[((size_t)lg * SP + pp) * SCH + 2 * hh + 1];
        wr[hh] = pack2(fr * br0 - fi * bi0, fr * br1 - fi * bi1);
        wi[hh] = pack2(fr * bi0 + fi * br0, fr * bi1 + fi * br1);
      }
      u32x4* dr = (u32x4*)(p.ssmB() + ((size_t)lg * 128 + pp) * 16);
      u32x4* di = (u32x4*)(p.ssmB() + ((size_t)lg * 128 + 64 + pp) * 16);
      dr[0] = (u32x4){wr[0], wr[1], wr[2], wr[3]}; dr[1] = (u32x4){wr[4], wr[5], wr[6], wr[7]};
      di[0] = (u32x4){wi[0], wi[1], wi[2], wi[3]}; di[1] = (u32x4){wi[4], wi[5], wi[6], wi[7]};
    }
    for (int o = tid; o < 16 * 64; o += NTHR) {
      const int hh = o >> 6, pp = o & 63;
      const float cr = p.in.c_re[(size_t)lg * SCH * SP + o], ci = p.in.c_im[(size_t)lg * SCH * SP + o];
      *(unsigned*)(p.ssmC() + ((size_t)lg * 16 + hh) * 128 + 2 * pp) = pack2(cr, -ci);
    }
    return;
  }
  it -= P0_SSM;
  if (it < P0_WRF) {
    const int i = it * 256 + tid, ks = i >> 6, ln = i & 63;
    const float* w = p.in.w_router + ((size_t)32 * ks + 8 * (ln >> 4)) * NE + (ln & 15);
    unsigned hi[4], lo[4];
#pragma unroll
    for (int j = 0; j < 4; ++j) {
      const float w0 = w[(2 * j) * NE], w1 = w[(2 * j + 1) * NE];
      hi[j] = pack2(w0, w1);
      lo[j] = pack2(w0 - bf_lo(hi[j]), w1 - bf_hi(hi[j]));
    }
    u32x4* dst = p.wrf() + ((size_t)ks * 2) * 64 + ln;
    dst[0] = (u32x4){hi[0], hi[1], hi[2], hi[3]}; dst[64] = (u32x4){lo[0], lo[1], lo[2], lo[3]};
    return;
  }
  for (int i = tid; i < 256 * DEPTH; i += NTHR) p.cnt()[i] = 0;
}

struct TrDesc { const float* src; bf16_t* dst; const float* gain; int N, K, k0, n0; };
__device__ __forceinline__ void tr_decode(const MP& p, int it, TrDesc& d) {
  const int l = it / TT_LAYER; int r = it % TT_LAYER;
  d.gain = nullptr;
  if (r < TT_WIN) { d.src = p.in.w_in + (size_t)l * D * INW; d.N = INW; d.dst = p.WinT() + (size_t)l * INW * D; d.K = D; d.k0 = (r / 20) * 128; d.n0 = (r % 20) * 64; return; }
  r -= TT_WIN;
  if (r < TT_GLU) { d.src = p.in.w_glu + (size_t)l * SW * SW; d.N = SW; d.dst = p.WgluT() + (size_t)l * SW * SW; d.K = SW; d.k0 = (r / 8) * 128; d.n0 = (r % 8) * 64; return; }
  r -= TT_GLU;
  if (r < TT_OUT) {
    d.k0 = (r / 16) * 128; d.n0 = (r % 16) * 64;
    d.gain = d.k0 < 512 ? (p.in.attn_out_g + l * AW) : (p.in.ssm_out_g + l * SW - 512);
    d.src = p.in.w_out + (size_t)l * D * D; d.N = D; d.dst = p.WoutT() + (size_t)l * D * D; d.K = D; return; }
  r -= TT_OUT;
  const int kind = r / TT_EXP; r %= TT_EXP;
  const int e = r / 64, tt = r % 64;
  if (kind == 0) { d.src = p.in.w_gate + (size_t)(l * NE + e) * D * DFF; d.N = DFF; d.dst = p.WgT() + (size_t)(l * NE + e) * DFF * D; d.K = D; d.k0 = (tt / 8) * 128; d.n0 = (tt % 8) * 64; return; }
  if (kind == 1) { d.src = p.in.w_up + (size_t)(l * NE + e) * D * DFF; d.N = DFF; d.dst = p.WuT() + (size_t)(l * NE + e) * DFF * D; d.K = D; d.k0 = (tt / 8) * 128; d.n0 = (tt % 8) * 64; return; }
  d.src = p.in.w_down + (size_t)(l * NE + e) * DFF * D; d.N = D; d.dst = p.WdT() + (size_t)(l * NE + e) * D * DFF; d.K = DFF; d.k0 = (tt / 16) * 128; d.n0 = (tt % 16) * 64;
}
__device__ __forceinline__ void phase0_transposes(const MP& p, char* smem, int first, int last, int brank, int nblk) {
  const int tid = launder(threadIdx.x);
  float* lds = (float*)smem;
  const int r = tid >> 4, c4 = (tid & 15) * 4;
  const int n = tid >> 2, kq = (tid & 3) * 32;
  TrDesc cur, nxt;
  float4 v[8]; float gg[8];
  auto load = [&](const TrDesc& d) {
#pragma unroll
    for (int i = 0; i < 8; ++i) v[i] = *(const float4*)(d.src + (size_t)(d.k0 + r + 16 * i) * d.N + d.n0 + c4);
    if (d.gain) {
#pragma unroll
      for (int i = 0; i < 8; ++i) gg[i] = d.gain[d.k0 + r + 16 * i];
    } else {
#pragma unroll
      for (int i = 0; i < 8; ++i) gg[i] = 1.f;
    }
  };
  int it = first + brank;
  if (it < last) { tr_decode(p, it, cur); load(cur); nxt = cur; }
  for (; it < last; it += nblk) {
#pragma unroll
    for (int i = 0; i < 8; ++i) {
      float* d = lds + (r + 16 * i) * 65 + c4;
      d[0] = v[i].x * gg[i]; d[1] = v[i].y * gg[i]; d[2] = v[i].z * gg[i]; d[3] = v[i].w * gg[i];
    }
    __syncthreads();
    const int nit = it + nblk;
    if (nit < last) { tr_decode(p, nit, nxt); load(nxt); }
    unsigned w[16];
#pragma unroll
    for (int j = 0; j < 16; ++j) w[j] = pack2(lds[(kq + 2 * j) * 65 + n], lds[(kq + 2 * j + 1) * 65 + n]);
    u32x4* dd = (u32x4*)(cur.dst + (size_t)(cur.n0 + n) * cur.K + cur.k0 + kq);
#pragma unroll
    for (int j = 0; j < 4; ++j) dd[j] = (u32x4){w[4 * j], w[4 * j + 1], w[4 * j + 2], w[4 * j + 3]};
    __syncthreads();
    cur = nxt;
  }
}

template <bool XB>
__device__ __forceinline__ void norm_token(const void* __restrict__ xrow, const float* __restrict__ g, const float* __restrict__ sh,
                                           const float* __restrict__ sc, bf16_t* __restrict__ hr, int lane, float (&hv)[16]) {
  float4 v[4]; float ss = 0.f;
#pragma unroll
  for (int i = 0; i < 4; ++i) {
    if (XB) { const u32x2 r = *(const u32x2*)((const bf16_t*)xrow + lane * 4 + 256 * i); v[i] = make_float4(bf_lo(r[0]), bf_hi(r[0]), bf_lo(r[1]), bf_hi(r[1])); }
    else v[i] = *(const float4*)((const float*)xrow + lane * 4 + 256 * i);
    ss += v[i].x * v[i].x + v[i].y * v[i].y + v[i].z * v[i].z + v[i].w * v[i].w;
  }
  ss = wave_sum(ss);
  const float rinv = rsqrtf(ss * (1.f / D) + EPS);
#pragma unroll
  for (int i = 0; i < 4; ++i) {
    const int d = lane * 4 + 256 * i;
    const float4 gg = *(const float4*)(g + d), s1 = *(const float4*)(sc + d), s0 = *(const float4*)(sh + d);
    hv[4 * i + 0] = v[i].x * rinv * gg.x * (1.f + s1.x) + s0.x;
    hv[4 * i + 1] = v[i].y * rinv * gg.y * (1.f + s1.y) + s0.y;
    hv[4 * i + 2] = v[i].z * rinv * gg.z * (1.f + s1.z) + s0.z;
    hv[4 * i + 3] = v[i].w * rinv * gg.w * (1.f + s1.w) + s0.w;
    *(u32x2*)(hr + d) = (u32x2){pack2(hv[4 * i], hv[4 * i + 1]), pack2(hv[4 * i + 2], hv[4 * i + 3])};
  }
}

struct TokRange { int t0, step, end; };
__device__ __forceinline__ TokRange tok_range(int wave) {
  TokRange r;
  if ((gridDim.x & 7) == 0) { const int xcd = blockIdx.x & 7, lb = blockIdx.x >> 3, nlb = gridDim.x >> 3; r.t0 = xcd * S + lb * 4 + wave; r.step = nlb * 4; r.end = (xcd + 1) * S; }
  else { r.t0 = blockIdx.x * 4 + wave; r.step = gridDim.x * 4; r.end = T; }
  return r;
}
template <bool XB>
__device__ __forceinline__ void phase_norm1(const MP& p, int l, const float* xin) {
  const int tid = launder(threadIdx.x);
  const int wave = tid >> 6, lane = tid & 63;
  const float* modl = p.mod() + (size_t)l * 8 * 6144;
  const TokRange tr = tok_range(wave);
  for (int t = tr.t0; t < tr.end; t += tr.step) {
    const int b = t / S; float hv[16];
    norm_token<XB>(XB ? (const void*)(p.xb() + (size_t)t * D) : (const void*)(xin + (size_t)t * D), p.in.norm1_g + l * D, modl + (size_t)b * 6144, modl + (size_t)b * 6144 + 1024, p.h() + (size_t)t * D, lane, hv);
  }
}

struct GemmTile {
  const bf16_t* A0; const bf16_t* A1; long lda; int ksA;
  int arow[4];
  const bf16_t* Blo0; const bf16_t* Bhi0;
  const bf16_t* Blo1; const bf16_t* Bhi1;
  long ldb; int ksB;
  int K; int rot;
};

__device__ __forceinline__ int lds_off(int row, int chunk) { return row * 128 + ((chunk ^ ((row >> 1) & 7)) << 4); }

template <bool BSPLIT, bool MID>
__device__ __forceinline__ void gemm_mainloop_t(const GemmTile& g, const GemmTile& gnext, bool hasnext, bool preloaded, char* smem, f32x4 (&acc)[4][4],
                                                int ktmid, const float (&mids)[4]) {
  const int tid = launder(threadIdx.x), lane = tid & 63, wave = tid >> 6, wr = wave >> 1, wc = wave & 1, fr = lane & 15, fq = lane >> 4;
  const int r0 = tid >> 3, c8 = tid & 7;
  const int csrc = (c8 ^ ((r0 >> 1) & 7)) * 8;
  const int wbase = __builtin_amdgcn_readfirstlane(wave) * 1024;
#pragma unroll
  for (int m = 0; m < 4; ++m)
#pragma unroll
    for (int n = 0; n < 4; ++n) acc[m][n] = (f32x4){0.f, 0.f, 0.f, 0.f};
  auto stage = [&](const GemmTile& gg, int kt, int buf) {
    const int kk = ((kt + gg.rot) & (gg.K / 64 - 1)) * 64;
    const bf16_t* Ab = kk < gg.ksA ? gg.A0 + kk : gg.A1 + (kk - gg.ksA);
    const bool bs = kk < gg.ksB; const int kb = bs ? kk : kk - gg.ksB;
    char* As = smem + buf * 32768 + wbase; char* Bs = As + 16384;
#pragma unroll
    for (int i = 0; i < 4; ++i) {
      __builtin_amdgcn_global_load_lds((const void*)(Ab + (size_t)gg.arow[i] * gg.lda + csrc), (void*)(As + i * 4096), 16, 0, 0);
      const bf16_t* Bb = bs ? (i < 2 ? gg.Blo0 : gg.Bhi0) : (i < 2 ? gg.Blo1 : gg.Bhi1);
      __builtin_amdgcn_global_load_lds((const void*)(Bb + (size_t)(r0 + 32 * (i & 1)) * gg.ldb + kb + csrc), (void*)(Bs + i * 4096), 16, 0, 0);
    }
  };
  const int nk = g.K / 64;
  if (!preloaded) {
    stage(g, 0, 0);
    asm volatile("s_waitcnt vmcnt(0)" ::: "memory");
    __syncthreads();
  }
  for (int kt = 0; kt < nk; ++kt) {
    if (kt + 1 < nk) stage(g, kt + 1, (kt + 1) & 1);
    else if (hasnext) stage(gnext, 0, 0);
    if (MID && kt == ktmid) {
#pragma unroll
      for (int m = 0; m < 4; ++m)
#pragma unroll
        for (int n = 0; n < 4; ++n) acc[m][n] *= mids[m];
    }
    const char* As = smem + (kt & 1) * 32768; const char* Bs = As + 16384;
    {
      bf16x8 af[2][4], bfr[2][4];
#pragma unroll
      for (int ks = 0; ks < 2; ++ks) {
#pragma unroll
        for (int m = 0; m < 4; ++m) af[ks][m] = *(const bf16x8*)(As + lds_off(wr * 64 + 16 * m + fr, ks * 4 + fq));
#pragma unroll
        for (int n = 0; n < 4; ++n) {
          const int brow = BSPLIT ? ((n >> 1) * 64 + wc * 32 + (n & 1) * 16 + fr) : (wc * 64 + 16 * n + fr);
          bfr[ks][n] = *(const bf16x8*)(Bs + lds_off(brow, ks * 4 + fq));
        }
      }
#pragma unroll
      for (int ks = 0; ks < 2; ++ks)
#pragma unroll
        for (int m = 0; m < 4; ++m)
#pragma unroll
          for (int n = 0; n < 4; ++n) acc[m][n] = __builtin_amdgcn_mfma_f32_16x16x32_bf16(bfr[ks][n], af[ks][m], acc[m][n], 0, 0, 0);
      __builtin_amdgcn_sched_group_barrier(0x100, 8, 0);
#pragma unroll
      for (int i = 0; i < 8; ++i) { __builtin_amdgcn_sched_group_barrier(0x008, 2, 0); __builtin_amdgcn_sched_group_barrier(0x100, 1, 0); }
      __builtin_amdgcn_sched_group_barrier(0x008, 16, 0);
    }
    __builtin_amdgcn_sched_barrier(0);
    asm volatile("s_waitcnt vmcnt(0)" ::: "memory");
    __syncthreads();
  }
}
template <bool BSPLIT>
__device__ __forceinline__ void gemm_mainloop(const GemmTile& g, const GemmTile& gnext, bool hasnext, bool preloaded, char* smem, f32x4 (&acc)[4][4]) {
  const float dummy[4] = {1.f, 1.f, 1.f, 1.f};
  gemm_mainloop_t<BSPLIT, false>(g, gnext, hasnext, preloaded, smem, acc, -1, dummy);
}

struct TileMap { int base, ntl, lb, nlb; };
__device__ __forceinline__ TileMap tm_init(int nMt, int nNt) {
  TileMap t;
  if ((gridDim.x & 7) == 0) {
    const int xcd = blockIdx.x & 7;
    t.lb = blockIdx.x >> 3; t.nlb = gridDim.x >> 3;
    const int mlo = (nMt * xcd) >> 3, mhi = (nMt * (xcd + 1)) >> 3;
    t.base = mlo * nNt; t.ntl = (mhi - mlo) * nNt;
  } else { t.lb = blockIdx.x; t.nlb = gridDim.x; t.base = 0; t.ntl = nMt * nNt; }
  return t;
}
__device__ __forceinline__ int tm_tile(const TileMap& t, int j) { const int li = t.lb + t.nlb * j; return li < t.ntl ? t.base + li : -1; }
template <bool FUSEN>
__device__ __forceinline__ void phase_inproj(const MP& p, int l, char* smem) {
  const int tid = launder(threadIdx.x), lane = tid & 63, wave = tid >> 6, wr = wave >> 1, wc = wave & 1, fr = lane & 15, fq = lane >> 4;
  const int r0 = tid >> 3;
  const int ntiles = (T / 128) * (INW / 128);
  const bf16_t* W = p.WinT() + (size_t)l * INW * D;
  auto make = [&](int tile, GemmTile& g) {
    const int m0 = (tile / 10) * 128, n0 = (tile % 10) * 128;
    g.A0 = FUSEN ? p.xb() : p.h(); g.A1 = g.A0; g.lda = D; g.ksA = D; g.K = D;
#pragma unroll
    for (int i = 0; i < 4; ++i) g.arow[i] = m0 + r0 + 32 * i;
    const bf16_t* Wt = FUSEN ? p.w1b() + (size_t)(m0 / S) * INW * D : W;
    g.Blo0 = Wt + (size_t)n0 * D; g.Bhi0 = g.Blo0 + (size_t)64 * D; g.Blo1 = g.Blo0; g.Bhi1 = g.Bhi0;
    g.ldb = D; g.ksB = D; g.rot = ROT_OF(tile / 10, tile % 10);
  };
  GemmTile g, gn; bool pre = false;
  const TileMap tmap = tm_init(T / 128, INW / 128);
  { const int t0 = tm_tile(tmap, 0); if (t0 >= 0) { make(t0, g); gn = g; } }
  for (int jt = 0; ; ++jt) {
    const int tile = tm_tile(tmap, jt); if (tile < 0) break;
    const int mt = tile / 10, nt = tile % 10, m0 = mt * 128;
    const int nxt = tm_tile(tmap, jt + 1); const bool hasn = nxt >= 0;
    if (hasn) make(nxt, gn);
    f32x4 acc[4][4];
    gemm_mainloop<false>(g, gn, hasn, pre, smem, acc);
    pre = hasn; g = gn;
    const int rowb = m0 + wr * 64 + fr;
    if (FUSEN) {
      f32x4 sq[4][4], bz[4];
#pragma unroll
      for (int m = 0; m < 4; ++m)
#pragma unroll
        for (int i = 0; i < 4; ++i) sq[m][i] = *(const f32x4*)(p.ssqx() + (size_t)(rowb + 16 * m) * 16 + 4 * i);
#pragma unroll
      for (int n = 0; n < 4; ++n) bz[n] = *(const f32x4*)(p.bias1() + (size_t)(m0 / S) * INW + nt * 128 + wc * 64 + 16 * n + 4 * fq);
#pragma unroll
      for (int m = 0; m < 4; ++m) {
        float ssx = 0.f;
#pragma unroll
        for (int i = 0; i < 4; ++i) ssx += (sq[m][i][0] + sq[m][i][1]) + (sq[m][i][2] + sq[m][i][3]);
        const float rinv = rsqrtf(ssx * (1.f / D) + EPS);
#pragma unroll
        for (int n = 0; n < 4; ++n)
#pragma unroll
          for (int j = 0; j < 4; ++j) acc[m][n][j] = acc[m][n][j] * rinv + bz[n][j];
      }
    }
    if (nt <= 4) {
      const float* gv = (nt < 4 ? p.in.q_norm_g : p.in.k_norm_g) + l * HD;
      const float scl = nt < 4 ? 0.125f * 1.4426950408889634f : 1.f;
      f32x4 g1[2], g2[2];
#pragma unroll
      for (int n = 0; n < 2; ++n) { g1[n] = *(const f32x4*)(gv + 16 * n + 4 * fq); g2[n] = *(const f32x4*)(gv + 32 + 16 * n + 4 * fq); }
      float frq[2][4]; int posv[4];
#pragma unroll
      for (int n = 0; n < 2; ++n)
#pragma unroll
        for (int j = 0; j < 4; ++j) frq[n][j] = __builtin_amdgcn_exp2f(-(float)(16 * n + 4 * fq + j) * (13.287712379549449f / 32.f)) * 0.15915494309189535f;
#pragma unroll
      for (int m = 0; m < 4; ++m) posv[m] = p.in.pos[rowb + 16 * m];
#pragma unroll
      for (int m = 0; m < 4; ++m) {
        const int t = rowb + 16 * m;
        float ss = 0.f;
#pragma unroll
        for (int n = 0; n < 4; ++n)
#pragma unroll
          for (int j = 0; j < 4; ++j) ss += acc[m][n][j] * acc[m][n][j];
        ss += __shfl_xor(ss, 16); ss += __shfl_xor(ss, 32);
        const float rinv = rsqrtf(ss * (1.f / 64.f) + EPS) * scl;
        bf16_t* dst = nt < 4 ? (p.q() + (size_t)t * AW + (2 * nt + wc) * 64) : (p.k() + (size_t)t * 128 + wc * 64);
#pragma unroll
        for (int n = 0; n < 2; ++n) {
          const int c = 16 * n + 4 * fq;
          float cn[4], sn[4];
#pragma unroll
          for (int j = 0; j < 4; ++j) {
            const float rev = (float)posv[m] * frq[n][j];
            const float rr = rev - floorf(rev);
            cn[j] = __builtin_amdgcn_cosf(rr); sn[j] = __builtin_amdgcn_sinf(rr);
          }
          float o1[4], o2[4];
#pragma unroll
          for (int j = 0; j < 4; ++j) {
            const float x1 = acc[m][n][j] * rinv * g1[n][j], x2 = acc[m][n + 2][j] * rinv * g2[n][j];
            o1[j] = x1 * cn[j] - x2 * sn[j]; o2[j] = x2 * cn[j] + x1 * sn[j];
          }
          *(u32x2*)(dst + c) = (u32x2){pack2(o1[0], o1[1]), pack2(o1[2], o1[3])};
          *(u32x2*)(dst + 32 + c) = (u32x2){pack2(o2[0], o2[1]), pack2(o2[2], o2[3])};
        }
      }
    } else if (nt == 5) {
      const int b = m0 / S;
      char* Tl = smem + 32768;
#pragma unroll
      for (int m = 0; m < 4; ++m) {
        const int r = wr * 64 + 16 * m + fr;
        const int k16 = r & 15;
        const int rp = (r & ~15) | (k16 & 3) | (((k16 >> 3) & 1) << 2) | (((k16 >> 2) & 1) << 3);
#pragma unroll
        for (int n = 0; n < 4; ++n)
#pragma unroll
          for (int j = 0; j < 4; ++j)
            *(bf16_t*)(Tl + (wc * 64 + 16 * n + 4 * fq + j) * 256 + rp * 2) = (bf16_t)(pack2(acc[m][n][j], 0.f) & 0xffffu);
      }
      __syncthreads();
      const int sb = m0 % S;
#pragma unroll
      for (int i = 0; i < 8; ++i) {
        const int ch = tid + 256 * i, dg = ch >> 4, c16 = ch & 15;
        const u32x4 v = *(const u32x4*)(Tl + dg * 256 + c16 * 16);
        *(u32x4*)(p.vT() + ((size_t)(b * 2) * 64 + dg) * S + sb + c16 * 8) = v;
      }
      __syncthreads();
    } else {
#pragma unroll
      for (int m = 0; m < 4; ++m) {
        const int t = rowb + 16 * m;
#pragma unroll
        for (int n = 0; n < 4; ++n)
          *(u32x2*)(p.u() + (size_t)t * SW + (nt - 6) * 128 + wc * 64 + 16 * n + 4 * fq) = (u32x2){pack2(acc[m][n][0], acc[m][n][1]), pack2(acc[m][n][2], acc[m][n][3])};
      }
    }
  }
}

__device__ __forceinline__ int crow32(int r, int hf) { return (r & 3) + 8 * (r >> 2) + 4 * hf; }
__device__ __forceinline__ void attn_task(const MP& p, int l, int task, int lane) {
  lane = launder(lane);
  task = __builtin_amdgcn_readfirstlane(task);
  const int h = task & 7, qt = (task >> 3) & 63, b = task >> 9, kvh = h >> 2;
  const int s0 = qt * 32, t0 = b * S + s0, ql = lane & 31, hf = lane >> 5;
  int kst[5];
#pragma unroll
  for (int kt = 0; kt < 5; ++kt) { const int ks = s0 - 128 + 32 * kt; kst[kt] = ks < 0 ? 0 : ks; }
  bf16x8 qf[4], kf[5][4];
#pragma unroll
  for (int st = 0; st < 4; ++st) qf[st] = *(const bf16x8*)(p.q() + (size_t)(t0 + ql) * AW + h * 64 + 16 * st + 8 * hf);
#pragma unroll
  for (int kt = 0; kt < 5; ++kt)
#pragma unroll
    for (int st = 0; st < 4; ++st) kf[kt][st] = *(const bf16x8*)(p.k() + (size_t)(b * S + kst[kt] + ql) * 128 + kvh * 64 + 8 * hf + 16 * st);
  f32x16 sc[5];
#pragma unroll
  for (int kt = 0; kt < 5; ++kt) {
#pragma unroll
    for (int r = 0; r < 16; ++r) sc[kt][r] = 0.f;
#pragma unroll
    for (int st = 0; st < 4; ++st) sc[kt] = __builtin_amdgcn_mfma_f32_32x32x16_bf16(kf[kt][st], qf[st], sc[kt], 0, 0, 0);
  }
  bf16x8 vb[5][2][2];
#pragma unroll
  for (int kt = 0; kt < 5; ++kt)
#pragma unroll
    for (int s = 0; s < 2; ++s)
#pragma unroll
      for (int dt = 0; dt < 2; ++dt)
        vb[kt][s][dt] = *(const bf16x8*)(p.vT() + ((size_t)(b * 2 + kvh) * 64 + 32 * dt + ql) * S + kst[kt] + 16 * s + 8 * hf);
  const float sink = p.in.attn_sink[l * NQ + h];
  float mx = sink;
#pragma unroll
  for (int kt = 0; kt < 5; ++kt) {
#pragma unroll
    for (int r = 0; r < 16; ++r) {
      const int kp = s0 - 128 + 32 * kt + crow32(r, hf);
      const int dk = kp - (s0 + ql);
      const bool valid = kp >= 0 && dk <= 0 && dk > -128;
      sc[kt][r] = valid ? sc[kt][r] : -1e30f;
      mx = fmaxf(mx, sc[kt][r]);
    }
  }
  mx = xhalf_max(mx);
  float lsum = 0.f;
#pragma unroll
  for (int kt = 0; kt < 5; ++kt) {
#pragma unroll
    for (int r = 0; r < 16; ++r) { const float e = __expf(sc[kt][r] - mx); sc[kt][r] = e; lsum += e; }
  }
  lsum = xhalf_sum(lsum);
  lsum += __expf(sink - mx);
  const float inv = 1.f / lsum;
  f32x16 o[2];
#pragma unroll
  for (int r = 0; r < 16; ++r) { o[0][r] = 0.f; o[1][r] = 0.f; }
#pragma unroll
  for (int kt = 0; kt < 5; ++kt) {
#pragma unroll
    for (int s = 0; s < 2; ++s) {
      u32x4 pw;
#pragma unroll
      for (int j = 0; j < 4; ++j) pw[j] = pack2(sc[kt][8 * s + 2 * j], sc[kt][8 * s + 2 * j + 1]);
      const bf16x8 pa = __builtin_bit_cast(bf16x8, pw);
#pragma unroll
      for (int dt = 0; dt < 2; ++dt) o[dt] = __builtin_amdgcn_mfma_f32_32x32x16_bf16(vb[kt][s][dt], pa, o[dt], 0, 0, 0);
    }
  }
  bf16_t* dst = p.attn() + (size_t)(t0 + ql) * AW + h * 64 + 4 * hf;
  float ssq = 0.f;
#pragma unroll
  for (int dt = 0; dt < 2; ++dt)
#pragma unroll
    for (int g4 = 0; g4 < 4; ++g4) {
      const float a0 = o[dt][4 * g4] * inv, a1 = o[dt][4 * g4 + 1] * inv, a2 = o[dt][4 * g4 + 2] * inv, a3 = o[dt][4 * g4 + 3] * inv;
      ssq += (a0 * a0 + a1 * a1) + (a2 * a2 + a3 * a3);
      *(u32x2*)(dst + 32 * dt + 8 * g4) = (u32x2){pack2(a0, a1), pack2(a2, a3)};
    }
  ssq = xhalf_sum(ssq);
  if (hf == 0) p.ssqa()[(size_t)(t0 + ql) * 8 + h] = ssq;
}
constexpr int SSEG = 4, SEGLEN = S / SSEG, SEGCH = SEGLEN / 32;

__device__ __forceinline__ void ssm_bu(const bf16x8& ua, const bf16x8 (&bB)[4], f32x16 (&bu)[4]) {
#pragma unroll
  for (int nt = 0; nt < 4; ++nt) {
#pragma unroll
    for (int r = 0; r < 16; ++r) bu[nt][r] = 0.f;
    bu[nt] = __builtin_amdgcn_mfma_f32_32x32x16_bf16(ua, bB[nt], bu[nt], 0, 0, 0);
  }
  asm volatile("s_nop 15\n\ts_nop 7" : "+v"(bu[0]), "+v"(bu[1]), "+v"(bu[2]), "+v"(bu[3]));
#pragma unroll
  for (int r = 0; r < 16; ++r) {
    auto s0 = __builtin_amdgcn_permlane32_swap(__float_as_uint(bu[0][r]), __float_as_uint(bu[1][r]), false, false);
    bu[0][r] = __uint_as_float(s0[0]); bu[1][r] = __uint_as_float(s0[1]);
    auto s1 = __builtin_amdgcn_permlane32_swap(__float_as_uint(bu[2][r]), __float_as_uint(bu[3][r]), false, false);
    bu[2][r] = __uint_as_float(s1[0]); bu[3][r] = __uint_as_float(s1[1]);
  }
}

__device__ __forceinline__ void ssm_block(const MP& p, int l, int b, int g, int tid, char* smem) {
  const int lane = tid & 63, seg = tid >> 6;
  char* wl = smem + seg * 8192;
  float* fin = (float*)(smem + 4 * 8192);
  const int lg = l * SG + g, hf = lane >> 5, fr = lane & 15, fq = lane >> 4;
  const float ar = p.ssmL()[(lg * SP + lane) * 2], ai = p.ssmL()[(lg * SP + lane) * 2 + 1];
  bf16x8 bB[4], cB[4];
#pragma unroll
  for (int nt = 0; nt < 4; ++nt) bB[nt] = *(const bf16x8*)(p.ssmB() + ((size_t)lg * 128 + nt * 32 + (lane & 31)) * 16 + 8 * hf);
#pragma unroll
  for (int ks = 0; ks < 4; ++ks) cB[ks] = *(const bf16x8*)(p.ssmC() + ((size_t)lg * 16 + fr) * 128 + 32 * ks + 8 * fq);
  const f32x4 dsk = *(const f32x4*)(p.in.ssm_d + l * SW + g * 16 + 4 * fq);
  const int t0 = b * S + seg * SEGLEN;
  const bf16_t* urow = p.u() + (size_t)(t0 + (lane & 31)) * SW + g * 16 + 8 * hf;
  float xr = 0.f, xi = 0.f;
  if (seg < SSEG - 1) {
    bf16x8 ua = *(const bf16x8*)(urow);
    for (int c = 0; c < SEGCH; ++c) {
      const bf16x8 un = *(const bf16x8*)(urow + (size_t)((c + 1 < SEGCH ? c + 1 : c) * 32) * SW);
      f32x16 bu[4];
      ssm_bu(ua, bB, bu);
#pragma unroll
      for (int r4 = 0; r4 < 4; ++r4)
#pragma unroll
        for (int half = 0; half < 2; ++half)
#pragma unroll
          for (int j = 0; j < 4; ++j) {
            const int r = 4 * r4 + j;
            const float bre = half ? bu[1][r] : bu[0][r], bim = half ? bu[3][r] : bu[2][r];
            const float nr = ar * xr - ai * xi + bre, ni = ar * xi + ai * xr + bim;
            xr = nr; xi = ni;
          }
      ua = un;
    }
  }
  fin[(seg * 64 + lane) * 2] = xr; fin[(seg * 64 + lane) * 2 + 1] = xi;
  __syncthreads();
  {
    float pr = ar, pi = ai;
#pragma unroll
    for (int i = 0; i < 9; ++i) { const float nr = pr * pr - pi * pi, ni = 2.f * pr * pi; pr = nr; pi = ni; }
    static_assert(SEGLEN == 512, "lam^SEGLEN squaring count");
    float cr = 0.f, ci = 0.f;
    for (int j = 0; j < seg; ++j) {
      const float fr_ = fin[(j * 64 + lane) * 2], fi_ = fin[(j * 64 + lane) * 2 + 1];
      const float nr = pr * cr - pi * ci + fr_, ni = pr * ci + pi * cr + fi_;
      cr = nr; ci = ni;
    }
    xr = cr; xi = ci;
  }
  const int wbase = (lane & 3) * 4;
  const int pch = lane >> 2;
  const bf16_t* uep = p.u() + (size_t)(t0 + fr) * SW + g * 16 + 4 * fq;
  bf16x8 ua = *(const bf16x8*)(urow);
  u32x2 uraw[2];
#pragma unroll
  for (int i = 0; i < 2; ++i) uraw[i] = *(const u32x2*)(uep + (size_t)(16 * i) * SW);
  for (int c = 0; c < SEGCH; ++c) {
    const int tb = t0 + c * 32;
    const int cn = (c + 1 < SEGCH ? c + 1 : c) * 32;
    const bf16x8 un = *(const bf16x8*)(urow + (size_t)cn * SW);
    u32x2 unraw[2];
#pragma unroll
    for (int i = 0; i < 2; ++i) unraw[i] = *(const u32x2*)(uep + (size_t)(cn + 16 * i) * SW);
    f32x16 bu[4];
    ssm_bu(ua, bB, bu);
#pragma unroll
    for (int r4 = 0; r4 < 4; ++r4) {
#pragma unroll
      for (int half = 0; half < 2; ++half) {
#pragma unroll
        for (int j = 0; j < 4; ++j) {
          const int t = 8 * r4 + 4 * half + j, r = 4 * r4 + j;
          const float bre = half ? bu[1][r] : bu[0][r], bim = half ? bu[3][r] : bu[2][r];
          const float nr = ar * xr - ai * xi + bre, ni = ar * xi + ai * xr + bim;
          xr = nr; xi = ni;
          *(unsigned*)(wl + t * 256 + ((pch ^ (t & 15)) << 4) + wbase) = pack2(nr, ni);
        }
      }
    }
    asm volatile("s_waitcnt lgkmcnt(0)" ::: "memory");
#pragma unroll
    for (int mt = 0; mt < 2; ++mt) {
      f32x4 acc = {0.f, 0.f, 0.f, 0.f};
      const int t = 16 * mt + fr;
#pragma unroll
      for (int ks = 0; ks < 4; ++ks) {
        const bf16x8 af = *(const bf16x8*)(wl + t * 256 + (((4 * ks + fq) ^ (t & 15)) << 4));
        acc = __builtin_amdgcn_mfma_f32_16x16x32_bf16(cB[ks], af, acc, 0, 0, 0);
      }
      const float uu[4] = {bf_lo(uraw[mt][0]), bf_hi(uraw[mt][0]), bf_lo(uraw[mt][1]), bf_hi(uraw[mt][1])};
      float ge[4];
#pragma unroll
      for (int j = 0; j < 4; ++j) {
        const float v = acc[j] + dsk[j] * uu[j];
        const float z2 = 1.5957691216057308f * (v + 0.044715f * v * v * v);
        ge[j] = v * __builtin_amdgcn_rcpf(1.f + __expf(-z2));
      }
      *(u32x2*)(p.y() + (size_t)(tb + t) * SW + g * 16 + 4 * fq) = (u32x2){pack2(ge[0], ge[1]), pack2(ge[2], ge[3])};
    }
    asm volatile("s_waitcnt lgkmcnt(0)" ::: "memory");
    ua = un;
#pragma unroll
    for (int i = 0; i < 2; ++i) uraw[i] = unraw[i];
  }
}

constexpr int ATT_KBYTES = 160 * 128, ATT_VCH = 21, ATT_VBYTES = 64 * ATT_VCH * 16;
__device__ __forceinline__ void attn_block(const MP& p, int l, int b, int qt, int kvh, char* smem, int tid) {
  const int lane = tid & 63, wave = __builtin_amdgcn_readfirstlane(tid >> 6);
  const int h = kvh * 4 + wave;
  const int s0 = qt * 32, t0 = b * S + s0, ql = lane & 31, hf = lane >> 5;
  char* Ks = smem; char* Vs = smem + ATT_KBYTES;
  {
    const bf16_t* kb = p.k() + (size_t)b * S * 128 + kvh * 64;
#pragma unroll
    for (int j = 0; j < 5; ++j) {
      const int pc = wave + 4 * j;
      const int R = 8 * pc + (lane >> 3);
      int ks = s0 - 128 + R; ks = ks < 0 ? 0 : ks;
      const int c = (lane & 7) ^ ((R >> 1) & 7);
      __builtin_amdgcn_global_load_lds((const void*)(kb + (size_t)ks * 128 + c * 8), (void*)(Ks + pc * 1024), 16, 0, 0);
    }
    const bf16_t* vbp = p.vT() + (size_t)(b * 2 + kvh) * 64 * S;
#pragma unroll
    for (int j = 0; j < 6; ++j) {
      const int pc = wave + 4 * j;
      if (pc < ATT_VCH) {
        const int q = 64 * pc + lane, d = q / ATT_VCH, c = q - d * ATT_VCH;
        int ko = s0 - 128 + 8 * (c < 20 ? c : 19); ko = ko < 0 ? 0 : ko;
        __builtin_amdgcn_global_load_lds((const void*)(vbp + (size_t)d * S + ko), (void*)(Vs + pc * 1024), 16, 0, 0);
      }
    }
  }
  bf16x8 qf[4];
#pragma unroll
  for (int st = 0; st < 4; ++st) qf[st] = *(const bf16x8*)(p.q() + (size_t)(t0 + ql) * AW + h * 64 + 16 * st + 8 * hf);
  asm volatile("s_waitcnt vmcnt(0)" ::: "memory");
  __syncthreads();
  f32x16 sc[5];
#pragma unroll
  for (int kt = 0; kt < 5; ++kt) {
#pragma unroll
    for (int r = 0; r < 16; ++r) sc[kt][r] = 0.f;
#pragma unroll
    for (int st = 0; st < 4; ++st) {
      const int R = 32 * kt + ql, c = 2 * st + hf;
      const bf16x8 kf = *(const bf16x8*)(Ks + R * 128 + ((c ^ ((R >> 1) & 7)) << 4));
      sc[kt] = __builtin_amdgcn_mfma_f32_32x32x16_bf16(kf, qf[st], sc[kt], 0, 0, 0);
    }
  }
  const float sink = p.in.attn_sink[l * NQ + h] * 1.4426950408889634f;
  const int qlh = ql - 4 * hf;
  float mx = sink;
#pragma unroll
  for (int kt = 0; kt < 5; ++kt) {
    const float tbias = (s0 - 128 + 32 * kt) >= 0 ? 0.f : -1e30f;
#pragma unroll
    for (int r = 0; r < 16; ++r) {
      const int cr = (r & 3) + 8 * (r >> 2);
      float v = sc[kt][r];
      if (kt == 0) v = cr > qlh ? v + tbias : -1e30f;
      else if (kt == 4) v = cr <= qlh ? v : -1e30f;
      else v = v + tbias;
      sc[kt][r] = v;
      mx = fmaxf(mx, v);
    }
  }
  mx = xhalf_max(mx);
  float lsum = 0.f;
#pragma unroll
  for (int kt = 0; kt < 5; ++kt) {
#pragma unroll
    for (int r = 0; r < 16; ++r) { const float e = __builtin_amdgcn_exp2f(sc[kt][r] - mx); sc[kt][r] = e; lsum += e; }
  }
  lsum = xhalf_sum(lsum);
  lsum += __builtin_amdgcn_exp2f(sink - mx);
  const float inv = 1.f / lsum;
  f32x16 o[2];
#pragma unroll
  for (int r = 0; r < 16; ++r) { o[0][r] = 0.f; o[1][r] = 0.f; }
#pragma unroll
  for (int kt = 0; kt < 5; ++kt) {
#pragma unroll
    for (int s = 0; s < 2; ++s) {
      u32x4 pw;
#pragma unroll
      for (int j = 0; j < 4; ++j) pw[j] = pack2(sc[kt][8 * s + 2 * j], sc[kt][8 * s + 2 * j + 1]);
      const bf16x8 pa = __builtin_bit_cast(bf16x8, pw);
#pragma unroll
      for (int dt = 0; dt < 2; ++dt) {
        const bf16x8 vb = *(const bf16x8*)(Vs + ((32 * dt + ql) * ATT_VCH + 4 * kt + 2 * s + hf) * 16);
        o[dt] = __builtin_amdgcn_mfma_f32_32x32x16_bf16(vb, pa, o[dt], 0, 0, 0);
      }
    }
  }
  bf16_t* dst = p.attn() + (size_t)(t0 + ql) * AW + h * 64 + 4 * hf;
  float ssq = 0.f;
#pragma unroll
  for (int dt = 0; dt < 2; ++dt)
#pragma unroll
    for (int g4 = 0; g4 < 4; ++g4) {
      const float a0 = o[dt][4 * g4] * inv, a1 = o[dt][4 * g4 + 1] * inv, a2 = o[dt][4 * g4 + 2] * inv, a3 = o[dt][4 * g4 + 3] * inv;
      ssq += (a0 * a0 + a1 * a1) + (a2 * a2 + a3 * a3);
      *(u32x2*)(dst + 32 * dt + 8 * g4) = (u32x2){pack2(a0, a1), pack2(a2, a3)};
    }
  ssq = xhalf_sum(ssq);
  if (hf == 0) p.ssqa()[(size_t)(t0 + ql) * 8 + h] = ssq;
  __syncthreads();
}

__device__ __forceinline__ void phase_attn(const MP& p, int l, char* smem) {
  const int tid = launder(threadIdx.x);
  if ((gridDim.x & 7) == 0) {
    const int xcd = blockIdx.x & 7, lb = blockIdx.x >> 3, nlb = gridDim.x >> 3;
#pragma unroll 1
    for (int it = lb; it < 128; it += nlb) attn_block(p, l, xcd, it & 63, it >> 6, smem, tid);
  } else {
#pragma unroll 1
    for (int it = blockIdx.x; it < NB * 128; it += gridDim.x) attn_block(p, l, it >> 7, it & 63, (it >> 6) & 1, smem, tid);
  }
}
__device__ __forceinline__ void phase_ssm(const MP& p, int l, char* smem, int wid, int lrank) {
  const int tid = launder(threadIdx.x);
  if (wid < 0) return;
  unsigned nwl = 0; bool all = (gridDim.x & 7) == 0;
#pragma unroll
  for (int x = 0; x < 8; ++x) {
    const unsigned c = __hip_atomic_load(p.claim() + 4104 + x, __ATOMIC_RELAXED, __HIP_MEMORY_SCOPE_AGENT);
    all = all && c > 0u; nwl = (x == (int)(blockIdx.x & 7)) ? c : nwl;
  }
  if (all) {
    const int b = blockIdx.x & 7;
    for (int g = lrank; g < SG; g += (int)nwl) { ssm_block(p, l, b, g, tid, smem); __syncthreads(); }
  } else {
    const int nw = (int)__hip_atomic_load(p.claim() + 4096, __ATOMIC_RELAXED, __HIP_MEMORY_SCOPE_AGENT);
    for (int task = wid; task < NB * SG; task += nw) { ssm_block(p, l, task / SG, task % SG, tid, smem); __syncthreads(); }
  }
}
__device__ __forceinline__ void phase_glu(const MP& p, int l, char* smem) {
  const int tid = launder(threadIdx.x), lane = tid & 63, wave = tid >> 6, wr = wave >> 1, wc = wave & 1, fr = lane & 15, fq = lane >> 4;
  const int r0 = tid >> 3;
  const int ntiles = (T / 128) * (SW / 128);
  const bf16_t* W = p.WgluT() + (size_t)l * SW * SW;
  auto make = [&](int tile, GemmTile& g) {
    const int m0 = (tile >> 2) * 128, n0 = (tile & 3) * 128;
    g.A0 = p.y(); g.A1 = p.y(); g.lda = SW; g.ksA = SW; g.K = SW;
#pragma unroll
    for (int i = 0; i < 4; ++i) g.arow[i] = m0 + r0 + 32 * i;
    g.Blo0 = W + (size_t)n0 * SW; g.Bhi0 = g.Blo0 + (size_t)64 * SW; g.Blo1 = g.Blo0; g.Bhi1 = g.Bhi0;
    g.ldb = SW; g.ksB = SW; g.rot = ROT_OF(tile >> 2, tile & 3) & 7;
  };
  GemmTile g, gn; bool pre = false;
  const TileMap tmap = tm_init(T / 128, SW / 128);
  { const int t0 = tm_tile(tmap, 0); if (t0 >= 0) { make(t0, g); gn = g; } }
  for (int jt = 0; ; ++jt) {
    const int tile = tm_tile(tmap, jt); if (tile < 0) break;
    const int mt = tile >> 2, nt = tile & 3, m0 = mt * 128, n0 = nt * 128;
    const int nxt = tm_tile(tmap, jt + 1); const bool hasn = nxt >= 0;
    if (hasn) make(nxt, gn);
    f32x4 acc[4][4];
    gemm_mainloop<false>(g, gn, hasn, pre, smem, acc);
    pre = hasn; g = gn;
    u32x2 yrv[4][4];
#pragma unroll
    for (int m = 0; m < 4; ++m)
#pragma unroll
      for (int n = 0; n < 4; ++n) yrv[m][n] = *(const u32x2*)(p.y() + (size_t)(m0 + wr * 64 + 16 * m + fr) * SW + n0 + wc * 64 + 16 * n + 4 * fq);
#pragma unroll
    for (int m = 0; m < 4; ++m) {
      const int t = m0 + wr * 64 + 16 * m + fr;
      float ss = 0.f;
#pragma unroll
      for (int n = 0; n < 4; ++n) {
        const int col = n0 + wc * 64 + 16 * n + 4 * fq;
        const u32x2 yr = yrv[m][n];
        const float yv[4] = {bf_lo(yr[0]), bf_hi(yr[0]), bf_lo(yr[1]), bf_hi(yr[1])};
        float o[4];
#pragma unroll
        for (int j = 0; j < 4; ++j) { o[j] = yv[j] * __builtin_amdgcn_rcpf(1.f + __expf(-acc[m][n][j])); ss += o[j] * o[j]; }
        *(u32x2*)(p.ssm() + (size_t)t * SW + col) = (u32x2){pack2(o[0], o[1]), pack2(o[2], o[3])};
      }
      ss += __shfl_xor(ss, 16); ss += __shfl_xor(ss, 32);
      if (fq == 0) p.ssqs()[(size_t)t * 8 + nt * 2 + wc] = ss;
    }
  }
}

template <bool XB>
__device__ __forceinline__ void phase_out(const MP& p, int l, char* smem, const float* xin) {
  const int tid = launder(threadIdx.x), lane = tid & 63, wave = tid >> 6, wr = wave >> 1, wc = wave & 1, fr = lane & 15, fq = lane >> 4;
  const int r0 = tid >> 3;
  const float* modl = p.mod() + (size_t)l * 8 * 6144;
  const int ntiles = (T / 128) * (D / 128);
  const bf16_t* W = p.WoutT() + (size_t)l * D * D;
  auto make = [&](int tile, GemmTile& g) {
    const int m0 = (tile >> 3) * 128, n0 = (tile & 7) * 128;
    g.A0 = p.attn(); g.A1 = p.ssm(); g.lda = AW; g.ksA = AW; g.K = D;
#pragma unroll
    for (int i = 0; i < 4; ++i) g.arow[i] = m0 + r0 + 32 * i;
    g.Blo0 = W + (size_t)n0 * D; g.Bhi0 = g.Blo0 + (size_t)64 * D; g.Blo1 = g.Blo0; g.Bhi1 = g.Bhi0;
    g.ldb = D; g.ksB = D; g.rot = 0;
  };
  GemmTile g, gn; bool pre = false;
  const TileMap tmap = tm_init(T / 128, D / 128);
  { const int t0 = tm_tile(tmap, 0); if (t0 >= 0) { make(t0, g); gn = g; } }
  for (int jt = 0; ; ++jt) {
    const int tile = tm_tile(tmap, jt); if (tile < 0) break;
    const int mt = tile >> 3, nt = tile & 7, m0 = mt * 128, n0 = nt * 128, b = m0 / S;
    const int nxt = tm_tile(tmap, jt + 1); const bool hasn = nxt >= 0;
    if (hasn) make(nxt, gn);
    float mids[4], rs[4];
#pragma unroll
    for (int m = 0; m < 4; ++m) {
      const int t = m0 + wr * 64 + 16 * m + fr;
      const f32x4 a0 = *(const f32x4*)(p.ssqa() + (size_t)t * 8), a1 = *(const f32x4*)(p.ssqa() + (size_t)t * 8 + 4);
      const f32x4 s0 = *(const f32x4*)(p.ssqs() + (size_t)t * 8), s1 = *(const f32x4*)(p.ssqs() + (size_t)t * 8 + 4);
      const float sa = ((a0[0] + a0[1]) + (a0[2] + a0[3])) + ((a1[0] + a1[1]) + (a1[2] + a1[3]));
      const float sq = ((s0[0] + s0[1]) + (s0[2] + s0[3])) + ((s1[0] + s1[1]) + (s1[2] + s1[3]));
      const float ra = rsqrtf(sa * (1.f / 512.f) + EPS);
      rs[m] = rsqrtf(sq * (1.f / 512.f) + EPS);
      mids[m] = ra / rs[m];
    }
    f32x4 acc[4][4];
    gemm_mainloop_t<false, true>(g, gn, hasn, pre, smem, acc, 8, mids);
    pre = hasn; g = gn;
    f32x4 g1v[4], xvv[4][4]; u32x2 xbv[4][4];
#pragma unroll
    for (int n = 0; n < 4; ++n) g1v[n] = *(const f32x4*)(modl + (size_t)b * 6144 + 2 * 1024 + n0 + wc * 64 + 16 * n + 4 * fq);
#pragma unroll
    for (int m = 0; m < 4; ++m)
#pragma unroll
      for (int n = 0; n < 4; ++n) {
        const size_t xo = (size_t)(m0 + wr * 64 + 16 * m + fr) * D + n0 + wc * 64 + 16 * n + 4 * fq;
        if (XB) xbv[m][n] = *(const u32x2*)(p.xb() + xo); else xvv[m][n] = *(const f32x4*)(xin + xo);
      }
#pragma unroll
    for (int m = 0; m < 4; ++m) {
      const int t = m0 + wr * 64 + 16 * m + fr;
#pragma unroll
      for (int n = 0; n < 4; ++n) {
        const int col = n0 + wc * 64 + 16 * n + 4 * fq;
        const f32x4 xv = XB ? (f32x4){bf_lo(xbv[m][n][0]), bf_hi(xbv[m][n][0]), bf_lo(xbv[m][n][1]), bf_hi(xbv[m][n][1])} : xvv[m][n];
        const f32x4 g1 = g1v[n];
        f32x4 o;
#pragma unroll
        for (int j = 0; j < 4; ++j) o[j] = xv[j] + g1[j] * (acc[m][n][j] * rs[m]);
        *(u32x2*)(p.x1() + (size_t)t * D + col) = (u32x2){pack2(o[0], o[1]), pack2(o[2], o[3])};
      }
    }
  }
}
__device__ __forceinline__ void phase_norm2_route(const MP& p, int l, char* smem) {
  const int tid = launder(threadIdx.x);
  const int wave = tid >> 6, lane = tid & 63, fr = lane & 15, fq = lane >> 4;
  const float* modl = p.mod() + (size_t)l * 8 * 6144;
  const float* g2n = p.in.norm2_g + l * D;
  float* gsl = (float*)smem;
  float* shl = gsl + 1024;
  int* cntl = p.cnt() + l * 256;
  for (int s = blockIdx.x; s < 512; s += gridDim.x) {
    const int b = s & 7, q = s >> 3;
    __syncthreads();
    {
      const int d = tid * 4;
      const float4 gg = *(const float4*)(g2n + d), s1 = *(const float4*)(modl + (size_t)b * 6144 + 4 * 1024 + d), s0 = *(const float4*)(modl + (size_t)b * 6144 + 3 * 1024 + d);
      *(float4*)(gsl + d) = make_float4(gg.x * (1.f + s1.x), gg.y * (1.f + s1.y), gg.z * (1.f + s1.z), gg.w * (1.f + s1.w));
      *(float4*)(shl + d) = s0;
    }
    __syncthreads();
    {
      const int g = wave & 1, kh = wave >> 1;
      float* pss = (float*)(smem + 8192);
      f32x4* pacc = (f32x4*)(smem + 8192 + 256);
      const int t = b * S + (q * 2 + g) * 16 + fr;
      const bf16_t* xrow = p.x1() + (size_t)t * D + 512 * kh + 8 * fq;
      float ss = 0.f;
#pragma unroll 8
      for (int ks = 0; ks < 16; ++ks) {
        const u32x4 xr = *(const u32x4*)(xrow + 32 * ks);
#pragma unroll
        for (int j = 0; j < 4; ++j) { const float a = bf_lo(xr[j]), c = bf_hi(xr[j]); ss += a * a + c * c; }
      }
      ss += __shfl_xor(ss, 16); ss += __shfl_xor(ss, 32);
      if (fq == 0) pss[(g * 2 + kh) * 16 + fr] = ss;
      __syncthreads();
      ss = pss[(g * 2) * 16 + fr] + pss[(g * 2 + 1) * 16 + fr];
      const float rinv = rsqrtf(ss * (1.f / D) + EPS);
      const u32x4* wf = p.wrf() + (size_t)(kh * 16) * 2 * 64 + lane;
      bf16_t* hrow = p.h() + (size_t)t * D + 512 * kh + 8 * fq;
      const float* gq = gsl + 512 * kh + 8 * fq; const float* sq = shl + 512 * kh + 8 * fq;
      f32x4 acc = {0.f, 0.f, 0.f, 0.f};
#pragma unroll 4
      for (int ks = 0; ks < 16; ++ks) {
        const u32x4 xr = *(const u32x4*)(xrow + 32 * ks);
        const float* gp = gq + 32 * ks; const float* sp = sq + 32 * ks;
        const f32x4 ga = *(const f32x4*)gp, gb = *(const f32x4*)(gp + 4), sa = *(const f32x4*)sp, sb = *(const f32x4*)(sp + 4);
        const float gv[8] = {ga[0], ga[1], ga[2], ga[3], gb[0], gb[1], gb[2], gb[3]}, sv[8] = {sa[0], sa[1], sa[2], sa[3], sb[0], sb[1], sb[2], sb[3]};
        u32x4 hi, lo;
#pragma unroll
        for (int j = 0; j < 4; ++j) {
          const float h0 = bf_lo(xr[j]) * rinv * gv[2 * j] + sv[2 * j], h1 = bf_hi(xr[j]) * rinv * gv[2 * j + 1] + sv[2 * j + 1];
          hi[j] = pack2(h0, h1);
          lo[j] = pack2(h0 - bf_lo(hi[j]), h1 - bf_hi(hi[j]));
        }
        *(u32x4*)(hrow + 32 * ks) = hi;
        const bf16x8 whi = __builtin_bit_cast(bf16x8, wf[(ks * 2) * 64]), wlo = __builtin_bit_cast(bf16x8, wf[(ks * 2 + 1) * 64]);
        const bf16x8 hhi = __builtin_bit_cast(bf16x8, hi), hlo = __builtin_bit_cast(bf16x8, lo);
        acc = __builtin_amdgcn_mfma_f32_16x16x32_bf16(whi, hhi, acc, 0, 0, 0);
        acc = __builtin_amdgcn_mfma_f32_16x16x32_bf16(whi, hlo, acc, 0, 0, 0);
        acc = __builtin_amdgcn_mfma_f32_16x16x32_bf16(wlo, hhi, acc, 0, 0, 0);
      }
      if (kh == 1) pacc[g * 64 + lane] = acc;
      __syncthreads();
      if (kh == 0) {
      const f32x4 oth = pacc[g * 64 + lane];
#pragma unroll
      for (int j = 0; j < 4; ++j) acc[j] += oth[j];
      float mx = fmaxf(fmaxf(acc[0], acc[1]), fmaxf(acc[2], acc[3]));
      mx = fmaxf(mx, __shfl_xor(mx, 16)); mx = fmaxf(mx, __shfl_xor(mx, 32));
      float pr[4], sel[4]; float sum = 0.f;
#pragma unroll
      for (int j = 0; j < 4; ++j) { pr[j] = __expf(acc[j] - mx); sum += pr[j]; }
      sum += __shfl_xor(sum, 16); sum += __shfl_xor(sum, 32);
      const float inv = 1.f / sum;
      const f32x4 rb = *(const f32x4*)(p.in.router_bias + 4 * fq);
#pragma unroll
      for (int j = 0; j < 4; ++j) { pr[j] *= inv; sel[j] = pr[j] + rb[j]; }
      float m1 = -1e30f, m2 = -1e30f;
#pragma unroll
      for (int j = 0; j < 4; ++j) { const float v = sel[j]; if (v > m1) { m2 = m1; m1 = v; } else if (v > m2) m2 = v; }
      const float gs = m1 + m2;
      int gbest = 0; float gbs = -1e30f;
#pragma unroll
      for (int gg = 0; gg < 4; ++gg) { const float v = __shfl(gs, fr + 16 * gg); if (v > gbs) { gbs = v; gbest = gg; } }
      if (fq == gbest) {
        int i0 = 0; float b0 = sel[0];
#pragma unroll
        for (int j = 1; j < 4; ++j) if (sel[j] > b0) { b0 = sel[j]; i0 = j; }
        int i1 = -1; float bb1 = -1e30f;
#pragma unroll
        for (int j = 0; j < 4; ++j) if (j != i0 && sel[j] > bb1) { bb1 = sel[j]; i1 = j; }
        float p0 = 0.f, p1 = 0.f;
#pragma unroll
        for (int j = 0; j < 4; ++j) { if (j == i0) p0 = pr[j]; if (j == i1) p1 = pr[j]; }
        const float w0 = p0 / (p0 + p1), w1 = p1 / (p0 + p1);
        const int lo2 = i0 < i1 ? i0 : i1, hi2 = i0 < i1 ? i1 : i0;
        const float wlo = i0 < i1 ? w0 : w1, whi2 = i0 < i1 ? w1 : w0;
        const int pidx = (lo2 == 0) ? (hi2 - 1) : (lo2 == 1 ? (hi2 + 1) : 5);
        const int bucket = gbest * 6 + pidx;
        const int sl = bucket * NSUBL + (blockIdx.x & (NSUBL - 1));
        const int pos = atomicAdd(&cntl[sl], 1);
        p.list()[(size_t)sl * T + pos] = t;
        p.tokw()[t] = make_float2(wlo, whi2);
      }
      }
    }
  }
  __syncthreads();
}

__device__ __forceinline__ void bucket_experts2(int bucket, int& elo, int& ehi) {
  const int g = bucket / 6, pi = bucket % 6;
  const int lo = pi < 3 ? 0 : (pi < 5 ? 1 : 2);
  const int hi = pi < 3 ? pi + 1 : (pi < 5 ? pi - 1 : 3);
  elo = g * 4 + lo; ehi = g * 4 + hi;
}
__device__ __forceinline__ void moe_map_build(const int* cnt, int* mm, int tid) {
  if (tid < NBUCKET) {
    int acc = 0;
#pragma unroll
    for (int x = 0; x < NSUBL; ++x) { mm[32 + 16 * tid + x] = acc; acc += cnt[tid * NSUBL + x]; }
    mm[32 + 16 * tid + 8] = acc;
  }
  __syncthreads();
  if (tid == 0) {
    int acc = 0;
    for (int bk = 0; bk < NBUCKET; ++bk) { mm[bk] = acc; acc += (mm[32 + 16 * bk + 8] + TM - 1) / TM; }
    mm[NBUCKET] = acc;
  }
  __syncthreads();
}
__device__ __forceinline__ void moe_find_tile(const int* mm, int mt, int& bucket, int& tib, int& nrow) {
  int bk = 0;
#pragma unroll
  for (int j = 1; j < NBUCKET; ++j) bk += (mt >= mm[j]) ? 1 : 0;
  bucket = bk; tib = mt - mm[bk]; nrow = mm[32 + 16 * bk + 8] - tib * TM;
}
__device__ __forceinline__ int moe_token(const int* list, const int* mm, int bk, int q) {
  const int* sp = mm + 32 + 16 * bk;
  int x = 0, s = 0;
#pragma unroll
  for (int j = 1; j < NSUBL; ++j) { const int v = sp[j]; const bool ge = q >= v; x += ge ? 1 : 0; s = ge ? v : s; }
  return list[(size_t)(bk * NSUBL + x) * T + (q - s)];
}

__device__ __forceinline__ void fold_inproj_next(const MP& p, int ln) {
  const int tid = launder(threadIdx.x), wave = tid >> 6, lane = tid & 63;
  const float* modn = p.mod() + (size_t)ln * 8 * 6144;
  const float* gn = p.in.norm1_g + ln * D;
  const bf16_t* W = p.WinT() + (size_t)ln * INW * D;
  const int d = tid * 4;
  const float4 gg = *(const float4*)(gn + d);
  for (int u = blockIdx.x; u < 8 * INW; u += gridDim.x) {
    const int b = u / INW, n = u - b * INW;
    const float4 s1 = *(const float4*)(modn + (size_t)b * 6144 + 1024 + d);
    const u32x2 wr2 = *(const u32x2*)(W + (size_t)n * D + d);
    const float o0 = bf_lo(wr2[0]) * gg.x * (1.f + s1.x), o1 = bf_hi(wr2[0]) * gg.y * (1.f + s1.y);
    const float o2 = bf_lo(wr2[1]) * gg.z * (1.f + s1.z), o3 = bf_hi(wr2[1]) * gg.w * (1.f + s1.w);
    *(u32x2*)(p.w1b() + ((size_t)b * INW + n) * D + d) = (u32x2){pack2(o0, o1), pack2(o2, o3)};
  }
  for (int n = blockIdx.x * 4 + wave; n < INW; n += gridDim.x * 4) {
    float wv[16];
#pragma unroll
    for (int i = 0; i < 4; ++i) {
      const u32x2 r = *(const u32x2*)(W + (size_t)n * D + lane * 4 + 256 * i);
      wv[4 * i] = bf_lo(r[0]); wv[4 * i + 1] = bf_hi(r[0]); wv[4 * i + 2] = bf_lo(r[1]); wv[4 * i + 3] = bf_hi(r[1]);
    }
#pragma unroll 1
    for (int b = 0; b < 8; ++b) {
      float sacc = 0.f;
#pragma unroll
      for (int i = 0; i < 4; ++i) {
        const float4 sh = *(const float4*)(modn + (size_t)b * 6144 + lane * 4 + 256 * i);
        sacc += sh.x * wv[4 * i] + sh.y * wv[4 * i + 1] + sh.z * wv[4 * i + 2] + sh.w * wv[4 * i + 3];
      }
      sacc = wave_sum(sacc);
      if (lane == 0) p.bias1()[b * INW + n] = sacc;
    }
  }
}

__device__ __forceinline__ void phase_moe_gu(const MP& p, int l, char* smem) {
  const int tid = launder(threadIdx.x), lane = tid & 63, wave = tid >> 6, wr = wave >> 1, wc = wave & 1, fr = lane & 15, fq = lane >> 4;
  const int r0 = tid >> 3;
  int* mm = (int*)(smem + SMEM_MM);
  moe_map_build(p.cnt() + l * 256, mm, tid);
  const int nmt = mm[NBUCKET];
  const int ntiles = nmt * 16;
  auto make = [&](int tile, GemmTile& g) {
    const int mt = tile >> 4, nt = tile & 15;
    int bucket, tib, nrow;
    moe_find_tile(mm, mt, bucket, tib, nrow);
    int elo, ehi; bucket_experts2(bucket, elo, ehi);
    const int e = nt < 8 ? elo : ehi, f0 = (nt & 7) * 64;
    g.A0 = p.h(); g.A1 = p.h(); g.lda = D; g.ksA = D; g.K = D;
    const bf16_t* Wg = p.WgT() + ((size_t)(l * NE + e) * DFF + f0) * D;
    const bf16_t* Wu = p.WuT() + ((size_t)(l * NE + e) * DFF + f0) * D;
#pragma unroll
    for (int i = 0; i < 4; ++i) {
      const int r = r0 + 32 * i;
      g.arow[i] = moe_token(p.list(), mm, bucket, tib * TM + (r < nrow ? r : nrow - 1));
    }
    g.Blo0 = Wg; g.Bhi0 = Wu; g.Blo1 = Wg; g.Bhi1 = Wu;
    g.ldb = D; g.ksB = D; g.rot = ROT_OF(bucket, nt);
  };
  GemmTile g, gn; bool pre = false;
  const TileMap tmap = tm_init(nmt, 16);
  { const int t0 = tm_tile(tmap, 0); if (t0 >= 0) { make(t0, g); gn = g; } }
  for (int jt = 0; ; ++jt) {
    const int tile = tm_tile(tmap, jt); if (tile < 0) break;
    const int mt = tile >> 4, nt = tile & 15;
    int bucket, tib, nrow;
    moe_find_tile(mm, mt, bucket, tib, nrow);
    const int f0 = (nt & 7) * 64;
    const int nxt = tm_tile(tmap, jt + 1); const bool hasn = nxt >= 0;
    if (hasn) make(nxt, gn);
    float wv[4];
#pragma unroll
    for (int m = 0; m < 4; ++m) {
      const int r = wr * 64 + 16 * m + fr;
      const float2 ww = p.tokw()[moe_token(p.list(), mm, bucket, tib * TM + (r < nrow ? r : nrow - 1))];
      wv[m] = r < nrow ? (nt < 8 ? ww.x : ww.y) : 0.f;
    }
    f32x4 acc[4][4];
    gemm_mainloop<true>(g, gn, hasn, pre, smem, acc);
    pre = hasn; g = gn;
#pragma unroll
    for (int m = 0; m < 4; ++m) {
      const int r = wr * 64 + 16 * m + fr;
      const float w = wv[m];
      bf16_t* dst = p.act() + (size_t)(mt * TM + r) * D + (nt < 8 ? 0 : 512) + f0 + wc * 32 + 4 * fq;
#pragma unroll
      for (int n = 0; n < 2; ++n) {
        float o[4];
#pragma unroll
        for (int j = 0; j < 4; ++j) { const float gv = acc[m][n][j], uv = acc[m][n + 2][j]; o[j] = gv * __builtin_amdgcn_rcpf(1.f + __expf(-gv)) * uv * w; }
        *(u32x2*)(dst + 16 * n) = (u32x2){pack2(o[0], o[1]), pack2(o[2], o[3])};
      }
    }
  }
}

template <bool XBOUT>
__device__ __forceinline__ void phase_moe_down(const MP& p, int l, char* smem) {
  const int tid = launder(threadIdx.x), lane = tid & 63, wave = tid >> 6, wr = wave >> 1, wc = wave & 1, fr = lane & 15, fq = lane >> 4;
  const int r0 = tid >> 3;
  int* mm = (int*)(smem + SMEM_MM);
  moe_map_build(p.cnt() + l * 256, mm, tid);
  const float* modl = p.mod() + (size_t)l * 8 * 6144;
  const int nmt = mm[NBUCKET];
  const int ntiles = nmt * 8;
  auto make = [&](int tile, GemmTile& g) {
    const int mt = tile >> 3, n0 = (tile & 7) * 128;
    int bucket, tib, nrow;
    moe_find_tile(mm, mt, bucket, tib, nrow);
    int elo, ehi; bucket_experts2(bucket, elo, ehi);
    g.A0 = p.act(); g.A1 = p.act(); g.lda = D; g.ksA = D; g.K = D;
    const bf16_t* Wlo = p.WdT() + ((size_t)(l * NE + elo) * D + n0) * DFF;
    const bf16_t* Whi = p.WdT() + ((size_t)(l * NE + ehi) * D + n0) * DFF;
#pragma unroll
    for (int i = 0; i < 4; ++i) {
      g.arow[i] = mt * TM + r0 + 32 * i;
    }
    g.Blo0 = Wlo; g.Bhi0 = Wlo + (size_t)64 * DFF; g.Blo1 = Whi; g.Bhi1 = Whi + (size_t)64 * DFF;
    g.ldb = DFF; g.ksB = DFF; g.rot = ROT_OF(bucket, tile & 7);
  };
  GemmTile g, gn; bool pre = false;
  const TileMap tmap = tm_init(nmt, 8);
  { const int t0 = tm_tile(tmap, 0); if (t0 >= 0) { make(t0, g); gn = g; } }
  for (int jt = 0; ; ++jt) {
    const int tile = tm_tile(tmap, jt); if (tile < 0) break;
    const int mt = tile >> 3, nt = tile & 7, n0 = nt * 128;
    int bucket, tib, nrow;
    moe_find_tile(mm, mt, bucket, tib, nrow);
    const int nxt = tm_tile(tmap, jt + 1); const bool hasn = nxt >= 0;
    if (hasn) make(nxt, gn);
    int tkv[4];
#pragma unroll
    for (int m = 0; m < 4; ++m) {
      const int r = wr * 64 + 16 * m + fr;
      tkv[m] = moe_token(p.list(), mm, bucket, tib * TM + (r < nrow ? r : nrow - 1));
    }
    f32x4 acc[4][4];
    gemm_mainloop<false>(g, gn, hasn, pre, smem, acc);
    pre = hasn; g = gn;
    u32x2 xrv[4][4]; f32x4 g2v[4][4];
#pragma unroll
    for (int m = 0; m < 4; ++m)
#pragma unroll
      for (int n = 0; n < 4; ++n) {
        const int col = n0 + wc * 64 + 16 * n + 4 * fq;
        xrv[m][n] = *(const u32x2*)(p.x1() + (size_t)tkv[m] * D + col);
        g2v[m][n] = *(const f32x4*)(modl + (size_t)(tkv[m] / S) * 6144 + 5 * 1024 + col);
      }
#pragma unroll
    for (int m = 0; m < 4; ++m) {
      const int r = wr * 64 + 16 * m + fr;
      const int tk = tkv[m];
      f32x4 o[4];
#pragma unroll
      for (int n = 0; n < 4; ++n) {
        const u32x2 xr = xrv[m][n];
        const f32x4 xv = {bf_lo(xr[0]), bf_hi(xr[0]), bf_lo(xr[1]), bf_hi(xr[1])};
        const f32x4 g2 = g2v[m][n];
#pragma unroll
        for (int j = 0; j < 4; ++j) o[n][j] = xv[j] + g2[j] * acc[m][n][j];
      }
      if (XBOUT) {
        float ssr = 0.f;
#pragma unroll
        for (int n = 0; n < 4; ++n) ssr += (o[n][0] * o[n][0] + o[n][1] * o[n][1]) + (o[n][2] * o[n][2] + o[n][3] * o[n][3]);
        ssr += __shfl_xor(ssr, 16); ssr += __shfl_xor(ssr, 32);
        if (fq == 0 && r < nrow) p.ssqx()[(size_t)tk * 16 + nt * 2 + wc] = ssr;
      }
      if (r < nrow) {
#pragma unroll
        for (int n = 0; n < 4; ++n) {
          const size_t oo = (size_t)tk * D + n0 + wc * 64 + 16 * n + 4 * fq;
          if (XBOUT) *(u32x2*)(p.xb() + oo) = (u32x2){pack2(o[n][0], o[n][1]), pack2(o[n][2], o[n][3])};
          else *(f32x4*)(p.out + oo) = o[n];
        }
      }
    }
  }
}
#define XB_TMO      128
#define XB_XCNT(j)  (256  + 64 * (j))
#define XB_XSUB(j)  (1280 + 64 * (j))
#define XB_XGEN(j)  (2304 + 64 * (j))
#define XB_TOP      3328
#define XB_TOPGEN   3392
#define XCD_BAR_WORDS 3456
#define XB_SPIN_CAP (1u << 22)
#define LAS __attribute__((address_space(3)))

__device__ __forceinline__ unsigned xb_ld(unsigned* p)              { return __hip_atomic_load(p, __ATOMIC_RELAXED, __HIP_MEMORY_SCOPE_AGENT); }
__device__ __forceinline__ unsigned xb_add(unsigned* p, unsigned v) { return __hip_atomic_fetch_add(p, v, __ATOMIC_RELAXED, __HIP_MEMORY_SCOPE_AGENT); }
__device__ __forceinline__ unsigned xb_xcc_id() { return (unsigned)__builtin_amdgcn_s_getreg((3 << 11) | 20) & 0xFu; }
#define XB_SPIN(cond, bar) do { unsigned _sp = 0; while (cond) { __builtin_amdgcn_s_sleep(1); \
    if ((++_sp & 255u) == 0u) { if (xb_ld(&(bar)[XB_TMO])) break; if (_sp > XB_SPIN_CAP) { atomicAdd(&(bar)[XB_TMO], 1u); break; } } } } while (0)

struct XcdBarrier { unsigned* bar; unsigned x; volatile LAS unsigned* st; };

__device__ __forceinline__ XcdBarrier xcd_barrier_post(unsigned* bar, volatile LAS unsigned* st) {
  XcdBarrier b; b.bar = bar; b.x = xb_xcc_id(); b.st = st;
  if (threadIdx.x == 0) (void)xb_add(&bar[XB_XCNT(b.x)], 1u);
  return b;
}
__device__ __forceinline__ void xcd_barrier_complete(unsigned* bar, unsigned x, unsigned& nloc, unsigned& nx) {
  const unsigned G = gridDim.x * gridDim.y * gridDim.z;
  unsigned sum, cnt, mine, sp = 0u;
  for (;;) {
    sum = 0u; cnt = 0u; mine = 0u;
#pragma unroll
    for (unsigned j = 0; j < 16; ++j) { const unsigned c = xb_ld(&bar[XB_XCNT(j)]); sum += c; cnt += (c > 0u) ? 1u : 0u; mine = (j == x) ? c : mine; }
    if (sum == G) break;
    __builtin_amdgcn_s_sleep(1);
    if ((++sp & 255u) == 0u) { if (xb_ld(&bar[XB_TMO])) break; if (sp > XB_SPIN_CAP) { atomicAdd(&bar[XB_TMO], 1u); break; } }
  }
  nloc = mine > 0u ? mine : 1u; nx = cnt > 0u ? cnt : 1u;
}
__device__ __forceinline__ void xcd_barrier(const XcdBarrier& b) {
  asm volatile("s_waitcnt vmcnt(0)" ::: "memory");
  __syncthreads();
  if (threadIdx.x == 0) {
    unsigned* bar = b.bar;
    __builtin_amdgcn_s_waitcnt(0);
    unsigned nloc = b.st[0], nx = b.st[1];
    if (nloc == 0u) { xcd_barrier_complete(bar, b.x, nloc, nx); b.st[0] = nloc; b.st[1] = nx; }
    const unsigned old = xb_add(&bar[XB_XSUB(b.x)], 1u);
    const unsigned gen = old / nloc;
    if (old + 1u == (gen + 1u) * nloc) {
      __builtin_amdgcn_fence(__ATOMIC_RELEASE, "agent");
      asm volatile("s_waitcnt vmcnt(0)" ::: "memory");
      const unsigned og = xb_add(&bar[XB_TOP], 1u);
      const unsigned tg = og / nx;
      if (og + 1u == (tg + 1u) * nx) xb_add(&bar[XB_TOPGEN], 1u);
      else XB_SPIN(xb_ld(&bar[XB_TOPGEN]) == tg, bar);
      __builtin_amdgcn_fence(__ATOMIC_ACQUIRE, "agent");
      xb_add(&bar[XB_XGEN(b.x)], 1u);
      asm volatile("s_waitcnt vmcnt(0)" ::: "memory");
    } else {
      XB_SPIN(xb_ld(&bar[XB_XGEN(b.x)]) == gen, bar);
      __builtin_amdgcn_fence(__ATOMIC_ACQUIRE, "agent");
      asm volatile("s_waitcnt vmcnt(0)" ::: "memory");
    }
  }
  __syncthreads();
}

constexpr int NSUB = 9;

template <int L>
__device__ __forceinline__ void run_layer(const MP& p, char* smem, const XcdBarrier& xb, int ssm_wid, int idle_id, int ssm_lrank) {
  constexpr int l = L;
  const float* xin = L == 0 ? p.in.x : p.out;
  if (L == 0) { phase_norm1<false>(p, l, xin); xcd_barrier(xb); }
  phase_inproj<(L > 0)>(p, l, smem);        xcd_barrier(xb);
  phase_ssm(p, l, smem, ssm_wid, ssm_lrank);
  {
    constexpr int TT_SMALL = TT_WIN + TT_GLU + TT_OUT, E0 = L * TT_LAYER + TT_SMALL, NCH = 3 * TT_EXP / 4 / 8;
    const int x = blockIdx.x & 7;
    unsigned* ctr = p.claim() + 4128 + L * 8 + x;
    volatile int* bw = (volatile int*)(smem + SMEM_MM);
#pragma unroll 1
    for (;;) {
      __syncthreads();
      if (threadIdx.x == 0) bw[0] = (int)xb_add(ctr, 1u);
      __syncthreads();
      const int c = launder_s(__builtin_amdgcn_readfirstlane(bw[0]));
      if (c >= NCH) break;
      const int t0 = E0 + (x * NCH + c) * 4;
      phase0_transposes(p, smem, t0, t0 + 4, 0, 1);
    }
  }
  xcd_barrier(xb);
#pragma unroll 1
  for (int step = 0; step < 2; ++step) {
    if ((step == 0) == (ssm_wid >= 0)) phase_glu(p, l, smem);
    else phase_attn(p, l, smem);
  }
  xcd_barrier(xb);
  phase_out<(L > 0)>(p, l, smem, xin);      xcd_barrier(xb);
  phase_norm2_route(p, l, smem);
  if (L + 1 < DEPTH) fold_inproj_next(p, l + 1);
  xcd_barrier(xb);
  phase_moe_gu(p, l, smem);        xcd_barrier(xb);
  phase_moe_down<(L + 1 < DEPTH)>(p, l, smem);
  if (L + 1 < DEPTH) xcd_barrier(xb);
}

__global__ void __launch_bounds__(NTHR, 2) mega(MP p) {
  __shared__ __attribute__((aligned(16))) char smem[65536 + 32 + 2048];
  unsigned* xb_words = (unsigned*)(smem + 65536);
  if (threadIdx.x < 8) xb_words[threadIdx.x] = 0u;
  __syncthreads();
  const XcdBarrier xb = xcd_barrier_post(p.bar(), (volatile LAS unsigned*)xb_words);
  if (threadIdx.x == 0) {
    const unsigned key = (xb_xcc_id() << 8) | ((unsigned)__builtin_amdgcn_s_getreg((7 << 11) | (8 << 6) | 4) & 0xffu);
    const unsigned rank = xb_add(p.claim() + key, 1u);
    xb_words[2] = rank == 0u ? xb_add(p.claim() + 4096, 1u) : 0xffffffffu;
    xb_words[3] = rank == 0u ? 0xffffffffu : xb_add(p.claim() + 4097, 1u);
    xb_words[4] = rank == 0u ? xb_add(p.claim() + 4104 + (blockIdx.x & 7), 1u) : 0xffffffffu;
  }
  __syncthreads();
  const int ssm_wid = (int)xb_words[2], idle_id = (int)xb_words[3], ssm_lrank = (int)xb_words[4];
  for (int it = blockIdx.x; it < P0_MISC; it += gridDim.x) phase0_item(p, it, smem);
  {
    const int G = (int)gridDim.x, r1 = G - 1 - (int)blockIdx.x;
    int r2 = (G - 1 - (TT_WIN + TT_GLU + TT_OUT) % G) - (int)blockIdx.x; r2 += r2 < 0 ? G : 0;
    phase0_transposes(p, smem, 0, TT_WIN + TT_GLU + TT_OUT, r1, G);
    phase0_transposes(p, smem, TT_LAYER, TT_LAYER + TT_WIN + TT_GLU + TT_OUT, r2, G);
  }
  xcd_barrier(xb);
  run_layer<0>(p, smem, xb, ssm_wid, idle_id, ssm_lrank);
  run_layer<1>(p, smem, xb, ssm_wid, idle_id, ssm_lrank);
  static_assert(DEPTH == 2, "two layers instantiated");
}

}

extern "C" void kernel_launch(void* const* d_in, const int* in_sizes, int n_in, void* d_out, int out_size, void* d_ws,
                              size_t ws_size, hipStream_t stream) {
  MP p; memset(&p, 0, sizeof(p));
  Ptrs& P = p.in;
  P.x = (const float*)d_in[0]; P.c = (const float*)d_in[1]; P.pos = (const int*)d_in[2];
  P.ada_w = (const float*)d_in[3]; P.ada_b = (const float*)d_in[4]; P.norm1_g = (const float*)d_in[5];
  P.w_in = (const float*)d_in[6]; P.q_norm_g = (const float*)d_in[7]; P.k_norm_g = (const float*)d_in[8];
  P.attn_sink = (const float*)d_in[9]; P.lam_re = (const float*)d_in[10]; P.lam_im = (const float*)d_in[11];
  P.b_re = (const float*)d_in[12]; P.b_im = (const float*)d_in[13]; P.c_re = (const float*)d_in[14]; P.c_im = (const float*)d_in[15];
  P.ssm_d = (const float*)d_in[16]; P.log_dt = (const float*)d_in[17]; P.w_glu = (const float*)d_in[18];
  P.attn_out_g = (const float*)d_in[19]; P.ssm_out_g = (const float*)d_in[20]; P.w_out = (const float*)d_in[21];
  P.norm2_g = (const float*)d_in[22]; P.w_router = (const float*)d_in[23]; P.router_bias = (const float*)d_in[24];
  P.w_gate = (const float*)d_in[25]; P.w_up = (const float*)d_in[26]; P.w_down = (const float*)d_in[27];
  p.out = (float*)d_out;

  p.ws = (char*)d_ws;
  if (WS_TOTAL > ws_size) { fprintf(stderr, "workspace too small: need %zu have %zu\n", (size_t)WS_TOTAL, ws_size); return; }
  (void)in_sizes; (void)n_in; (void)out_size;

  static int grid_blocks = 0;
  if (!grid_blocks) {
    int dev = 0, cus = 0, per_cu = 0;
    (void)hipGetDevice(&dev);
    (void)hipDeviceGetAttribute(&cus, hipDeviceAttributeMultiprocessorCount, dev);
    (void)hipOccupancyMaxActiveBlocksPerMultiprocessor(&per_cu, mega, NTHR, 0);
    if (per_cu > 2) per_cu = 2;
    if (per_cu < 1) per_cu = 1;
    grid_blocks = cus * per_cu;
  }
  (void)hipMemsetAsync(p.ws + OFF_BAR, 0, OFF_MOD - OFF_BAR, stream);
  void* args[] = {&p};
  hipError_t e = hipLaunchCooperativeKernel((void*)mega, dim3(grid_blocks), dim3(NTHR), args, 0, stream);
  if (e != hipSuccess) fprintf(stderr, "cooperative launch failed: %s (grid %d)\n", hipGetErrorString(e), grid_blocks);
}
```

```cpp
#include <hip/hip_runtime.h>
#include <hip/hip_cooperative_groups.h>
#include <stdint.h>
#include <cstdio>
#include <cstring>

namespace {
constexpr int D = 1024, NB = 8, S = 2048, T = NB * S, DEPTH = 2;
constexpr int AW = 512, HD = 64, NQ = 8, NKV = 2, INW = 1280;
constexpr int SG = 32, SCH = 16, SP = 64, SW = 512;
constexpr int NE = 16, DFF = 512;
constexpr int NBUCKET = 24;
constexpr float EPS = 1e-6f;

struct Ptrs {
  const float *x, *c; const int* pos; const float *ada_w, *ada_b, *norm1_g, *w_in, *q_norm_g, *k_norm_g, *attn_sink,
      *lam_re, *lam_im, *b_re, *b_im, *c_re, *c_im, *ssm_d, *log_dt, *w_glu, *attn_out_g, *ssm_out_g, *w_out, *norm2_g,
      *w_router, *router_bias, *w_gate, *w_up, *w_down;
};

__device__ __forceinline__ float row_sum32_dpp(float v) {
  v += __int_as_float(__builtin_amdgcn_update_dpp(0, __float_as_int(v), 0xB1, 0xF, 0xF, true));
  v += __int_as_float(__builtin_amdgcn_update_dpp(0, __float_as_int(v), 0x4E, 0xF, 0xF, true));
  v += __int_as_float(__builtin_amdgcn_update_dpp(0, __float_as_int(v), 0x141, 0xF, 0xF, true));
  v += __int_as_float(__builtin_amdgcn_update_dpp(0, __float_as_int(v), 0x140, 0xF, 0xF, true));
  v += __int_as_float(__builtin_amdgcn_update_dpp(0, __float_as_int(v), 0x142, 0xA, 0xF, false));
  return v;
}
__device__ __forceinline__ float wave_sum(float v) {
  v = row_sum32_dpp(v);
  return __int_as_float(__builtin_amdgcn_readlane(__float_as_int(v), 31)) + __int_as_float(__builtin_amdgcn_readlane(__float_as_int(v), 63));
}
__device__ __forceinline__ float xhalf_sum(float v) {
  const auto r = __builtin_amdgcn_permlane32_swap(__float_as_uint(v), __float_as_uint(v), false, false);
  return __uint_as_float(r[0]) + __uint_as_float(r[1]);
}
__device__ __forceinline__ float xhalf_max(float v) {
  const auto r = __builtin_amdgcn_permlane32_swap(__float_as_uint(v), __float_as_uint(v), false, false);
  return fmaxf(__uint_as_float(r[0]), __uint_as_float(r[1]));
}

#ifndef ROT_OF
#define ROT_OF(mt, nt) ((mt) & 15)
#endif

typedef unsigned short bf16_t;
typedef short bf16x8 __attribute__((ext_vector_type(8)));
typedef float f32x4 __attribute__((ext_vector_type(4)));
typedef float f32x16 __attribute__((ext_vector_type(16)));
typedef float f32x2 __attribute__((ext_vector_type(2)));
typedef __bf16 bf16x2_t __attribute__((ext_vector_type(2)));
typedef unsigned u32x4 __attribute__((ext_vector_type(4)));
typedef unsigned u32x2 __attribute__((ext_vector_type(2)));

constexpr int NTHR = 256;
constexpr int TM = 128;
constexpr int MAXMT = T / TM + NBUCKET;
constexpr int NSUBL = 8;
constexpr int SMEM_MM = 65536 + 32;

__device__ __forceinline__ unsigned pack2(float lo, float hi) {
  f32x2 v = {lo, hi};
  return __builtin_bit_cast(unsigned, __builtin_convertvector(v, bf16x2_t));
}
__device__ __forceinline__ int launder(int x) { asm volatile("" : "+v"(x)); return x; }
__device__ __forceinline__ int launder_s(int x) { asm volatile("" : "+s"(x)); return x; }
__device__ __forceinline__ u32x4 pair16(u32x2 a, u32x2 b) {
  const auto s0 = __builtin_amdgcn_permlane16_swap(a[0], b[0], false, false);
  const auto s1 = __builtin_amdgcn_permlane16_swap(a[1], b[1], false, false);
  return (u32x4){s0[0], s1[0], s0[1], s1[1]};
}
__device__ __forceinline__ u32x4 pair32(u32x2 a, u32x2 b) {
  const auto s0 = __builtin_amdgcn_permlane32_swap(a[0], b[0], false, false);
  const auto s1 = __builtin_amdgcn_permlane32_swap(a[1], b[1], false, false);
  return (u32x4){s0[0], s1[0], s0[1], s1[1]};
}
__device__ __forceinline__ float bf_lo(unsigned u) { return __uint_as_float(u << 16); }
__device__ __forceinline__ float bf_hi(unsigned u) { return __uint_as_float(u & 0xffff0000u); }
__device__ __forceinline__ float bf1(bf16_t u) { return __uint_as_float(((unsigned)u) << 16); }

constexpr size_t al256(size_t x) { return (x + 255) & ~(size_t)255; }
constexpr size_t OFF_BAR = 0;
constexpr size_t OFF_CLAIM = OFF_BAR + al256(4096 * 4);
constexpr size_t OFF_MOD = OFF_CLAIM + al256(4096 * 4 + 256);
constexpr int CL_XCC = 0, CL_MTC = 512, CL_STR = 32, CL_ODONE = CL_MTC + DEPTH * 1024, CL_GU = CL_ODONE + DEPTH * 8 * CL_STR, CL_OA = CL_GU + DEPTH * (T / 128 + 24) * 16, CL_N1 = CL_OA + DEPTH * (T / 128) * 16, CL_SSM = CL_N1 + (T / 128) * 4, CL_IP = CL_SSM + DEPTH * 8 * 32, CL_WORDS = CL_IP + DEPTH * 8 * 64;
constexpr size_t OFF_CS = OFF_MOD + al256((size_t)DEPTH * 8 * 6144 * 4);
constexpr size_t OFF_CNT = OFF_CS + al256((size_t)T * 32 * 8);
constexpr size_t OFF_LIST = OFF_CNT + al256(256 * 4 * DEPTH);
constexpr size_t OFF_TOKW = OFF_LIST + al256((size_t)NBUCKET * NSUBL * T * 4);
constexpr size_t OFF_SSMB = OFF_TOKW + al256((size_t)T * 8);
constexpr size_t OFF_SSMC = OFF_SSMB + al256((size_t)DEPTH * SG * 128 * 16 * 2);
constexpr size_t OFF_SSML = OFF_SSMC + al256((size_t)DEPTH * SG * 16 * 128 * 2);
constexpr size_t OFF_WINT = OFF_SSML + al256((size_t)DEPTH * SG * SP * 2 * 4);
constexpr size_t OFF_WGLUT = OFF_WINT + al256((size_t)DEPTH * INW * D * 2);
constexpr size_t OFF_WOUTT = OFF_WGLUT + al256((size_t)DEPTH * SW * SW * 2);
constexpr size_t OFF_H = OFF_WOUTT + al256((size_t)DEPTH * D * D * 2);
constexpr size_t OFF_Q = OFF_H + al256((size_t)T * D * 2);
constexpr size_t OFF_K = OFF_Q + al256((size_t)T * AW * 2);
constexpr size_t OFF_VT = OFF_K + al256((size_t)T * 128 * 2);
constexpr size_t OFF_U = OFF_VT + al256((size_t)T * 128 * 2);
constexpr size_t OFF_ATTN = OFF_U + al256((size_t)T * SW * 2);
constexpr size_t OFF_ACT = OFF_Q;
static_assert((size_t)MAXMT * TM * D * 2 <= OFF_ATTN - OFF_Q, "act overlay too small");
constexpr size_t OFF_SSQA = OFF_ATTN + al256((size_t)T * AW * 2);
constexpr size_t OFF_Y = OFF_SSQA + al256((size_t)T * 8 * 4);
constexpr size_t OFF_SSM = OFF_Y + al256((size_t)T * SW * 2);
constexpr size_t OFF_SSQS = OFF_SSM + al256((size_t)T * SW * 2);
constexpr size_t OFF_X1 = OFF_SSQS + al256((size_t)T * 8 * 4);
constexpr size_t OFF_WGT = OFF_X1 + al256((size_t)T * D * 4);
static_assert((size_t)8 * INW * D * 2 + (size_t)T * 16 * 4 + (size_t)8 * INW * 4 <= (size_t)T * D * 2, "folded in-proj operands must fit the upper half of the x1 region");
constexpr size_t OFF_WUT = OFF_WGT + al256((size_t)DEPTH * NE * DFF * D * 2);
constexpr size_t OFF_WDT = OFF_WUT + al256((size_t)DEPTH * NE * DFF * D * 2);
constexpr size_t OFF_WRF = OFF_WDT + al256((size_t)DEPTH * NE * DFF * D * 2);
static_assert((size_t)8 * INW * D * 2 <= OFF_SSM - OFF_ATTN, "folded in-proj weights overlay too small");
constexpr size_t OFF_FLAGS = OFF_WRF + al256((size_t)32 * 2 * 64 * 16);
constexpr size_t WS_TOTAL = OFF_FLAGS + al256((size_t)CL_WORDS * 4);

struct MP {
  Ptrs in;
  float* out;
  char* ws;
  __device__ __forceinline__ unsigned* bar() const { return (unsigned*)(ws + OFF_BAR); }
  __device__ __forceinline__ unsigned* claim() const { return (unsigned*)(ws + OFF_CLAIM); }
  __device__ __forceinline__ unsigned* flags() const { return (unsigned*)(ws + OFF_FLAGS); }
  __device__ __forceinline__ float* mod() const { return (float*)(ws + OFF_MOD); }
  __device__ __forceinline__ float2* cs() const { return (float2*)(ws + OFF_CS); }
  __device__ __forceinline__ int* cnt() const { return (int*)(ws + OFF_CNT); }
  __device__ __forceinline__ int* list() const { return (int*)(ws + OFF_LIST); }
  __device__ __forceinline__ float2* tokw() const { return (float2*)(ws + OFF_TOKW); }
  __device__ __forceinline__ bf16_t* ssmB() const { return (bf16_t*)(ws + OFF_SSMB); }
  __device__ __forceinline__ bf16_t* ssmC() const { return (bf16_t*)(ws + OFF_SSMC); }
  __device__ __forceinline__ float* ssmL() const { return (float*)(ws + OFF_SSML); }
  __device__ __forceinline__ bf16_t* WinT() const { return (bf16_t*)(ws + OFF_WINT); }
  __device__ __forceinline__ bf16_t* WgluT() const { return (bf16_t*)(ws + OFF_WGLUT); }
  __device__ __forceinline__ bf16_t* WoutT() const { return (bf16_t*)(ws + OFF_WOUTT); }
  __device__ __forceinline__ bf16_t* WgT() const { return (bf16_t*)(ws + OFF_WGT); }
  __device__ __forceinline__ bf16_t* WuT() const { return (bf16_t*)(ws + OFF_WUT); }
  __device__ __forceinline__ bf16_t* WdT() const { return (bf16_t*)(ws + OFF_WDT); }
  __device__ __forceinline__ bf16_t* h() const { return (bf16_t*)(ws + OFF_H); }
  __device__ __forceinline__ bf16_t* q() const { return (bf16_t*)(ws + OFF_Q); }
  __device__ __forceinline__ bf16_t* k() const { return (bf16_t*)(ws + OFF_K); }
  __device__ __forceinline__ bf16_t* vT() const { return (bf16_t*)(ws + OFF_VT); }
  __device__ __forceinline__ bf16_t* u() const { return (bf16_t*)(ws + OFF_U); }
  __device__ __forceinline__ bf16_t* attn() const { return (bf16_t*)(ws + OFF_U); }
  __device__ __forceinline__ bf16_t* y() const { return (bf16_t*)(ws + OFF_Y); }
  __device__ __forceinline__ bf16_t* ssm() const { return (bf16_t*)(ws + OFF_SSM); }
  __device__ __forceinline__ bf16_t* act() const { return (bf16_t*)(ws + OFF_ACT); }
  __device__ __forceinline__ float* ssqa() const { return (float*)(ws + OFF_SSQA); }
  __device__ __forceinline__ float* ssqs() const { return (float*)(ws + OFF_SSQS); }
  __device__ __forceinline__ u32x4* wrf() const { return (u32x4*)(ws + OFF_WRF); }
  __device__ __forceinline__ bf16_t* w1b() const { return (bf16_t*)(ws + OFF_X1 + (size_t)T * D * 2); }
  __device__ __forceinline__ float* ssqx() const { return (float*)(ws + OFF_X1 + (size_t)T * D * 2 + (size_t)8 * INW * D * 2); }
  __device__ __forceinline__ float* bias1() const { return (float*)(ws + OFF_X1 + (size_t)T * D * 2 + (size_t)8 * INW * D * 2 + (size_t)T * 16 * 4); }
  __device__ __forceinline__ bf16_t* x1() const { return (bf16_t*)(ws + OFF_X1); }
  __device__ __forceinline__ bf16_t* xb() const { return (bf16_t*)(ws + OFF_H); }
};

constexpr int TT_WIN = 8 * 20, TT_GLU = 4 * 8, TT_OUT = 8 * 16, TT_EXP = 16 * 64;
constexpr int TT_LAYER = TT_WIN + TT_GLU + TT_OUT + 3 * TT_EXP;
constexpr int P0_MOD = DEPTH * 192;
constexpr int P0_TR = DEPTH * TT_LAYER;
constexpr int P0_CS = 0;
constexpr int P0_SSM = DEPTH * SG;
constexpr int P0_WRF = 32 * 64 / 256;
constexpr int P0_MISC = P0_MOD + P0_CS + P0_SSM + P0_WRF + 1;

__device__ __forceinline__ void phase0_item(const MP& p, int it, char* smem) {
  const int tid = launder(threadIdx.x);
  float* ldsf = (float*)smem;
  if (it < P0_MOD) {
    const int l = it / 192, j0 = (it % 192) * 32;
    float* sc = ldsf;
    float* red = ldsf + 8192;
    {
      f32x4 cv[8];
#pragma unroll
      for (int i = 0; i < 8; ++i) cv[i] = *(const f32x4*)(p.in.c + (size_t)(i * NTHR + tid) * 4);
#pragma unroll
      for (int i = 0; i < 8; ++i) {
        f32x4 o;
#pragma unroll
        for (int j = 0; j < 4; ++j) { const float v = cv[i][j]; o[j] = v / (1.f + __expf(-v)); }
        *(f32x4*)(sc + (i * NTHR + tid) * 4) = o;
      }
    }
    __syncthreads();
    const int kg = tid >> 3, cq = (tid & 7) * 4;
    float acc[8][4];
#pragma unroll
    for (int b = 0; b < 8; ++b)
#pragma unroll
      for (int j = 0; j < 4; ++j) acc[b][j] = 0.f;
    const float* w = p.in.ada_w + (size_t)l * 1024 * 6144 + j0 + cq;
#pragma unroll 1
    for (int h = 0; h < 2; ++h) {
      f32x4 wq[16];
#pragma unroll
      for (int q = 0; q < 16; ++q) wq[q] = __builtin_nontemporal_load((const f32x4*)(w + (size_t)(kg * 32 + h * 16 + q) * 6144));
#pragma unroll
      for (int k4 = 0; k4 < 4; ++k4) {
        const int k = kg * 32 + h * 16 + k4 * 4;
#pragma unroll
        for (int b = 0; b < 8; ++b) {
          const f32x4 s = *(const f32x4*)(sc + b * 1024 + k);
#pragma unroll
          for (int i = 0; i < 4; ++i) { const f32x4 t = wq[k4 * 4 + i]; acc[b][0] += s[i] * t[0]; acc[b][1] += s[i] * t[1]; acc[b][2] += s[i] * t[2]; acc[b][3] += s[i] * t[3]; }
        }
      }
    }
#pragma unroll
    for (int b = 0; b < 8; ++b) *(float4*)(red + (kg * 8 + b) * 32 + cq) = make_float4(acc[b][0], acc[b][1], acc[b][2], acc[b][3]);
    __syncthreads();
    {
      const int b = tid >> 5, c = tid & 31;
      float v = 0.f;
#pragma unroll 8
      for (int g = 0; g < 32; ++g) v += red[(g * 8 + b) * 32 + c];
      p.mod()[(size_t)(l * 8 + b) * 6144 + j0 + c] = v + p.in.ada_b[l * 6144 + j0 + c];
    }
    __syncthreads();
    return;
  }
  it -= P0_MOD;
  if (it < P0_CS) {
    const int i = it * 256 + tid, t = i >> 5, f = i & 31;
    const float freq = __builtin_amdgcn_exp2f(-(float)f * (13.287712379549449f / 32.f));
    const float ang = (float)p.in.pos[t] * freq;
    const float rev = ang * 0.15915494309189535f;
    const float r = rev - floorf(rev);
    p.cs()[i] = make_float2(__builtin_amdgcn_cosf(r), __builtin_amdgcn_sinf(r));
    return;
  }
  it -= P0_CS;
  if (it < P0_SSM) {
    const int lg = it;
    float crv[4], civ[4];
#pragma unroll
    for (int q = 0; q < 4; ++q) { const int o = tid + q * NTHR; crv[q] = p.in.c_re[(size_t)lg * SCH * SP + o]; civ[q] = p.in.c_im[(size_t)lg * SCH * SP + o]; }
    if (tid < 64) {
      const int pp = tid;
      const float dt = expf(p.in.log_dt[lg]);
      const float lr = p.in.lam_re[lg * SP + pp], li = p.in.lam_im[lg * SP + pp];
      const float mag = expf(lr * dt);
      float sn, cn; sincosf(li * dt, &sn, &cn);
      const float ar = mag * cn, ai = mag * sn;
      const float den = lr * lr + li * li;
      const float fr = ((ar - 1.f) * lr + ai * li) / den, fi = (ai * lr - (ar - 1.f) * li) / den;
      unsigned wr[8], wi[8];
      float brv[16], biv[16];
#pragma unroll
      for (int q = 0; q < 16; ++q) { brv[q] = p.in.b_re[((size_t)lg * SP + pp) * SCH + q]; biv[q] = p.in.b_im[((size_t)lg * SP + pp) * SCH + q]; }
#pragma unroll
      for (int hh = 0; hh < 8; ++hh) {
        const float br0 = brv[2 * hh], bi0 = biv[2 * hh], br1 = brv[2 * hh + 1], bi1 = biv[2 * hh + 1];
        wr[hh] = pack2(fr * br0 - fi * bi0, fr * br1 - fi * bi1);
        wi[hh] = pack2(fr * bi0 + fi * br0, fr * bi1 + fi * br1);
      }
      p.ssmL()[(lg * SP + pp) * 2] = ar; p.ssmL()[(lg * SP + pp) * 2 + 1] = ai;
      u32x4* dr = (u32x4*)(p.ssmB() + ((size_t)lg * 128 + pp) * 16);
      u32x4* di = (u32x4*)(p.ssmB() + ((size_t)lg * 128 + 64 + pp) * 16);
      dr[0] = (u32x4){wr[0], wr[1], wr[2], wr[3]}; dr[1] = (u32x4){wr[4], wr[5], wr[6], wr[7]};
      di[0] = (u32x4){wi[0], wi[1], wi[2], wi[3]}; di[1] = (u32x4){wi[4], wi[5], wi[6], wi[7]};
    }
    {
#pragma unroll
      for (int q = 0; q < 4; ++q) {
        const int o = tid + q * NTHR, hh = o >> 6, pp = o & 63;
        *(unsigned*)(p.ssmC() + ((size_t)lg * 16 + hh) * 128 + 2 * pp) = pack2(crv[q], -civ[q]);
      }
    }
    return;
  }
  it -= P0_SSM;
  if (it < P0_WRF) {
    const int i = it * 256 + tid, ks = i >> 6, ln = i & 63;
    const float* w = p.in.w_router + ((size_t)32 * ks + 8 * (ln >> 4)) * NE + (ln & 15);
    unsigned hi[4], lo[4];
    float wl[8];
#pragma unroll
    for (int j = 0; j < 8; ++j) wl[j] = w[j * NE];
#pragma unroll
    for (int j = 0; j < 4; ++j) {
      const float w0 = wl[2 * j], w1 = wl[2 * j + 1];
      hi[j] = pack2(w0, w1);
      lo[j] = pack2(w0 - bf_lo(hi[j]), w1 - bf_hi(hi[j]));
    }
    u32x4* dst = p.wrf() + ((size_t)ks * 2) * 64 + ln;
    dst[0] = (u32x4){hi[0], hi[1], hi[2], hi[3]}; dst[64] = (u32x4){lo[0], lo[1], lo[2], lo[3]};
    return;
  }
  for (int i = tid; i < 256 * DEPTH; i += NTHR) p.cnt()[i] = 0;
}

struct TrDesc { const float* src; bf16_t* dst; const float* gain; int N, K, k0, n0; };
__device__ __forceinline__ void tr_decode(const MP& p, int it, TrDesc& d) {
  const int l = it / TT_LAYER; int r = it % TT_LAYER;
  d.gain = nullptr;
  if (r < TT_WIN) { d.src = p.in.w_in + (size_t)l * D * INW; d.N = INW; d.dst = p.WinT() + (size_t)l * INW * D; d.K = D; d.k0 = (r / 20) * 128; d.n0 = (r % 20) * 64; return; }
  r -= TT_WIN;
  if (r < TT_GLU) { d.src = p.in.w_glu + (size_t)l * SW * SW; d.N = SW; d.dst = p.WgluT() + (size_t)l * SW * SW; d.K = SW; d.k0 = (r / 8) * 128; d.n0 = (r % 8) * 64; return; }
  r -= TT_GLU;
  if (r < TT_OUT) {
    d.k0 = (r / 16) * 128; d.n0 = (r % 16) * 64;
    d.gain = d.k0 < 512 ? (p.in.attn_out_g + l * AW) : (p.in.ssm_out_g + l * SW - 512);
    d.src = p.in.w_out + (size_t)l * D * D; d.N = D; d.dst = p.WoutT() + (size_t)l * D * D; d.K = D; return; }
  r -= TT_OUT;
  const int kind = r / TT_EXP; r %= TT_EXP;
  const int e = r / 64, tt = r % 64;
  if (kind == 0) { d.src = p.in.w_gate + (size_t)(l * NE + e) * D * DFF; d.N = DFF; d.dst = p.WgT() + (size_t)e * DFF * D; d.K = D; d.k0 = (tt / 8) * 128; d.n0 = (tt % 8) * 64; return; }
  if (kind == 1) { d.src = p.in.w_up + (size_t)(l * NE + e) * D * DFF; d.N = DFF; d.dst = p.WuT() + (size_t)e * DFF * D; d.K = D; d.k0 = (tt / 8) * 128; d.n0 = (tt % 8) * 64; return; }
  d.src = p.in.w_down + (size_t)(l * NE + e) * DFF * D; d.N = D; d.dst = p.WdT() + (size_t)e * D * DFF; d.K = DFF; d.k0 = (tt / 16) * 128; d.n0 = (tt % 16) * 64;
}
__device__ __forceinline__ void phase0_transposes(const MP& p, char* smem, int first, int last, int brank, int nblk) {
  const int tid = launder(threadIdx.x);
  float* lds = (float*)smem;
  const int r = tid >> 4, c4 = (tid & 15) * 4;
  const int n = tid >> 2, kq = (tid & 3) * 32;
  TrDesc cur, nxt;
  float4 v[8]; float gg[8];
  auto load = [&](const TrDesc& d) {
#pragma unroll
    for (int i = 0; i < 8; ++i) {
      const f32x4 t = __builtin_nontemporal_load((const f32x4*)(d.src + (size_t)(d.k0 + r + 16 * i) * d.N + d.n0 + c4));
      v[i] = make_float4(t[0], t[1], t[2], t[3]);
    }
    if (d.gain) {
#pragma unroll
      for (int i = 0; i < 8; ++i) gg[i] = d.gain[d.k0 + r + 16 * i];
    } else {
#pragma unroll
      for (int i = 0; i < 8; ++i) gg[i] = 1.f;
    }
  };
  int it = first + brank;
  if (it < last) { tr_decode(p, it, cur); load(cur); nxt = cur; }
  for (; it < last; it += nblk) {
#pragma unroll
    for (int i = 0; i < 8; ++i) {
      float* d = lds + (r + 16 * i) * 65 + c4;
      d[0] = v[i].x * gg[i]; d[1] = v[i].y * gg[i]; d[2] = v[i].z * gg[i]; d[3] = v[i].w * gg[i];
    }
    __syncthreads();
    const int nit = it + nblk;
    if (nit < last) { tr_decode(p, nit, nxt); load(nxt); }
    unsigned w[16];
#pragma unroll
    for (int j = 0; j < 16; ++j) w[j] = pack2(lds[(kq + 2 * j) * 65 + n], lds[(kq + 2 * j + 1) * 65 + n]);
    u32x4* dd = (u32x4*)(cur.dst + (size_t)(cur.n0 + n) * cur.K + cur.k0 + kq);
#pragma unroll
    for (int j = 0; j < 4; ++j) dd[j] = (u32x4){w[4 * j], w[4 * j + 1], w[4 * j + 2], w[4 * j + 3]};
    __syncthreads();
    cur = nxt;
  }
}

template <bool XB>
__device__ __forceinline__ void norm_token(const void* __restrict__ xrow, const float* __restrict__ g, const float* __restrict__ sh,
                                           const float* __restrict__ sc, bf16_t* __restrict__ hr, int lane, float (&hv)[16]) {
  float4 v[4]; float ss = 0.f;
#pragma unroll
  for (int i = 0; i < 4; ++i) {
    if (XB) { const u32x2 r = *(const u32x2*)((const bf16_t*)xrow + lane * 4 + 256 * i); v[i] = make_float4(bf_lo(r[0]), bf_hi(r[0]), bf_lo(r[1]), bf_hi(r[1])); }
    else { const f32x4 t = __builtin_nontemporal_load((const f32x4*)((const float*)xrow + lane * 4 + 256 * i)); v[i] = make_float4(t[0], t[1], t[2], t[3]); }
    ss += v[i].x * v[i].x + v[i].y * v[i].y + v[i].z * v[i].z + v[i].w * v[i].w;
  }
  ss = wave_sum(ss);
  const float rinv = rsqrtf(ss * (1.f / D) + EPS);
#pragma unroll
  for (int i = 0; i < 4; ++i) {
    const int d = lane * 4 + 256 * i;
    const float4 gg = *(const float4*)(g + d), s1 = *(const float4*)(sc + d), s0 = *(const float4*)(sh + d);
    hv[4 * i + 0] = v[i].x * rinv * gg.x * (1.f + s1.x) + s0.x;
    hv[4 * i + 1] = v[i].y * rinv * gg.y * (1.f + s1.y) + s0.y;
    hv[4 * i + 2] = v[i].z * rinv * gg.z * (1.f + s1.z) + s0.z;
    hv[4 * i + 3] = v[i].w * rinv * gg.w * (1.f + s1.w) + s0.w;
    *(u32x2*)(hr + d) = (u32x2){pack2(hv[4 * i], hv[4 * i + 1]), pack2(hv[4 * i + 2], hv[4 * i + 3])};
  }
}

struct TokRange { int t0, step, end; };
__device__ __forceinline__ TokRange tok_range(int wave) {
  TokRange r;
  if ((gridDim.x & 7) == 0 && (int)(gridDim.x >> 3) * 32 == S) {
    const int xcd = blockIdx.x & 7, lb = blockIdx.x >> 3; r.t0 = xcd * S + lb * 32 + wave * 8; r.step = 1; r.end = r.t0 + 8;
  }
  else if ((gridDim.x & 7) == 0) { const int xcd = blockIdx.x & 7, lb = blockIdx.x >> 3, nlb = gridDim.x >> 3; r.t0 = xcd * S + lb * 4 + wave; r.step = nlb * 4; r.end = (xcd + 1) * S; }
  else { r.t0 = blockIdx.x * 4 + wave; r.step = gridDim.x * 4; r.end = T; }
  return r;
}
template <bool XB>
__device__ __forceinline__ void phase_norm1(const MP& p, int l, const float* xin) {
  const int tid = launder(threadIdx.x);
  const int wave = tid >> 6, lane = tid & 63;
  const float* modl = p.mod() + (size_t)l * 8 * 6144;
  const TokRange tr = tok_range(wave);
  if (!XB && tr.step == 1) {
    const int b = tr.t0 / S;
    const float* g = p.in.norm1_g + l * D; const float* sh = modl + (size_t)b * 6144; const float* sc = sh + 1024;
    float gs[16], sf[16];
#pragma unroll
    for (int i = 0; i < 4; ++i) {
      const int d = lane * 4 + 256 * i;
      const float4 gg = *(const float4*)(g + d), s1 = *(const float4*)(sc + d), s0 = *(const float4*)(sh + d);
      gs[4 * i] = gg.x * (1.f + s1.x); gs[4 * i + 1] = gg.y * (1.f + s1.y); gs[4 * i + 2] = gg.z * (1.f + s1.z); gs[4 * i + 3] = gg.w * (1.f + s1.w);
      sf[4 * i] = s0.x; sf[4 * i + 1] = s0.y; sf[4 * i + 2] = s0.z; sf[4 * i + 3] = s0.w;
    }
    f32x4 xv[4];
#pragma unroll
    for (int i = 0; i < 4; ++i) xv[i] = __builtin_nontemporal_load((const f32x4*)(xin + (size_t)tr.t0 * D + lane * 4 + 256 * i));
#pragma unroll 1
    for (int t = tr.t0; t < tr.end; ++t) {
      f32x4 xn[4];
#pragma unroll
      for (int i = 0; i < 4; ++i) xn[i] = xv[i];
      if (t + 1 < tr.end) {
#pragma unroll
        for (int i = 0; i < 4; ++i) xn[i] = __builtin_nontemporal_load((const f32x4*)(xin + (size_t)(t + 1) * D + lane * 4 + 256 * i));
      }
      float ss = 0.f;
#pragma unroll
      for (int i = 0; i < 4; ++i) ss += (xv[i][0] * xv[i][0] + xv[i][1] * xv[i][1]) + (xv[i][2] * xv[i][2] + xv[i][3] * xv[i][3]);
      ss = wave_sum(ss);
      const float rinv = rsqrtf(ss * (1.f / D) + EPS);
#pragma unroll
      for (int i = 0; i < 4; ++i) {
        const float h0 = xv[i][0] * rinv * gs[4 * i] + sf[4 * i], h1 = xv[i][1] * rinv * gs[4 * i + 1] + sf[4 * i + 1];
        const float h2 = xv[i][2] * rinv * gs[4 * i + 2] + sf[4 * i + 2], h3 = xv[i][3] * rinv * gs[4 * i + 3] + sf[4 * i + 3];
        *(u32x2*)(p.h() + (size_t)t * D + lane * 4 + 256 * i) = (u32x2){pack2(h0, h1), pack2(h2, h3)};
      }
#pragma unroll
      for (int i = 0; i < 4; ++i) xv[i] = xn[i];
    }
  } else {
    for (int t = tr.t0; t < tr.end; t += tr.step) {
      const int b = t / S; float hv[16];
      norm_token<XB>(XB ? (const void*)(p.xb() + (size_t)t * D) : (const void*)(xin + (size_t)t * D), p.in.norm1_g + l * D, modl + (size_t)b * 6144, modl + (size_t)b * 6144 + 1024, p.h() + (size_t)t * D, lane, hv);
    }
  }
  asm volatile("s_waitcnt vmcnt(0)" ::: "memory");
  __syncthreads();
  if (!XB && tid == 0 && (gridDim.x & 7) == 0 && (int)(gridDim.x >> 3) * 32 == S)
    asm volatile("global_store_dword %0, %1, off" :: "v"(p.flags() + CL_N1 + (blockIdx.x & 7) * 64 + (blockIdx.x >> 3)), "v"(1u) : "memory");
}

struct GemmTile {
  const bf16_t* A0; const bf16_t* A1; long lda; int ksA;
  int arow[4];
  const bf16_t* Blo0; const bf16_t* Bhi0;
  const bf16_t* Blo1; const bf16_t* Bhi1;
  long ldb; int ksB;
  int K; int rot;
};

__device__ __forceinline__ int lds_off(int row, int chunk) { return row * 128 + ((chunk ^ ((row >> 1) & 7)) << 4); }

template <bool BSPLIT, bool MID>
__device__ __forceinline__ void gemm_mainloop_t(const GemmTile& g, const GemmTile& gnext, bool hasnext, bool preloaded, char* smem, f32x4 (&acc)[4][4],
                                                int ktmid, const float (&mids)[4]) {
  const int tid = launder(threadIdx.x), lane = tid & 63, wave = tid >> 6, wr = wave >> 1, wc = wave & 1, fr = lane & 15, fq = lane >> 4;
  const int r0 = tid >> 3, c8 = tid & 7;
  const int csrc = (c8 ^ ((r0 >> 1) & 7)) * 8;
  const int wbase = __builtin_amdgcn_readfirstlane(wave) * 1024;
#pragma unroll
  for (int m = 0; m < 4; ++m)
#pragma unroll
    for (int n = 0; n < 4; ++n) acc[m][n] = (f32x4){0.f, 0.f, 0.f, 0.f};
  auto stage = [&](const GemmTile& gg, int kt, int buf) {
    const int kk = ((kt + gg.rot) & (gg.K / 64 - 1)) * 64;
    const bf16_t* Ab = kk < gg.ksA ? gg.A0 + kk : gg.A1 + (kk - gg.ksA);
    const bool bs = kk < gg.ksB; const int kb = bs ? kk : kk - gg.ksB;
    char* As = smem + buf * 32768 + wbase; char* Bs = As + 16384;
#pragma unroll
    for (int i = 0; i < 4; ++i) {
      __builtin_amdgcn_global_load_lds((const void*)(Ab + (size_t)gg.arow[i] * gg.lda + csrc), (void*)(As + i * 4096), 16, 0, 0);
      const bf16_t* Bb = bs ? (i < 2 ? gg.Blo0 : gg.Bhi0) : (i < 2 ? gg.Blo1 : gg.Bhi1);
      __builtin_amdgcn_global_load_lds((const void*)(Bb + (size_t)(r0 + 32 * (i & 1)) * gg.ldb + kb + csrc), (void*)(Bs + i * 4096), 16, 0, 0);
    }
  };
  const int nk = g.K / 64;
  if (!preloaded) {
    stage(g, 0, 0);
    asm volatile("s_waitcnt vmcnt(0)" ::: "memory");
    __syncthreads();
  }
  for (int kt = 0; kt < nk; ++kt) {
    if (kt + 1 < nk) stage(g, kt + 1, (kt + 1) & 1);
    else if (hasnext) stage(gnext, 0, 0);
    if (MID && kt == ktmid) {
#pragma unroll
      for (int m = 0; m < 4; ++m)
#pragma unroll
        for (int n = 0; n < 4; ++n) acc[m][n] *= mids[m];
    }
    const char* As = smem + (kt & 1) * 32768; const char* Bs = As + 16384;
    __builtin_amdgcn_s_setprio(1);
    {
      bf16x8 af[2][4], bfr[2][4];
#pragma unroll
      for (int ks = 0; ks < 2; ++ks) {
#pragma unroll
        for (int m = 0; m < 4; ++m) af[ks][m] = *(const bf16x8*)(As + lds_off(wr * 64 + 16 * m + fr, ks * 4 + fq));
#pragma unroll
        for (int n = 0; n < 4; ++n) {
          const int brow = BSPLIT ? ((n >> 1) * 64 + wc * 32 + (n & 1) * 16 + fr) : (wc * 64 + 16 * n + fr);
          bfr[ks][n] = *(const bf16x8*)(Bs + lds_off(brow, ks * 4 + fq));
        }
      }
#pragma unroll
      for (int ks = 0; ks < 2; ++ks)
#pragma unroll
        for (int m = 0; m < 4; ++m)
#pragma unroll
          for (int n = 0; n < 4; ++n) acc[m][n] = __builtin_amdgcn_mfma_f32_16x16x32_bf16(bfr[ks][n], af[ks][m], acc[m][n], 0, 0, 0);
      __builtin_amdgcn_sched_group_barrier(0x100, 8, 0);
#pragma unroll
      for (int i = 0; i < 8; ++i) { __builtin_amdgcn_sched_group_barrier(0x008, 2, 0); __builtin_amdgcn_sched_group_barrier(0x100, 1, 0); }
      __builtin_amdgcn_sched_group_barrier(0x008, 16, 0);
    }
    __builtin_amdgcn_sched_barrier(0);
    __builtin_amdgcn_s_setprio(0);
    asm volatile("s_waitcnt vmcnt(0)" ::: "memory");
    __syncthreads();
  }
}
template <bool BSPLIT>
__device__ __forceinline__ void gemm_mainloop(const GemmTile& g, const GemmTile& gnext, bool hasnext, bool preloaded, char* smem, f32x4 (&acc)[4][4]) {
  const float dummy[4] = {1.f, 1.f, 1.f, 1.f};
  gemm_mainloop_t<BSPLIT, false>(g, gnext, hasnext, preloaded, smem, acc, -1, dummy);
}

struct TileMap { int base, ntl, lb, nlb; };
__device__ __forceinline__ TileMap tm_init(int nMt, int nNt) {
  TileMap t;
  if ((gridDim.x & 7) == 0) {
    const int xcd = blockIdx.x & 7;
    t.lb = blockIdx.x >> 3; t.nlb = gridDim.x >> 3;
    const int mlo = (nMt * xcd) >> 3, mhi = (nMt * (xcd + 1)) >> 3;
    t.base = mlo * nNt; t.ntl = (mhi - mlo) * nNt;
  } else { t.lb = blockIdx.x; t.nlb = gridDim.x; t.base = 0; t.ntl = nMt * nNt; }
  return t;
}
__device__ __forceinline__ int tm_tile(const TileMap& t, int j) { const int li = t.lb + t.nlb * j; return li < t.ntl ? t.base + li : -1; }
template <bool FUSEN>
__device__ __forceinline__ void phase_inproj(const MP& p, int l, char* smem, bool waitf) {
  const int tid = launder(threadIdx.x), lane = tid & 63, wave = tid >> 6, wr = wave >> 1, wc = wave & 1, fr = lane & 15, fq = lane >> 4;
  const int r0 = tid >> 3;
  const int ntiles = (T / 128) * (INW / 128);
  const bf16_t* W = p.WinT() + (size_t)l * INW * D;
  auto make = [&](int tile, GemmTile& g) {
    const int m0 = (tile / 10) * 128, n0 = (tile % 10) * 128;
    g.A0 = FUSEN ? p.xb() : p.h(); g.A1 = g.A0; g.lda = D; g.ksA = D; g.K = D;
#pragma unroll
    for (int i = 0; i < 4; ++i) g.arow[i] = m0 + r0 + 32 * i;
    const bf16_t* Wt = FUSEN ? p.w1b() + (size_t)(m0 / S) * INW * D : W;
    g.Blo0 = Wt + (size_t)n0 * D; g.Bhi0 = g.Blo0 + (size_t)64 * D; g.Blo1 = g.Blo0; g.Bhi1 = g.Bhi0;
    g.ldb = D; g.ksB = D; g.rot = ROT_OF(tile / 10, tile % 10);
  };
  GemmTile g, gn; bool pre = false;
  const TileMap tmap = tm_init(T / 128, INW / 128);
  auto wait_mt = [&](int mtw) {
    if (!waitf) return;
    if (tid < 64) {
      const unsigned* f = p.flags() + CL_N1 + mtw * 4 + (tid & 3);
      unsigned sp = 0;
      for (;;) {
        unsigned v;
        asm volatile("global_load_dword %0, %1, off sc1\n\ts_waitcnt vmcnt(0)" : "=&v"(v) : "v"(f) : "memory");
        if ((__builtin_amdgcn_ballot_w64(v == 0u) & 0xfull) == 0ull || ++sp > (1u << 16)) break;
        __builtin_amdgcn_s_sleep(1);
      }
    }
    __syncthreads();
  };
  { const int t0 = tm_tile(tmap, 0); if (t0 >= 0) { make(t0, g); gn = g; wait_mt(t0 / 10); } }
  for (int jt = 0; ; ++jt) {
    const int tile = tm_tile(tmap, jt); if (tile < 0) break;
    const int mt = tile / 10, nt = tile % 10, m0 = mt * 128;
    const int nxt = tm_tile(tmap, jt + 1); const bool hasn = nxt >= 0;
    if (hasn) { make(nxt, gn); wait_mt(nxt / 10); }
    f32x4 acc[4][4];
    gemm_mainloop<false>(g, gn, hasn, pre, smem, acc);
    pre = hasn; g = gn;
    const int rowb = m0 + wr * 64 + fr;
    if (FUSEN) {
      f32x4 sq[4][4], bz[4];
#pragma unroll
      for (int m = 0; m < 4; ++m)
#pragma unroll
        for (int i = 0; i < 4; ++i) sq[m][i] = *(const f32x4*)(p.ssqx() + (size_t)(rowb + 16 * m) * 16 + 4 * i);
#pragma unroll
      for (int n = 0; n < 4; ++n) bz[n] = *(const f32x4*)(p.bias1() + (size_t)(m0 / S) * INW + nt * 128 + wc * 64 + 16 * n + 4 * fq);
#pragma unroll
      for (int m = 0; m < 4; ++m) {
        float ssx = 0.f;
#pragma unroll
        for (int i = 0; i < 4; ++i) ssx += (sq[m][i][0] + sq[m][i][1]) + (sq[m][i][2] + sq[m][i][3]);
        const float rinv = rsqrtf(ssx * (1.f / D) + EPS);
#pragma unroll
        for (int n = 0; n < 4; ++n)
#pragma unroll
          for (int j = 0; j < 4; ++j) acc[m][n][j] = acc[m][n][j] * rinv + bz[n][j];
      }
    }
    if (nt <= 4) {
      const float* gv = (nt < 4 ? p.in.q_norm_g : p.in.k_norm_g) + l * HD;
      const float scl = nt < 4 ? 0.125f * 1.4426950408889634f : 1.f;
      f32x4 g1[2], g2[2];
#pragma unroll
      for (int n = 0; n < 2; ++n) { g1[n] = *(const f32x4*)(gv + 16 * n + 4 * fq); g2[n] = *(const f32x4*)(gv + 32 + 16 * n + 4 * fq); }
      float frq[2][4]; int posv[4];
#pragma unroll
      for (int n = 0; n < 2; ++n)
#pragma unroll
        for (int j = 0; j < 4; ++j) frq[n][j] = __builtin_amdgcn_exp2f(-(float)(16 * n + 4 * fq + j) * (13.287712379549449f / 32.f)) * 0.15915494309189535f;
#pragma unroll
      for (int m = 0; m < 4; ++m) posv[m] = p.in.pos[rowb + 16 * m];
#pragma unroll
      for (int mp = 0; mp < 2; ++mp) {
        u32x2 pk1[2][2], pk2[2][2];
#pragma unroll
        for (int mm = 0; mm < 2; ++mm) {
          const int m = 2 * mp + mm;
          float ss = 0.f;
#pragma unroll
          for (int n = 0; n < 4; ++n)
#pragma unroll
            for (int j = 0; j < 4; ++j) ss += acc[m][n][j] * acc[m][n][j];
          ss += __shfl_xor(ss, 16); ss += __shfl_xor(ss, 32);
          const float rinv = rsqrtf(ss * (1.f / 64.f) + EPS) * scl;
#pragma unroll
          for (int n = 0; n < 2; ++n) {
            float cn[4], sn[4];
#pragma unroll
            for (int j = 0; j < 4; ++j) {
              const float rev = (float)posv[m] * frq[n][j];
              const float rr = rev - floorf(rev);
              cn[j] = __builtin_amdgcn_cosf(rr); sn[j] = __builtin_amdgcn_sinf(rr);
            }
            float o1[4], o2[4];
#pragma unroll
            for (int j = 0; j < 4; ++j) {
              const float x1 = acc[m][n][j] * rinv * g1[n][j], x2 = acc[m][n + 2][j] * rinv * g2[n][j];
              o1[j] = x1 * cn[j] - x2 * sn[j]; o2[j] = x2 * cn[j] + x1 * sn[j];
            }
            pk1[mm][n] = (u32x2){pack2(o1[0], o1[1]), pack2(o1[2], o1[3])};
            pk2[mm][n] = (u32x2){pack2(o2[0], o2[1]), pack2(o2[2], o2[3])};
          }
        }
        const int t = rowb + 16 * (2 * mp + (fq & 1));
        bf16_t* dst = (nt < 4 ? (p.q() + (size_t)t * AW + (2 * nt + wc) * 64) : (p.k() + (size_t)t * 128 + wc * 64)) + 8 * (fq >> 1);
#pragma unroll
        for (int n = 0; n < 2; ++n) {
          *(u32x4*)(dst + 16 * n) = pair16(pk1[0][n], pk1[1][n]);
          *(u32x4*)(dst + 32 + 16 * n) = pair16(pk2[0][n], pk2[1][n]);
        }
      }
    } else if (nt == 5) {
      const int b = m0 / S;
      char* Tl = smem + 32768;
#pragma unroll
      for (int m = 0; m < 4; ++m) {
        const int r = wr * 64 + 16 * m + fr;
        const int k16 = r & 15;
        const int rp = (r & ~15) | (k16 & 3) | (((k16 >> 3) & 1) << 2) | (((k16 >> 2) & 1) << 3);
#pragma unroll
        for (int n = 0; n < 4; ++n)
#pragma unroll
          for (int j = 0; j < 4; ++j)
            *(bf16_t*)(Tl + (wc * 64 + 16 * n + 4 * fq + j) * 256 + rp * 2) = (bf16_t)(pack2(acc[m][n][j], 0.f) & 0xffffu);
      }
      __syncthreads();
      const int sb = m0 % S;
#pragma unroll
      for (int i = 0; i < 8; ++i) {
        const int ch = tid + 256 * i, dg = ch >> 4, c16 = ch & 15;
        const u32x4 v = *(const u32x4*)(Tl + dg * 256 + c16 * 16);
        *(u32x4*)(p.vT() + ((size_t)(b * 2) * 64 + dg) * S + sb + c16 * 8) = v;
      }
      __syncthreads();
    } else {
#pragma unroll
      for (int mp = 0; mp < 2; ++mp) {
        const int t = rowb + 16 * (2 * mp + (fq & 1));
#pragma unroll
        for (int n = 0; n < 4; ++n)
          *(u32x4*)(p.u() + (size_t)t * SW + (nt - 6) * 128 + wc * 64 + 16 * n + 8 * (fq >> 1)) =
              pair16((u32x2){pack2(acc[2 * mp][n][0], acc[2 * mp][n][1]), pack2(acc[2 * mp][n][2], acc[2 * mp][n][3])},
                     (u32x2){pack2(acc[2 * mp + 1][n][0], acc[2 * mp + 1][n][1]), pack2(acc[2 * mp + 1][n][2], acc[2 * mp + 1][n][3])});
      }
    }
  }
  asm volatile("s_waitcnt vmcnt(0)" ::: "memory");
  __syncthreads();
  if (tid == 0 && (gridDim.x & 7) == 0 && (gridDim.x >> 3) == 64u)
    asm volatile("global_store_dword %0, %1, off" :: "v"(p.flags() + CL_IP + (l * 8 + (int)(blockIdx.x & 7)) * 64 + (int)(blockIdx.x >> 3)), "v"(1u) : "memory");
}

__device__ __forceinline__ int crow32(int r, int hf) { return (r & 3) + 8 * (r >> 2) + 4 * hf; }
constexpr int SSEG = 4, SEGLEN = S / SSEG, SEGCH = SEGLEN / 32;

__device__ __forceinline__ float fma1(float a, float b, float c) { float d; asm("v_fma_f32 %0, %1, %2, %3" : "=v"(d) : "v"(a), "v"(b), "v"(c)); return d; }
__device__ __forceinline__ void ssm_bu(const bf16x8& ua, const bf16x8 (&bB)[4], f32x16 (&bu)[4]) {
#pragma unroll
  for (int nt = 0; nt < 4; ++nt) {
#pragma unroll
    for (int r = 0; r < 16; ++r) bu[nt][r] = 0.f;
    bu[nt] = __builtin_amdgcn_mfma_f32_32x32x16_bf16(ua, bB[nt], bu[nt], 0, 0, 0);
  }
  asm volatile("s_nop 15\n\ts_nop 7" : "+v"(bu[0]), "+v"(bu[1]), "+v"(bu[2]), "+v"(bu[3]));
#pragma unroll
  for (int r = 0; r < 16; ++r) {
    auto s0 = __builtin_amdgcn_permlane32_swap(__float_as_uint(bu[0][r]), __float_as_uint(bu[1][r]), false, false);
    bu[0][r] = __uint_as_float(s0[0]); bu[1][r] = __uint_as_float(s0[1]);
    auto s1 = __builtin_amdgcn_permlane32_swap(__float_as_uint(bu[2][r]), __float_as_uint(bu[3][r]), false, false);
    bu[2][r] = __uint_as_float(s1[0]); bu[3][r] = __uint_as_float(s1[1]);
  }
}

__device__ __forceinline__ void ssm_block(const MP& p, int l, int b, int g, int tid, char* smem) {
  const int lane = tid & 63, seg = tid >> 6;
  char* wl = smem + seg * 8192;
  float* fin = (float*)(smem + 4 * 8192);
  const int lg = l * SG + g, hf = lane >> 5, fr = lane & 15, fq = lane >> 4;
  const float ar = p.ssmL()[(lg * SP + lane) * 2], ai = p.ssmL()[(lg * SP + lane) * 2 + 1];
  const float nai = -ai;
  bf16x8 bB[4], cB[4];
#pragma unroll
  for (int nt = 0; nt < 4; ++nt) bB[nt] = *(const bf16x8*)(p.ssmB() + ((size_t)lg * 128 + nt * 32 + (lane & 31)) * 16 + 8 * hf);
#pragma unroll
  for (int ks = 0; ks < 4; ++ks) cB[ks] = *(const bf16x8*)(p.ssmC() + ((size_t)lg * 16 + fr) * 128 + 32 * ks + 8 * fq);
  const f32x4 dsk = *(const f32x4*)(p.in.ssm_d + l * SW + g * 16 + 4 * fq);
  const int t0 = b * S + seg * SEGLEN;
  const bf16_t* urow = p.u() + (size_t)(t0 + (lane & 31)) * SW + g * 16 + 8 * hf;
  float xr = 0.f, xi = 0.f;
  if (seg < SSEG - 1) {
    bf16x8 ua = *(const bf16x8*)(urow);
    for (int c = 0; c < SEGCH; ++c) {
      const bf16x8 un = *(const bf16x8*)(urow + (size_t)((c + 1 < SEGCH ? c + 1 : c) * 32) * SW);
      f32x16 bu[4];
      ssm_bu(ua, bB, bu);
#pragma unroll
      for (int r4 = 0; r4 < 4; ++r4)
#pragma unroll
        for (int half = 0; half < 2; ++half)
#pragma unroll
          for (int j = 0; j < 4; ++j) {
            const int r = 4 * r4 + j;
            const float bre = half ? bu[1][r] : bu[0][r], bim = half ? bu[3][r] : bu[2][r];
            const float nr = fma1(ar, xr, fma1(nai, xi, bre)), ni = fma1(ar, xi, fma1(ai, xr, bim));
            xr = nr; xi = ni;
          }
      ua = un;
    }
  }
  fin[(seg * 64 + lane) * 2] = xr; fin[(seg * 64 + lane) * 2 + 1] = xi;
  __syncthreads();
  {
    float pr = ar, pi = ai;
#pragma unroll
    for (int i = 0; i < 9; ++i) { const float nr = pr * pr - pi * pi, ni = 2.f * pr * pi; pr = nr; pi = ni; }
    static_assert(SEGLEN == 512, "lam^SEGLEN squaring count");
    float cr = 0.f, ci = 0.f;
    for (int j = 0; j < seg; ++j) {
      const float fr_ = fin[(j * 64 + lane) * 2], fi_ = fin[(j * 64 + lane) * 2 + 1];
      const float nr = pr * cr - pi * ci + fr_, ni = pr * ci + pi * cr + fi_;
      cr = nr; ci = ni;
    }
    xr = cr; xi = ci;
  }
  const int wbase = (lane & 3) * 4;
  const int pch = lane >> 2;
  const bf16_t* uep = p.u() + (size_t)(t0 + fr) * SW + g * 16 + 4 * fq;
  bf16x8 ua = *(const bf16x8*)(urow);
  u32x2 uraw[2];
#pragma unroll
  for (int i = 0; i < 2; ++i) uraw[i] = *(const u32x2*)(uep + (size_t)(16 * i) * SW);
  for (int c = 0; c < SEGCH; ++c) {
    const int tb = t0 + c * 32;
    const int cn = (c + 1 < SEGCH ? c + 1 : c) * 32;
    const bf16x8 un = *(const bf16x8*)(urow + (size_t)cn * SW);
    u32x2 unraw[2];
#pragma unroll
    for (int i = 0; i < 2; ++i) unraw[i] = *(const u32x2*)(uep + (size_t)(cn + 16 * i) * SW);
    f32x16 bu[4];
    ssm_bu(ua, bB, bu);
#pragma unroll
    for (int r4 = 0; r4 < 4; ++r4) {
#pragma unroll
      for (int half = 0; half < 2; ++half) {
#pragma unroll
        for (int j = 0; j < 4; ++j) {
          const int t = 8 * r4 + 4 * half + j, r = 4 * r4 + j;
          const float bre = half ? bu[1][r] : bu[0][r], bim = half ? bu[3][r] : bu[2][r];
          const float nr = fma1(ar, xr, fma1(nai, xi, bre)), ni = fma1(ar, xi, fma1(ai, xr, bim));
          xr = nr; xi = ni;
          *(unsigned*)(wl + t * 256 + ((pch ^ (t & 15)) << 4) + wbase) = pack2(nr, ni);
        }
      }
    }
    asm volatile("s_waitcnt lgkmcnt(0)" ::: "memory");
    u32x2 ypk[2];
#pragma unroll
    for (int mt = 0; mt < 2; ++mt) {
      f32x4 acc = {0.f, 0.f, 0.f, 0.f};
      const int t = 16 * mt + fr;
#pragma unroll
      for (int ks = 0; ks < 4; ++ks) {
        const bf16x8 af = *(const bf16x8*)(wl + t * 256 + (((4 * ks + fq) ^ (t & 15)) << 4));
        acc = __builtin_amdgcn_mfma_f32_16x16x32_bf16(cB[ks], af, acc, 0, 0, 0);
      }
      const float uu[4] = {bf_lo(uraw[mt][0]), bf_hi(uraw[mt][0]), bf_lo(uraw[mt][1]), bf_hi(uraw[mt][1])};
      float ge[4];
#pragma unroll
      for (int j = 0; j < 4; ++j) {
        const float v = acc[j] + dsk[j] * uu[j];
        const float z2 = 1.5957691216057308f * (v + 0.044715f * v * v * v);
        ge[j] = v * __builtin_amdgcn_rcpf(1.f + __expf(-z2));
      }
      ypk[mt] = (u32x2){pack2(ge[0], ge[1]), pack2(ge[2], ge[3])};
    }
    *(u32x4*)(p.y() + (size_t)(tb + 16 * (fq & 1) + fr) * SW + g * 16 + 8 * (fq >> 1)) = pair16(ypk[0], ypk[1]);
    asm volatile("s_waitcnt lgkmcnt(0)" ::: "memory");
    ua = un;
#pragma unroll
    for (int i = 0; i < 2; ++i) uraw[i] = unraw[i];
  }
}

constexpr int ATT_KBYTES = 160 * 128, ATT_VCH = 21, ATT_VBYTES = 64 * ATT_VCH * 16;
__device__ __forceinline__ void attn_block(const MP& p, int l, int b, int qt, int kvh, char* smem, int tid, unsigned* pflag) {
  const int lane = tid & 63, wave = __builtin_amdgcn_readfirstlane(tid >> 6);
  const int h = kvh * 4 + wave;
  const int s0 = qt * 32, t0 = b * S + s0, ql = lane & 31, hf = lane >> 5;
  char* Ks = smem; char* Vs = smem + ATT_KBYTES;
  {
    const bf16_t* kb = p.k() + (size_t)b * S * 128 + kvh * 64;
#pragma unroll
    for (int j = 0; j < 5; ++j) {
      const int pc = wave + 4 * j;
      const int R = 8 * pc + (lane >> 3);
      int ks = s0 - 128 + R; ks = ks < 0 ? 0 : ks;
      const int c = (lane & 7) ^ ((R >> 1) & 7);
      __builtin_amdgcn_global_load_lds((const void*)(kb + (size_t)ks * 128 + c * 8), (void*)(Ks + pc * 1024), 16, 0, 0);
    }
    const bf16_t* vbp = p.vT() + (size_t)(b * 2 + kvh) * 64 * S;
#pragma unroll
    for (int j = 0; j < 6; ++j) {
      const int pc = wave + 4 * j;
      if (pc < ATT_VCH) {
        const int q = 64 * pc + lane, d = q / ATT_VCH, c = q - d * ATT_VCH;
        int ko = s0 - 128 + 8 * (c < 20 ? c : 19); ko = ko < 0 ? 0 : ko;
        __builtin_amdgcn_global_load_lds((const void*)(vbp + (size_t)d * S + ko), (void*)(Vs + pc * 1024), 16, 0, 0);
      }
    }
  }
  bf16x8 qf[4];
#pragma unroll
  for (int st = 0; st < 4; ++st) qf[st] = *(const bf16x8*)(p.q() + (size_t)(t0 + ql) * AW + h * 64 + 16 * st + 8 * hf);
  asm volatile("s_waitcnt vmcnt(0)" ::: "memory");
  __syncthreads();
  if (pflag != nullptr && tid == 0) asm volatile("global_store_dword %0, %1, off" :: "v"(pflag), "v"(1u) : "memory");
  f32x16 sc[5];
#pragma unroll
  for (int kt = 0; kt < 5; ++kt) {
#pragma unroll
    for (int r = 0; r < 16; ++r) sc[kt][r] = 0.f;
#pragma unroll
    for (int st = 0; st < 4; ++st) {
      const int R = 32 * kt + ql, c = 2 * st + hf;
      const bf16x8 kf = *(const bf16x8*)(Ks + R * 128 + ((c ^ ((R >> 1) & 7)) << 4));
      sc[kt] = __builtin_amdgcn_mfma_f32_32x32x16_bf16(kf, qf[st], sc[kt], 0, 0, 0);
    }
  }
  const float sink = p.in.attn_sink[l * NQ + h] * 1.4426950408889634f;
  const int qlh = ql - 4 * hf;
  float mx = sink;
#pragma unroll
  for (int kt = 0; kt < 5; ++kt) {
    const float tbias = (s0 - 128 + 32 * kt) >= 0 ? 0.f : -1e30f;
#pragma unroll
    for (int r = 0; r < 16; ++r) {
      const int cr = (r & 3) + 8 * (r >> 2);
      float v = sc[kt][r];
      if (kt == 0) v = cr > qlh ? v + tbias : -1e30f;
      else if (kt == 4) v = cr <= qlh ? v : -1e30f;
      else v = v + tbias;
      sc[kt][r] = v;
      mx = fmaxf(mx, v);
    }
  }
  mx = xhalf_max(mx);
  float lsum = 0.f;
#pragma unroll
  for (int kt = 0; kt < 5; ++kt) {
#pragma unroll
    for (int r = 0; r < 16; ++r) { const float e = __builtin_amdgcn_exp2f(sc[kt][r] - mx); sc[kt][r] = e; lsum += e; }
  }
  lsum = xhalf_sum(lsum);
  lsum += __builtin_amdgcn_exp2f(sink - mx);
  const float inv = 1.f / lsum;
  f32x16 o[2];
#pragma unroll
  for (int r = 0; r < 16; ++r) { o[0][r] = 0.f; o[1][r] = 0.f; }
#pragma unroll
  for (int kt = 0; kt < 5; ++kt) {
#pragma unroll
    for (int s = 0; s < 2; ++s) {
      u32x4 pw;
#pragma unroll
      for (int j = 0; j < 4; ++j) pw[j] = pack2(sc[kt][8 * s + 2 * j], sc[kt][8 * s + 2 * j + 1]);
      const bf16x8 pa = __builtin_bit_cast(bf16x8, pw);
#pragma unroll
      for (int dt = 0; dt < 2; ++dt) {
        const bf16x8 vb = *(const bf16x8*)(Vs + ((32 * dt + ql) * ATT_VCH + 4 * kt + 2 * s + hf) * 16);
        o[dt] = __builtin_amdgcn_mfma_f32_32x32x16_bf16(vb, pa, o[dt], 0, 0, 0);
      }
    }
  }
  bf16_t* dst = p.attn() + (size_t)(t0 + ql) * AW + h * 64;
  float ssq = 0.f;
#pragma unroll
  for (int dt = 0; dt < 2; ++dt)
#pragma unroll
    for (int gp = 0; gp < 2; ++gp) {
      u32x2 pk[2];
#pragma unroll
      for (int gg = 0; gg < 2; ++gg) {
        const int g4 = 2 * gp + gg;
        const float a0 = o[dt][4 * g4] * inv, a1 = o[dt][4 * g4 + 1] * inv, a2 = o[dt][4 * g4 + 2] * inv, a3 = o[dt][4 * g4 + 3] * inv;
        ssq += (a0 * a0 + a1 * a1) + (a2 * a2 + a3 * a3);
        pk[gg] = (u32x2){pack2(a0, a1), pack2(a2, a3)};
      }
      *(u32x4*)(dst + 32 * dt + 8 * (2 * gp + hf)) = pair32(pk[0], pk[1]);
    }
  ssq = xhalf_sum(ssq);
  if (hf == 0) p.ssqa()[(size_t)(t0 + ql) * 8 + h] = ssq;
  __syncthreads();
}

__device__ __forceinline__ void phase_attn(const MP& p, int l, char* smem) {
  const int tid = launder(threadIdx.x);
  unsigned* oaf = p.flags() + CL_OA + l * (T / 128) * 16;
  unsigned* pend = nullptr;
  if ((gridDim.x & 7) == 0) {
    const int xcd = blockIdx.x & 7, lb = blockIdx.x >> 3, nlb = gridDim.x >> 3;
#pragma unroll 1
    for (int it = lb; it < 128; it += nlb) {
      const int qt = it & 63, kvh = it >> 6;
      attn_block(p, l, xcd, qt, kvh, smem, tid, pend);
      pend = oaf + (xcd * 16 + (qt >> 2)) * 16 + 4 + (qt & 3) * 2 + kvh;
    }
  } else {
#pragma unroll 1
    for (int it = blockIdx.x; it < NB * 128; it += gridDim.x) {
      const int b = it >> 7, qt = it & 63, kvh = (it >> 6) & 1;
      attn_block(p, l, b, qt, kvh, smem, tid, pend);
      pend = oaf + (b * 16 + (qt >> 2)) * 16 + 4 + (qt & 3) * 2 + kvh;
    }
  }
  asm volatile("s_waitcnt vmcnt(0)" ::: "memory");
  __syncthreads();
  if (pend != nullptr && tid == 0) asm volatile("global_store_dword %0, %1, off" :: "v"(pend), "v"(1u) : "memory");
}
__device__ __forceinline__ void phase_ssm(const MP& p, int l, char* smem, int wid, int lrank) {
  const int tid = launder(threadIdx.x);
  if (wid < 0) return;
  unsigned nwl = 0; bool all = (gridDim.x & 7) == 0;
#pragma unroll
  for (int x = 0; x < 8; ++x) {
    const unsigned c = __hip_atomic_load(p.claim() + 4104 + x, __ATOMIC_RELAXED, __HIP_MEMORY_SCOPE_AGENT);
    all = all && c > 0u; nwl = (x == (int)(blockIdx.x & 7)) ? c : nwl;
  }
  if (all) {
    const int b = blockIdx.x & 7;
    for (int g = lrank; g < SG; g += (int)nwl) {
      ssm_block(p, l, b, g, tid, smem);
      asm volatile("s_waitcnt vmcnt(0)" ::: "memory");
      __syncthreads();
      if (tid == 0) asm volatile("global_store_dword %0, %1, off" :: "v"(p.flags() + CL_SSM + (l * 8 + b) * 32 + g), "v"(1u) : "memory");
    }
  } else {
    const int nw = (int)__hip_atomic_load(p.claim() + 4096, __ATOMIC_RELAXED, __HIP_MEMORY_SCOPE_AGENT);
    for (int task = wid; task < NB * SG; task += nw) { ssm_block(p, l, task / SG, task % SG, tid, smem); __syncthreads(); }
  }
}
__device__ __forceinline__ void phase_glu(const MP& p, int l, char* smem) {
  const int tid = launder(threadIdx.x), lane = tid & 63, wave = tid >> 6, wr = wave >> 1, wc = wave & 1, fr = lane & 15, fq = lane >> 4;
  const int r0 = tid >> 3;
  const int ntiles = (T / 128) * (SW / 128);
  const bf16_t* W = p.WgluT() + (size_t)l * SW * SW;
  auto make = [&](int tile, GemmTile& g) {
    const int m0 = (tile >> 2) * 128, n0 = (tile & 3) * 128;
    g.A0 = p.y(); g.A1 = p.y(); g.lda = SW; g.ksA = SW; g.K = SW;
#pragma unroll
    for (int i = 0; i < 4; ++i) g.arow[i] = m0 + r0 + 32 * i;
    g.Blo0 = W + (size_t)n0 * SW; g.Bhi0 = g.Blo0 + (size_t)64 * SW; g.Blo1 = g.Blo0; g.Bhi1 = g.Bhi0;
    g.ldb = SW; g.ksB = SW; g.rot = ROT_OF(tile >> 2, tile & 3) & 7;
  };
  GemmTile g, gn; bool pre = false;
  const TileMap tmap = tm_init(T / 128, SW / 128);
  { const int t0 = tm_tile(tmap, 0); if (t0 >= 0) { make(t0, g); gn = g; } }
  unsigned* oaf = p.flags() + CL_OA + l * (T / 128) * 16;
  int pend = -1;
  auto announce = [&](int tp) {
    if (tp >= 0 && tid == 0) asm volatile("global_store_dword %0, %1, off" :: "v"(oaf + (tp >> 2) * 16 + (tp & 3)), "v"(1u) : "memory");
  };
  for (int jt = 0; ; ++jt) {
    const int tile = tm_tile(tmap, jt); if (tile < 0) break;
    const int mt = tile >> 2, nt = tile & 3, m0 = mt * 128, n0 = nt * 128;
    const int nxt = tm_tile(tmap, jt + 1); const bool hasn = nxt >= 0;
    if (hasn) make(nxt, gn);
    f32x4 acc[4][4];
    gemm_mainloop<false>(g, gn, hasn, pre, smem, acc);
    pre = hasn; g = gn;
    announce(pend); pend = tile;
    u32x2 yrv[4][4];
#pragma unroll
    for (int m = 0; m < 4; ++m)
#pragma unroll
      for (int n = 0; n < 4; ++n) yrv[m][n] = *(const u32x2*)(p.y() + (size_t)(m0 + wr * 64 + 16 * m + fr) * SW + n0 + wc * 64 + 16 * n + 4 * fq);
#pragma unroll
    for (int mp = 0; mp < 2; ++mp) {
      u32x2 pk[2][4];
#pragma unroll
      for (int mm = 0; mm < 2; ++mm) {
        const int m = 2 * mp + mm;
        const int t = m0 + wr * 64 + 16 * m + fr;
        float ss = 0.f;
#pragma unroll
        for (int n = 0; n < 4; ++n) {
          const u32x2 yr = yrv[m][n];
          const float yv[4] = {bf_lo(yr[0]), bf_hi(yr[0]), bf_lo(yr[1]), bf_hi(yr[1])};
          float o[4];
#pragma unroll
          for (int j = 0; j < 4; ++j) { o[j] = yv[j] * __builtin_amdgcn_rcpf(1.f + __expf(-acc[m][n][j])); ss += o[j] * o[j]; }
          pk[mm][n] = (u32x2){pack2(o[0], o[1]), pack2(o[2], o[3])};
        }
        ss += __shfl_xor(ss, 16); ss += __shfl_xor(ss, 32);
        if (fq == 0) p.ssqs()[(size_t)t * 8 + nt * 2 + wc] = ss;
      }
      const int ts = m0 + wr * 64 + 16 * (2 * mp + (fq & 1)) + fr;
#pragma unroll
      for (int n = 0; n < 4; ++n) *(u32x4*)(p.ssm() + (size_t)ts * SW + n0 + wc * 64 + 16 * n + 8 * (fq >> 1)) = pair16(pk[0][n], pk[1][n]);
    }
  }
  asm volatile("s_waitcnt vmcnt(0)" ::: "memory");
  __syncthreads();
  announce(pend);
}

template <bool XB>
__device__ __forceinline__ void phase_out(const MP& p, int l, char* smem, const float* xin) {
  const int tid = launder(threadIdx.x), lane = tid & 63, wave = tid >> 6, wr = wave >> 1, wc = wave & 1, fr = lane & 15, fq = lane >> 4;
  const int r0 = tid >> 3;
  const float* modl = p.mod() + (size_t)l * 8 * 6144;
  const int ntiles = (T / 128) * (D / 128);
  const bf16_t* W = p.WoutT() + (size_t)l * D * D;
  auto make = [&](int tile, GemmTile& g) {
    const int m0 = (tile >> 3) * 128, n0 = (tile & 7) * 128;
    g.A0 = p.attn(); g.A1 = p.ssm(); g.lda = AW; g.ksA = AW; g.K = D;
#pragma unroll
    for (int i = 0; i < 4; ++i) g.arow[i] = m0 + r0 + 32 * i;
    g.Blo0 = W + (size_t)n0 * D; g.Bhi0 = g.Blo0 + (size_t)64 * D; g.Blo1 = g.Blo0; g.Bhi1 = g.Bhi0;
    g.ldb = D; g.ksB = D; g.rot = 0;
  };
  GemmTile g, gn; bool pre = false;
  const TileMap tmap = tm_init(T / 128, D / 128);
  const unsigned* oaf = p.flags() + CL_OA + l * (T / 128) * 16;
  auto wait_mt = [&](int mtw) {
    if (tid < 64) {
      const unsigned* f = oaf + mtw * 16 + (tid & 15);
      unsigned sp = 0;
      for (;;) {
        unsigned v;
        asm volatile("global_load_dword %0, %1, off sc1\n\ts_waitcnt vmcnt(0)" : "=&v"(v) : "v"(f) : "memory");
        if ((__builtin_amdgcn_ballot_w64(v == 0u) & 0x0fffull) == 0ull || ++sp > (1u << 16)) break;
        __builtin_amdgcn_s_sleep(1);
      }
    }
    __syncthreads();
  };
  { const int t0 = tm_tile(tmap, 0); if (t0 >= 0) { make(t0, g); gn = g; wait_mt(t0 >> 3); } }
  unsigned* tflag = p.flags() + CL_MTC + l * 1024;
  int pend = -1, ndone = 0;
  auto announce = [&](int tp) {
    if (tp >= 0 && tid == 0) asm volatile("global_store_dword %0, %1, off" :: "v"(tflag + tp), "v"(1u) : "memory");
  };
  for (int jt = 0; ; ++jt) {
    const int tile = tm_tile(tmap, jt); if (tile < 0) break;
    const int mt = tile >> 3, nt = tile & 7, m0 = mt * 128, n0 = nt * 128, b = m0 / S;
    const int nxt = tm_tile(tmap, jt + 1); const bool hasn = nxt >= 0;
    if (hasn) { make(nxt, gn); wait_mt(nxt >> 3); }
    float mids[4], rs[4];
#pragma unroll
    for (int m = 0; m < 4; ++m) {
      const int t = m0 + wr * 64 + 16 * m + fr;
      const f32x4 a0 = *(const f32x4*)(p.ssqa() + (size_t)t * 8), a1 = *(const f32x4*)(p.ssqa() + (size_t)t * 8 + 4);
      const f32x4 s0 = *(const f32x4*)(p.ssqs() + (size_t)t * 8), s1 = *(const f32x4*)(p.ssqs() + (size_t)t * 8 + 4);
      const float sa = ((a0[0] + a0[1]) + (a0[2] + a0[3])) + ((a1[0] + a1[1]) + (a1[2] + a1[3]));
      const float sq = ((s0[0] + s0[1]) + (s0[2] + s0[3])) + ((s1[0] + s1[1]) + (s1[2] + s1[3]));
      const float ra = rsqrtf(sa * (1.f / 512.f) + EPS);
      rs[m] = rsqrtf(sq * (1.f / 512.f) + EPS);
      mids[m] = ra / rs[m];
    }
    f32x4 acc[4][4];
    gemm_mainloop_t<false, true>(g, gn, hasn, pre, smem, acc, 8, mids);
    pre = hasn; g = gn;
    announce(pend); pend = tile; ++ndone;
    f32x4 g1v[4], xvv[4][4]; u32x2 xbv[4][4];
#pragma unroll
    for (int n = 0; n < 4; ++n) g1v[n] = *(const f32x4*)(modl + (size_t)b * 6144 + 2 * 1024 + n0 + wc * 64 + 16 * n + 4 * fq);
#pragma unroll
    for (int m = 0; m < 4; ++m)
#pragma unroll
      for (int n = 0; n < 4; ++n) {
        const size_t xo = (size_t)(m0 + wr * 64 + 16 * m + fr) * D + n0 + wc * 64 + 16 * n + 4 * fq;
        if (XB) xbv[m][n] = *(const u32x2*)(p.xb() + xo); else xvv[m][n] = __builtin_nontemporal_load((const f32x4*)(xin + xo));
      }
#pragma unroll
    for (int mp = 0; mp < 2; ++mp) {
      u32x2 pk[2][4];
#pragma unroll
      for (int mm = 0; mm < 2; ++mm) {
        const int m = 2 * mp + mm;
#pragma unroll
        for (int n = 0; n < 4; ++n) {
          const f32x4 xv = XB ? (f32x4){bf_lo(xbv[m][n][0]), bf_hi(xbv[m][n][0]), bf_lo(xbv[m][n][1]), bf_hi(xbv[m][n][1])} : xvv[m][n];
          const f32x4 g1 = g1v[n];
          f32x4 o;
#pragma unroll
          for (int j = 0; j < 4; ++j) o[j] = xv[j] + g1[j] * (acc[m][n][j] * rs[m]);
          pk[mm][n] = (u32x2){pack2(o[0], o[1]), pack2(o[2], o[3])};
        }
      }
      const int t = m0 + wr * 64 + 16 * (2 * mp + (fq & 1)) + fr;
#pragma unroll
      for (int n = 0; n < 4; ++n) *(u32x4*)(p.x1() + (size_t)t * D + n0 + wc * 64 + 16 * n + 8 * (fq >> 1)) = pair16(pk[0][n], pk[1][n]);
    }
  }
  asm volatile("s_waitcnt vmcnt(0)" ::: "memory");
  __syncthreads();
  announce(pend);
}
__device__ __forceinline__ void phase_norm2_route(const MP& p, int l, char* smem) {
  const int tid = launder(threadIdx.x);
  const int wave = tid >> 6, lane = tid & 63, fr = lane & 15, fq = lane >> 4;
  const float* modl = p.mod() + (size_t)l * 8 * 6144;
  const float* g2n = p.in.norm2_g + l * D;
  float* gsl = (float*)smem;
  float* shl = gsl + 1024;
  int* cntl = p.cnt() + l * 256;
  for (int s = blockIdx.x; s < 512; s += gridDim.x) {
    const int b = s & 7, q = s >> 3;
    __syncthreads();
    {
      const int d = tid * 4;
      const float4 gg = *(const float4*)(g2n + d), s1 = *(const float4*)(modl + (size_t)b * 6144 + 4 * 1024 + d), s0 = *(const float4*)(modl + (size_t)b * 6144 + 3 * 1024 + d);
      *(float4*)(gsl + d) = make_float4(gg.x * (1.f + s1.x), gg.y * (1.f + s1.y), gg.z * (1.f + s1.z), gg.w * (1.f + s1.w));
      *(float4*)(shl + d) = s0;
    }
    if (tid == 0) {
      const unsigned* f = p.flags() + CL_MTC + l * 1024 + (b * 16 + (q >> 2)) * 8;
      unsigned sp = 0;
      for (;;) {
        u32x4 fa, fb;
        asm volatile("global_load_dwordx4 %0, %2, off sc1\n\tglobal_load_dwordx4 %1, %2, off offset:16 sc1\n\ts_waitcnt vmcnt(0)" : "=&v"(fa), "=&v"(fb) : "v"(f) : "memory");
        const unsigned all = (fa[0] & fa[1]) & (fa[2] & fa[3]) & (fb[0] & fb[1]) & (fb[2] & fb[3]);
        if (all != 0u || ++sp > (1u << 16)) break;
        __builtin_amdgcn_s_sleep(1);
      }
    }
    __syncthreads();
    {
      const int g = wave & 1, kh = wave >> 1;
      float* pss = (float*)(smem + 8192);
      f32x4* pacc = (f32x4*)(smem + 8192 + 256);
      const int t = b * S + (q * 2 + g) * 16 + fr;
      const bf16_t* xrow = p.x1() + (size_t)t * D + 512 * kh + 8 * fq;
      float ss = 0.f;
#pragma unroll 8
      for (int ks = 0; ks < 16; ++ks) {
        const u32x4 xr = *(const u32x4*)(xrow + 32 * ks);
#pragma unroll
        for (int j = 0; j < 4; ++j) { const float a = bf_lo(xr[j]), c = bf_hi(xr[j]); ss += a * a + c * c; }
      }
      ss += __shfl_xor(ss, 16); ss += __shfl_xor(ss, 32);
      if (fq == 0) pss[(g * 2 + kh) * 16 + fr] = ss;
      __syncthreads();
      ss = pss[(g * 2) * 16 + fr] + pss[(g * 2 + 1) * 16 + fr];
      const float rinv = rsqrtf(ss * (1.f / D) + EPS);
      const u32x4* wf = p.wrf() + (size_t)(kh * 16) * 2 * 64 + lane;
      bf16_t* hrow = p.h() + (size_t)t * D + 512 * kh + 8 * fq;
      const float* gq = gsl + 512 * kh + 8 * fq; const float* sq = shl + 512 * kh + 8 * fq;
      f32x4 acc = {0.f, 0.f, 0.f, 0.f};
#pragma unroll 4
      for (int ks = 0; ks < 16; ++ks) {
        const u32x4 xr = *(const u32x4*)(xrow + 32 * ks);
        const float* gp = gq + 32 * ks; const float* sp = sq + 32 * ks;
        const f32x4 ga = *(const f32x4*)gp, gb = *(const f32x4*)(gp + 4), sa = *(const f32x4*)sp, sb = *(const f32x4*)(sp + 4);
        const float gv[8] = {ga[0], ga[1], ga[2], ga[3], gb[0], gb[1], gb[2], gb[3]}, sv[8] = {sa[0], sa[1], sa[2], sa[3], sb[0], sb[1], sb[2], sb[3]};
        u32x4 hi, lo;
#pragma unroll
        for (int j = 0; j < 4; ++j) {
          const float h0 = bf_lo(xr[j]) * rinv * gv[2 * j] + sv[2 * j], h1 = bf_hi(xr[j]) * rinv * gv[2 * j + 1] + sv[2 * j + 1];
          hi[j] = pack2(h0, h1);
          lo[j] = pack2(h0 - bf_lo(hi[j]), h1 - bf_hi(hi[j]));
        }
        *(u32x4*)(hrow + 32 * ks) = hi;
        const bf16x8 whi = __builtin_bit_cast(bf16x8, wf[(ks * 2) * 64]), wlo = __builtin_bit_cast(bf16x8, wf[(ks * 2 + 1) * 64]);
        const bf16x8 hhi = __builtin_bit_cast(bf16x8, hi), hlo = __builtin_bit_cast(bf16x8, lo);
        acc = __builtin_amdgcn_mfma_f32_16x16x32_bf16(whi, hhi, acc, 0, 0, 0);
        acc = __builtin_amdgcn_mfma_f32_16x16x32_bf16(whi, hlo, acc, 0, 0, 0);
        acc = __builtin_amdgcn_mfma_f32_16x16x32_bf16(wlo, hhi, acc, 0, 0, 0);
      }
      if (kh == 1) pacc[g * 64 + lane] = acc;
      __syncthreads();
      if (kh == 0) {
      const f32x4 oth = pacc[g * 64 + lane];
#pragma unroll
      for (int j = 0; j < 4; ++j) acc[j] += oth[j];
      float mx = fmaxf(fmaxf(acc[0], acc[1]), fmaxf(acc[2], acc[3]));
      mx = fmaxf(mx, __shfl_xor(mx, 16)); mx = fmaxf(mx, __shfl_xor(mx, 32));
      float pr[4], sel[4]; float sum = 0.f;
#pragma unroll
      for (int j = 0; j < 4; ++j) { pr[j] = __expf(acc[j] - mx); sum += pr[j]; }
      sum += __shfl_xor(sum, 16); sum += __shfl_xor(sum, 32);
      const float inv = 1.f / sum;
      const f32x4 rb = *(const f32x4*)(p.in.router_bias + 4 * fq);
#pragma unroll
      for (int j = 0; j < 4; ++j) { pr[j] *= inv; sel[j] = pr[j] + rb[j]; }
      float m1 = -1e30f, m2 = -1e30f;
#pragma unroll
      for (int j = 0; j < 4; ++j) { const float v = sel[j]; if (v > m1) { m2 = m1; m1 = v; } else if (v > m2) m2 = v; }
      const float gs = m1 + m2;
      int gbest = 0; float gbs = -1e30f;
#pragma unroll
      for (int gg = 0; gg < 4; ++gg) { const float v = __shfl(gs, fr + 16 * gg); if (v > gbs) { gbs = v; gbest = gg; } }
      if (fq == gbest) {
        int i0 = 0; float b0 = sel[0];
#pragma unroll
        for (int j = 1; j < 4; ++j) if (sel[j] > b0) { b0 = sel[j]; i0 = j; }
        int i1 = -1; float bb1 = -1e30f;
#pragma unroll
        for (int j = 0; j < 4; ++j) if (j != i0 && sel[j] > bb1) { bb1 = sel[j]; i1 = j; }
        float p0 = 0.f, p1 = 0.f;
#pragma unroll
        for (int j = 0; j < 4; ++j) { if (j == i0) p0 = pr[j]; if (j == i1) p1 = pr[j]; }
        const float w0 = p0 / (p0 + p1), w1 = p1 / (p0 + p1);
        const int lo2 = i0 < i1 ? i0 : i1, hi2 = i0 < i1 ? i1 : i0;
        const float wlo = i0 < i1 ? w0 : w1, whi2 = i0 < i1 ? w1 : w0;
        const int pidx = (lo2 == 0) ? (hi2 - 1) : (lo2 == 1 ? (hi2 + 1) : 5);
        const int bucket = gbest * 6 + pidx;
        const int sl = bucket * NSUBL + (blockIdx.x & (NSUBL - 1));
        const int pos = atomicAdd(&cntl[sl], 1);
        p.list()[(size_t)sl * T + pos] = t;
        p.tokw()[t] = make_float2(wlo, whi2);
      }
      }
    }
  }
  __syncthreads();
}

__device__ __forceinline__ void bucket_experts2(int bucket, int& elo, int& ehi) {
  const int g = bucket / 6, pi = bucket % 6;
  const int lo = pi < 3 ? 0 : (pi < 5 ? 1 : 2);
  const int hi = pi < 3 ? pi + 1 : (pi < 5 ? pi - 1 : 3);
  elo = g * 4 + lo; ehi = g * 4 + hi;
}
__device__ __forceinline__ void moe_map_build(const int* cnt, int* mm, int tid) {
  if (tid < NBUCKET) {
    int acc = 0;
#pragma unroll
    for (int x = 0; x < NSUBL; ++x) { mm[32 + 16 * tid + x] = acc; acc += cnt[tid * NSUBL + x]; }
    mm[32 + 16 * tid + 8] = acc;
  }
  __syncthreads();
  if (tid == 0) {
    int acc = 0;
    for (int bk = 0; bk < NBUCKET; ++bk) { mm[bk] = acc; acc += (mm[32 + 16 * bk + 8] + TM - 1) / TM; }
    mm[NBUCKET] = acc;
  }
  __syncthreads();
}
__device__ __forceinline__ void moe_find_tile(const int* mm, int mt, int& bucket, int& tib, int& nrow) {
  int bk = 0;
#pragma unroll
  for (int j = 1; j < NBUCKET; ++j) bk += (mt >= mm[j]) ? 1 : 0;
  bucket = bk; tib = mt - mm[bk]; nrow = mm[32 + 16 * bk + 8] - tib * TM;
}
__device__ __forceinline__ int moe_token(const int* list, const int* mm, int bk, int q) {
  const int* sp = mm + 32 + 16 * bk;
  int x = 0, s = 0;
#pragma unroll
  for (int j = 1; j < NSUBL; ++j) { const int v = sp[j]; const bool ge = q >= v; x += ge ? 1 : 0; s = ge ? v : s; }
  return list[(size_t)(bk * NSUBL + x) * T + (q - s)];
}

__device__ __forceinline__ void fold_inproj_next(const MP& p, int ln) {
  const int tid = launder(threadIdx.x), wave = tid >> 6, lane = tid & 63;
  const float* modn = p.mod() + (size_t)ln * 8 * 6144;
  const float* gn = p.in.norm1_g + ln * D;
  const bf16_t* W = p.WinT() + (size_t)ln * INW * D;
  const int d = tid * 4;
  const float4 gg = *(const float4*)(gn + d);
  const int G = (int)gridDim.x;
  for (int u0 = blockIdx.x; u0 < 8 * INW; u0 += G * 10) {
    float4 s1[10]; u32x2 wr2[10];
#pragma unroll
    for (int q = 0; q < 10; ++q) {
      const int u = u0 + q * G, uu = u < 8 * INW ? u : u0;
      const int b = uu / INW, n = uu - b * INW;
      s1[q] = *(const float4*)(modn + (size_t)b * 6144 + 1024 + d);
      wr2[q] = *(const u32x2*)(W + (size_t)n * D + d);
    }
#pragma unroll
    for (int q = 0; q < 10; ++q) {
      const int u = u0 + q * G;
      if (u < 8 * INW) {
        const int b = u / INW, n = u - b * INW;
        const float o0 = bf_lo(wr2[q][0]) * gg.x * (1.f + s1[q].x), o1 = bf_hi(wr2[q][0]) * gg.y * (1.f + s1[q].y);
        const float o2 = bf_lo(wr2[q][1]) * gg.z * (1.f + s1[q].z), o3 = bf_hi(wr2[q][1]) * gg.w * (1.f + s1[q].w);
        *(u32x2*)(p.w1b() + ((size_t)b * INW + n) * D + d) = (u32x2){pack2(o0, o1), pack2(o2, o3)};
      }
    }
  }
  for (int n = blockIdx.x * 4 + wave; n < INW; n += gridDim.x * 4) {
    float wv[16];
#pragma unroll
    for (int i = 0; i < 4; ++i) {
      const u32x2 r = *(const u32x2*)(W + (size_t)n * D + lane * 4 + 256 * i);
      wv[4 * i] = bf_lo(r[0]); wv[4 * i + 1] = bf_hi(r[0]); wv[4 * i + 2] = bf_lo(r[1]); wv[4 * i + 3] = bf_hi(r[1]);
    }
#pragma unroll 1
    for (int bh = 0; bh < 2; ++bh) {
      float4 sh[4][4];
#pragma unroll
      for (int bb = 0; bb < 4; ++bb)
#pragma unroll
        for (int i = 0; i < 4; ++i) sh[bb][i] = *(const float4*)(modn + (size_t)(bh * 4 + bb) * 6144 + lane * 4 + 256 * i);
      float sacc[4];
#pragma unroll
      for (int bb = 0; bb < 4; ++bb) {
        float a = 0.f;
#pragma unroll
        for (int i = 0; i < 4; ++i) a += sh[bb][i].x * wv[4 * i] + sh[bb][i].y * wv[4 * i + 1] + sh[bb][i].z * wv[4 * i + 2] + sh[bb][i].w * wv[4 * i + 3];
        sacc[bb] = wave_sum(a);
      }
#pragma unroll
      for (int bb = 0; bb < 4; ++bb) if (lane == 0) p.bias1()[(bh * 4 + bb) * INW + n] = sacc[bb];
    }
  }
}

__device__ __forceinline__ void phase_moe_gu(const MP& p, int l, char* smem) {
  const int tid = launder(threadIdx.x), lane = tid & 63, wave = tid >> 6, wr = wave >> 1, wc = wave & 1, fr = lane & 15, fq = lane >> 4;
  const int r0 = tid >> 3;
  int* mm = (int*)(smem + SMEM_MM);
  moe_map_build(p.cnt() + l * 256, mm, tid);
  const int nmt = mm[NBUCKET];
  const int ntiles = nmt * 16;
  auto make = [&](int tile, GemmTile& g) {
    const int mt = tile >> 4, nt = tile & 15;
    int bucket, tib, nrow;
    moe_find_tile(mm, mt, bucket, tib, nrow);
    int elo, ehi; bucket_experts2(bucket, elo, ehi);
    const int e = nt < 8 ? elo : ehi, f0 = (nt & 7) * 64;
    g.A0 = p.h(); g.A1 = p.h(); g.lda = D; g.ksA = D; g.K = D;
    const bf16_t* Wg = p.WgT() + ((size_t)e * DFF + f0) * D;
    const bf16_t* Wu = p.WuT() + ((size_t)e * DFF + f0) * D;
#pragma unroll
    for (int i = 0; i < 4; ++i) {
      const int r = r0 + 32 * i;
      g.arow[i] = moe_token(p.list(), mm, bucket, tib * TM + (r < nrow ? r : nrow - 1));
    }
    g.Blo0 = Wg; g.Bhi0 = Wu; g.Blo1 = Wg; g.Bhi1 = Wu;
    g.ldb = D; g.ksB = D; g.rot = ROT_OF(bucket, nt);
  };
  GemmTile g, gn; bool pre = false;
  const TileMap tmap = tm_init(nmt, 16);
  { const int t0 = tm_tile(tmap, 0); if (t0 >= 0) { make(t0, g); gn = g; } }
  unsigned* gflag = p.flags() + CL_GU + l * MAXMT * 16;
  int pend = -1;
  auto announce = [&](int tp) {
    if (tp >= 0 && tid == 0) asm volatile("global_store_dword %0, %1, off" :: "v"(gflag + tp), "v"(1u) : "memory");
  };
  for (int jt = 0; ; ++jt) {
    const int tile = tm_tile(tmap, jt); if (tile < 0) break;
    const int mt = tile >> 4, nt = tile & 15;
    int bucket, tib, nrow;
    moe_find_tile(mm, mt, bucket, tib, nrow);
    const int f0 = (nt & 7) * 64;
    const int nxt = tm_tile(tmap, jt + 1); const bool hasn = nxt >= 0;
    if (hasn) make(nxt, gn);
    float wv[4];
#pragma unroll
    for (int m = 0; m < 4; ++m) {
      const int r = wr * 64 + 16 * m + fr;
      const float2 ww = p.tokw()[moe_token(p.list(), mm, bucket, tib * TM + (r < nrow ? r : nrow - 1))];
      wv[m] = r < nrow ? (nt < 8 ? ww.x : ww.y) : 0.f;
    }
    f32x4 acc[4][4];
    gemm_mainloop<true>(g, gn, hasn, pre, smem, acc);
    pre = hasn; g = gn;
    announce(pend); pend = tile;
#pragma unroll
    for (int mp = 0; mp < 2; ++mp) {
      u32x2 pk[2][2];
#pragma unroll
      for (int mm = 0; mm < 2; ++mm) {
        const int m = 2 * mp + mm;
        const float w = wv[m];
#pragma unroll
        for (int n = 0; n < 2; ++n) {
          float o[4];
#pragma unroll
          for (int j = 0; j < 4; ++j) { const float gv = acc[m][n][j], uv = acc[m][n + 2][j]; o[j] = gv * __builtin_amdgcn_rcpf(1.f + __expf(-gv)) * uv * w; }
          pk[mm][n] = (u32x2){pack2(o[0], o[1]), pack2(o[2], o[3])};
        }
      }
      const int r = wr * 64 + 16 * (2 * mp + (fq & 1)) + fr;
      bf16_t* dst = p.act() + (size_t)(mt * TM + r) * D + (nt < 8 ? 0 : 512) + f0 + wc * 32 + 8 * (fq >> 1);
#pragma unroll
      for (int n = 0; n < 2; ++n) *(u32x4*)(dst + 16 * n) = pair16(pk[0][n], pk[1][n]);
    }
  }
  asm volatile("s_waitcnt vmcnt(0)" ::: "memory");
  __syncthreads();
  announce(pend);
}

template <bool XBOUT>
__device__ __forceinline__ void phase_moe_down(const MP& p, int l, char* smem) {
  const int tid = launder(threadIdx.x), lane = tid & 63, wave = tid >> 6, wr = wave >> 1, wc = wave & 1, fr = lane & 15, fq = lane >> 4;
  const int r0 = tid >> 3;
  int* mm = (int*)(smem + SMEM_MM);
  const float* modl = p.mod() + (size_t)l * 8 * 6144;
  const int nmt = mm[NBUCKET];
  const int ntiles = nmt * 8;
  auto make = [&](int tile, GemmTile& g) {
    const int mt = tile >> 3, n0 = (tile & 7) * 128;
    int bucket, tib, nrow;
    moe_find_tile(mm, mt, bucket, tib, nrow);
    int elo, ehi; bucket_experts2(bucket, elo, ehi);
    g.A0 = p.act(); g.A1 = p.act(); g.lda = D; g.ksA = D; g.K = D;
    const bf16_t* Wlo = p.WdT() + ((size_t)elo * D + n0) * DFF;
    const bf16_t* Whi = p.WdT() + ((size_t)ehi * D + n0) * DFF;
#pragma unroll
    for (int i = 0; i < 4; ++i) {
      g.arow[i] = mt * TM + r0 + 32 * i;
    }
    g.Blo0 = Wlo; g.Bhi0 = Wlo + (size_t)64 * DFF; g.Blo1 = Whi; g.Bhi1 = Whi + (size_t)64 * DFF;
    g.ldb = DFF; g.ksB = DFF; g.rot = ROT_OF(bucket, tile & 7);
  };
  GemmTile g, gn; bool pre = false;
  const TileMap tmap = tm_init(nmt, 8);
  const unsigned* gflag = p.flags() + CL_GU + l * MAXMT * 16;
  auto wait_mt = [&](int mtw) {
    if (tid < 64) {
      const unsigned* f = gflag + mtw * 16 + (tid & 15);
      unsigned sp = 0;
      for (;;) {
        unsigned v;
        asm volatile("global_load_dword %0, %1, off sc1\n\ts_waitcnt vmcnt(0)" : "=&v"(v) : "v"(f) : "memory");
        if (__builtin_amdgcn_ballot_w64(v == 0u) == 0ull || ++sp > (1u << 16)) break;
        __builtin_amdgcn_s_sleep(1);
      }
    }
    __syncthreads();
  };
  { const int t0 = tm_tile(tmap, 0); if (t0 >= 0) { make(t0, g); gn = g; wait_mt(t0 >> 3); } }
  for (int jt = 0; ; ++jt) {
    const int tile = tm_tile(tmap, jt); if (tile < 0) break;
    const int mt = tile >> 3, nt = tile & 7, n0 = nt * 128;
    int bucket, tib, nrow;
    moe_find_tile(mm, mt, bucket, tib, nrow);
    const int nxt = tm_tile(tmap, jt + 1); const bool hasn = nxt >= 0;
    if (hasn) { make(nxt, gn); wait_mt(nxt >> 3); }
    int tkv[4];
#pragma unroll
    for (int m = 0; m < 4; ++m) {
      const int r = wr * 64 + 16 * m + fr;
      tkv[m] = moe_token(p.list(), mm, bucket, tib * TM + (r < nrow ? r : nrow - 1));
    }
    f32x4 acc[4][4];
    gemm_mainloop<false>(g, gn, hasn, pre, smem, acc);
    pre = hasn; g = gn;
    u32x2 xrv[4][4]; f32x4 g2v[4][4];
    u32x2 pkx[2][4];
    float* g2l = (float*)(smem + 32768);
    *(f32x4*)(g2l + (tid >> 5) * 128 + (tid & 31) * 4) = *(const f32x4*)(modl + (size_t)(tid >> 5) * 6144 + 5 * 1024 + n0 + (tid & 31) * 4);
#pragma unroll
    for (int m = 0; m < 4; ++m)
#pragma unroll
      for (int n = 0; n < 4; ++n) xrv[m][n] = *(const u32x2*)(p.x1() + (size_t)tkv[m] * D + n0 + wc * 64 + 16 * n + 4 * fq);
    __syncthreads();
#pragma unroll
    for (int m = 0; m < 4; ++m)
#pragma unroll
      for (int n = 0; n < 4; ++n) g2v[m][n] = *(const f32x4*)(g2l + (tkv[m] / S) * 128 + wc * 64 + 16 * n + 4 * fq);
    __syncthreads();
#pragma unroll
    for (int m = 0; m < 4; ++m) {
      const int r = wr * 64 + 16 * m + fr;
      const int tk = tkv[m];
      f32x4 o[4];
#pragma unroll
      for (int n = 0; n < 4; ++n) {
        const u32x2 xr = xrv[m][n];
        const f32x4 xv = {bf_lo(xr[0]), bf_hi(xr[0]), bf_lo(xr[1]), bf_hi(xr[1])};
        const f32x4 g2 = g2v[m][n];
#pragma unroll
        for (int j = 0; j < 4; ++j) o[n][j] = xv[j] + g2[j] * acc[m][n][j];
      }
      if (XBOUT) {
        float ssr = 0.f;
#pragma unroll
        for (int n = 0; n < 4; ++n) ssr += (o[n][0] * o[n][0] + o[n][1] * o[n][1]) + (o[n][2] * o[n][2] + o[n][3] * o[n][3]);
        ssr += __shfl_xor(ssr, 16); ssr += __shfl_xor(ssr, 32);
        if (fq == 0 && r < nrow) p.ssqx()[(size_t)tk * 16 + nt * 2 + wc] = ssr;
      }
      if (XBOUT) {
#pragma unroll
        for (int n = 0; n < 4; ++n) pkx[m & 1][n] = (u32x2){pack2(o[n][0], o[n][1]), pack2(o[n][2], o[n][3])};
        if (m & 1) {
          const int mr = m - 1 + (fq & 1);
          const int rr = wr * 64 + 16 * mr + fr;
          const int tkr = (fq & 1) ? tkv[m] : tkv[m - 1];
#pragma unroll
          for (int n = 0; n < 4; ++n) {
            const u32x4 v = pair16(pkx[0][n], pkx[1][n]);
            if (rr < nrow) *(u32x4*)(p.xb() + (size_t)tkr * D + n0 + wc * 64 + 16 * n + 8 * (fq >> 1)) = v;
          }
        }
      } else if (r < nrow) {
#pragma unroll
        for (int n = 0; n < 4; ++n) __builtin_nontemporal_store(o[n], (f32x4*)(p.out + (size_t)tk * D + n0 + wc * 64 + 16 * n + 4 * fq));
      }
    }
  }
}
#define XB_TMO      128
#define XB_XCNT(j)  (256  + 64 * (j))
#define XB_XSUB(j)  (1280 + 64 * (j))
#define XB_XGEN(j)  (2304 + 64 * (j))
#define XB_TOP      3328
#define XB_TOPGEN   3392
#define XCD_BAR_WORDS 3456
#define XB_SPIN_CAP (1u << 22)
#define LAS __attribute__((address_space(3)))

__device__ __forceinline__ unsigned xb_ld(unsigned* p)              { return __hip_atomic_load(p, __ATOMIC_RELAXED, __HIP_MEMORY_SCOPE_AGENT); }
__device__ __forceinline__ unsigned xb_add(unsigned* p, unsigned v) { return __hip_atomic_fetch_add(p, v, __ATOMIC_RELAXED, __HIP_MEMORY_SCOPE_AGENT); }
__device__ __forceinline__ unsigned xb_xcc_id() { return (unsigned)__builtin_amdgcn_s_getreg((3 << 11) | 20) & 0xFu; }
#define XB_SPIN(cond, bar) do { unsigned _sp = 0; while (cond) { __builtin_amdgcn_s_sleep(1); \
    if ((++_sp & 255u) == 0u) { if (xb_ld(&(bar)[XB_TMO])) break; if (_sp > XB_SPIN_CAP) { atomicAdd(&(bar)[XB_TMO], 1u); break; } } } } while (0)

struct XcdBarrier { unsigned* bar; unsigned x; volatile LAS unsigned* st; };

__device__ __forceinline__ XcdBarrier xcd_barrier_post(unsigned* bar, volatile LAS unsigned* st) {
  XcdBarrier b; b.bar = bar; b.x = xb_xcc_id(); b.st = st;
  if (threadIdx.x == 0) (void)xb_add(&bar[XB_XCNT(b.x)], 1u);
  return b;
}
__device__ __forceinline__ void xcd_barrier_complete(unsigned* bar, unsigned x, unsigned& nloc, unsigned& nx) {
  const unsigned G = gridDim.x * gridDim.y * gridDim.z;
  unsigned sum, cnt, mine, sp = 0u;
  for (;;) {
    sum = 0u; cnt = 0u; mine = 0u;
#pragma unroll
    for (unsigned j = 0; j < 16; ++j) { const unsigned c = xb_ld(&bar[XB_XCNT(j)]); sum += c; cnt += (c > 0u) ? 1u : 0u; mine = (j == x) ? c : mine; }
    if (sum == G) break;
    __builtin_amdgcn_s_sleep(1);
    if ((++sp & 255u) == 0u) { if (xb_ld(&bar[XB_TMO])) break; if (sp > XB_SPIN_CAP) { atomicAdd(&bar[XB_TMO], 1u); break; } }
  }
  nloc = mine > 0u ? mine : 1u; nx = cnt > 0u ? cnt : 1u;
}
__device__ __forceinline__ void xcd_barrier(const XcdBarrier& b) {
  asm volatile("s_waitcnt vmcnt(0)" ::: "memory");
  __syncthreads();
  if (threadIdx.x == 0) {
    unsigned* bar = b.bar;
    __builtin_amdgcn_s_waitcnt(0);
    unsigned nloc = b.st[0], nx = b.st[1];
    if (nloc == 0u) { xcd_barrier_complete(bar, b.x, nloc, nx); b.st[0] = nloc; b.st[1] = nx; }
    const unsigned old = xb_add(&bar[XB_XSUB(b.x)], 1u);
    const unsigned gen = old / nloc;
    if (old + 1u == (gen + 1u) * nloc) {
      __builtin_amdgcn_fence(__ATOMIC_RELEASE, "");
      asm volatile("s_waitcnt vmcnt(0)" ::: "memory");
      const unsigned og = xb_add(&bar[XB_TOP], 1u);
      const unsigned tg = og / nx;
      if (og + 1u == (tg + 1u) * nx) xb_add(&bar[XB_TOPGEN], 1u);
      else XB_SPIN(xb_ld(&bar[XB_TOPGEN]) == tg, bar);
      __builtin_amdgcn_fence(__ATOMIC_ACQUIRE, "");
      xb_add(&bar[XB_XGEN(b.x)], 1u);
      asm volatile("s_waitcnt vmcnt(0)" ::: "memory");
    } else {
      XB_SPIN(xb_ld(&bar[XB_XGEN(b.x)]) == gen, bar);
      __builtin_amdgcn_fence(__ATOMIC_ACQUIRE, "");
      asm volatile("s_waitcnt vmcnt(0)" ::: "memory");
    }
  }
  __syncthreads();
}

constexpr int NSUB = 9;

template <int L>
__device__ __forceinline__ void run_layer(const MP& p, char* smem, const XcdBarrier& xb, int ssm_wid, int idle_id, int ssm_lrank, bool fast, bool fast_ssm) {
  constexpr int l = L;
  const float* xin = L == 0 ? p.in.x : p.out;
  if (L == 0) { phase_norm1<false>(p, l, xin); if (!fast) xcd_barrier(xb); }
  phase_inproj<(L > 0)>(p, l, smem, fast && L == 0);
  if (fast_ssm) {
    if (ssm_wid >= 0) {
      if (threadIdx.x < 64) {
        const unsigned* f = p.flags() + CL_IP + (l * 8 + (int)(blockIdx.x & 7)) * 64 + threadIdx.x;
        unsigned sp = 0;
        for (;;) {
          unsigned v;
          asm volatile("global_load_dword %0, %1, off sc1\n\ts_waitcnt vmcnt(0)" : "=&v"(v) : "v"(f) : "memory");
          if (__builtin_amdgcn_ballot_w64(v == 0u) == 0ull || ++sp > (1u << 16)) break;
          __builtin_amdgcn_s_sleep(1);
        }
      }
      __syncthreads();
    }
  } else xcd_barrier(xb);
  phase_ssm(p, l, smem, ssm_wid, ssm_lrank);
  {
    constexpr int TT_SMALL = TT_WIN + TT_GLU + TT_OUT, E0 = L * TT_LAYER + TT_SMALL, NCH = 3 * TT_EXP / 4 / 8;
    const int x = blockIdx.x & 7;
    unsigned* ctr = p.claim() + 4128 + L * 8 + x;
    volatile int* bw = (volatile int*)(smem + SMEM_MM);
#pragma unroll 1
    for (;;) {
      __syncthreads();
      if (threadIdx.x == 0) bw[0] = (int)xb_add(ctr, 1u);
      __syncthreads();
      const int c = launder_s(__builtin_amdgcn_readfirstlane(bw[0]));
      if (c >= NCH) break;
      const int t0 = E0 + (x * NCH + c) * 4;
      phase0_transposes(p, smem, t0, t0 + 4, 0, 1);
    }
  }
  if (fast_ssm) {
    if (threadIdx.x < 64) {
      const unsigned* f = p.flags() + CL_SSM + (l * 8 + (int)(blockIdx.x & 7)) * 32 + (threadIdx.x & 31);
      unsigned sp = 0;
      for (;;) {
        unsigned v;
        asm volatile("global_load_dword %0, %1, off sc1\n\ts_waitcnt vmcnt(0)" : "=&v"(v) : "v"(f) : "memory");
        if (__builtin_amdgcn_ballot_w64(v == 0u) == 0ull || ++sp > (1u << 16)) break;
        __builtin_amdgcn_s_sleep(1);
      }
    }
    __syncthreads();
  } else xcd_barrier(xb);
#pragma unroll 1
  for (int step = 0; step < 2; ++step) {
    if ((step == 0) == (ssm_wid >= 0)) phase_glu(p, l, smem);
    else phase_attn(p, l, smem);
  }
  if (!fast) xcd_barrier(xb);
  phase_out<(L > 0)>(p, l, smem, xin);
  if (!fast) xcd_barrier(xb);
  phase_norm2_route(p, l, smem);
  if (L + 1 < DEPTH) {
    fold_inproj_next(p, l + 1);
  }
  xcd_barrier(xb);
  phase_moe_gu(p, l, smem);
  if (!fast) xcd_barrier(xb);
  phase_moe_down<(L + 1 < DEPTH)>(p, l, smem);
  if (L + 1 < DEPTH) xcd_barrier(xb);
}

__global__ void __launch_bounds__(NTHR, 2) mega(MP p) {
  __shared__ __attribute__((aligned(16))) char smem[65536 + 32 + 2048];
  unsigned* xb_words = (unsigned*)(smem + 65536);
  if (threadIdx.x < 8) xb_words[threadIdx.x] = 0u;
  __syncthreads();
  const XcdBarrier xb = xcd_barrier_post(p.bar(), (volatile LAS unsigned*)xb_words);
  if (threadIdx.x == 0) __hip_atomic_store(p.flags() + CL_XCC + blockIdx.x, xb.x + 1u, __ATOMIC_RELAXED, __HIP_MEMORY_SCOPE_AGENT);
  if (threadIdx.x == 0) {
    const unsigned key = (xb_xcc_id() << 8) | ((unsigned)__builtin_amdgcn_s_getreg((7 << 11) | (8 << 6) | 4) & 0xffu);
    const unsigned rank = xb_add(p.claim() + key, 1u);
    xb_words[2] = rank == 0u ? xb_add(p.claim() + 4096, 1u) : 0xffffffffu;
    xb_words[3] = rank == 0u ? 0xffffffffu : xb_add(p.claim() + 4097, 1u);
    xb_words[4] = rank == 0u ? xb_add(p.claim() + 4104 + (blockIdx.x & 7), 1u) : 0xffffffffu;
  }
  __syncthreads();
  const int ssm_wid = (int)xb_words[2], idle_id = (int)xb_words[3], ssm_lrank = (int)xb_words[4];
  for (int i = blockIdx.x * NTHR + threadIdx.x; i < CL_WORDS - CL_MTC; i += gridDim.x * NTHR) p.flags()[CL_MTC + i] = 0u;
  for (int it = blockIdx.x; it < P0_MISC; it += gridDim.x) phase0_item(p, it, smem);
  {
    const int G = (int)gridDim.x, r1 = G - 1 - (int)blockIdx.x;
    int r2 = (G - 1 - (TT_WIN + TT_GLU + TT_OUT) % G) - (int)blockIdx.x; r2 += r2 < 0 ? G : 0;
    phase0_transposes(p, smem, 0, TT_WIN + TT_GLU + TT_OUT, r1, G);
    phase0_transposes(p, smem, TT_LAYER, TT_LAYER + TT_WIN + TT_GLU + TT_OUT, r2, G);
  }
  xcd_barrier(xb);
  bool fast;
  {
    int ok = gridDim.x == 512u ? 1 : 0;
    if (ok) {
      for (int i = threadIdx.x; i < 512; i += NTHR) {
        const unsigned a = p.flags()[CL_XCC + i], r = p.flags()[CL_XCC + (i & 7)];
        ok &= (a == r && a != 0u) ? 1 : 0;
      }
    }
    if (!ok) xb_words[5] = 1u;
    __syncthreads();
    fast = xb_words[5] == 0u;
  }
  bool fast_ssm = fast;
#pragma unroll
  for (int x = 0; x < 8; ++x) fast_ssm = fast_ssm && p.claim()[4104 + x] > 0u;
  run_layer<0>(p, smem, xb, ssm_wid, idle_id, ssm_lrank, fast, fast_ssm);
  run_layer<1>(p, smem, xb, ssm_wid, idle_id, ssm_lrank, fast, fast_ssm);
  static_assert(DEPTH == 2, "two layers instantiated");
}

}

extern "C" void kernel_launch(void* const* d_in, const int* in_sizes, int n_in, void* d_out, int out_size, void* d_ws,
                              size_t ws_size, hipStream_t stream) {
  MP p; memset(&p, 0, sizeof(p));
  Ptrs& P = p.in;
  P.x = (const float*)d_in[0]; P.c = (const float*)d_in[1]; P.pos = (const int*)d_in[2];
  P.ada_w = (const float*)d_in[3]; P.ada_b = (const float*)d_in[4]; P.norm1_g = (const float*)d_in[5];
  P.w_in = (const float*)d_in[6]; P.q_norm_g = (const float*)d_in[7]; P.k_norm_g = (const float*)d_in[8];
  P.attn_sink = (const float*)d_in[9]; P.lam_re = (const float*)d_in[10]; P.lam_im = (const float*)d_in[11];
  P.b_re = (const float*)d_in[12]; P.b_im = (const float*)d_in[13]; P.c_re = (const float*)d_in[14]; P.c_im = (const float*)d_in[15];
  P.ssm_d = (const float*)d_in[16]; P.log_dt = (const float*)d_in[17]; P.w_glu = (const float*)d_in[18];
  P.attn_out_g = (const float*)d_in[19]; P.ssm_out_g = (const float*)d_in[20]; P.w_out = (const float*)d_in[21];
  P.norm2_g = (const float*)d_in[22]; P.w_router = (const float*)d_in[23]; P.router_bias = (const float*)d_in[24];
  P.w_gate = (const float*)d_in[25]; P.w_up = (const float*)d_in[26]; P.w_down = (const float*)d_in[27];
  p.out = (float*)d_out;

  p.ws = (char*)d_ws;
  if (WS_TOTAL > ws_size) { fprintf(stderr, "workspace too small: need %zu have %zu\n", (size_t)WS_TOTAL, ws_size); return; }
  (void)in_sizes; (void)n_in; (void)out_size;

  static int grid_blocks = 0;
  if (!grid_blocks) {
    int dev = 0, cus = 0, per_cu = 0;
    (void)hipGetDevice(&dev);
    (void)hipDeviceGetAttribute(&cus, hipDeviceAttributeMultiprocessorCount, dev);
    (void)hipOccupancyMaxActiveBlocksPerMultiprocessor(&per_cu, mega, NTHR, 0);
    if (per_cu > 2) per_cu = 2;
    if (per_cu < 1) per_cu = 1;
    grid_blocks = cus * per_cu;
  }
  (void)hipMemsetAsync(p.ws + OFF_BAR, 0, OFF_MOD - OFF_BAR, stream);
  void* args[] = {&p};
  hipError_t e = hipLaunchCooperativeKernel((void*)mega, dim3(grid_blocks), dim3(NTHR), args, 0, stream);
  if (e != hipSuccess) fprintf(stderr, "cooperative launch failed: %s (grid %d)\n", hipGetErrorString(e), grid_blocks);
}
```
